# Optimizing an MI355X kernel written in HIP

```python
import jax, jax.numpy as jnp
from jax import lax
import numpy as np

D_MODEL = 1024
BATCH = 8
SEQ = 4096
DEPTH = 1

GRID_W = 64
EPS = 1e-6
SSD_HEADS = 16
SSD_HEADDIM = 64
D_SSD = SSD_HEADS * SSD_HEADDIM
SSD_GROUPS = 4
SSD_HPG = SSD_HEADS // SSD_GROUPS
SSD_STATE = 128
SSD_CHUNK = 128
CONV_W = 5
D_XBC = D_SSD + 2 * SSD_GROUPS * SSD_STATE
NA_HEADS = 16
NA_HEADDIM = 64
D_NA = NA_HEADS * NA_HEADDIM
NA_KH = 8
NA_KW = 16
NA_QB = 16
NA_KB = NA_QB + NA_KW
PEER_HEADS = 8
PEER_NKEYS = 128
PEER_EXPERTS = PEER_NKEYS * PEER_NKEYS
PEER_TOPK = 16
PEER_DKEY = 256
PEER_DHALF = PEER_DKEY // 2
PEER_CHUNK = 128
IN_SIZES = (D_SSD, D_XBC, SSD_HEADS, SSD_HEADS, 3 * D_NA, D_MODEL, D_MODEL)
D_IN = sum(IN_SIZES)
IN_OFFSETS = [int(o) for o in np.cumsum(IN_SIZES)[:-1]]

kernel_name = "hybrid_ssd_natten_peer_block"


def rms_norm(x, g):
    xf = x.astype(jnp.float32)
    y = xf * lax.rsqrt(jnp.mean(xf * xf, axis=-1, keepdims=True) + EPS)
    return (y * g.astype(jnp.float32)).astype(x.dtype)


def modulate(h, g, shift, scale):
    return rms_norm(h, g) * (1 + scale[:, None, :]) + shift[:, None, :]


def ssd_direction(xh, dt, a, bm, cm):
    b, l, g, k, p = xh.shape
    nc, L = l // SSD_CHUNK, SSD_CHUNK
    f32 = jnp.float32
    xdt = (xh.astype(f32) * dt[..., None]).reshape(b, nc, L, g, k, p)
    bc = bm.astype(f32).reshape(b, nc, L, g, SSD_STATE)
    cc = cm.astype(f32).reshape(b, nc, L, g, SSD_STATE)
    da = (dt * a).reshape(b, nc, L, g, k).transpose(0, 3, 4, 1, 2)
    cs = jnp.cumsum(da, axis=-1)
    lower = jnp.tril(jnp.ones((L, L), dtype=bool))
    seg = jnp.exp(jnp.where(lower, cs[..., :, None] - cs[..., None, :], -jnp.inf))
    cb = jnp.einsum('bclgn,bcsgn->bcgls', cc, bc)
    y_diag = jnp.einsum('bcgls,bgkcls,bcsgkp->bclgkp', cb, seg, xdt)
    decay_in = jnp.exp(cs[..., -1:] - cs)
    states = jnp.einsum('bclgn,bgkcl,bclgkp->cbgkpn', bc, decay_in, xdt)
    chunk_decay = jnp.exp(cs[..., -1]).transpose(3, 0, 1, 2)

    def step(hs, inp):
        s_c, d_c = inp
        return d_c[..., None, None] * hs + s_c, hs

    _, prev = lax.scan(step, jnp.zeros(states.shape[1:], f32), (states, chunk_decay))
    y_off = jnp.einsum('bclgn,cbgkpn,bgkcl->bclgkp', cc, prev, jnp.exp(cs))
    return (y_diag + y_off).reshape(b, l, g, k, p)


def ssd_branch(z, xbc, dt_raw_f, dt_raw_b, conv_w, conv_b, dt_bias_f, dt_bias_b,
               a_log_f, a_log_b, d_skip, norm_g):
    b, l, _ = xbc.shape
    f32 = jnp.float32
    xbc = lax.conv_general_dilated(xbc, conv_w[:, None, :].astype(xbc.dtype), (1,),
                                   [(CONV_W // 2, CONV_W // 2)],
                                   dimension_numbers=('NWC', 'WIO', 'NWC'),
                                   feature_group_count=D_XBC)
    xbc = jax.nn.silu(xbc + conv_b)
    xs, bm, cm = jnp.split(xbc, [D_SSD, D_SSD + SSD_GROUPS * SSD_STATE], axis=-1)
    xh = xs.reshape(b, l, SSD_GROUPS, SSD_HPG, SSD_HEADDIM)
    bm = bm.reshape(b, l, SSD_GROUPS, SSD_STATE)
    cm = cm.reshape(b, l, SSD_GROUPS, SSD_STATE)
    gk = (b, l, SSD_GROUPS, SSD_HPG)
    dt_f = jax.nn.softplus(dt_raw_f.astype(f32) + dt_bias_f.astype(f32)).reshape(gk)
    dt_b = jax.nn.softplus(dt_raw_b.astype(f32) + dt_bias_b.astype(f32)).reshape(gk)
    a_f = -jnp.exp(a_log_f.astype(f32)).reshape(SSD_GROUPS, SSD_HPG)
    a_b = -jnp.exp(a_log_b.astype(f32)).reshape(SSD_GROUPS, SSD_HPG)
    y_f = ssd_direction(xh, dt_f, a_f, bm, cm)
    y_b = ssd_direction(xh[:, ::-1], dt_b[:, ::-1], a_b, bm[:, ::-1], cm[:, ::-1])[:, ::-1]
    y = y_f + y_b + d_skip.astype(f32).reshape(SSD_GROUPS, SSD_HPG, 1) * xh.astype(f32)
    y = y.reshape(b, l, D_SSD).astype(z.dtype)
    return rms_norm(y * jax.nn.silu(z), norm_g)


def neighbourhood_attention(q, k, v, rpb):
    b, l, _ = q.shape
    rows = l // GRID_W
    kh = min(NA_KH, rows)
    ncb = GRID_W // NA_QB

    def grid(t):
        return t.reshape(b, rows, GRID_W, NA_HEADS, NA_HEADDIM).transpose(0, 3, 1, 2, 4)

    qg = grid(q) * (NA_HEADDIM ** -0.5)
    kg, vg = grid(k), grid(v)
    cols = np.arange(GRID_W)
    win_start = np.clip(cols - NA_KW // 2, 0, GRID_W - NA_KW).reshape(ncb, NA_QB)
    blk_start = np.clip(np.arange(ncb) * NA_QB - NA_KW // 2, 0, GRID_W - NA_KB)
    key_cols = blk_start[:, None] + np.arange(NA_KB)
    q_cols = cols.reshape(ncb, NA_QB)
    kc = key_cols[:, None, :]
    in_win = (kc >= win_start[:, :, None]) & (kc < win_start[:, :, None] + NA_KW)
    dcol = np.clip(kc - q_cols[:, :, None] + NA_KW - 1, 0, 2 * NA_KW - 2)
    col_bias = jnp.where(in_win, rpb.astype(jnp.float32)[:, :, dcol], -jnp.inf)

    def row(r):
        rs = jnp.clip(r - kh // 2, 0, rows - kh)
        drow = rs + jnp.arange(kh) - r + NA_KH - 1
        bias = col_bias[:, drow].transpose(0, 2, 3, 1, 4)
        qr = lax.dynamic_index_in_dim(qg, r, axis=2, keepdims=False)
        qr = qr.reshape(b, NA_HEADS, ncb, NA_QB, NA_HEADDIM)
        kr = lax.dynamic_slice_in_dim(kg, rs, kh, axis=2)[:, :, :, key_cols]
        vr = lax.dynamic_slice_in_dim(vg, rs, kh, axis=2)[:, :, :, key_cols]
        s = jnp.einsum('bhmqd,bhimjd->bhmqij', qr, kr).astype(jnp.float32) + bias
        sh = s.shape
        p = jax.nn.softmax(s.reshape(sh[0], sh[1], sh[2], sh[3], kh * NA_KB), axis=-1)
        p = p.reshape(sh).astype(vr.dtype)
        o = jnp.einsum('bhmqij,bhimjd->bhmqd', p, vr)
        return o.reshape(b, NA_HEADS, GRID_W, NA_HEADDIM)

    out = lax.map(row, jnp.arange(rows))
    return out.transpose(1, 0, 3, 2, 4).reshape(b, l, D_NA)


def peer(xn, w_q, sub_keys, u, v):
    b, l, d = xn.shape
    xt = xn.reshape(-1, PEER_CHUNK, d)

    def chunk(xc):
        q = (xc @ w_q).reshape(PEER_CHUNK, PEER_HEADS, 2, PEER_DHALF)
        s = jnp.einsum('thzd,znd->thzn', q, sub_keys).astype(jnp.float32)
        s1, i1 = lax.top_k(s[:, :, 0], PEER_TOPK)
        s2, i2 = lax.top_k(s[:, :, 1], PEER_TOPK)
        cand = (s1[..., :, None] + s2[..., None, :]).reshape(PEER_CHUNK, PEER_HEADS, PEER_TOPK * PEER_TOPK)
        cidx = (i1[..., :, None] * PEER_NKEYS + i2[..., None, :]).reshape(PEER_CHUNK, PEER_HEADS, PEER_TOPK * PEER_TOPK)
        top, pos = lax.top_k(cand, PEER_TOPK)
        eidx = jnp.take_along_axis(cidx, pos, axis=-1)
        gate = jax.nn.softmax(top, axis=-1)
        act = jax.nn.gelu(jnp.einsum('thkd,td->thk', u[eidx], xc).astype(jnp.float32), approximate=False)
        return jnp.einsum('thk,thkd->td', (gate * act).astype(v.dtype), v[eidx])

    return lax.map(chunk, xt).reshape(b, l, d)


def hybrid_layer(h, c, w_ada, b_ada, norm1_g, w_in, conv_w, conv_b, dt_bias_f, dt_bias_b,
                 a_log_f, a_log_b, d_skip, ssd_norm_g, w_ssd_br, na_rpb, w_na_br, w_out,
                 norm2_g, peer_wq, peer_keys, peer_u, peer_v):
    mod = jax.nn.silu(c) @ w_ada + b_ada
    sh1, sc1, g1, sh2, sc2, g2 = jnp.split(mod, 6, axis=-1)
    n1 = modulate(h, norm1_g, sh1, sc1)
    proj = n1 @ w_in
    z, xbc, dtf, dtb, qkv, gate_ssd, gate_na = jnp.split(proj, IN_OFFSETS, axis=-1)
    y_ssd = ssd_branch(z, xbc, dtf, dtb, conv_w, conv_b, dt_bias_f, dt_bias_b,
                       a_log_f, a_log_b, d_skip, ssd_norm_g) @ w_ssd_br
    q, k, v = jnp.split(qkv, 3, axis=-1)
    y_na = neighbourhood_attention(q, k, v, na_rpb) @ w_na_br
    mixed = jax.nn.sigmoid(gate_ssd) * y_ssd + jax.nn.sigmoid(gate_na) * y_na
    h = h + g1[:, None, :] * (mixed @ w_out)
    n2 = modulate(h, norm2_g, sh2, sc2)
    h = h + g2[:, None, :] * peer(n2, peer_wq, peer_keys, peer_u, peer_v)
    return h


def setup_inputs(seed: int = 0) -> dict:
    key = jax.random.key(seed)
    ks = jax.random.split(key, 32)
    f32 = jnp.float32
    nrm = lambda k, shape, s: jax.random.normal(k, shape, f32) * s
    dt0 = jnp.exp(jax.random.uniform(ks[8], (DEPTH, 2, SSD_HEADS), f32) * (np.log(0.1) - np.log(0.001)) + np.log(0.001))
    dt_bias = dt0 + jnp.log(-jnp.expm1(-dt0))
    a_log = jnp.log(jax.random.uniform(ks[9], (DEPTH, 2, SSD_HEADS), f32, 1.0, 16.0))
    return {
        "x": nrm(ks[0], (BATCH, SEQ, D_MODEL), 1.0),
        "c": nrm(ks[1], (BATCH, D_MODEL), 1.0),
        "w_ada": nrm(ks[2], (DEPTH, D_MODEL, 6 * D_MODEL), D_MODEL ** -0.5),
        "b_ada": nrm(ks[3], (DEPTH, 6 * D_MODEL), 0.01),
        "norm1_g": 1.0 + nrm(ks[4], (DEPTH, D_MODEL), 0.05),
        "w_in": nrm(ks[5], (DEPTH, D_MODEL, D_IN), D_MODEL ** -0.5),
        "conv_w": nrm(ks[6], (DEPTH, CONV_W, D_XBC), CONV_W ** -0.5),
        "conv_b": nrm(ks[7], (DEPTH, D_XBC), 0.01),
        "dt_bias_f": dt_bias[:, 0],
        "dt_bias_b": dt_bias[:, 1],
        "a_log_f": a_log[:, 0],
        "a_log_b": a_log[:, 1],
        "d_skip": 1.0 + nrm(ks[10], (DEPTH, SSD_HEADS), 0.1),
        "ssd_norm_g": 1.0 + nrm(ks[11], (DEPTH, D_SSD), 0.05),
        "w_ssd_br": nrm(ks[12], (DEPTH, D_SSD, D_MODEL), D_SSD ** -0.5),
        "na_rpb": nrm(ks[13], (DEPTH, NA_HEADS, 2 * NA_KH - 1, 2 * NA_KW - 1), 0.1),
        "w_na_br": nrm(ks[14], (DEPTH, D_NA, D_MODEL), D_NA ** -0.5),
        "w_out": nrm(ks[15], (DEPTH, D_MODEL, D_MODEL), D_MODEL ** -0.5),
        "norm2_g": 1.0 + nrm(ks[16], (DEPTH, D_MODEL), 0.05),
        "peer_wq": nrm(ks[17], (DEPTH, D_MODEL, PEER_HEADS * PEER_DKEY), D_MODEL ** -0.5),
        "peer_keys": nrm(ks[18], (DEPTH, 2, PEER_NKEYS, PEER_DHALF), PEER_DHALF ** -0.5),
        "peer_u": nrm(ks[19], (DEPTH, PEER_EXPERTS, D_MODEL), D_MODEL ** -0.5),
        "peer_v": nrm(ks[20], (DEPTH, PEER_EXPERTS, D_MODEL), PEER_HEADS ** -0.5),
        "final_g": 1.0 + nrm(ks[21], (D_MODEL,), 0.05),
    }


def reference(x, c, w_ada, b_ada, norm1_g, w_in, conv_w, conv_b, dt_bias_f, dt_bias_b,
              a_log_f, a_log_b, d_skip, ssd_norm_g, w_ssd_br, na_rpb, w_na_br, w_out,
              norm2_g, peer_wq, peer_keys, peer_u, peer_v, final_g):
    h = x
    for i in range(DEPTH):
        h = hybrid_layer(h, c, w_ada[i], b_ada[i], norm1_g[i], w_in[i], conv_w[i], conv_b[i],
                         dt_bias_f[i], dt_bias_b[i], a_log_f[i], a_log_b[i], d_skip[i],
                         ssd_norm_g[i], w_ssd_br[i], na_rpb[i], w_na_br[i], w_out[i],
                         norm2_g[i], peer_wq[i], peer_keys[i], peer_u[i], peer_v[i])
    return rms_norm(h, final_g)
```

```cpp
#include <hip/hip_runtime.h>
#include <cstdio>
#include <cstdint>

#define LAS __attribute__((address_space(3)))
typedef unsigned short bf16_t;
typedef float f32x4 __attribute__((ext_vector_type(4)));
typedef unsigned u32x4 __attribute__((ext_vector_type(4)));
typedef unsigned u32x2 __attribute__((ext_vector_type(2)));
typedef __bf16 bf16x2_t __attribute__((ext_vector_type(2)));

constexpr int T = 32768, D = 1024, NB = 8, SEQ = 4096;
constexpr int NWAVES = 8, NTHR = 512;
constexpr float EPS = 1e-6f;
constexpr int OFF_Z = 0, OFF_XBC = 1024, OFF_DTF = 3072, OFF_DTB = 3088, OFF_QKV = 3104, OFF_GS = 6176, OFF_GN = 7200, D_IN = 8224;

constexpr size_t MiB = 1u << 20;
constexpr size_t WS_CTL = 0;
constexpr size_t WS_MOD = 1 * MiB;
constexpr size_t WS_RSTD = 1 * MiB + 512 * 1024;
constexpr size_t WS_DT = 2 * MiB;
constexpr size_t WS_WIN_T = 6 * MiB;
constexpr size_t WS_WG_T = 18 * MiB;
constexpr size_t WS_WDT_T = 22 * MiB;
constexpr size_t WS_KEYS = 22 * MiB + 512 * 1024;
constexpr size_t WS_WSSD_T = 23 * MiB, WS_WNA_T = 25 * MiB, WS_WOUT_T = 27 * MiB, WS_WPQ_T = 29 * MiB;
constexpr size_t WS_R0 = 40 * MiB, WS_R1 = 104 * MiB, WS_R2 = 168 * MiB, WS_R3 = 296 * MiB, WS_END = 488 * MiB;

constexpr int LDS_BYTES = 147456;

struct Args { const float* in[24]; float* out; unsigned char* ws; int ph_lo, ph_hi; };

__device__ __forceinline__ float bf2f(unsigned v) { return __uint_as_float(v << 16); }
__device__ __forceinline__ float bflo(unsigned v) { return __uint_as_float(v << 16); }
__device__ __forceinline__ float bfhi(unsigned v) { return __uint_as_float(v & 0xffff0000u); }
__device__ __forceinline__ unsigned f2bf(float f) { unsigned u = __float_as_uint(f); return (u + 0x7fffu + ((u >> 16) & 1u)) >> 16; }
__device__ __forceinline__ unsigned pk2(float lo, float hi) { return f2bf(lo) | (f2bf(hi) << 16); }
__device__ __forceinline__ float wave_sum(float v) {
#pragma unroll
    for (int o = 1; o < 64; o <<= 1) v += __shfl_xor(v, o);
    return v;
}
__device__ __forceinline__ float silu_f(float x) { return x / (1.f + __expf(-x)); }
__device__ __forceinline__ float sigmoid_f(float x) { return 1.f / (1.f + __expf(-x)); }
__device__ __forceinline__ float softplus_f(float x) { return x > 20.f ? x : log1pf(__expf(x)); }
__device__ __forceinline__ float gelu_f(float x) { return 0.5f * x * (1.f + erff(x * 0.70710678118654752f)); }

struct Ctx {
    const float* const* in; float* out; unsigned char* ws;
    int tid, lane, wave, G, bid;
    LAS unsigned char* lds;
    __device__ __forceinline__ float* f32p(size_t off) const { return (float*)(ws + off); }
    __device__ __forceinline__ bf16_t* bfp(size_t off) const { return (bf16_t*)(ws + off); }
};

__device__ __forceinline__ void p_prep(const Ctx& C) {
    const int gt = C.bid * NTHR + C.tid, NT = C.G * NTHR;
    const float* c = C.in[1]; const float* w_ada = C.in[2]; const float* b_ada = C.in[3];
    float* mod = C.f32p(WS_MOD);
    for (int i = gt; i < NB * 6144; i += NT) {
        const int b = i / 6144, j = i % 6144; float acc = 0.f;
        for (int k = 0; k < D; ++k) acc += silu_f(c[b * D + k]) * w_ada[(size_t)k * 6144 + j];
        mod[i] = acc + b_ada[j];
    }
    const float* w_in = C.in[5];
    {
        bf16_t* wt = C.bfp(WS_WIN_T);
        for (int i = gt; i < 6144 * (D / 8); i += NT) { const int n = i % 6144, k8 = i / 6144; const int col = n < 3072 ? n : OFF_QKV + (n - 3072);
            u32x4 o; const float* s = w_in + (size_t)(k8 * 8) * D_IN + col;
            o.x = pk2(s[0], s[(size_t)D_IN]); o.y = pk2(s[2 * (size_t)D_IN], s[3 * (size_t)D_IN]); o.z = pk2(s[4 * (size_t)D_IN], s[5 * (size_t)D_IN]); o.w = pk2(s[6 * (size_t)D_IN], s[7 * (size_t)D_IN]);
            *(u32x4*)(wt + (size_t)n * D + k8 * 8) = o; }
    }
    {
        bf16_t* wt = C.bfp(WS_WG_T);
        for (int i = gt; i < 2048 * (D / 8); i += NT) { const int n = i % 2048, k8 = i / 2048; const int col = OFF_GS + n;
            u32x4 o; const float* s = w_in + (size_t)(k8 * 8) * D_IN + col;
            o.x = pk2(s[0], s[(size_t)D_IN]); o.y = pk2(s[2 * (size_t)D_IN], s[3 * (size_t)D_IN]); o.z = pk2(s[4 * (size_t)D_IN], s[5 * (size_t)D_IN]); o.w = pk2(s[6 * (size_t)D_IN], s[7 * (size_t)D_IN]);
            *(u32x4*)(wt + (size_t)n * D + k8 * 8) = o; }
    }
    {
        bf16_t* wt = C.bfp(WS_WDT_T);
        for (int i = gt; i < 32 * (D / 8); i += NT) { const int n = i % 32, k8 = i / 32; const int col = OFF_DTF + n;
            u32x4 o; const float* s = w_in + (size_t)(k8 * 8) * D_IN + col;
            o.x = pk2(s[0], s[(size_t)D_IN]); o.y = pk2(s[2 * (size_t)D_IN], s[3 * (size_t)D_IN]); o.z = pk2(s[4 * (size_t)D_IN], s[5 * (size_t)D_IN]); o.w = pk2(s[6 * (size_t)D_IN], s[7 * (size_t)D_IN]);
            *(u32x4*)(wt + (size_t)n * D + k8 * 8) = o; }
    }
    {
        const float* gk = C.in[13];
        const float* srcs[3] = {C.in[14], C.in[16], C.in[17]};
        const size_t dsts[3] = {WS_WSSD_T, WS_WNA_T, WS_WOUT_T};
#pragma unroll
        for (int w = 0; w < 3; ++w) {
            const float* W = srcs[w]; bf16_t* wt = C.bfp(dsts[w]);
            for (int i = gt; i < D * (D / 8); i += NT) { const int n = i % D, k8 = i / D; const float* s = W + (size_t)(k8 * 8) * D + n;
                float v[8];
#pragma unroll
                for (int q = 0; q < 8; ++q) v[q] = s[(size_t)q * D] * (w == 0 ? gk[k8 * 8 + q] : 1.f);
                u32x4 o; o.x = pk2(v[0], v[1]); o.y = pk2(v[2], v[3]); o.z = pk2(v[4], v[5]); o.w = pk2(v[6], v[7]);
                *(u32x4*)(wt + (size_t)n * D + k8 * 8) = o; }
        }
    }
    {
        const float* W = C.in[19]; bf16_t* wt = C.bfp(WS_WPQ_T);
        for (int i = gt; i < 2048 * (D / 8); i += NT) { const int n = i % 2048, k8 = i / 2048; const float* s = W + (size_t)(k8 * 8) * 2048 + n;
            u32x4 o; o.x = pk2(s[0], s[2048]); o.y = pk2(s[2 * 2048], s[3 * 2048]); o.z = pk2(s[4 * 2048], s[5 * 2048]); o.w = pk2(s[6 * 2048], s[7 * 2048]);
            *(u32x4*)(wt + (size_t)n * D + k8 * 8) = o; }
    }
    {
        const float* kf = C.in[20]; bf16_t* kb = C.bfp(WS_KEYS);
        for (int i = gt; i < 2 * 128 * 128; i += NT) kb[i] = (bf16_t)f2bf(kf[i]);
    }
}

__device__ __forceinline__ void p_rownorm(const Ctx& C, const float* X, const float* gamma, int sh_off, int sc_off, bf16_t* dst) {
    const float* mod = C.f32p(WS_MOD);
    const int gw = C.bid * NWAVES + C.wave, NGW = C.G * NWAVES;
    for (int row = gw; row < T; row += NGW) {
        const int b = row / SEQ;
        const f32x4* xr = (const f32x4*)(X + (size_t)row * D) + C.lane;
        f32x4 v[4]; float s = 0.f;
#pragma unroll
        for (int j = 0; j < 4; ++j) { v[j] = xr[64 * j]; s += (v[j].x * v[j].x + v[j].y * v[j].y) + (v[j].z * v[j].z + v[j].w * v[j].w); }
        const float rstd = rsqrtf(wave_sum(s) * (1.f / D) + EPS);
        u32x2* o8 = (u32x2*)(dst + (size_t)row * D) + C.lane;
#pragma unroll
        for (int j = 0; j < 4; ++j) {
            const int col = 4 * C.lane + 256 * j;
            const f32x4 g = *(const f32x4*)(gamma + col), sh = *(const f32x4*)(mod + b * 6144 + sh_off + col), sc = *(const f32x4*)(mod + b * 6144 + sc_off + col);
            f32x4 y = v[j] * rstd * g * (sc + 1.f) + sh;
            u32x2 w; w.x = pk2(y.x, y.y); w.y = pk2(y.z, y.w); o8[64 * j] = w;
        }
    }
}

template <class Epi>
__device__ __forceinline__ void naive_gemm(const Ctx& C, const bf16_t* A, const bf16_t* Bt, int M, int N, int K, const Epi& E) {
    LAS float* As = (LAS float*)C.lds;
    LAS float* Bs = (LAS float*)(C.lds + 32 * 132 * 4);
    const int tilesN = (N + 63) / 64, tilesM = M / 128, ntiles = tilesM * tilesN;
    const int ty = C.tid >> 4, tx = C.tid & 15;
    for (int tile = C.bid; tile < ntiles; tile += C.G) {
        const int tm = tile / tilesN, tn = tile % tilesN, m0 = tm * 128, n0 = tn * 64;
        float acc[4][4];
#pragma unroll
        for (int i = 0; i < 4; ++i)
#pragma unroll
            for (int j = 0; j < 4; ++j) acc[i][j] = 0.f;
        for (int k0 = 0; k0 < K; k0 += 32) {
            __syncthreads();
            {
                const int r = C.tid >> 2, kc = (C.tid & 3) * 8;
                const u32x4 v = *(const u32x4*)(A + (size_t)(m0 + r) * K + k0 + kc);
                As[(kc + 0) * 132 + r] = bflo(v.x); As[(kc + 1) * 132 + r] = bfhi(v.x); As[(kc + 2) * 132 + r] = bflo(v.y); As[(kc + 3) * 132 + r] = bfhi(v.y);
                As[(kc + 4) * 132 + r] = bflo(v.z); As[(kc + 5) * 132 + r] = bfhi(v.z); As[(kc + 6) * 132 + r] = bflo(v.w); As[(kc + 7) * 132 + r] = bfhi(v.w);
            }
            if (C.tid < 256) {
                const int r = C.tid >> 2, kc = (C.tid & 3) * 8;
                u32x4 v = (u32x4){0u, 0u, 0u, 0u};
                if (n0 + r < N) v = *(const u32x4*)(Bt + (size_t)(n0 + r) * K + k0 + kc);
                Bs[(kc + 0) * 68 + r] = bflo(v.x); Bs[(kc + 1) * 68 + r] = bfhi(v.x); Bs[(kc + 2) * 68 + r] = bflo(v.y); Bs[(kc + 3) * 68 + r] = bfhi(v.y);
                Bs[(kc + 4) * 68 + r] = bflo(v.z); Bs[(kc + 5) * 68 + r] = bfhi(v.z); Bs[(kc + 6) * 68 + r] = bflo(v.w); Bs[(kc + 7) * 68 + r] = bfhi(v.w);
            }
            __syncthreads();
#pragma unroll 8
            for (int k = 0; k < 32; ++k) {
                const f32x4 a = *(const LAS f32x4*)(As + k * 132 + ty * 4);
                const f32x4 b = *(const LAS f32x4*)(Bs + k * 68 + tx * 4);
#pragma unroll
                for (int i = 0; i < 4; ++i)
#pragma unroll
                    for (int j = 0; j < 4; ++j) acc[i][j] += a[i] * b[j];
            }
        }
#pragma unroll
        for (int i = 0; i < 4; ++i)
#pragma unroll
            for (int j = 0; j < 4; ++j) { const int col = n0 + tx * 4 + j; if (col < N) E(m0 + ty * 4 + i, col, acc[i][j]); }
    }
    __syncthreads();
}

struct EInProj { bf16_t *sz, *xbc, *q, *k, *v;
    __device__ __forceinline__ void operator()(int r, int c, float x) const {
        if (c < 1024) sz[(size_t)r * 1024 + c] = (bf16_t)f2bf(silu_f(x));
        else if (c < 3072) xbc[(size_t)r * 2048 + (c - 1024)] = (bf16_t)f2bf(x);
        else if (c < 4096) q[(size_t)r * 1024 + (c - 3072)] = (bf16_t)f2bf(x * 0.125f);
        else if (c < 5120) k[(size_t)r * 1024 + (c - 4096)] = (bf16_t)f2bf(x);
        else v[(size_t)r * 1024 + (c - 5120)] = (bf16_t)f2bf(x);
    } };
struct EDt { float* dt; const float *bf, *bb;
    __device__ __forceinline__ void operator()(int r, int c, float x) const { const float bias = c < 16 ? bf[c] : bb[c - 16]; dt[(size_t)r * 32 + c] = softplus_f(x + bias); } };
struct EGate { bf16_t* sg;
    __device__ __forceinline__ void operator()(int r, int c, float x) const { sg[(size_t)(c >> 10) * T * 1024 + (size_t)r * 1024 + (c & 1023)] = (bf16_t)f2bf(sigmoid_f(x)); } };
struct ED1 { bf16_t* p1; const bf16_t* sg1; const float* rstd;
    __device__ __forceinline__ void operator()(int r, int c, float x) const { const size_t i = (size_t)r * 1024 + c; p1[i] = (bf16_t)f2bf(x * rstd[r] * bf2f(sg1[i])); } };
struct ED2 { bf16_t* mixed; const bf16_t *p1, *sg2;
    __device__ __forceinline__ void operator()(int r, int c, float x) const { const size_t i = (size_t)r * 1024 + c; mixed[i] = (bf16_t)f2bf(bf2f(p1[i]) + bf2f(sg2[i]) * x); } };
struct ED3 { float* h; const float* x; const float* mod;
    __device__ __forceinline__ void operator()(int r, int c, float v) const { const size_t i = (size_t)r * 1024 + c; h[i] = x[i] + mod[(r / SEQ) * 6144 + 2048 + c] * v; } };
struct EQp { bf16_t* qp;
    __device__ __forceinline__ void operator()(int r, int c, float v) const { qp[(size_t)r * 2048 + c] = (bf16_t)f2bf(v); } };

__device__ __forceinline__ void p_conv(const Ctx& C, const bf16_t* xbc, bf16_t* xc) {
    const float* cw = C.in[6]; const float* cb = C.in[7];
    const int gt = C.bid * NTHR + C.tid, NT = C.G * NTHR;
    for (int i = gt; i < T * 256; i += NT) {
        const int t = i >> 8, cg = i & 255, l = t & (SEQ - 1), ch = cg * 8;
        float acc[8];
#pragma unroll
        for (int q = 0; q < 8; ++q) acc[q] = cb[ch + q];
#pragma unroll
        for (int j = 0; j < 5; ++j) {
            const int ll = l + j - 2;
            if (ll >= 0 && ll < SEQ) {
                const u32x4 v = *(const u32x4*)(xbc + (size_t)(t + j - 2) * 2048 + ch);
                const f32x4 w0 = *(const f32x4*)(cw + j * 2048 + ch), w1 = *(const f32x4*)(cw + j * 2048 + ch + 4);
                acc[0] += w0.x * bflo(v.x); acc[1] += w0.y * bfhi(v.x); acc[2] += w0.z * bflo(v.y); acc[3] += w0.w * bfhi(v.y);
                acc[4] += w1.x * bflo(v.z); acc[5] += w1.y * bfhi(v.z); acc[6] += w1.z * bflo(v.w); acc[7] += w1.w * bfhi(v.w);
            }
        }
        u32x4 o; o.x = pk2(silu_f(acc[0]), silu_f(acc[1])); o.y = pk2(silu_f(acc[2]), silu_f(acc[3])); o.z = pk2(silu_f(acc[4]), silu_f(acc[5])); o.w = pk2(silu_f(acc[6]), silu_f(acc[7]));
        *(u32x4*)(xc + (size_t)t * 2048 + ch) = o;
    }
}

__device__ __forceinline__ void p_ssd_naive(const Ctx& C, const bf16_t* xc, const float* dtb, bf16_t* yf, bf16_t* yb) {
    if (C.wave != 0) return;
    for (int unit = C.bid; unit < 256; unit += C.G) {
        const int dir = unit & 1, hd = (unit >> 1) & 15, b = unit >> 5, g = hd >> 2, p = C.lane;
        const float a = -__expf((dir ? C.in[11] : C.in[10])[hd]);
        const float dsk = C.in[12][hd];
        float h[128];
#pragma unroll
        for (int n = 0; n < 128; ++n) h[n] = 0.f;
        for (int s = 0; s < SEQ; ++s) {
            const int t = dir ? (SEQ - 1 - s) : s; const size_t row = (size_t)b * SEQ + t;
            const float dt = dtb[row * 32 + dir * 16 + hd];
            const float dA = __expf(dt * a);
            const float x = bf2f(xc[row * 2048 + hd * 64 + p]);
            const float xdt = x * dt;
            const u32x4* Bp = (const u32x4*)(xc + row * 2048 + 1024 + g * 128);
            const u32x4* Cp = (const u32x4*)(xc + row * 2048 + 1536 + g * 128);
            float y = 0.f;
#pragma unroll
            for (int n8 = 0; n8 < 16; ++n8) {
                const u32x4 bv = Bp[n8], cv = Cp[n8];
                const float bb[8] = {bflo(bv.x), bfhi(bv.x), bflo(bv.y), bfhi(bv.y), bflo(bv.z), bfhi(bv.z), bflo(bv.w), bfhi(bv.w)};
                const float cc[8] = {bflo(cv.x), bfhi(cv.x), bflo(cv.y), bfhi(cv.y), bflo(cv.z), bfhi(cv.z), bflo(cv.w), bfhi(cv.w)};
#pragma unroll
                for (int q = 0; q < 8; ++q) { const int n = n8 * 8 + q; h[n] = dA * h[n] + xdt * bb[q]; y += cc[q] * h[n]; }
            }
            if (dir == 0) yf[row * 1024 + hd * 64 + p] = (bf16_t)f2bf(y + dsk * x);
            else yb[row * 1024 + hd * 64 + p] = (bf16_t)f2bf(y);
        }
    }
}

__device__ __forceinline__ void p_na_naive(const Ctx& C, bf16_t* q, const bf16_t* k, const bf16_t* v) {
    const float* rpb = C.in[15];
    const int gt = C.bid * NTHR + C.tid, NT = C.G * NTHR;
    for (int i = gt; i < T * 16; i += NT) {
        const int hh = i & 15, tok = i >> 4, b = tok >> 12, l = tok & 4095, r = l >> 6, col = l & 63;
        int rs = r - 4; rs = rs < 0 ? 0 : (rs > 56 ? 56 : rs);
        int wsx = col - 8; wsx = wsx < 0 ? 0 : (wsx > 48 ? 48 : wsx);
        float qv[64], o[64];
        {
            const u32x4* qp = (const u32x4*)(q + (size_t)tok * 1024 + hh * 64);
#pragma unroll
            for (int d8 = 0; d8 < 8; ++d8) { const u32x4 w = qp[d8]; qv[d8 * 8 + 0] = bflo(w.x); qv[d8 * 8 + 1] = bfhi(w.x); qv[d8 * 8 + 2] = bflo(w.y); qv[d8 * 8 + 3] = bfhi(w.y);
                qv[d8 * 8 + 4] = bflo(w.z); qv[d8 * 8 + 5] = bfhi(w.z); qv[d8 * 8 + 6] = bflo(w.w); qv[d8 * 8 + 7] = bfhi(w.w); }
        }
#pragma unroll
        for (int d = 0; d < 64; ++d) o[d] = 0.f;
        float m = -1e30f, lsum = 0.f;
        for (int ii = 0; ii < 8; ++ii)
            for (int jj = 0; jj < 16; ++jj) {
                const int kr = rs + ii, kc = wsx + jj; const size_t kt = (size_t)b * SEQ + kr * 64 + kc;
                const u32x4* kp = (const u32x4*)(k + kt * 1024 + hh * 64);
                float s = 0.f;
#pragma unroll
                for (int d8 = 0; d8 < 8; ++d8) { const u32x4 w = kp[d8];
                    s += qv[d8 * 8 + 0] * bflo(w.x) + qv[d8 * 8 + 1] * bfhi(w.x) + qv[d8 * 8 + 2] * bflo(w.y) + qv[d8 * 8 + 3] * bfhi(w.y)
                       + qv[d8 * 8 + 4] * bflo(w.z) + qv[d8 * 8 + 5] * bfhi(w.z) + qv[d8 * 8 + 6] * bflo(w.w) + qv[d8 * 8 + 7] * bfhi(w.w); }
                s += rpb[hh * 15 * 31 + (kr - r + 7) * 31 + (kc - col + 15)];
                const float mn = fmaxf(m, s), al = __expf(m - mn), pe = __expf(s - mn);
                lsum = lsum * al + pe; m = mn;
                const u32x4* vp = (const u32x4*)(v + kt * 1024 + hh * 64);
#pragma unroll
                for (int d8 = 0; d8 < 8; ++d8) { const u32x4 w = vp[d8];
                    o[d8 * 8 + 0] = o[d8 * 8 + 0] * al + pe * bflo(w.x); o[d8 * 8 + 1] = o[d8 * 8 + 1] * al + pe * bfhi(w.x);
                    o[d8 * 8 + 2] = o[d8 * 8 + 2] * al + pe * bflo(w.y); o[d8 * 8 + 3] = o[d8 * 8 + 3] * al + pe * bfhi(w.y);
                    o[d8 * 8 + 4] = o[d8 * 8 + 4] * al + pe * bflo(w.z); o[d8 * 8 + 5] = o[d8 * 8 + 5] * al + pe * bfhi(w.z);
                    o[d8 * 8 + 6] = o[d8 * 8 + 6] * al + pe * bflo(w.w); o[d8 * 8 + 7] = o[d8 * 8 + 7] * al + pe * bfhi(w.w); }
            }
        const float inv = 1.f / lsum;
        u32x4* op = (u32x4*)(q + (size_t)tok * 1024 + hh * 64);
#pragma unroll
        for (int d8 = 0; d8 < 8; ++d8) { u32x4 w; w.x = pk2(o[d8 * 8 + 0] * inv, o[d8 * 8 + 1] * inv); w.y = pk2(o[d8 * 8 + 2] * inv, o[d8 * 8 + 3] * inv);
            w.z = pk2(o[d8 * 8 + 4] * inv, o[d8 * 8 + 5] * inv); w.w = pk2(o[d8 * 8 + 6] * inv, o[d8 * 8 + 7] * inv); op[d8] = w; }
    }
}

__device__ __forceinline__ void p_combine(const Ctx& C, const bf16_t* yf, const bf16_t* yb, bf16_t* szu, float* rstd) {
    const int gw = C.bid * NWAVES + C.wave, NGW = C.G * NWAVES;
    for (int row = gw; row < T; row += NGW) {
        const size_t base = (size_t)row * 1024;
        float s = 0.f; u32x4 outv[2];
#pragma unroll
        for (int j = 0; j < 2; ++j) {
            const size_t off = base + j * 512 + C.lane * 8;
            const u32x4 a = *(const u32x4*)(yf + off), b = *(const u32x4*)(yb + off), z = *(const u32x4*)(szu + off);
            float u[8];
            u[0] = (bflo(a.x) + bflo(b.x)) * bflo(z.x); u[1] = (bfhi(a.x) + bfhi(b.x)) * bfhi(z.x);
            u[2] = (bflo(a.y) + bflo(b.y)) * bflo(z.y); u[3] = (bfhi(a.y) + bfhi(b.y)) * bfhi(z.y);
            u[4] = (bflo(a.z) + bflo(b.z)) * bflo(z.z); u[5] = (bfhi(a.z) + bfhi(b.z)) * bfhi(z.z);
            u[6] = (bflo(a.w) + bflo(b.w)) * bflo(z.w); u[7] = (bfhi(a.w) + bfhi(b.w)) * bfhi(z.w);
#pragma unroll
            for (int q = 0; q < 8; ++q) s += u[q] * u[q];
            outv[j].x = pk2(u[0], u[1]); outv[j].y = pk2(u[2], u[3]); outv[j].z = pk2(u[4], u[5]); outv[j].w = pk2(u[6], u[7]);
        }
        s = wave_sum(s);
#pragma unroll
        for (int j = 0; j < 2; ++j) *(u32x4*)(szu + base + j * 512 + C.lane * 8) = outv[j];
        if (C.lane == 0) rstd[row] = rsqrtf(s * (1.f / 1024.f) + EPS);
    }
}

__device__ __forceinline__ void p_cvt_tables(const Ctx& C, bf16_t* ub, bf16_t* vb) {
    const int gt = C.bid * NTHR + C.tid, NT = C.G * NTHR;
    const float* u = C.in[21]; const float* v = C.in[22];
    for (int i = gt; i < 16384 * 1024 / 8; i += NT) {
        const f32x4 a0 = *(const f32x4*)(u + (size_t)i * 8), a1 = *(const f32x4*)(u + (size_t)i * 8 + 4);
        u32x4 o; o.x = pk2(a0.x, a0.y); o.y = pk2(a0.z, a0.w); o.z = pk2(a1.x, a1.y); o.w = pk2(a1.z, a1.w);
        *(u32x4*)(ub + (size_t)i * 8) = o;
        const f32x4 b0 = *(const f32x4*)(v + (size_t)i * 8), b1 = *(const f32x4*)(v + (size_t)i * 8 + 4);
        u32x4 p; p.x = pk2(b0.x, b0.y); p.y = pk2(b0.z, b0.w); p.z = pk2(b1.x, b1.y); p.w = pk2(b1.z, b1.w);
        *(u32x4*)(vb + (size_t)i * 8) = p;
    }
}

__device__ __forceinline__ void p_topk_naive(const Ctx& C, const bf16_t* qp, const bf16_t* keys, unsigned short* pidx, float* pgate) {
    if (C.tid >= 64) return;
    constexpr int NTK = 64;
    LAS float* S = (LAS float*)C.lds;
    LAS float* TV = (LAS float*)(C.lds + 256 * NTK * 4);
    LAS int* TI = (LAS int*)(C.lds + 256 * NTK * 4 + 32 * NTK * 4);
    const int tl = C.tid;
    for (int item = C.bid * NTK + tl; item < T * 8; item += C.G * NTK) {
        const int t = item >> 3, hh = item & 7;
        for (int z = 0; z < 2; ++z) {
            unsigned qv[64];
            const u32x4* qptr = (const u32x4*)(qp + (size_t)t * 2048 + hh * 256 + z * 128);
#pragma unroll
            for (int d8 = 0; d8 < 16; ++d8) { const u32x4 w = qptr[d8]; qv[d8 * 4 + 0] = w.x; qv[d8 * 4 + 1] = w.y; qv[d8 * 4 + 2] = w.z; qv[d8 * 4 + 3] = w.w; }
            for (int n = 0; n < 128; ++n) {
                const u32x4* kp = (const u32x4*)(keys + (size_t)(z * 128 + n) * 128);
                float acc = 0.f;
#pragma unroll
                for (int d8 = 0; d8 < 16; ++d8) { const u32x4 w = kp[d8];
                    acc += bflo(qv[d8 * 4 + 0]) * bflo(w.x) + bfhi(qv[d8 * 4 + 0]) * bfhi(w.x) + bflo(qv[d8 * 4 + 1]) * bflo(w.y) + bfhi(qv[d8 * 4 + 1]) * bfhi(w.y)
                         + bflo(qv[d8 * 4 + 2]) * bflo(w.z) + bfhi(qv[d8 * 4 + 2]) * bfhi(w.z) + bflo(qv[d8 * 4 + 3]) * bflo(w.w) + bfhi(qv[d8 * 4 + 3]) * bfhi(w.w); }
                S[(z * 128 + n) * NTK + tl] = acc;
            }
            float pv = 3.0e38f; int pi = -1;
            for (int r = 0; r < 16; ++r) {
                float best = -3.0e38f; int bi = 0;
                for (int n = 0; n < 128; ++n) { const float x = S[(z * 128 + n) * NTK + tl];
                    const bool elig = (x < pv) || (x == pv && n > pi);
                    if (elig && x > best) { best = x; bi = n; } }
                TV[(z * 16 + r) * NTK + tl] = best; TI[(z * 16 + r) * NTK + tl] = bi; pv = best; pi = bi;
            }
        }
        float pv = 3.0e38f; int pi = -1; float top[16]; int ei[16];
#pragma unroll
        for (int r = 0; r < 16; ++r) {
            float best = -3.0e38f; int bi = 0;
            for (int c = 0; c < 256; ++c) { const float x = TV[(c >> 4) * NTK + tl] + TV[(16 + (c & 15)) * NTK + tl];
                const bool elig = (x < pv) || (x == pv && c > pi);
                if (elig && x > best) { best = x; bi = c; } }
            top[r] = best; ei[r] = TI[(bi >> 4) * NTK + tl] * 128 + TI[(16 + (bi & 15)) * NTK + tl]; pv = best; pi = bi;
        }
        float den = 0.f, e[16];
#pragma unroll
        for (int r = 0; r < 16; ++r) { e[r] = __expf(top[r] - top[0]); den += e[r]; }
        const float inv = 1.f / den;
#pragma unroll
        for (int r = 0; r < 16; ++r) { pidx[(size_t)t * 128 + hh * 16 + r] = (unsigned short)ei[r]; pgate[(size_t)t * 128 + hh * 16 + r] = e[r] * inv; }
    }
}

__device__ __forceinline__ float dot2u(unsigned a, unsigned x, float acc) {
    return __builtin_amdgcn_fdot2_f32_bf16(__builtin_bit_cast(bf16x2_t, a), __builtin_bit_cast(bf16x2_t, x), acc, false);
}
__device__ __forceinline__ float dot8(const u32x4 a, const u32x4 x, float acc) {
    const unsigned a0 = a.x, a1 = a.y, a2 = a.z, a3 = a.w, x0 = x.x, x1 = x.y, x2 = x.z, x3 = x.w;
    acc = dot2u(a0, x0, acc); acc = dot2u(a1, x1, acc); acc = dot2u(a2, x2, acc); acc = dot2u(a3, x3, acc);
    return acc;
}
__device__ __forceinline__ void p_gather(const Ctx& C, const bf16_t* n2, const unsigned short* pidx, const float* pgate, const bf16_t* ub, const bf16_t* vb, const float* h, float* out) {
    const float* mod = C.f32p(WS_MOD); const float* fg = C.in[23];
    LAS float* cbuf = (LAS float*)C.lds + C.wave * 128;
    const int gw = C.bid * NWAVES + C.wave, NGW = C.G * NWAVES, lane = C.lane;
    for (int t = gw; t < T; t += NGW) {
        const int b = t / SEQ;
        const u32x4 x0 = *(const u32x4*)(n2 + (size_t)t * 1024 + lane * 8), x1 = *(const u32x4*)(n2 + (size_t)t * 1024 + 512 + lane * 8);
        const int id0 = pidx[(size_t)t * 128 + lane], id1 = pidx[(size_t)t * 128 + 64 + lane];
        const float g0 = pgate[(size_t)t * 128 + lane], g1 = pgate[(size_t)t * 128 + 64 + lane];
#pragma unroll 1
        for (int grp = 0; grp < 8; ++grp) {
            const int idv = grp < 4 ? id0 : id1; const int lbase = (grp & 3) * 16;
            float part[16];
#pragma unroll
            for (int j = 0; j < 16; ++j) {
                const int e = __shfl(idv, lbase + j);
                const bf16_t* rowp = ub + (size_t)e * 1024;
                const u32x4 a0 = *(const u32x4*)(rowp + lane * 8), a1 = *(const u32x4*)(rowp + 512 + lane * 8);
                part[j] = dot8(a1, x1, dot8(a0, x0, 0.f));
            }
            float p8[8];
            { const bool hi = (lane & 32) != 0;
#pragma unroll
              for (int j = 0; j < 8; ++j) { const float keep = hi ? part[j + 8] : part[j], send = hi ? part[j] : part[j + 8]; p8[j] = keep + __shfl_xor(send, 32); } }
            float p4[4];
            { const bool hi = (lane & 16) != 0;
#pragma unroll
              for (int j = 0; j < 4; ++j) { const float keep = hi ? p8[j + 4] : p8[j], send = hi ? p8[j] : p8[j + 4]; p4[j] = keep + __shfl_xor(send, 16); } }
            float p2[2];
            { const bool hi = (lane & 8) != 0;
#pragma unroll
              for (int j = 0; j < 2; ++j) { const float keep = hi ? p4[j + 2] : p4[j], send = hi ? p4[j] : p4[j + 2]; p2[j] = keep + __shfl_xor(send, 8); } }
            float p1;
            { const bool hi = (lane & 4) != 0; const float keep = hi ? p2[1] : p2[0], send = hi ? p2[0] : p2[1]; p1 = keep + __shfl_xor(send, 4); }
            p1 += __shfl_xor(p1, 2); p1 += __shfl_xor(p1, 1);
            const int E = ((lane >> 5) & 1) * 8 + ((lane >> 4) & 1) * 4 + ((lane >> 3) & 1) * 2 + ((lane >> 2) & 1);
            if ((lane & 3) == 0) cbuf[grp * 16 + E] = gelu_f(p1);
        }
        asm volatile("s_waitcnt lgkmcnt(0)" ::: "memory");
        const float c0 = cbuf[lane] * g0, c1 = cbuf[64 + lane] * g1;
        asm volatile("s_waitcnt lgkmcnt(0)" ::: "memory");
        float acc[16];
#pragma unroll
        for (int i = 0; i < 16; ++i) acc[i] = 0.f;
#pragma unroll 1
        for (int kb = 0; kb < 128; kb += 8) {
            const int idv = kb < 64 ? id0 : id1; const float cv = kb < 64 ? c0 : c1;
#pragma unroll
            for (int j = 0; j < 8; ++j) {
                const int e = __shfl(idv, (kb & 63) + j); const float ck = __shfl(cv, (kb & 63) + j);
                const bf16_t* rowp = vb + (size_t)e * 1024;
                const u32x4 a0 = *(const u32x4*)(rowp + lane * 8), a1 = *(const u32x4*)(rowp + 512 + lane * 8);
                acc[0] += ck * bflo(a0.x); acc[1] += ck * bfhi(a0.x); acc[2] += ck * bflo(a0.y); acc[3] += ck * bfhi(a0.y);
                acc[4] += ck * bflo(a0.z); acc[5] += ck * bfhi(a0.z); acc[6] += ck * bflo(a0.w); acc[7] += ck * bfhi(a0.w);
                acc[8] += ck * bflo(a1.x); acc[9] += ck * bfhi(a1.x); acc[10] += ck * bflo(a1.y); acc[11] += ck * bfhi(a1.y);
                acc[12] += ck * bflo(a1.z); acc[13] += ck * bfhi(a1.z); acc[14] += ck * bflo(a1.w); acc[15] += ck * bfhi(a1.w);
            }
        }
        float hf[16]; float ss = 0.f;
#pragma unroll
        for (int half = 0; half < 2; ++half) {
            const int col = half * 512 + lane * 8;
            const f32x4 h0 = *(const f32x4*)(h + (size_t)t * 1024 + col), h1 = *(const f32x4*)(h + (size_t)t * 1024 + col + 4);
            const f32x4 m0 = *(const f32x4*)(mod + b * 6144 + 5120 + col), m1 = *(const f32x4*)(mod + b * 6144 + 5120 + col + 4);
            hf[half * 8 + 0] = h0.x + m0.x * acc[half * 8 + 0]; hf[half * 8 + 1] = h0.y + m0.y * acc[half * 8 + 1];
            hf[half * 8 + 2] = h0.z + m0.z * acc[half * 8 + 2]; hf[half * 8 + 3] = h0.w + m0.w * acc[half * 8 + 3];
            hf[half * 8 + 4] = h1.x + m1.x * acc[half * 8 + 4]; hf[half * 8 + 5] = h1.y + m1.y * acc[half * 8 + 5];
            hf[half * 8 + 6] = h1.z + m1.z * acc[half * 8 + 6]; hf[half * 8 + 7] = h1.w + m1.w * acc[half * 8 + 7];
        }
#pragma unroll
        for (int i = 0; i < 16; ++i) ss += hf[i] * hf[i];
        const float rstd = rsqrtf(wave_sum(ss) * (1.f / 1024.f) + EPS);
#pragma unroll
        for (int half = 0; half < 2; ++half) {
            const int col = half * 512 + lane * 8;
            const f32x4 f0 = *(const f32x4*)(fg + col), f1 = *(const f32x4*)(fg + col + 4);
            f32x4 o0, o1;
            o0.x = hf[half * 8 + 0] * rstd * f0.x; o0.y = hf[half * 8 + 1] * rstd * f0.y; o0.z = hf[half * 8 + 2] * rstd * f0.z; o0.w = hf[half * 8 + 3] * rstd * f0.w;
            o1.x = hf[half * 8 + 4] * rstd * f1.x; o1.y = hf[half * 8 + 5] * rstd * f1.y; o1.z = hf[half * 8 + 6] * rstd * f1.z; o1.w = hf[half * 8 + 7] * rstd * f1.w;
            *(f32x4*)(out + (size_t)t * 1024 + col) = o0; *(f32x4*)(out + (size_t)t * 1024 + col + 4) = o1;
        }
    }
}


__device__ __forceinline__ void p_gather_ref(const Ctx& C, const bf16_t* n2, const unsigned short* pidx, const float* pgate, const float* h, float* out) {
    const float* mod = C.f32p(WS_MOD); const float* fg = C.in[23]; const float* U = C.in[21]; const float* V = C.in[22];
    LAS float* xs = (LAS float*)C.lds;
    LAS float* part = xs + 1024;
    LAS float* cs = part + 512;
    LAS float* red = cs + 128;
    LAS int* es = (LAS int*)(red + 512);
    const int tid = C.tid;
    for (int t = C.bid; t < T; t += C.G) {
        const int b = t / SEQ;
        __syncthreads();
        xs[tid] = bf2f(n2[(size_t)t * 1024 + tid]); xs[tid + 512] = bf2f(n2[(size_t)t * 1024 + 512 + tid]);
        if (tid < 128) es[tid] = pidx[(size_t)t * 128 + tid];
        __syncthreads();
        { const int k = tid >> 2, qd = tid & 3; const float* ur = U + (size_t)es[k] * 1024 + qd * 256; float acc = 0.f;
          for (int d = 0; d < 256; ++d) acc += ur[d] * xs[qd * 256 + d];
          part[tid] = acc; }
        __syncthreads();
        if (tid < 128) { const float dsum = part[tid * 4] + part[tid * 4 + 1] + part[tid * 4 + 2] + part[tid * 4 + 3]; cs[tid] = gelu_f(dsum) * pgate[(size_t)t * 128 + tid]; }
        __syncthreads();
        float o0 = 0.f, o1 = 0.f;
        for (int k = 0; k < 128; ++k) { const float* vr = V + (size_t)es[k] * 1024; const float ck = cs[k]; o0 += ck * vr[tid]; o1 += ck * vr[tid + 512]; }
        const float h0 = h[(size_t)t * 1024 + tid] + mod[b * 6144 + 5120 + tid] * o0, h1 = h[(size_t)t * 1024 + 512 + tid] + mod[b * 6144 + 5120 + 512 + tid] * o1;
        red[tid] = h0 * h0 + h1 * h1;
        __syncthreads();
        for (int sft = 256; sft > 0; sft >>= 1) { if (tid < sft) red[tid] += red[tid + sft]; __syncthreads(); }
        const float rstd = rsqrtf(red[0] * (1.f / 1024.f) + EPS);
        out[(size_t)t * 1024 + tid] = h0 * rstd * fg[tid]; out[(size_t)t * 1024 + 512 + tid] = h1 * rstd * fg[tid + 512];
    }
}

constexpr int N_PHASES = 14;
template <int PH>
__global__ void __launch_bounds__(NTHR, 2) mega_ph(Args a) {
    extern __shared__ __attribute__((aligned(16))) unsigned char lds_raw[];
    Ctx C; C.in = a.in; C.out = a.out; C.ws = a.ws; C.tid = threadIdx.x; C.lane = C.tid & 63; C.wave = __builtin_amdgcn_readfirstlane(C.tid >> 6);
    C.G = gridDim.x; C.bid = blockIdx.x; C.lds = (LAS unsigned char*)lds_raw;
    bf16_t* R0 = C.bfp(WS_R0); bf16_t* R1 = C.bfp(WS_R1); bf16_t* R2 = C.bfp(WS_R2); bf16_t* R3 = C.bfp(WS_R3);
    bf16_t* OB = (bf16_t*)a.out;
    const size_t TD = (size_t)T * 1024;
    if constexpr (PH == 0) p_prep(C);
    if constexpr (PH == 1) p_rownorm(C, C.in[0], C.in[4], 0, 1024, R0);
    if constexpr (PH == 2) {
        EInProj e{R1, R2, R3, R3 + TD, R3 + 2 * TD};
        naive_gemm(C, R0, C.bfp(WS_WIN_T), T, 6144, 1024, e);
        EDt ed{C.f32p(WS_DT), C.in[8], C.in[9]};
        naive_gemm(C, R0, C.bfp(WS_WDT_T), T, 32, 1024, ed);
    }
    if constexpr (PH == 3) p_conv(C, R2, OB);
    if constexpr (PH == 4) p_ssd_naive(C, OB, C.f32p(WS_DT), R2, R2 + TD);
    if constexpr (PH == 5) p_na_naive(C, R3, R3 + TD, R3 + 2 * TD);
    if constexpr (PH == 6) p_combine(C, R2, R2 + TD, R1, C.f32p(WS_RSTD));
    if constexpr (PH == 7) { EGate eg{OB}; naive_gemm(C, R0, C.bfp(WS_WG_T), T, 2048, 1024, eg); }
    if constexpr (PH == 8) { ED1 e1{R2, OB, C.f32p(WS_RSTD)}; naive_gemm(C, R1, C.bfp(WS_WSSD_T), T, 1024, 1024, e1); }
    if constexpr (PH == 9) { ED2 e2{R2 + TD, R2, OB + TD}; naive_gemm(C, R3, C.bfp(WS_WNA_T), T, 1024, 1024, e2); }
    if constexpr (PH == 10) { ED3 e3{(float*)(R3 + TD), C.in[0], C.f32p(WS_MOD)}; naive_gemm(C, R2 + TD, C.bfp(WS_WOUT_T), T, 1024, 1024, e3); }
    if constexpr (PH == 11) { p_rownorm(C, (const float*)(R3 + TD), C.in[18], 3072, 4096, R0); p_cvt_tables(C, R2, R2 + (size_t)16384 * 1024); }
    if constexpr (PH == 12) { EQp eq{OB}; naive_gemm(C, R0, C.bfp(WS_WPQ_T), T, 2048, 1024, eq); }
    if constexpr (PH == 13) p_topk_naive(C, OB, C.bfp(WS_KEYS), (unsigned short*)R1, (float*)(R1 + 4 * MiB));
    if constexpr (PH == 14) p_gather(C, R0, (const unsigned short*)R1, (const float*)(R1 + 4 * MiB), R2, R2 + (size_t)16384 * 1024, (const float*)(R3 + TD), a.out);
}

template <int PH> static void launch_ph(int grid, hipStream_t stream, const Args& a) {
    static bool attr = false;
    if (!attr) { (void)hipFuncSetAttribute((const void*)mega_ph<PH>, hipFuncAttributeMaxDynamicSharedMemorySize, LDS_BYTES); attr = true; }
    hipLaunchKernelGGL(mega_ph<PH>, dim3(grid), dim3(NTHR), LDS_BYTES, stream, a);
}

extern "C" void kernel_launch(void* const* d_in, const int* in_sizes, int n_in, void* d_out, int out_size, void* d_ws, size_t ws_size, hipStream_t stream) {
    static int grid = 0;
    if (grid == 0) {
        if (n_in != 24 || out_size != T * D || ws_size < WS_END) { fprintf(stderr, "kernel_launch: unexpected shapes n_in %d out %d ws %zu\n", n_in, out_size, ws_size); grid = -1; return; }
        int dev = 0, cus = 0;
        if (hipGetDevice(&dev) != hipSuccess || hipDeviceGetAttribute(&cus, hipDeviceAttributeMultiprocessorCount, dev) != hipSuccess) { grid = -1; return; }
        grid = cus;
    }
    if (grid < 0) return;
    Args a{};
    for (int i = 0; i < 24; ++i) a.in[i] = (const float*)d_in[i];
    a.out = (float*)d_out; a.ws = (unsigned char*)d_ws; a.ph_lo = 0; a.ph_hi = 0;
    launch_ph<0>(grid, stream, a); launch_ph<1>(grid, stream, a); launch_ph<2>(grid, stream, a); launch_ph<3>(grid, stream, a);
    launch_ph<4>(grid, stream, a); launch_ph<5>(grid, stream, a); launch_ph<6>(grid, stream, a); launch_ph<7>(grid, stream, a);
    launch_ph<8>(grid, stream, a); launch_ph<9>(grid, stream, a); launch_ph<10>(grid, stream, a); launch_ph<11>(grid, stream, a);
    launch_ph<12>(grid, stream, a); launch_ph<13>(grid, stream, a); launch_ph<14>(grid, stream, a);
}
```

```cpp
#include <hip/hip_runtime.h>
#include <cstdio>
#include <cstdint>

#define LAS __attribute__((address_space(3)))
typedef unsigned short bf16_t;
typedef float f32x4 __attribute__((ext_vector_type(4)));
typedef unsigned u32x4 __attribute__((ext_vector_type(4)));
typedef unsigned u32x2 __attribute__((ext_vector_type(2)));
typedef __bf16 bf16x2_t __attribute__((ext_vector_type(2)));

constexpr int T = 32768, D = 1024, NB = 8, SEQ = 4096;
constexpr int NWAVES = 8, NTHR = 512;
constexpr float EPS = 1e-6f;
constexpr int OFF_Z = 0, OFF_XBC = 1024, OFF_DTF = 3072, OFF_DTB = 3088, OFF_QKV = 3104, OFF_GS = 6176, OFF_GN = 7200, D_IN = 8224;

constexpr size_t MiB = 1u << 20;
constexpr size_t WS_CTL = 0;
constexpr size_t WS_MOD = 1 * MiB;
constexpr size_t WS_RSTD = 1 * MiB + 512 * 1024;
constexpr size_t WS_DT = 2 * MiB;
constexpr size_t WS_WIN_T = 6 * MiB;
constexpr size_t WS_WG_T = 18 * MiB;
constexpr size_t WS_WDT_T = 22 * MiB;
constexpr size_t WS_KEYS = 22 * MiB + 512 * 1024;
constexpr size_t WS_WSSD_T = 23 * MiB, WS_WNA_T = 25 * MiB, WS_WOUT_T = 27 * MiB, WS_WPQ_T = 29 * MiB;
constexpr size_t WS_R0 = 40 * MiB, WS_R1 = 104 * MiB, WS_R2 = 168 * MiB, WS_R3 = 296 * MiB, WS_END = 488 * MiB;

constexpr int LDS_BYTES = 147456;

struct Args { const float* in[24]; float* out; unsigned char* ws; int ph_lo, ph_hi; };

__device__ __forceinline__ float bf2f(unsigned v) { return __uint_as_float(v << 16); }
__device__ __forceinline__ float bflo(unsigned v) { return __uint_as_float(v << 16); }
__device__ __forceinline__ float bfhi(unsigned v) { return __uint_as_float(v & 0xffff0000u); }
__device__ __forceinline__ unsigned f2bf(float f) { unsigned u = __float_as_uint(f); return (u + 0x7fffu + ((u >> 16) & 1u)) >> 16; }
__device__ __forceinline__ unsigned pk2(float lo, float hi) { return f2bf(lo) | (f2bf(hi) << 16); }
__device__ __forceinline__ float wave_sum(float v) {
#pragma unroll
    for (int o = 1; o < 64; o <<= 1) v += __shfl_xor(v, o);
    return v;
}
__device__ __forceinline__ float silu_f(float x) { return x / (1.f + __expf(-x)); }
__device__ __forceinline__ float sigmoid_f(float x) { return 1.f / (1.f + __expf(-x)); }
__device__ __forceinline__ float softplus_f(float x) { return x > 20.f ? x : log1pf(__expf(x)); }
__device__ __forceinline__ float gelu_f(float x) { return 0.5f * x * (1.f + erff(x * 0.70710678118654752f)); }

struct Ctx {
    const float* const* in; float* out; unsigned char* ws;
    int tid, lane, wave, G, bid;
    LAS unsigned char* lds;
    __device__ __forceinline__ float* f32p(size_t off) const { return (float*)(ws + off); }
    __device__ __forceinline__ bf16_t* bfp(size_t off) const { return (bf16_t*)(ws + off); }
};

__device__ __forceinline__ void p_prep(const Ctx& C) {
    const int gt = C.bid * NTHR + C.tid, NT = C.G * NTHR;
    const float* c = C.in[1]; const float* w_ada = C.in[2]; const float* b_ada = C.in[3];
    float* mod = C.f32p(WS_MOD);
    for (int i = gt; i < NB * 6144; i += NT) {
        const int b = i / 6144, j = i % 6144; float acc = 0.f;
        for (int k = 0; k < D; ++k) acc += silu_f(c[b * D + k]) * w_ada[(size_t)k * 6144 + j];
        mod[i] = acc + b_ada[j];
    }
    const float* w_in = C.in[5];
    {
        bf16_t* wt = C.bfp(WS_WIN_T);
        for (int i = gt; i < 6144 * (D / 8); i += NT) { const int n = i % 6144, k8 = i / 6144; const int col = n < 3072 ? n : OFF_QKV + (n - 3072);
            u32x4 o; const float* s = w_in + (size_t)(k8 * 8) * D_IN + col;
            o.x = pk2(s[0], s[(size_t)D_IN]); o.y = pk2(s[2 * (size_t)D_IN], s[3 * (size_t)D_IN]); o.z = pk2(s[4 * (size_t)D_IN], s[5 * (size_t)D_IN]); o.w = pk2(s[6 * (size_t)D_IN], s[7 * (size_t)D_IN]);
            *(u32x4*)(wt + (size_t)n * D + k8 * 8) = o; }
    }
    {
        bf16_t* wt = C.bfp(WS_WG_T);
        for (int i = gt; i < 2048 * (D / 8); i += NT) { const int n = i % 2048, k8 = i / 2048; const int col = OFF_GS + n;
            u32x4 o; const float* s = w_in + (size_t)(k8 * 8) * D_IN + col;
            o.x = pk2(s[0], s[(size_t)D_IN]); o.y = pk2(s[2 * (size_t)D_IN], s[3 * (size_t)D_IN]); o.z = pk2(s[4 * (size_t)D_IN], s[5 * (size_t)D_IN]); o.w = pk2(s[6 * (size_t)D_IN], s[7 * (size_t)D_IN]);
            *(u32x4*)(wt + (size_t)n * D + k8 * 8) = o; }
    }
    {
        bf16_t* wt = C.bfp(WS_WDT_T);
        for (int i = gt; i < 32 * (D / 8); i += NT) { const int n = i % 32, k8 = i / 32; const int col = OFF_DTF + n;
            u32x4 o; const float* s = w_in + (size_t)(k8 * 8) * D_IN + col;
            o.x = pk2(s[0], s[(size_t)D_IN]); o.y = pk2(s[2 * (size_t)D_IN], s[3 * (size_t)D_IN]); o.z = pk2(s[4 * (size_t)D_IN], s[5 * (size_t)D_IN]); o.w = pk2(s[6 * (size_t)D_IN], s[7 * (size_t)D_IN]);
            *(u32x4*)(wt + (size_t)n * D + k8 * 8) = o; }
    }
    {
        const float* gk = C.in[13];
        const float* srcs[3] = {C.in[14], C.in[16], C.in[17]};
        const size_t dsts[3] = {WS_WSSD_T, WS_WNA_T, WS_WOUT_T};
#pragma unroll
        for (int w = 0; w < 3; ++w) {
            const float* W = srcs[w]; bf16_t* wt = C.bfp(dsts[w]);
            for (int i = gt; i < D * (D / 8); i += NT) { const int n = i % D, k8 = i / D; const float* s = W + (size_t)(k8 * 8) * D + n;
                float v[8];
#pragma unroll
                for (int q = 0; q < 8; ++q) v[q] = s[(size_t)q * D] * (w == 0 ? gk[k8 * 8 + q] : 1.f);
                u32x4 o; o.x = pk2(v[0], v[1]); o.y = pk2(v[2], v[3]); o.z = pk2(v[4], v[5]); o.w = pk2(v[6], v[7]);
                *(u32x4*)(wt + (size_t)n * D + k8 * 8) = o; }
        }
    }
    {
        const float* W = C.in[19]; bf16_t* wt = C.bfp(WS_WPQ_T);
        for (int i = gt; i < 2048 * (D / 8); i += NT) { const int n = i % 2048, k8 = i / 2048; const float* s = W + (size_t)(k8 * 8) * 2048 + n;
            u32x4 o; o.x = pk2(s[0], s[2048]); o.y = pk2(s[2 * 2048], s[3 * 2048]); o.z = pk2(s[4 * 2048], s[5 * 2048]); o.w = pk2(s[6 * 2048], s[7 * 2048]);
            *(u32x4*)(wt + (size_t)n * D + k8 * 8) = o; }
    }
    {
        const float* kf = C.in[20]; bf16_t* kb = C.bfp(WS_KEYS);
        for (int i = gt; i < 2 * 128 * 128; i += NT) kb[i] = (bf16_t)f2bf(kf[i]);
    }
}

__device__ __forceinline__ void p_rownorm(const Ctx& C, const float* X, const float* gamma, int sh_off, int sc_off, bf16_t* dst) {
    const float* mod = C.f32p(WS_MOD);
    const int gw = C.bid * NWAVES + C.wave, NGW = C.G * NWAVES;
    for (int row = gw; row < T; row += NGW) {
        const int b = row / SEQ;
        const f32x4* xr = (const f32x4*)(X + (size_t)row * D) + C.lane;
        f32x4 v[4]; float s = 0.f;
#pragma unroll
        for (int j = 0; j < 4; ++j) { v[j] = xr[64 * j]; s += (v[j].x * v[j].x + v[j].y * v[j].y) + (v[j].z * v[j].z + v[j].w * v[j].w); }
        const float rstd = rsqrtf(wave_sum(s) * (1.f / D) + EPS);
        u32x2* o8 = (u32x2*)(dst + (size_t)row * D) + C.lane;
#pragma unroll
        for (int j = 0; j < 4; ++j) {
            const int col = 4 * C.lane + 256 * j;
            const f32x4 g = *(const f32x4*)(gamma + col), sh = *(const f32x4*)(mod + b * 6144 + sh_off + col), sc = *(const f32x4*)(mod + b * 6144 + sc_off + col);
            f32x4 y = v[j] * rstd * g * (sc + 1.f) + sh;
            u32x2 w; w.x = pk2(y.x, y.y); w.y = pk2(y.z, y.w); o8[64 * j] = w;
        }
    }
}

template <class Epi>
__device__ __forceinline__ void naive_gemm(const Ctx& C, const bf16_t* A, const bf16_t* Bt, int M, int N, int K, const Epi& E) {
    LAS float* As = (LAS float*)C.lds;
    LAS float* Bs = (LAS float*)(C.lds + 32 * 132 * 4);
    const int tilesN = (N + 63) / 64, tilesM = M / 128, ntiles = tilesM * tilesN;
    const int ty = C.tid >> 4, tx = C.tid & 15;
    for (int tile = C.bid; tile < ntiles; tile += C.G) {
        const int tm = tile / tilesN, tn = tile % tilesN, m0 = tm * 128, n0 = tn * 64;
        float acc[4][4];
#pragma unroll
        for (int i = 0; i < 4; ++i)
#pragma unroll
            for (int j = 0; j < 4; ++j) acc[i][j] = 0.f;
        for (int k0 = 0; k0 < K; k0 += 32) {
            __syncthreads();
            {
                const int r = C.tid >> 2, kc = (C.tid & 3) * 8;
                const u32x4 v = *(const u32x4*)(A + (size_t)(m0 + r) * K + k0 + kc);
                As[(kc + 0) * 132 + r] = bflo(v.x); As[(kc + 1) * 132 + r] = bfhi(v.x); As[(kc + 2) * 132 + r] = bflo(v.y); As[(kc + 3) * 132 + r] = bfhi(v.y);
                As[(kc + 4) * 132 + r] = bflo(v.z); As[(kc + 5) * 132 + r] = bfhi(v.z); As[(kc + 6) * 132 + r] = bflo(v.w); As[(kc + 7) * 132 + r] = bfhi(v.w);
            }
            if (C.tid < 256) {
                const int r = C.tid >> 2, kc = (C.tid & 3) * 8;
                u32x4 v = (u32x4){0u, 0u, 0u, 0u};
                if (n0 + r < N) v = *(const u32x4*)(Bt + (size_t)(n0 + r) * K + k0 + kc);
                Bs[(kc + 0) * 68 + r] = bflo(v.x); Bs[(kc + 1) * 68 + r] = bfhi(v.x); Bs[(kc + 2) * 68 + r] = bflo(v.y); Bs[(kc + 3) * 68 + r] = bfhi(v.y);
                Bs[(kc + 4) * 68 + r] = bflo(v.z); Bs[(kc + 5) * 68 + r] = bfhi(v.z); Bs[(kc + 6) * 68 + r] = bflo(v.w); Bs[(kc + 7) * 68 + r] = bfhi(v.w);
            }
            __syncthreads();
#pragma unroll 8
            for (int k = 0; k < 32; ++k) {
                const f32x4 a = *(const LAS f32x4*)(As + k * 132 + ty * 4);
                const f32x4 b = *(const LAS f32x4*)(Bs + k * 68 + tx * 4);
#pragma unroll
                for (int i = 0; i < 4; ++i)
#pragma unroll
                    for (int j = 0; j < 4; ++j) acc[i][j] += a[i] * b[j];
            }
        }
#pragma unroll
        for (int i = 0; i < 4; ++i)
#pragma unroll
            for (int j = 0; j < 4; ++j) { const int col = n0 + tx * 4 + j; if (col < N) E(m0 + ty * 4 + i, col, acc[i][j]); }
    }
    __syncthreads();
}

struct EInProj { bf16_t *sz, *xbc, *q, *k, *v;
    __device__ __forceinline__ void operator()(int r, int c, float x) const {
        if (c < 1024) sz[(size_t)r * 1024 + c] = (bf16_t)f2bf(silu_f(x));
        else if (c < 3072) xbc[(size_t)r * 2048 + (c - 1024)] = (bf16_t)f2bf(x);
        else if (c < 4096) q[(size_t)r * 1024 + (c - 3072)] = (bf16_t)f2bf(x * 0.125f);
        else if (c < 5120) k[(size_t)r * 1024 + (c - 4096)] = (bf16_t)f2bf(x);
        else v[(size_t)r * 1024 + (c - 5120)] = (bf16_t)f2bf(x);
    } };
struct EDt { float* dt; const float *bf, *bb;
    __device__ __forceinline__ void operator()(int r, int c, float x) const { const float bias = c < 16 ? bf[c] : bb[c - 16]; dt[(size_t)r * 32 + c] = softplus_f(x + bias); } };
struct EGate { bf16_t* sg;
    __device__ __forceinline__ void operator()(int r, int c, float x) const { sg[(size_t)(c >> 10) * T * 1024 + (size_t)r * 1024 + (c & 1023)] = (bf16_t)f2bf(sigmoid_f(x)); } };
struct ED1 { bf16_t* p1; const bf16_t* sg1; const float* rstd;
    __device__ __forceinline__ void operator()(int r, int c, float x) const { const size_t i = (size_t)r * 1024 + c; p1[i] = (bf16_t)f2bf(x * rstd[r] * bf2f(sg1[i])); } };
struct ED2 { bf16_t* mixed; const bf16_t *p1, *sg2;
    __device__ __forceinline__ void operator()(int r, int c, float x) const { const size_t i = (size_t)r * 1024 + c; mixed[i] = (bf16_t)f2bf(bf2f(p1[i]) + bf2f(sg2[i]) * x); } };
struct ED3 { float* h; const float* x; const float* mod;
    __device__ __forceinline__ void operator()(int r, int c, float v) const { const size_t i = (size_t)r * 1024 + c; h[i] = x[i] + mod[(r / SEQ) * 6144 + 2048 + c] * v; } };
struct EQp { bf16_t* qp;
    __device__ __forceinline__ void operator()(int r, int c, float v) const { qp[(size_t)r * 2048 + c] = (bf16_t)f2bf(v); } };

__device__ __forceinline__ void p_conv(const Ctx& C, const bf16_t* xbc, bf16_t* xc) {
    const float* cw = C.in[6]; const float* cb = C.in[7];
    const int gt = C.bid * NTHR + C.tid, NT = C.G * NTHR;
    for (int i = gt; i < T * 256; i += NT) {
        const int t = i >> 8, cg = i & 255, l = t & (SEQ - 1), ch = cg * 8;
        float acc[8];
#pragma unroll
        for (int q = 0; q < 8; ++q) acc[q] = cb[ch + q];
#pragma unroll
        for (int j = 0; j < 5; ++j) {
            const int ll = l + j - 2;
            if (ll >= 0 && ll < SEQ) {
                const u32x4 v = *(const u32x4*)(xbc + (size_t)(t + j - 2) * 2048 + ch);
                const f32x4 w0 = *(const f32x4*)(cw + j * 2048 + ch), w1 = *(const f32x4*)(cw + j * 2048 + ch + 4);
                acc[0] += w0.x * bflo(v.x); acc[1] += w0.y * bfhi(v.x); acc[2] += w0.z * bflo(v.y); acc[3] += w0.w * bfhi(v.y);
                acc[4] += w1.x * bflo(v.z); acc[5] += w1.y * bfhi(v.z); acc[6] += w1.z * bflo(v.w); acc[7] += w1.w * bfhi(v.w);
            }
        }
        u32x4 o; o.x = pk2(silu_f(acc[0]), silu_f(acc[1])); o.y = pk2(silu_f(acc[2]), silu_f(acc[3])); o.z = pk2(silu_f(acc[4]), silu_f(acc[5])); o.w = pk2(silu_f(acc[6]), silu_f(acc[7]));
        *(u32x4*)(xc + (size_t)t * 2048 + ch) = o;
    }
}

__device__ __forceinline__ void p_ssd_naive(const Ctx& C, const bf16_t* xc, const float* dtb, bf16_t* yf, bf16_t* yb) {
    if (C.wave == 0)
    for (int unit = C.bid; unit < 256; unit += C.G) {
        const int dir = unit & 1, hd = (unit >> 1) & 15, b = unit >> 5, g = hd >> 2, p = C.lane;
        const float a = -__expf((dir ? C.in[11] : C.in[10])[hd]);
        const float dsk = C.in[12][hd];
        float h[128];
#pragma unroll
        for (int n = 0; n < 128; ++n) h[n] = 0.f;
        for (int s = 0; s < SEQ; ++s) {
            const int t = dir ? (SEQ - 1 - s) : s; const size_t row = (size_t)b * SEQ + t;
            const float dt = dtb[row * 32 + dir * 16 + hd];
            const float dA = __expf(dt * a);
            const float x = bf2f(xc[row * 2048 + hd * 64 + p]);
            const float xdt = x * dt;
            const u32x4* Bp = (const u32x4*)(xc + row * 2048 + 1024 + g * 128);
            const u32x4* Cp = (const u32x4*)(xc + row * 2048 + 1536 + g * 128);
            float y = 0.f;
#pragma unroll
            for (int n8 = 0; n8 < 16; ++n8) {
                const u32x4 bv = Bp[n8], cv = Cp[n8];
                const float bb[8] = {bflo(bv.x), bfhi(bv.x), bflo(bv.y), bfhi(bv.y), bflo(bv.z), bfhi(bv.z), bflo(bv.w), bfhi(bv.w)};
                const float cc[8] = {bflo(cv.x), bfhi(cv.x), bflo(cv.y), bfhi(cv.y), bflo(cv.z), bfhi(cv.z), bflo(cv.w), bfhi(cv.w)};
#pragma unroll
                for (int q = 0; q < 8; ++q) { const int n = n8 * 8 + q; h[n] = dA * h[n] + xdt * bb[q]; y += cc[q] * h[n]; }
            }
            if (dir == 0) yf[row * 1024 + hd * 64 + p] = (bf16_t)f2bf(y + dsk * x);
            else yb[row * 1024 + hd * 64 + p] = (bf16_t)f2bf(y);
        }
    }
}

__device__ __forceinline__ void p_na_naive(const Ctx& C, bf16_t* q, const bf16_t* k, const bf16_t* v) {
    const float* rpb = C.in[15];
    const int gt = C.bid * NTHR + C.tid, NT = C.G * NTHR;
    for (int i = gt; i < T * 16; i += NT) {
        const int hh = i & 15, tok = i >> 4, b = tok >> 12, l = tok & 4095, r = l >> 6, col = l & 63;
        int rs = r - 4; rs = rs < 0 ? 0 : (rs > 56 ? 56 : rs);
        int wsx = col - 8; wsx = wsx < 0 ? 0 : (wsx > 48 ? 48 : wsx);
        float qv[64], o[64];
        {
            const u32x4* qp = (const u32x4*)(q + (size_t)tok * 1024 + hh * 64);
#pragma unroll
            for (int d8 = 0; d8 < 8; ++d8) { const u32x4 w = qp[d8]; qv[d8 * 8 + 0] = bflo(w.x); qv[d8 * 8 + 1] = bfhi(w.x); qv[d8 * 8 + 2] = bflo(w.y); qv[d8 * 8 + 3] = bfhi(w.y);
                qv[d8 * 8 + 4] = bflo(w.z); qv[d8 * 8 + 5] = bfhi(w.z); qv[d8 * 8 + 6] = bflo(w.w); qv[d8 * 8 + 7] = bfhi(w.w); }
        }
#pragma unroll
        for (int d = 0; d < 64; ++d) o[d] = 0.f;
        float m = -1e30f, lsum = 0.f;
        for (int ii = 0; ii < 8; ++ii)
            for (int jj = 0; jj < 16; ++jj) {
                const int kr = rs + ii, kc = wsx + jj; const size_t kt = (size_t)b * SEQ + kr * 64 + kc;
                const u32x4* kp = (const u32x4*)(k + kt * 1024 + hh * 64);
                float s = 0.f;
#pragma unroll
                for (int d8 = 0; d8 < 8; ++d8) { const u32x4 w = kp[d8];
                    s += qv[d8 * 8 + 0] * bflo(w.x) + qv[d8 * 8 + 1] * bfhi(w.x) + qv[d8 * 8 + 2] * bflo(w.y) + qv[d8 * 8 + 3] * bfhi(w.y)
                       + qv[d8 * 8 + 4] * bflo(w.z) + qv[d8 * 8 + 5] * bfhi(w.z) + qv[d8 * 8 + 6] * bflo(w.w) + qv[d8 * 8 + 7] * bfhi(w.w); }
                s += rpb[hh * 15 * 31 + (kr - r + 7) * 31 + (kc - col + 15)];
                const float mn = fmaxf(m, s), al = __expf(m - mn), pe = __expf(s - mn);
                lsum = lsum * al + pe; m = mn;
                const u32x4* vp = (const u32x4*)(v + kt * 1024 + hh * 64);
#pragma unroll
                for (int d8 = 0; d8 < 8; ++d8) { const u32x4 w = vp[d8];
                    o[d8 * 8 + 0] = o[d8 * 8 + 0] * al + pe * bflo(w.x); o[d8 * 8 + 1] = o[d8 * 8 + 1] * al + pe * bfhi(w.x);
                    o[d8 * 8 + 2] = o[d8 * 8 + 2] * al + pe * bflo(w.y); o[d8 * 8 + 3] = o[d8 * 8 + 3] * al + pe * bfhi(w.y);
                    o[d8 * 8 + 4] = o[d8 * 8 + 4] * al + pe * bflo(w.z); o[d8 * 8 + 5] = o[d8 * 8 + 5] * al + pe * bfhi(w.z);
                    o[d8 * 8 + 6] = o[d8 * 8 + 6] * al + pe * bflo(w.w); o[d8 * 8 + 7] = o[d8 * 8 + 7] * al + pe * bfhi(w.w); }
            }
        const float inv = 1.f / lsum;
        u32x4* op = (u32x4*)(q + (size_t)tok * 1024 + hh * 64);
#pragma unroll
        for (int d8 = 0; d8 < 8; ++d8) { u32x4 w; w.x = pk2(o[d8 * 8 + 0] * inv, o[d8 * 8 + 1] * inv); w.y = pk2(o[d8 * 8 + 2] * inv, o[d8 * 8 + 3] * inv);
            w.z = pk2(o[d8 * 8 + 4] * inv, o[d8 * 8 + 5] * inv); w.w = pk2(o[d8 * 8 + 6] * inv, o[d8 * 8 + 7] * inv); op[d8] = w; }
    }
}

__device__ __forceinline__ void p_combine(const Ctx& C, const bf16_t* yf, const bf16_t* yb, bf16_t* szu, float* rstd) {
    const int gw = C.bid * NWAVES + C.wave, NGW = C.G * NWAVES;
    for (int row = gw; row < T; row += NGW) {
        const size_t base = (size_t)row * 1024;
        float s = 0.f; u32x4 outv[2];
#pragma unroll
        for (int j = 0; j < 2; ++j) {
            const size_t off = base + j * 512 + C.lane * 8;
            const u32x4 a = *(const u32x4*)(yf + off), b = *(const u32x4*)(yb + off), z = *(const u32x4*)(szu + off);
            float u[8];
            u[0] = (bflo(a.x) + bflo(b.x)) * bflo(z.x); u[1] = (bfhi(a.x) + bfhi(b.x)) * bfhi(z.x);
            u[2] = (bflo(a.y) + bflo(b.y)) * bflo(z.y); u[3] = (bfhi(a.y) + bfhi(b.y)) * bfhi(z.y);
            u[4] = (bflo(a.z) + bflo(b.z)) * bflo(z.z); u[5] = (bfhi(a.z) + bfhi(b.z)) * bfhi(z.z);
            u[6] = (bflo(a.w) + bflo(b.w)) * bflo(z.w); u[7] = (bfhi(a.w) + bfhi(b.w)) * bfhi(z.w);
#pragma unroll
            for (int q = 0; q < 8; ++q) s += u[q] * u[q];
            outv[j].x = pk2(u[0], u[1]); outv[j].y = pk2(u[2], u[3]); outv[j].z = pk2(u[4], u[5]); outv[j].w = pk2(u[6], u[7]);
        }
        s = wave_sum(s);
#pragma unroll
        for (int j = 0; j < 2; ++j) *(u32x4*)(szu + base + j * 512 + C.lane * 8) = outv[j];
        if (C.lane == 0) rstd[row] = rsqrtf(s * (1.f / 1024.f) + EPS);
    }
}

__device__ __forceinline__ void p_cvt_tables(const Ctx& C, bf16_t* ub, bf16_t* vb) {
    const int gt = C.bid * NTHR + C.tid, NT = C.G * NTHR;
    const float* u = C.in[21]; const float* v = C.in[22];
    for (int i = gt; i < 16384 * 1024 / 8; i += NT) {
        const f32x4 a0 = *(const f32x4*)(u + (size_t)i * 8), a1 = *(const f32x4*)(u + (size_t)i * 8 + 4);
        u32x4 o; o.x = pk2(a0.x, a0.y); o.y = pk2(a0.z, a0.w); o.z = pk2(a1.x, a1.y); o.w = pk2(a1.z, a1.w);
        *(u32x4*)(ub + (size_t)i * 8) = o;
        const f32x4 b0 = *(const f32x4*)(v + (size_t)i * 8), b1 = *(const f32x4*)(v + (size_t)i * 8 + 4);
        u32x4 p; p.x = pk2(b0.x, b0.y); p.y = pk2(b0.z, b0.w); p.z = pk2(b1.x, b1.y); p.w = pk2(b1.z, b1.w);
        *(u32x4*)(vb + (size_t)i * 8) = p;
    }
}

__device__ __forceinline__ void p_topk_naive(const Ctx& C, const bf16_t* qp, const bf16_t* keys, unsigned short* pidx, float* pgate) {
    constexpr int NTK = 64;
    LAS float* S = (LAS float*)C.lds;
    LAS float* TV = (LAS float*)(C.lds + 256 * NTK * 4);
    LAS int* TI = (LAS int*)(C.lds + 256 * NTK * 4 + 32 * NTK * 4);
    const int tl = C.tid;
    if (C.tid < 64)
    for (int item = C.bid * NTK + tl; item < T * 8; item += C.G * NTK) {
        const int t = item >> 3, hh = item & 7;
        for (int z = 0; z < 2; ++z) {
            unsigned qv[64];
            const u32x4* qptr = (const u32x4*)(qp + (size_t)t * 2048 + hh * 256 + z * 128);
#pragma unroll
            for (int d8 = 0; d8 < 16; ++d8) { const u32x4 w = qptr[d8]; qv[d8 * 4 + 0] = w.x; qv[d8 * 4 + 1] = w.y; qv[d8 * 4 + 2] = w.z; qv[d8 * 4 + 3] = w.w; }
            for (int n = 0; n < 128; ++n) {
                const u32x4* kp = (const u32x4*)(keys + (size_t)(z * 128 + n) * 128);
                float acc = 0.f;
#pragma unroll
                for (int d8 = 0; d8 < 16; ++d8) { const u32x4 w = kp[d8];
                    acc += bflo(qv[d8 * 4 + 0]) * bflo(w.x) + bfhi(qv[d8 * 4 + 0]) * bfhi(w.x) + bflo(qv[d8 * 4 + 1]) * bflo(w.y) + bfhi(qv[d8 * 4 + 1]) * bfhi(w.y)
                         + bflo(qv[d8 * 4 + 2]) * bflo(w.z) + bfhi(qv[d8 * 4 + 2]) * bfhi(w.z) + bflo(qv[d8 * 4 + 3]) * bflo(w.w) + bfhi(qv[d8 * 4 + 3]) * bfhi(w.w); }
                S[(z * 128 + n) * NTK + tl] = acc;
            }
            float pv = 3.0e38f; int pi = -1;
            for (int r = 0; r < 16; ++r) {
                float best = -3.0e38f; int bi = 0;
                for (int n = 0; n < 128; ++n) { const float x = S[(z * 128 + n) * NTK + tl];
                    const bool elig = (x < pv) || (x == pv && n > pi);
                    if (elig && x > best) { best = x; bi = n; } }
                TV[(z * 16 + r) * NTK + tl] = best; TI[(z * 16 + r) * NTK + tl] = bi; pv = best; pi = bi;
            }
        }
        float pv = 3.0e38f; int pi = -1; float top[16]; int ei[16];
#pragma unroll
        for (int r = 0; r < 16; ++r) {
            float best = -3.0e38f; int bi = 0;
            for (int c = 0; c < 256; ++c) { const float x = TV[(c >> 4) * NTK + tl] + TV[(16 + (c & 15)) * NTK + tl];
                const bool elig = (x < pv) || (x == pv && c > pi);
                if (elig && x > best) { best = x; bi = c; } }
            top[r] = best; ei[r] = TI[(bi >> 4) * NTK + tl] * 128 + TI[(16 + (bi & 15)) * NTK + tl]; pv = best; pi = bi;
        }
        float den = 0.f, e[16];
#pragma unroll
        for (int r = 0; r < 16; ++r) { e[r] = __expf(top[r] - top[0]); den += e[r]; }
        const float inv = 1.f / den;
#pragma unroll
        for (int r = 0; r < 16; ++r) { pidx[(size_t)t * 128 + hh * 16 + r] = (unsigned short)ei[r]; pgate[(size_t)t * 128 + hh * 16 + r] = e[r] * inv; }
    }
}

__device__ __forceinline__ float dot2u(unsigned a, unsigned x, float acc) {
    return __builtin_amdgcn_fdot2_f32_bf16(__builtin_bit_cast(bf16x2_t, a), __builtin_bit_cast(bf16x2_t, x), acc, false);
}
__device__ __forceinline__ float dot8(const u32x4 a, const u32x4 x, float acc) {
    const unsigned a0 = a.x, a1 = a.y, a2 = a.z, a3 = a.w, x0 = x.x, x1 = x.y, x2 = x.z, x3 = x.w;
    acc = dot2u(a0, x0, acc); acc = dot2u(a1, x1, acc); acc = dot2u(a2, x2, acc); acc = dot2u(a3, x3, acc);
    return acc;
}
__device__ __forceinline__ void p_gather(const Ctx& C, const bf16_t* n2, const unsigned short* pidx, const float* pgate, const bf16_t* ub, const bf16_t* vb, const float* h, float* out) {
    const float* mod = C.f32p(WS_MOD); const float* fg = C.in[23];
    LAS float* cbuf = (LAS float*)C.lds + C.wave * 128;
    const int gw = C.bid * NWAVES + C.wave, NGW = C.G * NWAVES, lane = C.lane;
    for (int t = gw; t < T; t += NGW) {
        const int b = t / SEQ;
        const u32x4 x0 = *(const u32x4*)(n2 + (size_t)t * 1024 + lane * 8), x1 = *(const u32x4*)(n2 + (size_t)t * 1024 + 512 + lane * 8);
        const int id0 = pidx[(size_t)t * 128 + lane], id1 = pidx[(size_t)t * 128 + 64 + lane];
        const float g0 = pgate[(size_t)t * 128 + lane], g1 = pgate[(size_t)t * 128 + 64 + lane];
#pragma unroll 1
        for (int grp = 0; grp < 8; ++grp) {
            const int idv = grp < 4 ? id0 : id1; const int lbase = (grp & 3) * 16;
            float part[16];
#pragma unroll
            for (int j = 0; j < 16; ++j) {
                const int e = __shfl(idv, lbase + j);
                const bf16_t* rowp = ub + (size_t)e * 1024;
                const u32x4 a0 = *(const u32x4*)(rowp + lane * 8), a1 = *(const u32x4*)(rowp + 512 + lane * 8);
                part[j] = dot8(a1, x1, dot8(a0, x0, 0.f));
            }
            float p8[8];
            { const bool hi = (lane & 32) != 0;
#pragma unroll
              for (int j = 0; j < 8; ++j) { const float keep = hi ? part[j + 8] : part[j], send = hi ? part[j] : part[j + 8]; p8[j] = keep + __shfl_xor(send, 32); } }
            float p4[4];
            { const bool hi = (lane & 16) != 0;
#pragma unroll
              for (int j = 0; j < 4; ++j) { const float keep = hi ? p8[j + 4] : p8[j], send = hi ? p8[j] : p8[j + 4]; p4[j] = keep + __shfl_xor(send, 16); } }
            float p2[2];
            { const bool hi = (lane & 8) != 0;
#pragma unroll
              for (int j = 0; j < 2; ++j) { const float keep = hi ? p4[j + 2] : p4[j], send = hi ? p4[j] : p4[j + 2]; p2[j] = keep + __shfl_xor(send, 8); } }
            float p1;
            { const bool hi = (lane & 4) != 0; const float keep = hi ? p2[1] : p2[0], send = hi ? p2[0] : p2[1]; p1 = keep + __shfl_xor(send, 4); }
            p1 += __shfl_xor(p1, 2); p1 += __shfl_xor(p1, 1);
            const int E = ((lane >> 5) & 1) * 8 + ((lane >> 4) & 1) * 4 + ((lane >> 3) & 1) * 2 + ((lane >> 2) & 1);
            if ((lane & 3) == 0) cbuf[grp * 16 + E] = gelu_f(p1);
        }
        asm volatile("s_waitcnt lgkmcnt(0)" ::: "memory");
        const float c0 = cbuf[lane] * g0, c1 = cbuf[64 + lane] * g1;
        asm volatile("s_waitcnt lgkmcnt(0)" ::: "memory");
        float acc[16];
#pragma unroll
        for (int i = 0; i < 16; ++i) acc[i] = 0.f;
#pragma unroll 1
        for (int kb = 0; kb < 128; kb += 8) {
            const int idv = kb < 64 ? id0 : id1; const float cv = kb < 64 ? c0 : c1;
#pragma unroll
            for (int j = 0; j < 8; ++j) {
                const int e = __shfl(idv, (kb & 63) + j); const float ck = __shfl(cv, (kb & 63) + j);
                const bf16_t* rowp = vb + (size_t)e * 1024;
                const u32x4 a0 = *(const u32x4*)(rowp + lane * 8), a1 = *(const u32x4*)(rowp + 512 + lane * 8);
                acc[0] += ck * bflo(a0.x); acc[1] += ck * bfhi(a0.x); acc[2] += ck * bflo(a0.y); acc[3] += ck * bfhi(a0.y);
                acc[4] += ck * bflo(a0.z); acc[5] += ck * bfhi(a0.z); acc[6] += ck * bflo(a0.w); acc[7] += ck * bfhi(a0.w);
                acc[8] += ck * bflo(a1.x); acc[9] += ck * bfhi(a1.x); acc[10] += ck * bflo(a1.y); acc[11] += ck * bfhi(a1.y);
                acc[12] += ck * bflo(a1.z); acc[13] += ck * bfhi(a1.z); acc[14] += ck * bflo(a1.w); acc[15] += ck * bfhi(a1.w);
            }
        }
        float hf[16]; float ss = 0.f;
#pragma unroll
        for (int half = 0; half < 2; ++half) {
            const int col = half * 512 + lane * 8;
            const f32x4 h0 = *(const f32x4*)(h + (size_t)t * 1024 + col), h1 = *(const f32x4*)(h + (size_t)t * 1024 + col + 4);
            const f32x4 m0 = *(const f32x4*)(mod + b * 6144 + 5120 + col), m1 = *(const f32x4*)(mod + b * 6144 + 5120 + col + 4);
            hf[half * 8 + 0] = h0.x + m0.x * acc[half * 8 + 0]; hf[half * 8 + 1] = h0.y + m0.y * acc[half * 8 + 1];
            hf[half * 8 + 2] = h0.z + m0.z * acc[half * 8 + 2]; hf[half * 8 + 3] = h0.w + m0.w * acc[half * 8 + 3];
            hf[half * 8 + 4] = h1.x + m1.x * acc[half * 8 + 4]; hf[half * 8 + 5] = h1.y + m1.y * acc[half * 8 + 5];
            hf[half * 8 + 6] = h1.z + m1.z * acc[half * 8 + 6]; hf[half * 8 + 7] = h1.w + m1.w * acc[half * 8 + 7];
        }
#pragma unroll
        for (int i = 0; i < 16; ++i) ss += hf[i] * hf[i];
        const float rstd = rsqrtf(wave_sum(ss) * (1.f / 1024.f) + EPS);
#pragma unroll
        for (int half = 0; half < 2; ++half) {
            const int col = half * 512 + lane * 8;
            const f32x4 f0 = *(const f32x4*)(fg + col), f1 = *(const f32x4*)(fg + col + 4);
            f32x4 o0, o1;
            o0.x = hf[half * 8 + 0] * rstd * f0.x; o0.y = hf[half * 8 + 1] * rstd * f0.y; o0.z = hf[half * 8 + 2] * rstd * f0.z; o0.w = hf[half * 8 + 3] * rstd * f0.w;
            o1.x = hf[half * 8 + 4] * rstd * f1.x; o1.y = hf[half * 8 + 5] * rstd * f1.y; o1.z = hf[half * 8 + 6] * rstd * f1.z; o1.w = hf[half * 8 + 7] * rstd * f1.w;
            *(f32x4*)(out + (size_t)t * 1024 + col) = o0; *(f32x4*)(out + (size_t)t * 1024 + col + 4) = o1;
        }
    }
}


__device__ __forceinline__ void p_gather_ref(const Ctx& C, const bf16_t* n2, const unsigned short* pidx, const float* pgate, const float* h, float* out) {
    const float* mod = C.f32p(WS_MOD); const float* fg = C.in[23]; const float* U = C.in[21]; const float* V = C.in[22];
    LAS float* xs = (LAS float*)C.lds;
    LAS float* part = xs + 1024;
    LAS float* cs = part + 512;
    LAS float* red = cs + 128;
    LAS int* es = (LAS int*)(red + 512);
    const int tid = C.tid;
    for (int t = C.bid; t < T; t += C.G) {
        const int b = t / SEQ;
        __syncthreads();
        xs[tid] = bf2f(n2[(size_t)t * 1024 + tid]); xs[tid + 512] = bf2f(n2[(size_t)t * 1024 + 512 + tid]);
        if (tid < 128) es[tid] = pidx[(size_t)t * 128 + tid];
        __syncthreads();
        { const int k = tid >> 2, qd = tid & 3; const float* ur = U + (size_t)es[k] * 1024 + qd * 256; float acc = 0.f;
          for (int d = 0; d < 256; ++d) acc += ur[d] * xs[qd * 256 + d];
          part[tid] = acc; }
        __syncthreads();
        if (tid < 128) { const float dsum = part[tid * 4] + part[tid * 4 + 1] + part[tid * 4 + 2] + part[tid * 4 + 3]; cs[tid] = gelu_f(dsum) * pgate[(size_t)t * 128 + tid]; }
        __syncthreads();
        float o0 = 0.f, o1 = 0.f;
        for (int k = 0; k < 128; ++k) { const float* vr = V + (size_t)es[k] * 1024; const float ck = cs[k]; o0 += ck * vr[tid]; o1 += ck * vr[tid + 512]; }
        const float h0 = h[(size_t)t * 1024 + tid] + mod[b * 6144 + 5120 + tid] * o0, h1 = h[(size_t)t * 1024 + 512 + tid] + mod[b * 6144 + 5120 + 512 + tid] * o1;
        red[tid] = h0 * h0 + h1 * h1;
        __syncthreads();
        for (int sft = 256; sft > 0; sft >>= 1) { if (tid < sft) red[tid] += red[tid + sft]; __syncthreads(); }
        const float rstd = rsqrtf(red[0] * (1.f / 1024.f) + EPS);
        out[(size_t)t * 1024 + tid] = h0 * rstd * fg[tid]; out[(size_t)t * 1024 + 512 + tid] = h1 * rstd * fg[tid + 512];
    }
}

namespace pg8 {
#define PG8_LAS __attribute__((address_space(3)))
typedef unsigned short bf16_t;
typedef short bf16x8 __attribute__((ext_vector_type(8)));
typedef float f32x4 __attribute__((ext_vector_type(4)));
typedef unsigned u32x4 __attribute__((ext_vector_type(4)));
constexpr int BM = 256, BK = 64, HALF = 128, HTB = HALF * BK * 2  , STAGE_BYTES = 8 * HTB, NXCD = 8, WGM = 8;

__host__ __device__ __forceinline__ int lds_byte(int r, int c) { const int st = (r >> 4) * 2 + (c >> 5), rr = r & 15, cc = c & 31, ob = rr * 64 + cc * 2; return st * 1024 + (ob ^ (((ob >> 9) & 1) << 5)); }
__host__ __device__ __forceinline__ void stage_rc(int b, int& R, int& C) { const int st = b / 1024, sb = b % 1024, swz = sb ^ (((sb >> 9) & 1) << 5); R = (st >> 1) * 16 + swz / 64; C = (st & 1) * 32 + (swz % 64) / 2; }
__host__ __device__ __forceinline__ int perm32(int rho) { const int n = rho >> 4, i = rho & 15; return 8 * (i >> 2) + 4 * n + (i & 3); }

struct Unit { int pm, pn; };
struct Gemm { const bf16_t* A; const bf16_t* Bt; int M, N, K; };

struct StaticOrder {
    int nM, nN, nwg, G, c;
    __host__ __device__ void init(int M, int N, int G_, int c_) { nM = M / BM; nN = N / BM; nwg = nM * nN; G = G_; c = c_; }
    __host__ __device__ bool next(int i, Unit& u) const {
        const long L = (long)i * G + c; if (L >= nwg) return false;
        int wgid = (int)L; { const int q = nwg / NXCD, r = nwg % NXCD, xcd = wgid % NXCD, off = wgid / NXCD; wgid = (xcd < r ? xcd * (q + 1) : r * (q + 1) + (xcd - r) * q) + off; }
        const int nig = WGM * nN, gid = wgid / nig, fm = gid * WGM, gsz = (nM - fm) < WGM ? (nM - fm) : WGM;
        u.pm = fm + ((wgid % nig) % gsz); u.pn = (wgid % nig) / gsz; return true;
    }
    __device__ __forceinline__ void a_ready(const Unit&) const {}
    __device__ __forceinline__ void done(const Unit&) const {}
};

__device__ __forceinline__ unsigned cvt_pk_bf16(float lo, float hi) { unsigned r; asm volatile("v_cvt_pk_bf16_f32 %0, %1, %2" : "=v"(r) : "v"(lo), "v"(hi)); return r; }
__device__ __forceinline__ float e_silu(float x) { return x / (1.f + __expf(-x)); }
__device__ __forceinline__ float e_sigm(float x) { return 1.f / (1.f + __expf(-x)); }
__device__ __forceinline__ float e_lo(unsigned v) { return __uint_as_float(v << 16); }
__device__ __forceinline__ float e_hi(unsigned v) { return __uint_as_float(v & 0xffff0000u); }
__device__ __forceinline__ u32x4 pack8(const f32x4 v0, const f32x4 v1) { u32x4 w; w.x = cvt_pk_bf16(v0[0], v0[1]); w.y = cvt_pk_bf16(v0[2], v0[3]); w.z = cvt_pk_bf16(v1[0], v1[1]); w.w = cvt_pk_bf16(v1[2], v1[3]); return w; }

struct EpiInProj {
    static constexpr bool PERM = true, AFTER_DRAIN = false;
    bf16_t *sz, *xbc, *q, *k, *v;
    __device__ __forceinline__ void operator()(const f32x4 (&acc)[2][2][4][2], const Unit& u, int wr, int wc, int fr, int fq) const {
        const int pn = u.pn; bf16_t* base; int ldc = 1024, colt, mode = 0;
        if (pn < 4) { base = sz; colt = pn * 256; mode = 1; }
        else if (pn < 12) { base = xbc; ldc = 2048; colt = (pn - 4) * 256; }
        else if (pn < 16) { base = q; colt = (pn - 12) * 256; mode = 2; }
        else if (pn < 20) { base = k; colt = (pn - 16) * 256; }
        else { base = v; colt = (pn - 20) * 256; }
        const int row0 = u.pm * BM + wr * 64 + fr, col0 = colt + wc * 32 + 8 * fq;
#pragma unroll
        for (int ai = 0; ai < 2; ++ai)
#pragma unroll
            for (int m = 0; m < 4; ++m) { bf16_t* rowp = base + (size_t)(row0 + ai * HALF + m * 16) * ldc + col0;
#pragma unroll
                for (int bj = 0; bj < 2; ++bj) { f32x4 v0 = acc[ai][bj][m][0], v1 = acc[ai][bj][m][1];
                    if (mode == 1) {
#pragma unroll
                        for (int i = 0; i < 4; ++i) { v0[i] = e_silu(v0[i]); v1[i] = e_silu(v1[i]); } }
                    else if (mode == 2) { v0 = v0 * 0.125f; v1 = v1 * 0.125f; }
                    *(u32x4*)(rowp + bj * HALF) = pack8(v0, v1); } }
    }
};
struct EpiGate {
    static constexpr bool PERM = true, AFTER_DRAIN = false;
    bf16_t* sg; size_t plane;
    __device__ __forceinline__ void operator()(const f32x4 (&acc)[2][2][4][2], const Unit& u, int wr, int wc, int fr, int fq) const {
        bf16_t* base = sg + (size_t)(u.pn >> 2) * plane; const int colt = (u.pn & 3) * 256;
        const int row0 = u.pm * BM + wr * 64 + fr, col0 = colt + wc * 32 + 8 * fq;
#pragma unroll
        for (int ai = 0; ai < 2; ++ai)
#pragma unroll
            for (int m = 0; m < 4; ++m) { bf16_t* rowp = base + (size_t)(row0 + ai * HALF + m * 16) * 1024 + col0;
#pragma unroll
                for (int bj = 0; bj < 2; ++bj) { f32x4 v0 = acc[ai][bj][m][0], v1 = acc[ai][bj][m][1];
#pragma unroll
                    for (int i = 0; i < 4; ++i) { v0[i] = e_sigm(v0[i]); v1[i] = e_sigm(v1[i]); }
                    *(u32x4*)(rowp + bj * HALF) = pack8(v0, v1); } }
    }
};
struct EpiD1 {
    static constexpr bool PERM = true, AFTER_DRAIN = false;
    bf16_t* p1; const bf16_t* sg1; const float* rstd;
    __device__ __forceinline__ void operator()(const f32x4 (&acc)[2][2][4][2], const Unit& u, int wr, int wc, int fr, int fq) const {
        const int row0 = u.pm * BM + wr * 64 + fr, col0 = u.pn * BM + wc * 32 + 8 * fq;
#pragma unroll
        for (int ai = 0; ai < 2; ++ai)
#pragma unroll
            for (int m = 0; m < 4; ++m) { const int row = row0 + ai * HALF + m * 16; const float rs = rstd[row]; const size_t off = (size_t)row * 1024 + col0;
#pragma unroll
                for (int bj = 0; bj < 2; ++bj) { f32x4 v0 = acc[ai][bj][m][0] * rs, v1 = acc[ai][bj][m][1] * rs;
                    const u32x4 g = *(const u32x4*)(sg1 + off + bj * HALF);
                    v0[0] *= e_lo(g.x); v0[1] *= e_hi(g.x); v0[2] *= e_lo(g.y); v0[3] *= e_hi(g.y); v1[0] *= e_lo(g.z); v1[1] *= e_hi(g.z); v1[2] *= e_lo(g.w); v1[3] *= e_hi(g.w);
                    *(u32x4*)(p1 + off + bj * HALF) = pack8(v0, v1); } }
    }
};
struct EpiD2 {
    static constexpr bool PERM = true, AFTER_DRAIN = false;
    bf16_t* mixed; const bf16_t *p1, *sg2;
    __device__ __forceinline__ void operator()(const f32x4 (&acc)[2][2][4][2], const Unit& u, int wr, int wc, int fr, int fq) const {
        const int row0 = u.pm * BM + wr * 64 + fr, col0 = u.pn * BM + wc * 32 + 8 * fq;
#pragma unroll
        for (int ai = 0; ai < 2; ++ai)
#pragma unroll
            for (int m = 0; m < 4; ++m) { const int row = row0 + ai * HALF + m * 16; const size_t off = (size_t)row * 1024 + col0;
#pragma unroll
                for (int bj = 0; bj < 2; ++bj) { f32x4 v0 = acc[ai][bj][m][0], v1 = acc[ai][bj][m][1];
                    const u32x4 g = *(const u32x4*)(sg2 + off + bj * HALF), p = *(const u32x4*)(p1 + off + bj * HALF);
                    v0[0] = e_lo(p.x) + v0[0] * e_lo(g.x); v0[1] = e_hi(p.x) + v0[1] * e_hi(g.x); v0[2] = e_lo(p.y) + v0[2] * e_lo(g.y); v0[3] = e_hi(p.y) + v0[3] * e_hi(g.y);
                    v1[0] = e_lo(p.z) + v1[0] * e_lo(g.z); v1[1] = e_hi(p.z) + v1[1] * e_hi(g.z); v1[2] = e_lo(p.w) + v1[2] * e_lo(g.w); v1[3] = e_hi(p.w) + v1[3] * e_hi(g.w);
                    *(u32x4*)(mixed + off + bj * HALF) = pack8(v0, v1); } }
    }
};
struct EpiD3 {
    static constexpr bool PERM = false, AFTER_DRAIN = false;
    float* h; const float* x; const float* mod;
    __device__ __forceinline__ void operator()(const f32x4 (&acc)[2][2][4][2], const Unit& u, int wr, int wc, int fr, int fq) const {
        const int row0 = u.pm * BM + wr * 64 + fr, col0 = u.pn * BM + wc * 32 + 4 * fq;
        const float* g1 = mod + (size_t)((u.pm * BM) >> 12) * 6144 + 2048;
#pragma unroll
        for (int ai = 0; ai < 2; ++ai)
#pragma unroll
            for (int m = 0; m < 4; ++m) { const size_t off = (size_t)(row0 + ai * HALF + m * 16) * 1024 + col0;
#pragma unroll
                for (int bj = 0; bj < 2; ++bj)
#pragma unroll
                    for (int n = 0; n < 2; ++n) { const int c = bj * HALF + n * 16; const f32x4 xv = *(const f32x4*)(x + off + c), gv = *(const f32x4*)(g1 + col0 + c);
                        *(f32x4*)(h + off + c) = xv + gv * acc[ai][bj][m][n]; } }
    }
};
struct EpiQp {
    static constexpr bool PERM = true, AFTER_DRAIN = false;
    bf16_t* qp;
    __device__ __forceinline__ void operator()(const f32x4 (&acc)[2][2][4][2], const Unit& u, int wr, int wc, int fr, int fq) const {
        const int row0 = u.pm * BM + wr * 64 + fr, col0 = u.pn * BM + wc * 32 + 8 * fq;
#pragma unroll
        for (int ai = 0; ai < 2; ++ai)
#pragma unroll
            for (int m = 0; m < 4; ++m) { bf16_t* rowp = qp + (size_t)(row0 + ai * HALF + m * 16) * 2048 + col0;
#pragma unroll
                for (int bj = 0; bj < 2; ++bj) *(u32x4*)(rowp + bj * HALF) = pack8(acc[ai][bj][m][0], acc[ai][bj][m][1]); }
    }
};

template <class Epi, class Sched, bool ALIGN_EPI = false, bool SP2 = false>
__device__ __forceinline__ void gemm_phase(PG8_LAS unsigned char* lds, const Gemm g, const Sched& S, const Epi& E) {
    const int tid = threadIdx.x, wid = __builtin_amdgcn_readfirstlane(tid >> 6), lane = tid & 63, wr = wid >> 2, wc = wid & 3, fr = lane & 15, fq = lane >> 4;
    const int K = g.K, nt = K / BK;
    unsigned voffA[2], voffB[2];
#pragma unroll
    for (int i = 0; i < 2; ++i) { int R, C; stage_rc(tid * 16 + i * 8192, R, C); const int Rb = Epi::PERM ? ((R & ~31) + perm32(R & 31)) : R;
        voffA[i] = (unsigned)(R * K + C) * 2u; voffB[i] = (unsigned)(Rb * K + C) * 2u; }
    const size_t kstep = (size_t)(BK * 2);
    const size_t hstep = (size_t)HALF * K * 2;
    const size_t tstep = 2 * hstep;
    const unsigned ldsw = (unsigned)wid * 1024u;
    const int aoff = lds_byte(wr * 64 + fr, fq * 8), boff = lds_byte(wc * 32 + fr, fq * 8);
#define PG8_SA(b, h) (((b) * 2 + (h)) * HTB)
#define PG8_SB(b, h) ((4 + (b) * 2 + (h)) * HTB)
#define PG8_STAGE(bufoff, gbase, voff) do { _Pragma("unroll") for (int _i = 0; _i < 2; ++_i) \
        __builtin_amdgcn_global_load_lds((const unsigned*)((const char*)(gbase) + (voff)[_i]), (PG8_LAS unsigned*)(lds + (bufoff) + ldsw + _i * 8192), 16, 0, 0); } while (0)
#define PG8_LDA(dst, b, h) do { _Pragma("unroll") for (int m = 0; m < 4; ++m) _Pragma("unroll") for (int k = 0; k < 2; ++k) dst[m][k] = *(const PG8_LAS bf16x8*)(lds + PG8_SA(b, h) + aoff + m * 2048 + k * 1024); } while (0)
#define PG8_LDB(dst, b, h) do { _Pragma("unroll") for (int n = 0; n < 2; ++n) _Pragma("unroll") for (int k = 0; k < 2; ++k) dst[n][k] = *(const PG8_LAS bf16x8*)(lds + PG8_SB(b, h) + boff + n * 2048 + k * 1024); } while (0)
#define PG8_MMA(ai, bj, At, Bt) do { __builtin_amdgcn_s_setprio(1); _Pragma("unroll") for (int m = 0; m < 4; ++m) _Pragma("unroll") for (int n = 0; n < 2; ++n) _Pragma("unroll") for (int k = 0; k < 2; ++k) \
        acc[ai][bj][m][n] = __builtin_amdgcn_mfma_f32_16x16x32_bf16(Bt[n][k], At[m][k], acc[ai][bj][m][n], 0, 0, 0); __builtin_amdgcn_s_setprio(0); } while (0)
#define PG8_WAIT_V(n) asm volatile("s_waitcnt vmcnt(" #n ")" ::: "memory")
#define PG8_WAIT_L(n) asm volatile("s_waitcnt lgkmcnt(" #n ")" ::: "memory")
#define PG8_BAR __builtin_amdgcn_s_barrier()
#define PG8_SCHED __builtin_amdgcn_sched_barrier(0)
    Unit cur, nxt; int ui = 0;
    if (!S.next(0, cur)) return;
    f32x4 acc[2][2][4][2];
#pragma unroll
    for (int a = 0; a < 2; ++a)
#pragma unroll
        for (int b = 0; b < 2; ++b)
#pragma unroll
            for (int m = 0; m < 4; ++m)
#pragma unroll
                for (int n = 0; n < 2; ++n) acc[a][b][m][n] = (f32x4){0.f, 0.f, 0.f, 0.f};
    bf16x8 At[4][2], B0[2][2], B1[2][2];
    const char* cA = (const char*)g.A + (size_t)cur.pm * tstep; const char* cB = (const char*)g.Bt + (size_t)cur.pn * tstep;
    S.a_ready(cur);
    if constexpr (SP2) {
        PG8_STAGE(PG8_SB(0, 0), cB, voffB); PG8_STAGE(PG8_SB(0, 1), cB + hstep, voffB); PG8_STAGE(PG8_SA(0, 0), cA, voffA); PG8_STAGE(PG8_SA(0, 1), cA + hstep, voffA);
        if (wr == 1) PG8_BAR;
        PG8_WAIT_V(2); PG8_BAR;
        PG8_STAGE(PG8_SB(1, 0), cB + kstep, voffB); PG8_STAGE(PG8_SA(1, 0), cA + kstep, voffA); PG8_STAGE(PG8_SB(1, 1), cB + hstep + kstep, voffB);
        PG8_WAIT_V(6); PG8_BAR;
    } else {
        PG8_STAGE(PG8_SB(0, 0), cB, voffB); PG8_STAGE(PG8_SA(0, 0), cA, voffA); PG8_STAGE(PG8_SB(0, 1), cB + hstep, voffB); PG8_STAGE(PG8_SA(0, 1), cA + hstep, voffA);
        if (wr == 1) PG8_BAR;
        PG8_WAIT_V(4); PG8_BAR;
        PG8_STAGE(PG8_SB(1, 0), cB + kstep, voffB); PG8_STAGE(PG8_SA(1, 0), cA + kstep, voffA); PG8_STAGE(PG8_SB(1, 1), cB + hstep + kstep, voffB);
        PG8_WAIT_V(6); PG8_BAR;
    }
    for (;;) {
        const bool has_next = S.next(ui + 1, nxt);
        const char* nA = has_next ? (const char*)g.A + (size_t)nxt.pm * tstep : cA; const char* nB = has_next ? (const char*)g.Bt + (size_t)nxt.pn * tstep : cB;
        for (int t = 0; t < nt; t += 2) {
            const bool last = (t == nt - 2);
            const char* a1 = cA + (size_t)(t + 1) * kstep;
            const char* a2 = last ? nA : cA + (size_t)(t + 2) * kstep; const char* b2 = last ? nB : cB + (size_t)(t + 2) * kstep;
            const char* a3 = a2 + kstep; const char* b3 = b2 + kstep;
            if (last && has_next) S.a_ready(nxt);
            if constexpr (SP2) {
            PG8_LDB(B0, 0, 0); PG8_LDB(B1, 0, 1); PG8_SCHED; PG8_LDA(At, 0, 0); PG8_STAGE(PG8_SA(1, 1), a1 + hstep, voffA);
            PG8_WAIT_V(8); PG8_WAIT_L(0); PG8_BAR; PG8_MMA(0, 0, At, B0); PG8_MMA(0, 1, At, B1); PG8_BAR; PG8_SCHED;
            PG8_LDA(At, 0, 1); PG8_STAGE(PG8_SB(0, 0), b2, voffB); PG8_STAGE(PG8_SB(0, 1), b2 + hstep, voffB); PG8_STAGE(PG8_SA(0, 0), a2, voffA);
            PG8_WAIT_V(8); PG8_WAIT_L(0); PG8_BAR; PG8_MMA(1, 0, At, B0); PG8_MMA(1, 1, At, B1); PG8_BAR; PG8_SCHED;
            PG8_LDB(B0, 1, 0); PG8_LDB(B1, 1, 1); PG8_SCHED; PG8_LDA(At, 1, 0); PG8_STAGE(PG8_SA(0, 1), a2 + hstep, voffA);
            PG8_WAIT_V(8); PG8_WAIT_L(0); PG8_BAR; PG8_MMA(0, 0, At, B0); PG8_MMA(0, 1, At, B1); PG8_BAR; PG8_SCHED;
            PG8_LDA(At, 1, 1); PG8_STAGE(PG8_SB(1, 0), b3, voffB); PG8_STAGE(PG8_SB(1, 1), b3 + hstep, voffB); PG8_STAGE(PG8_SA(1, 0), a3, voffA);
            PG8_WAIT_V(8); PG8_WAIT_L(0); PG8_BAR; PG8_MMA(1, 0, At, B0); PG8_MMA(1, 1, At, B1); PG8_BAR; PG8_SCHED;
            } else {
            PG8_LDB(B0, 0, 0); PG8_SCHED; PG8_LDA(At, 0, 0); PG8_STAGE(PG8_SA(1, 1), a1 + hstep, voffA);
            PG8_WAIT_L(8); PG8_BAR; PG8_WAIT_L(0); PG8_MMA(0, 0, At, B0); PG8_BAR; PG8_SCHED;
            PG8_LDB(B1, 0, 1); PG8_STAGE(PG8_SB(0, 0), b2, voffB);
            PG8_BAR; PG8_WAIT_L(0); PG8_MMA(0, 1, At, B1); PG8_BAR;
            PG8_LDA(At, 0, 1); PG8_STAGE(PG8_SA(0, 0), a2, voffA);
            PG8_BAR; PG8_WAIT_L(0); PG8_MMA(1, 0, At, B0); PG8_BAR; PG8_SCHED;
            PG8_STAGE(PG8_SB(0, 1), b2 + hstep, voffB);
            PG8_WAIT_V(6); PG8_BAR; PG8_MMA(1, 1, At, B1); PG8_BAR;
            PG8_LDB(B0, 1, 0); PG8_SCHED; PG8_LDA(At, 1, 0); PG8_STAGE(PG8_SA(0, 1), a2 + hstep, voffA);
            PG8_WAIT_L(8); PG8_BAR; PG8_WAIT_L(0); PG8_MMA(0, 0, At, B0); PG8_BAR; PG8_SCHED;
            PG8_LDB(B1, 1, 1); PG8_STAGE(PG8_SB(1, 0), b3, voffB);
            PG8_BAR; PG8_WAIT_L(0); PG8_MMA(0, 1, At, B1); PG8_BAR;
            PG8_LDA(At, 1, 1); PG8_STAGE(PG8_SA(1, 0), a3, voffA);
            PG8_BAR; PG8_WAIT_L(0); PG8_MMA(1, 0, At, B0); PG8_BAR; PG8_SCHED;
            PG8_STAGE(PG8_SB(1, 1), b3 + hstep, voffB);
            PG8_WAIT_V(6); PG8_BAR; PG8_MMA(1, 1, At, B1); PG8_BAR;
            }
        }
        if constexpr (ALIGN_EPI) { if (wr == 0) PG8_BAR; }
        if constexpr (!Epi::AFTER_DRAIN) { E(acc, cur, wr, wc, fr, fq); S.done(cur); }
        if (!has_next) break;
#pragma unroll
        for (int a = 0; a < 2; ++a)
#pragma unroll
            for (int b = 0; b < 2; ++b)
#pragma unroll
                for (int m = 0; m < 4; ++m)
#pragma unroll
                    for (int n = 0; n < 2; ++n) acc[a][b][m][n] = (f32x4){0.f, 0.f, 0.f, 0.f};
        cur = nxt; cA = nA; cB = nB; ++ui;
        if constexpr (ALIGN_EPI) { if (wr == 1) PG8_BAR; }
    }
    PG8_WAIT_V(0);
    if constexpr (!ALIGN_EPI) { if (wr == 0) PG8_BAR; }
    PG8_BAR;
    if constexpr (Epi::AFTER_DRAIN) { E.fused(acc, cur, wr, wc, fr, fq, lds, wid, lane); S.done(cur); }
#undef PG8_SA
#undef PG8_SB
#undef PG8_STAGE
#undef PG8_LDA
#undef PG8_LDB
#undef PG8_MMA
#undef PG8_WAIT_V
#undef PG8_WAIT_L
#undef PG8_BAR
#undef PG8_SCHED
}
}

#define GAS __attribute__((address_space(1)))
typedef GAS unsigned gu32;
#define RLX_AGENT __ATOMIC_RELAXED, __HIP_MEMORY_SCOPE_AGENT
#define XB_TMO      128
#define XB_XCNT(j)  (256  + 64 * (j))
#define XB_XSUB(j)  (1280 + 64 * (j))
#define XB_XGEN(j)  (2304 + 64 * (j))
#define XB_TOP      3328
#define XB_TOPGEN   3392
#define XCD_BAR_WORDS 3456
#define XB_SPIN_CAP (1u << 18)

__device__ __forceinline__ unsigned xb_ld(unsigned* p)              { return __hip_atomic_load(p, __ATOMIC_RELAXED, __HIP_MEMORY_SCOPE_AGENT); }
__device__ __forceinline__ unsigned xb_add(unsigned* p, unsigned v) { return __hip_atomic_fetch_add(p, v, __ATOMIC_RELAXED, __HIP_MEMORY_SCOPE_AGENT); }
__device__ __forceinline__ unsigned xb_xcc_id() { return (unsigned)__builtin_amdgcn_s_getreg((3 << 11) | 20) & 0xFu; }
#define XB_SPIN(cond, bar) do { unsigned _sp = 0; while (cond) { __builtin_amdgcn_s_sleep(1); \
    if ((++_sp & 255u) == 0u) { if (xb_ld(&(bar)[XB_TMO])) break; if (_sp > XB_SPIN_CAP) { atomicAdd(&(bar)[XB_TMO], 1u); break; } } } } while (0)

struct XcdBarrier {
    unsigned* bar; unsigned x;
    volatile LAS unsigned* st;
};

__device__ __forceinline__ XcdBarrier xcd_barrier_post(unsigned* bar, volatile LAS unsigned* st) {
    XcdBarrier b; b.bar = bar; b.x = xb_xcc_id(); b.st = st;
    if (threadIdx.x == 0) (void)xb_add(&bar[XB_XCNT(b.x)], 1u);
    return b;
}
__device__ __forceinline__ void xcd_barrier_complete(unsigned* bar, unsigned x, unsigned& nloc, unsigned& nx) {
    const unsigned G = gridDim.x * gridDim.y * gridDim.z;
    unsigned sum, cnt, mine, sp = 0u;
    for (;;) {
        sum = 0u; cnt = 0u; mine = 0u;
#pragma unroll
        for (unsigned j = 0; j < 16; ++j) { const unsigned c = xb_ld(&bar[XB_XCNT(j)]); sum += c; cnt += (c > 0u) ? 1u : 0u; mine = (j == x) ? c : mine; }
        if (sum == G) break;
        __builtin_amdgcn_s_sleep(1);
        if ((++sp & 255u) == 0u) { if (xb_ld(&bar[XB_TMO])) break; if (sp > XB_SPIN_CAP) { atomicAdd(&bar[XB_TMO], 1u); break; } }
    }
    nloc = mine > 0u ? mine : 1u; nx = cnt > 0u ? cnt : 1u;
}

__device__ __forceinline__ void xcd_barrier(const XcdBarrier& b) {
    asm volatile("s_waitcnt vmcnt(0)" ::: "memory");
    __syncthreads();
    if (threadIdx.x == 0) {
        unsigned* bar = b.bar;
        __builtin_amdgcn_s_waitcnt(0);
        unsigned nloc = b.st[0], nx = b.st[1];
        if (nloc == 0u) { xcd_barrier_complete(bar, b.x, nloc, nx); b.st[0] = nloc; b.st[1] = nx; }
        const unsigned old = xb_add(&bar[XB_XSUB(b.x)], 1u);
        const unsigned gen = old / nloc;
        if (old + 1u == (gen + 1u) * nloc) {
            __builtin_amdgcn_fence(__ATOMIC_RELEASE, "agent");
            asm volatile("s_waitcnt vmcnt(0)" ::: "memory");
            const unsigned og = xb_add(&bar[XB_TOP], 1u);
            const unsigned tg = og / nx;
            if (og + 1u == (tg + 1u) * nx) xb_add(&bar[XB_TOPGEN], 1u);
            else XB_SPIN(xb_ld(&bar[XB_TOPGEN]) == tg, bar);
            __builtin_amdgcn_fence(__ATOMIC_ACQUIRE, "agent");
            xb_add(&bar[XB_XGEN(b.x)], 1u);
            asm volatile("s_waitcnt vmcnt(0)" ::: "memory");
        } else {
            XB_SPIN(xb_ld(&bar[XB_XGEN(b.x)]) == gen, bar);
            __builtin_amdgcn_fence(__ATOMIC_ACQUIRE, "agent");
            asm volatile("s_waitcnt vmcnt(0)" ::: "memory");
        }
    }
    __syncthreads();
}


constexpr int N_PHASES = 15;
constexpr int CW_BAR = 4096;
constexpr size_t CTL_ZERO_BYTES = 64 * 1024;
constexpr int MISC_OFF = LDS_BYTES - 256;

template <int PH>
__device__ __forceinline__ void run_phase(const Ctx& C, const Args& a) {
    bf16_t* R0 = C.bfp(WS_R0); bf16_t* R1 = C.bfp(WS_R1); bf16_t* R2 = C.bfp(WS_R2); bf16_t* R3 = C.bfp(WS_R3);
    bf16_t* OB = (bf16_t*)a.out;
    const size_t TD = (size_t)T * 1024;
    if constexpr (PH == 0) p_prep(C);
    if constexpr (PH == 1) p_rownorm(C, C.in[0], C.in[4], 0, 1024, R0);
    if constexpr (PH == 2) {
        { pg8::Gemm g{R0, C.bfp(WS_WIN_T), T, 6144, 1024}; pg8::StaticOrder S; S.init(T, 6144, C.G, C.bid);
          pg8::EpiInProj e{R1, R2, R3, R3 + TD, R3 + 2 * TD};
          pg8::gemm_phase<pg8::EpiInProj, pg8::StaticOrder, true, true>(C.lds, g, S, e); }
        EDt ed{C.f32p(WS_DT), C.in[8], C.in[9]};
        naive_gemm(C, R0, C.bfp(WS_WDT_T), T, 32, 1024, ed);
    }
    if constexpr (PH == 3) p_conv(C, R2, OB);
    if constexpr (PH == 4) p_ssd_naive(C, OB, C.f32p(WS_DT), R2, R2 + TD);
    if constexpr (PH == 5) p_na_naive(C, R3, R3 + TD, R3 + 2 * TD);
    if constexpr (PH == 6) p_combine(C, R2, R2 + TD, R1, C.f32p(WS_RSTD));
    if constexpr (PH == 7) { pg8::Gemm g{R0, C.bfp(WS_WG_T), T, 2048, 1024}; pg8::StaticOrder S; S.init(T, 2048, C.G, C.bid);
        pg8::EpiGate e{OB, TD}; pg8::gemm_phase<pg8::EpiGate, pg8::StaticOrder, true, true>(C.lds, g, S, e); }
    if constexpr (PH == 8) { pg8::Gemm g{R1, C.bfp(WS_WSSD_T), T, 1024, 1024}; pg8::StaticOrder S; S.init(T, 1024, C.G, C.bid);
        pg8::EpiD1 e{R2, OB, C.f32p(WS_RSTD)}; pg8::gemm_phase<pg8::EpiD1, pg8::StaticOrder, true, true>(C.lds, g, S, e); }
    if constexpr (PH == 9) { pg8::Gemm g{R3, C.bfp(WS_WNA_T), T, 1024, 1024}; pg8::StaticOrder S; S.init(T, 1024, C.G, C.bid);
        pg8::EpiD2 e{R2 + TD, R2, OB + TD}; pg8::gemm_phase<pg8::EpiD2, pg8::StaticOrder, true, true>(C.lds, g, S, e); }
    if constexpr (PH == 10) { pg8::Gemm g{R2 + TD, C.bfp(WS_WOUT_T), T, 1024, 1024}; pg8::StaticOrder S; S.init(T, 1024, C.G, C.bid);
        pg8::EpiD3 e{(float*)(R3 + TD), C.in[0], C.f32p(WS_MOD)}; pg8::gemm_phase<pg8::EpiD3, pg8::StaticOrder, true, true>(C.lds, g, S, e); }
    if constexpr (PH == 11) { p_rownorm(C, (const float*)(R3 + TD), C.in[18], 3072, 4096, R0); p_cvt_tables(C, R2, R2 + (size_t)16384 * 1024); }
    if constexpr (PH == 12) { pg8::Gemm g{R0, C.bfp(WS_WPQ_T), T, 2048, 1024}; pg8::StaticOrder S; S.init(T, 2048, C.G, C.bid);
        pg8::EpiQp e{OB}; pg8::gemm_phase<pg8::EpiQp, pg8::StaticOrder, true, true>(C.lds, g, S, e); }
    if constexpr (PH == 13) p_topk_naive(C, OB, C.bfp(WS_KEYS), (unsigned short*)R1, (float*)(R1 + 4 * MiB));
    if constexpr (PH == 14) p_gather(C, R0, (const unsigned short*)R1, (const float*)(R1 + 4 * MiB), R2, R2 + (size_t)16384 * 1024, (const float*)(R3 + TD), a.out);
}

template <int PH> struct PhaseLoop {
    static __device__ __forceinline__ void run(const Ctx& C, const Args& a, const XcdBarrier& bar) {
        if (PH >= a.ph_lo && PH < a.ph_hi) { run_phase<PH>(C, a); if (PH + 1 < a.ph_hi) xcd_barrier(bar); }
        PhaseLoop<PH + 1>::run(C, a, bar);
    }
};
template <> struct PhaseLoop<N_PHASES> { static __device__ __forceinline__ void run(const Ctx&, const Args&, const XcdBarrier&) {} };

__global__ void __launch_bounds__(NTHR, 2) mega(Args a) {
    extern __shared__ __attribute__((aligned(16))) unsigned char lds_raw[];
    Ctx C; C.in = a.in; C.out = a.out; C.ws = a.ws; C.tid = threadIdx.x; C.lane = C.tid & 63; C.wave = __builtin_amdgcn_readfirstlane(C.tid >> 6);
    C.G = gridDim.x; C.bid = blockIdx.x; C.lds = (LAS unsigned char*)lds_raw;
    volatile LAS unsigned* MISC = (volatile LAS unsigned*)(C.lds + MISC_OFF);
    if (C.tid < 64) MISC[C.tid] = 0u;
    __syncthreads();
    XcdBarrier bar; bar.bar = (unsigned*)(a.ws + WS_CTL) + CW_BAR; bar.x = 0; bar.st = nullptr;
    if (a.ph_hi - a.ph_lo > 1) bar = xcd_barrier_post((unsigned*)(a.ws + WS_CTL) + CW_BAR, MISC + 8);
    PhaseLoop<0>::run(C, a, bar);
}

extern "C" void kernel_launch(void* const* d_in, const int* in_sizes, int n_in, void* d_out, int out_size, void* d_ws, size_t ws_size, hipStream_t stream) {
    static int grid = 0;
    if (grid == 0) {
        if (n_in != 24 || out_size != T * D || ws_size < WS_END) { fprintf(stderr, "kernel_launch: unexpected shapes n_in %d out %d ws %zu\n", n_in, out_size, ws_size); grid = -1; return; }
        int dev = 0, cus = 0;
        if (hipGetDevice(&dev) != hipSuccess || hipDeviceGetAttribute(&cus, hipDeviceAttributeMultiprocessorCount, dev) != hipSuccess) { grid = -1; return; }
        if (hipFuncSetAttribute((const void*)mega, hipFuncAttributeMaxDynamicSharedMemorySize, LDS_BYTES) != hipSuccess) { grid = -1; return; }
        grid = cus;
    }
    if (grid < 0) return;
    (void)hipMemsetAsync((char*)d_ws + WS_CTL, 0, CTL_ZERO_BYTES, stream);
    Args a{};
    for (int i = 0; i < 24; ++i) a.in[i] = (const float*)d_in[i];
    a.out = (float*)d_out; a.ws = (unsigned char*)d_ws; a.ph_lo = 0; a.ph_hi = N_PHASES;
    hipLaunchKernelGGL(mega, dim3(grid), dim3(NTHR), LDS_BYTES, stream, a);
}
```

```cpp
#include <hip/hip_runtime.h>
#include <cstdio>
#include <cstdint>

#define LAS __attribute__((address_space(3)))
typedef unsigned short bf16_t;
typedef float f32x4 __attribute__((ext_vector_type(4)));
typedef unsigned u32x4 __attribute__((ext_vector_type(4)));
typedef unsigned u32x2 __attribute__((ext_vector_type(2)));
typedef __bf16 bf16x2_t __attribute__((ext_vector_type(2)));

constexpr int T = 32768, D = 1024, NB = 8, SEQ = 4096;
constexpr int NWAVES = 8, NTHR = 512;
constexpr float EPS = 1e-6f;
constexpr int OFF_Z = 0, OFF_XBC = 1024, OFF_DTF = 3072, OFF_DTB = 3088, OFF_QKV = 3104, OFF_GS = 6176, OFF_GN = 7200, D_IN = 8224;

constexpr size_t MiB = 1u << 20;
constexpr size_t WS_CTL = 0;
constexpr size_t WS_MOD = 1 * MiB;
constexpr size_t WS_RSTD = 1 * MiB + 512 * 1024;
constexpr size_t WS_DT = 2 * MiB;
constexpr size_t WS_WIN_T = 6 * MiB;
constexpr size_t WS_WG_T = 18 * MiB;
constexpr size_t WS_WDT_T = 22 * MiB;
constexpr size_t WS_KEYS = 22 * MiB + 512 * 1024;
constexpr size_t WS_WSSD_T = 23 * MiB, WS_WNA_T = 25 * MiB, WS_WOUT_T = 27 * MiB, WS_WPQ_T = 29 * MiB;
constexpr size_t WS_R0 = 40 * MiB, WS_R1 = 104 * MiB, WS_R2 = 168 * MiB, WS_R3 = 296 * MiB, WS_END = 488 * MiB;

constexpr int LDS_BYTES = 147456;

struct Args { const float* in[24]; float* out; unsigned char* ws; int ph_lo, ph_hi; };

__device__ __forceinline__ float bf2f(unsigned v) { return __uint_as_float(v << 16); }
__device__ __forceinline__ float bflo(unsigned v) { return __uint_as_float(v << 16); }
__device__ __forceinline__ float bfhi(unsigned v) { return __uint_as_float(v & 0xffff0000u); }
__device__ __forceinline__ unsigned f2bf(float f) { unsigned u = __float_as_uint(f); return (u + 0x7fffu + ((u >> 16) & 1u)) >> 16; }
typedef float f32x2_t __attribute__((ext_vector_type(2)));
__device__ __forceinline__ unsigned pk2(float lo, float hi) { f32x2_t v = {lo, hi}; bf16x2_t b = __builtin_convertvector(v, bf16x2_t); return __builtin_bit_cast(unsigned, b); }
__device__ __forceinline__ float wave_sum(float v) {
#pragma unroll
    for (int o = 1; o < 64; o <<= 1) v += __shfl_xor(v, o);
    return v;
}
__device__ __forceinline__ float silu_f(float x) { return x / (1.f + __expf(-x)); }
__device__ __forceinline__ float sigmoid_f(float x) { return 1.f / (1.f + __expf(-x)); }
__device__ __forceinline__ float softplus_f(float x) { return x > 20.f ? x : log1pf(__expf(x)); }
__device__ __forceinline__ float gelu_f(float x) { return 0.5f * x * (1.f + erff(x * 0.70710678118654752f)); }

struct Ctx {
    const float* const* in; float* out; unsigned char* ws;
    int tid, lane, wave, G, bid;
    LAS unsigned char* lds;
    __device__ __forceinline__ float* f32p(size_t off) const { return (float*)(ws + off); }
    __device__ __forceinline__ bf16_t* bfp(size_t off) const { return (bf16_t*)(ws + off); }
};

__device__ __forceinline__ void p_prep(const Ctx& C) {
    const int gt = C.bid * NTHR + C.tid, NT = C.G * NTHR;
    const float* c = C.in[1]; const float* w_ada = C.in[2]; const float* b_ada = C.in[3];
    float* mod = C.f32p(WS_MOD);
    for (int i = gt; i < NB * 6144; i += NT) {
        const int b = i / 6144, j = i % 6144; float acc = 0.f;
        for (int k = 0; k < D; ++k) acc += silu_f(c[b * D + k]) * w_ada[(size_t)k * 6144 + j];
        mod[i] = acc + b_ada[j];
    }
    const float* w_in = C.in[5];
    {
        bf16_t* wt = C.bfp(WS_WIN_T);
        for (int i = gt; i < 6144 * (D / 8); i += NT) { const int n = i % 6144, k8 = i / 6144; const int col = n < 3072 ? n : OFF_QKV + (n - 3072);
            u32x4 o; const float* s = w_in + (size_t)(k8 * 8) * D_IN + col;
            o.x = pk2(s[0], s[(size_t)D_IN]); o.y = pk2(s[2 * (size_t)D_IN], s[3 * (size_t)D_IN]); o.z = pk2(s[4 * (size_t)D_IN], s[5 * (size_t)D_IN]); o.w = pk2(s[6 * (size_t)D_IN], s[7 * (size_t)D_IN]);
            *(u32x4*)(wt + (size_t)n * D + k8 * 8) = o; }
    }
    {
        bf16_t* wt = C.bfp(WS_WG_T);
        for (int i = gt; i < 2048 * (D / 8); i += NT) { const int n = i % 2048, k8 = i / 2048; const int col = OFF_GS + n;
            u32x4 o; const float* s = w_in + (size_t)(k8 * 8) * D_IN + col;
            o.x = pk2(s[0], s[(size_t)D_IN]); o.y = pk2(s[2 * (size_t)D_IN], s[3 * (size_t)D_IN]); o.z = pk2(s[4 * (size_t)D_IN], s[5 * (size_t)D_IN]); o.w = pk2(s[6 * (size_t)D_IN], s[7 * (size_t)D_IN]);
            *(u32x4*)(wt + (size_t)n * D + k8 * 8) = o; }
    }
    {
        bf16_t* wt = C.bfp(WS_WDT_T);
        for (int i = gt; i < 32 * (D / 8); i += NT) { const int n = i % 32, k8 = i / 32; const int col = OFF_DTF + n;
            u32x4 o; const float* s = w_in + (size_t)(k8 * 8) * D_IN + col;
            o.x = pk2(s[0], s[(size_t)D_IN]); o.y = pk2(s[2 * (size_t)D_IN], s[3 * (size_t)D_IN]); o.z = pk2(s[4 * (size_t)D_IN], s[5 * (size_t)D_IN]); o.w = pk2(s[6 * (size_t)D_IN], s[7 * (size_t)D_IN]);
            *(u32x4*)(wt + (size_t)n * D + k8 * 8) = o; }
    }
    {
        const float* gk = C.in[13];
        const float* srcs[3] = {C.in[14], C.in[16], C.in[17]};
        const size_t dsts[3] = {WS_WSSD_T, WS_WNA_T, WS_WOUT_T};
#pragma unroll
        for (int w = 0; w < 3; ++w) {
            const float* W = srcs[w]; bf16_t* wt = C.bfp(dsts[w]);
            for (int i = gt; i < D * (D / 8); i += NT) { const int n = i % D, k8 = i / D; const float* s = W + (size_t)(k8 * 8) * D + n;
                float v[8];
#pragma unroll
                for (int q = 0; q < 8; ++q) v[q] = s[(size_t)q * D] * (w == 0 ? gk[k8 * 8 + q] : 1.f);
                u32x4 o; o.x = pk2(v[0], v[1]); o.y = pk2(v[2], v[3]); o.z = pk2(v[4], v[5]); o.w = pk2(v[6], v[7]);
                *(u32x4*)(wt + (size_t)n * D + k8 * 8) = o; }
        }
    }
    {
        const float* W = C.in[19]; bf16_t* wt = C.bfp(WS_WPQ_T);
        for (int i = gt; i < 2048 * (D / 8); i += NT) { const int n = i % 2048, k8 = i / 2048; const float* s = W + (size_t)(k8 * 8) * 2048 + n;
            u32x4 o; o.x = pk2(s[0], s[2048]); o.y = pk2(s[2 * 2048], s[3 * 2048]); o.z = pk2(s[4 * 2048], s[5 * 2048]); o.w = pk2(s[6 * 2048], s[7 * 2048]);
            *(u32x4*)(wt + (size_t)n * D + k8 * 8) = o; }
    }
    {
        const float* kf = C.in[20]; bf16_t* kb = C.bfp(WS_KEYS);
        for (int i = gt; i < 2 * 128 * 128; i += NT) kb[i] = (bf16_t)f2bf(kf[i]);
    }
}

__device__ __forceinline__ void p_rownorm(const Ctx& C, const float* X, const float* gamma, int sh_off, int sc_off, bf16_t* dst) {
    const float* mod = C.f32p(WS_MOD);
    const int gw = C.bid * NWAVES + C.wave, NGW = C.G * NWAVES;
    for (int row = gw; row < T; row += NGW) {
        const int b = row / SEQ;
        const f32x4* xr = (const f32x4*)(X + (size_t)row * D) + C.lane;
        f32x4 v[4]; float s = 0.f;
#pragma unroll
        for (int j = 0; j < 4; ++j) { v[j] = xr[64 * j]; s += (v[j].x * v[j].x + v[j].y * v[j].y) + (v[j].z * v[j].z + v[j].w * v[j].w); }
        const float rstd = rsqrtf(wave_sum(s) * (1.f / D) + EPS);
        u32x2* o8 = (u32x2*)(dst + (size_t)row * D) + C.lane;
#pragma unroll
        for (int j = 0; j < 4; ++j) {
            const int col = 4 * C.lane + 256 * j;
            const f32x4 g = *(const f32x4*)(gamma + col), sh = *(const f32x4*)(mod + b * 6144 + sh_off + col), sc = *(const f32x4*)(mod + b * 6144 + sc_off + col);
            f32x4 y = v[j] * rstd * g * (sc + 1.f) + sh;
            u32x2 w; w.x = pk2(y.x, y.y); w.y = pk2(y.z, y.w); o8[64 * j] = w;
        }
    }
}

template <class Epi>
__device__ __forceinline__ void naive_gemm(const Ctx& C, const bf16_t* A, const bf16_t* Bt, int M, int N, int K, const Epi& E) {
    LAS float* As = (LAS float*)C.lds;
    LAS float* Bs = (LAS float*)(C.lds + 32 * 132 * 4);
    const int tilesN = (N + 63) / 64, tilesM = M / 128, ntiles = tilesM * tilesN;
    const int ty = C.tid >> 4, tx = C.tid & 15;
    for (int tile = C.bid; tile < ntiles; tile += C.G) {
        const int tm = tile / tilesN, tn = tile % tilesN, m0 = tm * 128, n0 = tn * 64;
        float acc[4][4];
#pragma unroll
        for (int i = 0; i < 4; ++i)
#pragma unroll
            for (int j = 0; j < 4; ++j) acc[i][j] = 0.f;
        for (int k0 = 0; k0 < K; k0 += 32) {
            __syncthreads();
            {
                const int r = C.tid >> 2, kc = (C.tid & 3) * 8;
                const u32x4 v = *(const u32x4*)(A + (size_t)(m0 + r) * K + k0 + kc);
                As[(kc + 0) * 132 + r] = bflo(v.x); As[(kc + 1) * 132 + r] = bfhi(v.x); As[(kc + 2) * 132 + r] = bflo(v.y); As[(kc + 3) * 132 + r] = bfhi(v.y);
                As[(kc + 4) * 132 + r] = bflo(v.z); As[(kc + 5) * 132 + r] = bfhi(v.z); As[(kc + 6) * 132 + r] = bflo(v.w); As[(kc + 7) * 132 + r] = bfhi(v.w);
            }
            if (C.tid < 256) {
                const int r = C.tid >> 2, kc = (C.tid & 3) * 8;
                u32x4 v = (u32x4){0u, 0u, 0u, 0u};
                if (n0 + r < N) v = *(const u32x4*)(Bt + (size_t)(n0 + r) * K + k0 + kc);
                Bs[(kc + 0) * 68 + r] = bflo(v.x); Bs[(kc + 1) * 68 + r] = bfhi(v.x); Bs[(kc + 2) * 68 + r] = bflo(v.y); Bs[(kc + 3) * 68 + r] = bfhi(v.y);
                Bs[(kc + 4) * 68 + r] = bflo(v.z); Bs[(kc + 5) * 68 + r] = bfhi(v.z); Bs[(kc + 6) * 68 + r] = bflo(v.w); Bs[(kc + 7) * 68 + r] = bfhi(v.w);
            }
            __syncthreads();
#pragma unroll 8
            for (int k = 0; k < 32; ++k) {
                const f32x4 a = *(const LAS f32x4*)(As + k * 132 + ty * 4);
                const f32x4 b = *(const LAS f32x4*)(Bs + k * 68 + tx * 4);
#pragma unroll
                for (int i = 0; i < 4; ++i)
#pragma unroll
                    for (int j = 0; j < 4; ++j) acc[i][j] += a[i] * b[j];
            }
        }
#pragma unroll
        for (int i = 0; i < 4; ++i)
#pragma unroll
            for (int j = 0; j < 4; ++j) { const int col = n0 + tx * 4 + j; if (col < N) E(m0 + ty * 4 + i, col, acc[i][j]); }
    }
    __syncthreads();
}

struct EInProj { bf16_t *sz, *xbc, *q, *k, *v;
    __device__ __forceinline__ void operator()(int r, int c, float x) const {
        if (c < 1024) sz[(size_t)r * 1024 + c] = (bf16_t)f2bf(silu_f(x));
        else if (c < 3072) xbc[(size_t)r * 2048 + (c - 1024)] = (bf16_t)f2bf(x);
        else if (c < 4096) q[(size_t)r * 1024 + (c - 3072)] = (bf16_t)f2bf(x * 0.125f);
        else if (c < 5120) k[(size_t)r * 1024 + (c - 4096)] = (bf16_t)f2bf(x);
        else v[(size_t)r * 1024 + (c - 5120)] = (bf16_t)f2bf(x);
    } };
struct EDt { float* dt; const float *bf, *bb;
    __device__ __forceinline__ void operator()(int r, int c, float x) const { const float bias = c < 16 ? bf[c] : bb[c - 16]; dt[(size_t)r * 32 + c] = softplus_f(x + bias); } };
struct EGate { bf16_t* sg;
    __device__ __forceinline__ void operator()(int r, int c, float x) const { sg[(size_t)(c >> 10) * T * 1024 + (size_t)r * 1024 + (c & 1023)] = (bf16_t)f2bf(sigmoid_f(x)); } };
struct ED1 { bf16_t* p1; const bf16_t* sg1; const float* rstd;
    __device__ __forceinline__ void operator()(int r, int c, float x) const { const size_t i = (size_t)r * 1024 + c; p1[i] = (bf16_t)f2bf(x * rstd[r] * bf2f(sg1[i])); } };
struct ED2 { bf16_t* mixed; const bf16_t *p1, *sg2;
    __device__ __forceinline__ void operator()(int r, int c, float x) const { const size_t i = (size_t)r * 1024 + c; mixed[i] = (bf16_t)f2bf(bf2f(p1[i]) + bf2f(sg2[i]) * x); } };
struct ED3 { float* h; const float* x; const float* mod;
    __device__ __forceinline__ void operator()(int r, int c, float v) const { const size_t i = (size_t)r * 1024 + c; h[i] = x[i] + mod[(r / SEQ) * 6144 + 2048 + c] * v; } };
struct EQp { bf16_t* qp;
    __device__ __forceinline__ void operator()(int r, int c, float v) const { qp[(size_t)r * 2048 + c] = (bf16_t)f2bf(v); } };

__device__ __forceinline__ void p_conv(const Ctx& C, const bf16_t* xbc, bf16_t* xc) {
    const float* cw = C.in[6]; const float* cb = C.in[7];
    const int gt = C.bid * NTHR + C.tid, NT = C.G * NTHR;
    for (int i = gt; i < T * 256; i += NT) {
        const int t = i >> 8, cg = i & 255, l = t & (SEQ - 1), ch = cg * 8;
        float acc[8];
#pragma unroll
        for (int q = 0; q < 8; ++q) acc[q] = cb[ch + q];
#pragma unroll
        for (int j = 0; j < 5; ++j) {
            const int ll = l + j - 2;
            if (ll >= 0 && ll < SEQ) {
                const u32x4 v = *(const u32x4*)(xbc + (size_t)(t + j - 2) * 2048 + ch);
                const f32x4 w0 = *(const f32x4*)(cw + j * 2048 + ch), w1 = *(const f32x4*)(cw + j * 2048 + ch + 4);
                acc[0] += w0.x * bflo(v.x); acc[1] += w0.y * bfhi(v.x); acc[2] += w0.z * bflo(v.y); acc[3] += w0.w * bfhi(v.y);
                acc[4] += w1.x * bflo(v.z); acc[5] += w1.y * bfhi(v.z); acc[6] += w1.z * bflo(v.w); acc[7] += w1.w * bfhi(v.w);
            }
        }
        u32x4 o; o.x = pk2(silu_f(acc[0]), silu_f(acc[1])); o.y = pk2(silu_f(acc[2]), silu_f(acc[3])); o.z = pk2(silu_f(acc[4]), silu_f(acc[5])); o.w = pk2(silu_f(acc[6]), silu_f(acc[7]));
        *(u32x4*)(xc + (size_t)t * 2048 + ch) = o;
    }
}

__device__ __forceinline__ void p_ssd_naive(const Ctx& C, const bf16_t* xc, const float* dtb, bf16_t* yf, bf16_t* yb) {
    if (C.wave == 0)
    for (int unit = C.bid; unit < 256; unit += C.G) {
        const int dir = unit & 1, hd = (unit >> 1) & 15, b = unit >> 5, g = hd >> 2, p = C.lane;
        const float a = -__expf((dir ? C.in[11] : C.in[10])[hd]);
        const float dsk = C.in[12][hd];
        float h[128];
#pragma unroll
        for (int n = 0; n < 128; ++n) h[n] = 0.f;
        for (int s = 0; s < SEQ; ++s) {
#ifdef DIAG_LOCAL
            if ((s & 127) == 0) {
#pragma unroll
                for (int n = 0; n < 128; ++n) h[n] = 0.f; }
#endif
            const int t = dir ? (SEQ - 1 - s) : s; const size_t row = (size_t)b * SEQ + t;
            const float dt = dtb[row * 32 + dir * 16 + hd];
            const float dA = __expf(dt * a);
            const float x = bf2f(xc[row * 2048 + hd * 64 + p]);
            const float xdt = x * dt;
            const u32x4* Bp = (const u32x4*)(xc + row * 2048 + 1024 + g * 128);
            const u32x4* Cp = (const u32x4*)(xc + row * 2048 + 1536 + g * 128);
            float y = 0.f;
#pragma unroll
            for (int n8 = 0; n8 < 16; ++n8) {
                const u32x4 bv = Bp[n8], cv = Cp[n8];
                const float bb[8] = {bflo(bv.x), bfhi(bv.x), bflo(bv.y), bfhi(bv.y), bflo(bv.z), bfhi(bv.z), bflo(bv.w), bfhi(bv.w)};
                const float cc[8] = {bflo(cv.x), bfhi(cv.x), bflo(cv.y), bfhi(cv.y), bflo(cv.z), bfhi(cv.z), bflo(cv.w), bfhi(cv.w)};
#pragma unroll
                for (int q = 0; q < 8; ++q) { const int n = n8 * 8 + q; h[n] = dA * h[n] + xdt * bb[q]; y += cc[q] * h[n]; }
            }
            if (dir == 0) yf[row * 1024 + hd * 64 + p] = (bf16_t)f2bf(y + dsk * x);
            else yb[row * 1024 + hd * 64 + p] = (bf16_t)f2bf(y);
        }
    }
}


namespace ssd {
typedef short bf16x8 __attribute__((ext_vector_type(8)));
typedef short s16x4 __attribute__((ext_vector_type(4)));
constexpr int RS = 272, RSX = 144;
constexpr int CN = 0, BN = 34816, BS = 69632, SL = 104448, XN = 121856, CSB = 140288;
__device__ __forceinline__ bf16x8 trfrag(LAS unsigned char* base, int stride, int ks, int c, int g, int q, int pp) {
    LAS unsigned char* a0 = base + (32 * ks + 8 * g + q) * stride + 32 * c + 8 * pp;
    const s16x4 v0 = __builtin_amdgcn_ds_read_tr16_b64_v4i16((LAS s16x4*)a0);
    const s16x4 v1 = __builtin_amdgcn_ds_read_tr16_b64_v4i16((LAS s16x4*)(a0 + 4 * stride));
    bf16x8 r; r[0] = v0[0]; r[1] = v0[1]; r[2] = v0[2]; r[3] = v0[3]; r[4] = v1[0]; r[5] = v1[1]; r[6] = v1[2]; r[7] = v1[3]; return r;
}
__device__ __forceinline__ unsigned pkbf(float lo, float hi) { return pk2(lo, hi); }
}
__device__ __forceinline__ void p_ssd(const Ctx& C, const bf16_t* xc, const float* dtb, bf16_t* yf, bf16_t* yb) {
    using namespace ssd;
    LAS unsigned char* L = C.lds;
    const int tid = C.tid, lane = C.lane, w = C.wave, g = lane >> 4, i16 = lane & 15, q = (lane >> 2) & 3, pp = lane & 3;
    for (int unit = C.bid; unit < 256; unit += C.G) {
        const int dir = unit & 1, hd = (unit >> 1) & 15, b = unit >> 5, grp = hd >> 2;
        const float a = -__expf((dir ? C.in[11] : C.in[10])[hd]);
        const float dsk = dir ? 0.f : C.in[12][hd];
        bf16_t* yout = dir ? yb : yf;
        f32x4 sacc[4];
#pragma unroll
        for (int pt = 0; pt < 4; ++pt) sacc[pt] = (f32x4){0.f, 0.f, 0.f, 0.f};
        __syncthreads();
        for (int i = tid; i < 17408 / 4; i += NTHR) ((LAS unsigned*)(L + SL))[i] = 0u;
        u32x4 pfC[4], pfB[4], pfX[2]; float pfd0 = 0.f, pfd1 = 0.f;
#define SSD_ISSUE(ci_) do { const int c_ = dir ? (31 - (ci_)) : (ci_); const size_t t0_ = (size_t)b * SEQ + (size_t)c_ * 128; \
            _Pragma("unroll") for (int i_ = 0; i_ < 4; ++i_) { const int idx_ = tid + NTHR * i_, l_ = idx_ >> 4, cc_ = idx_ & 15; const bf16_t* rp_ = xc + (t0_ + l_) * 2048 + grp * 128 + cc_ * 8; \
                pfB[i_] = *(const u32x4*)(rp_ + 1024); pfC[i_] = *(const u32x4*)(rp_ + 1536); } \
            _Pragma("unroll") for (int i_ = 0; i_ < 2; ++i_) { const int idx_ = tid + NTHR * i_, l_ = idx_ >> 3, cc_ = idx_ & 7; pfX[i_] = *(const u32x4*)(xc + (t0_ + l_) * 2048 + hd * 64 + cc_ * 8); } \
            if (w == 0) { const int l0_ = dir ? (127 - 2 * lane) : (2 * lane), l1_ = dir ? (126 - 2 * lane) : (2 * lane + 1); \
                pfd0 = dtb[(t0_ + l0_) * 32 + dir * 16 + hd]; pfd1 = dtb[(t0_ + l1_) * 32 + dir * 16 + hd]; } } while (0)
#define SSD_SCAN(buf_) do { if (w == 0) { const float da0_ = pfd0 * a, da1_ = pfd1 * a; const float p1_ = da0_ + da1_; float s_ = p1_; \
            _Pragma("unroll") for (int o_ = 1; o_ < 64; o_ <<= 1) { const float t_ = __shfl_up(s_, o_); if (lane >= o_) s_ += t_; } \
            const float ex_ = s_ - p1_, cs0_ = ex_ + da0_, cs1_ = ex_ + p1_, tot_ = __shfl(s_, 63); \
            const int l0_ = dir ? (127 - 2 * lane) : (2 * lane), l1_ = dir ? (126 - 2 * lane) : (2 * lane + 1); \
            LAS float* cb_ = (LAS float*)(L + CSB + (buf_) * 1536); \
            cb_[l0_] = cs0_; cb_[l1_] = cs1_; cb_[128 + l0_] = pfd0; cb_[128 + l1_] = pfd1; cb_[256 + l0_] = pfd0 * __expf(tot_ - cs0_); cb_[256 + l1_] = pfd1 * __expf(tot_ - cs1_); \
            if (lane == 0) *(LAS float*)(L + CSB + 3072 + 8 * (buf_)) = tot_; } } while (0)
#define SSD_WRITE(buf_) do { const LAS float* dw_ = (const LAS float*)(L + CSB + (buf_) * 1536 + 1024); \
            _Pragma("unroll") for (int i_ = 0; i_ < 4; ++i_) { const int idx_ = tid + NTHR * i_, l_ = idx_ >> 4, cc_ = idx_ & 15; \
                *(LAS u32x4*)(L + CN + l_ * RS + cc_ * 16) = pfC[i_]; *(LAS u32x4*)(L + BN + l_ * RS + cc_ * 16) = pfB[i_]; \
                const float sc_ = dw_[l_]; const u32x4 v_ = pfB[i_]; u32x4 o_; \
                o_.x = pkbf(bflo(v_.x) * sc_, bfhi(v_.x) * sc_); o_.y = pkbf(bflo(v_.y) * sc_, bfhi(v_.y) * sc_); o_.z = pkbf(bflo(v_.z) * sc_, bfhi(v_.z) * sc_); o_.w = pkbf(bflo(v_.w) * sc_, bfhi(v_.w) * sc_); \
                *(LAS u32x4*)(L + BS + l_ * RS + cc_ * 16) = o_; } \
            _Pragma("unroll") for (int i_ = 0; i_ < 2; ++i_) { const int idx_ = tid + NTHR * i_, l_ = idx_ >> 3, cc_ = idx_ & 7; *(LAS u32x4*)(L + XN + l_ * RSX + cc_ * 16) = pfX[i_]; } } while (0)
        SSD_ISSUE(0);
        SSD_SCAN(0);
        __syncthreads();
        SSD_WRITE(0);
        __syncthreads();
        for (int ci = 0; ci < 32; ++ci) {
            const int buf = ci & 1;
            const int c = dir ? (31 - ci) : ci; const size_t t0 = (size_t)b * SEQ + (size_t)c * 128;
            if (ci + 1 < 32) SSD_ISSUE(ci + 1);
            const LAS float* csb = (const LAS float*)(L + CSB + buf * 1536);
            const float cs_l = csb[16 * w + i16];
            const float cs_end = *(const LAS float*)(L + CSB + 3072 + 8 * buf);
            bf16x8 cfrag[4];
#pragma unroll
            for (int ks = 0; ks < 4; ++ks) cfrag[ks] = *(const LAS bf16x8*)(L + CN + (16 * w + i16) * RS + ks * 64 + g * 16);
            u32x2 mreg[8];
            const int lrow = 16 * w + i16;
#pragma unroll
            for (int st = 0; st < 8; ++st) {
                f32x4 acc = (f32x4){0.f, 0.f, 0.f, 0.f};
#pragma unroll
                for (int ks = 0; ks < 4; ++ks) { const bf16x8 af = *(const LAS bf16x8*)(L + BN + (16 * st + i16) * RS + ks * 64 + g * 16);
                    acc = __builtin_amdgcn_mfma_f32_16x16x32_bf16(af, cfrag[ks], acc, 0, 0, 0); }
                const f32x4 cs_s = *(const LAS f32x4*)(csb + 16 * st + 4 * g), dt_s = *(const LAS f32x4*)(csb + 128 + 16 * st + 4 * g);
                float mv[4];
#pragma unroll
                for (int r = 0; r < 4; ++r) { const int srow = 16 * st + 4 * g + r; const bool valid = dir ? (srow >= lrow) : (srow <= lrow);
                    const float e = valid ? __expf(cs_l - cs_s[r]) : 0.f; mv[r] = acc[r] * dt_s[r] * e; }
                mreg[st].x = pkbf(mv[0], mv[1]); mreg[st].y = pkbf(mv[2], mv[3]);
            }
            f32x4 yacc[4];
            const float el = __expf(cs_l);
#pragma unroll
            for (int pt = 0; pt < 4; ++pt) { f32x4 acc = (f32x4){0.f, 0.f, 0.f, 0.f};
#pragma unroll
                for (int ks = 0; ks < 4; ++ks) { const bf16x8 af = *(const LAS bf16x8*)(L + SL + (16 * pt + i16) * RS + ks * 64 + g * 16);
                    acc = __builtin_amdgcn_mfma_f32_16x16x32_bf16(af, cfrag[ks], acc, 0, 0, 0); }
                yacc[pt] = acc * el; }
            __syncthreads();
#pragma unroll
            for (int st = 0; st < 8; ++st) *(LAS u32x2*)(L + BN + lrow * RS + 32 * st + 8 * g) = mreg[st];
            __syncthreads();
#pragma unroll
            for (int ks = 0; ks < 4; ++ks) { const bf16x8 mf = *(const LAS bf16x8*)(L + BN + lrow * RS + ks * 64 + g * 16);
#pragma unroll
                for (int pt = 0; pt < 4; ++pt) { const bf16x8 xf = trfrag(L + XN, RSX, ks, pt, g, q, pp); yacc[pt] = __builtin_amdgcn_mfma_f32_16x16x32_bf16(xf, mf, yacc[pt], 0, 0, 0); } }
#pragma unroll
            for (int pt = 0; pt < 4; ++pt) { const u32x2 xv = *(const LAS u32x2*)(L + XN + lrow * RSX + (16 * pt + 4 * g) * 2);
                u32x2 o; o.x = pkbf(yacc[pt][0] + dsk * bflo(xv.x), yacc[pt][1] + dsk * bfhi(xv.x)); o.y = pkbf(yacc[pt][2] + dsk * bflo(xv.y), yacc[pt][3] + dsk * bfhi(xv.y));
                *(u32x2*)(yout + (t0 + lrow) * 1024 + hd * 64 + 16 * pt + 4 * g) = o; }
            { const float dec = __expf(cs_end);
#pragma unroll
              for (int pt = 0; pt < 4; ++pt) sacc[pt] = sacc[pt] * dec; }
#pragma unroll
            for (int ks = 0; ks < 4; ++ks) { const bf16x8 bf = trfrag(L + BS, RS, ks, w, g, q, pp);
#pragma unroll
                for (int pt = 0; pt < 4; ++pt) { const bf16x8 xf = trfrag(L + XN, RSX, ks, pt, g, q, pp); sacc[pt] = __builtin_amdgcn_mfma_f32_16x16x32_bf16(bf, xf, sacc[pt], 0, 0, 0); } }
#ifdef DIAG_LOCAL
#pragma unroll
            for (int pt = 0; pt < 4; ++pt) sacc[pt] = (f32x4){0.f, 0.f, 0.f, 0.f};
#endif
#pragma unroll
            for (int pt = 0; pt < 4; ++pt) { u32x2 o; o.x = pkbf(sacc[pt][0], sacc[pt][1]); o.y = pkbf(sacc[pt][2], sacc[pt][3]);
                *(LAS u32x2*)(L + SL + (16 * pt + i16) * RS + (16 * w + 4 * g) * 2) = o; }
            if (ci + 1 < 32) SSD_SCAN(buf ^ 1);
            __syncthreads();
            if (ci + 1 < 32) SSD_WRITE(buf ^ 1);
            __syncthreads();
        }
#undef SSD_ISSUE
#undef SSD_SCAN
#undef SSD_WRITE
    }
}

__device__ __forceinline__ void p_na_naive(const Ctx& C, bf16_t* q, const bf16_t* k, const bf16_t* v) {
    const float* rpb = C.in[15];
    const int gt = C.bid * NTHR + C.tid, NT = C.G * NTHR;
    for (int i = gt; i < T * 16; i += NT) {
        const int hh = i & 15, tok = i >> 4, b = tok >> 12, l = tok & 4095, r = l >> 6, col = l & 63;
        int rs = r - 4; rs = rs < 0 ? 0 : (rs > 56 ? 56 : rs);
        int wsx = col - 8; wsx = wsx < 0 ? 0 : (wsx > 48 ? 48 : wsx);
        float qv[64], o[64];
        {
            const u32x4* qp = (const u32x4*)(q + (size_t)tok * 1024 + hh * 64);
#pragma unroll
            for (int d8 = 0; d8 < 8; ++d8) { const u32x4 w = qp[d8]; qv[d8 * 8 + 0] = bflo(w.x); qv[d8 * 8 + 1] = bfhi(w.x); qv[d8 * 8 + 2] = bflo(w.y); qv[d8 * 8 + 3] = bfhi(w.y);
                qv[d8 * 8 + 4] = bflo(w.z); qv[d8 * 8 + 5] = bfhi(w.z); qv[d8 * 8 + 6] = bflo(w.w); qv[d8 * 8 + 7] = bfhi(w.w); }
        }
#pragma unroll
        for (int d = 0; d < 64; ++d) o[d] = 0.f;
        float m = -1e30f, lsum = 0.f;
        for (int ii = 0; ii < 8; ++ii)
            for (int jj = 0; jj < 16; ++jj) {
                const int kr = rs + ii, kc = wsx + jj; const size_t kt = (size_t)b * SEQ + kr * 64 + kc;
                const u32x4* kp = (const u32x4*)(k + kt * 1024 + hh * 64);
                float s = 0.f;
#pragma unroll
                for (int d8 = 0; d8 < 8; ++d8) { const u32x4 w = kp[d8];
                    s += qv[d8 * 8 + 0] * bflo(w.x) + qv[d8 * 8 + 1] * bfhi(w.x) + qv[d8 * 8 + 2] * bflo(w.y) + qv[d8 * 8 + 3] * bfhi(w.y)
                       + qv[d8 * 8 + 4] * bflo(w.z) + qv[d8 * 8 + 5] * bfhi(w.z) + qv[d8 * 8 + 6] * bflo(w.w) + qv[d8 * 8 + 7] * bfhi(w.w); }
                s += rpb[hh * 15 * 31 + (kr - r + 7) * 31 + (kc - col + 15)];
                const float mn = fmaxf(m, s), al = __expf(m - mn), pe = __expf(s - mn);
                lsum = lsum * al + pe; m = mn;
                const u32x4* vp = (const u32x4*)(v + kt * 1024 + hh * 64);
#pragma unroll
                for (int d8 = 0; d8 < 8; ++d8) { const u32x4 w = vp[d8];
                    o[d8 * 8 + 0] = o[d8 * 8 + 0] * al + pe * bflo(w.x); o[d8 * 8 + 1] = o[d8 * 8 + 1] * al + pe * bfhi(w.x);
                    o[d8 * 8 + 2] = o[d8 * 8 + 2] * al + pe * bflo(w.y); o[d8 * 8 + 3] = o[d8 * 8 + 3] * al + pe * bfhi(w.y);
                    o[d8 * 8 + 4] = o[d8 * 8 + 4] * al + pe * bflo(w.z); o[d8 * 8 + 5] = o[d8 * 8 + 5] * al + pe * bfhi(w.z);
                    o[d8 * 8 + 6] = o[d8 * 8 + 6] * al + pe * bflo(w.w); o[d8 * 8 + 7] = o[d8 * 8 + 7] * al + pe * bfhi(w.w); }
            }
        const float inv = 1.f / lsum;
        u32x4* op = (u32x4*)(q + (size_t)tok * 1024 + hh * 64);
#pragma unroll
        for (int d8 = 0; d8 < 8; ++d8) { u32x4 w; w.x = pk2(o[d8 * 8 + 0] * inv, o[d8 * 8 + 1] * inv); w.y = pk2(o[d8 * 8 + 2] * inv, o[d8 * 8 + 3] * inv);
            w.z = pk2(o[d8 * 8 + 4] * inv, o[d8 * 8 + 5] * inv); w.w = pk2(o[d8 * 8 + 6] * inv, o[d8 * 8 + 7] * inv); op[d8] = w; }
    }
}

__device__ __forceinline__ void p_combine(const Ctx& C, const bf16_t* yf, const bf16_t* yb, bf16_t* szu, float* rstd) {
    const int gw = C.bid * NWAVES + C.wave, NGW = C.G * NWAVES;
    for (int row = gw; row < T; row += NGW) {
        const size_t base = (size_t)row * 1024;
        float s = 0.f; u32x4 outv[2];
#pragma unroll
        for (int j = 0; j < 2; ++j) {
            const size_t off = base + j * 512 + C.lane * 8;
            const u32x4 a = *(const u32x4*)(yf + off), b = *(const u32x4*)(yb + off), z = *(const u32x4*)(szu + off);
            float u[8];
            u[0] = (bflo(a.x) + bflo(b.x)) * bflo(z.x); u[1] = (bfhi(a.x) + bfhi(b.x)) * bfhi(z.x);
            u[2] = (bflo(a.y) + bflo(b.y)) * bflo(z.y); u[3] = (bfhi(a.y) + bfhi(b.y)) * bfhi(z.y);
            u[4] = (bflo(a.z) + bflo(b.z)) * bflo(z.z); u[5] = (bfhi(a.z) + bfhi(b.z)) * bfhi(z.z);
            u[6] = (bflo(a.w) + bflo(b.w)) * bflo(z.w); u[7] = (bfhi(a.w) + bfhi(b.w)) * bfhi(z.w);
#pragma unroll
            for (int q = 0; q < 8; ++q) s += u[q] * u[q];
            outv[j].x = pk2(u[0], u[1]); outv[j].y = pk2(u[2], u[3]); outv[j].z = pk2(u[4], u[5]); outv[j].w = pk2(u[6], u[7]);
        }
        s = wave_sum(s);
#pragma unroll
        for (int j = 0; j < 2; ++j) *(u32x4*)(szu + base + j * 512 + C.lane * 8) = outv[j];
        if (C.lane == 0) rstd[row] = rsqrtf(s * (1.f / 1024.f) + EPS);
    }
}

__device__ __forceinline__ void p_cvt_tables(const Ctx& C, bf16_t* ub, bf16_t* vb) {
    const int gt = C.bid * NTHR + C.tid, NT = C.G * NTHR;
    const float* u = C.in[21]; const float* v = C.in[22];
    for (int i = gt; i < 16384 * 1024 / 8; i += NT) {
        const f32x4 a0 = *(const f32x4*)(u + (size_t)i * 8), a1 = *(const f32x4*)(u + (size_t)i * 8 + 4);
        u32x4 o; o.x = pk2(a0.x, a0.y); o.y = pk2(a0.z, a0.w); o.z = pk2(a1.x, a1.y); o.w = pk2(a1.z, a1.w);
        *(u32x4*)(ub + (size_t)i * 8) = o;
        const f32x4 b0 = *(const f32x4*)(v + (size_t)i * 8), b1 = *(const f32x4*)(v + (size_t)i * 8 + 4);
        u32x4 p; p.x = pk2(b0.x, b0.y); p.y = pk2(b0.z, b0.w); p.z = pk2(b1.x, b1.y); p.w = pk2(b1.z, b1.w);
        *(u32x4*)(vb + (size_t)i * 8) = p;
    }
}

__device__ __forceinline__ void p_topk_naive(const Ctx& C, const bf16_t* qp, const bf16_t* keys, unsigned short* pidx, float* pgate) {
    constexpr int NTK = 64;
    LAS float* S = (LAS float*)C.lds;
    LAS float* TV = (LAS float*)(C.lds + 256 * NTK * 4);
    LAS int* TI = (LAS int*)(C.lds + 256 * NTK * 4 + 32 * NTK * 4);
    const int tl = C.tid;
    if (C.tid < 64)
    for (int item = C.bid * NTK + tl; item < T * 8; item += C.G * NTK) {
        const int t = item >> 3, hh = item & 7;
        for (int z = 0; z < 2; ++z) {
            unsigned qv[64];
            const u32x4* qptr = (const u32x4*)(qp + (size_t)t * 2048 + hh * 256 + z * 128);
#pragma unroll
            for (int d8 = 0; d8 < 16; ++d8) { const u32x4 w = qptr[d8]; qv[d8 * 4 + 0] = w.x; qv[d8 * 4 + 1] = w.y; qv[d8 * 4 + 2] = w.z; qv[d8 * 4 + 3] = w.w; }
            for (int n = 0; n < 128; ++n) {
                const u32x4* kp = (const u32x4*)(keys + (size_t)(z * 128 + n) * 128);
                float acc = 0.f;
#pragma unroll
                for (int d8 = 0; d8 < 16; ++d8) { const u32x4 w = kp[d8];
                    acc += bflo(qv[d8 * 4 + 0]) * bflo(w.x) + bfhi(qv[d8 * 4 + 0]) * bfhi(w.x) + bflo(qv[d8 * 4 + 1]) * bflo(w.y) + bfhi(qv[d8 * 4 + 1]) * bfhi(w.y)
                         + bflo(qv[d8 * 4 + 2]) * bflo(w.z) + bfhi(qv[d8 * 4 + 2]) * bfhi(w.z) + bflo(qv[d8 * 4 + 3]) * bflo(w.w) + bfhi(qv[d8 * 4 + 3]) * bfhi(w.w); }
                S[(z * 128 + n) * NTK + tl] = acc;
            }
            float pv = 3.0e38f; int pi = -1;
            for (int r = 0; r < 16; ++r) {
                float best = -3.0e38f; int bi = 0;
                for (int n = 0; n < 128; ++n) { const float x = S[(z * 128 + n) * NTK + tl];
                    const bool elig = (x < pv) || (x == pv && n > pi);
                    if (elig && x > best) { best = x; bi = n; } }
                TV[(z * 16 + r) * NTK + tl] = best; TI[(z * 16 + r) * NTK + tl] = bi; pv = best; pi = bi;
            }
        }
        float pv = 3.0e38f; int pi = -1; float top[16]; int ei[16];
#pragma unroll
        for (int r = 0; r < 16; ++r) {
            float best = -3.0e38f; int bi = 0;
            for (int c = 0; c < 256; ++c) { const float x = TV[(c >> 4) * NTK + tl] + TV[(16 + (c & 15)) * NTK + tl];
                const bool elig = (x < pv) || (x == pv && c > pi);
                if (elig && x > best) { best = x; bi = c; } }
            top[r] = best; ei[r] = TI[(bi >> 4) * NTK + tl] * 128 + TI[(16 + (bi & 15)) * NTK + tl]; pv = best; pi = bi;
        }
        float den = 0.f, e[16];
#pragma unroll
        for (int r = 0; r < 16; ++r) { e[r] = __expf(top[r] - top[0]); den += e[r]; }
        const float inv = 1.f / den;
#pragma unroll
        for (int r = 0; r < 16; ++r) { pidx[(size_t)t * 128 + hh * 16 + r] = (unsigned short)ei[r]; pgate[(size_t)t * 128 + hh * 16 + r] = e[r] * inv; }
    }
}


namespace tk {
typedef short bf16x8 __attribute__((ext_vector_type(8)));
constexpr int RSK = 272, TAB = 69632, TABW = 33 * 16 * 4, IJT = TAB + 8 * TABW;
__device__ __forceinline__ void ce(float& a, float& b) { const float hi = __builtin_fmaxf(a, b), lo = __builtin_fminf(a, b); a = hi; b = lo; }
__device__ __forceinline__ void sort16(float (&v)[16]) {
#pragma unroll
    for (int k = 2; k <= 16; k <<= 1)
#pragma unroll
        for (int j = k >> 1; j > 0; j >>= 1)
#pragma unroll
            for (int i = 0; i < 16; ++i) { const int l = i ^ j; if (l > i) { if ((i & k) == 0) ce(v[i], v[l]); else ce(v[l], v[i]); } }
}
__device__ __forceinline__ void merge16(float (&a)[16], const float (&b)[16]) {
#pragma unroll
    for (int i = 0; i < 16; ++i) a[i] = __builtin_fmaxf(a[i], b[15 - i]);
#pragma unroll
    for (int j = 8; j > 0; j >>= 1)
#pragma unroll
        for (int i = 0; i < 16; ++i) { const int l = i ^ j; if (l > i) ce(a[i], a[l]); }
}
__device__ __forceinline__ void xmerge(float (&a)[16], int mask) { float b[16];
#pragma unroll
    for (int i = 0; i < 16; ++i) b[i] = __shfl_xor(a[i], mask);
    merge16(a, b); }
}
__device__ __forceinline__ void p_topk(const Ctx& C, const bf16_t* qp, const bf16_t* keys, unsigned short* pidx, float* pgate) {
    using namespace tk;
    LAS unsigned char* L = C.lds;
    const int tid = C.tid, lane = C.lane, w = C.wave, g = lane >> 4, i16 = lane & 15;
    __syncthreads();
    for (int i = tid; i < 4096; i += NTHR) { const int r = i >> 4, cc = i & 15; *(LAS u32x4*)(L + r * RSK + cc * 16) = *(const u32x4*)(keys + (size_t)r * 128 + cc * 8); }
    if (tid < 64) { int cnt = 0, fi = 0, fj = 0;
        for (int i = 0; i < 16; ++i) for (int j = 0; j < 16; ++j) if ((i + 1) * (j + 1) <= 16) { if (cnt == tid) { fi = i; fj = j; } ++cnt; }
        ((LAS unsigned*)(L + IJT))[tid] = (unsigned)(fi | (fj << 4)); }
    __syncthreads();
    LAS unsigned* tab = (LAS unsigned*)(L + TAB + w * TABW) + i16 * 33;
    const LAS unsigned* ijt = (const LAS unsigned*)(L + IJT);
    const float NEGV = -1.0e30f;
    const int gw = C.bid * NWAVES + w, NGW = C.G * NWAVES;
    for (int unit = gw; unit < (T / 16) * 8; unit += NGW) {
        const int tg = unit >> 3, hh = unit & 7; const size_t t0 = (size_t)tg * 16;
        float s1[16], s2[16];
#pragma unroll
        for (int z = 0; z < 2; ++z) {
            bf16x8 qf[4];
#pragma unroll
            for (int ks = 0; ks < 4; ++ks) qf[ks] = *(const bf16x8*)(qp + (t0 + i16) * 2048 + hh * 256 + z * 128 + ks * 32 + g * 8);
            float lo[16], hi[16];
#pragma unroll
            for (int nt = 0; nt < 8; ++nt) { f32x4 acc = (f32x4){0.f, 0.f, 0.f, 0.f};
#pragma unroll
                for (int ks = 0; ks < 4; ++ks) { const bf16x8 kf = *(const LAS bf16x8*)(L + (z * 128 + 16 * nt + i16) * RSK + ks * 64 + g * 16);
                    acc = __builtin_amdgcn_mfma_f32_16x16x32_bf16(kf, qf[ks], acc, 0, 0, 0); }
#pragma unroll
                for (int r = 0; r < 4; ++r) { const float pv = __uint_as_float((__float_as_uint(acc[r]) & 0xFFFFFF80u) | (unsigned)(16 * nt + 4 * g + r));
                    if (nt < 4) lo[nt * 4 + r] = pv; else hi[(nt - 4) * 4 + r] = pv; } }
            sort16(lo); sort16(hi); merge16(lo, hi);
            xmerge(lo, 16); xmerge(lo, 32);
#pragma unroll
            for (int i = 0; i < 16; ++i) { if (z == 0) s1[i] = lo[i]; else s2[i] = lo[i]; }
        }
#pragma unroll
        for (int i = 0; i < 16; ++i) { tab[i] = __float_as_uint(s1[i]); tab[16 + i] = __float_as_uint(s2[i]); }
        float cand[16];
            { const float a_ = (g == 0 ? s1[0] : g == 1 ? s1[1] : g == 2 ? s1[3] : s1[14]), b_ = (g == 0 ? s2[0] : g == 1 ? s2[0] : g == 2 ? s2[3] : s2[0]); cand[0] = __uint_as_float((__float_as_uint(a_ + b_) & 0xFFFFFFC0u) | (unsigned)(16 * g + 0)); }
            { const float a_ = (g == 0 ? s1[0] : g == 1 ? s1[1] : g == 2 ? s1[4] : s1[15]), b_ = (g == 0 ? s2[1] : g == 1 ? s2[1] : g == 2 ? s2[0] : s2[0]); cand[1] = __uint_as_float((__float_as_uint(a_ + b_) & 0xFFFFFFC0u) | (unsigned)(16 * g + 1)); }
            { const float a_ = (g == 0 ? s1[0] : g == 1 ? s1[1] : g == 2 ? s1[4] : NEGV), b_ = (g == 0 ? s2[2] : g == 1 ? s2[2] : g == 2 ? s2[1] : NEGV); cand[2] = __uint_as_float((__float_as_uint(a_ + b_) & 0xFFFFFFC0u) | (unsigned)(16 * g + 2)); }
            { const float a_ = (g == 0 ? s1[0] : g == 1 ? s1[1] : g == 2 ? s1[4] : NEGV), b_ = (g == 0 ? s2[3] : g == 1 ? s2[3] : g == 2 ? s2[2] : NEGV); cand[3] = __uint_as_float((__float_as_uint(a_ + b_) & 0xFFFFFFC0u) | (unsigned)(16 * g + 3)); }
            { const float a_ = (g == 0 ? s1[0] : g == 1 ? s1[1] : g == 2 ? s1[5] : NEGV), b_ = (g == 0 ? s2[4] : g == 1 ? s2[4] : g == 2 ? s2[0] : NEGV); cand[4] = __uint_as_float((__float_as_uint(a_ + b_) & 0xFFFFFFC0u) | (unsigned)(16 * g + 4)); }
            { const float a_ = (g == 0 ? s1[0] : g == 1 ? s1[1] : g == 2 ? s1[5] : NEGV), b_ = (g == 0 ? s2[5] : g == 1 ? s2[5] : g == 2 ? s2[1] : NEGV); cand[5] = __uint_as_float((__float_as_uint(a_ + b_) & 0xFFFFFFC0u) | (unsigned)(16 * g + 5)); }
            { const float a_ = (g == 0 ? s1[0] : g == 1 ? s1[1] : g == 2 ? s1[6] : NEGV), b_ = (g == 0 ? s2[6] : g == 1 ? s2[6] : g == 2 ? s2[0] : NEGV); cand[6] = __uint_as_float((__float_as_uint(a_ + b_) & 0xFFFFFFC0u) | (unsigned)(16 * g + 6)); }
            { const float a_ = (g == 0 ? s1[0] : g == 1 ? s1[1] : g == 2 ? s1[6] : NEGV), b_ = (g == 0 ? s2[7] : g == 1 ? s2[7] : g == 2 ? s2[1] : NEGV); cand[7] = __uint_as_float((__float_as_uint(a_ + b_) & 0xFFFFFFC0u) | (unsigned)(16 * g + 7)); }
            { const float a_ = (g == 0 ? s1[0] : g == 1 ? s1[2] : g == 2 ? s1[7] : NEGV), b_ = (g == 0 ? s2[8] : g == 1 ? s2[0] : g == 2 ? s2[0] : NEGV); cand[8] = __uint_as_float((__float_as_uint(a_ + b_) & 0xFFFFFFC0u) | (unsigned)(16 * g + 8)); }
            { const float a_ = (g == 0 ? s1[0] : g == 1 ? s1[2] : g == 2 ? s1[7] : NEGV), b_ = (g == 0 ? s2[9] : g == 1 ? s2[1] : g == 2 ? s2[1] : NEGV); cand[9] = __uint_as_float((__float_as_uint(a_ + b_) & 0xFFFFFFC0u) | (unsigned)(16 * g + 9)); }
            { const float a_ = (g == 0 ? s1[0] : g == 1 ? s1[2] : g == 2 ? s1[8] : NEGV), b_ = (g == 0 ? s2[10] : g == 1 ? s2[2] : g == 2 ? s2[0] : NEGV); cand[10] = __uint_as_float((__float_as_uint(a_ + b_) & 0xFFFFFFC0u) | (unsigned)(16 * g + 10)); }
            { const float a_ = (g == 0 ? s1[0] : g == 1 ? s1[2] : g == 2 ? s1[9] : NEGV), b_ = (g == 0 ? s2[11] : g == 1 ? s2[3] : g == 2 ? s2[0] : NEGV); cand[11] = __uint_as_float((__float_as_uint(a_ + b_) & 0xFFFFFFC0u) | (unsigned)(16 * g + 11)); }
            { const float a_ = (g == 0 ? s1[0] : g == 1 ? s1[2] : g == 2 ? s1[10] : NEGV), b_ = (g == 0 ? s2[12] : g == 1 ? s2[4] : g == 2 ? s2[0] : NEGV); cand[12] = __uint_as_float((__float_as_uint(a_ + b_) & 0xFFFFFFC0u) | (unsigned)(16 * g + 12)); }
            { const float a_ = (g == 0 ? s1[0] : g == 1 ? s1[3] : g == 2 ? s1[11] : NEGV), b_ = (g == 0 ? s2[13] : g == 1 ? s2[0] : g == 2 ? s2[0] : NEGV); cand[13] = __uint_as_float((__float_as_uint(a_ + b_) & 0xFFFFFFC0u) | (unsigned)(16 * g + 13)); }
            { const float a_ = (g == 0 ? s1[0] : g == 1 ? s1[3] : g == 2 ? s1[12] : NEGV), b_ = (g == 0 ? s2[14] : g == 1 ? s2[1] : g == 2 ? s2[0] : NEGV); cand[14] = __uint_as_float((__float_as_uint(a_ + b_) & 0xFFFFFFC0u) | (unsigned)(16 * g + 14)); }
            { const float a_ = (g == 0 ? s1[0] : g == 1 ? s1[3] : g == 2 ? s1[13] : NEGV), b_ = (g == 0 ? s2[15] : g == 1 ? s2[2] : g == 2 ? s2[0] : NEGV); cand[15] = __uint_as_float((__float_as_uint(a_ + b_) & 0xFFFFFFC0u) | (unsigned)(16 * g + 15)); }
        sort16(cand);
        xmerge(cand, 16); xmerge(cand, 32);
        float den = 0.f, ex[16];
#pragma unroll
        for (int i = 0; i < 16; ++i) { ex[i] = __expf(cand[i] - cand[0]); den += ex[i]; }
        const float inv = 1.f / den;
        unsigned short eo[4]; float go[4];
#pragma unroll
        for (int e = 0; e < 4; ++e) {
            const float cv = (g == 0 ? cand[e] : g == 1 ? cand[4 + e] : g == 2 ? cand[8 + e] : cand[12 + e]);
            const float gv = (g == 0 ? ex[e] : g == 1 ? ex[4 + e] : g == 2 ? ex[8 + e] : ex[12 + e]);
            const unsigned code = __float_as_uint(cv) & 63u; const unsigned ij = ijt[code];
            const unsigned p1 = tab[ij & 15u], p2 = tab[16 + (ij >> 4)];
            eo[e] = (unsigned short)((p1 & 127u) * 128u + (p2 & 127u)); go[e] = gv * inv; }
        u32x2 ov; ov.x = (unsigned)eo[0] | ((unsigned)eo[1] << 16); ov.y = (unsigned)eo[2] | ((unsigned)eo[3] << 16);
        *(u32x2*)(pidx + (t0 + i16) * 128 + hh * 16 + 4 * g) = ov;
        *(f32x4*)(pgate + (t0 + i16) * 128 + hh * 16 + 4 * g) = (f32x4){go[0], go[1], go[2], go[3]};
    }
    __syncthreads();
}

__device__ __forceinline__ float dot2u(unsigned a, unsigned x, float acc) {
    return __builtin_amdgcn_fdot2_f32_bf16(__builtin_bit_cast(bf16x2_t, a), __builtin_bit_cast(bf16x2_t, x), acc, false);
}
__device__ __forceinline__ float dot8(const u32x4 a, const u32x4 x, float acc) {
    const unsigned a0 = a.x, a1 = a.y, a2 = a.z, a3 = a.w, x0 = x.x, x1 = x.y, x2 = x.z, x3 = x.w;
    acc = dot2u(a0, x0, acc); acc = dot2u(a1, x1, acc); acc = dot2u(a2, x2, acc); acc = dot2u(a3, x3, acc);
    return acc;
}
__device__ __forceinline__ void p_gather(const Ctx& C, const bf16_t* n2, const unsigned short* pidx, const float* pgate, const bf16_t* ub, const bf16_t* vb, const float* h, float* out) {
    const float* mod = C.f32p(WS_MOD); const float* fg = C.in[23];
    LAS float* cbuf = (LAS float*)C.lds + C.wave * 128;
    const int gw = C.bid * NWAVES + C.wave, NGW = C.G * NWAVES, lane = C.lane;
    for (int t = gw; t < T; t += NGW) {
        const int b = t / SEQ;
        const u32x4 x0 = *(const u32x4*)(n2 + (size_t)t * 1024 + lane * 8), x1 = *(const u32x4*)(n2 + (size_t)t * 1024 + 512 + lane * 8);
        const int id0 = pidx[(size_t)t * 128 + lane], id1 = pidx[(size_t)t * 128 + 64 + lane];
        const float g0 = pgate[(size_t)t * 128 + lane], g1 = pgate[(size_t)t * 128 + 64 + lane];
#pragma unroll 1
        for (int grp = 0; grp < 8; ++grp) {
            const int idv = grp < 4 ? id0 : id1; const int lbase = (grp & 3) * 16;
            float part[16];
#pragma unroll
            for (int j = 0; j < 16; ++j) {
                const int e = __shfl(idv, lbase + j);
                const bf16_t* rowp = ub + (size_t)e * 1024;
                const u32x4 a0 = *(const u32x4*)(rowp + lane * 8), a1 = *(const u32x4*)(rowp + 512 + lane * 8);
                part[j] = dot8(a1, x1, dot8(a0, x0, 0.f));
            }
            float p8[8];
            { const bool hi = (lane & 32) != 0;
#pragma unroll
              for (int j = 0; j < 8; ++j) { const float keep = hi ? part[j + 8] : part[j], send = hi ? part[j] : part[j + 8]; p8[j] = keep + __shfl_xor(send, 32); } }
            float p4[4];
            { const bool hi = (lane & 16) != 0;
#pragma unroll
              for (int j = 0; j < 4; ++j) { const float keep = hi ? p8[j + 4] : p8[j], send = hi ? p8[j] : p8[j + 4]; p4[j] = keep + __shfl_xor(send, 16); } }
            float p2[2];
            { const bool hi = (lane & 8) != 0;
#pragma unroll
              for (int j = 0; j < 2; ++j) { const float keep = hi ? p4[j + 2] : p4[j], send = hi ? p4[j] : p4[j + 2]; p2[j] = keep + __shfl_xor(send, 8); } }
            float p1;
            { const bool hi = (lane & 4) != 0; const float keep = hi ? p2[1] : p2[0], send = hi ? p2[0] : p2[1]; p1 = keep + __shfl_xor(send, 4); }
            p1 += __shfl_xor(p1, 2); p1 += __shfl_xor(p1, 1);
            const int E = ((lane >> 5) & 1) * 8 + ((lane >> 4) & 1) * 4 + ((lane >> 3) & 1) * 2 + ((lane >> 2) & 1);
            if ((lane & 3) == 0) cbuf[grp * 16 + E] = gelu_f(p1);
        }
        asm volatile("s_waitcnt lgkmcnt(0)" ::: "memory");
        const float c0 = cbuf[lane] * g0, c1 = cbuf[64 + lane] * g1;
        asm volatile("s_waitcnt lgkmcnt(0)" ::: "memory");
        float acc[16];
#pragma unroll
        for (int i = 0; i < 16; ++i) acc[i] = 0.f;
#pragma unroll 1
        for (int kb = 0; kb < 128; kb += 8) {
            const int idv = kb < 64 ? id0 : id1; const float cv = kb < 64 ? c0 : c1;
#pragma unroll
            for (int j = 0; j < 8; ++j) {
                const int e = __shfl(idv, (kb & 63) + j); const float ck = __shfl(cv, (kb & 63) + j);
                const bf16_t* rowp = vb + (size_t)e * 1024;
                const u32x4 a0 = *(const u32x4*)(rowp + lane * 8), a1 = *(const u32x4*)(rowp + 512 + lane * 8);
                acc[0] += ck * bflo(a0.x); acc[1] += ck * bfhi(a0.x); acc[2] += ck * bflo(a0.y); acc[3] += ck * bfhi(a0.y);
                acc[4] += ck * bflo(a0.z); acc[5] += ck * bfhi(a0.z); acc[6] += ck * bflo(a0.w); acc[7] += ck * bfhi(a0.w);
                acc[8] += ck * bflo(a1.x); acc[9] += ck * bfhi(a1.x); acc[10] += ck * bflo(a1.y); acc[11] += ck * bfhi(a1.y);
                acc[12] += ck * bflo(a1.z); acc[13] += ck * bfhi(a1.z); acc[14] += ck * bflo(a1.w); acc[15] += ck * bfhi(a1.w);
            }
        }
        float hf[16]; float ss = 0.f;
#pragma unroll
        for (int half = 0; half < 2; ++half) {
            const int col = half * 512 + lane * 8;
            const f32x4 h0 = *(const f32x4*)(h + (size_t)t * 1024 + col), h1 = *(const f32x4*)(h + (size_t)t * 1024 + col + 4);
            const f32x4 m0 = *(const f32x4*)(mod + b * 6144 + 5120 + col), m1 = *(const f32x4*)(mod + b * 6144 + 5120 + col + 4);
            hf[half * 8 + 0] = h0.x + m0.x * acc[half * 8 + 0]; hf[half * 8 + 1] = h0.y + m0.y * acc[half * 8 + 1];
            hf[half * 8 + 2] = h0.z + m0.z * acc[half * 8 + 2]; hf[half * 8 + 3] = h0.w + m0.w * acc[half * 8 + 3];
            hf[half * 8 + 4] = h1.x + m1.x * acc[half * 8 + 4]; hf[half * 8 + 5] = h1.y + m1.y * acc[half * 8 + 5];
            hf[half * 8 + 6] = h1.z + m1.z * acc[half * 8 + 6]; hf[half * 8 + 7] = h1.w + m1.w * acc[half * 8 + 7];
        }
#pragma unroll
        for (int i = 0; i < 16; ++i) ss += hf[i] * hf[i];
        const float rstd = rsqrtf(wave_sum(ss) * (1.f / 1024.f) + EPS);
#pragma unroll
        for (int half = 0; half < 2; ++half) {
            const int col = half * 512 + lane * 8;
            const f32x4 f0 = *(const f32x4*)(fg + col), f1 = *(const f32x4*)(fg + col + 4);
            f32x4 o0, o1;
            o0.x = hf[half * 8 + 0] * rstd * f0.x; o0.y = hf[half * 8 + 1] * rstd * f0.y; o0.z = hf[half * 8 + 2] * rstd * f0.z; o0.w = hf[half * 8 + 3] * rstd * f0.w;
            o1.x = hf[half * 8 + 4] * rstd * f1.x; o1.y = hf[half * 8 + 5] * rstd * f1.y; o1.z = hf[half * 8 + 6] * rstd * f1.z; o1.w = hf[half * 8 + 7] * rstd * f1.w;
            *(f32x4*)(out + (size_t)t * 1024 + col) = o0; *(f32x4*)(out + (size_t)t * 1024 + col + 4) = o1;
        }
    }
}


__device__ __forceinline__ void p_gather_ref(const Ctx& C, const bf16_t* n2, const unsigned short* pidx, const float* pgate, const float* h, float* out) {
    const float* mod = C.f32p(WS_MOD); const float* fg = C.in[23]; const float* U = C.in[21]; const float* V = C.in[22];
    LAS float* xs = (LAS float*)C.lds;
    LAS float* part = xs + 1024;
    LAS float* cs = part + 512;
    LAS float* red = cs + 128;
    LAS int* es = (LAS int*)(red + 512);
    const int tid = C.tid;
    for (int t = C.bid; t < T; t += C.G) {
        const int b = t / SEQ;
        __syncthreads();
        xs[tid] = bf2f(n2[(size_t)t * 1024 + tid]); xs[tid + 512] = bf2f(n2[(size_t)t * 1024 + 512 + tid]);
        if (tid < 128) es[tid] = pidx[(size_t)t * 128 + tid];
        __syncthreads();
        { const int k = tid >> 2, qd = tid & 3; const float* ur = U + (size_t)es[k] * 1024 + qd * 256; float acc = 0.f;
          for (int d = 0; d < 256; ++d) acc += ur[d] * xs[qd * 256 + d];
          part[tid] = acc; }
        __syncthreads();
        if (tid < 128) { const float dsum = part[tid * 4] + part[tid * 4 + 1] + part[tid * 4 + 2] + part[tid * 4 + 3]; cs[tid] = gelu_f(dsum) * pgate[(size_t)t * 128 + tid]; }
        __syncthreads();
        float o0 = 0.f, o1 = 0.f;
        for (int k = 0; k < 128; ++k) { const float* vr = V + (size_t)es[k] * 1024; const float ck = cs[k]; o0 += ck * vr[tid]; o1 += ck * vr[tid + 512]; }
        const float h0 = h[(size_t)t * 1024 + tid] + mod[b * 6144 + 5120 + tid] * o0, h1 = h[(size_t)t * 1024 + 512 + tid] + mod[b * 6144 + 5120 + 512 + tid] * o1;
        red[tid] = h0 * h0 + h1 * h1;
        __syncthreads();
        for (int sft = 256; sft > 0; sft >>= 1) { if (tid < sft) red[tid] += red[tid + sft]; __syncthreads(); }
        const float rstd = rsqrtf(red[0] * (1.f / 1024.f) + EPS);
        out[(size_t)t * 1024 + tid] = h0 * rstd * fg[tid]; out[(size_t)t * 1024 + 512 + tid] = h1 * rstd * fg[tid + 512];
    }
}

namespace pg8 {
#define PG8_LAS __attribute__((address_space(3)))
typedef unsigned short bf16_t;
typedef short bf16x8 __attribute__((ext_vector_type(8)));
typedef float f32x4 __attribute__((ext_vector_type(4)));
typedef unsigned u32x4 __attribute__((ext_vector_type(4)));
constexpr int BM = 256, BK = 64, HALF = 128, HTB = HALF * BK * 2  , STAGE_BYTES = 8 * HTB, NXCD = 8, WGM = 8;

__host__ __device__ __forceinline__ int lds_byte(int r, int c) { const int st = (r >> 4) * 2 + (c >> 5), rr = r & 15, cc = c & 31, ob = rr * 64 + cc * 2; return st * 1024 + (ob ^ (((ob >> 9) & 1) << 5)); }
__host__ __device__ __forceinline__ void stage_rc(int b, int& R, int& C) { const int st = b / 1024, sb = b % 1024, swz = sb ^ (((sb >> 9) & 1) << 5); R = (st >> 1) * 16 + swz / 64; C = (st & 1) * 32 + (swz % 64) / 2; }
__host__ __device__ __forceinline__ int perm32(int rho) { const int n = rho >> 4, i = rho & 15; return 8 * (i >> 2) + 4 * n + (i & 3); }

struct Unit { int pm, pn; };
struct Gemm { const bf16_t* A; const bf16_t* Bt; int M, N, K; };

struct StaticOrder {
    int nM, nN, nwg, G, c;
    __host__ __device__ void init(int M, int N, int G_, int c_) { nM = M / BM; nN = N / BM; nwg = nM * nN; G = G_; c = c_; }
    __host__ __device__ bool next(int i, Unit& u) const {
        const long L = (long)i * G + c; if (L >= nwg) return false;
        int wgid = (int)L; { const int q = nwg / NXCD, r = nwg % NXCD, xcd = wgid % NXCD, off = wgid / NXCD; wgid = (xcd < r ? xcd * (q + 1) : r * (q + 1) + (xcd - r) * q) + off; }
        const int nig = WGM * nN, gid = wgid / nig, fm = gid * WGM, gsz = (nM - fm) < WGM ? (nM - fm) : WGM;
        u.pm = fm + ((wgid % nig) % gsz); u.pn = (wgid % nig) / gsz; return true;
    }
    __device__ __forceinline__ void a_ready(const Unit&) const {}
    __device__ __forceinline__ void done(const Unit&) const {}
};

__device__ __forceinline__ unsigned cvt_pk_bf16(float lo, float hi) { return ::pk2(lo, hi); }
__device__ __forceinline__ float e_silu(float x) { return x / (1.f + __expf(-x)); }
__device__ __forceinline__ float e_sigm(float x) { return 1.f / (1.f + __expf(-x)); }
__device__ __forceinline__ float e_lo(unsigned v) { return __uint_as_float(v << 16); }
__device__ __forceinline__ float e_hi(unsigned v) { return __uint_as_float(v & 0xffff0000u); }
__device__ __forceinline__ u32x4 pack8(const f32x4 v0, const f32x4 v1) { u32x4 w; w.x = cvt_pk_bf16(v0[0], v0[1]); w.y = cvt_pk_bf16(v0[2], v0[3]); w.z = cvt_pk_bf16(v1[0], v1[1]); w.w = cvt_pk_bf16(v1[2], v1[3]); return w; }

struct EpiInProj {
    static constexpr bool PERM = true, AFTER_DRAIN = false;
    bf16_t *sz, *xbc, *q, *k, *v;
    __device__ __forceinline__ void operator()(const f32x4 (&acc)[2][2][4][2], const Unit& u, int wr, int wc, int fr, int fq) const {
        const int pn = u.pn; bf16_t* base; int ldc = 1024, colt, mode = 0;
        if (pn < 4) { base = sz; colt = pn * 256; mode = 1; }
        else if (pn < 12) { base = xbc; ldc = 2048; colt = (pn - 4) * 256; }
        else if (pn < 16) { base = q; colt = (pn - 12) * 256; mode = 2; }
        else if (pn < 20) { base = k; colt = (pn - 16) * 256; }
        else { base = v; colt = (pn - 20) * 256; }
        const int row0 = u.pm * BM + wr * 64 + fr, col0 = colt + wc * 32 + 8 * fq;
#pragma unroll
        for (int ai = 0; ai < 2; ++ai)
#pragma unroll
            for (int m = 0; m < 4; ++m) { bf16_t* rowp = base + (size_t)(row0 + ai * HALF + m * 16) * ldc + col0;
#pragma unroll
                for (int bj = 0; bj < 2; ++bj) { f32x4 v0 = acc[ai][bj][m][0], v1 = acc[ai][bj][m][1];
                    if (mode == 1) {
#pragma unroll
                        for (int i = 0; i < 4; ++i) { v0[i] = e_silu(v0[i]); v1[i] = e_silu(v1[i]); } }
                    else if (mode == 2) { v0 = v0 * 0.125f; v1 = v1 * 0.125f; }
                    *(u32x4*)(rowp + bj * HALF) = pack8(v0, v1); } }
    }
};
struct EpiGate {
    static constexpr bool PERM = true, AFTER_DRAIN = false;
    bf16_t* sg; size_t plane;
    __device__ __forceinline__ void operator()(const f32x4 (&acc)[2][2][4][2], const Unit& u, int wr, int wc, int fr, int fq) const {
        bf16_t* base = sg + (size_t)(u.pn >> 2) * plane; const int colt = (u.pn & 3) * 256;
        const int row0 = u.pm * BM + wr * 64 + fr, col0 = colt + wc * 32 + 8 * fq;
#pragma unroll
        for (int ai = 0; ai < 2; ++ai)
#pragma unroll
            for (int m = 0; m < 4; ++m) { bf16_t* rowp = base + (size_t)(row0 + ai * HALF + m * 16) * 1024 + col0;
#pragma unroll
                for (int bj = 0; bj < 2; ++bj) { f32x4 v0 = acc[ai][bj][m][0], v1 = acc[ai][bj][m][1];
#pragma unroll
                    for (int i = 0; i < 4; ++i) { v0[i] = e_sigm(v0[i]); v1[i] = e_sigm(v1[i]); }
                    *(u32x4*)(rowp + bj * HALF) = pack8(v0, v1); } }
    }
};
struct EpiD1 {
    static constexpr bool PERM = true, AFTER_DRAIN = false;
    bf16_t* p1; const bf16_t* sg1; const float* rstd;
    __device__ __forceinline__ void operator()(const f32x4 (&acc)[2][2][4][2], const Unit& u, int wr, int wc, int fr, int fq) const {
        const int row0 = u.pm * BM + wr * 64 + fr, col0 = u.pn * BM + wc * 32 + 8 * fq;
#pragma unroll
        for (int ai = 0; ai < 2; ++ai)
#pragma unroll
            for (int m = 0; m < 4; ++m) { const int row = row0 + ai * HALF + m * 16; const float rs = rstd[row]; const size_t off = (size_t)row * 1024 + col0;
#pragma unroll
                for (int bj = 0; bj < 2; ++bj) { f32x4 v0 = acc[ai][bj][m][0] * rs, v1 = acc[ai][bj][m][1] * rs;
                    const u32x4 g = *(const u32x4*)(sg1 + off + bj * HALF);
                    v0[0] *= e_lo(g.x); v0[1] *= e_hi(g.x); v0[2] *= e_lo(g.y); v0[3] *= e_hi(g.y); v1[0] *= e_lo(g.z); v1[1] *= e_hi(g.z); v1[2] *= e_lo(g.w); v1[3] *= e_hi(g.w);
                    *(u32x4*)(p1 + off + bj * HALF) = pack8(v0, v1); } }
    }
};
struct EpiD2 {
    static constexpr bool PERM = true, AFTER_DRAIN = false;
    bf16_t* mixed; const bf16_t *p1, *sg2;
    __device__ __forceinline__ void operator()(const f32x4 (&acc)[2][2][4][2], const Unit& u, int wr, int wc, int fr, int fq) const {
        const int row0 = u.pm * BM + wr * 64 + fr, col0 = u.pn * BM + wc * 32 + 8 * fq;
#pragma unroll
        for (int ai = 0; ai < 2; ++ai)
#pragma unroll
            for (int m = 0; m < 4; ++m) { const int row = row0 + ai * HALF + m * 16; const size_t off = (size_t)row * 1024 + col0;
#pragma unroll
                for (int bj = 0; bj < 2; ++bj) { f32x4 v0 = acc[ai][bj][m][0], v1 = acc[ai][bj][m][1];
                    const u32x4 g = *(const u32x4*)(sg2 + off + bj * HALF), p = *(const u32x4*)(p1 + off + bj * HALF);
                    v0[0] = e_lo(p.x) + v0[0] * e_lo(g.x); v0[1] = e_hi(p.x) + v0[1] * e_hi(g.x); v0[2] = e_lo(p.y) + v0[2] * e_lo(g.y); v0[3] = e_hi(p.y) + v0[3] * e_hi(g.y);
                    v1[0] = e_lo(p.z) + v1[0] * e_lo(g.z); v1[1] = e_hi(p.z) + v1[1] * e_hi(g.z); v1[2] = e_lo(p.w) + v1[2] * e_lo(g.w); v1[3] = e_hi(p.w) + v1[3] * e_hi(g.w);
                    *(u32x4*)(mixed + off + bj * HALF) = pack8(v0, v1); } }
    }
};
struct EpiD3 {
    static constexpr bool PERM = false, AFTER_DRAIN = false;
    float* h; const float* x; const float* mod;
    __device__ __forceinline__ void operator()(const f32x4 (&acc)[2][2][4][2], const Unit& u, int wr, int wc, int fr, int fq) const {
        const int row0 = u.pm * BM + wr * 64 + fr, col0 = u.pn * BM + wc * 32 + 4 * fq;
        const float* g1 = mod + (size_t)((u.pm * BM) >> 12) * 6144 + 2048;
#pragma unroll
        for (int ai = 0; ai < 2; ++ai)
#pragma unroll
            for (int m = 0; m < 4; ++m) { const size_t off = (size_t)(row0 + ai * HALF + m * 16) * 1024 + col0;
#pragma unroll
                for (int bj = 0; bj < 2; ++bj)
#pragma unroll
                    for (int n = 0; n < 2; ++n) { const int c = bj * HALF + n * 16; const f32x4 xv = *(const f32x4*)(x + off + c), gv = *(const f32x4*)(g1 + col0 + c);
                        *(f32x4*)(h + off + c) = xv + gv * acc[ai][bj][m][n]; } }
    }
};
struct EpiQp {
    static constexpr bool PERM = true, AFTER_DRAIN = false;
    bf16_t* qp;
    __device__ __forceinline__ void operator()(const f32x4 (&acc)[2][2][4][2], const Unit& u, int wr, int wc, int fr, int fq) const {
        const int row0 = u.pm * BM + wr * 64 + fr, col0 = u.pn * BM + wc * 32 + 8 * fq;
#pragma unroll
        for (int ai = 0; ai < 2; ++ai)
#pragma unroll
            for (int m = 0; m < 4; ++m) { bf16_t* rowp = qp + (size_t)(row0 + ai * HALF + m * 16) * 2048 + col0;
#pragma unroll
                for (int bj = 0; bj < 2; ++bj) *(u32x4*)(rowp + bj * HALF) = pack8(acc[ai][bj][m][0], acc[ai][bj][m][1]); }
    }
};

template <class Epi, class Sched, bool ALIGN_EPI = false, bool SP2 = false>
__device__ __forceinline__ void gemm_phase(PG8_LAS unsigned char* lds, const Gemm g, const Sched& S, const Epi& E) {
    const int tid = threadIdx.x, wid = __builtin_amdgcn_readfirstlane(tid >> 6), lane = tid & 63, wr = wid >> 2, wc = wid & 3, fr = lane & 15, fq = lane >> 4;
    const int K = g.K, nt = K / BK;
    unsigned voffA[2], voffB[2];
#pragma unroll
    for (int i = 0; i < 2; ++i) { int R, C; stage_rc(tid * 16 + i * 8192, R, C); const int Rb = Epi::PERM ? ((R & ~31) + perm32(R & 31)) : R;
        voffA[i] = (unsigned)(R * K + C) * 2u; voffB[i] = (unsigned)(Rb * K + C) * 2u; }
    const size_t kstep = (size_t)(BK * 2);
    const size_t hstep = (size_t)HALF * K * 2;
    const size_t tstep = 2 * hstep;
    const unsigned ldsw = (unsigned)wid * 1024u;
    const int aoff = lds_byte(wr * 64 + fr, fq * 8), boff = lds_byte(wc * 32 + fr, fq * 8);
#define PG8_SA(b, h) (((b) * 2 + (h)) * HTB)
#define PG8_SB(b, h) ((4 + (b) * 2 + (h)) * HTB)
#define PG8_STAGE(bufoff, gbase, voff) do { _Pragma("unroll") for (int _i = 0; _i < 2; ++_i) \
        __builtin_amdgcn_global_load_lds((const unsigned*)((const char*)(gbase) + (voff)[_i]), (PG8_LAS unsigned*)(lds + (bufoff) + ldsw + _i * 8192), 16, 0, 0); } while (0)
#define PG8_LDA(dst, b, h) do { _Pragma("unroll") for (int m = 0; m < 4; ++m) _Pragma("unroll") for (int k = 0; k < 2; ++k) dst[m][k] = *(const PG8_LAS bf16x8*)(lds + PG8_SA(b, h) + aoff + m * 2048 + k * 1024); } while (0)
#define PG8_LDB(dst, b, h) do { _Pragma("unroll") for (int n = 0; n < 2; ++n) _Pragma("unroll") for (int k = 0; k < 2; ++k) dst[n][k] = *(const PG8_LAS bf16x8*)(lds + PG8_SB(b, h) + boff + n * 2048 + k * 1024); } while (0)
#define PG8_MMA(ai, bj, At, Bt) do { __builtin_amdgcn_s_setprio(1); _Pragma("unroll") for (int m = 0; m < 4; ++m) _Pragma("unroll") for (int n = 0; n < 2; ++n) _Pragma("unroll") for (int k = 0; k < 2; ++k) \
        acc[ai][bj][m][n] = __builtin_amdgcn_mfma_f32_16x16x32_bf16(Bt[n][k], At[m][k], acc[ai][bj][m][n], 0, 0, 0); __builtin_amdgcn_s_setprio(0); } while (0)
#define PG8_WAIT_V(n) asm volatile("s_waitcnt vmcnt(" #n ")" ::: "memory")
#define PG8_WAIT_L(n) asm volatile("s_waitcnt lgkmcnt(" #n ")" ::: "memory")
#define PG8_BAR __builtin_amdgcn_s_barrier()
#define PG8_SCHED __builtin_amdgcn_sched_barrier(0)
    Unit cur, nxt; int ui = 0;
    if (!S.next(0, cur)) return;
    f32x4 acc[2][2][4][2];
#pragma unroll
    for (int a = 0; a < 2; ++a)
#pragma unroll
        for (int b = 0; b < 2; ++b)
#pragma unroll
            for (int m = 0; m < 4; ++m)
#pragma unroll
                for (int n = 0; n < 2; ++n) acc[a][b][m][n] = (f32x4){0.f, 0.f, 0.f, 0.f};
    bf16x8 At[4][2], B0[2][2], B1[2][2];
    const char* cA = (const char*)g.A + (size_t)cur.pm * tstep; const char* cB = (const char*)g.Bt + (size_t)cur.pn * tstep;
    S.a_ready(cur);
    if constexpr (SP2) {
        PG8_STAGE(PG8_SB(0, 0), cB, voffB); PG8_STAGE(PG8_SB(0, 1), cB + hstep, voffB); PG8_STAGE(PG8_SA(0, 0), cA, voffA); PG8_STAGE(PG8_SA(0, 1), cA + hstep, voffA);
        if (wr == 1) PG8_BAR;
        PG8_WAIT_V(2); PG8_BAR;
        PG8_STAGE(PG8_SB(1, 0), cB + kstep, voffB); PG8_STAGE(PG8_SA(1, 0), cA + kstep, voffA); PG8_STAGE(PG8_SB(1, 1), cB + hstep + kstep, voffB);
        PG8_WAIT_V(6); PG8_BAR;
    } else {
        PG8_STAGE(PG8_SB(0, 0), cB, voffB); PG8_STAGE(PG8_SA(0, 0), cA, voffA); PG8_STAGE(PG8_SB(0, 1), cB + hstep, voffB); PG8_STAGE(PG8_SA(0, 1), cA + hstep, voffA);
        if (wr == 1) PG8_BAR;
        PG8_WAIT_V(4); PG8_BAR;
        PG8_STAGE(PG8_SB(1, 0), cB + kstep, voffB); PG8_STAGE(PG8_SA(1, 0), cA + kstep, voffA); PG8_STAGE(PG8_SB(1, 1), cB + hstep + kstep, voffB);
        PG8_WAIT_V(6); PG8_BAR;
    }
    for (;;) {
        const bool has_next = S.next(ui + 1, nxt);
        const char* nA = has_next ? (const char*)g.A + (size_t)nxt.pm * tstep : cA; const char* nB = has_next ? (const char*)g.Bt + (size_t)nxt.pn * tstep : cB;
        for (int t = 0; t < nt; t += 2) {
            const bool last = (t == nt - 2);
            const char* a1 = cA + (size_t)(t + 1) * kstep;
            const char* a2 = last ? nA : cA + (size_t)(t + 2) * kstep; const char* b2 = last ? nB : cB + (size_t)(t + 2) * kstep;
            const char* a3 = a2 + kstep; const char* b3 = b2 + kstep;
            if (last && has_next) S.a_ready(nxt);
            if constexpr (SP2) {
            PG8_LDB(B0, 0, 0); PG8_LDB(B1, 0, 1); PG8_SCHED; PG8_LDA(At, 0, 0); PG8_STAGE(PG8_SA(1, 1), a1 + hstep, voffA);
            PG8_WAIT_V(8); PG8_WAIT_L(0); PG8_BAR; PG8_MMA(0, 0, At, B0); PG8_MMA(0, 1, At, B1); PG8_BAR; PG8_SCHED;
            PG8_LDA(At, 0, 1); PG8_STAGE(PG8_SB(0, 0), b2, voffB); PG8_STAGE(PG8_SB(0, 1), b2 + hstep, voffB); PG8_STAGE(PG8_SA(0, 0), a2, voffA);
            PG8_WAIT_V(8); PG8_WAIT_L(0); PG8_BAR; PG8_MMA(1, 0, At, B0); PG8_MMA(1, 1, At, B1); PG8_BAR; PG8_SCHED;
            PG8_LDB(B0, 1, 0); PG8_LDB(B1, 1, 1); PG8_SCHED; PG8_LDA(At, 1, 0); PG8_STAGE(PG8_SA(0, 1), a2 + hstep, voffA);
            PG8_WAIT_V(8); PG8_WAIT_L(0); PG8_BAR; PG8_MMA(0, 0, At, B0); PG8_MMA(0, 1, At, B1); PG8_BAR; PG8_SCHED;
            PG8_LDA(At, 1, 1); PG8_STAGE(PG8_SB(1, 0), b3, voffB); PG8_STAGE(PG8_SB(1, 1), b3 + hstep, voffB); PG8_STAGE(PG8_SA(1, 0), a3, voffA);
            PG8_WAIT_V(8); PG8_WAIT_L(0); PG8_BAR; PG8_MMA(1, 0, At, B0); PG8_MMA(1, 1, At, B1); PG8_BAR; PG8_SCHED;
            } else {
            PG8_LDB(B0, 0, 0); PG8_SCHED; PG8_LDA(At, 0, 0); PG8_STAGE(PG8_SA(1, 1), a1 + hstep, voffA);
            PG8_WAIT_L(8); PG8_BAR; PG8_WAIT_L(0); PG8_MMA(0, 0, At, B0); PG8_BAR; PG8_SCHED;
            PG8_LDB(B1, 0, 1); PG8_STAGE(PG8_SB(0, 0), b2, voffB);
            PG8_BAR; PG8_WAIT_L(0); PG8_MMA(0, 1, At, B1); PG8_BAR;
            PG8_LDA(At, 0, 1); PG8_STAGE(PG8_SA(0, 0), a2, voffA);
            PG8_BAR; PG8_WAIT_L(0); PG8_MMA(1, 0, At, B0); PG8_BAR; PG8_SCHED;
            PG8_STAGE(PG8_SB(0, 1), b2 + hstep, voffB);
            PG8_WAIT_V(6); PG8_BAR; PG8_MMA(1, 1, At, B1); PG8_BAR;
            PG8_LDB(B0, 1, 0); PG8_SCHED; PG8_LDA(At, 1, 0); PG8_STAGE(PG8_SA(0, 1), a2 + hstep, voffA);
            PG8_WAIT_L(8); PG8_BAR; PG8_WAIT_L(0); PG8_MMA(0, 0, At, B0); PG8_BAR; PG8_SCHED;
            PG8_LDB(B1, 1, 1); PG8_STAGE(PG8_SB(1, 0), b3, voffB);
            PG8_BAR; PG8_WAIT_L(0); PG8_MMA(0, 1, At, B1); PG8_BAR;
            PG8_LDA(At, 1, 1); PG8_STAGE(PG8_SA(1, 0), a3, voffA);
            PG8_BAR; PG8_WAIT_L(0); PG8_MMA(1, 0, At, B0); PG8_BAR; PG8_SCHED;
            PG8_STAGE(PG8_SB(1, 1), b3 + hstep, voffB);
            PG8_WAIT_V(6); PG8_BAR; PG8_MMA(1, 1, At, B1); PG8_BAR;
            }
        }
        if constexpr (ALIGN_EPI) { if (wr == 0) PG8_BAR; }
        if constexpr (!Epi::AFTER_DRAIN) { E(acc, cur, wr, wc, fr, fq); S.done(cur); }
        if (!has_next) break;
#pragma unroll
        for (int a = 0; a < 2; ++a)
#pragma unroll
            for (int b = 0; b < 2; ++b)
#pragma unroll
                for (int m = 0; m < 4; ++m)
#pragma unroll
                    for (int n = 0; n < 2; ++n) acc[a][b][m][n] = (f32x4){0.f, 0.f, 0.f, 0.f};
        cur = nxt; cA = nA; cB = nB; ++ui;
        if constexpr (ALIGN_EPI) { if (wr == 1) PG8_BAR; }
    }
    PG8_WAIT_V(0);
    if constexpr (!ALIGN_EPI) { if (wr == 0) PG8_BAR; }
    PG8_BAR;
    if constexpr (Epi::AFTER_DRAIN) { E.fused(acc, cur, wr, wc, fr, fq, lds, wid, lane); S.done(cur); }
#undef PG8_SA
#undef PG8_SB
#undef PG8_STAGE
#undef PG8_LDA
#undef PG8_LDB
#undef PG8_MMA
#undef PG8_WAIT_V
#undef PG8_WAIT_L
#undef PG8_BAR
#undef PG8_SCHED
}
}


__device__ __forceinline__ void p_diag_cmp(const Ctx& C, const bf16_t* a, const bf16_t* b, size_t n, unsigned* res) {
    const size_t gt = (size_t)C.bid * NTHR + C.tid, NT = (size_t)C.G * NTHR;
    float md = 0.f, mr = 0.f;
    for (size_t i = gt; i < n; i += NT) { const float x = bf2f(a[i]), y = bf2f(b[i]); const float d = x - y; md += (d == d ? d * d : 1e30f); mr += x * x; }
#pragma unroll
    for (int o = 1; o < 64; o <<= 1) { md += __shfl_xor(md, o); mr += __shfl_xor(mr, o); }
    if (C.lane == 0) { atomicAdd((float*)res, md); atomicAdd((float*)res + 1, mr); }
}
__device__ __forceinline__ void p_diag_out(const Ctx& C, const unsigned* res, float* out) {
    const size_t gt = (size_t)C.bid * NTHR + C.tid, NT = (size_t)C.G * NTHR;
    for (size_t i = gt; i < (size_t)T * 1024; i += NT) out[i] = 0.f;
    __syncthreads();
    if (C.bid == 0 && C.tid == 0) { const float md = __uint_as_float(res[0]), mr = __uint_as_float(res[1]); const float rel = sqrtf(md / fmaxf(mr, 1e-30f));
        out[0] = 1.0e4f * (13.f + log10f(rel + 1e-12f)); }
}

#define GAS __attribute__((address_space(1)))
typedef GAS unsigned gu32;
#define RLX_AGENT __ATOMIC_RELAXED, __HIP_MEMORY_SCOPE_AGENT
#define XB_TMO      128
#define XB_XCNT(j)  (256  + 64 * (j))
#define XB_XSUB(j)  (1280 + 64 * (j))
#define XB_XGEN(j)  (2304 + 64 * (j))
#define XB_TOP      3328
#define XB_TOPGEN   3392
#define XCD_BAR_WORDS 3456
#define XB_SPIN_CAP (1u << 18)

__device__ __forceinline__ unsigned xb_ld(unsigned* p)              { return __hip_atomic_load(p, __ATOMIC_RELAXED, __HIP_MEMORY_SCOPE_AGENT); }
__device__ __forceinline__ unsigned xb_add(unsigned* p, unsigned v) { return __hip_atomic_fetch_add(p, v, __ATOMIC_RELAXED, __HIP_MEMORY_SCOPE_AGENT); }
__device__ __forceinline__ unsigned xb_xcc_id() { return (unsigned)__builtin_amdgcn_s_getreg((3 << 11) | 20) & 0xFu; }
#define XB_SPIN(cond, bar) do { unsigned _sp = 0; while (cond) { __builtin_amdgcn_s_sleep(1); \
    if ((++_sp & 255u) == 0u) { if (xb_ld(&(bar)[XB_TMO])) break; if (_sp > XB_SPIN_CAP) { atomicAdd(&(bar)[XB_TMO], 1u); break; } } } } while (0)

struct XcdBarrier {
    unsigned* bar; unsigned x;
    volatile LAS unsigned* st;
};

__device__ __forceinline__ XcdBarrier xcd_barrier_post(unsigned* bar, volatile LAS unsigned* st) {
    XcdBarrier b; b.bar = bar; b.x = xb_xcc_id(); b.st = st;
    if (threadIdx.x == 0) (void)xb_add(&bar[XB_XCNT(b.x)], 1u);
    return b;
}
__device__ __forceinline__ void xcd_barrier_complete(unsigned* bar, unsigned x, unsigned& nloc, unsigned& nx) {
    const unsigned G = gridDim.x * gridDim.y * gridDim.z;
    unsigned sum, cnt, mine, sp = 0u;
    for (;;) {
        sum = 0u; cnt = 0u; mine = 0u;
#pragma unroll
        for (unsigned j = 0; j < 16; ++j) { const unsigned c = xb_ld(&bar[XB_XCNT(j)]); sum += c; cnt += (c > 0u) ? 1u : 0u; mine = (j == x) ? c : mine; }
        if (sum == G) break;
        __builtin_amdgcn_s_sleep(1);
        if ((++sp & 255u) == 0u) { if (xb_ld(&bar[XB_TMO])) break; if (sp > XB_SPIN_CAP) { atomicAdd(&bar[XB_TMO], 1u); break; } }
    }
    nloc = mine > 0u ? mine : 1u; nx = cnt > 0u ? cnt : 1u;
}

__device__ __forceinline__ void xcd_barrier(const XcdBarrier& b) {
    asm volatile("s_waitcnt vmcnt(0)" ::: "memory");
    __syncthreads();
    if (threadIdx.x == 0) {
        unsigned* bar = b.bar;
        __builtin_amdgcn_s_waitcnt(0);
        unsigned nloc = b.st[0], nx = b.st[1];
        if (nloc == 0u) { xcd_barrier_complete(bar, b.x, nloc, nx); b.st[0] = nloc; b.st[1] = nx; }
        const unsigned old = xb_add(&bar[XB_XSUB(b.x)], 1u);
        const unsigned gen = old / nloc;
        if (old + 1u == (gen + 1u) * nloc) {
            __builtin_amdgcn_fence(__ATOMIC_RELEASE, "agent");
            asm volatile("s_waitcnt vmcnt(0)" ::: "memory");
            const unsigned og = xb_add(&bar[XB_TOP], 1u);
            const unsigned tg = og / nx;
            if (og + 1u == (tg + 1u) * nx) xb_add(&bar[XB_TOPGEN], 1u);
            else XB_SPIN(xb_ld(&bar[XB_TOPGEN]) == tg, bar);
            __builtin_amdgcn_fence(__ATOMIC_ACQUIRE, "agent");
            xb_add(&bar[XB_XGEN(b.x)], 1u);
            asm volatile("s_waitcnt vmcnt(0)" ::: "memory");
        } else {
            XB_SPIN(xb_ld(&bar[XB_XGEN(b.x)]) == gen, bar);
            __builtin_amdgcn_fence(__ATOMIC_ACQUIRE, "agent");
            asm volatile("s_waitcnt vmcnt(0)" ::: "memory");
        }
    }
    __syncthreads();
}


constexpr int N_PHASES = 15;
constexpr int CW_BAR = 4096;
constexpr size_t CTL_ZERO_BYTES = 64 * 1024;
constexpr int MISC_OFF = LDS_BYTES - 256;

template <int PH>
__device__ __forceinline__ void run_phase(const Ctx& C, const Args& a) {
    bf16_t* R0 = C.bfp(WS_R0); bf16_t* R1 = C.bfp(WS_R1); bf16_t* R2 = C.bfp(WS_R2); bf16_t* R3 = C.bfp(WS_R3);
    bf16_t* OB = (bf16_t*)a.out;
    const size_t TD = (size_t)T * 1024;
    if constexpr (PH == 0) p_prep(C);
    if constexpr (PH == 1) p_rownorm(C, C.in[0], C.in[4], 0, 1024, R0);
    if constexpr (PH == 2) {
        { pg8::Gemm g{R0, C.bfp(WS_WIN_T), T, 6144, 1024}; pg8::StaticOrder S; S.init(T, 6144, C.G, C.bid);
          pg8::EpiInProj e{R1, R2, R3, R3 + TD, R3 + 2 * TD};
          pg8::gemm_phase<pg8::EpiInProj, pg8::StaticOrder, true, true>(C.lds, g, S, e); }
        EDt ed{C.f32p(WS_DT), C.in[8], C.in[9]};
        naive_gemm(C, R0, C.bfp(WS_WDT_T), T, 32, 1024, ed);
    }
    if constexpr (PH == 3) p_conv(C, R2, OB);
#ifdef DIAG_SSD
    if constexpr (PH == 4) p_ssd_naive(C, OB, C.f32p(WS_DT), R2, R2 + TD);
    if constexpr (PH == 6) p_ssd(C, OB, C.f32p(WS_DT), R3 + TD, R3 + 2 * TD);
    if constexpr (PH == 7) p_diag_cmp(C, R2, R3 + TD, 2 * TD, (unsigned*)(a.ws + WS_CTL) + 1024);
    if constexpr (PH == 8) p_diag_out(C, (unsigned*)(a.ws + WS_CTL) + 1024, a.out);
#else
    if constexpr (PH == 4) p_ssd(C, OB, C.f32p(WS_DT), R2, R2 + TD);
#endif
    if constexpr (PH == 5) p_na_naive(C, R3, R3 + TD, R3 + 2 * TD);
#ifndef DIAG_SSD
    if constexpr (PH == 6) p_combine(C, R2, R2 + TD, R1, C.f32p(WS_RSTD));
    if constexpr (PH == 7) { pg8::Gemm g{R0, C.bfp(WS_WG_T), T, 2048, 1024}; pg8::StaticOrder S; S.init(T, 2048, C.G, C.bid);
        pg8::EpiGate e{OB, TD}; pg8::gemm_phase<pg8::EpiGate, pg8::StaticOrder, true, true>(C.lds, g, S, e); }
    if constexpr (PH == 8) { pg8::Gemm g{R1, C.bfp(WS_WSSD_T), T, 1024, 1024}; pg8::StaticOrder S; S.init(T, 1024, C.G, C.bid);
        pg8::EpiD1 e{R2, OB, C.f32p(WS_RSTD)}; pg8::gemm_phase<pg8::EpiD1, pg8::StaticOrder, true, true>(C.lds, g, S, e); }
    if constexpr (PH == 9) { pg8::Gemm g{R3, C.bfp(WS_WNA_T), T, 1024, 1024}; pg8::StaticOrder S; S.init(T, 1024, C.G, C.bid);
        pg8::EpiD2 e{R2 + TD, R2, OB + TD}; pg8::gemm_phase<pg8::EpiD2, pg8::StaticOrder, true, true>(C.lds, g, S, e); }
    if constexpr (PH == 10) { pg8::Gemm g{R2 + TD, C.bfp(WS_WOUT_T), T, 1024, 1024}; pg8::StaticOrder S; S.init(T, 1024, C.G, C.bid);
        pg8::EpiD3 e{(float*)(R3 + TD), C.in[0], C.f32p(WS_MOD)}; pg8::gemm_phase<pg8::EpiD3, pg8::StaticOrder, true, true>(C.lds, g, S, e); }
    if constexpr (PH == 11) { p_rownorm(C, (const float*)(R3 + TD), C.in[18], 3072, 4096, R0); p_cvt_tables(C, R2, R2 + (size_t)16384 * 1024); }
    if constexpr (PH == 12) { pg8::Gemm g{R0, C.bfp(WS_WPQ_T), T, 2048, 1024}; pg8::StaticOrder S; S.init(T, 2048, C.G, C.bid);
        pg8::EpiQp e{OB}; pg8::gemm_phase<pg8::EpiQp, pg8::StaticOrder, true, true>(C.lds, g, S, e); }
    if constexpr (PH == 13) p_topk(C, OB, C.bfp(WS_KEYS), (unsigned short*)R1, (float*)(R1 + 4 * MiB));
    if constexpr (PH == 14) p_gather(C, R0, (const unsigned short*)R1, (const float*)(R1 + 4 * MiB), R2, R2 + (size_t)16384 * 1024, (const float*)(R3 + TD), a.out);
#endif
}

template <int PH> struct PhaseLoop {
    static __device__ __forceinline__ void run(const Ctx& C, const Args& a, const XcdBarrier& bar) {
        if (PH >= a.ph_lo && PH < a.ph_hi) { run_phase<PH>(C, a); if (PH + 1 < a.ph_hi) xcd_barrier(bar); }
        PhaseLoop<PH + 1>::run(C, a, bar);
    }
};
template <> struct PhaseLoop<N_PHASES> { static __device__ __forceinline__ void run(const Ctx&, const Args&, const XcdBarrier&) {} };

__global__ void __launch_bounds__(NTHR, 2) mega(Args a) {
    extern __shared__ __attribute__((aligned(16))) unsigned char lds_raw[];
    Ctx C; C.in = a.in; C.out = a.out; C.ws = a.ws; C.tid = threadIdx.x; C.lane = C.tid & 63; C.wave = __builtin_amdgcn_readfirstlane(C.tid >> 6);
    C.G = gridDim.x; C.bid = blockIdx.x; C.lds = (LAS unsigned char*)lds_raw;
    volatile LAS unsigned* MISC = (volatile LAS unsigned*)(C.lds + MISC_OFF);
    if (C.tid < 64) MISC[C.tid] = 0u;
    __syncthreads();
    XcdBarrier bar; bar.bar = (unsigned*)(a.ws + WS_CTL) + CW_BAR; bar.x = 0; bar.st = nullptr;
    if (a.ph_hi - a.ph_lo > 1) bar = xcd_barrier_post((unsigned*)(a.ws + WS_CTL) + CW_BAR, MISC + 8);
    PhaseLoop<0>::run(C, a, bar);
}

extern "C" void kernel_launch(void* const* d_in, const int* in_sizes, int n_in, void* d_out, int out_size, void* d_ws, size_t ws_size, hipStream_t stream) {
    static int grid = 0;
    if (grid == 0) {
        if (n_in != 24 || out_size != T * D || ws_size < WS_END) { fprintf(stderr, "kernel_launch: unexpected shapes n_in %d out %d ws %zu\n", n_in, out_size, ws_size); grid = -1; return; }
        int dev = 0, cus = 0;
        if (hipGetDevice(&dev) != hipSuccess || hipDeviceGetAttribute(&cus, hipDeviceAttributeMultiprocessorCount, dev) != hipSuccess) { grid = -1; return; }
        if (hipFuncSetAttribute((const void*)mega, hipFuncAttributeMaxDynamicSharedMemorySize, LDS_BYTES) != hipSuccess) { grid = -1; return; }
        grid = cus;
    }
    if (grid < 0) return;
    (void)hipMemsetAsync((char*)d_ws + WS_CTL, 0, CTL_ZERO_BYTES, stream);
    Args a{};
    for (int i = 0; i < 24; ++i) a.in[i] = (const float*)d_in[i];
    a.out = (float*)d_out; a.ws = (unsigned char*)d_ws;
#ifdef DIAG_SSD
    for (int ph = 0; ph < 9; ++ph) { a.ph_lo = ph; a.ph_hi = ph + 1; hipLaunchKernelGGL(mega, dim3(grid), dim3(NTHR), LDS_BYTES, stream, a); }
#else
    a.ph_lo = 0; a.ph_hi = N_PHASES;
    hipLaunchKernelGGL(mega, dim3(grid), dim3(NTHR), LDS_BYTES, stream, a);
#endif
}
```

```cpp
#include <hip/hip_runtime.h>
#include <cstdio>
#include <cstdint>

#define LAS __attribute__((address_space(3)))
typedef unsigned short bf16_t;
typedef float f32x4 __attribute__((ext_vector_type(4)));
typedef unsigned u32x4 __attribute__((ext_vector_type(4)));
typedef unsigned u32x2 __attribute__((ext_vector_type(2)));
typedef __bf16 bf16x2_t __attribute__((ext_vector_type(2)));

constexpr int T = 32768, D = 1024, NB = 8, SEQ = 4096;
constexpr int NWAVES = 8, NTHR = 512;
constexpr float EPS = 1e-6f;
constexpr int OFF_Z = 0, OFF_XBC = 1024, OFF_DTF = 3072, OFF_DTB = 3088, OFF_QKV = 3104, OFF_GS = 6176, OFF_GN = 7200, D_IN = 8224;

constexpr size_t MiB = 1u << 20;
constexpr size_t WS_CTL = 0;
constexpr size_t WS_MOD = 1 * MiB;
constexpr size_t WS_RSTD = 1 * MiB + 512 * 1024;
constexpr size_t WS_DT = 2 * MiB;
constexpr size_t WS_WIN_T = 6 * MiB;
constexpr size_t WS_WG_T = 18 * MiB;
constexpr size_t WS_WDT_T = 22 * MiB;
constexpr size_t WS_KEYS = 22 * MiB + 512 * 1024;
constexpr size_t WS_WSSD_T = 23 * MiB, WS_WNA_T = 25 * MiB, WS_WOUT_T = 27 * MiB, WS_WPQ_T = 29 * MiB;
constexpr size_t WS_R0 = 40 * MiB, WS_R1 = 104 * MiB, WS_R2 = 168 * MiB, WS_R3 = 296 * MiB, WS_END = 488 * MiB;

constexpr int LDS_BYTES = 147456;

struct Args { const float* in[24]; float* out; unsigned char* ws; int ph_lo, ph_hi; };

__device__ __forceinline__ float bf2f(unsigned v) { return __uint_as_float(v << 16); }
__device__ __forceinline__ float bflo(unsigned v) { return __uint_as_float(v << 16); }
__device__ __forceinline__ float bfhi(unsigned v) { return __uint_as_float(v & 0xffff0000u); }
__device__ __forceinline__ unsigned f2bf(float f) { unsigned u = __float_as_uint(f); return (u + 0x7fffu + ((u >> 16) & 1u)) >> 16; }
typedef float f32x2_t __attribute__((ext_vector_type(2)));
__device__ __forceinline__ unsigned pk2(float lo, float hi) { f32x2_t v = {lo, hi}; bf16x2_t b = __builtin_convertvector(v, bf16x2_t); return __builtin_bit_cast(unsigned, b); }
__device__ __forceinline__ float wave_sum(float v) {
#pragma unroll
    for (int o = 1; o < 64; o <<= 1) v += __shfl_xor(v, o);
    return v;
}
__device__ __forceinline__ float silu_f(float x) { return x / (1.f + __expf(-x)); }
__device__ __forceinline__ float sigmoid_f(float x) { return 1.f / (1.f + __expf(-x)); }
__device__ __forceinline__ float softplus_f(float x) { return x > 20.f ? x : log1pf(__expf(x)); }
__device__ __forceinline__ float gelu_f(float x) { return 0.5f * x * (1.f + erff(x * 0.70710678118654752f)); }

struct Ctx {
    const float* const* in; float* out; unsigned char* ws;
    int tid, lane, wave, G, bid;
    LAS unsigned char* lds;
    __device__ __forceinline__ float* f32p(size_t off) const { return (float*)(ws + off); }
    __device__ __forceinline__ bf16_t* bfp(size_t off) const { return (bf16_t*)(ws + off); }
};

__device__ __forceinline__ void p_prep(const Ctx& C) {
    const int gt = C.bid * NTHR + C.tid, NT = C.G * NTHR;
    const float* c = C.in[1]; const float* w_ada = C.in[2]; const float* b_ada = C.in[3];
    float* mod = C.f32p(WS_MOD);
    for (int i = gt; i < NB * 6144; i += NT) {
        const int b = i / 6144, j = i % 6144; float acc = 0.f;
        for (int k = 0; k < D; ++k) acc += silu_f(c[b * D + k]) * w_ada[(size_t)k * 6144 + j];
        mod[i] = acc + b_ada[j];
    }
    const float* w_in = C.in[5];
    {
        bf16_t* wt = C.bfp(WS_WIN_T);
        for (int i = gt; i < 6144 * (D / 8); i += NT) { const int n = i % 6144, k8 = i / 6144; const int col = n < 3072 ? n : OFF_QKV + (n - 3072);
            u32x4 o; const float* s = w_in + (size_t)(k8 * 8) * D_IN + col;
            o.x = pk2(s[0], s[(size_t)D_IN]); o.y = pk2(s[2 * (size_t)D_IN], s[3 * (size_t)D_IN]); o.z = pk2(s[4 * (size_t)D_IN], s[5 * (size_t)D_IN]); o.w = pk2(s[6 * (size_t)D_IN], s[7 * (size_t)D_IN]);
            *(u32x4*)(wt + (size_t)n * D + k8 * 8) = o; }
    }
    {
        bf16_t* wt = C.bfp(WS_WG_T);
        for (int i = gt; i < 2048 * (D / 8); i += NT) { const int n = i % 2048, k8 = i / 2048; const int col = OFF_GS + n;
            u32x4 o; const float* s = w_in + (size_t)(k8 * 8) * D_IN + col;
            o.x = pk2(s[0], s[(size_t)D_IN]); o.y = pk2(s[2 * (size_t)D_IN], s[3 * (size_t)D_IN]); o.z = pk2(s[4 * (size_t)D_IN], s[5 * (size_t)D_IN]); o.w = pk2(s[6 * (size_t)D_IN], s[7 * (size_t)D_IN]);
            *(u32x4*)(wt + (size_t)n * D + k8 * 8) = o; }
    }
    {
        bf16_t* wt = C.bfp(WS_WDT_T);
        for (int i = gt; i < 32 * (D / 8); i += NT) { const int n = i % 32, k8 = i / 32; const int col = OFF_DTF + n;
            u32x4 o; const float* s = w_in + (size_t)(k8 * 8) * D_IN + col;
            o.x = pk2(s[0], s[(size_t)D_IN]); o.y = pk2(s[2 * (size_t)D_IN], s[3 * (size_t)D_IN]); o.z = pk2(s[4 * (size_t)D_IN], s[5 * (size_t)D_IN]); o.w = pk2(s[6 * (size_t)D_IN], s[7 * (size_t)D_IN]);
            *(u32x4*)(wt + (size_t)n * D + k8 * 8) = o; }
    }
    {
        const float* gk = C.in[13];
        const float* srcs[3] = {C.in[14], C.in[16], C.in[17]};
        const size_t dsts[3] = {WS_WSSD_T, WS_WNA_T, WS_WOUT_T};
#pragma unroll
        for (int w = 0; w < 3; ++w) {
            const float* W = srcs[w]; bf16_t* wt = C.bfp(dsts[w]);
            for (int i = gt; i < D * (D / 8); i += NT) { const int n = i % D, k8 = i / D; const float* s = W + (size_t)(k8 * 8) * D + n;
                float v[8];
#pragma unroll
                for (int q = 0; q < 8; ++q) v[q] = s[(size_t)q * D] * (w == 0 ? gk[k8 * 8 + q] : 1.f);
                u32x4 o; o.x = pk2(v[0], v[1]); o.y = pk2(v[2], v[3]); o.z = pk2(v[4], v[5]); o.w = pk2(v[6], v[7]);
                *(u32x4*)(wt + (size_t)n * D + k8 * 8) = o; }
        }
    }
    {
        const float* W = C.in[19]; bf16_t* wt = C.bfp(WS_WPQ_T);
        for (int i = gt; i < 2048 * (D / 8); i += NT) { const int n = i % 2048, k8 = i / 2048; const float* s = W + (size_t)(k8 * 8) * 2048 + n;
            u32x4 o; o.x = pk2(s[0], s[2048]); o.y = pk2(s[2 * 2048], s[3 * 2048]); o.z = pk2(s[4 * 2048], s[5 * 2048]); o.w = pk2(s[6 * 2048], s[7 * 2048]);
            *(u32x4*)(wt + (size_t)n * D + k8 * 8) = o; }
    }
    {
        const float* kf = C.in[20]; bf16_t* kb = C.bfp(WS_KEYS);
        for (int i = gt; i < 2 * 128 * 128; i += NT) kb[i] = (bf16_t)f2bf(kf[i]);
    }
}

__device__ __forceinline__ void p_rownorm(const Ctx& C, const float* X, const float* gamma, int sh_off, int sc_off, bf16_t* dst) {
    const float* mod = C.f32p(WS_MOD);
    const int gw = C.bid * NWAVES + C.wave, NGW = C.G * NWAVES;
    for (int row = gw; row < T; row += NGW) {
        const int b = row / SEQ;
        const f32x4* xr = (const f32x4*)(X + (size_t)row * D) + C.lane;
        f32x4 v[4]; float s = 0.f;
#pragma unroll
        for (int j = 0; j < 4; ++j) { v[j] = xr[64 * j]; s += (v[j].x * v[j].x + v[j].y * v[j].y) + (v[j].z * v[j].z + v[j].w * v[j].w); }
        const float rstd = rsqrtf(wave_sum(s) * (1.f / D) + EPS);
        u32x2* o8 = (u32x2*)(dst + (size_t)row * D) + C.lane;
#pragma unroll
        for (int j = 0; j < 4; ++j) {
            const int col = 4 * C.lane + 256 * j;
            const f32x4 g = *(const f32x4*)(gamma + col), sh = *(const f32x4*)(mod + b * 6144 + sh_off + col), sc = *(const f32x4*)(mod + b * 6144 + sc_off + col);
            f32x4 y = v[j] * rstd * g * (sc + 1.f) + sh;
            u32x2 w; w.x = pk2(y.x, y.y); w.y = pk2(y.z, y.w); o8[64 * j] = w;
        }
    }
}

template <class Epi>
__device__ __forceinline__ void naive_gemm(const Ctx& C, const bf16_t* A, const bf16_t* Bt, int M, int N, int K, const Epi& E) {
    LAS float* As = (LAS float*)C.lds;
    LAS float* Bs = (LAS float*)(C.lds + 32 * 132 * 4);
    const int tilesN = (N + 63) / 64, tilesM = M / 128, ntiles = tilesM * tilesN;
    const int ty = C.tid >> 4, tx = C.tid & 15;
    for (int tile = C.bid; tile < ntiles; tile += C.G) {
        const int tm = tile / tilesN, tn = tile % tilesN, m0 = tm * 128, n0 = tn * 64;
        float acc[4][4];
#pragma unroll
        for (int i = 0; i < 4; ++i)
#pragma unroll
            for (int j = 0; j < 4; ++j) acc[i][j] = 0.f;
        for (int k0 = 0; k0 < K; k0 += 32) {
            __syncthreads();
            {
                const int r = C.tid >> 2, kc = (C.tid & 3) * 8;
                const u32x4 v = *(const u32x4*)(A + (size_t)(m0 + r) * K + k0 + kc);
                As[(kc + 0) * 132 + r] = bflo(v.x); As[(kc + 1) * 132 + r] = bfhi(v.x); As[(kc + 2) * 132 + r] = bflo(v.y); As[(kc + 3) * 132 + r] = bfhi(v.y);
                As[(kc + 4) * 132 + r] = bflo(v.z); As[(kc + 5) * 132 + r] = bfhi(v.z); As[(kc + 6) * 132 + r] = bflo(v.w); As[(kc + 7) * 132 + r] = bfhi(v.w);
            }
            if (C.tid < 256) {
                const int r = C.tid >> 2, kc = (C.tid & 3) * 8;
                u32x4 v = (u32x4){0u, 0u, 0u, 0u};
                if (n0 + r < N) v = *(const u32x4*)(Bt + (size_t)(n0 + r) * K + k0 + kc);
                Bs[(kc + 0) * 68 + r] = bflo(v.x); Bs[(kc + 1) * 68 + r] = bfhi(v.x); Bs[(kc + 2) * 68 + r] = bflo(v.y); Bs[(kc + 3) * 68 + r] = bfhi(v.y);
                Bs[(kc + 4) * 68 + r] = bflo(v.z); Bs[(kc + 5) * 68 + r] = bfhi(v.z); Bs[(kc + 6) * 68 + r] = bflo(v.w); Bs[(kc + 7) * 68 + r] = bfhi(v.w);
            }
            __syncthreads();
#pragma unroll 8
            for (int k = 0; k < 32; ++k) {
                const f32x4 a = *(const LAS f32x4*)(As + k * 132 + ty * 4);
                const f32x4 b = *(const LAS f32x4*)(Bs + k * 68 + tx * 4);
#pragma unroll
                for (int i = 0; i < 4; ++i)
#pragma unroll
                    for (int j = 0; j < 4; ++j) acc[i][j] += a[i] * b[j];
            }
        }
#pragma unroll
        for (int i = 0; i < 4; ++i)
#pragma unroll
            for (int j = 0; j < 4; ++j) { const int col = n0 + tx * 4 + j; if (col < N) E(m0 + ty * 4 + i, col, acc[i][j]); }
    }
    __syncthreads();
}

struct EInProj { bf16_t *sz, *xbc, *q, *k, *v;
    __device__ __forceinline__ void operator()(int r, int c, float x) const {
        if (c < 1024) sz[(size_t)r * 1024 + c] = (bf16_t)f2bf(silu_f(x));
        else if (c < 3072) xbc[(size_t)r * 2048 + (c - 1024)] = (bf16_t)f2bf(x);
        else if (c < 4096) q[(size_t)r * 1024 + (c - 3072)] = (bf16_t)f2bf(x * 0.125f);
        else if (c < 5120) k[(size_t)r * 1024 + (c - 4096)] = (bf16_t)f2bf(x);
        else v[(size_t)r * 1024 + (c - 5120)] = (bf16_t)f2bf(x);
    } };
struct EDt { float* dt; const float *bf, *bb;
    __device__ __forceinline__ void operator()(int r, int c, float x) const { const float bias = c < 16 ? bf[c] : bb[c - 16]; dt[(size_t)r * 32 + c] = softplus_f(x + bias); } };
struct EGate { bf16_t* sg;
    __device__ __forceinline__ void operator()(int r, int c, float x) const { sg[(size_t)(c >> 10) * T * 1024 + (size_t)r * 1024 + (c & 1023)] = (bf16_t)f2bf(sigmoid_f(x)); } };
struct ED1 { bf16_t* p1; const bf16_t* sg1; const float* rstd;
    __device__ __forceinline__ void operator()(int r, int c, float x) const { const size_t i = (size_t)r * 1024 + c; p1[i] = (bf16_t)f2bf(x * rstd[r] * bf2f(sg1[i])); } };
struct ED2 { bf16_t* mixed; const bf16_t *p1, *sg2;
    __device__ __forceinline__ void operator()(int r, int c, float x) const { const size_t i = (size_t)r * 1024 + c; mixed[i] = (bf16_t)f2bf(bf2f(p1[i]) + bf2f(sg2[i]) * x); } };
struct ED3 { float* h; const float* x; const float* mod;
    __device__ __forceinline__ void operator()(int r, int c, float v) const { const size_t i = (size_t)r * 1024 + c; h[i] = x[i] + mod[(r / SEQ) * 6144 + 2048 + c] * v; } };
struct EQp { bf16_t* qp;
    __device__ __forceinline__ void operator()(int r, int c, float v) const { qp[(size_t)r * 2048 + c] = (bf16_t)f2bf(v); } };

__device__ __forceinline__ void p_conv(const Ctx& C, const bf16_t* xbc, bf16_t* xc) {
    const float* cw = C.in[6]; const float* cb = C.in[7];
    const int gt = C.bid * NTHR + C.tid, NT = C.G * NTHR;
    for (int i = gt; i < T * 256; i += NT) {
        const int t = i >> 8, cg = i & 255, l = t & (SEQ - 1), ch = cg * 8;
        float acc[8];
#pragma unroll
        for (int q = 0; q < 8; ++q) acc[q] = cb[ch + q];
#pragma unroll
        for (int j = 0; j < 5; ++j) {
            const int ll = l + j - 2;
            if (ll >= 0 && ll < SEQ) {
                const u32x4 v = *(const u32x4*)(xbc + (size_t)(t + j - 2) * 2048 + ch);
                const f32x4 w0 = *(const f32x4*)(cw + j * 2048 + ch), w1 = *(const f32x4*)(cw + j * 2048 + ch + 4);
                acc[0] += w0.x * bflo(v.x); acc[1] += w0.y * bfhi(v.x); acc[2] += w0.z * bflo(v.y); acc[3] += w0.w * bfhi(v.y);
                acc[4] += w1.x * bflo(v.z); acc[5] += w1.y * bfhi(v.z); acc[6] += w1.z * bflo(v.w); acc[7] += w1.w * bfhi(v.w);
            }
        }
        u32x4 o; o.x = pk2(silu_f(acc[0]), silu_f(acc[1])); o.y = pk2(silu_f(acc[2]), silu_f(acc[3])); o.z = pk2(silu_f(acc[4]), silu_f(acc[5])); o.w = pk2(silu_f(acc[6]), silu_f(acc[7]));
        *(u32x4*)(xc + (size_t)t * 2048 + ch) = o;
    }
}

__device__ __forceinline__ void p_ssd_naive(const Ctx& C, const bf16_t* xc, const float* dtb, bf16_t* yf, bf16_t* yb) {
    if (C.wave == 0)
    for (int unit = C.bid; unit < 256; unit += C.G) {
        const int dir = unit & 1, hd = (unit >> 1) & 15, b = unit >> 5, g = hd >> 2, p = C.lane;
        const float a = -__expf((dir ? C.in[11] : C.in[10])[hd]);
        const float dsk = C.in[12][hd];
        float h[128];
#pragma unroll
        for (int n = 0; n < 128; ++n) h[n] = 0.f;
        for (int s = 0; s < SEQ; ++s) {
#ifdef DIAG_LOCAL
            if ((s & 127) == 0) {
#pragma unroll
                for (int n = 0; n < 128; ++n) h[n] = 0.f; }
#endif
            const int t = dir ? (SEQ - 1 - s) : s; const size_t row = (size_t)b * SEQ + t;
            const float dt = dtb[row * 32 + dir * 16 + hd];
            const float dA = __expf(dt * a);
            const float x = bf2f(xc[row * 2048 + hd * 64 + p]);
            const float xdt = x * dt;
            const u32x4* Bp = (const u32x4*)(xc + row * 2048 + 1024 + g * 128);
            const u32x4* Cp = (const u32x4*)(xc + row * 2048 + 1536 + g * 128);
            float y = 0.f;
#pragma unroll
            for (int n8 = 0; n8 < 16; ++n8) {
                const u32x4 bv = Bp[n8], cv = Cp[n8];
                const float bb[8] = {bflo(bv.x), bfhi(bv.x), bflo(bv.y), bfhi(bv.y), bflo(bv.z), bfhi(bv.z), bflo(bv.w), bfhi(bv.w)};
                const float cc[8] = {bflo(cv.x), bfhi(cv.x), bflo(cv.y), bfhi(cv.y), bflo(cv.z), bfhi(cv.z), bflo(cv.w), bfhi(cv.w)};
#pragma unroll
                for (int q = 0; q < 8; ++q) { const int n = n8 * 8 + q; h[n] = dA * h[n] + xdt * bb[q]; y += cc[q] * h[n]; }
            }
            if (dir == 0) yf[row * 1024 + hd * 64 + p] = (bf16_t)f2bf(y + dsk * x);
            else yb[row * 1024 + hd * 64 + p] = (bf16_t)f2bf(y);
        }
    }
}


namespace ssd {
typedef short bf16x8 __attribute__((ext_vector_type(8)));
typedef short s16x4 __attribute__((ext_vector_type(4)));
constexpr int RS = 272, RSX = 144;
constexpr int CN = 0, BN = 34816, BS = 69632, SL = 104448, XN = 121856, CSB = 140288;
__device__ __forceinline__ bf16x8 trfrag(LAS unsigned char* base, int stride, int ks, int c, int g, int q, int pp) {
    LAS unsigned char* a0 = base + (32 * ks + 8 * g + q) * stride + 32 * c + 8 * pp;
    const s16x4 v0 = __builtin_amdgcn_ds_read_tr16_b64_v4i16((LAS s16x4*)a0);
    const s16x4 v1 = __builtin_amdgcn_ds_read_tr16_b64_v4i16((LAS s16x4*)(a0 + 4 * stride));
    bf16x8 r; r[0] = v0[0]; r[1] = v0[1]; r[2] = v0[2]; r[3] = v0[3]; r[4] = v1[0]; r[5] = v1[1]; r[6] = v1[2]; r[7] = v1[3]; return r;
}
__device__ __forceinline__ unsigned pkbf(float lo, float hi) { return pk2(lo, hi); }
}
__device__ __forceinline__ void p_ssd(const Ctx& C, const bf16_t* xc, const float* dtb, bf16_t* yf, bf16_t* yb) {
    using namespace ssd;
    LAS unsigned char* L = C.lds;
    const int tid = C.tid, lane = C.lane, w = C.wave, g = lane >> 4, i16 = lane & 15, q = (lane >> 2) & 3, pp = lane & 3;
    for (int unit = C.bid; unit < 256; unit += C.G) {
        const int dir = unit & 1, hd = (unit >> 1) & 15, b = unit >> 5, grp = hd >> 2;
        const float a = -__expf((dir ? C.in[11] : C.in[10])[hd]);
        const float dsk = dir ? 0.f : C.in[12][hd];
        bf16_t* yout = dir ? yb : yf;
        f32x4 sacc[4];
#pragma unroll
        for (int pt = 0; pt < 4; ++pt) sacc[pt] = (f32x4){0.f, 0.f, 0.f, 0.f};
        __syncthreads();
        for (int i = tid; i < 17408 / 4; i += NTHR) ((LAS unsigned*)(L + SL))[i] = 0u;
        u32x4 pfC[4], pfB[4], pfX[2]; float pfd0 = 0.f, pfd1 = 0.f;
#define SSD_ISSUE(ci_) do { const int c_ = dir ? (31 - (ci_)) : (ci_); const size_t t0_ = (size_t)b * SEQ + (size_t)c_ * 128; \
            _Pragma("unroll") for (int i_ = 0; i_ < 4; ++i_) { const int idx_ = tid + NTHR * i_, l_ = idx_ >> 4, cc_ = idx_ & 15; const bf16_t* rp_ = xc + (t0_ + l_) * 2048 + grp * 128 + cc_ * 8; \
                pfB[i_] = *(const u32x4*)(rp_ + 1024); pfC[i_] = *(const u32x4*)(rp_ + 1536); } \
            _Pragma("unroll") for (int i_ = 0; i_ < 2; ++i_) { const int idx_ = tid + NTHR * i_, l_ = idx_ >> 3, cc_ = idx_ & 7; pfX[i_] = *(const u32x4*)(xc + (t0_ + l_) * 2048 + hd * 64 + cc_ * 8); } \
            if (w == 0) { const int l0_ = dir ? (127 - 2 * lane) : (2 * lane), l1_ = dir ? (126 - 2 * lane) : (2 * lane + 1); \
                pfd0 = dtb[(t0_ + l0_) * 32 + dir * 16 + hd]; pfd1 = dtb[(t0_ + l1_) * 32 + dir * 16 + hd]; } } while (0)
#define SSD_SCAN(buf_) do { if (w == 0) { const float da0_ = pfd0 * a, da1_ = pfd1 * a; const float p1_ = da0_ + da1_; float s_ = p1_; \
            _Pragma("unroll") for (int o_ = 1; o_ < 64; o_ <<= 1) { const float t_ = __shfl_up(s_, o_); if (lane >= o_) s_ += t_; } \
            const float ex_ = s_ - p1_, cs0_ = ex_ + da0_, cs1_ = ex_ + p1_, tot_ = __shfl(s_, 63); \
            const int l0_ = dir ? (127 - 2 * lane) : (2 * lane), l1_ = dir ? (126 - 2 * lane) : (2 * lane + 1); \
            LAS float* cb_ = (LAS float*)(L + CSB + (buf_) * 1536); \
            cb_[l0_] = cs0_; cb_[l1_] = cs1_; cb_[128 + l0_] = pfd0; cb_[128 + l1_] = pfd1; cb_[256 + l0_] = pfd0 * __expf(tot_ - cs0_); cb_[256 + l1_] = pfd1 * __expf(tot_ - cs1_); \
            if (lane == 0) *(LAS float*)(L + CSB + 3072 + 8 * (buf_)) = tot_; } } while (0)
#define SSD_WRITE(buf_) do { const LAS float* dw_ = (const LAS float*)(L + CSB + (buf_) * 1536 + 1024); \
            _Pragma("unroll") for (int i_ = 0; i_ < 4; ++i_) { const int idx_ = tid + NTHR * i_, l_ = idx_ >> 4, cc_ = idx_ & 15; \
                *(LAS u32x4*)(L + CN + l_ * RS + cc_ * 16) = pfC[i_]; *(LAS u32x4*)(L + BN + l_ * RS + cc_ * 16) = pfB[i_]; \
                const float sc_ = dw_[l_]; const u32x4 v_ = pfB[i_]; u32x4 o_; \
                o_.x = pkbf(bflo(v_.x) * sc_, bfhi(v_.x) * sc_); o_.y = pkbf(bflo(v_.y) * sc_, bfhi(v_.y) * sc_); o_.z = pkbf(bflo(v_.z) * sc_, bfhi(v_.z) * sc_); o_.w = pkbf(bflo(v_.w) * sc_, bfhi(v_.w) * sc_); \
                *(LAS u32x4*)(L + BS + l_ * RS + cc_ * 16) = o_; } \
            _Pragma("unroll") for (int i_ = 0; i_ < 2; ++i_) { const int idx_ = tid + NTHR * i_, l_ = idx_ >> 3, cc_ = idx_ & 7; *(LAS u32x4*)(L + XN + l_ * RSX + cc_ * 16) = pfX[i_]; } } while (0)
        SSD_ISSUE(0);
        SSD_SCAN(0);
        __syncthreads();
        SSD_WRITE(0);
        __syncthreads();
        for (int ci = 0; ci < 32; ++ci) {
            const int buf = ci & 1;
            const int c = dir ? (31 - ci) : ci; const size_t t0 = (size_t)b * SEQ + (size_t)c * 128;
            if (ci + 1 < 32) SSD_ISSUE(ci + 1);
            const LAS float* csb = (const LAS float*)(L + CSB + buf * 1536);
            const float cs_l = csb[16 * w + i16];
            const float cs_end = *(const LAS float*)(L + CSB + 3072 + 8 * buf);
            bf16x8 cfrag[4];
#pragma unroll
            for (int ks = 0; ks < 4; ++ks) cfrag[ks] = *(const LAS bf16x8*)(L + CN + (16 * w + i16) * RS + ks * 64 + g * 16);
            u32x2 mreg[8];
            const int lrow = 16 * w + i16;
#pragma unroll
            for (int st = 0; st < 8; ++st) {
                f32x4 acc = (f32x4){0.f, 0.f, 0.f, 0.f};
#pragma unroll
                for (int ks = 0; ks < 4; ++ks) { const bf16x8 af = *(const LAS bf16x8*)(L + BN + (16 * st + i16) * RS + ks * 64 + g * 16);
                    acc = __builtin_amdgcn_mfma_f32_16x16x32_bf16(af, cfrag[ks], acc, 0, 0, 0); }
                const f32x4 cs_s = *(const LAS f32x4*)(csb + 16 * st + 4 * g), dt_s = *(const LAS f32x4*)(csb + 128 + 16 * st + 4 * g);
                float mv[4];
#pragma unroll
                for (int r = 0; r < 4; ++r) { const int srow = 16 * st + 4 * g + r; const bool valid = dir ? (srow >= lrow) : (srow <= lrow);
                    const float e = valid ? __expf(cs_l - cs_s[r]) : 0.f; mv[r] = acc[r] * dt_s[r] * e; }
                mreg[st].x = pkbf(mv[0], mv[1]); mreg[st].y = pkbf(mv[2], mv[3]);
            }
            f32x4 yacc[4];
            const float el = __expf(cs_l);
#pragma unroll
            for (int pt = 0; pt < 4; ++pt) { f32x4 acc = (f32x4){0.f, 0.f, 0.f, 0.f};
#pragma unroll
                for (int ks = 0; ks < 4; ++ks) { const bf16x8 af = *(const LAS bf16x8*)(L + SL + (16 * pt + i16) * RS + ks * 64 + g * 16);
                    acc = __builtin_amdgcn_mfma_f32_16x16x32_bf16(af, cfrag[ks], acc, 0, 0, 0); }
                yacc[pt] = acc * el; }
            __syncthreads();
#pragma unroll
            for (int st = 0; st < 8; ++st) *(LAS u32x2*)(L + BN + lrow * RS + 32 * st + 8 * g) = mreg[st];
            __syncthreads();
#pragma unroll
            for (int ks = 0; ks < 4; ++ks) { const bf16x8 mf = *(const LAS bf16x8*)(L + BN + lrow * RS + ks * 64 + g * 16);
#pragma unroll
                for (int pt = 0; pt < 4; ++pt) { const bf16x8 xf = trfrag(L + XN, RSX, ks, pt, g, q, pp); yacc[pt] = __builtin_amdgcn_mfma_f32_16x16x32_bf16(xf, mf, yacc[pt], 0, 0, 0); } }
#pragma unroll
            for (int pt = 0; pt < 4; ++pt) { const u32x2 xv = *(const LAS u32x2*)(L + XN + lrow * RSX + (16 * pt + 4 * g) * 2);
                u32x2 o; o.x = pkbf(yacc[pt][0] + dsk * bflo(xv.x), yacc[pt][1] + dsk * bfhi(xv.x)); o.y = pkbf(yacc[pt][2] + dsk * bflo(xv.y), yacc[pt][3] + dsk * bfhi(xv.y));
                *(u32x2*)(yout + (t0 + lrow) * 1024 + hd * 64 + 16 * pt + 4 * g) = o; }
            { const float dec = __expf(cs_end);
#pragma unroll
              for (int pt = 0; pt < 4; ++pt) sacc[pt] = sacc[pt] * dec; }
#pragma unroll
            for (int ks = 0; ks < 4; ++ks) { const bf16x8 bf = trfrag(L + BS, RS, ks, w, g, q, pp);
#pragma unroll
                for (int pt = 0; pt < 4; ++pt) { const bf16x8 xf = trfrag(L + XN, RSX, ks, pt, g, q, pp); sacc[pt] = __builtin_amdgcn_mfma_f32_16x16x32_bf16(bf, xf, sacc[pt], 0, 0, 0); } }
#ifdef DIAG_LOCAL
#pragma unroll
            for (int pt = 0; pt < 4; ++pt) sacc[pt] = (f32x4){0.f, 0.f, 0.f, 0.f};
#endif
#pragma unroll
            for (int pt = 0; pt < 4; ++pt) { u32x2 o; o.x = pkbf(sacc[pt][0], sacc[pt][1]); o.y = pkbf(sacc[pt][2], sacc[pt][3]);
                *(LAS u32x2*)(L + SL + (16 * pt + i16) * RS + (16 * w + 4 * g) * 2) = o; }
            if (ci + 1 < 32) SSD_SCAN(buf ^ 1);
            __syncthreads();
            if (ci + 1 < 32) SSD_WRITE(buf ^ 1);
            __syncthreads();
        }
#undef SSD_ISSUE
#undef SSD_SCAN
#undef SSD_WRITE
    }
}

__device__ __forceinline__ void p_na_naive(const Ctx& C, bf16_t* q, const bf16_t* k, const bf16_t* v) {
    const float* rpb = C.in[15];
    const int gt = C.bid * NTHR + C.tid, NT = C.G * NTHR;
    for (int i = gt; i < T * 16; i += NT) {
        const int hh = i & 15, tok = i >> 4, b = tok >> 12, l = tok & 4095, r = l >> 6, col = l & 63;
        int rs = r - 4; rs = rs < 0 ? 0 : (rs > 56 ? 56 : rs);
        int wsx = col - 8; wsx = wsx < 0 ? 0 : (wsx > 48 ? 48 : wsx);
        float qv[64], o[64];
        {
            const u32x4* qp = (const u32x4*)(q + (size_t)tok * 1024 + hh * 64);
#pragma unroll
            for (int d8 = 0; d8 < 8; ++d8) { const u32x4 w = qp[d8]; qv[d8 * 8 + 0] = bflo(w.x); qv[d8 * 8 + 1] = bfhi(w.x); qv[d8 * 8 + 2] = bflo(w.y); qv[d8 * 8 + 3] = bfhi(w.y);
                qv[d8 * 8 + 4] = bflo(w.z); qv[d8 * 8 + 5] = bfhi(w.z); qv[d8 * 8 + 6] = bflo(w.w); qv[d8 * 8 + 7] = bfhi(w.w); }
        }
#pragma unroll
        for (int d = 0; d < 64; ++d) o[d] = 0.f;
        float m = -1e30f, lsum = 0.f;
        for (int ii = 0; ii < 8; ++ii)
            for (int jj = 0; jj < 16; ++jj) {
                const int kr = rs + ii, kc = wsx + jj; const size_t kt = (size_t)b * SEQ + kr * 64 + kc;
                const u32x4* kp = (const u32x4*)(k + kt * 1024 + hh * 64);
                float s = 0.f;
#pragma unroll
                for (int d8 = 0; d8 < 8; ++d8) { const u32x4 w = kp[d8];
                    s += qv[d8 * 8 + 0] * bflo(w.x) + qv[d8 * 8 + 1] * bfhi(w.x) + qv[d8 * 8 + 2] * bflo(w.y) + qv[d8 * 8 + 3] * bfhi(w.y)
                       + qv[d8 * 8 + 4] * bflo(w.z) + qv[d8 * 8 + 5] * bfhi(w.z) + qv[d8 * 8 + 6] * bflo(w.w) + qv[d8 * 8 + 7] * bfhi(w.w); }
                s += rpb[hh * 15 * 31 + (kr - r + 7) * 31 + (kc - col + 15)];
                const float mn = fmaxf(m, s), al = __expf(m - mn), pe = __expf(s - mn);
                lsum = lsum * al + pe; m = mn;
                const u32x4* vp = (const u32x4*)(v + kt * 1024 + hh * 64);
#pragma unroll
                for (int d8 = 0; d8 < 8; ++d8) { const u32x4 w = vp[d8];
                    o[d8 * 8 + 0] = o[d8 * 8 + 0] * al + pe * bflo(w.x); o[d8 * 8 + 1] = o[d8 * 8 + 1] * al + pe * bfhi(w.x);
                    o[d8 * 8 + 2] = o[d8 * 8 + 2] * al + pe * bflo(w.y); o[d8 * 8 + 3] = o[d8 * 8 + 3] * al + pe * bfhi(w.y);
                    o[d8 * 8 + 4] = o[d8 * 8 + 4] * al + pe * bflo(w.z); o[d8 * 8 + 5] = o[d8 * 8 + 5] * al + pe * bfhi(w.z);
                    o[d8 * 8 + 6] = o[d8 * 8 + 6] * al + pe * bflo(w.w); o[d8 * 8 + 7] = o[d8 * 8 + 7] * al + pe * bfhi(w.w); }
            }
        const float inv = 1.f / lsum;
        u32x4* op = (u32x4*)(q + (size_t)tok * 1024 + hh * 64);
#pragma unroll
        for (int d8 = 0; d8 < 8; ++d8) { u32x4 w; w.x = pk2(o[d8 * 8 + 0] * inv, o[d8 * 8 + 1] * inv); w.y = pk2(o[d8 * 8 + 2] * inv, o[d8 * 8 + 3] * inv);
            w.z = pk2(o[d8 * 8 + 4] * inv, o[d8 * 8 + 5] * inv); w.w = pk2(o[d8 * 8 + 6] * inv, o[d8 * 8 + 7] * inv); op[d8] = w; }
    }
}


namespace nat {
typedef short bf16x8 __attribute__((ext_vector_type(8)));
typedef short s16x4 __attribute__((ext_vector_type(4)));
constexpr int VH = 65536, RPB = 131072;
__device__ __forceinline__ int voff(int ks, int d) { return ks * 128 + ((((d >> 3) ^ (ks & 7))) << 4) + (d & 7) * 2; }
__device__ __forceinline__ int clampi(int x, int lo, int hi) { return x < lo ? lo : (x > hi ? hi : x); }
}
__device__ __forceinline__ void p_na(const Ctx& C, bf16_t* q, const bf16_t* k, const bf16_t* v) {
    using namespace nat;
    LAS unsigned char* L = C.lds;
    const float* rpb = C.in[15];
    const int tid = C.tid, lane = C.lane, w = C.wave, g = lane >> 4, i16 = lane & 15, qq = (lane >> 2) & 3, pp = lane & 3;
    const int hl = w >> 2, m = w & 3;
    const int bs = (m == 0) ? 0 : (m == 1) ? 8 : (m == 2) ? 24 : 32;
    const int qc = 16 * m + i16, wsx = clampi(qc - 8, 0, 48);
    unsigned vmask = 0u; int dcol[8];
#pragma unroll
    for (int c = 0; c < 8; ++c) { const int kc = bs + (c >> 2) * 16 + 4 * g + (c & 3); if (kc >= wsx && kc < wsx + 16) vmask |= (1u << c); dcol[c] = clampi(kc - qc + 15, 0, 30); }
    for (int unit = C.bid; unit < 256; unit += C.G) {
        const int rseg = unit & 3, hp = (unit >> 2) & 7, b = unit >> 5, h = 2 * hp + hl;
        __syncthreads();
        for (int i = tid; i < 930; i += NTHR) ((LAS float*)(L + RPB))[i] = rpb[(2 * hp) * 465 + i];
#define NA_LOAD_ROW(row_) do { _Pragma("unroll") for (int i_ = 0; i_ < 2; ++i_) { const int idx_ = tid + NTHR * i_, hl_ = idx_ >> 9, col_ = (idx_ >> 3) & 63, dch_ = idx_ & 7; \
            const u32x4 val_ = *(const u32x4*)(v + ((size_t)b * SEQ + (size_t)(row_) * 64 + col_) * 1024 + (2 * hp + hl_) * 64 + dch_ * 8); \
            *(LAS u32x4*)(L + hl_ * VH + voff(((row_) & 7) * 64 + col_, dch_ * 8)) = val_; } } while (0)
        const int r0 = 16 * rseg; int rs_prev = clampi(r0 - 4, 0, 56);
        for (int rr = 0; rr < 8; ++rr) NA_LOAD_ROW(rs_prev + rr);
        __syncthreads();
        const LAS float* rpbl = (const LAS float*)(L + RPB) + hl * 465;
        for (int s = 0; s < 16; ++s) {
            const int r = r0 + s, rs = clampi(r - 4, 0, 56);
            if (rs != rs_prev) { __syncthreads(); NA_LOAD_ROW(rs + 7); __syncthreads(); rs_prev = rs; }
            const size_t tokq = (size_t)b * SEQ + (size_t)r * 64 + qc;
            bf16x8 qf[2];
#pragma unroll
            for (int ks = 0; ks < 2; ++ks) qf[ks] = *(const bf16x8*)(q + tokq * 1024 + h * 64 + ks * 32 + g * 8);
            f32x4 sc[16];
#pragma unroll
            for (int kt = 0; kt < 16; ++kt) { const size_t tokk = (size_t)b * SEQ + (size_t)(rs + (kt >> 1)) * 64 + bs + (kt & 1) * 16 + i16;
                f32x4 acc = (f32x4){0.f, 0.f, 0.f, 0.f};
#pragma unroll
                for (int ks = 0; ks < 2; ++ks) { const bf16x8 kf = *(const bf16x8*)(k + tokk * 1024 + h * 64 + ks * 32 + g * 8); acc = __builtin_amdgcn_mfma_f32_16x16x32_bf16(kf, qf[ks], acc, 0, 0, 0); }
                sc[kt] = acc; }
            float mx = -1.0e30f;
#pragma unroll
            for (int kt = 0; kt < 16; ++kt) { const int drow = rs + (kt >> 1) - r + 7;
#pragma unroll
                for (int e = 0; e < 4; ++e) { const int c = (kt & 1) * 4 + e; const float bias = rpbl[drow * 31 + dcol[c]];
                    const float val = ((vmask >> c) & 1u) ? sc[kt][e] + bias : -1.0e30f; sc[kt][e] = val; mx = fmaxf(mx, val); } }
            mx = fmaxf(mx, __shfl_xor(mx, 16)); mx = fmaxf(mx, __shfl_xor(mx, 32));
            float sum = 0.f;
#pragma unroll
            for (int kt = 0; kt < 16; ++kt)
#pragma unroll
                for (int e = 0; e < 4; ++e) { const float p = __expf(sc[kt][e] - mx); sc[kt][e] = p; sum += p; }
            sum += __shfl_xor(sum, 16); sum += __shfl_xor(sum, 32);
            f32x4 o[4];
#pragma unroll
            for (int dt = 0; dt < 4; ++dt) o[dt] = (f32x4){0.f, 0.f, 0.f, 0.f};
#pragma unroll
            for (int kk = 0; kk < 8; ++kk) {
                u32x4 pw; pw.x = pk2(sc[2 * kk][0], sc[2 * kk][1]); pw.y = pk2(sc[2 * kk][2], sc[2 * kk][3]); pw.z = pk2(sc[2 * kk + 1][0], sc[2 * kk + 1][1]); pw.w = pk2(sc[2 * kk + 1][2], sc[2 * kk + 1][3]);
                const bf16x8 pf = __builtin_bit_cast(bf16x8, pw);
                const int ks0 = ((rs + kk) & 7) * 64 + bs + 4 * g + qq, ks1 = ks0 + 16;
#pragma unroll
                for (int dt = 0; dt < 4; ++dt) {
                    const s16x4 v0 = __builtin_amdgcn_ds_read_tr16_b64_v4i16((LAS s16x4*)(L + hl * VH + voff(ks0, 16 * dt + 4 * pp)));
                    const s16x4 v1 = __builtin_amdgcn_ds_read_tr16_b64_v4i16((LAS s16x4*)(L + hl * VH + voff(ks1, 16 * dt + 4 * pp)));
                    bf16x8 vf; vf[0] = v0[0]; vf[1] = v0[1]; vf[2] = v0[2]; vf[3] = v0[3]; vf[4] = v1[0]; vf[5] = v1[1]; vf[6] = v1[2]; vf[7] = v1[3];
                    o[dt] = __builtin_amdgcn_mfma_f32_16x16x32_bf16(vf, pf, o[dt], 0, 0, 0); }
            }
            const float inv = 1.f / sum;
#pragma unroll
            for (int dt = 0; dt < 4; ++dt) { u32x2 ov; ov.x = pk2(o[dt][0] * inv, o[dt][1] * inv); ov.y = pk2(o[dt][2] * inv, o[dt][3] * inv);
                *(u32x2*)(q + tokq * 1024 + h * 64 + 16 * dt + 4 * g) = ov; }
        }
#undef NA_LOAD_ROW
    }
    __syncthreads();
}

__device__ __forceinline__ void p_combine(const Ctx& C, const bf16_t* yf, const bf16_t* yb, bf16_t* szu, float* rstd) {
    const int gw = C.bid * NWAVES + C.wave, NGW = C.G * NWAVES;
    for (int row = gw; row < T; row += NGW) {
        const size_t base = (size_t)row * 1024;
        float s = 0.f; u32x4 outv[2];
#pragma unroll
        for (int j = 0; j < 2; ++j) {
            const size_t off = base + j * 512 + C.lane * 8;
            const u32x4 a = *(const u32x4*)(yf + off), b = *(const u32x4*)(yb + off), z = *(const u32x4*)(szu + off);
            float u[8];
            u[0] = (bflo(a.x) + bflo(b.x)) * bflo(z.x); u[1] = (bfhi(a.x) + bfhi(b.x)) * bfhi(z.x);
            u[2] = (bflo(a.y) + bflo(b.y)) * bflo(z.y); u[3] = (bfhi(a.y) + bfhi(b.y)) * bfhi(z.y);
            u[4] = (bflo(a.z) + bflo(b.z)) * bflo(z.z); u[5] = (bfhi(a.z) + bfhi(b.z)) * bfhi(z.z);
            u[6] = (bflo(a.w) + bflo(b.w)) * bflo(z.w); u[7] = (bfhi(a.w) + bfhi(b.w)) * bfhi(z.w);
#pragma unroll
            for (int q = 0; q < 8; ++q) s += u[q] * u[q];
            outv[j].x = pk2(u[0], u[1]); outv[j].y = pk2(u[2], u[3]); outv[j].z = pk2(u[4], u[5]); outv[j].w = pk2(u[6], u[7]);
        }
        s = wave_sum(s);
#pragma unroll
        for (int j = 0; j < 2; ++j) *(u32x4*)(szu + base + j * 512 + C.lane * 8) = outv[j];
        if (C.lane == 0) rstd[row] = rsqrtf(s * (1.f / 1024.f) + EPS);
    }
}

__device__ __forceinline__ void p_cvt_tables(const Ctx& C, bf16_t* ub, bf16_t* vb) {
    const int gt = C.bid * NTHR + C.tid, NT = C.G * NTHR;
    const float* u = C.in[21]; const float* v = C.in[22];
    for (int i = gt; i < 16384 * 1024 / 8; i += NT) {
        const f32x4 a0 = *(const f32x4*)(u + (size_t)i * 8), a1 = *(const f32x4*)(u + (size_t)i * 8 + 4);
        u32x4 o; o.x = pk2(a0.x, a0.y); o.y = pk2(a0.z, a0.w); o.z = pk2(a1.x, a1.y); o.w = pk2(a1.z, a1.w);
        *(u32x4*)(ub + (size_t)i * 8) = o;
        const f32x4 b0 = *(const f32x4*)(v + (size_t)i * 8), b1 = *(const f32x4*)(v + (size_t)i * 8 + 4);
        u32x4 p; p.x = pk2(b0.x, b0.y); p.y = pk2(b0.z, b0.w); p.z = pk2(b1.x, b1.y); p.w = pk2(b1.z, b1.w);
        *(u32x4*)(vb + (size_t)i * 8) = p;
    }
}

__device__ __forceinline__ void p_topk_naive(const Ctx& C, const bf16_t* qp, const bf16_t* keys, unsigned short* pidx, float* pgate) {
    constexpr int NTK = 64;
    LAS float* S = (LAS float*)C.lds;
    LAS float* TV = (LAS float*)(C.lds + 256 * NTK * 4);
    LAS int* TI = (LAS int*)(C.lds + 256 * NTK * 4 + 32 * NTK * 4);
    const int tl = C.tid;
    if (C.tid < 64)
    for (int item = C.bid * NTK + tl; item < T * 8; item += C.G * NTK) {
        const int t = item >> 3, hh = item & 7;
        for (int z = 0; z < 2; ++z) {
            unsigned qv[64];
            const u32x4* qptr = (const u32x4*)(qp + (size_t)t * 2048 + hh * 256 + z * 128);
#pragma unroll
            for (int d8 = 0; d8 < 16; ++d8) { const u32x4 w = qptr[d8]; qv[d8 * 4 + 0] = w.x; qv[d8 * 4 + 1] = w.y; qv[d8 * 4 + 2] = w.z; qv[d8 * 4 + 3] = w.w; }
            for (int n = 0; n < 128; ++n) {
                const u32x4* kp = (const u32x4*)(keys + (size_t)(z * 128 + n) * 128);
                float acc = 0.f;
#pragma unroll
                for (int d8 = 0; d8 < 16; ++d8) { const u32x4 w = kp[d8];
                    acc += bflo(qv[d8 * 4 + 0]) * bflo(w.x) + bfhi(qv[d8 * 4 + 0]) * bfhi(w.x) + bflo(qv[d8 * 4 + 1]) * bflo(w.y) + bfhi(qv[d8 * 4 + 1]) * bfhi(w.y)
                         + bflo(qv[d8 * 4 + 2]) * bflo(w.z) + bfhi(qv[d8 * 4 + 2]) * bfhi(w.z) + bflo(qv[d8 * 4 + 3]) * bflo(w.w) + bfhi(qv[d8 * 4 + 3]) * bfhi(w.w); }
                S[(z * 128 + n) * NTK + tl] = acc;
            }
            float pv = 3.0e38f; int pi = -1;
            for (int r = 0; r < 16; ++r) {
                float best = -3.0e38f; int bi = 0;
                for (int n = 0; n < 128; ++n) { const float x = S[(z * 128 + n) * NTK + tl];
                    const bool elig = (x < pv) || (x == pv && n > pi);
                    if (elig && x > best) { best = x; bi = n; } }
                TV[(z * 16 + r) * NTK + tl] = best; TI[(z * 16 + r) * NTK + tl] = bi; pv = best; pi = bi;
            }
        }
        float pv = 3.0e38f; int pi = -1; float top[16]; int ei[16];
#pragma unroll
        for (int r = 0; r < 16; ++r) {
            float best = -3.0e38f; int bi = 0;
            for (int c = 0; c < 256; ++c) { const float x = TV[(c >> 4) * NTK + tl] + TV[(16 + (c & 15)) * NTK + tl];
                const bool elig = (x < pv) || (x == pv && c > pi);
                if (elig && x > best) { best = x; bi = c; } }
            top[r] = best; ei[r] = TI[(bi >> 4) * NTK + tl] * 128 + TI[(16 + (bi & 15)) * NTK + tl]; pv = best; pi = bi;
        }
        float den = 0.f, e[16];
#pragma unroll
        for (int r = 0; r < 16; ++r) { e[r] = __expf(top[r] - top[0]); den += e[r]; }
        const float inv = 1.f / den;
#pragma unroll
        for (int r = 0; r < 16; ++r) { pidx[(size_t)t * 128 + hh * 16 + r] = (unsigned short)ei[r]; pgate[(size_t)t * 128 + hh * 16 + r] = e[r] * inv; }
    }
}


namespace tk {
typedef short bf16x8 __attribute__((ext_vector_type(8)));
constexpr int RSK = 272, TAB = 69632, TABW = 33 * 16 * 4, IJT = TAB + 8 * TABW;
__device__ __forceinline__ void ce(float& a, float& b) { const float hi = __builtin_fmaxf(a, b), lo = __builtin_fminf(a, b); a = hi; b = lo; }
__device__ __forceinline__ void sort16(float (&v)[16]) {
#pragma unroll
    for (int k = 2; k <= 16; k <<= 1)
#pragma unroll
        for (int j = k >> 1; j > 0; j >>= 1)
#pragma unroll
            for (int i = 0; i < 16; ++i) { const int l = i ^ j; if (l > i) { if ((i & k) == 0) ce(v[i], v[l]); else ce(v[l], v[i]); } }
}
__device__ __forceinline__ void merge16(float (&a)[16], const float (&b)[16]) {
#pragma unroll
    for (int i = 0; i < 16; ++i) a[i] = __builtin_fmaxf(a[i], b[15 - i]);
#pragma unroll
    for (int j = 8; j > 0; j >>= 1)
#pragma unroll
        for (int i = 0; i < 16; ++i) { const int l = i ^ j; if (l > i) ce(a[i], a[l]); }
}
__device__ __forceinline__ void xmerge(float (&a)[16], int mask) { float b[16];
#pragma unroll
    for (int i = 0; i < 16; ++i) b[i] = __shfl_xor(a[i], mask);
    merge16(a, b); }
}
__device__ __forceinline__ void p_topk(const Ctx& C, const bf16_t* qp, const bf16_t* keys, unsigned short* pidx, float* pgate) {
    using namespace tk;
    LAS unsigned char* L = C.lds;
    const int tid = C.tid, lane = C.lane, w = C.wave, g = lane >> 4, i16 = lane & 15;
    __syncthreads();
    for (int i = tid; i < 4096; i += NTHR) { const int r = i >> 4, cc = i & 15; *(LAS u32x4*)(L + r * RSK + cc * 16) = *(const u32x4*)(keys + (size_t)r * 128 + cc * 8); }
    if (tid < 64) { int cnt = 0, fi = 0, fj = 0;
        for (int i = 0; i < 16; ++i) for (int j = 0; j < 16; ++j) if ((i + 1) * (j + 1) <= 16) { if (cnt == tid) { fi = i; fj = j; } ++cnt; }
        ((LAS unsigned*)(L + IJT))[tid] = (unsigned)(fi | (fj << 4)); }
    __syncthreads();
    LAS unsigned* tab = (LAS unsigned*)(L + TAB + w * TABW) + i16 * 33;
    const LAS unsigned* ijt = (const LAS unsigned*)(L + IJT);
    const float NEGV = -1.0e30f;
    const int gw = C.bid * NWAVES + w, NGW = C.G * NWAVES;
    for (int unit = gw; unit < (T / 16) * 8; unit += NGW) {
        const int tg = unit >> 3, hh = unit & 7; const size_t t0 = (size_t)tg * 16;
        float s1[16], s2[16];
#pragma unroll
        for (int z = 0; z < 2; ++z) {
            bf16x8 qf[4];
#pragma unroll
            for (int ks = 0; ks < 4; ++ks) qf[ks] = *(const bf16x8*)(qp + (t0 + i16) * 2048 + hh * 256 + z * 128 + ks * 32 + g * 8);
            float lo[16], hi[16];
#pragma unroll
            for (int nt = 0; nt < 8; ++nt) { f32x4 acc = (f32x4){0.f, 0.f, 0.f, 0.f};
#pragma unroll
                for (int ks = 0; ks < 4; ++ks) { const bf16x8 kf = *(const LAS bf16x8*)(L + (z * 128 + 16 * nt + i16) * RSK + ks * 64 + g * 16);
                    acc = __builtin_amdgcn_mfma_f32_16x16x32_bf16(kf, qf[ks], acc, 0, 0, 0); }
#pragma unroll
                for (int r = 0; r < 4; ++r) { const float pv = __uint_as_float((__float_as_uint(acc[r]) & 0xFFFFFF80u) | (unsigned)(16 * nt + 4 * g + r));
                    if (nt < 4) lo[nt * 4 + r] = pv; else hi[(nt - 4) * 4 + r] = pv; } }
            sort16(lo); sort16(hi); merge16(lo, hi);
            xmerge(lo, 16); xmerge(lo, 32);
#pragma unroll
            for (int i = 0; i < 16; ++i) { if (z == 0) s1[i] = lo[i]; else s2[i] = lo[i]; }
        }
#pragma unroll
        for (int i = 0; i < 16; ++i) { tab[i] = __float_as_uint(s1[i]); tab[16 + i] = __float_as_uint(s2[i]); }
        float cand[16];
            { const float a_ = (g == 0 ? s1[0] : g == 1 ? s1[1] : g == 2 ? s1[3] : s1[14]), b_ = (g == 0 ? s2[0] : g == 1 ? s2[0] : g == 2 ? s2[3] : s2[0]); cand[0] = __uint_as_float((__float_as_uint(a_ + b_) & 0xFFFFFFC0u) | (unsigned)(16 * g + 0)); }
            { const float a_ = (g == 0 ? s1[0] : g == 1 ? s1[1] : g == 2 ? s1[4] : s1[15]), b_ = (g == 0 ? s2[1] : g == 1 ? s2[1] : g == 2 ? s2[0] : s2[0]); cand[1] = __uint_as_float((__float_as_uint(a_ + b_) & 0xFFFFFFC0u) | (unsigned)(16 * g + 1)); }
            { const float a_ = (g == 0 ? s1[0] : g == 1 ? s1[1] : g == 2 ? s1[4] : NEGV), b_ = (g == 0 ? s2[2] : g == 1 ? s2[2] : g == 2 ? s2[1] : NEGV); cand[2] = __uint_as_float((__float_as_uint(a_ + b_) & 0xFFFFFFC0u) | (unsigned)(16 * g + 2)); }
            { const float a_ = (g == 0 ? s1[0] : g == 1 ? s1[1] : g == 2 ? s1[4] : NEGV), b_ = (g == 0 ? s2[3] : g == 1 ? s2[3] : g == 2 ? s2[2] : NEGV); cand[3] = __uint_as_float((__float_as_uint(a_ + b_) & 0xFFFFFFC0u) | (unsigned)(16 * g + 3)); }
            { const float a_ = (g == 0 ? s1[0] : g == 1 ? s1[1] : g == 2 ? s1[5] : NEGV), b_ = (g == 0 ? s2[4] : g == 1 ? s2[4] : g == 2 ? s2[0] : NEGV); cand[4] = __uint_as_float((__float_as_uint(a_ + b_) & 0xFFFFFFC0u) | (unsigned)(16 * g + 4)); }
            { const float a_ = (g == 0 ? s1[0] : g == 1 ? s1[1] : g == 2 ? s1[5] : NEGV), b_ = (g == 0 ? s2[5] : g == 1 ? s2[5] : g == 2 ? s2[1] : NEGV); cand[5] = __uint_as_float((__float_as_uint(a_ + b_) & 0xFFFFFFC0u) | (unsigned)(16 * g + 5)); }
            { const float a_ = (g == 0 ? s1[0] : g == 1 ? s1[1] : g == 2 ? s1[6] : NEGV), b_ = (g == 0 ? s2[6] : g == 1 ? s2[6] : g == 2 ? s2[0] : NEGV); cand[6] = __uint_as_float((__float_as_uint(a_ + b_) & 0xFFFFFFC0u) | (unsigned)(16 * g + 6)); }
            { const float a_ = (g == 0 ? s1[0] : g == 1 ? s1[1] : g == 2 ? s1[6] : NEGV), b_ = (g == 0 ? s2[7] : g == 1 ? s2[7] : g == 2 ? s2[1] : NEGV); cand[7] = __uint_as_float((__float_as_uint(a_ + b_) & 0xFFFFFFC0u) | (unsigned)(16 * g + 7)); }
            { const float a_ = (g == 0 ? s1[0] : g == 1 ? s1[2] : g == 2 ? s1[7] : NEGV), b_ = (g == 0 ? s2[8] : g == 1 ? s2[0] : g == 2 ? s2[0] : NEGV); cand[8] = __uint_as_float((__float_as_uint(a_ + b_) & 0xFFFFFFC0u) | (unsigned)(16 * g + 8)); }
            { const float a_ = (g == 0 ? s1[0] : g == 1 ? s1[2] : g == 2 ? s1[7] : NEGV), b_ = (g == 0 ? s2[9] : g == 1 ? s2[1] : g == 2 ? s2[1] : NEGV); cand[9] = __uint_as_float((__float_as_uint(a_ + b_) & 0xFFFFFFC0u) | (unsigned)(16 * g + 9)); }
            { const float a_ = (g == 0 ? s1[0] : g == 1 ? s1[2] : g == 2 ? s1[8] : NEGV), b_ = (g == 0 ? s2[10] : g == 1 ? s2[2] : g == 2 ? s2[0] : NEGV); cand[10] = __uint_as_float((__float_as_uint(a_ + b_) & 0xFFFFFFC0u) | (unsigned)(16 * g + 10)); }
            { const float a_ = (g == 0 ? s1[0] : g == 1 ? s1[2] : g == 2 ? s1[9] : NEGV), b_ = (g == 0 ? s2[11] : g == 1 ? s2[3] : g == 2 ? s2[0] : NEGV); cand[11] = __uint_as_float((__float_as_uint(a_ + b_) & 0xFFFFFFC0u) | (unsigned)(16 * g + 11)); }
            { const float a_ = (g == 0 ? s1[0] : g == 1 ? s1[2] : g == 2 ? s1[10] : NEGV), b_ = (g == 0 ? s2[12] : g == 1 ? s2[4] : g == 2 ? s2[0] : NEGV); cand[12] = __uint_as_float((__float_as_uint(a_ + b_) & 0xFFFFFFC0u) | (unsigned)(16 * g + 12)); }
            { const float a_ = (g == 0 ? s1[0] : g == 1 ? s1[3] : g == 2 ? s1[11] : NEGV), b_ = (g == 0 ? s2[13] : g == 1 ? s2[0] : g == 2 ? s2[0] : NEGV); cand[13] = __uint_as_float((__float_as_uint(a_ + b_) & 0xFFFFFFC0u) | (unsigned)(16 * g + 13)); }
            { const float a_ = (g == 0 ? s1[0] : g == 1 ? s1[3] : g == 2 ? s1[12] : NEGV), b_ = (g == 0 ? s2[14] : g == 1 ? s2[1] : g == 2 ? s2[0] : NEGV); cand[14] = __uint_as_float((__float_as_uint(a_ + b_) & 0xFFFFFFC0u) | (unsigned)(16 * g + 14)); }
            { const float a_ = (g == 0 ? s1[0] : g == 1 ? s1[3] : g == 2 ? s1[13] : NEGV), b_ = (g == 0 ? s2[15] : g == 1 ? s2[2] : g == 2 ? s2[0] : NEGV); cand[15] = __uint_as_float((__float_as_uint(a_ + b_) & 0xFFFFFFC0u) | (unsigned)(16 * g + 15)); }
        sort16(cand);
        xmerge(cand, 16); xmerge(cand, 32);
        float den = 0.f, ex[16];
#pragma unroll
        for (int i = 0; i < 16; ++i) { ex[i] = __expf(cand[i] - cand[0]); den += ex[i]; }
        const float inv = 1.f / den;
        unsigned short eo[4]; float go[4];
#pragma unroll
        for (int e = 0; e < 4; ++e) {
            const float cv = (g == 0 ? cand[e] : g == 1 ? cand[4 + e] : g == 2 ? cand[8 + e] : cand[12 + e]);
            const float gv = (g == 0 ? ex[e] : g == 1 ? ex[4 + e] : g == 2 ? ex[8 + e] : ex[12 + e]);
            const unsigned code = __float_as_uint(cv) & 63u; const unsigned ij = ijt[code];
            const unsigned p1 = tab[ij & 15u], p2 = tab[16 + (ij >> 4)];
            eo[e] = (unsigned short)((p1 & 127u) * 128u + (p2 & 127u)); go[e] = gv * inv; }
        u32x2 ov; ov.x = (unsigned)eo[0] | ((unsigned)eo[1] << 16); ov.y = (unsigned)eo[2] | ((unsigned)eo[3] << 16);
        *(u32x2*)(pidx + (t0 + i16) * 128 + hh * 16 + 4 * g) = ov;
        *(f32x4*)(pgate + (t0 + i16) * 128 + hh * 16 + 4 * g) = (f32x4){go[0], go[1], go[2], go[3]};
    }
    __syncthreads();
}

__device__ __forceinline__ float dot2u(unsigned a, unsigned x, float acc) {
    return __builtin_amdgcn_fdot2_f32_bf16(__builtin_bit_cast(bf16x2_t, a), __builtin_bit_cast(bf16x2_t, x), acc, false);
}
__device__ __forceinline__ float dot8(const u32x4 a, const u32x4 x, float acc) {
    const unsigned a0 = a.x, a1 = a.y, a2 = a.z, a3 = a.w, x0 = x.x, x1 = x.y, x2 = x.z, x3 = x.w;
    acc = dot2u(a0, x0, acc); acc = dot2u(a1, x1, acc); acc = dot2u(a2, x2, acc); acc = dot2u(a3, x3, acc);
    return acc;
}
__device__ __forceinline__ void p_gather(const Ctx& C, const bf16_t* n2, const unsigned short* pidx, const float* pgate, const bf16_t* ub, const bf16_t* vb, const float* h, float* out) {
    const float* mod = C.f32p(WS_MOD); const float* fg = C.in[23];
    LAS float* cbuf = (LAS float*)C.lds + C.wave * 128;
    const int gw = C.bid * NWAVES + C.wave, NGW = C.G * NWAVES, lane = C.lane;
    for (int t = gw; t < T; t += NGW) {
        const int b = t / SEQ;
        const u32x4 x0 = *(const u32x4*)(n2 + (size_t)t * 1024 + lane * 8), x1 = *(const u32x4*)(n2 + (size_t)t * 1024 + 512 + lane * 8);
        const int id0 = pidx[(size_t)t * 128 + lane], id1 = pidx[(size_t)t * 128 + 64 + lane];
        const float g0 = pgate[(size_t)t * 128 + lane], g1 = pgate[(size_t)t * 128 + 64 + lane];
#pragma unroll 1
        for (int grp = 0; grp < 8; ++grp) {
            const int idv = grp < 4 ? id0 : id1; const int lbase = (grp & 3) * 16;
            float part[16];
#pragma unroll
            for (int j = 0; j < 16; ++j) {
                const int e = __shfl(idv, lbase + j);
                const bf16_t* rowp = ub + (size_t)e * 1024;
                const u32x4 a0 = *(const u32x4*)(rowp + lane * 8), a1 = *(const u32x4*)(rowp + 512 + lane * 8);
                part[j] = dot8(a1, x1, dot8(a0, x0, 0.f));
            }
            float p8[8];
            { const bool hi = (lane & 32) != 0;
#pragma unroll
              for (int j = 0; j < 8; ++j) { const float keep = hi ? part[j + 8] : part[j], send = hi ? part[j] : part[j + 8]; p8[j] = keep + __shfl_xor(send, 32); } }
            float p4[4];
            { const bool hi = (lane & 16) != 0;
#pragma unroll
              for (int j = 0; j < 4; ++j) { const float keep = hi ? p8[j + 4] : p8[j], send = hi ? p8[j] : p8[j + 4]; p4[j] = keep + __shfl_xor(send, 16); } }
            float p2[2];
            { const bool hi = (lane & 8) != 0;
#pragma unroll
              for (int j = 0; j < 2; ++j) { const float keep = hi ? p4[j + 2] : p4[j], send = hi ? p4[j] : p4[j + 2]; p2[j] = keep + __shfl_xor(send, 8); } }
            float p1;
            { const bool hi = (lane & 4) != 0; const float keep = hi ? p2[1] : p2[0], send = hi ? p2[0] : p2[1]; p1 = keep + __shfl_xor(send, 4); }
            p1 += __shfl_xor(p1, 2); p1 += __shfl_xor(p1, 1);
            const int E = ((lane >> 5) & 1) * 8 + ((lane >> 4) & 1) * 4 + ((lane >> 3) & 1) * 2 + ((lane >> 2) & 1);
            if ((lane & 3) == 0) cbuf[grp * 16 + E] = gelu_f(p1);
        }
        asm volatile("s_waitcnt lgkmcnt(0)" ::: "memory");
        const float c0 = cbuf[lane] * g0, c1 = cbuf[64 + lane] * g1;
        asm volatile("s_waitcnt lgkmcnt(0)" ::: "memory");
        float acc[16];
#pragma unroll
        for (int i = 0; i < 16; ++i) acc[i] = 0.f;
#pragma unroll 1
        for (int kb = 0; kb < 128; kb += 8) {
            const int idv = kb < 64 ? id0 : id1; const float cv = kb < 64 ? c0 : c1;
#pragma unroll
            for (int j = 0; j < 8; ++j) {
                const int e = __shfl(idv, (kb & 63) + j); const float ck = __shfl(cv, (kb & 63) + j);
                const bf16_t* rowp = vb + (size_t)e * 1024;
                const u32x4 a0 = *(const u32x4*)(rowp + lane * 8), a1 = *(const u32x4*)(rowp + 512 + lane * 8);
                acc[0] += ck * bflo(a0.x); acc[1] += ck * bfhi(a0.x); acc[2] += ck * bflo(a0.y); acc[3] += ck * bfhi(a0.y);
                acc[4] += ck * bflo(a0.z); acc[5] += ck * bfhi(a0.z); acc[6] += ck * bflo(a0.w); acc[7] += ck * bfhi(a0.w);
                acc[8] += ck * bflo(a1.x); acc[9] += ck * bfhi(a1.x); acc[10] += ck * bflo(a1.y); acc[11] += ck * bfhi(a1.y);
                acc[12] += ck * bflo(a1.z); acc[13] += ck * bfhi(a1.z); acc[14] += ck * bflo(a1.w); acc[15] += ck * bfhi(a1.w);
            }
        }
        float hf[16]; float ss = 0.f;
#pragma unroll
        for (int half = 0; half < 2; ++half) {
            const int col = half * 512 + lane * 8;
            const f32x4 h0 = *(const f32x4*)(h + (size_t)t * 1024 + col), h1 = *(const f32x4*)(h + (size_t)t * 1024 + col + 4);
            const f32x4 m0 = *(const f32x4*)(mod + b * 6144 + 5120 + col), m1 = *(const f32x4*)(mod + b * 6144 + 5120 + col + 4);
            hf[half * 8 + 0] = h0.x + m0.x * acc[half * 8 + 0]; hf[half * 8 + 1] = h0.y + m0.y * acc[half * 8 + 1];
            hf[half * 8 + 2] = h0.z + m0.z * acc[half * 8 + 2]; hf[half * 8 + 3] = h0.w + m0.w * acc[half * 8 + 3];
            hf[half * 8 + 4] = h1.x + m1.x * acc[half * 8 + 4]; hf[half * 8 + 5] = h1.y + m1.y * acc[half * 8 + 5];
            hf[half * 8 + 6] = h1.z + m1.z * acc[half * 8 + 6]; hf[half * 8 + 7] = h1.w + m1.w * acc[half * 8 + 7];
        }
#pragma unroll
        for (int i = 0; i < 16; ++i) ss += hf[i] * hf[i];
        const float rstd = rsqrtf(wave_sum(ss) * (1.f / 1024.f) + EPS);
#pragma unroll
        for (int half = 0; half < 2; ++half) {
            const int col = half * 512 + lane * 8;
            const f32x4 f0 = *(const f32x4*)(fg + col), f1 = *(const f32x4*)(fg + col + 4);
            f32x4 o0, o1;
            o0.x = hf[half * 8 + 0] * rstd * f0.x; o0.y = hf[half * 8 + 1] * rstd * f0.y; o0.z = hf[half * 8 + 2] * rstd * f0.z; o0.w = hf[half * 8 + 3] * rstd * f0.w;
            o1.x = hf[half * 8 + 4] * rstd * f1.x; o1.y = hf[half * 8 + 5] * rstd * f1.y; o1.z = hf[half * 8 + 6] * rstd * f1.z; o1.w = hf[half * 8 + 7] * rstd * f1.w;
            *(f32x4*)(out + (size_t)t * 1024 + col) = o0; *(f32x4*)(out + (size_t)t * 1024 + col + 4) = o1;
        }
    }
}


__device__ __forceinline__ void p_gather_ref(const Ctx& C, const bf16_t* n2, const unsigned short* pidx, const float* pgate, const float* h, float* out) {
    const float* mod = C.f32p(WS_MOD); const float* fg = C.in[23]; const float* U = C.in[21]; const float* V = C.in[22];
    LAS float* xs = (LAS float*)C.lds;
    LAS float* part = xs + 1024;
    LAS float* cs = part + 512;
    LAS float* red = cs + 128;
    LAS int* es = (LAS int*)(red + 512);
    const int tid = C.tid;
    for (int t = C.bid; t < T; t += C.G) {
        const int b = t / SEQ;
        __syncthreads();
        xs[tid] = bf2f(n2[(size_t)t * 1024 + tid]); xs[tid + 512] = bf2f(n2[(size_t)t * 1024 + 512 + tid]);
        if (tid < 128) es[tid] = pidx[(size_t)t * 128 + tid];
        __syncthreads();
        { const int k = tid >> 2, qd = tid & 3; const float* ur = U + (size_t)es[k] * 1024 + qd * 256; float acc = 0.f;
          for (int d = 0; d < 256; ++d) acc += ur[d] * xs[qd * 256 + d];
          part[tid] = acc; }
        __syncthreads();
        if (tid < 128) { const float dsum = part[tid * 4] + part[tid * 4 + 1] + part[tid * 4 + 2] + part[tid * 4 + 3]; cs[tid] = gelu_f(dsum) * pgate[(size_t)t * 128 + tid]; }
        __syncthreads();
        float o0 = 0.f, o1 = 0.f;
        for (int k = 0; k < 128; ++k) { const float* vr = V + (size_t)es[k] * 1024; const float ck = cs[k]; o0 += ck * vr[tid]; o1 += ck * vr[tid + 512]; }
        const float h0 = h[(size_t)t * 1024 + tid] + mod[b * 6144 + 5120 + tid] * o0, h1 = h[(size_t)t * 1024 + 512 + tid] + mod[b * 6144 + 5120 + 512 + tid] * o1;
        red[tid] = h0 * h0 + h1 * h1;
        __syncthreads();
        for (int sft = 256; sft > 0; sft >>= 1) { if (tid < sft) red[tid] += red[tid + sft]; __syncthreads(); }
        const float rstd = rsqrtf(red[0] * (1.f / 1024.f) + EPS);
        out[(size_t)t * 1024 + tid] = h0 * rstd * fg[tid]; out[(size_t)t * 1024 + 512 + tid] = h1 * rstd * fg[tid + 512];
    }
}

namespace pg8 {
#define PG8_LAS __attribute__((address_space(3)))
typedef unsigned short bf16_t;
typedef short bf16x8 __attribute__((ext_vector_type(8)));
typedef float f32x4 __attribute__((ext_vector_type(4)));
typedef unsigned u32x4 __attribute__((ext_vector_type(4)));
constexpr int BM = 256, BK = 64, HALF = 128, HTB = HALF * BK * 2  , STAGE_BYTES = 8 * HTB, NXCD = 8, WGM = 8;

__host__ __device__ __forceinline__ int lds_byte(int r, int c) { const int st = (r >> 4) * 2 + (c >> 5), rr = r & 15, cc = c & 31, ob = rr * 64 + cc * 2; return st * 1024 + (ob ^ (((ob >> 9) & 1) << 5)); }
__host__ __device__ __forceinline__ void stage_rc(int b, int& R, int& C) { const int st = b / 1024, sb = b % 1024, swz = sb ^ (((sb >> 9) & 1) << 5); R = (st >> 1) * 16 + swz / 64; C = (st & 1) * 32 + (swz % 64) / 2; }
__host__ __device__ __forceinline__ int perm32(int rho) { const int n = rho >> 4, i = rho & 15; return 8 * (i >> 2) + 4 * n + (i & 3); }

struct Unit { int pm, pn; };
struct Gemm { const bf16_t* A; const bf16_t* Bt; int M, N, K; };

struct StaticOrder {
    int nM, nN, nwg, G, c;
    __host__ __device__ void init(int M, int N, int G_, int c_) { nM = M / BM; nN = N / BM; nwg = nM * nN; G = G_; c = c_; }
    __host__ __device__ bool next(int i, Unit& u) const {
        const long L = (long)i * G + c; if (L >= nwg) return false;
        int wgid = (int)L; { const int q = nwg / NXCD, r = nwg % NXCD, xcd = wgid % NXCD, off = wgid / NXCD; wgid = (xcd < r ? xcd * (q + 1) : r * (q + 1) + (xcd - r) * q) + off; }
        const int nig = WGM * nN, gid = wgid / nig, fm = gid * WGM, gsz = (nM - fm) < WGM ? (nM - fm) : WGM;
        u.pm = fm + ((wgid % nig) % gsz); u.pn = (wgid % nig) / gsz; return true;
    }
    __device__ __forceinline__ void a_ready(const Unit&) const {}
    __device__ __forceinline__ void done(const Unit&) const {}
};

__device__ __forceinline__ unsigned cvt_pk_bf16(float lo, float hi) { return ::pk2(lo, hi); }
__device__ __forceinline__ float e_silu(float x) { return x / (1.f + __expf(-x)); }
__device__ __forceinline__ float e_sigm(float x) { return 1.f / (1.f + __expf(-x)); }
__device__ __forceinline__ float e_lo(unsigned v) { return __uint_as_float(v << 16); }
__device__ __forceinline__ float e_hi(unsigned v) { return __uint_as_float(v & 0xffff0000u); }
__device__ __forceinline__ u32x4 pack8(const f32x4 v0, const f32x4 v1) { u32x4 w; w.x = cvt_pk_bf16(v0[0], v0[1]); w.y = cvt_pk_bf16(v0[2], v0[3]); w.z = cvt_pk_bf16(v1[0], v1[1]); w.w = cvt_pk_bf16(v1[2], v1[3]); return w; }

struct EpiInProj {
    static constexpr bool PERM = true, AFTER_DRAIN = false;
    bf16_t *sz, *xbc, *q, *k, *v;
    __device__ __forceinline__ void operator()(const f32x4 (&acc)[2][2][4][2], const Unit& u, int wr, int wc, int fr, int fq) const {
        const int pn = u.pn; bf16_t* base; int ldc = 1024, colt, mode = 0;
        if (pn < 4) { base = sz; colt = pn * 256; mode = 1; }
        else if (pn < 12) { base = xbc; ldc = 2048; colt = (pn - 4) * 256; }
        else if (pn < 16) { base = q; colt = (pn - 12) * 256; mode = 2; }
        else if (pn < 20) { base = k; colt = (pn - 16) * 256; }
        else { base = v; colt = (pn - 20) * 256; }
        const int row0 = u.pm * BM + wr * 64 + fr, col0 = colt + wc * 32 + 8 * fq;
#pragma unroll
        for (int ai = 0; ai < 2; ++ai)
#pragma unroll
            for (int m = 0; m < 4; ++m) { bf16_t* rowp = base + (size_t)(row0 + ai * HALF + m * 16) * ldc + col0;
#pragma unroll
                for (int bj = 0; bj < 2; ++bj) { f32x4 v0 = acc[ai][bj][m][0], v1 = acc[ai][bj][m][1];
                    if (mode == 1) {
#pragma unroll
                        for (int i = 0; i < 4; ++i) { v0[i] = e_silu(v0[i]); v1[i] = e_silu(v1[i]); } }
                    else if (mode == 2) { v0 = v0 * 0.125f; v1 = v1 * 0.125f; }
                    *(u32x4*)(rowp + bj * HALF) = pack8(v0, v1); } }
    }
};
struct EpiGate {
    static constexpr bool PERM = true, AFTER_DRAIN = false;
    bf16_t* sg; size_t plane;
    __device__ __forceinline__ void operator()(const f32x4 (&acc)[2][2][4][2], const Unit& u, int wr, int wc, int fr, int fq) const {
        bf16_t* base = sg + (size_t)(u.pn >> 2) * plane; const int colt = (u.pn & 3) * 256;
        const int row0 = u.pm * BM + wr * 64 + fr, col0 = colt + wc * 32 + 8 * fq;
#pragma unroll
        for (int ai = 0; ai < 2; ++ai)
#pragma unroll
            for (int m = 0; m < 4; ++m) { bf16_t* rowp = base + (size_t)(row0 + ai * HALF + m * 16) * 1024 + col0;
#pragma unroll
                for (int bj = 0; bj < 2; ++bj) { f32x4 v0 = acc[ai][bj][m][0], v1 = acc[ai][bj][m][1];
#pragma unroll
                    for (int i = 0; i < 4; ++i) { v0[i] = e_sigm(v0[i]); v1[i] = e_sigm(v1[i]); }
                    *(u32x4*)(rowp + bj * HALF) = pack8(v0, v1); } }
    }
};
struct EpiD1 {
    static constexpr bool PERM = true, AFTER_DRAIN = false;
    bf16_t* p1; const bf16_t* sg1; const float* rstd;
    __device__ __forceinline__ void operator()(const f32x4 (&acc)[2][2][4][2], const Unit& u, int wr, int wc, int fr, int fq) const {
        const int row0 = u.pm * BM + wr * 64 + fr, col0 = u.pn * BM + wc * 32 + 8 * fq;
#pragma unroll
        for (int ai = 0; ai < 2; ++ai)
#pragma unroll
            for (int m = 0; m < 4; ++m) { const int row = row0 + ai * HALF + m * 16; const float rs = rstd[row]; const size_t off = (size_t)row * 1024 + col0;
#pragma unroll
                for (int bj = 0; bj < 2; ++bj) { f32x4 v0 = acc[ai][bj][m][0] * rs, v1 = acc[ai][bj][m][1] * rs;
                    const u32x4 g = *(const u32x4*)(sg1 + off + bj * HALF);
                    v0[0] *= e_lo(g.x); v0[1] *= e_hi(g.x); v0[2] *= e_lo(g.y); v0[3] *= e_hi(g.y); v1[0] *= e_lo(g.z); v1[1] *= e_hi(g.z); v1[2] *= e_lo(g.w); v1[3] *= e_hi(g.w);
                    *(u32x4*)(p1 + off + bj * HALF) = pack8(v0, v1); } }
    }
};
struct EpiD2 {
    static constexpr bool PERM = true, AFTER_DRAIN = false;
    bf16_t* mixed; const bf16_t *p1, *sg2;
    __device__ __forceinline__ void operator()(const f32x4 (&acc)[2][2][4][2], const Unit& u, int wr, int wc, int fr, int fq) const {
        const int row0 = u.pm * BM + wr * 64 + fr, col0 = u.pn * BM + wc * 32 + 8 * fq;
#pragma unroll
        for (int ai = 0; ai < 2; ++ai)
#pragma unroll
            for (int m = 0; m < 4; ++m) { const int row = row0 + ai * HALF + m * 16; const size_t off = (size_t)row * 1024 + col0;
#pragma unroll
                for (int bj = 0; bj < 2; ++bj) { f32x4 v0 = acc[ai][bj][m][0], v1 = acc[ai][bj][m][1];
                    const u32x4 g = *(const u32x4*)(sg2 + off + bj * HALF), p = *(const u32x4*)(p1 + off + bj * HALF);
                    v0[0] = e_lo(p.x) + v0[0] * e_lo(g.x); v0[1] = e_hi(p.x) + v0[1] * e_hi(g.x); v0[2] = e_lo(p.y) + v0[2] * e_lo(g.y); v0[3] = e_hi(p.y) + v0[3] * e_hi(g.y);
                    v1[0] = e_lo(p.z) + v1[0] * e_lo(g.z); v1[1] = e_hi(p.z) + v1[1] * e_hi(g.z); v1[2] = e_lo(p.w) + v1[2] * e_lo(g.w); v1[3] = e_hi(p.w) + v1[3] * e_hi(g.w);
                    *(u32x4*)(mixed + off + bj * HALF) = pack8(v0, v1); } }
    }
};
struct EpiD3 {
    static constexpr bool PERM = false, AFTER_DRAIN = false;
    float* h; const float* x; const float* mod;
    __device__ __forceinline__ void operator()(const f32x4 (&acc)[2][2][4][2], const Unit& u, int wr, int wc, int fr, int fq) const {
        const int row0 = u.pm * BM + wr * 64 + fr, col0 = u.pn * BM + wc * 32 + 4 * fq;
        const float* g1 = mod + (size_t)((u.pm * BM) >> 12) * 6144 + 2048;
#pragma unroll
        for (int ai = 0; ai < 2; ++ai)
#pragma unroll
            for (int m = 0; m < 4; ++m) { const size_t off = (size_t)(row0 + ai * HALF + m * 16) * 1024 + col0;
#pragma unroll
                for (int bj = 0; bj < 2; ++bj)
#pragma unroll
                    for (int n = 0; n < 2; ++n) { const int c = bj * HALF + n * 16; const f32x4 xv = *(const f32x4*)(x + off + c), gv = *(const f32x4*)(g1 + col0 + c);
                        *(f32x4*)(h + off + c) = xv + gv * acc[ai][bj][m][n]; } }
    }
};
struct EpiQp {
    static constexpr bool PERM = true, AFTER_DRAIN = false;
    bf16_t* qp;
    __device__ __forceinline__ void operator()(const f32x4 (&acc)[2][2][4][2], const Unit& u, int wr, int wc, int fr, int fq) const {
        const int row0 = u.pm * BM + wr * 64 + fr, col0 = u.pn * BM + wc * 32 + 8 * fq;
#pragma unroll
        for (int ai = 0; ai < 2; ++ai)
#pragma unroll
            for (int m = 0; m < 4; ++m) { bf16_t* rowp = qp + (size_t)(row0 + ai * HALF + m * 16) * 2048 + col0;
#pragma unroll
                for (int bj = 0; bj < 2; ++bj) *(u32x4*)(rowp + bj * HALF) = pack8(acc[ai][bj][m][0], acc[ai][bj][m][1]); }
    }
};

template <class Epi, class Sched, bool ALIGN_EPI = false, bool SP2 = false>
__device__ __forceinline__ void gemm_phase(PG8_LAS unsigned char* lds, const Gemm g, const Sched& S, const Epi& E) {
    const int tid = threadIdx.x, wid = __builtin_amdgcn_readfirstlane(tid >> 6), lane = tid & 63, wr = wid >> 2, wc = wid & 3, fr = lane & 15, fq = lane >> 4;
    const int K = g.K, nt = K / BK;
    unsigned voffA[2], voffB[2];
#pragma unroll
    for (int i = 0; i < 2; ++i) { int R, C; stage_rc(tid * 16 + i * 8192, R, C); const int Rb = Epi::PERM ? ((R & ~31) + perm32(R & 31)) : R;
        voffA[i] = (unsigned)(R * K + C) * 2u; voffB[i] = (unsigned)(Rb * K + C) * 2u; }
    const size_t kstep = (size_t)(BK * 2);
    const size_t hstep = (size_t)HALF * K * 2;
    const size_t tstep = 2 * hstep;
    const unsigned ldsw = (unsigned)wid * 1024u;
    const int aoff = lds_byte(wr * 64 + fr, fq * 8), boff = lds_byte(wc * 32 + fr, fq * 8);
#define PG8_SA(b, h) (((b) * 2 + (h)) * HTB)
#define PG8_SB(b, h) ((4 + (b) * 2 + (h)) * HTB)
#define PG8_STAGE(bufoff, gbase, voff) do { _Pragma("unroll") for (int _i = 0; _i < 2; ++_i) \
        __builtin_amdgcn_global_load_lds((const unsigned*)((const char*)(gbase) + (voff)[_i]), (PG8_LAS unsigned*)(lds + (bufoff) + ldsw + _i * 8192), 16, 0, 0); } while (0)
#define PG8_LDA(dst, b, h) do { _Pragma("unroll") for (int m = 0; m < 4; ++m) _Pragma("unroll") for (int k = 0; k < 2; ++k) dst[m][k] = *(const PG8_LAS bf16x8*)(lds + PG8_SA(b, h) + aoff + m * 2048 + k * 1024); } while (0)
#define PG8_LDB(dst, b, h) do { _Pragma("unroll") for (int n = 0; n < 2; ++n) _Pragma("unroll") for (int k = 0; k < 2; ++k) dst[n][k] = *(const PG8_LAS bf16x8*)(lds + PG8_SB(b, h) + boff + n * 2048 + k * 1024); } while (0)
#define PG8_MMA(ai, bj, At, Bt) do { __builtin_amdgcn_s_setprio(1); _Pragma("unroll") for (int m = 0; m < 4; ++m) _Pragma("unroll") for (int n = 0; n < 2; ++n) _Pragma("unroll") for (int k = 0; k < 2; ++k) \
        acc[ai][bj][m][n] = __builtin_amdgcn_mfma_f32_16x16x32_bf16(Bt[n][k], At[m][k], acc[ai][bj][m][n], 0, 0, 0); __builtin_amdgcn_s_setprio(0); } while (0)
#define PG8_WAIT_V(n) asm volatile("s_waitcnt vmcnt(" #n ")" ::: "memory")
#define PG8_WAIT_L(n) asm volatile("s_waitcnt lgkmcnt(" #n ")" ::: "memory")
#define PG8_BAR __builtin_amdgcn_s_barrier()
#define PG8_SCHED __builtin_amdgcn_sched_barrier(0)
    Unit cur, nxt; int ui = 0;
    if (!S.next(0, cur)) return;
    f32x4 acc[2][2][4][2];
#pragma unroll
    for (int a = 0; a < 2; ++a)
#pragma unroll
        for (int b = 0; b < 2; ++b)
#pragma unroll
            for (int m = 0; m < 4; ++m)
#pragma unroll
                for (int n = 0; n < 2; ++n) acc[a][b][m][n] = (f32x4){0.f, 0.f, 0.f, 0.f};
    bf16x8 At[4][2], B0[2][2], B1[2][2];
    const char* cA = (const char*)g.A + (size_t)cur.pm * tstep; const char* cB = (const char*)g.Bt + (size_t)cur.pn * tstep;
    S.a_ready(cur);
    if constexpr (SP2) {
        PG8_STAGE(PG8_SB(0, 0), cB, voffB); PG8_STAGE(PG8_SB(0, 1), cB + hstep, voffB); PG8_STAGE(PG8_SA(0, 0), cA, voffA); PG8_STAGE(PG8_SA(0, 1), cA + hstep, voffA);
        if (wr == 1) PG8_BAR;
        PG8_WAIT_V(2); PG8_BAR;
        PG8_STAGE(PG8_SB(1, 0), cB + kstep, voffB); PG8_STAGE(PG8_SA(1, 0), cA + kstep, voffA); PG8_STAGE(PG8_SB(1, 1), cB + hstep + kstep, voffB);
        PG8_WAIT_V(6); PG8_BAR;
    } else {
        PG8_STAGE(PG8_SB(0, 0), cB, voffB); PG8_STAGE(PG8_SA(0, 0), cA, voffA); PG8_STAGE(PG8_SB(0, 1), cB + hstep, voffB); PG8_STAGE(PG8_SA(0, 1), cA + hstep, voffA);
        if (wr == 1) PG8_BAR;
        PG8_WAIT_V(4); PG8_BAR;
        PG8_STAGE(PG8_SB(1, 0), cB + kstep, voffB); PG8_STAGE(PG8_SA(1, 0), cA + kstep, voffA); PG8_STAGE(PG8_SB(1, 1), cB + hstep + kstep, voffB);
        PG8_WAIT_V(6); PG8_BAR;
    }
    for (;;) {
        const bool has_next = S.next(ui + 1, nxt);
        const char* nA = has_next ? (const char*)g.A + (size_t)nxt.pm * tstep : cA; const char* nB = has_next ? (const char*)g.Bt + (size_t)nxt.pn * tstep : cB;
        for (int t = 0; t < nt; t += 2) {
            const bool last = (t == nt - 2);
            const char* a1 = cA + (size_t)(t + 1) * kstep;
            const char* a2 = last ? nA : cA + (size_t)(t + 2) * kstep; const char* b2 = last ? nB : cB + (size_t)(t + 2) * kstep;
            const char* a3 = a2 + kstep; const char* b3 = b2 + kstep;
            if (last && has_next) S.a_ready(nxt);
            if constexpr (SP2) {
            PG8_LDB(B0, 0, 0); PG8_LDB(B1, 0, 1); PG8_SCHED; PG8_LDA(At, 0, 0); PG8_STAGE(PG8_SA(1, 1), a1 + hstep, voffA);
            PG8_WAIT_V(8); PG8_WAIT_L(0); PG8_BAR; PG8_MMA(0, 0, At, B0); PG8_MMA(0, 1, At, B1); PG8_BAR; PG8_SCHED;
            PG8_LDA(At, 0, 1); PG8_STAGE(PG8_SB(0, 0), b2, voffB); PG8_STAGE(PG8_SB(0, 1), b2 + hstep, voffB); PG8_STAGE(PG8_SA(0, 0), a2, voffA);
            PG8_WAIT_V(8); PG8_WAIT_L(0); PG8_BAR; PG8_MMA(1, 0, At, B0); PG8_MMA(1, 1, At, B1); PG8_BAR; PG8_SCHED;
            PG8_LDB(B0, 1, 0); PG8_LDB(B1, 1, 1); PG8_SCHED; PG8_LDA(At, 1, 0); PG8_STAGE(PG8_SA(0, 1), a2 + hstep, voffA);
            PG8_WAIT_V(8); PG8_WAIT_L(0); PG8_BAR; PG8_MMA(0, 0, At, B0); PG8_MMA(0, 1, At, B1); PG8_BAR; PG8_SCHED;
            PG8_LDA(At, 1, 1); PG8_STAGE(PG8_SB(1, 0), b3, voffB); PG8_STAGE(PG8_SB(1, 1), b3 + hstep, voffB); PG8_STAGE(PG8_SA(1, 0), a3, voffA);
            PG8_WAIT_V(8); PG8_WAIT_L(0); PG8_BAR; PG8_MMA(1, 0, At, B0); PG8_MMA(1, 1, At, B1); PG8_BAR; PG8_SCHED;
            } else {
            PG8_LDB(B0, 0, 0); PG8_SCHED; PG8_LDA(At, 0, 0); PG8_STAGE(PG8_SA(1, 1), a1 + hstep, voffA);
            PG8_WAIT_L(8); PG8_BAR; PG8_WAIT_L(0); PG8_MMA(0, 0, At, B0); PG8_BAR; PG8_SCHED;
            PG8_LDB(B1, 0, 1); PG8_STAGE(PG8_SB(0, 0), b2, voffB);
            PG8_BAR; PG8_WAIT_L(0); PG8_MMA(0, 1, At, B1); PG8_BAR;
            PG8_LDA(At, 0, 1); PG8_STAGE(PG8_SA(0, 0), a2, voffA);
            PG8_BAR; PG8_WAIT_L(0); PG8_MMA(1, 0, At, B0); PG8_BAR; PG8_SCHED;
            PG8_STAGE(PG8_SB(0, 1), b2 + hstep, voffB);
            PG8_WAIT_V(6); PG8_BAR; PG8_MMA(1, 1, At, B1); PG8_BAR;
            PG8_LDB(B0, 1, 0); PG8_SCHED; PG8_LDA(At, 1, 0); PG8_STAGE(PG8_SA(0, 1), a2 + hstep, voffA);
            PG8_WAIT_L(8); PG8_BAR; PG8_WAIT_L(0); PG8_MMA(0, 0, At, B0); PG8_BAR; PG8_SCHED;
            PG8_LDB(B1, 1, 1); PG8_STAGE(PG8_SB(1, 0), b3, voffB);
            PG8_BAR; PG8_WAIT_L(0); PG8_MMA(0, 1, At, B1); PG8_BAR;
            PG8_LDA(At, 1, 1); PG8_STAGE(PG8_SA(1, 0), a3, voffA);
            PG8_BAR; PG8_WAIT_L(0); PG8_MMA(1, 0, At, B0); PG8_BAR; PG8_SCHED;
            PG8_STAGE(PG8_SB(1, 1), b3 + hstep, voffB);
            PG8_WAIT_V(6); PG8_BAR; PG8_MMA(1, 1, At, B1); PG8_BAR;
            }
        }
        if constexpr (ALIGN_EPI) { if (wr == 0) PG8_BAR; }
        if constexpr (!Epi::AFTER_DRAIN) { E(acc, cur, wr, wc, fr, fq); S.done(cur); }
        if (!has_next) break;
#pragma unroll
        for (int a = 0; a < 2; ++a)
#pragma unroll
            for (int b = 0; b < 2; ++b)
#pragma unroll
                for (int m = 0; m < 4; ++m)
#pragma unroll
                    for (int n = 0; n < 2; ++n) acc[a][b][m][n] = (f32x4){0.f, 0.f, 0.f, 0.f};
        cur = nxt; cA = nA; cB = nB; ++ui;
        if constexpr (ALIGN_EPI) { if (wr == 1) PG8_BAR; }
    }
    PG8_WAIT_V(0);
    if constexpr (!ALIGN_EPI) { if (wr == 0) PG8_BAR; }
    PG8_BAR;
    if constexpr (Epi::AFTER_DRAIN) { E.fused(acc, cur, wr, wc, fr, fq, lds, wid, lane); S.done(cur); }
#undef PG8_SA
#undef PG8_SB
#undef PG8_STAGE
#undef PG8_LDA
#undef PG8_LDB
#undef PG8_MMA
#undef PG8_WAIT_V
#undef PG8_WAIT_L
#undef PG8_BAR
#undef PG8_SCHED
}
}


__device__ __forceinline__ void p_diag_cmp(const Ctx& C, const bf16_t* a, const bf16_t* b, size_t n, unsigned* res) {
    const size_t gt = (size_t)C.bid * NTHR + C.tid, NT = (size_t)C.G * NTHR;
    float md = 0.f, mr = 0.f;
    for (size_t i = gt; i < n; i += NT) { const float x = bf2f(a[i]), y = bf2f(b[i]); const float d = x - y; md += (d == d ? d * d : 1e30f); mr += x * x; }
#pragma unroll
    for (int o = 1; o < 64; o <<= 1) { md += __shfl_xor(md, o); mr += __shfl_xor(mr, o); }
    if (C.lane == 0) { atomicAdd((float*)res, md); atomicAdd((float*)res + 1, mr); }
}
__device__ __forceinline__ void p_diag_out(const Ctx& C, const unsigned* res, float* out) {
    const size_t gt = (size_t)C.bid * NTHR + C.tid, NT = (size_t)C.G * NTHR;
    for (size_t i = gt; i < (size_t)T * 1024; i += NT) out[i] = 0.f;
    __syncthreads();
    if (C.bid == 0 && C.tid == 0) { const float md = __uint_as_float(res[0]), mr = __uint_as_float(res[1]); const float rel = sqrtf(md / fmaxf(mr, 1e-30f));
        out[0] = 1.0e4f * (13.f + log10f(rel + 1e-12f)); }
}

#define GAS __attribute__((address_space(1)))
typedef GAS unsigned gu32;
#define RLX_AGENT __ATOMIC_RELAXED, __HIP_MEMORY_SCOPE_AGENT
#define XB_TMO      128
#define XB_XCNT(j)  (256  + 64 * (j))
#define XB_XSUB(j)  (1280 + 64 * (j))
#define XB_XGEN(j)  (2304 + 64 * (j))
#define XB_TOP      3328
#define XB_TOPGEN   3392
#define XCD_BAR_WORDS 3456
#define XB_SPIN_CAP (1u << 18)

__device__ __forceinline__ unsigned xb_ld(unsigned* p)              { return __hip_atomic_load(p, __ATOMIC_RELAXED, __HIP_MEMORY_SCOPE_AGENT); }
__device__ __forceinline__ unsigned xb_add(unsigned* p, unsigned v) { return __hip_atomic_fetch_add(p, v, __ATOMIC_RELAXED, __HIP_MEMORY_SCOPE_AGENT); }
__device__ __forceinline__ unsigned xb_xcc_id() { return (unsigned)__builtin_amdgcn_s_getreg((3 << 11) | 20) & 0xFu; }
#define XB_SPIN(cond, bar) do { unsigned _sp = 0; while (cond) { __builtin_amdgcn_s_sleep(1); \
    if ((++_sp & 255u) == 0u) { if (xb_ld(&(bar)[XB_TMO])) break; if (_sp > XB_SPIN_CAP) { atomicAdd(&(bar)[XB_TMO], 1u); break; } } } } while (0)

struct XcdBarrier {
    unsigned* bar; unsigned x;
    volatile LAS unsigned* st;
};

__device__ __forceinline__ XcdBarrier xcd_barrier_post(unsigned* bar, volatile LAS unsigned* st) {
    XcdBarrier b; b.bar = bar; b.x = xb_xcc_id(); b.st = st;
    if (threadIdx.x == 0) (void)xb_add(&bar[XB_XCNT(b.x)], 1u);
    return b;
}
__device__ __forceinline__ void xcd_barrier_complete(unsigned* bar, unsigned x, unsigned& nloc, unsigned& nx) {
    const unsigned G = gridDim.x * gridDim.y * gridDim.z;
    unsigned sum, cnt, mine, sp = 0u;
    for (;;) {
        sum = 0u; cnt = 0u; mine = 0u;
#pragma unroll
        for (unsigned j = 0; j < 16; ++j) { const unsigned c = xb_ld(&bar[XB_XCNT(j)]); sum += c; cnt += (c > 0u) ? 1u : 0u; mine = (j == x) ? c : mine; }
        if (sum == G) break;
        __builtin_amdgcn_s_sleep(1);
        if ((++sp & 255u) == 0u) { if (xb_ld(&bar[XB_TMO])) break; if (sp > XB_SPIN_CAP) { atomicAdd(&bar[XB_TMO], 1u); break; } }
    }
    nloc = mine > 0u ? mine : 1u; nx = cnt > 0u ? cnt : 1u;
}

__device__ __forceinline__ void xcd_barrier(const XcdBarrier& b) {
    asm volatile("s_waitcnt vmcnt(0)" ::: "memory");
    __syncthreads();
    if (threadIdx.x == 0) {
        unsigned* bar = b.bar;
        __builtin_amdgcn_s_waitcnt(0);
        unsigned nloc = b.st[0], nx = b.st[1];
        if (nloc == 0u) { xcd_barrier_complete(bar, b.x, nloc, nx); b.st[0] = nloc; b.st[1] = nx; }
        const unsigned old = xb_add(&bar[XB_XSUB(b.x)], 1u);
        const unsigned gen = old / nloc;
        if (old + 1u == (gen + 1u) * nloc) {
            __builtin_amdgcn_fence(__ATOMIC_RELEASE, "agent");
            asm volatile("s_waitcnt vmcnt(0)" ::: "memory");
            const unsigned og = xb_add(&bar[XB_TOP], 1u);
            const unsigned tg = og / nx;
            if (og + 1u == (tg + 1u) * nx) xb_add(&bar[XB_TOPGEN], 1u);
            else XB_SPIN(xb_ld(&bar[XB_TOPGEN]) == tg, bar);
            __builtin_amdgcn_fence(__ATOMIC_ACQUIRE, "agent");
            xb_add(&bar[XB_XGEN(b.x)], 1u);
            asm volatile("s_waitcnt vmcnt(0)" ::: "memory");
        } else {
            XB_SPIN(xb_ld(&bar[XB_XGEN(b.x)]) == gen, bar);
            __builtin_amdgcn_fence(__ATOMIC_ACQUIRE, "agent");
            asm volatile("s_waitcnt vmcnt(0)" ::: "memory");
        }
    }
    __syncthreads();
}


constexpr int N_PHASES = 15;
constexpr int CW_BAR = 4096;
constexpr size_t CTL_ZERO_BYTES = 64 * 1024;
constexpr int MISC_OFF = LDS_BYTES - 256;

template <int PH>
__device__ __forceinline__ void run_phase(const Ctx& C, const Args& a) {
    bf16_t* R0 = C.bfp(WS_R0); bf16_t* R1 = C.bfp(WS_R1); bf16_t* R2 = C.bfp(WS_R2); bf16_t* R3 = C.bfp(WS_R3);
    bf16_t* OB = (bf16_t*)a.out;
    const size_t TD = (size_t)T * 1024;
    if constexpr (PH == 0) p_prep(C);
    if constexpr (PH == 1) p_rownorm(C, C.in[0], C.in[4], 0, 1024, R0);
    if constexpr (PH == 2) {
        { pg8::Gemm g{R0, C.bfp(WS_WIN_T), T, 6144, 1024}; pg8::StaticOrder S; S.init(T, 6144, C.G, C.bid);
          pg8::EpiInProj e{R1, R2, R3, R3 + TD, R3 + 2 * TD};
          pg8::gemm_phase<pg8::EpiInProj, pg8::StaticOrder, true, true>(C.lds, g, S, e); }
        EDt ed{C.f32p(WS_DT), C.in[8], C.in[9]};
        naive_gemm(C, R0, C.bfp(WS_WDT_T), T, 32, 1024, ed);
    }
    if constexpr (PH == 3) p_conv(C, R2, OB);
#ifdef DIAG_SSD
    if constexpr (PH == 4) p_ssd_naive(C, OB, C.f32p(WS_DT), R2, R2 + TD);
    if constexpr (PH == 6) p_ssd(C, OB, C.f32p(WS_DT), R3 + TD, R3 + 2 * TD);
    if constexpr (PH == 7) p_diag_cmp(C, R2, R3 + TD, 2 * TD, (unsigned*)(a.ws + WS_CTL) + 1024);
    if constexpr (PH == 8) p_diag_out(C, (unsigned*)(a.ws + WS_CTL) + 1024, a.out);
#else
    if constexpr (PH == 4) p_ssd(C, OB, C.f32p(WS_DT), R2, R2 + TD);
#endif
    if constexpr (PH == 5) p_na(C, R3, R3 + TD, R3 + 2 * TD);
#ifndef DIAG_SSD
    if constexpr (PH == 6) p_combine(C, R2, R2 + TD, R1, C.f32p(WS_RSTD));
    if constexpr (PH == 7) { pg8::Gemm g{R0, C.bfp(WS_WG_T), T, 2048, 1024}; pg8::StaticOrder S; S.init(T, 2048, C.G, C.bid);
        pg8::EpiGate e{OB, TD}; pg8::gemm_phase<pg8::EpiGate, pg8::StaticOrder, true, true>(C.lds, g, S, e); }
    if constexpr (PH == 8) { pg8::Gemm g{R1, C.bfp(WS_WSSD_T), T, 1024, 1024}; pg8::StaticOrder S; S.init(T, 1024, C.G, C.bid);
        pg8::EpiD1 e{R2, OB, C.f32p(WS_RSTD)}; pg8::gemm_phase<pg8::EpiD1, pg8::StaticOrder, true, true>(C.lds, g, S, e); }
    if constexpr (PH == 9) { pg8::Gemm g{R3, C.bfp(WS_WNA_T), T, 1024, 1024}; pg8::StaticOrder S; S.init(T, 1024, C.G, C.bid);
        pg8::EpiD2 e{R2 + TD, R2, OB + TD}; pg8::gemm_phase<pg8::EpiD2, pg8::StaticOrder, true, true>(C.lds, g, S, e); }
    if constexpr (PH == 10) { pg8::Gemm g{R2 + TD, C.bfp(WS_WOUT_T), T, 1024, 1024}; pg8::StaticOrder S; S.init(T, 1024, C.G, C.bid);
        pg8::EpiD3 e{(float*)(R3 + TD), C.in[0], C.f32p(WS_MOD)}; pg8::gemm_phase<pg8::EpiD3, pg8::StaticOrder, true, true>(C.lds, g, S, e); }
    if constexpr (PH == 11) { p_rownorm(C, (const float*)(R3 + TD), C.in[18], 3072, 4096, R0); p_cvt_tables(C, R2, R2 + (size_t)16384 * 1024); }
    if constexpr (PH == 12) { pg8::Gemm g{R0, C.bfp(WS_WPQ_T), T, 2048, 1024}; pg8::StaticOrder S; S.init(T, 2048, C.G, C.bid);
        pg8::EpiQp e{OB}; pg8::gemm_phase<pg8::EpiQp, pg8::StaticOrder, true, true>(C.lds, g, S, e); }
    if constexpr (PH == 13) p_topk(C, OB, C.bfp(WS_KEYS), (unsigned short*)R1, (float*)(R1 + 4 * MiB));
    if constexpr (PH == 14) p_gather(C, R0, (const unsigned short*)R1, (const float*)(R1 + 4 * MiB), R2, R2 + (size_t)16384 * 1024, (const float*)(R3 + TD), a.out);
#endif
}

template <int PH> struct PhaseLoop {
    static __device__ __forceinline__ void run(const Ctx& C, const Args& a, const XcdBarrier& bar) {
        if (PH >= a.ph_lo && PH < a.ph_hi) { run_phase<PH>(C, a); if (PH + 1 < a.ph_hi) xcd_barrier(bar); }
        PhaseLoop<PH + 1>::run(C, a, bar);
    }
};
template <> struct PhaseLoop<N_PHASES> { static __device__ __forceinline__ void run(const Ctx&, const Args&, const XcdBarrier&) {} };

__global__ void __launch_bounds__(NTHR, 2) mega(Args a) {
    extern __shared__ __attribute__((aligned(16))) unsigned char lds_raw[];
    Ctx C; C.in = a.in; C.out = a.out; C.ws = a.ws; C.tid = threadIdx.x; C.lane = C.tid & 63; C.wave = __builtin_amdgcn_readfirstlane(C.tid >> 6);
    C.G = gridDim.x; C.bid = blockIdx.x; C.lds = (LAS unsigned char*)lds_raw;
    volatile LAS unsigned* MISC = (volatile LAS unsigned*)(C.lds + MISC_OFF);
    if (C.tid < 64) MISC[C.tid] = 0u;
    __syncthreads();
    XcdBarrier bar; bar.bar = (unsigned*)(a.ws + WS_CTL) + CW_BAR; bar.x = 0; bar.st = nullptr;
    if (a.ph_hi - a.ph_lo > 1) bar = xcd_barrier_post((unsigned*)(a.ws + WS_CTL) + CW_BAR, MISC + 8);
    PhaseLoop<0>::run(C, a, bar);
}

extern "C" void kernel_launch(void* const* d_in, const int* in_sizes, int n_in, void* d_out, int out_size, void* d_ws, size_t ws_size, hipStream_t stream) {
    static int grid = 0;
    if (grid == 0) {
        if (n_in != 24 || out_size != T * D || ws_size < WS_END) { fprintf(stderr, "kernel_launch: unexpected shapes n_in %d out %d ws %zu\n", n_in, out_size, ws_size); grid = -1; return; }
        int dev = 0, cus = 0;
        if (hipGetDevice(&dev) != hipSuccess || hipDeviceGetAttribute(&cus, hipDeviceAttributeMultiprocessorCount, dev) != hipSuccess) { grid = -1; return; }
        if (hipFuncSetAttribute((const void*)mega, hipFuncAttributeMaxDynamicSharedMemorySize, LDS_BYTES) != hipSuccess) { grid = -1; return; }
        grid = cus;
    }
    if (grid < 0) return;
    (void)hipMemsetAsync((char*)d_ws + WS_CTL, 0, CTL_ZERO_BYTES, stream);
    Args a{};
    for (int i = 0; i < 24; ++i) a.in[i] = (const float*)d_in[i];
    a.out = (float*)d_out; a.ws = (unsigned char*)d_ws;
#ifdef DIAG_SSD
    for (int ph = 0; ph < 9; ++ph) { a.ph_lo = ph; a.ph_hi = ph + 1; hipLaunchKernelGGL(mega, dim3(grid), dim3(NTHR), LDS_BYTES, stream, a); }
#else
    a.ph_lo = 0; a.ph_hi = N_PHASES;
    hipLaunchKernelGGL(mega, dim3(grid), dim3(NTHR), LDS_BYTES, stream, a);
#endif
}
```

```cpp
#include <hip/hip_runtime.h>
#include <cstdio>
#include <cstdint>

#define LAS __attribute__((address_space(3)))
typedef unsigned short bf16_t;
typedef float f32x4 __attribute__((ext_vector_type(4)));
typedef unsigned u32x4 __attribute__((ext_vector_type(4)));
typedef unsigned u32x2 __attribute__((ext_vector_type(2)));
typedef __bf16 bf16x2_t __attribute__((ext_vector_type(2)));

constexpr int T = 32768, D = 1024, NB = 8, SEQ = 4096;
constexpr int NWAVES = 8, NTHR = 512;
constexpr float EPS = 1e-6f;
constexpr int OFF_Z = 0, OFF_XBC = 1024, OFF_DTF = 3072, OFF_DTB = 3088, OFF_QKV = 3104, OFF_GS = 6176, OFF_GN = 7200, D_IN = 8224;

constexpr size_t MiB = 1u << 20;
constexpr size_t WS_CTL = 0;
constexpr size_t WS_MOD = 1 * MiB;
constexpr size_t WS_RSTD = 1 * MiB + 512 * 1024;
constexpr size_t WS_DT = 2 * MiB;
constexpr size_t WS_WIN_T = 6 * MiB;
constexpr size_t WS_WG_T = 18 * MiB;
constexpr size_t WS_WDT_T = 22 * MiB;
constexpr size_t WS_KEYS = 22 * MiB + 512 * 1024;
constexpr size_t WS_WSSD_T = 23 * MiB, WS_WNA_T = 25 * MiB, WS_WOUT_T = 27 * MiB, WS_WPQ_T = 29 * MiB;
constexpr size_t WS_R0 = 40 * MiB, WS_R1 = 104 * MiB, WS_R2 = 168 * MiB, WS_R3 = 296 * MiB, WS_END = 488 * MiB;

constexpr int LDS_BYTES = 147456;

struct Args { const float* in[24]; float* out; unsigned char* ws; int ph_lo, ph_hi; };

__device__ __forceinline__ float bf2f(unsigned v) { return __uint_as_float(v << 16); }
__device__ __forceinline__ float bflo(unsigned v) { return __uint_as_float(v << 16); }
__device__ __forceinline__ float bfhi(unsigned v) { return __uint_as_float(v & 0xffff0000u); }
__device__ __forceinline__ unsigned f2bf(float f) { unsigned u = __float_as_uint(f); return (u + 0x7fffu + ((u >> 16) & 1u)) >> 16; }
typedef float f32x2_t __attribute__((ext_vector_type(2)));
__device__ __forceinline__ unsigned pk2(float lo, float hi) { f32x2_t v = {lo, hi}; bf16x2_t b = __builtin_convertvector(v, bf16x2_t); return __builtin_bit_cast(unsigned, b); }
__device__ __forceinline__ float wave_sum(float v) {
#pragma unroll
    for (int o = 1; o < 64; o <<= 1) v += __shfl_xor(v, o);
    return v;
}
__device__ __forceinline__ float silu_f(float x) { return x / (1.f + __expf(-x)); }
__device__ __forceinline__ float sigmoid_f(float x) { return 1.f / (1.f + __expf(-x)); }
__device__ __forceinline__ float softplus_f(float x) { return x > 20.f ? x : log1pf(__expf(x)); }
__device__ __forceinline__ float gelu_f(float x) { return 0.5f * x * (1.f + erff(x * 0.70710678118654752f)); }

struct Ctx {
    const float* const* in; float* out; unsigned char* ws;
    int tid, lane, wave, G, bid;
    LAS unsigned char* lds;
    __device__ __forceinline__ float* f32p(size_t off) const { return (float*)(ws + off); }
    __device__ __forceinline__ bf16_t* bfp(size_t off) const { return (bf16_t*)(ws + off); }
};

__device__ __forceinline__ void p_prep(const Ctx& C) {
    const int gt = C.bid * NTHR + C.tid, NT = C.G * NTHR;
    const float* c = C.in[1]; const float* w_ada = C.in[2]; const float* b_ada = C.in[3];
    float* mod = C.f32p(WS_MOD);
    for (int i = gt; i < NB * 6144; i += NT) {
        const int b = i / 6144, j = i % 6144; float acc = 0.f;
        for (int k = 0; k < D; ++k) acc += silu_f(c[b * D + k]) * w_ada[(size_t)k * 6144 + j];
        mod[i] = acc + b_ada[j];
    }
    const float* w_in = C.in[5];
    {
        bf16_t* wt = C.bfp(WS_WIN_T);
        for (int i = gt; i < 6144 * (D / 8); i += NT) { const int n = i % 6144, k8 = i / 6144; const int col = n < 3072 ? n : OFF_QKV + (n - 3072);
            u32x4 o; const float* s = w_in + (size_t)(k8 * 8) * D_IN + col;
            o.x = pk2(s[0], s[(size_t)D_IN]); o.y = pk2(s[2 * (size_t)D_IN], s[3 * (size_t)D_IN]); o.z = pk2(s[4 * (size_t)D_IN], s[5 * (size_t)D_IN]); o.w = pk2(s[6 * (size_t)D_IN], s[7 * (size_t)D_IN]);
            *(u32x4*)(wt + (size_t)n * D + k8 * 8) = o; }
    }
    {
        bf16_t* wt = C.bfp(WS_WG_T);
        for (int i = gt; i < 2048 * (D / 8); i += NT) { const int n = i % 2048, k8 = i / 2048; const int col = OFF_GS + n;
            u32x4 o; const float* s = w_in + (size_t)(k8 * 8) * D_IN + col;
            o.x = pk2(s[0], s[(size_t)D_IN]); o.y = pk2(s[2 * (size_t)D_IN], s[3 * (size_t)D_IN]); o.z = pk2(s[4 * (size_t)D_IN], s[5 * (size_t)D_IN]); o.w = pk2(s[6 * (size_t)D_IN], s[7 * (size_t)D_IN]);
            *(u32x4*)(wt + (size_t)n * D + k8 * 8) = o; }
    }
    {
        bf16_t* wt = C.bfp(WS_WDT_T);
        for (int i = gt; i < 32 * (D / 8); i += NT) { const int n = i % 32, k8 = i / 32; const int col = OFF_DTF + n;
            u32x4 o; const float* s = w_in + (size_t)(k8 * 8) * D_IN + col;
            o.x = pk2(s[0], s[(size_t)D_IN]); o.y = pk2(s[2 * (size_t)D_IN], s[3 * (size_t)D_IN]); o.z = pk2(s[4 * (size_t)D_IN], s[5 * (size_t)D_IN]); o.w = pk2(s[6 * (size_t)D_IN], s[7 * (size_t)D_IN]);
            *(u32x4*)(wt + (size_t)n * D + k8 * 8) = o; }
    }
    {
        const float* gk = C.in[13];
        const float* srcs[3] = {C.in[14], C.in[16], C.in[17]};
        const size_t dsts[3] = {WS_WSSD_T, WS_WNA_T, WS_WOUT_T};
#pragma unroll
        for (int w = 0; w < 3; ++w) {
            const float* W = srcs[w]; bf16_t* wt = C.bfp(dsts[w]);
            for (int i = gt; i < D * (D / 8); i += NT) { const int n = i % D, k8 = i / D; const float* s = W + (size_t)(k8 * 8) * D + n;
                float v[8];
#pragma unroll
                for (int q = 0; q < 8; ++q) v[q] = s[(size_t)q * D] * (w == 0 ? gk[k8 * 8 + q] : 1.f);
                u32x4 o; o.x = pk2(v[0], v[1]); o.y = pk2(v[2], v[3]); o.z = pk2(v[4], v[5]); o.w = pk2(v[6], v[7]);
                *(u32x4*)(wt + (size_t)n * D + k8 * 8) = o; }
        }
    }
    {
        const float* W = C.in[19]; bf16_t* wt = C.bfp(WS_WPQ_T);
        for (int i = gt; i < 2048 * (D / 8); i += NT) { const int n = i % 2048, k8 = i / 2048; const float* s = W + (size_t)(k8 * 8) * 2048 + n;
            u32x4 o; o.x = pk2(s[0], s[2048]); o.y = pk2(s[2 * 2048], s[3 * 2048]); o.z = pk2(s[4 * 2048], s[5 * 2048]); o.w = pk2(s[6 * 2048], s[7 * 2048]);
            *(u32x4*)(wt + (size_t)n * D + k8 * 8) = o; }
    }
    {
        const float* kf = C.in[20]; bf16_t* kb = C.bfp(WS_KEYS);
        for (int i = gt; i < 2 * 128 * 128; i += NT) kb[i] = (bf16_t)f2bf(kf[i]);
    }
}

__device__ __forceinline__ void p_rownorm(const Ctx& C, const float* X, const float* gamma, int sh_off, int sc_off, bf16_t* dst) {
    const float* mod = C.f32p(WS_MOD);
    const int gw = C.bid * NWAVES + C.wave, NGW = C.G * NWAVES;
    for (int row = gw; row < T; row += NGW) {
        const int b = row / SEQ;
        const f32x4* xr = (const f32x4*)(X + (size_t)row * D) + C.lane;
        f32x4 v[4]; float s = 0.f;
#pragma unroll
        for (int j = 0; j < 4; ++j) { v[j] = xr[64 * j]; s += (v[j].x * v[j].x + v[j].y * v[j].y) + (v[j].z * v[j].z + v[j].w * v[j].w); }
        const float rstd = rsqrtf(wave_sum(s) * (1.f / D) + EPS);
        u32x2* o8 = (u32x2*)(dst + (size_t)row * D) + C.lane;
#pragma unroll
        for (int j = 0; j < 4; ++j) {
            const int col = 4 * C.lane + 256 * j;
            const f32x4 g = *(const f32x4*)(gamma + col), sh = *(const f32x4*)(mod + b * 6144 + sh_off + col), sc = *(const f32x4*)(mod + b * 6144 + sc_off + col);
            f32x4 y = v[j] * rstd * g * (sc + 1.f) + sh;
            u32x2 w; w.x = pk2(y.x, y.y); w.y = pk2(y.z, y.w); o8[64 * j] = w;
        }
    }
}

template <class Epi>
__device__ __forceinline__ void naive_gemm(const Ctx& C, const bf16_t* A, const bf16_t* Bt, int M, int N, int K, const Epi& E) {
    LAS float* As = (LAS float*)C.lds;
    LAS float* Bs = (LAS float*)(C.lds + 32 * 132 * 4);
    const int tilesN = (N + 63) / 64, tilesM = M / 128, ntiles = tilesM * tilesN;
    const int ty = C.tid >> 4, tx = C.tid & 15;
    for (int tile = C.bid; tile < ntiles; tile += C.G) {
        const int tm = tile / tilesN, tn = tile % tilesN, m0 = tm * 128, n0 = tn * 64;
        float acc[4][4];
#pragma unroll
        for (int i = 0; i < 4; ++i)
#pragma unroll
            for (int j = 0; j < 4; ++j) acc[i][j] = 0.f;
        for (int k0 = 0; k0 < K; k0 += 32) {
            __syncthreads();
            {
                const int r = C.tid >> 2, kc = (C.tid & 3) * 8;
                const u32x4 v = *(const u32x4*)(A + (size_t)(m0 + r) * K + k0 + kc);
                As[(kc + 0) * 132 + r] = bflo(v.x); As[(kc + 1) * 132 + r] = bfhi(v.x); As[(kc + 2) * 132 + r] = bflo(v.y); As[(kc + 3) * 132 + r] = bfhi(v.y);
                As[(kc + 4) * 132 + r] = bflo(v.z); As[(kc + 5) * 132 + r] = bfhi(v.z); As[(kc + 6) * 132 + r] = bflo(v.w); As[(kc + 7) * 132 + r] = bfhi(v.w);
            }
            if (C.tid < 256) {
                const int r = C.tid >> 2, kc = (C.tid & 3) * 8;
                u32x4 v = (u32x4){0u, 0u, 0u, 0u};
                if (n0 + r < N) v = *(const u32x4*)(Bt + (size_t)(n0 + r) * K + k0 + kc);
                Bs[(kc + 0) * 68 + r] = bflo(v.x); Bs[(kc + 1) * 68 + r] = bfhi(v.x); Bs[(kc + 2) * 68 + r] = bflo(v.y); Bs[(kc + 3) * 68 + r] = bfhi(v.y);
                Bs[(kc + 4) * 68 + r] = bflo(v.z); Bs[(kc + 5) * 68 + r] = bfhi(v.z); Bs[(kc + 6) * 68 + r] = bflo(v.w); Bs[(kc + 7) * 68 + r] = bfhi(v.w);
            }
            __syncthreads();
#pragma unroll 8
            for (int k = 0; k < 32; ++k) {
                const f32x4 a = *(const LAS f32x4*)(As + k * 132 + ty * 4);
                const f32x4 b = *(const LAS f32x4*)(Bs + k * 68 + tx * 4);
#pragma unroll
                for (int i = 0; i < 4; ++i)
#pragma unroll
                    for (int j = 0; j < 4; ++j) acc[i][j] += a[i] * b[j];
            }
        }
#pragma unroll
        for (int i = 0; i < 4; ++i)
#pragma unroll
            for (int j = 0; j < 4; ++j) { const int col = n0 + tx * 4 + j; if (col < N) E(m0 + ty * 4 + i, col, acc[i][j]); }
    }
    __syncthreads();
}

struct EInProj { bf16_t *sz, *xbc, *q, *k, *v;
    __device__ __forceinline__ void operator()(int r, int c, float x) const {
        if (c < 1024) sz[(size_t)r * 1024 + c] = (bf16_t)f2bf(silu_f(x));
        else if (c < 3072) xbc[(size_t)r * 2048 + (c - 1024)] = (bf16_t)f2bf(x);
        else if (c < 4096) q[(size_t)r * 1024 + (c - 3072)] = (bf16_t)f2bf(x * 0.125f);
        else if (c < 5120) k[(size_t)r * 1024 + (c - 4096)] = (bf16_t)f2bf(x);
        else v[(size_t)r * 1024 + (c - 5120)] = (bf16_t)f2bf(x);
    } };
struct EDt { float* dt; const float *bf, *bb;
    __device__ __forceinline__ void operator()(int r, int c, float x) const { const float bias = c < 16 ? bf[c] : bb[c - 16]; dt[(size_t)r * 32 + c] = softplus_f(x + bias); } };
struct EGate { bf16_t* sg;
    __device__ __forceinline__ void operator()(int r, int c, float x) const { sg[(size_t)(c >> 10) * T * 1024 + (size_t)r * 1024 + (c & 1023)] = (bf16_t)f2bf(sigmoid_f(x)); } };
struct ED1 { bf16_t* p1; const bf16_t* sg1; const float* rstd;
    __device__ __forceinline__ void operator()(int r, int c, float x) const { const size_t i = (size_t)r * 1024 + c; p1[i] = (bf16_t)f2bf(x * rstd[r] * bf2f(sg1[i])); } };
struct ED2 { bf16_t* mixed; const bf16_t *p1, *sg2;
    __device__ __forceinline__ void operator()(int r, int c, float x) const { const size_t i = (size_t)r * 1024 + c; mixed[i] = (bf16_t)f2bf(bf2f(p1[i]) + bf2f(sg2[i]) * x); } };
struct ED3 { float* h; const float* x; const float* mod;
    __device__ __forceinline__ void operator()(int r, int c, float v) const { const size_t i = (size_t)r * 1024 + c; h[i] = x[i] + mod[(r / SEQ) * 6144 + 2048 + c] * v; } };
struct EQp { bf16_t* qp;
    __device__ __forceinline__ void operator()(int r, int c, float v) const { qp[(size_t)r * 2048 + c] = (bf16_t)f2bf(v); } };

__device__ __forceinline__ void p_conv(const Ctx& C, const bf16_t* xbc, bf16_t* xc) {
    const float* cw = C.in[6]; const float* cb = C.in[7];
    const int gt = C.bid * NTHR + C.tid, NT = C.G * NTHR;
    for (int i = gt; i < T * 256; i += NT) {
        const int t = i >> 8, cg = i & 255, l = t & (SEQ - 1), ch = cg * 8;
        float acc[8];
#pragma unroll
        for (int q = 0; q < 8; ++q) acc[q] = cb[ch + q];
#pragma unroll
        for (int j = 0; j < 5; ++j) {
            const int ll = l + j - 2;
            if (ll >= 0 && ll < SEQ) {
                const u32x4 v = *(const u32x4*)(xbc + (size_t)(t + j - 2) * 2048 + ch);
                const f32x4 w0 = *(const f32x4*)(cw + j * 2048 + ch), w1 = *(const f32x4*)(cw + j * 2048 + ch + 4);
                acc[0] += w0.x * bflo(v.x); acc[1] += w0.y * bfhi(v.x); acc[2] += w0.z * bflo(v.y); acc[3] += w0.w * bfhi(v.y);
                acc[4] += w1.x * bflo(v.z); acc[5] += w1.y * bfhi(v.z); acc[6] += w1.z * bflo(v.w); acc[7] += w1.w * bfhi(v.w);
            }
        }
        u32x4 o; o.x = pk2(silu_f(acc[0]), silu_f(acc[1])); o.y = pk2(silu_f(acc[2]), silu_f(acc[3])); o.z = pk2(silu_f(acc[4]), silu_f(acc[5])); o.w = pk2(silu_f(acc[6]), silu_f(acc[7]));
        *(u32x4*)(xc + (size_t)t * 2048 + ch) = o;
    }
}

__device__ __forceinline__ void p_ssd_naive(const Ctx& C, const bf16_t* xc, const float* dtb, bf16_t* yf, bf16_t* yb) {
    if (C.wave == 0)
    for (int unit = C.bid; unit < 256; unit += C.G) {
        const int dir = unit & 1, hd = (unit >> 1) & 15, b = unit >> 5, g = hd >> 2, p = C.lane;
        const float a = -__expf((dir ? C.in[11] : C.in[10])[hd]);
        const float dsk = C.in[12][hd];
        float h[128];
#pragma unroll
        for (int n = 0; n < 128; ++n) h[n] = 0.f;
        for (int s = 0; s < SEQ; ++s) {
#ifdef DIAG_LOCAL
            if ((s & 127) == 0) {
#pragma unroll
                for (int n = 0; n < 128; ++n) h[n] = 0.f; }
#endif
            const int t = dir ? (SEQ - 1 - s) : s; const size_t row = (size_t)b * SEQ + t;
            const float dt = dtb[row * 32 + dir * 16 + hd];
            const float dA = __expf(dt * a);
            const float x = bf2f(xc[row * 2048 + hd * 64 + p]);
            const float xdt = x * dt;
            const u32x4* Bp = (const u32x4*)(xc + row * 2048 + 1024 + g * 128);
            const u32x4* Cp = (const u32x4*)(xc + row * 2048 + 1536 + g * 128);
            float y = 0.f;
#pragma unroll
            for (int n8 = 0; n8 < 16; ++n8) {
                const u32x4 bv = Bp[n8], cv = Cp[n8];
                const float bb[8] = {bflo(bv.x), bfhi(bv.x), bflo(bv.y), bfhi(bv.y), bflo(bv.z), bfhi(bv.z), bflo(bv.w), bfhi(bv.w)};
                const float cc[8] = {bflo(cv.x), bfhi(cv.x), bflo(cv.y), bfhi(cv.y), bflo(cv.z), bfhi(cv.z), bflo(cv.w), bfhi(cv.w)};
#pragma unroll
                for (int q = 0; q < 8; ++q) { const int n = n8 * 8 + q; h[n] = dA * h[n] + xdt * bb[q]; y += cc[q] * h[n]; }
            }
            if (dir == 0) yf[row * 1024 + hd * 64 + p] = (bf16_t)f2bf(y + dsk * x);
            else yb[row * 1024 + hd * 64 + p] = (bf16_t)f2bf(y);
        }
    }
}


namespace ssd {
typedef short bf16x8 __attribute__((ext_vector_type(8)));
typedef short s16x4 __attribute__((ext_vector_type(4)));
constexpr int RS = 272, RSX = 144;
constexpr int CN = 0, BN = 34816, BS = 69632, SL = 104448, XN = 121856, CSB = 140288;
__device__ __forceinline__ bf16x8 trfrag(LAS unsigned char* base, int stride, int ks, int c, int g, int q, int pp) {
    LAS unsigned char* a0 = base + (32 * ks + 8 * g + q) * stride + 32 * c + 8 * pp;
    const s16x4 v0 = __builtin_amdgcn_ds_read_tr16_b64_v4i16((LAS s16x4*)a0);
    const s16x4 v1 = __builtin_amdgcn_ds_read_tr16_b64_v4i16((LAS s16x4*)(a0 + 4 * stride));
    bf16x8 r; r[0] = v0[0]; r[1] = v0[1]; r[2] = v0[2]; r[3] = v0[3]; r[4] = v1[0]; r[5] = v1[1]; r[6] = v1[2]; r[7] = v1[3]; return r;
}
__device__ __forceinline__ unsigned pkbf(float lo, float hi) { return pk2(lo, hi); }
}
__device__ __forceinline__ void p_ssd(const Ctx& C, const bf16_t* xc, const float* dtb, bf16_t* yf, bf16_t* yb) {
    using namespace ssd;
    LAS unsigned char* L = C.lds;
    const int tid = C.tid, lane = C.lane, w = C.wave, g = lane >> 4, i16 = lane & 15, q = (lane >> 2) & 3, pp = lane & 3;
    for (int unit = C.bid; unit < 256; unit += C.G) {
        const int dir = unit & 1, hd = (unit >> 1) & 15, b = unit >> 5, grp = hd >> 2;
        const float a = -__expf((dir ? C.in[11] : C.in[10])[hd]);
        const float dsk = dir ? 0.f : C.in[12][hd];
        bf16_t* yout = dir ? yb : yf;
        f32x4 sacc[4];
#pragma unroll
        for (int pt = 0; pt < 4; ++pt) sacc[pt] = (f32x4){0.f, 0.f, 0.f, 0.f};
        __syncthreads();
        for (int i = tid; i < 17408 / 4; i += NTHR) ((LAS unsigned*)(L + SL))[i] = 0u;
        u32x4 pfC[4], pfB[4], pfX[2]; float pfd0 = 0.f, pfd1 = 0.f;
#define SSD_ISSUE(ci_) do { const int c_ = dir ? (31 - (ci_)) : (ci_); const size_t t0_ = (size_t)b * SEQ + (size_t)c_ * 128; \
            _Pragma("unroll") for (int i_ = 0; i_ < 4; ++i_) { const int idx_ = tid + NTHR * i_, l_ = idx_ >> 4, cc_ = idx_ & 15; const bf16_t* rp_ = xc + (t0_ + l_) * 2048 + grp * 128 + cc_ * 8; \
                pfB[i_] = *(const u32x4*)(rp_ + 1024); pfC[i_] = *(const u32x4*)(rp_ + 1536); } \
            _Pragma("unroll") for (int i_ = 0; i_ < 2; ++i_) { const int idx_ = tid + NTHR * i_, l_ = idx_ >> 3, cc_ = idx_ & 7; pfX[i_] = *(const u32x4*)(xc + (t0_ + l_) * 2048 + hd * 64 + cc_ * 8); } \
            if (w == 0) { const int l0_ = dir ? (127 - 2 * lane) : (2 * lane), l1_ = dir ? (126 - 2 * lane) : (2 * lane + 1); \
                pfd0 = dtb[(t0_ + l0_) * 32 + dir * 16 + hd]; pfd1 = dtb[(t0_ + l1_) * 32 + dir * 16 + hd]; } } while (0)
#define SSD_SCAN(buf_) do { if (w == 0) { const float da0_ = pfd0 * a, da1_ = pfd1 * a; const float p1_ = da0_ + da1_; float s_ = p1_; \
            _Pragma("unroll") for (int o_ = 1; o_ < 64; o_ <<= 1) { const float t_ = __shfl_up(s_, o_); if (lane >= o_) s_ += t_; } \
            const float ex_ = s_ - p1_, cs0_ = ex_ + da0_, cs1_ = ex_ + p1_, tot_ = __shfl(s_, 63); \
            const int l0_ = dir ? (127 - 2 * lane) : (2 * lane), l1_ = dir ? (126 - 2 * lane) : (2 * lane + 1); \
            LAS float* cb_ = (LAS float*)(L + CSB + (buf_) * 1536); \
            cb_[l0_] = cs0_; cb_[l1_] = cs1_; cb_[128 + l0_] = pfd0; cb_[128 + l1_] = pfd1; cb_[256 + l0_] = pfd0 * __expf(tot_ - cs0_); cb_[256 + l1_] = pfd1 * __expf(tot_ - cs1_); \
            if (lane == 0) *(LAS float*)(L + CSB + 3072 + 8 * (buf_)) = tot_; } } while (0)
#define SSD_WRITE(buf_) do { const LAS float* dw_ = (const LAS float*)(L + CSB + (buf_) * 1536 + 1024); \
            _Pragma("unroll") for (int i_ = 0; i_ < 4; ++i_) { const int idx_ = tid + NTHR * i_, l_ = idx_ >> 4, cc_ = idx_ & 15; \
                *(LAS u32x4*)(L + CN + l_ * RS + cc_ * 16) = pfC[i_]; *(LAS u32x4*)(L + BN + l_ * RS + cc_ * 16) = pfB[i_]; \
                const float sc_ = dw_[l_]; const u32x4 v_ = pfB[i_]; u32x4 o_; \
                o_.x = pkbf(bflo(v_.x) * sc_, bfhi(v_.x) * sc_); o_.y = pkbf(bflo(v_.y) * sc_, bfhi(v_.y) * sc_); o_.z = pkbf(bflo(v_.z) * sc_, bfhi(v_.z) * sc_); o_.w = pkbf(bflo(v_.w) * sc_, bfhi(v_.w) * sc_); \
                *(LAS u32x4*)(L + BS + l_ * RS + cc_ * 16) = o_; } \
            _Pragma("unroll") for (int i_ = 0; i_ < 2; ++i_) { const int idx_ = tid + NTHR * i_, l_ = idx_ >> 3, cc_ = idx_ & 7; *(LAS u32x4*)(L + XN + l_ * RSX + cc_ * 16) = pfX[i_]; } } while (0)
        SSD_ISSUE(0);
        SSD_SCAN(0);
        __syncthreads();
        SSD_WRITE(0);
        __syncthreads();
        for (int ci = 0; ci < 32; ++ci) {
            const int buf = ci & 1;
            const int c = dir ? (31 - ci) : ci; const size_t t0 = (size_t)b * SEQ + (size_t)c * 128;
            if (ci + 1 < 32) SSD_ISSUE(ci + 1);
            const LAS float* csb = (const LAS float*)(L + CSB + buf * 1536);
            const float cs_l = csb[16 * w + i16];
            const float cs_end = *(const LAS float*)(L + CSB + 3072 + 8 * buf);
            bf16x8 cfrag[4];
#pragma unroll
            for (int ks = 0; ks < 4; ++ks) cfrag[ks] = *(const LAS bf16x8*)(L + CN + (16 * w + i16) * RS + ks * 64 + g * 16);
            u32x2 mreg[8];
            const int lrow = 16 * w + i16;
#pragma unroll
            for (int st = 0; st < 8; ++st) {
                f32x4 acc = (f32x4){0.f, 0.f, 0.f, 0.f};
#pragma unroll
                for (int ks = 0; ks < 4; ++ks) { const bf16x8 af = *(const LAS bf16x8*)(L + BN + (16 * st + i16) * RS + ks * 64 + g * 16);
                    acc = __builtin_amdgcn_mfma_f32_16x16x32_bf16(af, cfrag[ks], acc, 0, 0, 0); }
                const f32x4 cs_s = *(const LAS f32x4*)(csb + 16 * st + 4 * g), dt_s = *(const LAS f32x4*)(csb + 128 + 16 * st + 4 * g);
                float mv[4];
#pragma unroll
                for (int r = 0; r < 4; ++r) { const int srow = 16 * st + 4 * g + r; const bool valid = dir ? (srow >= lrow) : (srow <= lrow);
                    const float e = valid ? __expf(cs_l - cs_s[r]) : 0.f; mv[r] = acc[r] * dt_s[r] * e; }
                mreg[st].x = pkbf(mv[0], mv[1]); mreg[st].y = pkbf(mv[2], mv[3]);
            }
            f32x4 yacc[4];
            const float el = __expf(cs_l);
#pragma unroll
            for (int pt = 0; pt < 4; ++pt) { f32x4 acc = (f32x4){0.f, 0.f, 0.f, 0.f};
#pragma unroll
                for (int ks = 0; ks < 4; ++ks) { const bf16x8 af = *(const LAS bf16x8*)(L + SL + (16 * pt + i16) * RS + ks * 64 + g * 16);
                    acc = __builtin_amdgcn_mfma_f32_16x16x32_bf16(af, cfrag[ks], acc, 0, 0, 0); }
                yacc[pt] = acc * el; }
            __syncthreads();
#pragma unroll
            for (int st = 0; st < 8; ++st) *(LAS u32x2*)(L + BN + lrow * RS + 32 * st + 8 * g) = mreg[st];
            __syncthreads();
#pragma unroll
            for (int ks = 0; ks < 4; ++ks) { const bf16x8 mf = *(const LAS bf16x8*)(L + BN + lrow * RS + ks * 64 + g * 16);
#pragma unroll
                for (int pt = 0; pt < 4; ++pt) { const bf16x8 xf = trfrag(L + XN, RSX, ks, pt, g, q, pp); yacc[pt] = __builtin_amdgcn_mfma_f32_16x16x32_bf16(xf, mf, yacc[pt], 0, 0, 0); } }
#pragma unroll
            for (int pt = 0; pt < 4; ++pt) { const u32x2 xv = *(const LAS u32x2*)(L + XN + lrow * RSX + (16 * pt + 4 * g) * 2);
                u32x2 o; o.x = pkbf(yacc[pt][0] + dsk * bflo(xv.x), yacc[pt][1] + dsk * bfhi(xv.x)); o.y = pkbf(yacc[pt][2] + dsk * bflo(xv.y), yacc[pt][3] + dsk * bfhi(xv.y));
                *(u32x2*)(yout + (t0 + lrow) * 1024 + hd * 64 + 16 * pt + 4 * g) = o; }
            { const float dec = __expf(cs_end);
#pragma unroll
              for (int pt = 0; pt < 4; ++pt) sacc[pt] = sacc[pt] * dec; }
#pragma unroll
            for (int ks = 0; ks < 4; ++ks) { const bf16x8 bf = trfrag(L + BS, RS, ks, w, g, q, pp);
#pragma unroll
                for (int pt = 0; pt < 4; ++pt) { const bf16x8 xf = trfrag(L + XN, RSX, ks, pt, g, q, pp); sacc[pt] = __builtin_amdgcn_mfma_f32_16x16x32_bf16(bf, xf, sacc[pt], 0, 0, 0); } }
#ifdef DIAG_LOCAL
#pragma unroll
            for (int pt = 0; pt < 4; ++pt) sacc[pt] = (f32x4){0.f, 0.f, 0.f, 0.f};
#endif
#pragma unroll
            for (int pt = 0; pt < 4; ++pt) { u32x2 o; o.x = pkbf(sacc[pt][0], sacc[pt][1]); o.y = pkbf(sacc[pt][2], sacc[pt][3]);
                *(LAS u32x2*)(L + SL + (16 * pt + i16) * RS + (16 * w + 4 * g) * 2) = o; }
            if (ci + 1 < 32) SSD_SCAN(buf ^ 1);
            __syncthreads();
            if (ci + 1 < 32) SSD_WRITE(buf ^ 1);
            __syncthreads();
        }
#undef SSD_ISSUE
#undef SSD_SCAN
#undef SSD_WRITE
    }
}

__device__ __forceinline__ void p_na_naive(const Ctx& C, bf16_t* q, const bf16_t* k, const bf16_t* v) {
    const float* rpb = C.in[15];
    const int gt = C.bid * NTHR + C.tid, NT = C.G * NTHR;
    for (int i = gt; i < T * 16; i += NT) {
        const int hh = i & 15, tok = i >> 4, b = tok >> 12, l = tok & 4095, r = l >> 6, col = l & 63;
        int rs = r - 4; rs = rs < 0 ? 0 : (rs > 56 ? 56 : rs);
        int wsx = col - 8; wsx = wsx < 0 ? 0 : (wsx > 48 ? 48 : wsx);
        float qv[64], o[64];
        {
            const u32x4* qp = (const u32x4*)(q + (size_t)tok * 1024 + hh * 64);
#pragma unroll
            for (int d8 = 0; d8 < 8; ++d8) { const u32x4 w = qp[d8]; qv[d8 * 8 + 0] = bflo(w.x); qv[d8 * 8 + 1] = bfhi(w.x); qv[d8 * 8 + 2] = bflo(w.y); qv[d8 * 8 + 3] = bfhi(w.y);
                qv[d8 * 8 + 4] = bflo(w.z); qv[d8 * 8 + 5] = bfhi(w.z); qv[d8 * 8 + 6] = bflo(w.w); qv[d8 * 8 + 7] = bfhi(w.w); }
        }
#pragma unroll
        for (int d = 0; d < 64; ++d) o[d] = 0.f;
        float m = -1e30f, lsum = 0.f;
        for (int ii = 0; ii < 8; ++ii)
            for (int jj = 0; jj < 16; ++jj) {
                const int kr = rs + ii, kc = wsx + jj; const size_t kt = (size_t)b * SEQ + kr * 64 + kc;
                const u32x4* kp = (const u32x4*)(k + kt * 1024 + hh * 64);
                float s = 0.f;
#pragma unroll
                for (int d8 = 0; d8 < 8; ++d8) { const u32x4 w = kp[d8];
                    s += qv[d8 * 8 + 0] * bflo(w.x) + qv[d8 * 8 + 1] * bfhi(w.x) + qv[d8 * 8 + 2] * bflo(w.y) + qv[d8 * 8 + 3] * bfhi(w.y)
                       + qv[d8 * 8 + 4] * bflo(w.z) + qv[d8 * 8 + 5] * bfhi(w.z) + qv[d8 * 8 + 6] * bflo(w.w) + qv[d8 * 8 + 7] * bfhi(w.w); }
                s += rpb[hh * 15 * 31 + (kr - r + 7) * 31 + (kc - col + 15)];
                const float mn = fmaxf(m, s), al = __expf(m - mn), pe = __expf(s - mn);
                lsum = lsum * al + pe; m = mn;
                const u32x4* vp = (const u32x4*)(v + kt * 1024 + hh * 64);
#pragma unroll
                for (int d8 = 0; d8 < 8; ++d8) { const u32x4 w = vp[d8];
                    o[d8 * 8 + 0] = o[d8 * 8 + 0] * al + pe * bflo(w.x); o[d8 * 8 + 1] = o[d8 * 8 + 1] * al + pe * bfhi(w.x);
                    o[d8 * 8 + 2] = o[d8 * 8 + 2] * al + pe * bflo(w.y); o[d8 * 8 + 3] = o[d8 * 8 + 3] * al + pe * bfhi(w.y);
                    o[d8 * 8 + 4] = o[d8 * 8 + 4] * al + pe * bflo(w.z); o[d8 * 8 + 5] = o[d8 * 8 + 5] * al + pe * bfhi(w.z);
                    o[d8 * 8 + 6] = o[d8 * 8 + 6] * al + pe * bflo(w.w); o[d8 * 8 + 7] = o[d8 * 8 + 7] * al + pe * bfhi(w.w); }
            }
        const float inv = 1.f / lsum;
        u32x4* op = (u32x4*)(q + (size_t)tok * 1024 + hh * 64);
#pragma unroll
        for (int d8 = 0; d8 < 8; ++d8) { u32x4 w; w.x = pk2(o[d8 * 8 + 0] * inv, o[d8 * 8 + 1] * inv); w.y = pk2(o[d8 * 8 + 2] * inv, o[d8 * 8 + 3] * inv);
            w.z = pk2(o[d8 * 8 + 4] * inv, o[d8 * 8 + 5] * inv); w.w = pk2(o[d8 * 8 + 6] * inv, o[d8 * 8 + 7] * inv); op[d8] = w; }
    }
}


namespace nat {
typedef short bf16x8 __attribute__((ext_vector_type(8)));
typedef short s16x4 __attribute__((ext_vector_type(4)));
constexpr int VH = 65536, RPB = 131072;
__device__ __forceinline__ int voff(int ks, int d) { return ks * 128 + ((((d >> 3) ^ (ks & 7))) << 4) + (d & 7) * 2; }
__device__ __forceinline__ int clampi(int x, int lo, int hi) { return x < lo ? lo : (x > hi ? hi : x); }
}
__device__ __forceinline__ void p_na(const Ctx& C, bf16_t* q, const bf16_t* k, const bf16_t* v) {
    using namespace nat;
    LAS unsigned char* L = C.lds;
    const float* rpb = C.in[15];
    const int tid = C.tid, lane = C.lane, w = C.wave, g = lane >> 4, i16 = lane & 15, qq = (lane >> 2) & 3, pp = lane & 3;
    const int hl = w >> 2, m = w & 3;
    const int bs = (m == 0) ? 0 : (m == 1) ? 8 : (m == 2) ? 24 : 32;
    const int qc = 16 * m + i16, wsx = clampi(qc - 8, 0, 48);
    unsigned vmask = 0u; int dcol[8];
#pragma unroll
    for (int c = 0; c < 8; ++c) { const int kc = bs + (c >> 2) * 16 + 4 * g + (c & 3); if (kc >= wsx && kc < wsx + 16) vmask |= (1u << c); dcol[c] = clampi(kc - qc + 15, 0, 30); }
    for (int unit = C.bid; unit < 256; unit += C.G) {
        const int rseg = unit & 3, hp = (unit >> 2) & 7, b = unit >> 5, h = 2 * hp + hl;
        __syncthreads();
        for (int i = tid; i < 930; i += NTHR) ((LAS float*)(L + RPB))[i] = rpb[(2 * hp) * 465 + i];
#define NA_LOAD_ROW(row_) do { _Pragma("unroll") for (int i_ = 0; i_ < 2; ++i_) { const int idx_ = tid + NTHR * i_, hl_ = idx_ >> 9, col_ = (idx_ >> 3) & 63, dch_ = idx_ & 7; \
            const u32x4 val_ = *(const u32x4*)(v + ((size_t)b * SEQ + (size_t)(row_) * 64 + col_) * 1024 + (2 * hp + hl_) * 64 + dch_ * 8); \
            *(LAS u32x4*)(L + hl_ * VH + voff(((row_) & 7) * 64 + col_, dch_ * 8)) = val_; } } while (0)
        const int r0 = 16 * rseg; int rs_prev = clampi(r0 - 4, 0, 56);
        for (int rr = 0; rr < 8; ++rr) NA_LOAD_ROW(rs_prev + rr);
        __syncthreads();
        const LAS float* rpbl = (const LAS float*)(L + RPB) + hl * 465;
        for (int s = 0; s < 16; ++s) {
            const int r = r0 + s, rs = clampi(r - 4, 0, 56);
            if (rs != rs_prev) { __syncthreads(); NA_LOAD_ROW(rs + 7); __syncthreads(); rs_prev = rs; }
            const size_t tokq = (size_t)b * SEQ + (size_t)r * 64 + qc;
            bf16x8 qf[2];
#pragma unroll
            for (int ks = 0; ks < 2; ++ks) qf[ks] = *(const bf16x8*)(q + tokq * 1024 + h * 64 + ks * 32 + g * 8);
            f32x4 sc[16];
#pragma unroll
            for (int kt = 0; kt < 16; ++kt) { const size_t tokk = (size_t)b * SEQ + (size_t)(rs + (kt >> 1)) * 64 + bs + (kt & 1) * 16 + i16;
                f32x4 acc = (f32x4){0.f, 0.f, 0.f, 0.f};
#pragma unroll
                for (int ks = 0; ks < 2; ++ks) { const bf16x8 kf = *(const bf16x8*)(k + tokk * 1024 + h * 64 + ks * 32 + g * 8); acc = __builtin_amdgcn_mfma_f32_16x16x32_bf16(kf, qf[ks], acc, 0, 0, 0); }
                sc[kt] = acc; }
            float mx = -1.0e30f;
#pragma unroll
            for (int kt = 0; kt < 16; ++kt) { const int drow = rs + (kt >> 1) - r + 7;
#pragma unroll
                for (int e = 0; e < 4; ++e) { const int c = (kt & 1) * 4 + e; const float bias = rpbl[drow * 31 + dcol[c]];
                    const float val = ((vmask >> c) & 1u) ? sc[kt][e] + bias : -1.0e30f; sc[kt][e] = val; mx = fmaxf(mx, val); } }
            mx = fmaxf(mx, __shfl_xor(mx, 16)); mx = fmaxf(mx, __shfl_xor(mx, 32));
            float sum = 0.f;
#pragma unroll
            for (int kt = 0; kt < 16; ++kt)
#pragma unroll
                for (int e = 0; e < 4; ++e) { const float p = __expf(sc[kt][e] - mx); sc[kt][e] = p; sum += p; }
            sum += __shfl_xor(sum, 16); sum += __shfl_xor(sum, 32);
            f32x4 o[4];
#pragma unroll
            for (int dt = 0; dt < 4; ++dt) o[dt] = (f32x4){0.f, 0.f, 0.f, 0.f};
#pragma unroll
            for (int kk = 0; kk < 8; ++kk) {
                u32x4 pw; pw.x = pk2(sc[2 * kk][0], sc[2 * kk][1]); pw.y = pk2(sc[2 * kk][2], sc[2 * kk][3]); pw.z = pk2(sc[2 * kk + 1][0], sc[2 * kk + 1][1]); pw.w = pk2(sc[2 * kk + 1][2], sc[2 * kk + 1][3]);
                const bf16x8 pf = __builtin_bit_cast(bf16x8, pw);
                const int ks0 = ((rs + kk) & 7) * 64 + bs + 4 * g + qq, ks1 = ks0 + 16;
#pragma unroll
                for (int dt = 0; dt < 4; ++dt) {
                    const s16x4 v0 = __builtin_amdgcn_ds_read_tr16_b64_v4i16((LAS s16x4*)(L + hl * VH + voff(ks0, 16 * dt + 4 * pp)));
                    const s16x4 v1 = __builtin_amdgcn_ds_read_tr16_b64_v4i16((LAS s16x4*)(L + hl * VH + voff(ks1, 16 * dt + 4 * pp)));
                    bf16x8 vf; vf[0] = v0[0]; vf[1] = v0[1]; vf[2] = v0[2]; vf[3] = v0[3]; vf[4] = v1[0]; vf[5] = v1[1]; vf[6] = v1[2]; vf[7] = v1[3];
                    o[dt] = __builtin_amdgcn_mfma_f32_16x16x32_bf16(vf, pf, o[dt], 0, 0, 0); }
            }
            const float inv = 1.f / sum;
#pragma unroll
            for (int dt = 0; dt < 4; ++dt) { u32x2 ov; ov.x = pk2(o[dt][0] * inv, o[dt][1] * inv); ov.y = pk2(o[dt][2] * inv, o[dt][3] * inv);
                *(u32x2*)(q + tokq * 1024 + h * 64 + 16 * dt + 4 * g) = ov; }
        }
#undef NA_LOAD_ROW
    }
    __syncthreads();
}

__device__ __forceinline__ void p_combine(const Ctx& C, const bf16_t* yf, const bf16_t* yb, bf16_t* szu, float* rstd) {
    const int gw = C.bid * NWAVES + C.wave, NGW = C.G * NWAVES;
    for (int row = gw; row < T; row += NGW) {
        const size_t base = (size_t)row * 1024;
        float s = 0.f; u32x4 outv[2];
#pragma unroll
        for (int j = 0; j < 2; ++j) {
            const size_t off = base + j * 512 + C.lane * 8;
            const u32x4 a = *(const u32x4*)(yf + off), b = *(const u32x4*)(yb + off), z = *(const u32x4*)(szu + off);
            float u[8];
            u[0] = (bflo(a.x) + bflo(b.x)) * bflo(z.x); u[1] = (bfhi(a.x) + bfhi(b.x)) * bfhi(z.x);
            u[2] = (bflo(a.y) + bflo(b.y)) * bflo(z.y); u[3] = (bfhi(a.y) + bfhi(b.y)) * bfhi(z.y);
            u[4] = (bflo(a.z) + bflo(b.z)) * bflo(z.z); u[5] = (bfhi(a.z) + bfhi(b.z)) * bfhi(z.z);
            u[6] = (bflo(a.w) + bflo(b.w)) * bflo(z.w); u[7] = (bfhi(a.w) + bfhi(b.w)) * bfhi(z.w);
#pragma unroll
            for (int q = 0; q < 8; ++q) s += u[q] * u[q];
            outv[j].x = pk2(u[0], u[1]); outv[j].y = pk2(u[2], u[3]); outv[j].z = pk2(u[4], u[5]); outv[j].w = pk2(u[6], u[7]);
        }
        s = wave_sum(s);
#pragma unroll
        for (int j = 0; j < 2; ++j) *(u32x4*)(szu + base + j * 512 + C.lane * 8) = outv[j];
        if (C.lane == 0) rstd[row] = rsqrtf(s * (1.f / 1024.f) + EPS);
    }
}

__device__ __forceinline__ void p_cvt_tables(const Ctx& C, bf16_t* ub, bf16_t* vb) {
    const int gt = C.bid * NTHR + C.tid, NT = C.G * NTHR;
    const float* u = C.in[21]; const float* v = C.in[22];
    for (int i = gt; i < 16384 * 1024 / 8; i += NT) {
        const f32x4 a0 = *(const f32x4*)(u + (size_t)i * 8), a1 = *(const f32x4*)(u + (size_t)i * 8 + 4);
        u32x4 o; o.x = pk2(a0.x, a0.y); o.y = pk2(a0.z, a0.w); o.z = pk2(a1.x, a1.y); o.w = pk2(a1.z, a1.w);
        *(u32x4*)(ub + (size_t)i * 8) = o;
        const f32x4 b0 = *(const f32x4*)(v + (size_t)i * 8), b1 = *(const f32x4*)(v + (size_t)i * 8 + 4);
        u32x4 p; p.x = pk2(b0.x, b0.y); p.y = pk2(b0.z, b0.w); p.z = pk2(b1.x, b1.y); p.w = pk2(b1.z, b1.w);
        *(u32x4*)(vb + (size_t)i * 8) = p;
    }
}

__device__ __forceinline__ void p_topk_naive(const Ctx& C, const bf16_t* qp, const bf16_t* keys, unsigned short* pidx, float* pgate) {
    constexpr int NTK = 64;
    LAS float* S = (LAS float*)C.lds;
    LAS float* TV = (LAS float*)(C.lds + 256 * NTK * 4);
    LAS int* TI = (LAS int*)(C.lds + 256 * NTK * 4 + 32 * NTK * 4);
    const int tl = C.tid;
    if (C.tid < 64)
    for (int item = C.bid * NTK + tl; item < T * 8; item += C.G * NTK) {
        const int t = item >> 3, hh = item & 7;
        for (int z = 0; z < 2; ++z) {
            unsigned qv[64];
            const u32x4* qptr = (const u32x4*)(qp + (size_t)t * 2048 + hh * 256 + z * 128);
#pragma unroll
            for (int d8 = 0; d8 < 16; ++d8) { const u32x4 w = qptr[d8]; qv[d8 * 4 + 0] = w.x; qv[d8 * 4 + 1] = w.y; qv[d8 * 4 + 2] = w.z; qv[d8 * 4 + 3] = w.w; }
            for (int n = 0; n < 128; ++n) {
                const u32x4* kp = (const u32x4*)(keys + (size_t)(z * 128 + n) * 128);
                float acc = 0.f;
#pragma unroll
                for (int d8 = 0; d8 < 16; ++d8) { const u32x4 w = kp[d8];
                    acc += bflo(qv[d8 * 4 + 0]) * bflo(w.x) + bfhi(qv[d8 * 4 + 0]) * bfhi(w.x) + bflo(qv[d8 * 4 + 1]) * bflo(w.y) + bfhi(qv[d8 * 4 + 1]) * bfhi(w.y)
                         + bflo(qv[d8 * 4 + 2]) * bflo(w.z) + bfhi(qv[d8 * 4 + 2]) * bfhi(w.z) + bflo(qv[d8 * 4 + 3]) * bflo(w.w) + bfhi(qv[d8 * 4 + 3]) * bfhi(w.w); }
                S[(z * 128 + n) * NTK + tl] = acc;
            }
            float pv = 3.0e38f; int pi = -1;
            for (int r = 0; r < 16; ++r) {
                float best = -3.0e38f; int bi = 0;
                for (int n = 0; n < 128; ++n) { const float x = S[(z * 128 + n) * NTK + tl];
                    const bool elig = (x < pv) || (x == pv && n > pi);
                    if (elig && x > best) { best = x; bi = n; } }
                TV[(z * 16 + r) * NTK + tl] = best; TI[(z * 16 + r) * NTK + tl] = bi; pv = best; pi = bi;
            }
        }
        float pv = 3.0e38f; int pi = -1; float top[16]; int ei[16];
#pragma unroll
        for (int r = 0; r < 16; ++r) {
            float best = -3.0e38f; int bi = 0;
            for (int c = 0; c < 256; ++c) { const float x = TV[(c >> 4) * NTK + tl] + TV[(16 + (c & 15)) * NTK + tl];
                const bool elig = (x < pv) || (x == pv && c > pi);
                if (elig && x > best) { best = x; bi = c; } }
            top[r] = best; ei[r] = TI[(bi >> 4) * NTK + tl] * 128 + TI[(16 + (bi & 15)) * NTK + tl]; pv = best; pi = bi;
        }
        float den = 0.f, e[16];
#pragma unroll
        for (int r = 0; r < 16; ++r) { e[r] = __expf(top[r] - top[0]); den += e[r]; }
        const float inv = 1.f / den;
#pragma unroll
        for (int r = 0; r < 16; ++r) { pidx[(size_t)t * 128 + hh * 16 + r] = (unsigned short)ei[r]; pgate[(size_t)t * 128 + hh * 16 + r] = e[r] * inv; }
    }
}


namespace tk {
typedef short bf16x8 __attribute__((ext_vector_type(8)));
constexpr int RSK = 272, TAB = 69632, TABW = 33 * 16 * 4, IJT = TAB + 8 * TABW;
__device__ __forceinline__ void ce(float& a, float& b) { const float hi = __builtin_fmaxf(a, b), lo = __builtin_fminf(a, b); a = hi; b = lo; }
__device__ __forceinline__ void sort16(float (&v)[16]) {
#pragma unroll
    for (int k = 2; k <= 16; k <<= 1)
#pragma unroll
        for (int j = k >> 1; j > 0; j >>= 1)
#pragma unroll
            for (int i = 0; i < 16; ++i) { const int l = i ^ j; if (l > i) { if ((i & k) == 0) ce(v[i], v[l]); else ce(v[l], v[i]); } }
}
__device__ __forceinline__ void merge16(float (&a)[16], const float (&b)[16]) {
#pragma unroll
    for (int i = 0; i < 16; ++i) a[i] = __builtin_fmaxf(a[i], b[15 - i]);
#pragma unroll
    for (int j = 8; j > 0; j >>= 1)
#pragma unroll
        for (int i = 0; i < 16; ++i) { const int l = i ^ j; if (l > i) ce(a[i], a[l]); }
}
__device__ __forceinline__ void xmerge(float (&a)[16], int mask) { float b[16];
#pragma unroll
    for (int i = 0; i < 16; ++i) b[i] = __shfl_xor(a[i], mask);
    merge16(a, b); }
}
__device__ __forceinline__ void p_topk(const Ctx& C, const bf16_t* qp, const bf16_t* keys, unsigned short* pidx, float* pgate) {
    using namespace tk;
    LAS unsigned char* L = C.lds;
    const int tid = C.tid, lane = C.lane, w = C.wave, g = lane >> 4, i16 = lane & 15;
    __syncthreads();
    for (int i = tid; i < 4096; i += NTHR) { const int r = i >> 4, cc = i & 15; *(LAS u32x4*)(L + r * RSK + cc * 16) = *(const u32x4*)(keys + (size_t)r * 128 + cc * 8); }
    if (tid < 64) { int cnt = 0, fi = 0, fj = 0;
        for (int i = 0; i < 16; ++i) for (int j = 0; j < 16; ++j) if ((i + 1) * (j + 1) <= 16) { if (cnt == tid) { fi = i; fj = j; } ++cnt; }
        ((LAS unsigned*)(L + IJT))[tid] = (unsigned)(fi | (fj << 4)); }
    __syncthreads();
    LAS unsigned* tab = (LAS unsigned*)(L + TAB + w * TABW) + i16 * 33;
    const LAS unsigned* ijt = (const LAS unsigned*)(L + IJT);
    const float NEGV = -1.0e30f;
    const int gw = C.bid * NWAVES + w, NGW = C.G * NWAVES;
    for (int unit = gw; unit < (T / 16) * 8; unit += NGW) {
        const int tg = unit >> 3, hh = unit & 7; const size_t t0 = (size_t)tg * 16;
        float s1[16], s2[16];
#pragma unroll
        for (int z = 0; z < 2; ++z) {
            bf16x8 qf[4];
#pragma unroll
            for (int ks = 0; ks < 4; ++ks) qf[ks] = *(const bf16x8*)(qp + (t0 + i16) * 2048 + hh * 256 + z * 128 + ks * 32 + g * 8);
            float lo[16], hi[16];
#pragma unroll
            for (int nt = 0; nt < 8; ++nt) { f32x4 acc = (f32x4){0.f, 0.f, 0.f, 0.f};
#pragma unroll
                for (int ks = 0; ks < 4; ++ks) { const bf16x8 kf = *(const LAS bf16x8*)(L + (z * 128 + 16 * nt + i16) * RSK + ks * 64 + g * 16);
                    acc = __builtin_amdgcn_mfma_f32_16x16x32_bf16(kf, qf[ks], acc, 0, 0, 0); }
#pragma unroll
                for (int r = 0; r < 4; ++r) { const float pv = __uint_as_float((__float_as_uint(acc[r]) & 0xFFFFFF80u) | (unsigned)(16 * nt + 4 * g + r));
                    if (nt < 4) lo[nt * 4 + r] = pv; else hi[(nt - 4) * 4 + r] = pv; } }
            sort16(lo); sort16(hi); merge16(lo, hi);
            xmerge(lo, 16); xmerge(lo, 32);
#pragma unroll
            for (int i = 0; i < 16; ++i) { if (z == 0) s1[i] = lo[i]; else s2[i] = lo[i]; }
        }
#pragma unroll
        for (int i = 0; i < 16; ++i) { tab[i] = __float_as_uint(s1[i]); tab[16 + i] = __float_as_uint(s2[i]); }
        float cand[16];
            { const float a_ = (g == 0 ? s1[0] : g == 1 ? s1[1] : g == 2 ? s1[3] : s1[14]), b_ = (g == 0 ? s2[0] : g == 1 ? s2[0] : g == 2 ? s2[3] : s2[0]); cand[0] = __uint_as_float((__float_as_uint(a_ + b_) & 0xFFFFFFC0u) | (unsigned)(16 * g + 0)); }
            { const float a_ = (g == 0 ? s1[0] : g == 1 ? s1[1] : g == 2 ? s1[4] : s1[15]), b_ = (g == 0 ? s2[1] : g == 1 ? s2[1] : g == 2 ? s2[0] : s2[0]); cand[1] = __uint_as_float((__float_as_uint(a_ + b_) & 0xFFFFFFC0u) | (unsigned)(16 * g + 1)); }
            { const float a_ = (g == 0 ? s1[0] : g == 1 ? s1[1] : g == 2 ? s1[4] : NEGV), b_ = (g == 0 ? s2[2] : g == 1 ? s2[2] : g == 2 ? s2[1] : NEGV); cand[2] = __uint_as_float((__float_as_uint(a_ + b_) & 0xFFFFFFC0u) | (unsigned)(16 * g + 2)); }
            { const float a_ = (g == 0 ? s1[0] : g == 1 ? s1[1] : g == 2 ? s1[4] : NEGV), b_ = (g == 0 ? s2[3] : g == 1 ? s2[3] : g == 2 ? s2[2] : NEGV); cand[3] = __uint_as_float((__float_as_uint(a_ + b_) & 0xFFFFFFC0u) | (unsigned)(16 * g + 3)); }
            { const float a_ = (g == 0 ? s1[0] : g == 1 ? s1[1] : g == 2 ? s1[5] : NEGV), b_ = (g == 0 ? s2[4] : g == 1 ? s2[4] : g == 2 ? s2[0] : NEGV); cand[4] = __uint_as_float((__float_as_uint(a_ + b_) & 0xFFFFFFC0u) | (unsigned)(16 * g + 4)); }
            { const float a_ = (g == 0 ? s1[0] : g == 1 ? s1[1] : g == 2 ? s1[5] : NEGV), b_ = (g == 0 ? s2[5] : g == 1 ? s2[5] : g == 2 ? s2[1] : NEGV); cand[5] = __uint_as_float((__float_as_uint(a_ + b_) & 0xFFFFFFC0u) | (unsigned)(16 * g + 5)); }
            { const float a_ = (g == 0 ? s1[0] : g == 1 ? s1[1] : g == 2 ? s1[6] : NEGV), b_ = (g == 0 ? s2[6] : g == 1 ? s2[6] : g == 2 ? s2[0] : NEGV); cand[6] = __uint_as_float((__float_as_uint(a_ + b_) & 0xFFFFFFC0u) | (unsigned)(16 * g + 6)); }
            { const float a_ = (g == 0 ? s1[0] : g == 1 ? s1[1] : g == 2 ? s1[6] : NEGV), b_ = (g == 0 ? s2[7] : g == 1 ? s2[7] : g == 2 ? s2[1] : NEGV); cand[7] = __uint_as_float((__float_as_uint(a_ + b_) & 0xFFFFFFC0u) | (unsigned)(16 * g + 7)); }
            { const float a_ = (g == 0 ? s1[0] : g == 1 ? s1[2] : g == 2 ? s1[7] : NEGV), b_ = (g == 0 ? s2[8] : g == 1 ? s2[0] : g == 2 ? s2[0] : NEGV); cand[8] = __uint_as_float((__float_as_uint(a_ + b_) & 0xFFFFFFC0u) | (unsigned)(16 * g + 8)); }
            { const float a_ = (g == 0 ? s1[0] : g == 1 ? s1[2] : g == 2 ? s1[7] : NEGV), b_ = (g == 0 ? s2[9] : g == 1 ? s2[1] : g == 2 ? s2[1] : NEGV); cand[9] = __uint_as_float((__float_as_uint(a_ + b_) & 0xFFFFFFC0u) | (unsigned)(16 * g + 9)); }
            { const float a_ = (g == 0 ? s1[0] : g == 1 ? s1[2] : g == 2 ? s1[8] : NEGV), b_ = (g == 0 ? s2[10] : g == 1 ? s2[2] : g == 2 ? s2[0] : NEGV); cand[10] = __uint_as_float((__float_as_uint(a_ + b_) & 0xFFFFFFC0u) | (unsigned)(16 * g + 10)); }
            { const float a_ = (g == 0 ? s1[0] : g == 1 ? s1[2] : g == 2 ? s1[9] : NEGV), b_ = (g == 0 ? s2[11] : g == 1 ? s2[3] : g == 2 ? s2[0] : NEGV); cand[11] = __uint_as_float((__float_as_uint(a_ + b_) & 0xFFFFFFC0u) | (unsigned)(16 * g + 11)); }
            { const float a_ = (g == 0 ? s1[0] : g == 1 ? s1[2] : g == 2 ? s1[10] : NEGV), b_ = (g == 0 ? s2[12] : g == 1 ? s2[4] : g == 2 ? s2[0] : NEGV); cand[12] = __uint_as_float((__float_as_uint(a_ + b_) & 0xFFFFFFC0u) | (unsigned)(16 * g + 12)); }
            { const float a_ = (g == 0 ? s1[0] : g == 1 ? s1[3] : g == 2 ? s1[11] : NEGV), b_ = (g == 0 ? s2[13] : g == 1 ? s2[0] : g == 2 ? s2[0] : NEGV); cand[13] = __uint_as_float((__float_as_uint(a_ + b_) & 0xFFFFFFC0u) | (unsigned)(16 * g + 13)); }
            { const float a_ = (g == 0 ? s1[0] : g == 1 ? s1[3] : g == 2 ? s1[12] : NEGV), b_ = (g == 0 ? s2[14] : g == 1 ? s2[1] : g == 2 ? s2[0] : NEGV); cand[14] = __uint_as_float((__float_as_uint(a_ + b_) & 0xFFFFFFC0u) | (unsigned)(16 * g + 14)); }
            { const float a_ = (g == 0 ? s1[0] : g == 1 ? s1[3] : g == 2 ? s1[13] : NEGV), b_ = (g == 0 ? s2[15] : g == 1 ? s2[2] : g == 2 ? s2[0] : NEGV); cand[15] = __uint_as_float((__float_as_uint(a_ + b_) & 0xFFFFFFC0u) | (unsigned)(16 * g + 15)); }
        sort16(cand);
        xmerge(cand, 16); xmerge(cand, 32);
        float den = 0.f, ex[16];
#pragma unroll
        for (int i = 0; i < 16; ++i) { ex[i] = __expf(cand[i] - cand[0]); den += ex[i]; }
        const float inv = 1.f / den;
        unsigned short eo[4]; float go[4];
#pragma unroll
        for (int e = 0; e < 4; ++e) {
            const float cv = (g == 0 ? cand[e] : g == 1 ? cand[4 + e] : g == 2 ? cand[8 + e] : cand[12 + e]);
            const float gv = (g == 0 ? ex[e] : g == 1 ? ex[4 + e] : g == 2 ? ex[8 + e] : ex[12 + e]);
            const unsigned code = __float_as_uint(cv) & 63u; const unsigned ij = ijt[code];
            const unsigned p1 = tab[ij & 15u], p2 = tab[16 + (ij >> 4)];
            eo[e] = (unsigned short)((p1 & 127u) * 128u + (p2 & 127u)); go[e] = gv * inv; }
        u32x2 ov; ov.x = (unsigned)eo[0] | ((unsigned)eo[1] << 16); ov.y = (unsigned)eo[2] | ((unsigned)eo[3] << 16);
        *(u32x2*)(pidx + (t0 + i16) * 128 + hh * 16 + 4 * g) = ov;
        *(f32x4*)(pgate + (t0 + i16) * 128 + hh * 16 + 4 * g) = (f32x4){go[0], go[1], go[2], go[3]};
    }
    __syncthreads();
}

__device__ __forceinline__ float dot2u(unsigned a, unsigned x, float acc) {
    return __builtin_amdgcn_fdot2_f32_bf16(__builtin_bit_cast(bf16x2_t, a), __builtin_bit_cast(bf16x2_t, x), acc, false);
}
__device__ __forceinline__ float dot8(const u32x4 a, const u32x4 x, float acc) {
    const unsigned a0 = a.x, a1 = a.y, a2 = a.z, a3 = a.w, x0 = x.x, x1 = x.y, x2 = x.z, x3 = x.w;
    acc = dot2u(a0, x0, acc); acc = dot2u(a1, x1, acc); acc = dot2u(a2, x2, acc); acc = dot2u(a3, x3, acc);
    return acc;
}
__device__ __forceinline__ void p_gather(const Ctx& C, const bf16_t* n2, const unsigned short* pidx, const float* pgate, const bf16_t* ub, const bf16_t* vb, const float* h, float* out) {
    const float* mod = C.f32p(WS_MOD); const float* fg = C.in[23];
    LAS float* cbuf = (LAS float*)C.lds + C.wave * 128;
    const int gw = C.bid * NWAVES + C.wave, NGW = C.G * NWAVES, lane = C.lane;
    for (int t = gw; t < T; t += NGW) {
        const int b = t / SEQ;
        const u32x4 x0 = *(const u32x4*)(n2 + (size_t)t * 1024 + lane * 8), x1 = *(const u32x4*)(n2 + (size_t)t * 1024 + 512 + lane * 8);
        const int id0 = pidx[(size_t)t * 128 + lane], id1 = pidx[(size_t)t * 128 + 64 + lane];
        const float g0 = pgate[(size_t)t * 128 + lane], g1 = pgate[(size_t)t * 128 + 64 + lane];
#pragma unroll 1
        for (int grp = 0; grp < 8; ++grp) {
            const int idv = grp < 4 ? id0 : id1; const int lbase = (grp & 3) * 16;
            float part[16];
#pragma unroll
            for (int j = 0; j < 16; ++j) {
                const int e = __shfl(idv, lbase + j);
                const bf16_t* rowp = ub + (size_t)e * 1024;
                const u32x4 a0 = *(const u32x4*)(rowp + lane * 8), a1 = *(const u32x4*)(rowp + 512 + lane * 8);
                part[j] = dot8(a1, x1, dot8(a0, x0, 0.f));
            }
            float p8[8];
            { const bool hi = (lane & 32) != 0;
#pragma unroll
              for (int j = 0; j < 8; ++j) { const float keep = hi ? part[j + 8] : part[j], send = hi ? part[j] : part[j + 8]; p8[j] = keep + __shfl_xor(send, 32); } }
            float p4[4];
            { const bool hi = (lane & 16) != 0;
#pragma unroll
              for (int j = 0; j < 4; ++j) { const float keep = hi ? p8[j + 4] : p8[j], send = hi ? p8[j] : p8[j + 4]; p4[j] = keep + __shfl_xor(send, 16); } }
            float p2[2];
            { const bool hi = (lane & 8) != 0;
#pragma unroll
              for (int j = 0; j < 2; ++j) { const float keep = hi ? p4[j + 2] : p4[j], send = hi ? p4[j] : p4[j + 2]; p2[j] = keep + __shfl_xor(send, 8); } }
            float p1;
            { const bool hi = (lane & 4) != 0; const float keep = hi ? p2[1] : p2[0], send = hi ? p2[0] : p2[1]; p1 = keep + __shfl_xor(send, 4); }
            p1 += __shfl_xor(p1, 2); p1 += __shfl_xor(p1, 1);
            const int E = ((lane >> 5) & 1) * 8 + ((lane >> 4) & 1) * 4 + ((lane >> 3) & 1) * 2 + ((lane >> 2) & 1);
            if ((lane & 3) == 0) cbuf[grp * 16 + E] = gelu_f(p1);
        }
        asm volatile("s_waitcnt lgkmcnt(0)" ::: "memory");
        const float c0 = cbuf[lane] * g0, c1 = cbuf[64 + lane] * g1;
        asm volatile("s_waitcnt lgkmcnt(0)" ::: "memory");
        float acc[16];
#pragma unroll
        for (int i = 0; i < 16; ++i) acc[i] = 0.f;
#pragma unroll 1
        for (int kb = 0; kb < 128; kb += 8) {
            const int idv = kb < 64 ? id0 : id1; const float cv = kb < 64 ? c0 : c1;
#pragma unroll
            for (int j = 0; j < 8; ++j) {
                const int e = __shfl(idv, (kb & 63) + j); const float ck = __shfl(cv, (kb & 63) + j);
                const bf16_t* rowp = vb + (size_t)e * 1024;
                const u32x4 a0 = *(const u32x4*)(rowp + lane * 8), a1 = *(const u32x4*)(rowp + 512 + lane * 8);
                acc[0] += ck * bflo(a0.x); acc[1] += ck * bfhi(a0.x); acc[2] += ck * bflo(a0.y); acc[3] += ck * bfhi(a0.y);
                acc[4] += ck * bflo(a0.z); acc[5] += ck * bfhi(a0.z); acc[6] += ck * bflo(a0.w); acc[7] += ck * bfhi(a0.w);
                acc[8] += ck * bflo(a1.x); acc[9] += ck * bfhi(a1.x); acc[10] += ck * bflo(a1.y); acc[11] += ck * bfhi(a1.y);
                acc[12] += ck * bflo(a1.z); acc[13] += ck * bfhi(a1.z); acc[14] += ck * bflo(a1.w); acc[15] += ck * bfhi(a1.w);
            }
        }
        float hf[16]; float ss = 0.f;
#pragma unroll
        for (int half = 0; half < 2; ++half) {
            const int col = half * 512 + lane * 8;
            const f32x4 h0 = *(const f32x4*)(h + (size_t)t * 1024 + col), h1 = *(const f32x4*)(h + (size_t)t * 1024 + col + 4);
            const f32x4 m0 = *(const f32x4*)(mod + b * 6144 + 5120 + col), m1 = *(const f32x4*)(mod + b * 6144 + 5120 + col + 4);
            hf[half * 8 + 0] = h0.x + m0.x * acc[half * 8 + 0]; hf[half * 8 + 1] = h0.y + m0.y * acc[half * 8 + 1];
            hf[half * 8 + 2] = h0.z + m0.z * acc[half * 8 + 2]; hf[half * 8 + 3] = h0.w + m0.w * acc[half * 8 + 3];
            hf[half * 8 + 4] = h1.x + m1.x * acc[half * 8 + 4]; hf[half * 8 + 5] = h1.y + m1.y * acc[half * 8 + 5];
            hf[half * 8 + 6] = h1.z + m1.z * acc[half * 8 + 6]; hf[half * 8 + 7] = h1.w + m1.w * acc[half * 8 + 7];
        }
#pragma unroll
        for (int i = 0; i < 16; ++i) ss += hf[i] * hf[i];
        const float rstd = rsqrtf(wave_sum(ss) * (1.f / 1024.f) + EPS);
#pragma unroll
        for (int half = 0; half < 2; ++half) {
            const int col = half * 512 + lane * 8;
            const f32x4 f0 = *(const f32x4*)(fg + col), f1 = *(const f32x4*)(fg + col + 4);
            f32x4 o0, o1;
            o0.x = hf[half * 8 + 0] * rstd * f0.x; o0.y = hf[half * 8 + 1] * rstd * f0.y; o0.z = hf[half * 8 + 2] * rstd * f0.z; o0.w = hf[half * 8 + 3] * rstd * f0.w;
            o1.x = hf[half * 8 + 4] * rstd * f1.x; o1.y = hf[half * 8 + 5] * rstd * f1.y; o1.z = hf[half * 8 + 6] * rstd * f1.z; o1.w = hf[half * 8 + 7] * rstd * f1.w;
            *(f32x4*)(out + (size_t)t * 1024 + col) = o0; *(f32x4*)(out + (size_t)t * 1024 + col + 4) = o1;
        }
    }
}


__device__ __forceinline__ void p_cvt_tables8(const Ctx& C, unsigned char* u8, unsigned char* v8) {
    const int gt = C.bid * NTHR + C.tid, NT = C.G * NTHR;
    const float* u = C.in[21]; const float* v = C.in[22];
    for (int i = gt; i < 16384 * 1024 / 16; i += NT) {
        u32x4 o, p;
#pragma unroll
        for (int d = 0; d < 4; ++d) {
            const f32x4 a = *(const f32x4*)(u + (size_t)i * 16 + d * 4) * 256.f, b = *(const f32x4*)(v + (size_t)i * 16 + d * 4) * 64.f;
            unsigned x = 0u, y = 0u;
            x = __builtin_amdgcn_cvt_pk_fp8_f32(a.x, a.y, x, false); x = __builtin_amdgcn_cvt_pk_fp8_f32(a.z, a.w, x, true);
            y = __builtin_amdgcn_cvt_pk_fp8_f32(b.x, b.y, y, false); y = __builtin_amdgcn_cvt_pk_fp8_f32(b.z, b.w, y, true);
            o[d] = x; p[d] = y; }
        *(u32x4*)(u8 + (size_t)i * 16) = o; *(u32x4*)(v8 + (size_t)i * 16) = p;
    }
}

__device__ __forceinline__ void p_gather8(const Ctx& C, const bf16_t* n2, const unsigned short* pidx, const float* pgate, const unsigned char* u8, const unsigned char* v8, const float* h, float* out) {
    const float* mod = C.f32p(WS_MOD); const float* fg = C.in[23];
    LAS float* cbuf = (LAS float*)C.lds + C.wave * 128;
    const int gw = C.bid * NWAVES + C.wave, NGW = C.G * NWAVES, lane = C.lane;
    for (int t = gw; t < T; t += NGW) {
        const int b = t / SEQ;
        unsigned xp[8];
        { const u32x4 x0 = *(const u32x4*)(n2 + (size_t)t * 1024 + lane * 16), x1 = *(const u32x4*)(n2 + (size_t)t * 1024 + lane * 16 + 8);
          xp[0] = x0.x; xp[1] = x0.y; xp[2] = x0.z; xp[3] = x0.w; xp[4] = x1.x; xp[5] = x1.y; xp[6] = x1.z; xp[7] = x1.w; }
        const int id0 = pidx[(size_t)t * 128 + lane], id1 = pidx[(size_t)t * 128 + 64 + lane];
        const float g0 = pgate[(size_t)t * 128 + lane], g1 = pgate[(size_t)t * 128 + 64 + lane];
        u32x4 bufA[8], bufB[8];
#define G8_LOAD8(buf_, tab_, slot0_) do { const int idv_ = (slot0_) < 64 ? id0 : id1; _Pragma("unroll") for (int j_ = 0; j_ < 8; ++j_) { const int e_ = __builtin_amdgcn_readlane(idv_, ((slot0_) & 63) + j_); \
            buf_[j_] = *(const u32x4*)((tab_) + (size_t)e_ * 1024 + lane * 16); } } while (0)
#define G8_UDOT8(buf_, off_) do { _Pragma("unroll") for (int j_ = 0; j_ < 8; ++j_) { float acc_ = 0.f; \
                _Pragma("unroll") for (int d_ = 0; d_ < 4; ++d_) { const unsigned wv_ = buf_[j_][d_]; \
                    const bf16x2_t lo_ = __builtin_amdgcn_cvt_scalef32_pk_bf16_fp8(wv_, 0.00390625f, false), hi_ = __builtin_amdgcn_cvt_scalef32_pk_bf16_fp8(wv_, 0.00390625f, true); \
                    const unsigned xa_ = xp[2 * d_], xb_ = xp[2 * d_ + 1]; \
                    acc_ = __builtin_amdgcn_fdot2_f32_bf16(lo_, __builtin_bit_cast(bf16x2_t, xa_), acc_, false); acc_ = __builtin_amdgcn_fdot2_f32_bf16(hi_, __builtin_bit_cast(bf16x2_t, xb_), acc_, false); } \
                part[(off_) + j_] = acc_; __builtin_amdgcn_sched_barrier(0); } } while (0)
#define G8_REDUCE(grp_) do { \
            float p8[8]; { const bool hi = (lane & 32) != 0; \
              _Pragma("unroll") for (int j_ = 0; j_ < 8; ++j_) { const float keep = hi ? part[j_ + 8] : part[j_], send = hi ? part[j_] : part[j_ + 8]; p8[j_] = keep + __shfl_xor(send, 32); } } \
            float p4[4]; { const bool hi = (lane & 16) != 0; \
              _Pragma("unroll") for (int j_ = 0; j_ < 4; ++j_) { const float keep = hi ? p8[j_ + 4] : p8[j_], send = hi ? p8[j_] : p8[j_ + 4]; p4[j_] = keep + __shfl_xor(send, 16); } } \
            float p2[2]; { const bool hi = (lane & 8) != 0; \
              _Pragma("unroll") for (int j_ = 0; j_ < 2; ++j_) { const float keep = hi ? p4[j_ + 2] : p4[j_], send = hi ? p4[j_] : p4[j_ + 2]; p2[j_] = keep + __shfl_xor(send, 8); } } \
            float p1; { const bool hi = (lane & 4) != 0; const float keep = hi ? p2[1] : p2[0], send = hi ? p2[0] : p2[1]; p1 = keep + __shfl_xor(send, 4); } \
            p1 += __shfl_xor(p1, 2); p1 += __shfl_xor(p1, 1); \
            const int E_ = ((lane >> 5) & 1) * 8 + ((lane >> 4) & 1) * 4 + ((lane >> 3) & 1) * 2 + ((lane >> 2) & 1); \
            if ((lane & 3) == 0) cbuf[(grp_) * 16 + E_] = gelu_f(p1); } while (0)
        G8_LOAD8(bufA, u8, 0); G8_LOAD8(bufB, u8, 8);
#pragma unroll 1
        for (int grp = 0; grp < 8; ++grp) {
            float part[16];
            G8_UDOT8(bufA, 0);
            if (grp < 7) G8_LOAD8(bufA, u8, 16 * (grp + 1)); else G8_LOAD8(bufA, v8, 0);
            G8_UDOT8(bufB, 8);
            if (grp < 7) G8_LOAD8(bufB, u8, 16 * (grp + 1) + 8); else G8_LOAD8(bufB, v8, 8);
            G8_REDUCE(grp);
        }
        asm volatile("s_waitcnt lgkmcnt(0)" ::: "memory");
        const float c0 = cbuf[lane] * g0 * 0.015625f, c1 = cbuf[64 + lane] * g1 * 0.015625f;
        asm volatile("s_waitcnt lgkmcnt(0)" ::: "memory");
        float acc[16];
#pragma unroll
        for (int i = 0; i < 16; ++i) acc[i] = 0.f;
#define G8_VCOMP8(buf_, slot0_) do { const float cv_ = (slot0_) < 64 ? c0 : c1; _Pragma("unroll") for (int j_ = 0; j_ < 8; ++j_) { const float ck_ = __int_as_float(__builtin_amdgcn_readlane(__float_as_int(cv_), ((slot0_) & 63) + j_)); \
            _Pragma("unroll") for (int d_ = 0; d_ < 4; ++d_) { const unsigned wv_ = buf_[j_][d_]; const f32x2_t lo_ = __builtin_amdgcn_cvt_pk_f32_fp8(wv_, false), hi_ = __builtin_amdgcn_cvt_pk_f32_fp8(wv_, true); \
                acc[4 * d_ + 0] += ck_ * lo_.x; acc[4 * d_ + 1] += ck_ * lo_.y; acc[4 * d_ + 2] += ck_ * hi_.x; acc[4 * d_ + 3] += ck_ * hi_.y; } \
            asm volatile("" : "+v"(acc[0]), "+v"(acc[1]), "+v"(acc[2]), "+v"(acc[3]), "+v"(acc[4]), "+v"(acc[5]), "+v"(acc[6]), "+v"(acc[7]), "+v"(acc[8]), "+v"(acc[9]), "+v"(acc[10]), "+v"(acc[11]), "+v"(acc[12]), "+v"(acc[13]), "+v"(acc[14]), "+v"(acc[15])); } } while (0)
#pragma unroll 1
        for (int grp = 0; grp < 8; ++grp) {
            G8_VCOMP8(bufA, 16 * grp);
            if (grp < 7) G8_LOAD8(bufA, v8, 16 * (grp + 1));
            G8_VCOMP8(bufB, 16 * grp + 8);
            if (grp < 7) G8_LOAD8(bufB, v8, 16 * (grp + 1) + 8);
        }
#undef G8_LOAD8
#undef G8_UDOT8
#undef G8_REDUCE
#undef G8_VCOMP8
        float hf[16]; float ss = 0.f;
#pragma unroll
        for (int d = 0; d < 4; ++d) { const int col = lane * 16 + d * 4;
            const f32x4 hv = *(const f32x4*)(h + (size_t)t * 1024 + col), mv = *(const f32x4*)(mod + b * 6144 + 5120 + col);
            hf[4 * d + 0] = hv.x + mv.x * acc[4 * d + 0]; hf[4 * d + 1] = hv.y + mv.y * acc[4 * d + 1]; hf[4 * d + 2] = hv.z + mv.z * acc[4 * d + 2]; hf[4 * d + 3] = hv.w + mv.w * acc[4 * d + 3]; }
#pragma unroll
        for (int i = 0; i < 16; ++i) ss += hf[i] * hf[i];
        const float rstd = rsqrtf(wave_sum(ss) * (1.f / 1024.f) + EPS);
#pragma unroll
        for (int d = 0; d < 4; ++d) { const int col = lane * 16 + d * 4; const f32x4 fv = *(const f32x4*)(fg + col);
            f32x4 o; o.x = hf[4 * d + 0] * rstd * fv.x; o.y = hf[4 * d + 1] * rstd * fv.y; o.z = hf[4 * d + 2] * rstd * fv.z; o.w = hf[4 * d + 3] * rstd * fv.w;
            *(f32x4*)(out + (size_t)t * 1024 + col) = o; }
    }
}

__device__ __forceinline__ void p_gather_ref(const Ctx& C, const bf16_t* n2, const unsigned short* pidx, const float* pgate, const float* h, float* out) {
    const float* mod = C.f32p(WS_MOD); const float* fg = C.in[23]; const float* U = C.in[21]; const float* V = C.in[22];
    LAS float* xs = (LAS float*)C.lds;
    LAS float* part = xs + 1024;
    LAS float* cs = part + 512;
    LAS float* red = cs + 128;
    LAS int* es = (LAS int*)(red + 512);
    const int tid = C.tid;
    for (int t = C.bid; t < T; t += C.G) {
        const int b = t / SEQ;
        __syncthreads();
        xs[tid] = bf2f(n2[(size_t)t * 1024 + tid]); xs[tid + 512] = bf2f(n2[(size_t)t * 1024 + 512 + tid]);
        if (tid < 128) es[tid] = pidx[(size_t)t * 128 + tid];
        __syncthreads();
        { const int k = tid >> 2, qd = tid & 3; const float* ur = U + (size_t)es[k] * 1024 + qd * 256; float acc = 0.f;
          for (int d = 0; d < 256; ++d) acc += ur[d] * xs[qd * 256 + d];
          part[tid] = acc; }
        __syncthreads();
        if (tid < 128) { const float dsum = part[tid * 4] + part[tid * 4 + 1] + part[tid * 4 + 2] + part[tid * 4 + 3]; cs[tid] = gelu_f(dsum) * pgate[(size_t)t * 128 + tid]; }
        __syncthreads();
        float o0 = 0.f, o1 = 0.f;
        for (int k = 0; k < 128; ++k) { const float* vr = V + (size_t)es[k] * 1024; const float ck = cs[k]; o0 += ck * vr[tid]; o1 += ck * vr[tid + 512]; }
        const float h0 = h[(size_t)t * 1024 + tid] + mod[b * 6144 + 5120 + tid] * o0, h1 = h[(size_t)t * 1024 + 512 + tid] + mod[b * 6144 + 5120 + 512 + tid] * o1;
        red[tid] = h0 * h0 + h1 * h1;
        __syncthreads();
        for (int sft = 256; sft > 0; sft >>= 1) { if (tid < sft) red[tid] += red[tid + sft]; __syncthreads(); }
        const float rstd = rsqrtf(red[0] * (1.f / 1024.f) + EPS);
        out[(size_t)t * 1024 + tid] = h0 * rstd * fg[tid]; out[(size_t)t * 1024 + 512 + tid] = h1 * rstd * fg[tid + 512];
    }
}

namespace pg8 {
#define PG8_LAS __attribute__((address_space(3)))
typedef unsigned short bf16_t;
typedef short bf16x8 __attribute__((ext_vector_type(8)));
typedef float f32x4 __attribute__((ext_vector_type(4)));
typedef unsigned u32x4 __attribute__((ext_vector_type(4)));
constexpr int BM = 256, BK = 64, HALF = 128, HTB = HALF * BK * 2  , STAGE_BYTES = 8 * HTB, NXCD = 8, WGM = 8;

__host__ __device__ __forceinline__ int lds_byte(int r, int c) { const int st = (r >> 4) * 2 + (c >> 5), rr = r & 15, cc = c & 31, ob = rr * 64 + cc * 2; return st * 1024 + (ob ^ (((ob >> 9) & 1) << 5)); }
__host__ __device__ __forceinline__ void stage_rc(int b, int& R, int& C) { const int st = b / 1024, sb = b % 1024, swz = sb ^ (((sb >> 9) & 1) << 5); R = (st >> 1) * 16 + swz / 64; C = (st & 1) * 32 + (swz % 64) / 2; }
__host__ __device__ __forceinline__ int perm32(int rho) { const int n = rho >> 4, i = rho & 15; return 8 * (i >> 2) + 4 * n + (i & 3); }

struct Unit { int pm, pn; };
struct Gemm { const bf16_t* A; const bf16_t* Bt; int M, N, K; };

struct StaticOrder {
    int nM, nN, nwg, G, c;
    __host__ __device__ void init(int M, int N, int G_, int c_) { nM = M / BM; nN = N / BM; nwg = nM * nN; G = G_; c = c_; }
    __host__ __device__ bool next(int i, Unit& u) const {
        const long L = (long)i * G + c; if (L >= nwg) return false;
        int wgid = (int)L; { const int q = nwg / NXCD, r = nwg % NXCD, xcd = wgid % NXCD, off = wgid / NXCD; wgid = (xcd < r ? xcd * (q + 1) : r * (q + 1) + (xcd - r) * q) + off; }
        const int nig = WGM * nN, gid = wgid / nig, fm = gid * WGM, gsz = (nM - fm) < WGM ? (nM - fm) : WGM;
        u.pm = fm + ((wgid % nig) % gsz); u.pn = (wgid % nig) / gsz; return true;
    }
    __device__ __forceinline__ void a_ready(const Unit&) const {}
    __device__ __forceinline__ void done(const Unit&) const {}
};

__device__ __forceinline__ unsigned cvt_pk_bf16(float lo, float hi) { return ::pk2(lo, hi); }
__device__ __forceinline__ float e_silu(float x) { return x / (1.f + __expf(-x)); }
__device__ __forceinline__ float e_sigm(float x) { return 1.f / (1.f + __expf(-x)); }
__device__ __forceinline__ float e_lo(unsigned v) { return __uint_as_float(v << 16); }
__device__ __forceinline__ float e_hi(unsigned v) { return __uint_as_float(v & 0xffff0000u); }
__device__ __forceinline__ u32x4 pack8(const f32x4 v0, const f32x4 v1) { u32x4 w; w.x = cvt_pk_bf16(v0[0], v0[1]); w.y = cvt_pk_bf16(v0[2], v0[3]); w.z = cvt_pk_bf16(v1[0], v1[1]); w.w = cvt_pk_bf16(v1[2], v1[3]); return w; }

struct EpiInProj {
    static constexpr bool PERM = true, AFTER_DRAIN = false;
    bf16_t *sz, *xbc, *q, *k, *v;
    __device__ __forceinline__ void operator()(const f32x4 (&acc)[2][2][4][2], const Unit& u, int wr, int wc, int fr, int fq) const {
        const int pn = u.pn; bf16_t* base; int ldc = 1024, colt, mode = 0;
        if (pn < 4) { base = sz; colt = pn * 256; mode = 1; }
        else if (pn < 12) { base = xbc; ldc = 2048; colt = (pn - 4) * 256; }
        else if (pn < 16) { base = q; colt = (pn - 12) * 256; mode = 2; }
        else if (pn < 20) { base = k; colt = (pn - 16) * 256; }
        else { base = v; colt = (pn - 20) * 256; }
        const int row0 = u.pm * BM + wr * 64 + fr, col0 = colt + wc * 32 + 8 * fq;
#pragma unroll
        for (int ai = 0; ai < 2; ++ai)
#pragma unroll
            for (int m = 0; m < 4; ++m) { bf16_t* rowp = base + (size_t)(row0 + ai * HALF + m * 16) * ldc + col0;
#pragma unroll
                for (int bj = 0; bj < 2; ++bj) { f32x4 v0 = acc[ai][bj][m][0], v1 = acc[ai][bj][m][1];
                    if (mode == 1) {
#pragma unroll
                        for (int i = 0; i < 4; ++i) { v0[i] = e_silu(v0[i]); v1[i] = e_silu(v1[i]); } }
                    else if (mode == 2) { v0 = v0 * 0.125f; v1 = v1 * 0.125f; }
                    *(u32x4*)(rowp + bj * HALF) = pack8(v0, v1); } }
    }
};
struct EpiGate {
    static constexpr bool PERM = true, AFTER_DRAIN = false;
    bf16_t* sg; size_t plane;
    __device__ __forceinline__ void operator()(const f32x4 (&acc)[2][2][4][2], const Unit& u, int wr, int wc, int fr, int fq) const {
        bf16_t* base = sg + (size_t)(u.pn >> 2) * plane; const int colt = (u.pn & 3) * 256;
        const int row0 = u.pm * BM + wr * 64 + fr, col0 = colt + wc * 32 + 8 * fq;
#pragma unroll
        for (int ai = 0; ai < 2; ++ai)
#pragma unroll
            for (int m = 0; m < 4; ++m) { bf16_t* rowp = base + (size_t)(row0 + ai * HALF + m * 16) * 1024 + col0;
#pragma unroll
                for (int bj = 0; bj < 2; ++bj) { f32x4 v0 = acc[ai][bj][m][0], v1 = acc[ai][bj][m][1];
#pragma unroll
                    for (int i = 0; i < 4; ++i) { v0[i] = e_sigm(v0[i]); v1[i] = e_sigm(v1[i]); }
                    *(u32x4*)(rowp + bj * HALF) = pack8(v0, v1); } }
    }
};
struct EpiD1 {
    static constexpr bool PERM = true, AFTER_DRAIN = false;
    bf16_t* p1; const bf16_t* sg1; const float* rstd;
    __device__ __forceinline__ void operator()(const f32x4 (&acc)[2][2][4][2], const Unit& u, int wr, int wc, int fr, int fq) const {
        const int row0 = u.pm * BM + wr * 64 + fr, col0 = u.pn * BM + wc * 32 + 8 * fq;
#pragma unroll
        for (int ai = 0; ai < 2; ++ai)
#pragma unroll
            for (int m = 0; m < 4; ++m) { const int row = row0 + ai * HALF + m * 16; const float rs = rstd[row]; const size_t off = (size_t)row * 1024 + col0;
#pragma unroll
                for (int bj = 0; bj < 2; ++bj) { f32x4 v0 = acc[ai][bj][m][0] * rs, v1 = acc[ai][bj][m][1] * rs;
                    const u32x4 g = *(const u32x4*)(sg1 + off + bj * HALF);
                    v0[0] *= e_lo(g.x); v0[1] *= e_hi(g.x); v0[2] *= e_lo(g.y); v0[3] *= e_hi(g.y); v1[0] *= e_lo(g.z); v1[1] *= e_hi(g.z); v1[2] *= e_lo(g.w); v1[3] *= e_hi(g.w);
                    *(u32x4*)(p1 + off + bj * HALF) = pack8(v0, v1); } }
    }
};
struct EpiD2 {
    static constexpr bool PERM = true, AFTER_DRAIN = false;
    bf16_t* mixed; const bf16_t *p1, *sg2;
    __device__ __forceinline__ void operator()(const f32x4 (&acc)[2][2][4][2], const Unit& u, int wr, int wc, int fr, int fq) const {
        const int row0 = u.pm * BM + wr * 64 + fr, col0 = u.pn * BM + wc * 32 + 8 * fq;
#pragma unroll
        for (int ai = 0; ai < 2; ++ai)
#pragma unroll
            for (int m = 0; m < 4; ++m) { const int row = row0 + ai * HALF + m * 16; const size_t off = (size_t)row * 1024 + col0;
#pragma unroll
                for (int bj = 0; bj < 2; ++bj) { f32x4 v0 = acc[ai][bj][m][0], v1 = acc[ai][bj][m][1];
                    const u32x4 g = *(const u32x4*)(sg2 + off + bj * HALF), p = *(const u32x4*)(p1 + off + bj * HALF);
                    v0[0] = e_lo(p.x) + v0[0] * e_lo(g.x); v0[1] = e_hi(p.x) + v0[1] * e_hi(g.x); v0[2] = e_lo(p.y) + v0[2] * e_lo(g.y); v0[3] = e_hi(p.y) + v0[3] * e_hi(g.y);
                    v1[0] = e_lo(p.z) + v1[0] * e_lo(g.z); v1[1] = e_hi(p.z) + v1[1] * e_hi(g.z); v1[2] = e_lo(p.w) + v1[2] * e_lo(g.w); v1[3] = e_hi(p.w) + v1[3] * e_hi(g.w);
                    *(u32x4*)(mixed + off + bj * HALF) = pack8(v0, v1); } }
    }
};
struct EpiD3 {
    static constexpr bool PERM = false, AFTER_DRAIN = false;
    float* h; const float* x; const float* mod;
    __device__ __forceinline__ void operator()(const f32x4 (&acc)[2][2][4][2], const Unit& u, int wr, int wc, int fr, int fq) const {
        const int row0 = u.pm * BM + wr * 64 + fr, col0 = u.pn * BM + wc * 32 + 4 * fq;
        const float* g1 = mod + (size_t)((u.pm * BM) >> 12) * 6144 + 2048;
#pragma unroll
        for (int ai = 0; ai < 2; ++ai)
#pragma unroll
            for (int m = 0; m < 4; ++m) { const size_t off = (size_t)(row0 + ai * HALF + m * 16) * 1024 + col0;
#pragma unroll
                for (int bj = 0; bj < 2; ++bj)
#pragma unroll
                    for (int n = 0; n < 2; ++n) { const int c = bj * HALF + n * 16; const f32x4 xv = *(const f32x4*)(x + off + c), gv = *(const f32x4*)(g1 + col0 + c);
                        *(f32x4*)(h + off + c) = xv + gv * acc[ai][bj][m][n]; } }
    }
};
struct EpiQp {
    static constexpr bool PERM = true, AFTER_DRAIN = false;
    bf16_t* qp;
    __device__ __forceinline__ void operator()(const f32x4 (&acc)[2][2][4][2], const Unit& u, int wr, int wc, int fr, int fq) const {
        const int row0 = u.pm * BM + wr * 64 + fr, col0 = u.pn * BM + wc * 32 + 8 * fq;
#pragma unroll
        for (int ai = 0; ai < 2; ++ai)
#pragma unroll
            for (int m = 0; m < 4; ++m) { bf16_t* rowp = qp + (size_t)(row0 + ai * HALF + m * 16) * 2048 + col0;
#pragma unroll
                for (int bj = 0; bj < 2; ++bj) *(u32x4*)(rowp + bj * HALF) = pack8(acc[ai][bj][m][0], acc[ai][bj][m][1]); }
    }
};

template <class Epi, class Sched, bool ALIGN_EPI = false, bool SP2 = false>
__device__ __forceinline__ void gemm_phase(PG8_LAS unsigned char* lds, const Gemm g, const Sched& S, const Epi& E) {
    const int tid = threadIdx.x, wid = __builtin_amdgcn_readfirstlane(tid >> 6), lane = tid & 63, wr = wid >> 2, wc = wid & 3, fr = lane & 15, fq = lane >> 4;
    const int K = g.K, nt = K / BK;
    unsigned voffA[2], voffB[2];
#pragma unroll
    for (int i = 0; i < 2; ++i) { int R, C; stage_rc(tid * 16 + i * 8192, R, C); const int Rb = Epi::PERM ? ((R & ~31) + perm32(R & 31)) : R;
        voffA[i] = (unsigned)(R * K + C) * 2u; voffB[i] = (unsigned)(Rb * K + C) * 2u; }
    const size_t kstep = (size_t)(BK * 2);
    const size_t hstep = (size_t)HALF * K * 2;
    const size_t tstep = 2 * hstep;
    const unsigned ldsw = (unsigned)wid * 1024u;
    const int aoff = lds_byte(wr * 64 + fr, fq * 8), boff = lds_byte(wc * 32 + fr, fq * 8);
#define PG8_SA(b, h) (((b) * 2 + (h)) * HTB)
#define PG8_SB(b, h) ((4 + (b) * 2 + (h)) * HTB)
#define PG8_STAGE(bufoff, gbase, voff) do { _Pragma("unroll") for (int _i = 0; _i < 2; ++_i) \
        __builtin_amdgcn_global_load_lds((const unsigned*)((const char*)(gbase) + (voff)[_i]), (PG8_LAS unsigned*)(lds + (bufoff) + ldsw + _i * 8192), 16, 0, 0); } while (0)
#define PG8_LDA(dst, b, h) do { _Pragma("unroll") for (int m = 0; m < 4; ++m) _Pragma("unroll") for (int k = 0; k < 2; ++k) dst[m][k] = *(const PG8_LAS bf16x8*)(lds + PG8_SA(b, h) + aoff + m * 2048 + k * 1024); } while (0)
#define PG8_LDB(dst, b, h) do { _Pragma("unroll") for (int n = 0; n < 2; ++n) _Pragma("unroll") for (int k = 0; k < 2; ++k) dst[n][k] = *(const PG8_LAS bf16x8*)(lds + PG8_SB(b, h) + boff + n * 2048 + k * 1024); } while (0)
#define PG8_MMA(ai, bj, At, Bt) do { __builtin_amdgcn_s_setprio(1); _Pragma("unroll") for (int m = 0; m < 4; ++m) _Pragma("unroll") for (int n = 0; n < 2; ++n) _Pragma("unroll") for (int k = 0; k < 2; ++k) \
        acc[ai][bj][m][n] = __builtin_amdgcn_mfma_f32_16x16x32_bf16(Bt[n][k], At[m][k], acc[ai][bj][m][n], 0, 0, 0); __builtin_amdgcn_s_setprio(0); } while (0)
#define PG8_WAIT_V(n) asm volatile("s_waitcnt vmcnt(" #n ")" ::: "memory")
#define PG8_WAIT_L(n) asm volatile("s_waitcnt lgkmcnt(" #n ")" ::: "memory")
#define PG8_BAR __builtin_amdgcn_s_barrier()
#define PG8_SCHED __builtin_amdgcn_sched_barrier(0)
    Unit cur, nxt; int ui = 0;
    if (!S.next(0, cur)) return;
    f32x4 acc[2][2][4][2];
#pragma unroll
    for (int a = 0; a < 2; ++a)
#pragma unroll
        for (int b = 0; b < 2; ++b)
#pragma unroll
            for (int m = 0; m < 4; ++m)
#pragma unroll
                for (int n = 0; n < 2; ++n) acc[a][b][m][n] = (f32x4){0.f, 0.f, 0.f, 0.f};
    bf16x8 At[4][2], B0[2][2], B1[2][2];
    const char* cA = (const char*)g.A + (size_t)cur.pm * tstep; const char* cB = (const char*)g.Bt + (size_t)cur.pn * tstep;
    S.a_ready(cur);
    if constexpr (SP2) {
        PG8_STAGE(PG8_SB(0, 0), cB, voffB); PG8_STAGE(PG8_SB(0, 1), cB + hstep, voffB); PG8_STAGE(PG8_SA(0, 0), cA, voffA); PG8_STAGE(PG8_SA(0, 1), cA + hstep, voffA);
        if (wr == 1) PG8_BAR;
        PG8_WAIT_V(2); PG8_BAR;
        PG8_STAGE(PG8_SB(1, 0), cB + kstep, voffB); PG8_STAGE(PG8_SA(1, 0), cA + kstep, voffA); PG8_STAGE(PG8_SB(1, 1), cB + hstep + kstep, voffB);
        PG8_WAIT_V(6); PG8_BAR;
    } else {
        PG8_STAGE(PG8_SB(0, 0), cB, voffB); PG8_STAGE(PG8_SA(0, 0), cA, voffA); PG8_STAGE(PG8_SB(0, 1), cB + hstep, voffB); PG8_STAGE(PG8_SA(0, 1), cA + hstep, voffA);
        if (wr == 1) PG8_BAR;
        PG8_WAIT_V(4); PG8_BAR;
        PG8_STAGE(PG8_SB(1, 0), cB + kstep, voffB); PG8_STAGE(PG8_SA(1, 0), cA + kstep, voffA); PG8_STAGE(PG8_SB(1, 1), cB + hstep + kstep, voffB);
        PG8_WAIT_V(6); PG8_BAR;
    }
    for (;;) {
        const bool has_next = S.next(ui + 1, nxt);
        const char* nA = has_next ? (const char*)g.A + (size_t)nxt.pm * tstep : cA; const char* nB = has_next ? (const char*)g.Bt + (size_t)nxt.pn * tstep : cB;
        for (int t = 0; t < nt; t += 2) {
            const bool last = (t == nt - 2);
            const char* a1 = cA + (size_t)(t + 1) * kstep;
            const char* a2 = last ? nA : cA + (size_t)(t + 2) * kstep; const char* b2 = last ? nB : cB + (size_t)(t + 2) * kstep;
            const char* a3 = a2 + kstep; const char* b3 = b2 + kstep;
            if (last && has_next) S.a_ready(nxt);
            if constexpr (SP2) {
            PG8_LDB(B0, 0, 0); PG8_LDB(B1, 0, 1); PG8_SCHED; PG8_LDA(At, 0, 0); PG8_STAGE(PG8_SA(1, 1), a1 + hstep, voffA);
            PG8_WAIT_V(8); PG8_WAIT_L(0); PG8_BAR; PG8_MMA(0, 0, At, B0); PG8_MMA(0, 1, At, B1); PG8_BAR; PG8_SCHED;
            PG8_LDA(At, 0, 1); PG8_STAGE(PG8_SB(0, 0), b2, voffB); PG8_STAGE(PG8_SB(0, 1), b2 + hstep, voffB); PG8_STAGE(PG8_SA(0, 0), a2, voffA);
            PG8_WAIT_V(8); PG8_WAIT_L(0); PG8_BAR; PG8_MMA(1, 0, At, B0); PG8_MMA(1, 1, At, B1); PG8_BAR; PG8_SCHED;
            PG8_LDB(B0, 1, 0); PG8_LDB(B1, 1, 1); PG8_SCHED; PG8_LDA(At, 1, 0); PG8_STAGE(PG8_SA(0, 1), a2 + hstep, voffA);
            PG8_WAIT_V(8); PG8_WAIT_L(0); PG8_BAR; PG8_MMA(0, 0, At, B0); PG8_MMA(0, 1, At, B1); PG8_BAR; PG8_SCHED;
            PG8_LDA(At, 1, 1); PG8_STAGE(PG8_SB(1, 0), b3, voffB); PG8_STAGE(PG8_SB(1, 1), b3 + hstep, voffB); PG8_STAGE(PG8_SA(1, 0), a3, voffA);
            PG8_WAIT_V(8); PG8_WAIT_L(0); PG8_BAR; PG8_MMA(1, 0, At, B0); PG8_MMA(1, 1, At, B1); PG8_BAR; PG8_SCHED;
            } else {
            PG8_LDB(B0, 0, 0); PG8_SCHED; PG8_LDA(At, 0, 0); PG8_STAGE(PG8_SA(1, 1), a1 + hstep, voffA);
            PG8_WAIT_L(8); PG8_BAR; PG8_WAIT_L(0); PG8_MMA(0, 0, At, B0); PG8_BAR; PG8_SCHED;
            PG8_LDB(B1, 0, 1); PG8_STAGE(PG8_SB(0, 0), b2, voffB);
            PG8_BAR; PG8_WAIT_L(0); PG8_MMA(0, 1, At, B1); PG8_BAR;
            PG8_LDA(At, 0, 1); PG8_STAGE(PG8_SA(0, 0), a2, voffA);
            PG8_BAR; PG8_WAIT_L(0); PG8_MMA(1, 0, At, B0); PG8_BAR; PG8_SCHED;
            PG8_STAGE(PG8_SB(0, 1), b2 + hstep, voffB);
            PG8_WAIT_V(6); PG8_BAR; PG8_MMA(1, 1, At, B1); PG8_BAR;
            PG8_LDB(B0, 1, 0); PG8_SCHED; PG8_LDA(At, 1, 0); PG8_STAGE(PG8_SA(0, 1), a2 + hstep, voffA);
            PG8_WAIT_L(8); PG8_BAR; PG8_WAIT_L(0); PG8_MMA(0, 0, At, B0); PG8_BAR; PG8_SCHED;
            PG8_LDB(B1, 1, 1); PG8_STAGE(PG8_SB(1, 0), b3, voffB);
            PG8_BAR; PG8_WAIT_L(0); PG8_MMA(0, 1, At, B1); PG8_BAR;
            PG8_LDA(At, 1, 1); PG8_STAGE(PG8_SA(1, 0), a3, voffA);
            PG8_BAR; PG8_WAIT_L(0); PG8_MMA(1, 0, At, B0); PG8_BAR; PG8_SCHED;
            PG8_STAGE(PG8_SB(1, 1), b3 + hstep, voffB);
            PG8_WAIT_V(6); PG8_BAR; PG8_MMA(1, 1, At, B1); PG8_BAR;
            }
        }
        if constexpr (ALIGN_EPI) { if (wr == 0) PG8_BAR; }
        if constexpr (!Epi::AFTER_DRAIN) { E(acc, cur, wr, wc, fr, fq); S.done(cur); }
        if (!has_next) break;
#pragma unroll
        for (int a = 0; a < 2; ++a)
#pragma unroll
            for (int b = 0; b < 2; ++b)
#pragma unroll
                for (int m = 0; m < 4; ++m)
#pragma unroll
                    for (int n = 0; n < 2; ++n) acc[a][b][m][n] = (f32x4){0.f, 0.f, 0.f, 0.f};
        cur = nxt; cA = nA; cB = nB; ++ui;
        if constexpr (ALIGN_EPI) { if (wr == 1) PG8_BAR; }
    }
    PG8_WAIT_V(0);
    if constexpr (!ALIGN_EPI) { if (wr == 0) PG8_BAR; }
    PG8_BAR;
    if constexpr (Epi::AFTER_DRAIN) { E.fused(acc, cur, wr, wc, fr, fq, lds, wid, lane); S.done(cur); }
#undef PG8_SA
#undef PG8_SB
#undef PG8_STAGE
#undef PG8_LDA
#undef PG8_LDB
#undef PG8_MMA
#undef PG8_WAIT_V
#undef PG8_WAIT_L
#undef PG8_BAR
#undef PG8_SCHED
}
}


__device__ __forceinline__ void p_diag_cmp(const Ctx& C, const bf16_t* a, const bf16_t* b, size_t n, unsigned* res) {
    const size_t gt = (size_t)C.bid * NTHR + C.tid, NT = (size_t)C.G * NTHR;
    float md = 0.f, mr = 0.f;
    for (size_t i = gt; i < n; i += NT) { const float x = bf2f(a[i]), y = bf2f(b[i]); const float d = x - y; md += (d == d ? d * d : 1e30f); mr += x * x; }
#pragma unroll
    for (int o = 1; o < 64; o <<= 1) { md += __shfl_xor(md, o); mr += __shfl_xor(mr, o); }
    if (C.lane == 0) { atomicAdd((float*)res, md); atomicAdd((float*)res + 1, mr); }
}
__device__ __forceinline__ void p_diag_out(const Ctx& C, const unsigned* res, float* out) {
    const size_t gt = (size_t)C.bid * NTHR + C.tid, NT = (size_t)C.G * NTHR;
    for (size_t i = gt; i < (size_t)T * 1024; i += NT) out[i] = 0.f;
    __syncthreads();
    if (C.bid == 0 && C.tid == 0) { const float md = __uint_as_float(res[0]), mr = __uint_as_float(res[1]); const float rel = sqrtf(md / fmaxf(mr, 1e-30f));
        out[0] = 1.0e4f * (13.f + log10f(rel + 1e-12f)); }
}

#define GAS __attribute__((address_space(1)))
typedef GAS unsigned gu32;
#define RLX_AGENT __ATOMIC_RELAXED, __HIP_MEMORY_SCOPE_AGENT
#define XB_TMO      128
#define XB_XCNT(j)  (256  + 64 * (j))
#define XB_XSUB(j)  (1280 + 64 * (j))
#define XB_XGEN(j)  (2304 + 64 * (j))
#define XB_TOP      3328
#define XB_TOPGEN   3392
#define XCD_BAR_WORDS 3456
#define XB_SPIN_CAP (1u << 18)

__device__ __forceinline__ unsigned xb_ld(unsigned* p)              { return __hip_atomic_load(p, __ATOMIC_RELAXED, __HIP_MEMORY_SCOPE_AGENT); }
__device__ __forceinline__ unsigned xb_add(unsigned* p, unsigned v) { return __hip_atomic_fetch_add(p, v, __ATOMIC_RELAXED, __HIP_MEMORY_SCOPE_AGENT); }
__device__ __forceinline__ unsigned xb_xcc_id() { return (unsigned)__builtin_amdgcn_s_getreg((3 << 11) | 20) & 0xFu; }
#define XB_SPIN(cond, bar) do { unsigned _sp = 0; while (cond) { __builtin_amdgcn_s_sleep(1); \
    if ((++_sp & 255u) == 0u) { if (xb_ld(&(bar)[XB_TMO])) break; if (_sp > XB_SPIN_CAP) { atomicAdd(&(bar)[XB_TMO], 1u); break; } } } } while (0)

struct XcdBarrier {
    unsigned* bar; unsigned x;
    volatile LAS unsigned* st;
};

__device__ __forceinline__ XcdBarrier xcd_barrier_post(unsigned* bar, volatile LAS unsigned* st) {
    XcdBarrier b; b.bar = bar; b.x = xb_xcc_id(); b.st = st;
    if (threadIdx.x == 0) (void)xb_add(&bar[XB_XCNT(b.x)], 1u);
    return b;
}
__device__ __forceinline__ void xcd_barrier_complete(unsigned* bar, unsigned x, unsigned& nloc, unsigned& nx) {
    const unsigned G = gridDim.x * gridDim.y * gridDim.z;
    unsigned sum, cnt, mine, sp = 0u;
    for (;;) {
        sum = 0u; cnt = 0u; mine = 0u;
#pragma unroll
        for (unsigned j = 0; j < 16; ++j) { const unsigned c = xb_ld(&bar[XB_XCNT(j)]); sum += c; cnt += (c > 0u) ? 1u : 0u; mine = (j == x) ? c : mine; }
        if (sum == G) break;
        __builtin_amdgcn_s_sleep(1);
        if ((++sp & 255u) == 0u) { if (xb_ld(&bar[XB_TMO])) break; if (sp > XB_SPIN_CAP) { atomicAdd(&bar[XB_TMO], 1u); break; } }
    }
    nloc = mine > 0u ? mine : 1u; nx = cnt > 0u ? cnt : 1u;
}

__device__ __forceinline__ void xcd_barrier(const XcdBarrier& b) {
    asm volatile("s_waitcnt vmcnt(0)" ::: "memory");
    __syncthreads();
    if (threadIdx.x == 0) {
        unsigned* bar = b.bar;
        __builtin_amdgcn_s_waitcnt(0);
        unsigned nloc = b.st[0], nx = b.st[1];
        if (nloc == 0u) { xcd_barrier_complete(bar, b.x, nloc, nx); b.st[0] = nloc; b.st[1] = nx; }
        const unsigned old = xb_add(&bar[XB_XSUB(b.x)], 1u);
        const unsigned gen = old / nloc;
        if (old + 1u == (gen + 1u) * nloc) {
            __builtin_amdgcn_fence(__ATOMIC_RELEASE, "agent");
            asm volatile("s_waitcnt vmcnt(0)" ::: "memory");
            const unsigned og = xb_add(&bar[XB_TOP], 1u);
            const unsigned tg = og / nx;
            if (og + 1u == (tg + 1u) * nx) xb_add(&bar[XB_TOPGEN], 1u);
            else XB_SPIN(xb_ld(&bar[XB_TOPGEN]) == tg, bar);
            __builtin_amdgcn_fence(__ATOMIC_ACQUIRE, "agent");
            xb_add(&bar[XB_XGEN(b.x)], 1u);
            asm volatile("s_waitcnt vmcnt(0)" ::: "memory");
        } else {
            XB_SPIN(xb_ld(&bar[XB_XGEN(b.x)]) == gen, bar);
            __builtin_amdgcn_fence(__ATOMIC_ACQUIRE, "agent");
            asm volatile("s_waitcnt vmcnt(0)" ::: "memory");
        }
    }
    __syncthreads();
}


constexpr int N_PHASES = 15;
constexpr int CW_BAR = 4096;
constexpr size_t CTL_ZERO_BYTES = 64 * 1024;
constexpr int MISC_OFF = LDS_BYTES - 256;

template <int PH>
__device__ __forceinline__ void run_phase(const Ctx& C, const Args& a) {
    bf16_t* R0 = C.bfp(WS_R0); bf16_t* R1 = C.bfp(WS_R1); bf16_t* R2 = C.bfp(WS_R2); bf16_t* R3 = C.bfp(WS_R3);
    bf16_t* OB = (bf16_t*)a.out;
    const size_t TD = (size_t)T * 1024;
    if constexpr (PH == 0) p_prep(C);
    if constexpr (PH == 1) p_rownorm(C, C.in[0], C.in[4], 0, 1024, R0);
    if constexpr (PH == 2) {
        { pg8::Gemm g{R0, C.bfp(WS_WIN_T), T, 6144, 1024}; pg8::StaticOrder S; S.init(T, 6144, C.G, C.bid);
          pg8::EpiInProj e{R1, R2, R3, R3 + TD, R3 + 2 * TD};
          pg8::gemm_phase<pg8::EpiInProj, pg8::StaticOrder, true, true>(C.lds, g, S, e); }
        EDt ed{C.f32p(WS_DT), C.in[8], C.in[9]};
        naive_gemm(C, R0, C.bfp(WS_WDT_T), T, 32, 1024, ed);
    }
    if constexpr (PH == 3) p_conv(C, R2, OB);
#ifdef DIAG_SSD
    if constexpr (PH == 4) p_ssd_naive(C, OB, C.f32p(WS_DT), R2, R2 + TD);
    if constexpr (PH == 6) p_ssd(C, OB, C.f32p(WS_DT), R3 + TD, R3 + 2 * TD);
    if constexpr (PH == 7) p_diag_cmp(C, R2, R3 + TD, 2 * TD, (unsigned*)(a.ws + WS_CTL) + 1024);
    if constexpr (PH == 8) p_diag_out(C, (unsigned*)(a.ws + WS_CTL) + 1024, a.out);
#else
    if constexpr (PH == 4) p_ssd(C, OB, C.f32p(WS_DT), R2, R2 + TD);
#endif
    if constexpr (PH == 5) p_na(C, R3, R3 + TD, R3 + 2 * TD);
#ifndef DIAG_SSD
    if constexpr (PH == 6) p_combine(C, R2, R2 + TD, R1, C.f32p(WS_RSTD));
    if constexpr (PH == 7) { pg8::Gemm g{R0, C.bfp(WS_WG_T), T, 2048, 1024}; pg8::StaticOrder S; S.init(T, 2048, C.G, C.bid);
        pg8::EpiGate e{OB, TD}; pg8::gemm_phase<pg8::EpiGate, pg8::StaticOrder, true, true>(C.lds, g, S, e); }
    if constexpr (PH == 8) { pg8::Gemm g{R1, C.bfp(WS_WSSD_T), T, 1024, 1024}; pg8::StaticOrder S; S.init(T, 1024, C.G, C.bid);
        pg8::EpiD1 e{R2, OB, C.f32p(WS_RSTD)}; pg8::gemm_phase<pg8::EpiD1, pg8::StaticOrder, true, true>(C.lds, g, S, e); }
    if constexpr (PH == 9) { pg8::Gemm g{R3, C.bfp(WS_WNA_T), T, 1024, 1024}; pg8::StaticOrder S; S.init(T, 1024, C.G, C.bid);
        pg8::EpiD2 e{R2 + TD, R2, OB + TD}; pg8::gemm_phase<pg8::EpiD2, pg8::StaticOrder, true, true>(C.lds, g, S, e); }
    if constexpr (PH == 10) { pg8::Gemm g{R2 + TD, C.bfp(WS_WOUT_T), T, 1024, 1024}; pg8::StaticOrder S; S.init(T, 1024, C.G, C.bid);
        pg8::EpiD3 e{(float*)(R3 + TD), C.in[0], C.f32p(WS_MOD)}; pg8::gemm_phase<pg8::EpiD3, pg8::StaticOrder, true, true>(C.lds, g, S, e); }
    if constexpr (PH == 11) { p_rownorm(C, (const float*)(R3 + TD), C.in[18], 3072, 4096, R0); p_cvt_tables8(C, (unsigned char*)R2, (unsigned char*)R2 + (size_t)16384 * 1024); }
    if constexpr (PH == 12) { pg8::Gemm g{R0, C.bfp(WS_WPQ_T), T, 2048, 1024}; pg8::StaticOrder S; S.init(T, 2048, C.G, C.bid);
        pg8::EpiQp e{OB}; pg8::gemm_phase<pg8::EpiQp, pg8::StaticOrder, true, true>(C.lds, g, S, e); }
    if constexpr (PH == 13) p_topk(C, OB, C.bfp(WS_KEYS), (unsigned short*)R1, (float*)(R1 + 4 * MiB));
    if constexpr (PH == 14) p_gather8(C, R0, (const unsigned short*)R1, (const float*)(R1 + 4 * MiB), (const unsigned char*)R2, (const unsigned char*)R2 + (size_t)16384 * 1024, (const float*)(R3 + TD), a.out);
#endif
}

template <int PH> struct PhaseLoop {
    static __device__ __forceinline__ void run(const Ctx& C, const Args& a, const XcdBarrier& bar) {
        if (PH >= a.ph_lo && PH < a.ph_hi) { run_phase<PH>(C, a);
#ifdef REP_PHASE
            if (PH == REP_PHASE) { xcd_barrier(bar); run_phase<PH>(C, a); }
#endif
            if (PH + 1 < a.ph_hi) xcd_barrier(bar); }
        PhaseLoop<PH + 1>::run(C, a, bar);
    }
};
template <> struct PhaseLoop<N_PHASES> { static __device__ __forceinline__ void run(const Ctx&, const Args&, const XcdBarrier&) {} };

__global__ void __launch_bounds__(NTHR, 2) mega(Args a) {
    extern __shared__ __attribute__((aligned(16))) unsigned char lds_raw[];
    Ctx C; C.in = a.in; C.out = a.out; C.ws = a.ws; C.tid = threadIdx.x; C.lane = C.tid & 63; C.wave = __builtin_amdgcn_readfirstlane(C.tid >> 6);
    C.G = gridDim.x; C.bid = blockIdx.x; C.lds = (LAS unsigned char*)lds_raw;
    volatile LAS unsigned* MISC = (volatile LAS unsigned*)(C.lds + MISC_OFF);
    if (C.tid < 64) MISC[C.tid] = 0u;
    __syncthreads();
    XcdBarrier bar; bar.bar = (unsigned*)(a.ws + WS_CTL) + CW_BAR; bar.x = 0; bar.st = nullptr;
    if (a.ph_hi - a.ph_lo > 1) bar = xcd_barrier_post((unsigned*)(a.ws + WS_CTL) + CW_BAR, MISC + 8);
    PhaseLoop<0>::run(C, a, bar);
}

extern "C" void kernel_launch(void* const* d_in, const int* in_sizes, int n_in, void* d_out, int out_size, void* d_ws, size_t ws_size, hipStream_t stream) {
    static int grid = 0;
    if (grid == 0) {
        if (n_in != 24 || out_size != T * D || ws_size < WS_END) { fprintf(stderr, "kernel_launch: unexpected shapes n_in %d out %d ws %zu\n", n_in, out_size, ws_size); grid = -1; return; }
        int dev = 0, cus = 0;
        if (hipGetDevice(&dev) != hipSuccess || hipDeviceGetAttribute(&cus, hipDeviceAttributeMultiprocessorCount, dev) != hipSuccess) { grid = -1; return; }
        if (hipFuncSetAttribute((const void*)mega, hipFuncAttributeMaxDynamicSharedMemorySize, LDS_BYTES) != hipSuccess) { grid = -1; return; }
        grid = cus;
    }
    if (grid < 0) return;
    (void)hipMemsetAsync((char*)d_ws + WS_CTL, 0, CTL_ZERO_BYTES, stream);
    Args a{};
    for (int i = 0; i < 24; ++i) a.in[i] = (const float*)d_in[i];
    a.out = (float*)d_out; a.ws = (unsigned char*)d_ws;
#ifdef DIAG_SSD
    for (int ph = 0; ph < 9; ++ph) { a.ph_lo = ph; a.ph_hi = ph + 1; hipLaunchKernelGGL(mega, dim3(grid), dim3(NTHR), LDS_BYTES, stream, a); }
#else
    a.ph_lo = 0; a.ph_hi = N_PHASES;
    hipLaunchKernelGGL(mega, dim3(grid), dim3(NTHR), LDS_BYTES, stream, a);
#endif
}
```

```cpp
#include <hip/hip_runtime.h>
#include <cstdio>
#include <cstdint>

#define LAS __attribute__((address_space(3)))
typedef unsigned short bf16_t;
typedef float f32x4 __attribute__((ext_vector_type(4)));
typedef unsigned u32x4 __attribute__((ext_vector_type(4)));
typedef unsigned u32x2 __attribute__((ext_vector_type(2)));
typedef __bf16 bf16x2_t __attribute__((ext_vector_type(2)));

constexpr int T = 32768, D = 1024, NB = 8, SEQ = 4096;
constexpr int NWAVES = 8, NTHR = 512;
constexpr float EPS = 1e-6f;
constexpr int OFF_Z = 0, OFF_XBC = 1024, OFF_DTF = 3072, OFF_DTB = 3088, OFF_QKV = 3104, OFF_GS = 6176, OFF_GN = 7200, D_IN = 8224;

constexpr size_t MiB = 1u << 20;
constexpr size_t WS_CTL = 0;
constexpr size_t WS_MOD = 1 * MiB;
constexpr size_t WS_RSTD = 1 * MiB + 512 * 1024;
constexpr size_t WS_DT = 2 * MiB;
constexpr size_t WS_WIN_T = 6 * MiB;
constexpr size_t WS_WG_T = 18 * MiB;
constexpr size_t WS_WDT_T = 22 * MiB;
constexpr size_t WS_KEYS = 22 * MiB + 512 * 1024;
constexpr size_t WS_WSSD_T = 23 * MiB, WS_WNA_T = 25 * MiB, WS_WOUT_T = 27 * MiB, WS_WPQ_T = 29 * MiB;
constexpr size_t WS_R0 = 40 * MiB, WS_R1 = 104 * MiB, WS_R2 = 168 * MiB, WS_R3 = 296 * MiB, WS_END = 488 * MiB;

constexpr int LDS_BYTES = 147456;

struct Args { const float* in[24]; float* out; unsigned char* ws; int ph_lo, ph_hi; };

__device__ __forceinline__ float bf2f(unsigned v) { return __uint_as_float(v << 16); }
__device__ __forceinline__ float bflo(unsigned v) { return __uint_as_float(v << 16); }
__device__ __forceinline__ float bfhi(unsigned v) { return __uint_as_float(v & 0xffff0000u); }
__device__ __forceinline__ unsigned f2bf(float f) { unsigned u = __float_as_uint(f); return (u + 0x7fffu + ((u >> 16) & 1u)) >> 16; }
typedef float f32x2_t __attribute__((ext_vector_type(2)));
__device__ __forceinline__ unsigned pk2(float lo, float hi) { f32x2_t v = {lo, hi}; bf16x2_t b = __builtin_convertvector(v, bf16x2_t); return __builtin_bit_cast(unsigned, b); }
__device__ __forceinline__ float wave_sum(float v) {
#pragma unroll
    for (int o = 1; o < 64; o <<= 1) v += __shfl_xor(v, o);
    return v;
}
__device__ __forceinline__ float silu_f(float x) { return x / (1.f + __expf(-x)); }
__device__ __forceinline__ float sigmoid_f(float x) { return 1.f / (1.f + __expf(-x)); }
__device__ __forceinline__ float softplus_f(float x) { return x > 20.f ? x : log1pf(__expf(x)); }
__device__ __forceinline__ float gelu_f(float x) { return 0.5f * x * (1.f + erff(x * 0.70710678118654752f)); }

struct Ctx {
    const float* const* in; float* out; unsigned char* ws;
    int tid, lane, wave, G, bid;
    LAS unsigned char* lds;
    __device__ __forceinline__ float* f32p(size_t off) const { return (float*)(ws + off); }
    __device__ __forceinline__ bf16_t* bfp(size_t off) const { return (bf16_t*)(ws + off); }
};

__device__ __forceinline__ void tr_item(const float* W, int ldw, int col0, int K, bf16_t* WT, int row_off, LAS float* scr, int item, int nblk, int lane, const float* kscale) {
    const int kb = item / nblk, nb = item % nblk, k0 = 64 * kb, n0 = 32 * nb;
#pragma unroll 8
    for (int i = 0; i < 32; ++i) { const int kk = 2 * i + (lane >> 5); float x = W[(size_t)(k0 + kk) * ldw + col0 + n0 + (lane & 31)]; if (kscale) x *= kscale[k0 + kk]; scr[kk * 33 + (lane & 31)] = x; }
    asm volatile("s_waitcnt lgkmcnt(0)" ::: "memory");
    const int c = lane & 7;
#pragma unroll
    for (int j = 0; j < 4; ++j) { const int n = (lane >> 3) + 8 * j; const LAS float* sp = scr + (8 * c) * 33 + n;
        u32x4 o; o.x = pk2(sp[0 * 33], sp[1 * 33]); o.y = pk2(sp[2 * 33], sp[3 * 33]); o.z = pk2(sp[4 * 33], sp[5 * 33]); o.w = pk2(sp[6 * 33], sp[7 * 33]);
        *(u32x4*)(WT + (size_t)(row_off + n0 + n) * K + k0 + 8 * c) = o; }
    asm volatile("s_waitcnt lgkmcnt(0)" ::: "memory");
}
__device__ __forceinline__ void p_prep(const Ctx& C) {
    const float* c = C.in[1]; const float* w_ada = C.in[2]; const float* b_ada = C.in[3];
    float* mod = C.f32p(WS_MOD);
    LAS float* sc = (LAS float*)C.lds;
    LAS float* red = sc + 8192;
    for (int i = C.tid; i < 8192; i += NTHR) sc[i] = silu_f(c[i]);
    __syncthreads();
    for (int jb = C.bid; jb < 256; jb += C.G) {
        const int j0 = jb * 24, jl = C.tid % 24, kq = C.tid / 24;
        if (C.tid < 504) { float acc[8];
#pragma unroll
            for (int b = 0; b < 8; ++b) acc[b] = 0.f;
            for (int k = kq; k < 1024; k += 21) { const float w = w_ada[(size_t)k * 6144 + j0 + jl];
#pragma unroll
                for (int b = 0; b < 8; ++b) acc[b] += sc[b * 1024 + k] * w; }
#pragma unroll
            for (int b = 0; b < 8; ++b) red[(kq * 24 + jl) * 8 + b] = acc[b]; }
        __syncthreads();
        if (C.tid < 192) { const int jl2 = C.tid % 24, b2 = C.tid / 24; float sacc = b_ada[j0 + jl2];
            for (int kq2 = 0; kq2 < 21; ++kq2) sacc += red[(kq2 * 24 + jl2) * 8 + b2];
            mod[b2 * 6144 + j0 + jl2] = sacc; }
        __syncthreads();
    }
    LAS float* scr = (LAS float*)(C.lds + 65536 + C.wave * 8448);
    const int gw = C.bid * NWAVES + C.wave, NGW = C.G * NWAVES;
    const float* w_in = C.in[5];
    constexpr int I_A = 16 * 96, I_B = 16 * 96, I_G = 16 * 64, I_DT = 16, I_S = 16 * 32, I_PQ = 16 * 64;
    constexpr int NIT = I_A + I_B + I_G + I_DT + 3 * I_S + I_PQ;
    for (int it = gw; it < NIT; it += NGW) {
        int r = it;
        if (r < I_A) { tr_item(w_in, D_IN, 0, D, C.bfp(WS_WIN_T), 0, scr, r, 96, C.lane, nullptr); continue; } r -= I_A;
        if (r < I_B) { tr_item(w_in, D_IN, OFF_QKV, D, C.bfp(WS_WIN_T), 3072, scr, r, 96, C.lane, nullptr); continue; } r -= I_B;
        if (r < I_G) { tr_item(w_in, D_IN, OFF_GS, D, C.bfp(WS_WG_T), 0, scr, r, 64, C.lane, nullptr); continue; } r -= I_G;
        if (r < I_DT) { tr_item(w_in, D_IN, OFF_DTF, D, C.bfp(WS_WDT_T), 0, scr, r, 1, C.lane, nullptr); continue; } r -= I_DT;
        if (r < I_S) { tr_item(C.in[14], D, 0, D, C.bfp(WS_WSSD_T), 0, scr, r, 32, C.lane, C.in[13]); continue; } r -= I_S;
        if (r < I_S) { tr_item(C.in[16], D, 0, D, C.bfp(WS_WNA_T), 0, scr, r, 32, C.lane, nullptr); continue; } r -= I_S;
        if (r < I_S) { tr_item(C.in[17], D, 0, D, C.bfp(WS_WOUT_T), 0, scr, r, 32, C.lane, nullptr); continue; } r -= I_S;
        tr_item(C.in[19], 2048, 0, D, C.bfp(WS_WPQ_T), 0, scr, r, 64, C.lane, nullptr);
    }
    { const int gt = C.bid * NTHR + C.tid, NT = C.G * NTHR; const float* kf = C.in[20]; bf16_t* kb = C.bfp(WS_KEYS);
      for (int i = gt; i < 2 * 128 * 128; i += NT) kb[i] = (bf16_t)f2bf(kf[i]); }
    __syncthreads();
}

__device__ __forceinline__ void p_rownorm(const Ctx& C, const float* X, const float* gamma, int sh_off, int sc_off, bf16_t* dst) {
    const float* mod = C.f32p(WS_MOD);
    const int gw = C.bid * NWAVES + C.wave, NGW = C.G * NWAVES;
    for (int row = gw; row < T; row += NGW) {
        const int b = row / SEQ;
        const f32x4* xr = (const f32x4*)(X + (size_t)row * D) + C.lane;
        f32x4 v[4]; float s = 0.f;
#pragma unroll
        for (int j = 0; j < 4; ++j) { v[j] = xr[64 * j]; s += (v[j].x * v[j].x + v[j].y * v[j].y) + (v[j].z * v[j].z + v[j].w * v[j].w); }
        const float rstd = rsqrtf(wave_sum(s) * (1.f / D) + EPS);
        u32x2* o8 = (u32x2*)(dst + (size_t)row * D) + C.lane;
#pragma unroll
        for (int j = 0; j < 4; ++j) {
            const int col = 4 * C.lane + 256 * j;
            const f32x4 g = *(const f32x4*)(gamma + col), sh = *(const f32x4*)(mod + b * 6144 + sh_off + col), sc = *(const f32x4*)(mod + b * 6144 + sc_off + col);
            f32x4 y = v[j] * rstd * g * (sc + 1.f) + sh;
            u32x2 w; w.x = pk2(y.x, y.y); w.y = pk2(y.z, y.w); o8[64 * j] = w;
        }
    }
}

template <class Epi>
__device__ __forceinline__ void naive_gemm(const Ctx& C, const bf16_t* A, const bf16_t* Bt, int M, int N, int K, const Epi& E) {
    LAS float* As = (LAS float*)C.lds;
    LAS float* Bs = (LAS float*)(C.lds + 32 * 132 * 4);
    const int tilesN = (N + 63) / 64, tilesM = M / 128, ntiles = tilesM * tilesN;
    const int ty = C.tid >> 4, tx = C.tid & 15;
    for (int tile = C.bid; tile < ntiles; tile += C.G) {
        const int tm = tile / tilesN, tn = tile % tilesN, m0 = tm * 128, n0 = tn * 64;
        float acc[4][4];
#pragma unroll
        for (int i = 0; i < 4; ++i)
#pragma unroll
            for (int j = 0; j < 4; ++j) acc[i][j] = 0.f;
        for (int k0 = 0; k0 < K; k0 += 32) {
            __syncthreads();
            {
                const int r = C.tid >> 2, kc = (C.tid & 3) * 8;
                const u32x4 v = *(const u32x4*)(A + (size_t)(m0 + r) * K + k0 + kc);
                As[(kc + 0) * 132 + r] = bflo(v.x); As[(kc + 1) * 132 + r] = bfhi(v.x); As[(kc + 2) * 132 + r] = bflo(v.y); As[(kc + 3) * 132 + r] = bfhi(v.y);
                As[(kc + 4) * 132 + r] = bflo(v.z); As[(kc + 5) * 132 + r] = bfhi(v.z); As[(kc + 6) * 132 + r] = bflo(v.w); As[(kc + 7) * 132 + r] = bfhi(v.w);
            }
            if (C.tid < 256) {
                const int r = C.tid >> 2, kc = (C.tid & 3) * 8;
                u32x4 v = (u32x4){0u, 0u, 0u, 0u};
                if (n0 + r < N) v = *(const u32x4*)(Bt + (size_t)(n0 + r) * K + k0 + kc);
                Bs[(kc + 0) * 68 + r] = bflo(v.x); Bs[(kc + 1) * 68 + r] = bfhi(v.x); Bs[(kc + 2) * 68 + r] = bflo(v.y); Bs[(kc + 3) * 68 + r] = bfhi(v.y);
                Bs[(kc + 4) * 68 + r] = bflo(v.z); Bs[(kc + 5) * 68 + r] = bfhi(v.z); Bs[(kc + 6) * 68 + r] = bflo(v.w); Bs[(kc + 7) * 68 + r] = bfhi(v.w);
            }
            __syncthreads();
#pragma unroll 8
            for (int k = 0; k < 32; ++k) {
                const f32x4 a = *(const LAS f32x4*)(As + k * 132 + ty * 4);
                const f32x4 b = *(const LAS f32x4*)(Bs + k * 68 + tx * 4);
#pragma unroll
                for (int i = 0; i < 4; ++i)
#pragma unroll
                    for (int j = 0; j < 4; ++j) acc[i][j] += a[i] * b[j];
            }
        }
#pragma unroll
        for (int i = 0; i < 4; ++i)
#pragma unroll
            for (int j = 0; j < 4; ++j) { const int col = n0 + tx * 4 + j; if (col < N) E(m0 + ty * 4 + i, col, acc[i][j]); }
    }
    __syncthreads();
}

struct EInProj { bf16_t *sz, *xbc, *q, *k, *v;
    __device__ __forceinline__ void operator()(int r, int c, float x) const {
        if (c < 1024) sz[(size_t)r * 1024 + c] = (bf16_t)f2bf(silu_f(x));
        else if (c < 3072) xbc[(size_t)r * 2048 + (c - 1024)] = (bf16_t)f2bf(x);
        else if (c < 4096) q[(size_t)r * 1024 + (c - 3072)] = (bf16_t)f2bf(x * 0.125f);
        else if (c < 5120) k[(size_t)r * 1024 + (c - 4096)] = (bf16_t)f2bf(x);
        else v[(size_t)r * 1024 + (c - 5120)] = (bf16_t)f2bf(x);
    } };
struct EDt { float* dt; const float *bf, *bb;
    __device__ __forceinline__ void operator()(int r, int c, float x) const { const float bias = c < 16 ? bf[c] : bb[c - 16]; dt[(size_t)r * 32 + c] = softplus_f(x + bias); } };
struct EGate { bf16_t* sg;
    __device__ __forceinline__ void operator()(int r, int c, float x) const { sg[(size_t)(c >> 10) * T * 1024 + (size_t)r * 1024 + (c & 1023)] = (bf16_t)f2bf(sigmoid_f(x)); } };
struct ED1 { bf16_t* p1; const bf16_t* sg1; const float* rstd;
    __device__ __forceinline__ void operator()(int r, int c, float x) const { const size_t i = (size_t)r * 1024 + c; p1[i] = (bf16_t)f2bf(x * rstd[r] * bf2f(sg1[i])); } };
struct ED2 { bf16_t* mixed; const bf16_t *p1, *sg2;
    __device__ __forceinline__ void operator()(int r, int c, float x) const { const size_t i = (size_t)r * 1024 + c; mixed[i] = (bf16_t)f2bf(bf2f(p1[i]) + bf2f(sg2[i]) * x); } };
struct ED3 { float* h; const float* x; const float* mod;
    __device__ __forceinline__ void operator()(int r, int c, float v) const { const size_t i = (size_t)r * 1024 + c; h[i] = x[i] + mod[(r / SEQ) * 6144 + 2048 + c] * v; } };
struct EQp { bf16_t* qp;
    __device__ __forceinline__ void operator()(int r, int c, float v) const { qp[(size_t)r * 2048 + c] = (bf16_t)f2bf(v); } };


__device__ __forceinline__ void p_dt(const Ctx& C, const bf16_t* n1, const bf16_t* wdt, float* dt) {
    typedef short bf16x8 __attribute__((ext_vector_type(8)));
    const float* bf = C.in[8]; const float* bb = C.in[9];
    const int gw = C.bid * NWAVES + C.wave, NGW = C.G * NWAVES, lane = C.lane, g = lane >> 4, i16 = lane & 15;
    for (int tile = gw; tile < T / 16; tile += NGW) {
        const size_t t0 = (size_t)tile * 16;
        f32x4 a0 = (f32x4){0.f, 0.f, 0.f, 0.f}, a1 = a0;
#pragma unroll 8
        for (int ks = 0; ks < 32; ++ks) {
            const bf16x8 av = *(const bf16x8*)(n1 + (t0 + i16) * 1024 + ks * 32 + g * 8);
            const bf16x8 b0 = *(const bf16x8*)(wdt + (size_t)i16 * 1024 + ks * 32 + g * 8), b1 = *(const bf16x8*)(wdt + (size_t)(16 + i16) * 1024 + ks * 32 + g * 8);
            a0 = __builtin_amdgcn_mfma_f32_16x16x32_bf16(av, b0, a0, 0, 0, 0); a1 = __builtin_amdgcn_mfma_f32_16x16x32_bf16(av, b1, a1, 0, 0, 0); }
        const float bias0 = bf[i16], bias1 = bb[i16];
#pragma unroll
        for (int r = 0; r < 4; ++r) { dt[(t0 + 4 * g + r) * 32 + i16] = softplus_f(a0[r] + bias0); dt[(t0 + 4 * g + r) * 32 + 16 + i16] = softplus_f(a1[r] + bias1); }
    }
}

__device__ __forceinline__ void p_conv(const Ctx& C, const bf16_t* xbc, bf16_t* xc) {
    const float* cw = C.in[6]; const float* cb = C.in[7];
    const int gt = C.bid * NTHR + C.tid, NT = C.G * NTHR;
    for (int i = gt; i < (T / 8) * 256; i += NT) {
        const int cg = i & 255, run = i >> 8, t0 = run * 8, l0 = t0 & (SEQ - 1), ch = cg * 8;
        float w[5][8], acc[8][8];
#pragma unroll
        for (int j = 0; j < 5; ++j) { const f32x4 w0 = *(const f32x4*)(cw + j * 2048 + ch), w1 = *(const f32x4*)(cw + j * 2048 + ch + 4);
            w[j][0] = w0.x; w[j][1] = w0.y; w[j][2] = w0.z; w[j][3] = w0.w; w[j][4] = w1.x; w[j][5] = w1.y; w[j][6] = w1.z; w[j][7] = w1.w; }
        { const f32x4 b0 = *(const f32x4*)(cb + ch), b1 = *(const f32x4*)(cb + ch + 4);
#pragma unroll
          for (int o = 0; o < 8; ++o) { acc[o][0] = b0.x; acc[o][1] = b0.y; acc[o][2] = b0.z; acc[o][3] = b0.w; acc[o][4] = b1.x; acc[o][5] = b1.y; acc[o][6] = b1.z; acc[o][7] = b1.w; } }
        u32x4 rw[12];
#pragma unroll
        for (int rr = 0; rr < 12; ++rr) { const int ll = l0 + rr - 2; rw[rr] = (u32x4){0u, 0u, 0u, 0u};
            if (ll >= 0 && ll < SEQ) rw[rr] = *(const u32x4*)(xbc + (size_t)(t0 + rr - 2) * 2048 + ch); }
#pragma unroll
        for (int rr = 0; rr < 12; ++rr) {
            const float x[8] = {bflo(rw[rr].x), bfhi(rw[rr].x), bflo(rw[rr].y), bfhi(rw[rr].y), bflo(rw[rr].z), bfhi(rw[rr].z), bflo(rw[rr].w), bfhi(rw[rr].w)};
#pragma unroll
            for (int j = 0; j < 5; ++j) { const int o = rr - j; if (o >= 0 && o < 8) {
#pragma unroll
                for (int q = 0; q < 8; ++q) acc[o][q] += w[j][q] * x[q]; } }
        }
#pragma unroll
        for (int o = 0; o < 8; ++o) { u32x4 ov; ov.x = pk2(silu_f(acc[o][0]), silu_f(acc[o][1])); ov.y = pk2(silu_f(acc[o][2]), silu_f(acc[o][3])); ov.z = pk2(silu_f(acc[o][4]), silu_f(acc[o][5])); ov.w = pk2(silu_f(acc[o][6]), silu_f(acc[o][7]));
            *(u32x4*)(xc + (size_t)(t0 + o) * 2048 + ch) = ov; }
    }
}

__device__ __forceinline__ void p_ssd_naive(const Ctx& C, const bf16_t* xc, const float* dtb, bf16_t* yf, bf16_t* yb) {
    if (C.wave == 0)
    for (int unit = C.bid; unit < 256; unit += C.G) {
        const int dir = unit & 1, hd = (unit >> 1) & 15, b = unit >> 5, g = hd >> 2, p = C.lane;
        const float a = -__expf((dir ? C.in[11] : C.in[10])[hd]);
        const float dsk = C.in[12][hd];
        float h[128];
#pragma unroll
        for (int n = 0; n < 128; ++n) h[n] = 0.f;
        for (int s = 0; s < SEQ; ++s) {
#ifdef DIAG_LOCAL
            if ((s & 127) == 0) {
#pragma unroll
                for (int n = 0; n < 128; ++n) h[n] = 0.f; }
#endif
            const int t = dir ? (SEQ - 1 - s) : s; const size_t row = (size_t)b * SEQ + t;
            const float dt = dtb[row * 32 + dir * 16 + hd];
            const float dA = __expf(dt * a);
            const float x = bf2f(xc[row * 2048 + hd * 64 + p]);
            const float xdt = x * dt;
            const u32x4* Bp = (const u32x4*)(xc + row * 2048 + 1024 + g * 128);
            const u32x4* Cp = (const u32x4*)(xc + row * 2048 + 1536 + g * 128);
            float y = 0.f;
#pragma unroll
            for (int n8 = 0; n8 < 16; ++n8) {
                const u32x4 bv = Bp[n8], cv = Cp[n8];
                const float bb[8] = {bflo(bv.x), bfhi(bv.x), bflo(bv.y), bfhi(bv.y), bflo(bv.z), bfhi(bv.z), bflo(bv.w), bfhi(bv.w)};
                const float cc[8] = {bflo(cv.x), bfhi(cv.x), bflo(cv.y), bfhi(cv.y), bflo(cv.z), bfhi(cv.z), bflo(cv.w), bfhi(cv.w)};
#pragma unroll
                for (int q = 0; q < 8; ++q) { const int n = n8 * 8 + q; h[n] = dA * h[n] + xdt * bb[q]; y += cc[q] * h[n]; }
            }
            if (dir == 0) yf[row * 1024 + hd * 64 + p] = (bf16_t)f2bf(y + dsk * x);
            else yb[row * 1024 + hd * 64 + p] = (bf16_t)f2bf(y);
        }
    }
}


namespace ssd {
typedef short bf16x8 __attribute__((ext_vector_type(8)));
typedef short s16x4 __attribute__((ext_vector_type(4)));
constexpr int RS = 272, RSX = 144;
constexpr int CN = 0, BN = 34816, BS = 69632, SL = 104448, XN = 121856, CSB = 140288;
__device__ __forceinline__ bf16x8 trfrag(LAS unsigned char* base, int stride, int ks, int c, int g, int q, int pp) {
    LAS unsigned char* a0 = base + (32 * ks + 8 * g + q) * stride + 32 * c + 8 * pp;
    const s16x4 v0 = __builtin_amdgcn_ds_read_tr16_b64_v4i16((LAS s16x4*)a0);
    const s16x4 v1 = __builtin_amdgcn_ds_read_tr16_b64_v4i16((LAS s16x4*)(a0 + 4 * stride));
    bf16x8 r; r[0] = v0[0]; r[1] = v0[1]; r[2] = v0[2]; r[3] = v0[3]; r[4] = v1[0]; r[5] = v1[1]; r[6] = v1[2]; r[7] = v1[3]; return r;
}
__device__ __forceinline__ unsigned pkbf(float lo, float hi) { return pk2(lo, hi); }
}
__device__ __forceinline__ void p_ssd(const Ctx& C, const bf16_t* xc, const float* dtb, bf16_t* yf, bf16_t* yb) {
    using namespace ssd;
    LAS unsigned char* L = C.lds;
    const int tid = C.tid, lane = C.lane, w = C.wave, g = lane >> 4, i16 = lane & 15, q = (lane >> 2) & 3, pp = lane & 3;
    for (int unit = C.bid; unit < 256; unit += C.G) {
        const int dir = unit & 1, hd = (unit >> 1) & 15, b = unit >> 5, grp = hd >> 2;
        const float a = -__expf((dir ? C.in[11] : C.in[10])[hd]);
        const float dsk = dir ? 0.f : C.in[12][hd];
        bf16_t* yout = dir ? yb : yf;
        f32x4 sacc[4];
#pragma unroll
        for (int pt = 0; pt < 4; ++pt) sacc[pt] = (f32x4){0.f, 0.f, 0.f, 0.f};
        __syncthreads();
        for (int i = tid; i < 17408 / 4; i += NTHR) ((LAS unsigned*)(L + SL))[i] = 0u;
        u32x4 pfC[4], pfB[4], pfX[2]; float pfd0 = 0.f, pfd1 = 0.f;
#define SSD_ISSUE(ci_) do { const int c_ = dir ? (31 - (ci_)) : (ci_); const size_t t0_ = (size_t)b * SEQ + (size_t)c_ * 128; \
            _Pragma("unroll") for (int i_ = 0; i_ < 4; ++i_) { const int idx_ = tid + NTHR * i_, l_ = idx_ >> 4, cc_ = idx_ & 15; const bf16_t* rp_ = xc + (t0_ + l_) * 2048 + grp * 128 + cc_ * 8; \
                pfB[i_] = *(const u32x4*)(rp_ + 1024); pfC[i_] = *(const u32x4*)(rp_ + 1536); } \
            _Pragma("unroll") for (int i_ = 0; i_ < 2; ++i_) { const int idx_ = tid + NTHR * i_, l_ = idx_ >> 3, cc_ = idx_ & 7; pfX[i_] = *(const u32x4*)(xc + (t0_ + l_) * 2048 + hd * 64 + cc_ * 8); } \
            if (w == 0) { const int l0_ = dir ? (127 - 2 * lane) : (2 * lane), l1_ = dir ? (126 - 2 * lane) : (2 * lane + 1); \
                pfd0 = dtb[(t0_ + l0_) * 32 + dir * 16 + hd]; pfd1 = dtb[(t0_ + l1_) * 32 + dir * 16 + hd]; } } while (0)
#define SSD_SCAN(buf_) do { if (w == 0) { const float da0_ = pfd0 * a, da1_ = pfd1 * a; const float p1_ = da0_ + da1_; float s_ = p1_; \
            _Pragma("unroll") for (int o_ = 1; o_ < 64; o_ <<= 1) { const float t_ = __shfl_up(s_, o_); if (lane >= o_) s_ += t_; } \
            const float ex_ = s_ - p1_, cs0_ = ex_ + da0_, cs1_ = ex_ + p1_, tot_ = __shfl(s_, 63); \
            const int l0_ = dir ? (127 - 2 * lane) : (2 * lane), l1_ = dir ? (126 - 2 * lane) : (2 * lane + 1); \
            LAS float* cb_ = (LAS float*)(L + CSB + (buf_) * 1536); \
            cb_[l0_] = cs0_; cb_[l1_] = cs1_; cb_[128 + l0_] = pfd0; cb_[128 + l1_] = pfd1; cb_[256 + l0_] = pfd0 * __expf(tot_ - cs0_); cb_[256 + l1_] = pfd1 * __expf(tot_ - cs1_); \
            if (lane == 0) *(LAS float*)(L + CSB + 3072 + 8 * (buf_)) = tot_; } } while (0)
#define SSD_WRITE(buf_) do { const LAS float* dw_ = (const LAS float*)(L + CSB + (buf_) * 1536 + 1024); \
            _Pragma("unroll") for (int i_ = 0; i_ < 4; ++i_) { const int idx_ = tid + NTHR * i_, l_ = idx_ >> 4, cc_ = idx_ & 15; \
                *(LAS u32x4*)(L + CN + l_ * RS + cc_ * 16) = pfC[i_]; *(LAS u32x4*)(L + BN + l_ * RS + cc_ * 16) = pfB[i_]; \
                const float sc_ = dw_[l_]; const u32x4 v_ = pfB[i_]; u32x4 o_; \
                o_.x = pkbf(bflo(v_.x) * sc_, bfhi(v_.x) * sc_); o_.y = pkbf(bflo(v_.y) * sc_, bfhi(v_.y) * sc_); o_.z = pkbf(bflo(v_.z) * sc_, bfhi(v_.z) * sc_); o_.w = pkbf(bflo(v_.w) * sc_, bfhi(v_.w) * sc_); \
                *(LAS u32x4*)(L + BS + l_ * RS + cc_ * 16) = o_; } \
            _Pragma("unroll") for (int i_ = 0; i_ < 2; ++i_) { const int idx_ = tid + NTHR * i_, l_ = idx_ >> 3, cc_ = idx_ & 7; *(LAS u32x4*)(L + XN + l_ * RSX + cc_ * 16) = pfX[i_]; } } while (0)
        SSD_ISSUE(0);
        SSD_SCAN(0);
        __syncthreads();
        SSD_WRITE(0);
        __syncthreads();
        for (int ci = 0; ci < 32; ++ci) {
            const int buf = ci & 1;
            const int c = dir ? (31 - ci) : ci; const size_t t0 = (size_t)b * SEQ + (size_t)c * 128;
            if (ci + 1 < 32) SSD_ISSUE(ci + 1);
            const LAS float* csb = (const LAS float*)(L + CSB + buf * 1536);
            const float cs_l = csb[16 * w + i16];
            const float cs_end = *(const LAS float*)(L + CSB + 3072 + 8 * buf);
            bf16x8 cfrag[4];
#pragma unroll
            for (int ks = 0; ks < 4; ++ks) cfrag[ks] = *(const LAS bf16x8*)(L + CN + (16 * w + i16) * RS + ks * 64 + g * 16);
            u32x2 mreg[8];
            const int lrow = 16 * w + i16;
#pragma unroll
            for (int st = 0; st < 8; ++st) {
                f32x4 acc = (f32x4){0.f, 0.f, 0.f, 0.f};
#pragma unroll
                for (int ks = 0; ks < 4; ++ks) { const bf16x8 af = *(const LAS bf16x8*)(L + BN + (16 * st + i16) * RS + ks * 64 + g * 16);
                    acc = __builtin_amdgcn_mfma_f32_16x16x32_bf16(af, cfrag[ks], acc, 0, 0, 0); }
                const f32x4 cs_s = *(const LAS f32x4*)(csb + 16 * st + 4 * g), dt_s = *(const LAS f32x4*)(csb + 128 + 16 * st + 4 * g);
                float mv[4];
#pragma unroll
                for (int r = 0; r < 4; ++r) { const int srow = 16 * st + 4 * g + r; const bool valid = dir ? (srow >= lrow) : (srow <= lrow);
                    const float e = valid ? __expf(cs_l - cs_s[r]) : 0.f; mv[r] = acc[r] * dt_s[r] * e; }
                mreg[st].x = pkbf(mv[0], mv[1]); mreg[st].y = pkbf(mv[2], mv[3]);
            }
            f32x4 yacc[4];
            const float el = __expf(cs_l);
#pragma unroll
            for (int pt = 0; pt < 4; ++pt) { f32x4 acc = (f32x4){0.f, 0.f, 0.f, 0.f};
#pragma unroll
                for (int ks = 0; ks < 4; ++ks) { const bf16x8 af = *(const LAS bf16x8*)(L + SL + (16 * pt + i16) * RS + ks * 64 + g * 16);
                    acc = __builtin_amdgcn_mfma_f32_16x16x32_bf16(af, cfrag[ks], acc, 0, 0, 0); }
                yacc[pt] = acc * el; }
            __syncthreads();
#pragma unroll
            for (int st = 0; st < 8; ++st) *(LAS u32x2*)(L + BN + lrow * RS + 32 * st + 8 * g) = mreg[st];
            __syncthreads();
#pragma unroll
            for (int ks = 0; ks < 4; ++ks) { const bf16x8 mf = *(const LAS bf16x8*)(L + BN + lrow * RS + ks * 64 + g * 16);
#pragma unroll
                for (int pt = 0; pt < 4; ++pt) { const bf16x8 xf = trfrag(L + XN, RSX, ks, pt, g, q, pp); yacc[pt] = __builtin_amdgcn_mfma_f32_16x16x32_bf16(xf, mf, yacc[pt], 0, 0, 0); } }
#pragma unroll
            for (int pt = 0; pt < 4; ++pt) { const u32x2 xv = *(const LAS u32x2*)(L + XN + lrow * RSX + (16 * pt + 4 * g) * 2);
                u32x2 o; o.x = pkbf(yacc[pt][0] + dsk * bflo(xv.x), yacc[pt][1] + dsk * bfhi(xv.x)); o.y = pkbf(yacc[pt][2] + dsk * bflo(xv.y), yacc[pt][3] + dsk * bfhi(xv.y));
                *(u32x2*)(yout + (t0 + lrow) * 1024 + hd * 64 + 16 * pt + 4 * g) = o; }
            { const float dec = __expf(cs_end);
#pragma unroll
              for (int pt = 0; pt < 4; ++pt) sacc[pt] = sacc[pt] * dec; }
#pragma unroll
            for (int ks = 0; ks < 4; ++ks) { const bf16x8 bf = trfrag(L + BS, RS, ks, w, g, q, pp);
#pragma unroll
                for (int pt = 0; pt < 4; ++pt) { const bf16x8 xf = trfrag(L + XN, RSX, ks, pt, g, q, pp); sacc[pt] = __builtin_amdgcn_mfma_f32_16x16x32_bf16(bf, xf, sacc[pt], 0, 0, 0); } }
#ifdef DIAG_LOCAL
#pragma unroll
            for (int pt = 0; pt < 4; ++pt) sacc[pt] = (f32x4){0.f, 0.f, 0.f, 0.f};
#endif
#pragma unroll
            for (int pt = 0; pt < 4; ++pt) { u32x2 o; o.x = pkbf(sacc[pt][0], sacc[pt][1]); o.y = pkbf(sacc[pt][2], sacc[pt][3]);
                *(LAS u32x2*)(L + SL + (16 * pt + i16) * RS + (16 * w + 4 * g) * 2) = o; }
            if (ci + 1 < 32) SSD_SCAN(buf ^ 1);
            __syncthreads();
            if (ci + 1 < 32) SSD_WRITE(buf ^ 1);
            __syncthreads();
        }
#undef SSD_ISSUE
#undef SSD_SCAN
#undef SSD_WRITE
    }
}

__device__ __forceinline__ void p_na_naive(const Ctx& C, bf16_t* q, const bf16_t* k, const bf16_t* v) {
    const float* rpb = C.in[15];
    const int gt = C.bid * NTHR + C.tid, NT = C.G * NTHR;
    for (int i = gt; i < T * 16; i += NT) {
        const int hh = i & 15, tok = i >> 4, b = tok >> 12, l = tok & 4095, r = l >> 6, col = l & 63;
        int rs = r - 4; rs = rs < 0 ? 0 : (rs > 56 ? 56 : rs);
        int wsx = col - 8; wsx = wsx < 0 ? 0 : (wsx > 48 ? 48 : wsx);
        float qv[64], o[64];
        {
            const u32x4* qp = (const u32x4*)(q + (size_t)tok * 1024 + hh * 64);
#pragma unroll
            for (int d8 = 0; d8 < 8; ++d8) { const u32x4 w = qp[d8]; qv[d8 * 8 + 0] = bflo(w.x); qv[d8 * 8 + 1] = bfhi(w.x); qv[d8 * 8 + 2] = bflo(w.y); qv[d8 * 8 + 3] = bfhi(w.y);
                qv[d8 * 8 + 4] = bflo(w.z); qv[d8 * 8 + 5] = bfhi(w.z); qv[d8 * 8 + 6] = bflo(w.w); qv[d8 * 8 + 7] = bfhi(w.w); }
        }
#pragma unroll
        for (int d = 0; d < 64; ++d) o[d] = 0.f;
        float m = -1e30f, lsum = 0.f;
        for (int ii = 0; ii < 8; ++ii)
            for (int jj = 0; jj < 16; ++jj) {
                const int kr = rs + ii, kc = wsx + jj; const size_t kt = (size_t)b * SEQ + kr * 64 + kc;
                const u32x4* kp = (const u32x4*)(k + kt * 1024 + hh * 64);
                float s = 0.f;
#pragma unroll
                for (int d8 = 0; d8 < 8; ++d8) { const u32x4 w = kp[d8];
                    s += qv[d8 * 8 + 0] * bflo(w.x) + qv[d8 * 8 + 1] * bfhi(w.x) + qv[d8 * 8 + 2] * bflo(w.y) + qv[d8 * 8 + 3] * bfhi(w.y)
                       + qv[d8 * 8 + 4] * bflo(w.z) + qv[d8 * 8 + 5] * bfhi(w.z) + qv[d8 * 8 + 6] * bflo(w.w) + qv[d8 * 8 + 7] * bfhi(w.w); }
                s += rpb[hh * 15 * 31 + (kr - r + 7) * 31 + (kc - col + 15)];
                const float mn = fmaxf(m, s), al = __expf(m - mn), pe = __expf(s - mn);
                lsum = lsum * al + pe; m = mn;
                const u32x4* vp = (const u32x4*)(v + kt * 1024 + hh * 64);
#pragma unroll
                for (int d8 = 0; d8 < 8; ++d8) { const u32x4 w = vp[d8];
                    o[d8 * 8 + 0] = o[d8 * 8 + 0] * al + pe * bflo(w.x); o[d8 * 8 + 1] = o[d8 * 8 + 1] * al + pe * bfhi(w.x);
                    o[d8 * 8 + 2] = o[d8 * 8 + 2] * al + pe * bflo(w.y); o[d8 * 8 + 3] = o[d8 * 8 + 3] * al + pe * bfhi(w.y);
                    o[d8 * 8 + 4] = o[d8 * 8 + 4] * al + pe * bflo(w.z); o[d8 * 8 + 5] = o[d8 * 8 + 5] * al + pe * bfhi(w.z);
                    o[d8 * 8 + 6] = o[d8 * 8 + 6] * al + pe * bflo(w.w); o[d8 * 8 + 7] = o[d8 * 8 + 7] * al + pe * bfhi(w.w); }
            }
        const float inv = 1.f / lsum;
        u32x4* op = (u32x4*)(q + (size_t)tok * 1024 + hh * 64);
#pragma unroll
        for (int d8 = 0; d8 < 8; ++d8) { u32x4 w; w.x = pk2(o[d8 * 8 + 0] * inv, o[d8 * 8 + 1] * inv); w.y = pk2(o[d8 * 8 + 2] * inv, o[d8 * 8 + 3] * inv);
            w.z = pk2(o[d8 * 8 + 4] * inv, o[d8 * 8 + 5] * inv); w.w = pk2(o[d8 * 8 + 6] * inv, o[d8 * 8 + 7] * inv); op[d8] = w; }
    }
}


namespace nat {
typedef short bf16x8 __attribute__((ext_vector_type(8)));
typedef short s16x4 __attribute__((ext_vector_type(4)));
constexpr int VH = 65536, RPB = 131072;
__device__ __forceinline__ int voff(int ks, int d) { return ks * 128 + ((((d >> 3) ^ (ks & 7))) << 4) + (d & 7) * 2; }
__device__ __forceinline__ int clampi(int x, int lo, int hi) { return x < lo ? lo : (x > hi ? hi : x); }
}
__device__ __forceinline__ void p_na(const Ctx& C, bf16_t* q, const bf16_t* k, const bf16_t* v) {
    using namespace nat;
    LAS unsigned char* L = C.lds;
    const float* rpb = C.in[15];
    const int tid = C.tid, lane = C.lane, w = C.wave, g = lane >> 4, i16 = lane & 15, qq = (lane >> 2) & 3, pp = lane & 3;
    const int hl = w >> 2, m = w & 3;
    const int bs = (m == 0) ? 0 : (m == 1) ? 8 : (m == 2) ? 24 : 32;
    const int qc = 16 * m + i16, wsx = clampi(qc - 8, 0, 48);
    unsigned vmask = 0u; int dcol[8];
#pragma unroll
    for (int c = 0; c < 8; ++c) { const int kc = bs + (c >> 2) * 16 + 4 * g + (c & 3); if (kc >= wsx && kc < wsx + 16) vmask |= (1u << c); dcol[c] = clampi(kc - qc + 15, 0, 30); }
    for (int unit = C.bid; unit < 256; unit += C.G) {
        const int rseg = unit & 3, hp = (unit >> 2) & 7, b = unit >> 5, h = 2 * hp + hl;
        __syncthreads();
        for (int i = tid; i < 930; i += NTHR) ((LAS float*)(L + RPB))[i] = rpb[(2 * hp) * 465 + i];
#define NA_LOAD_ROW(row_) do { _Pragma("unroll") for (int i_ = 0; i_ < 2; ++i_) { const int idx_ = tid + NTHR * i_, hl_ = idx_ >> 9, col_ = (idx_ >> 3) & 63, dch_ = idx_ & 7; \
            const u32x4 val_ = *(const u32x4*)(v + ((size_t)b * SEQ + (size_t)(row_) * 64 + col_) * 1024 + (2 * hp + hl_) * 64 + dch_ * 8); \
            *(LAS u32x4*)(L + hl_ * VH + voff(((row_) & 7) * 64 + col_, dch_ * 8)) = val_; } } while (0)
        const int r0 = 16 * rseg; int rs_prev = clampi(r0 - 4, 0, 56);
        for (int rr = 0; rr < 8; ++rr) NA_LOAD_ROW(rs_prev + rr);
        __syncthreads();
        const LAS float* rpbl = (const LAS float*)(L + RPB) + hl * 465;
        for (int s = 0; s < 16; ++s) {
            const int r = r0 + s, rs = clampi(r - 4, 0, 56);
            if (rs != rs_prev) { __syncthreads(); NA_LOAD_ROW(rs + 7); __syncthreads(); rs_prev = rs; }
            const size_t tokq = (size_t)b * SEQ + (size_t)r * 64 + qc;
            bf16x8 qf[2];
#pragma unroll
            for (int ks = 0; ks < 2; ++ks) qf[ks] = *(const bf16x8*)(q + tokq * 1024 + h * 64 + ks * 32 + g * 8);
            f32x4 sc[16];
#pragma unroll
            for (int kt = 0; kt < 16; ++kt) { const size_t tokk = (size_t)b * SEQ + (size_t)(rs + (kt >> 1)) * 64 + bs + (kt & 1) * 16 + i16;
                f32x4 acc = (f32x4){0.f, 0.f, 0.f, 0.f};
#pragma unroll
                for (int ks = 0; ks < 2; ++ks) { const bf16x8 kf = *(const bf16x8*)(k + tokk * 1024 + h * 64 + ks * 32 + g * 8); acc = __builtin_amdgcn_mfma_f32_16x16x32_bf16(kf, qf[ks], acc, 0, 0, 0); }
                sc[kt] = acc; }
            float mx = -1.0e30f;
#pragma unroll
            for (int kt = 0; kt < 16; ++kt) { const int drow = rs + (kt >> 1) - r + 7;
#pragma unroll
                for (int e = 0; e < 4; ++e) { const int c = (kt & 1) * 4 + e; const float bias = rpbl[drow * 31 + dcol[c]];
                    const float val = ((vmask >> c) & 1u) ? sc[kt][e] + bias : -1.0e30f; sc[kt][e] = val; mx = fmaxf(mx, val); } }
            mx = fmaxf(mx, __shfl_xor(mx, 16)); mx = fmaxf(mx, __shfl_xor(mx, 32));
            float sum = 0.f;
#pragma unroll
            for (int kt = 0; kt < 16; ++kt)
#pragma unroll
                for (int e = 0; e < 4; ++e) { const float p = __expf(sc[kt][e] - mx); sc[kt][e] = p; sum += p; }
            sum += __shfl_xor(sum, 16); sum += __shfl_xor(sum, 32);
            f32x4 o[4];
#pragma unroll
            for (int dt = 0; dt < 4; ++dt) o[dt] = (f32x4){0.f, 0.f, 0.f, 0.f};
#pragma unroll
            for (int kk = 0; kk < 8; ++kk) {
                u32x4 pw; pw.x = pk2(sc[2 * kk][0], sc[2 * kk][1]); pw.y = pk2(sc[2 * kk][2], sc[2 * kk][3]); pw.z = pk2(sc[2 * kk + 1][0], sc[2 * kk + 1][1]); pw.w = pk2(sc[2 * kk + 1][2], sc[2 * kk + 1][3]);
                const bf16x8 pf = __builtin_bit_cast(bf16x8, pw);
                const int ks0 = ((rs + kk) & 7) * 64 + bs + 4 * g + qq, ks1 = ks0 + 16;
#pragma unroll
                for (int dt = 0; dt < 4; ++dt) {
                    const s16x4 v0 = __builtin_amdgcn_ds_read_tr16_b64_v4i16((LAS s16x4*)(L + hl * VH + voff(ks0, 16 * dt + 4 * pp)));
                    const s16x4 v1 = __builtin_amdgcn_ds_read_tr16_b64_v4i16((LAS s16x4*)(L + hl * VH + voff(ks1, 16 * dt + 4 * pp)));
                    bf16x8 vf; vf[0] = v0[0]; vf[1] = v0[1]; vf[2] = v0[2]; vf[3] = v0[3]; vf[4] = v1[0]; vf[5] = v1[1]; vf[6] = v1[2]; vf[7] = v1[3];
                    o[dt] = __builtin_amdgcn_mfma_f32_16x16x32_bf16(vf, pf, o[dt], 0, 0, 0); }
            }
            const float inv = 1.f / sum;
#pragma unroll
            for (int dt = 0; dt < 4; ++dt) { u32x2 ov; ov.x = pk2(o[dt][0] * inv, o[dt][1] * inv); ov.y = pk2(o[dt][2] * inv, o[dt][3] * inv);
                *(u32x2*)(q + tokq * 1024 + h * 64 + 16 * dt + 4 * g) = ov; }
        }
#undef NA_LOAD_ROW
    }
    __syncthreads();
}

__device__ __forceinline__ void p_combine(const Ctx& C, const bf16_t* yf, const bf16_t* yb, bf16_t* szu, float* rstd) {
    const int gw = C.bid * NWAVES + C.wave, NGW = C.G * NWAVES;
    for (int row = gw; row < T; row += NGW) {
        const size_t base = (size_t)row * 1024;
        float s = 0.f; u32x4 outv[2];
#pragma unroll
        for (int j = 0; j < 2; ++j) {
            const size_t off = base + j * 512 + C.lane * 8;
            const u32x4 a = *(const u32x4*)(yf + off), b = *(const u32x4*)(yb + off), z = *(const u32x4*)(szu + off);
            float u[8];
            u[0] = (bflo(a.x) + bflo(b.x)) * bflo(z.x); u[1] = (bfhi(a.x) + bfhi(b.x)) * bfhi(z.x);
            u[2] = (bflo(a.y) + bflo(b.y)) * bflo(z.y); u[3] = (bfhi(a.y) + bfhi(b.y)) * bfhi(z.y);
            u[4] = (bflo(a.z) + bflo(b.z)) * bflo(z.z); u[5] = (bfhi(a.z) + bfhi(b.z)) * bfhi(z.z);
            u[6] = (bflo(a.w) + bflo(b.w)) * bflo(z.w); u[7] = (bfhi(a.w) + bfhi(b.w)) * bfhi(z.w);
#pragma unroll
            for (int q = 0; q < 8; ++q) s += u[q] * u[q];
            outv[j].x = pk2(u[0], u[1]); outv[j].y = pk2(u[2], u[3]); outv[j].z = pk2(u[4], u[5]); outv[j].w = pk2(u[6], u[7]);
        }
        s = wave_sum(s);
#pragma unroll
        for (int j = 0; j < 2; ++j) *(u32x4*)(szu + base + j * 512 + C.lane * 8) = outv[j];
        if (C.lane == 0) rstd[row] = rsqrtf(s * (1.f / 1024.f) + EPS);
    }
}

__device__ __forceinline__ void p_cvt_tables(const Ctx& C, bf16_t* ub, bf16_t* vb) {
    const int gt = C.bid * NTHR + C.tid, NT = C.G * NTHR;
    const float* u = C.in[21]; const float* v = C.in[22];
    for (int i = gt; i < 16384 * 1024 / 8; i += NT) {
        const f32x4 a0 = *(const f32x4*)(u + (size_t)i * 8), a1 = *(const f32x4*)(u + (size_t)i * 8 + 4);
        u32x4 o; o.x = pk2(a0.x, a0.y); o.y = pk2(a0.z, a0.w); o.z = pk2(a1.x, a1.y); o.w = pk2(a1.z, a1.w);
        *(u32x4*)(ub + (size_t)i * 8) = o;
        const f32x4 b0 = *(const f32x4*)(v + (size_t)i * 8), b1 = *(const f32x4*)(v + (size_t)i * 8 + 4);
        u32x4 p; p.x = pk2(b0.x, b0.y); p.y = pk2(b0.z, b0.w); p.z = pk2(b1.x, b1.y); p.w = pk2(b1.z, b1.w);
        *(u32x4*)(vb + (size_t)i * 8) = p;
    }
}

__device__ __forceinline__ void p_topk_naive(const Ctx& C, const bf16_t* qp, const bf16_t* keys, unsigned short* pidx, float* pgate) {
    constexpr int NTK = 64;
    LAS float* S = (LAS float*)C.lds;
    LAS float* TV = (LAS float*)(C.lds + 256 * NTK * 4);
    LAS int* TI = (LAS int*)(C.lds + 256 * NTK * 4 + 32 * NTK * 4);
    const int tl = C.tid;
    if (C.tid < 64)
    for (int item = C.bid * NTK + tl; item < T * 8; item += C.G * NTK) {
        const int t = item >> 3, hh = item & 7;
        for (int z = 0; z < 2; ++z) {
            unsigned qv[64];
            const u32x4* qptr = (const u32x4*)(qp + (size_t)t * 2048 + hh * 256 + z * 128);
#pragma unroll
            for (int d8 = 0; d8 < 16; ++d8) { const u32x4 w = qptr[d8]; qv[d8 * 4 + 0] = w.x; qv[d8 * 4 + 1] = w.y; qv[d8 * 4 + 2] = w.z; qv[d8 * 4 + 3] = w.w; }
            for (int n = 0; n < 128; ++n) {
                const u32x4* kp = (const u32x4*)(keys + (size_t)(z * 128 + n) * 128);
                float acc = 0.f;
#pragma unroll
                for (int d8 = 0; d8 < 16; ++d8) { const u32x4 w = kp[d8];
                    acc += bflo(qv[d8 * 4 + 0]) * bflo(w.x) + bfhi(qv[d8 * 4 + 0]) * bfhi(w.x) + bflo(qv[d8 * 4 + 1]) * bflo(w.y) + bfhi(qv[d8 * 4 + 1]) * bfhi(w.y)
                         + bflo(qv[d8 * 4 + 2]) * bflo(w.z) + bfhi(qv[d8 * 4 + 2]) * bfhi(w.z) + bflo(qv[d8 * 4 + 3]) * bflo(w.w) + bfhi(qv[d8 * 4 + 3]) * bfhi(w.w); }
                S[(z * 128 + n) * NTK + tl] = acc;
            }
            float pv = 3.0e38f; int pi = -1;
            for (int r = 0; r < 16; ++r) {
                float best = -3.0e38f; int bi = 0;
                for (int n = 0; n < 128; ++n) { const float x = S[(z * 128 + n) * NTK + tl];
                    const bool elig = (x < pv) || (x == pv && n > pi);
                    if (elig && x > best) { best = x; bi = n; } }
                TV[(z * 16 + r) * NTK + tl] = best; TI[(z * 16 + r) * NTK + tl] = bi; pv = best; pi = bi;
            }
        }
        float pv = 3.0e38f; int pi = -1; float top[16]; int ei[16];
#pragma unroll
        for (int r = 0; r < 16; ++r) {
            float best = -3.0e38f; int bi = 0;
            for (int c = 0; c < 256; ++c) { const float x = TV[(c >> 4) * NTK + tl] + TV[(16 + (c & 15)) * NTK + tl];
                const bool elig = (x < pv) || (x == pv && c > pi);
                if (elig && x > best) { best = x; bi = c; } }
            top[r] = best; ei[r] = TI[(bi >> 4) * NTK + tl] * 128 + TI[(16 + (bi & 15)) * NTK + tl]; pv = best; pi = bi;
        }
        float den = 0.f, e[16];
#pragma unroll
        for (int r = 0; r < 16; ++r) { e[r] = __expf(top[r] - top[0]); den += e[r]; }
        const float inv = 1.f / den;
#pragma unroll
        for (int r = 0; r < 16; ++r) { pidx[(size_t)t * 128 + hh * 16 + r] = (unsigned short)ei[r]; pgate[(size_t)t * 128 + hh * 16 + r] = e[r] * inv; }
    }
}


namespace tk {
typedef short bf16x8 __attribute__((ext_vector_type(8)));
constexpr int RSK = 272, TAB = 69632, TABW = 33 * 16 * 4, IJT = TAB + 8 * TABW;
__device__ __forceinline__ void ce(float& a, float& b) { const float hi = __builtin_fmaxf(a, b), lo = __builtin_fminf(a, b); a = hi; b = lo; }
__device__ __forceinline__ void sort16(float (&v)[16]) {
#pragma unroll
    for (int k = 2; k <= 16; k <<= 1)
#pragma unroll
        for (int j = k >> 1; j > 0; j >>= 1)
#pragma unroll
            for (int i = 0; i < 16; ++i) { const int l = i ^ j; if (l > i) { if ((i & k) == 0) ce(v[i], v[l]); else ce(v[l], v[i]); } }
}
__device__ __forceinline__ void merge16(float (&a)[16], const float (&b)[16]) {
#pragma unroll
    for (int i = 0; i < 16; ++i) a[i] = __builtin_fmaxf(a[i], b[15 - i]);
#pragma unroll
    for (int j = 8; j > 0; j >>= 1)
#pragma unroll
        for (int i = 0; i < 16; ++i) { const int l = i ^ j; if (l > i) ce(a[i], a[l]); }
}
__device__ __forceinline__ void xmerge(float (&a)[16], int mask) { float b[16];
#pragma unroll
    for (int i = 0; i < 16; ++i) b[i] = __shfl_xor(a[i], mask);
    merge16(a, b); }
}
__device__ __forceinline__ void p_topk(const Ctx& C, const bf16_t* qp, const bf16_t* keys, unsigned short* pidx, float* pgate) {
    using namespace tk;
    LAS unsigned char* L = C.lds;
    const int tid = C.tid, lane = C.lane, w = C.wave, g = lane >> 4, i16 = lane & 15;
    __syncthreads();
    for (int i = tid; i < 4096; i += NTHR) { const int r = i >> 4, cc = i & 15; *(LAS u32x4*)(L + r * RSK + cc * 16) = *(const u32x4*)(keys + (size_t)r * 128 + cc * 8); }
    if (tid < 64) { int cnt = 0, fi = 0, fj = 0;
        for (int i = 0; i < 16; ++i) for (int j = 0; j < 16; ++j) if ((i + 1) * (j + 1) <= 16) { if (cnt == tid) { fi = i; fj = j; } ++cnt; }
        ((LAS unsigned*)(L + IJT))[tid] = (unsigned)(fi | (fj << 4)); }
    __syncthreads();
    LAS unsigned* tab = (LAS unsigned*)(L + TAB + w * TABW) + i16 * 33;
    const LAS unsigned* ijt = (const LAS unsigned*)(L + IJT);
    const float NEGV = -1.0e30f;
    const int gw = C.bid * NWAVES + w, NGW = C.G * NWAVES;
    for (int unit = gw; unit < (T / 16) * 8; unit += NGW) {
        const int tg = unit >> 3, hh = unit & 7; const size_t t0 = (size_t)tg * 16;
        float s1[16], s2[16];
#pragma unroll
        for (int z = 0; z < 2; ++z) {
            bf16x8 qf[4];
#pragma unroll
            for (int ks = 0; ks < 4; ++ks) qf[ks] = *(const bf16x8*)(qp + (t0 + i16) * 2048 + hh * 256 + z * 128 + ks * 32 + g * 8);
            float lo[16], hi[16];
#pragma unroll
            for (int nt = 0; nt < 8; ++nt) { f32x4 acc = (f32x4){0.f, 0.f, 0.f, 0.f};
#pragma unroll
                for (int ks = 0; ks < 4; ++ks) { const bf16x8 kf = *(const LAS bf16x8*)(L + (z * 128 + 16 * nt + i16) * RSK + ks * 64 + g * 16);
                    acc = __builtin_amdgcn_mfma_f32_16x16x32_bf16(kf, qf[ks], acc, 0, 0, 0); }
#pragma unroll
                for (int r = 0; r < 4; ++r) { const float pv = __uint_as_float((__float_as_uint(acc[r]) & 0xFFFFFF80u) | (unsigned)(16 * nt + 4 * g + r));
                    if (nt < 4) lo[nt * 4 + r] = pv; else hi[(nt - 4) * 4 + r] = pv; } }
            sort16(lo); sort16(hi); merge16(lo, hi);
            xmerge(lo, 16); xmerge(lo, 32);
#pragma unroll
            for (int i = 0; i < 16; ++i) { if (z == 0) s1[i] = lo[i]; else s2[i] = lo[i]; }
        }
#pragma unroll
        for (int i = 0; i < 16; ++i) { tab[i] = __float_as_uint(s1[i]); tab[16 + i] = __float_as_uint(s2[i]); }
        float cand[16];
            { const float a_ = (g == 0 ? s1[0] : g == 1 ? s1[1] : g == 2 ? s1[3] : s1[14]), b_ = (g == 0 ? s2[0] : g == 1 ? s2[0] : g == 2 ? s2[3] : s2[0]); cand[0] = __uint_as_float((__float_as_uint(a_ + b_) & 0xFFFFFFC0u) | (unsigned)(16 * g + 0)); }
            { const float a_ = (g == 0 ? s1[0] : g == 1 ? s1[1] : g == 2 ? s1[4] : s1[15]), b_ = (g == 0 ? s2[1] : g == 1 ? s2[1] : g == 2 ? s2[0] : s2[0]); cand[1] = __uint_as_float((__float_as_uint(a_ + b_) & 0xFFFFFFC0u) | (unsigned)(16 * g + 1)); }
            { const float a_ = (g == 0 ? s1[0] : g == 1 ? s1[1] : g == 2 ? s1[4] : NEGV), b_ = (g == 0 ? s2[2] : g == 1 ? s2[2] : g == 2 ? s2[1] : NEGV); cand[2] = __uint_as_float((__float_as_uint(a_ + b_) & 0xFFFFFFC0u) | (unsigned)(16 * g + 2)); }
            { const float a_ = (g == 0 ? s1[0] : g == 1 ? s1[1] : g == 2 ? s1[4] : NEGV), b_ = (g == 0 ? s2[3] : g == 1 ? s2[3] : g == 2 ? s2[2] : NEGV); cand[3] = __uint_as_float((__float_as_uint(a_ + b_) & 0xFFFFFFC0u) | (unsigned)(16 * g + 3)); }
            { const float a_ = (g == 0 ? s1[0] : g == 1 ? s1[1] : g == 2 ? s1[5] : NEGV), b_ = (g == 0 ? s2[4] : g == 1 ? s2[4] : g == 2 ? s2[0] : NEGV); cand[4] = __uint_as_float((__float_as_uint(a_ + b_) & 0xFFFFFFC0u) | (unsigned)(16 * g + 4)); }
            { const float a_ = (g == 0 ? s1[0] : g == 1 ? s1[1] : g == 2 ? s1[5] : NEGV), b_ = (g == 0 ? s2[5] : g == 1 ? s2[5] : g == 2 ? s2[1] : NEGV); cand[5] = __uint_as_float((__float_as_uint(a_ + b_) & 0xFFFFFFC0u) | (unsigned)(16 * g + 5)); }
            { const float a_ = (g == 0 ? s1[0] : g == 1 ? s1[1] : g == 2 ? s1[6] : NEGV), b_ = (g == 0 ? s2[6] : g == 1 ? s2[6] : g == 2 ? s2[0] : NEGV); cand[6] = __uint_as_float((__float_as_uint(a_ + b_) & 0xFFFFFFC0u) | (unsigned)(16 * g + 6)); }
            { const float a_ = (g == 0 ? s1[0] : g == 1 ? s1[1] : g == 2 ? s1[6] : NEGV), b_ = (g == 0 ? s2[7] : g == 1 ? s2[7] : g == 2 ? s2[1] : NEGV); cand[7] = __uint_as_float((__float_as_uint(a_ + b_) & 0xFFFFFFC0u) | (unsigned)(16 * g + 7)); }
            { const float a_ = (g == 0 ? s1[0] : g == 1 ? s1[2] : g == 2 ? s1[7] : NEGV), b_ = (g == 0 ? s2[8] : g == 1 ? s2[0] : g == 2 ? s2[0] : NEGV); cand[8] = __uint_as_float((__float_as_uint(a_ + b_) & 0xFFFFFFC0u) | (unsigned)(16 * g + 8)); }
            { const float a_ = (g == 0 ? s1[0] : g == 1 ? s1[2] : g == 2 ? s1[7] : NEGV), b_ = (g == 0 ? s2[9] : g == 1 ? s2[1] : g == 2 ? s2[1] : NEGV); cand[9] = __uint_as_float((__float_as_uint(a_ + b_) & 0xFFFFFFC0u) | (unsigned)(16 * g + 9)); }
            { const float a_ = (g == 0 ? s1[0] : g == 1 ? s1[2] : g == 2 ? s1[8] : NEGV), b_ = (g == 0 ? s2[10] : g == 1 ? s2[2] : g == 2 ? s2[0] : NEGV); cand[10] = __uint_as_float((__float_as_uint(a_ + b_) & 0xFFFFFFC0u) | (unsigned)(16 * g + 10)); }
            { const float a_ = (g == 0 ? s1[0] : g == 1 ? s1[2] : g == 2 ? s1[9] : NEGV), b_ = (g == 0 ? s2[11] : g == 1 ? s2[3] : g == 2 ? s2[0] : NEGV); cand[11] = __uint_as_float((__float_as_uint(a_ + b_) & 0xFFFFFFC0u) | (unsigned)(16 * g + 11)); }
            { const float a_ = (g == 0 ? s1[0] : g == 1 ? s1[2] : g == 2 ? s1[10] : NEGV), b_ = (g == 0 ? s2[12] : g == 1 ? s2[4] : g == 2 ? s2[0] : NEGV); cand[12] = __uint_as_float((__float_as_uint(a_ + b_) & 0xFFFFFFC0u) | (unsigned)(16 * g + 12)); }
            { const float a_ = (g == 0 ? s1[0] : g == 1 ? s1[3] : g == 2 ? s1[11] : NEGV), b_ = (g == 0 ? s2[13] : g == 1 ? s2[0] : g == 2 ? s2[0] : NEGV); cand[13] = __uint_as_float((__float_as_uint(a_ + b_) & 0xFFFFFFC0u) | (unsigned)(16 * g + 13)); }
            { const float a_ = (g == 0 ? s1[0] : g == 1 ? s1[3] : g == 2 ? s1[12] : NEGV), b_ = (g == 0 ? s2[14] : g == 1 ? s2[1] : g == 2 ? s2[0] : NEGV); cand[14] = __uint_as_float((__float_as_uint(a_ + b_) & 0xFFFFFFC0u) | (unsigned)(16 * g + 14)); }
            { const float a_ = (g == 0 ? s1[0] : g == 1 ? s1[3] : g == 2 ? s1[13] : NEGV), b_ = (g == 0 ? s2[15] : g == 1 ? s2[2] : g == 2 ? s2[0] : NEGV); cand[15] = __uint_as_float((__float_as_uint(a_ + b_) & 0xFFFFFFC0u) | (unsigned)(16 * g + 15)); }
        sort16(cand);
        xmerge(cand, 16); xmerge(cand, 32);
        float den = 0.f, ex[16];
#pragma unroll
        for (int i = 0; i < 16; ++i) { ex[i] = __expf(cand[i] - cand[0]); den += ex[i]; }
        const float inv = 1.f / den;
        unsigned short eo[4]; float go[4];
#pragma unroll
        for (int e = 0; e < 4; ++e) {
            const float cv = (g == 0 ? cand[e] : g == 1 ? cand[4 + e] : g == 2 ? cand[8 + e] : cand[12 + e]);
            const float gv = (g == 0 ? ex[e] : g == 1 ? ex[4 + e] : g == 2 ? ex[8 + e] : ex[12 + e]);
            const unsigned code = __float_as_uint(cv) & 63u; const unsigned ij = ijt[code];
            const unsigned p1 = tab[ij & 15u], p2 = tab[16 + (ij >> 4)];
            eo[e] = (unsigned short)((p1 & 127u) * 128u + (p2 & 127u)); go[e] = gv * inv; }
        u32x2 ov; ov.x = (unsigned)eo[0] | ((unsigned)eo[1] << 16); ov.y = (unsigned)eo[2] | ((unsigned)eo[3] << 16);
        *(u32x2*)(pidx + (t0 + i16) * 128 + hh * 16 + 4 * g) = ov;
        *(f32x4*)(pgate + (t0 + i16) * 128 + hh * 16 + 4 * g) = (f32x4){go[0], go[1], go[2], go[3]};
    }
    __syncthreads();
}

__device__ __forceinline__ float dot2u(unsigned a, unsigned x, float acc) {
    return __builtin_amdgcn_fdot2_f32_bf16(__builtin_bit_cast(bf16x2_t, a), __builtin_bit_cast(bf16x2_t, x), acc, false);
}
__device__ __forceinline__ float dot8(const u32x4 a, const u32x4 x, float acc) {
    const unsigned a0 = a.x, a1 = a.y, a2 = a.z, a3 = a.w, x0 = x.x, x1 = x.y, x2 = x.z, x3 = x.w;
    acc = dot2u(a0, x0, acc); acc = dot2u(a1, x1, acc); acc = dot2u(a2, x2, acc); acc = dot2u(a3, x3, acc);
    return acc;
}
__device__ __forceinline__ void p_gather(const Ctx& C, const bf16_t* n2, const unsigned short* pidx, const float* pgate, const bf16_t* ub, const bf16_t* vb, const float* h, float* out) {
    const float* mod = C.f32p(WS_MOD); const float* fg = C.in[23];
    LAS float* cbuf = (LAS float*)C.lds + C.wave * 128;
    const int gw = C.bid * NWAVES + C.wave, NGW = C.G * NWAVES, lane = C.lane;
    for (int t = gw; t < T; t += NGW) {
        const int b = t / SEQ;
        const u32x4 x0 = *(const u32x4*)(n2 + (size_t)t * 1024 + lane * 8), x1 = *(const u32x4*)(n2 + (size_t)t * 1024 + 512 + lane * 8);
        const int id0 = pidx[(size_t)t * 128 + lane], id1 = pidx[(size_t)t * 128 + 64 + lane];
        const float g0 = pgate[(size_t)t * 128 + lane], g1 = pgate[(size_t)t * 128 + 64 + lane];
#pragma unroll 1
        for (int grp = 0; grp < 8; ++grp) {
            const int idv = grp < 4 ? id0 : id1; const int lbase = (grp & 3) * 16;
            float part[16];
#pragma unroll
            for (int j = 0; j < 16; ++j) {
                const int e = __shfl(idv, lbase + j);
                const bf16_t* rowp = ub + (size_t)e * 1024;
                const u32x4 a0 = *(const u32x4*)(rowp + lane * 8), a1 = *(const u32x4*)(rowp + 512 + lane * 8);
                part[j] = dot8(a1, x1, dot8(a0, x0, 0.f));
            }
            float p8[8];
            { const bool hi = (lane & 32) != 0;
#pragma unroll
              for (int j = 0; j < 8; ++j) { const float keep = hi ? part[j + 8] : part[j], send = hi ? part[j] : part[j + 8]; p8[j] = keep + __shfl_xor(send, 32); } }
            float p4[4];
            { const bool hi = (lane & 16) != 0;
#pragma unroll
              for (int j = 0; j < 4; ++j) { const float keep = hi ? p8[j + 4] : p8[j], send = hi ? p8[j] : p8[j + 4]; p4[j] = keep + __shfl_xor(send, 16); } }
            float p2[2];
            { const bool hi = (lane & 8) != 0;
#pragma unroll
              for (int j = 0; j < 2; ++j) { const float keep = hi ? p4[j + 2] : p4[j], send = hi ? p4[j] : p4[j + 2]; p2[j] = keep + __shfl_xor(send, 8); } }
            float p1;
            { const bool hi = (lane & 4) != 0; const float keep = hi ? p2[1] : p2[0], send = hi ? p2[0] : p2[1]; p1 = keep + __shfl_xor(send, 4); }
            p1 += __shfl_xor(p1, 2); p1 += __shfl_xor(p1, 1);
            const int E = ((lane >> 5) & 1) * 8 + ((lane >> 4) & 1) * 4 + ((lane >> 3) & 1) * 2 + ((lane >> 2) & 1);
            if ((lane & 3) == 0) cbuf[grp * 16 + E] = gelu_f(p1);
        }
        asm volatile("s_waitcnt lgkmcnt(0)" ::: "memory");
        const float c0 = cbuf[lane] * g0, c1 = cbuf[64 + lane] * g1;
        asm volatile("s_waitcnt lgkmcnt(0)" ::: "memory");
        float acc[16];
#pragma unroll
        for (int i = 0; i < 16; ++i) acc[i] = 0.f;
#pragma unroll 1
        for (int kb = 0; kb < 128; kb += 8) {
            const int idv = kb < 64 ? id0 : id1; const float cv = kb < 64 ? c0 : c1;
#pragma unroll
            for (int j = 0; j < 8; ++j) {
                const int e = __shfl(idv, (kb & 63) + j); const float ck = __shfl(cv, (kb & 63) + j);
                const bf16_t* rowp = vb + (size_t)e * 1024;
                const u32x4 a0 = *(const u32x4*)(rowp + lane * 8), a1 = *(const u32x4*)(rowp + 512 + lane * 8);
                acc[0] += ck * bflo(a0.x); acc[1] += ck * bfhi(a0.x); acc[2] += ck * bflo(a0.y); acc[3] += ck * bfhi(a0.y);
                acc[4] += ck * bflo(a0.z); acc[5] += ck * bfhi(a0.z); acc[6] += ck * bflo(a0.w); acc[7] += ck * bfhi(a0.w);
                acc[8] += ck * bflo(a1.x); acc[9] += ck * bfhi(a1.x); acc[10] += ck * bflo(a1.y); acc[11] += ck * bfhi(a1.y);
                acc[12] += ck * bflo(a1.z); acc[13] += ck * bfhi(a1.z); acc[14] += ck * bflo(a1.w); acc[15] += ck * bfhi(a1.w);
            }
        }
        float hf[16]; float ss = 0.f;
#pragma unroll
        for (int half = 0; half < 2; ++half) {
            const int col = half * 512 + lane * 8;
            const f32x4 h0 = *(const f32x4*)(h + (size_t)t * 1024 + col), h1 = *(const f32x4*)(h + (size_t)t * 1024 + col + 4);
            const f32x4 m0 = *(const f32x4*)(mod + b * 6144 + 5120 + col), m1 = *(const f32x4*)(mod + b * 6144 + 5120 + col + 4);
            hf[half * 8 + 0] = h0.x + m0.x * acc[half * 8 + 0]; hf[half * 8 + 1] = h0.y + m0.y * acc[half * 8 + 1];
            hf[half * 8 + 2] = h0.z + m0.z * acc[half * 8 + 2]; hf[half * 8 + 3] = h0.w + m0.w * acc[half * 8 + 3];
            hf[half * 8 + 4] = h1.x + m1.x * acc[half * 8 + 4]; hf[half * 8 + 5] = h1.y + m1.y * acc[half * 8 + 5];
            hf[half * 8 + 6] = h1.z + m1.z * acc[half * 8 + 6]; hf[half * 8 + 7] = h1.w + m1.w * acc[half * 8 + 7];
        }
#pragma unroll
        for (int i = 0; i < 16; ++i) ss += hf[i] * hf[i];
        const float rstd = rsqrtf(wave_sum(ss) * (1.f / 1024.f) + EPS);
#pragma unroll
        for (int half = 0; half < 2; ++half) {
            const int col = half * 512 + lane * 8;
            const f32x4 f0 = *(const f32x4*)(fg + col), f1 = *(const f32x4*)(fg + col + 4);
            f32x4 o0, o1;
            o0.x = hf[half * 8 + 0] * rstd * f0.x; o0.y = hf[half * 8 + 1] * rstd * f0.y; o0.z = hf[half * 8 + 2] * rstd * f0.z; o0.w = hf[half * 8 + 3] * rstd * f0.w;
            o1.x = hf[half * 8 + 4] * rstd * f1.x; o1.y = hf[half * 8 + 5] * rstd * f1.y; o1.z = hf[half * 8 + 6] * rstd * f1.z; o1.w = hf[half * 8 + 7] * rstd * f1.w;
            *(f32x4*)(out + (size_t)t * 1024 + col) = o0; *(f32x4*)(out + (size_t)t * 1024 + col + 4) = o1;
        }
    }
}


__device__ __forceinline__ void p_cvt_tables8(const Ctx& C, unsigned char* u8, unsigned char* v8) {
    const int gt = C.bid * NTHR + C.tid, NT = C.G * NTHR;
    const float* u = C.in[21]; const float* v = C.in[22];
    constexpr int N4 = 16384 * 1024 / 4;
    for (int i0 = gt; i0 < N4; i0 += 4 * NT) {
        f32x4 a[4], b[4];
#pragma unroll
        for (int r = 0; r < 4; ++r) { const int i = i0 + r * NT; if (i < N4) { a[r] = *(const f32x4*)(u + (size_t)i * 4); b[r] = *(const f32x4*)(v + (size_t)i * 4); } }
#pragma unroll
        for (int r = 0; r < 4; ++r) { const int i = i0 + r * NT; if (i < N4) {
            const f32x4 av = a[r] * 256.f, bv = b[r] * 64.f; unsigned x = 0u, y = 0u;
            x = __builtin_amdgcn_cvt_pk_fp8_f32(av.x, av.y, x, false); x = __builtin_amdgcn_cvt_pk_fp8_f32(av.z, av.w, x, true);
            y = __builtin_amdgcn_cvt_pk_fp8_f32(bv.x, bv.y, y, false); y = __builtin_amdgcn_cvt_pk_fp8_f32(bv.z, bv.w, y, true);
            *(unsigned*)(u8 + (size_t)i * 4) = x; *(unsigned*)(v8 + (size_t)i * 4) = y; } }
    }
}

__device__ __forceinline__ void p_gather8(const Ctx& C, const bf16_t* n2, const unsigned short* pidx, const float* pgate, const unsigned char* u8, const unsigned char* v8, const float* h, float* out) {
    const float* mod = C.f32p(WS_MOD); const float* fg = C.in[23];
    LAS float* cbuf = (LAS float*)C.lds + C.wave * 128;
    const int gw = C.bid * NWAVES + C.wave, NGW = C.G * NWAVES, lane = C.lane;
    for (int t = gw; t < T; t += NGW) {
        const int b = t / SEQ;
        unsigned xp[8];
        { const u32x4 x0 = *(const u32x4*)(n2 + (size_t)t * 1024 + lane * 16), x1 = *(const u32x4*)(n2 + (size_t)t * 1024 + lane * 16 + 8);
          xp[0] = x0.x; xp[1] = x0.y; xp[2] = x0.z; xp[3] = x0.w; xp[4] = x1.x; xp[5] = x1.y; xp[6] = x1.z; xp[7] = x1.w; }
        const int id0 = pidx[(size_t)t * 128 + lane], id1 = pidx[(size_t)t * 128 + 64 + lane];
        const float g0 = pgate[(size_t)t * 128 + lane], g1 = pgate[(size_t)t * 128 + 64 + lane];
        u32x4 bufA[8], bufB[8];
#define G8_LOAD8(buf_, tab_, slot0_) do { const int idv_ = (slot0_) < 64 ? id0 : id1; _Pragma("unroll") for (int j_ = 0; j_ < 8; ++j_) { const int e_ = __builtin_amdgcn_readlane(idv_, ((slot0_) & 63) + j_); \
            buf_[j_] = *(const u32x4*)((tab_) + (size_t)e_ * 1024 + lane * 16); } } while (0)
#define G8_UDOT8(buf_, off_) do { _Pragma("unroll") for (int j_ = 0; j_ < 8; ++j_) { float acc_ = 0.f; \
                _Pragma("unroll") for (int d_ = 0; d_ < 4; ++d_) { const unsigned wv_ = buf_[j_][d_]; \
                    const bf16x2_t lo_ = __builtin_amdgcn_cvt_scalef32_pk_bf16_fp8(wv_, 0.00390625f, false), hi_ = __builtin_amdgcn_cvt_scalef32_pk_bf16_fp8(wv_, 0.00390625f, true); \
                    const unsigned xa_ = xp[2 * d_], xb_ = xp[2 * d_ + 1]; \
                    acc_ = __builtin_amdgcn_fdot2_f32_bf16(lo_, __builtin_bit_cast(bf16x2_t, xa_), acc_, false); acc_ = __builtin_amdgcn_fdot2_f32_bf16(hi_, __builtin_bit_cast(bf16x2_t, xb_), acc_, false); } \
                part[(off_) + j_] = acc_; __builtin_amdgcn_sched_barrier(0); } } while (0)
#define G8_REDUCE(grp_) do { \
            float p8[8]; { const bool hi = (lane & 32) != 0; \
              _Pragma("unroll") for (int j_ = 0; j_ < 8; ++j_) { const float keep = hi ? part[j_ + 8] : part[j_], send = hi ? part[j_] : part[j_ + 8]; p8[j_] = keep + __shfl_xor(send, 32); } } \
            float p4[4]; { const bool hi = (lane & 16) != 0; \
              _Pragma("unroll") for (int j_ = 0; j_ < 4; ++j_) { const float keep = hi ? p8[j_ + 4] : p8[j_], send = hi ? p8[j_] : p8[j_ + 4]; p4[j_] = keep + __shfl_xor(send, 16); } } \
            float p2[2]; { const bool hi = (lane & 8) != 0; \
              _Pragma("unroll") for (int j_ = 0; j_ < 2; ++j_) { const float keep = hi ? p4[j_ + 2] : p4[j_], send = hi ? p4[j_] : p4[j_ + 2]; p2[j_] = keep + __shfl_xor(send, 8); } } \
            float p1; { const bool hi = (lane & 4) != 0; const float keep = hi ? p2[1] : p2[0], send = hi ? p2[0] : p2[1]; p1 = keep + __shfl_xor(send, 4); } \
            p1 += __shfl_xor(p1, 2); p1 += __shfl_xor(p1, 1); \
            const int E_ = ((lane >> 5) & 1) * 8 + ((lane >> 4) & 1) * 4 + ((lane >> 3) & 1) * 2 + ((lane >> 2) & 1); \
            if ((lane & 3) == 0) cbuf[(grp_) * 16 + E_] = gelu_f(p1); } while (0)
        G8_LOAD8(bufA, u8, 0); G8_LOAD8(bufB, u8, 8);
#pragma unroll 1
        for (int grp = 0; grp < 8; ++grp) {
            float part[16];
            G8_UDOT8(bufA, 0);
            if (grp < 7) G8_LOAD8(bufA, u8, 16 * (grp + 1)); else G8_LOAD8(bufA, v8, 0);
            G8_UDOT8(bufB, 8);
            if (grp < 7) G8_LOAD8(bufB, u8, 16 * (grp + 1) + 8); else G8_LOAD8(bufB, v8, 8);
            G8_REDUCE(grp);
        }
        asm volatile("s_waitcnt lgkmcnt(0)" ::: "memory");
        const float c0 = cbuf[lane] * g0 * 0.015625f, c1 = cbuf[64 + lane] * g1 * 0.015625f;
        asm volatile("s_waitcnt lgkmcnt(0)" ::: "memory");
        float acc[16];
#pragma unroll
        for (int i = 0; i < 16; ++i) acc[i] = 0.f;
#define G8_VCOMP8(buf_, slot0_) do { const float cv_ = (slot0_) < 64 ? c0 : c1; _Pragma("unroll") for (int j_ = 0; j_ < 8; ++j_) { const float ck_ = __int_as_float(__builtin_amdgcn_readlane(__float_as_int(cv_), ((slot0_) & 63) + j_)); \
            _Pragma("unroll") for (int d_ = 0; d_ < 4; ++d_) { const unsigned wv_ = buf_[j_][d_]; const f32x2_t lo_ = __builtin_amdgcn_cvt_pk_f32_fp8(wv_, false), hi_ = __builtin_amdgcn_cvt_pk_f32_fp8(wv_, true); \
                acc[4 * d_ + 0] += ck_ * lo_.x; acc[4 * d_ + 1] += ck_ * lo_.y; acc[4 * d_ + 2] += ck_ * hi_.x; acc[4 * d_ + 3] += ck_ * hi_.y; } \
            asm volatile("" : "+v"(acc[0]), "+v"(acc[1]), "+v"(acc[2]), "+v"(acc[3]), "+v"(acc[4]), "+v"(acc[5]), "+v"(acc[6]), "+v"(acc[7]), "+v"(acc[8]), "+v"(acc[9]), "+v"(acc[10]), "+v"(acc[11]), "+v"(acc[12]), "+v"(acc[13]), "+v"(acc[14]), "+v"(acc[15])); } } while (0)
#pragma unroll 1
        for (int grp = 0; grp < 8; ++grp) {
            G8_VCOMP8(bufA, 16 * grp);
            if (grp < 7) G8_LOAD8(bufA, v8, 16 * (grp + 1));
            G8_VCOMP8(bufB, 16 * grp + 8);
            if (grp < 7) G8_LOAD8(bufB, v8, 16 * (grp + 1) + 8);
        }
#undef G8_LOAD8
#undef G8_UDOT8
#undef G8_REDUCE
#undef G8_VCOMP8
        float hf[16]; float ss = 0.f;
#pragma unroll
        for (int d = 0; d < 4; ++d) { const int col = lane * 16 + d * 4;
            const f32x4 hv = *(const f32x4*)(h + (size_t)t * 1024 + col), mv = *(const f32x4*)(mod + b * 6144 + 5120 + col);
            hf[4 * d + 0] = hv.x + mv.x * acc[4 * d + 0]; hf[4 * d + 1] = hv.y + mv.y * acc[4 * d + 1]; hf[4 * d + 2] = hv.z + mv.z * acc[4 * d + 2]; hf[4 * d + 3] = hv.w + mv.w * acc[4 * d + 3]; }
#pragma unroll
        for (int i = 0; i < 16; ++i) ss += hf[i] * hf[i];
        const float rstd = rsqrtf(wave_sum(ss) * (1.f / 1024.f) + EPS);
#pragma unroll
        for (int d = 0; d < 4; ++d) { const int col = lane * 16 + d * 4; const f32x4 fv = *(const f32x4*)(fg + col);
            f32x4 o; o.x = hf[4 * d + 0] * rstd * fv.x; o.y = hf[4 * d + 1] * rstd * fv.y; o.z = hf[4 * d + 2] * rstd * fv.z; o.w = hf[4 * d + 3] * rstd * fv.w;
            *(f32x4*)(out + (size_t)t * 1024 + col) = o; }
    }
}


__device__ __forceinline__ int idx16(const u32x4& a, const u32x4& b, int i) { const unsigned w = (i < 8 ? a : b)[(i & 7) >> 1]; return (int)((i & 1) ? (w >> 16) : (w & 0xffffu)); }
__device__ __forceinline__ void p_gu(const Ctx& C, const bf16_t* n2, const unsigned short* pidx, const unsigned char* u8, float* pd) {
    const int j = C.bid & 7, nsl = C.G >> 3, NW = nsl * NWAVES, wsl = (C.bid >> 3) * NWAVES + C.wave, lane = C.lane, s = lane & 7, q = lane >> 3;
    if ((C.bid >> 3) >= nsl) return;
    u32x4 ea, eb, x0, x1;
    { const int t = wsl; ea = *(const u32x4*)(pidx + (size_t)t * 128 + q * 16); eb = *(const u32x4*)(pidx + (size_t)t * 128 + q * 16 + 8);
      x0 = *(const u32x4*)(n2 + (size_t)t * 1024 + 128 * j + 16 * s); x1 = *(const u32x4*)(n2 + (size_t)t * 1024 + 128 * j + 16 * s + 8); }
    for (int t = wsl; t < T; t += NW) {
        u32x4 p[16];
#pragma unroll
        for (int i = 0; i < 16; ++i) p[i] = *(const u32x4*)(u8 + (size_t)idx16(ea, eb, i) * 1024 + 128 * j + 16 * s);
        const unsigned xp[8] = {x0.x, x0.y, x0.z, x0.w, x1.x, x1.y, x1.z, x1.w};
        { const int tn = (t + NW < T) ? t + NW : t;
          ea = *(const u32x4*)(pidx + (size_t)tn * 128 + q * 16); eb = *(const u32x4*)(pidx + (size_t)tn * 128 + q * 16 + 8);
          x0 = *(const u32x4*)(n2 + (size_t)tn * 1024 + 128 * j + 16 * s); x1 = *(const u32x4*)(n2 + (size_t)tn * 1024 + 128 * j + 16 * s + 8); }
        float part[16];
#pragma unroll
        for (int i = 0; i < 16; ++i) { float acc = 0.f;
#pragma unroll
            for (int d = 0; d < 4; ++d) { const unsigned wv = p[i][d];
                const bf16x2_t lo = __builtin_amdgcn_cvt_scalef32_pk_bf16_fp8(wv, 0.00390625f, false), hi = __builtin_amdgcn_cvt_scalef32_pk_bf16_fp8(wv, 0.00390625f, true);
                const unsigned xa = xp[2 * d], xb = xp[2 * d + 1];
                acc = __builtin_amdgcn_fdot2_f32_bf16(lo, __builtin_bit_cast(bf16x2_t, xa), acc, false); acc = __builtin_amdgcn_fdot2_f32_bf16(hi, __builtin_bit_cast(bf16x2_t, xb), acc, false); }
            part[i] = acc; }
        float p8[8]; { const bool hb = (lane & 4) != 0;
#pragma unroll
            for (int i = 0; i < 8; ++i) { const float keep = hb ? part[i + 8] : part[i], send = hb ? part[i] : part[i + 8]; p8[i] = keep + __shfl_xor(send, 4); } }
        float p4[4]; { const bool hb = (lane & 2) != 0;
#pragma unroll
            for (int i = 0; i < 4; ++i) { const float keep = hb ? p8[i + 4] : p8[i], send = hb ? p8[i] : p8[i + 4]; p4[i] = keep + __shfl_xor(send, 2); } }
        float p2[2]; { const bool hb = (lane & 1) != 0;
#pragma unroll
            for (int i = 0; i < 2; ++i) { const float keep = hb ? p4[i + 2] : p4[i], send = hb ? p4[i] : p4[i + 2]; p2[i] = keep + __shfl_xor(send, 1); } }
        const int i0 = ((lane >> 2) & 1) * 8 + ((lane >> 1) & 1) * 4 + (lane & 1) * 2;
        f32x2_t o; o.x = p2[0]; o.y = p2[1];
        *(f32x2_t*)(pd + ((size_t)j * T + t) * 128 + q * 16 + i0) = o;
    }
}
__device__ __forceinline__ void p_gc(const Ctx& C, const float* pd, const float* pgate, float* cc) {
    const int gt = C.bid * NTHR + C.tid, NT = C.G * NTHR;
    for (int i = gt; i < T * 128; i += NT) { const int t = i >> 7, k = i & 127;
        float sdot = 0.f;
#pragma unroll
        for (int j = 0; j < 8; ++j) sdot += pd[((size_t)j * T + t) * 128 + k];
        cc[i] = gelu_f(sdot) * pgate[i] * 0.015625f; }
}
__device__ __forceinline__ void p_gv(const Ctx& C, const float* cc, const unsigned short* pidx, const unsigned char* v8, bf16_t* op) {
    const int j = C.bid & 7, nsl = C.G >> 3, NW = nsl * NWAVES, wsl = (C.bid >> 3) * NWAVES + C.wave, lane = C.lane, s = lane & 7, q = lane >> 3;
    if ((C.bid >> 3) >= nsl) return;
    u32x4 ea, eb; f32x4 c4[4];
    { const int t = wsl; ea = *(const u32x4*)(pidx + (size_t)t * 128 + q * 16); eb = *(const u32x4*)(pidx + (size_t)t * 128 + q * 16 + 8);
#pragma unroll
      for (int d = 0; d < 4; ++d) c4[d] = *(const f32x4*)(cc + (size_t)t * 128 + q * 16 + 4 * d); }
    for (int t = wsl; t < T; t += NW) {
        u32x4 p[16];
#pragma unroll
        for (int i = 0; i < 16; ++i) p[i] = *(const u32x4*)(v8 + (size_t)idx16(ea, eb, i) * 1024 + 128 * j + 16 * s);
        float cv[16];
#pragma unroll
        for (int d = 0; d < 4; ++d) { cv[4 * d] = c4[d].x; cv[4 * d + 1] = c4[d].y; cv[4 * d + 2] = c4[d].z; cv[4 * d + 3] = c4[d].w; }
        { const int tn = (t + NW < T) ? t + NW : t;
          ea = *(const u32x4*)(pidx + (size_t)tn * 128 + q * 16); eb = *(const u32x4*)(pidx + (size_t)tn * 128 + q * 16 + 8);
#pragma unroll
          for (int d = 0; d < 4; ++d) c4[d] = *(const f32x4*)(cc + (size_t)tn * 128 + q * 16 + 4 * d); }
        float acc[16];
#pragma unroll
        for (int c = 0; c < 16; ++c) acc[c] = 0.f;
#pragma unroll
        for (int i = 0; i < 16; ++i) { const float ck = cv[i];
#pragma unroll
            for (int d = 0; d < 4; ++d) { const unsigned wv = p[i][d]; const f32x2_t lo = __builtin_amdgcn_cvt_pk_f32_fp8(wv, false), hi = __builtin_amdgcn_cvt_pk_f32_fp8(wv, true);
                acc[4 * d + 0] += ck * lo.x; acc[4 * d + 1] += ck * lo.y; acc[4 * d + 2] += ck * hi.x; acc[4 * d + 3] += ck * hi.y; }
            asm volatile("" : "+v"(acc[0]), "+v"(acc[1]), "+v"(acc[2]), "+v"(acc[3]), "+v"(acc[4]), "+v"(acc[5]), "+v"(acc[6]), "+v"(acc[7]), "+v"(acc[8]), "+v"(acc[9]), "+v"(acc[10]), "+v"(acc[11]), "+v"(acc[12]), "+v"(acc[13]), "+v"(acc[14]), "+v"(acc[15])); }
        float p8[8]; { const bool hb = (lane & 32) != 0;
#pragma unroll
            for (int i = 0; i < 8; ++i) { const float keep = hb ? acc[i + 8] : acc[i], send = hb ? acc[i] : acc[i + 8]; p8[i] = keep + __shfl_xor(send, 32); } }
        float p4[4]; { const bool hb = (lane & 16) != 0;
#pragma unroll
            for (int i = 0; i < 4; ++i) { const float keep = hb ? p8[i + 4] : p8[i], send = hb ? p8[i] : p8[i + 4]; p4[i] = keep + __shfl_xor(send, 16); } }
        float p2[2]; { const bool hb = (lane & 8) != 0;
#pragma unroll
            for (int i = 0; i < 2; ++i) { const float keep = hb ? p4[i + 2] : p4[i], send = hb ? p4[i] : p4[i + 2]; p2[i] = keep + __shfl_xor(send, 8); } }
        const int c0 = ((lane >> 5) & 1) * 8 + ((lane >> 4) & 1) * 4 + ((lane >> 3) & 1) * 2;
        *(unsigned*)(op + (size_t)t * 1024 + 128 * j + 16 * s + c0) = pk2(p2[0], p2[1]);
    }
}
__device__ __forceinline__ void p_gf(const Ctx& C, const float* h, const bf16_t* op, float* out) {
    const float* mod = C.f32p(WS_MOD); const float* fg = C.in[23];
    const int gw = C.bid * NWAVES + C.wave, NGW = C.G * NWAVES, lane = C.lane;
    for (int t = gw; t < T; t += NGW) {
        const int b = t / SEQ;
        f32x4 hf[4]; float ss = 0.f;
#pragma unroll
        for (int d = 0; d < 4; ++d) { const int col = 256 * d + 4 * lane;
            const u32x2 ov = *(const u32x2*)(op + (size_t)t * 1024 + col);
            const f32x4 hv = *(const f32x4*)(h + (size_t)t * 1024 + col), mv = *(const f32x4*)(mod + b * 6144 + 5120 + col);
            f32x4 o4; o4.x = bflo(ov.x); o4.y = bfhi(ov.x); o4.z = bflo(ov.y); o4.w = bfhi(ov.y);
            hf[d] = hv + mv * o4; ss += (hf[d].x * hf[d].x + hf[d].y * hf[d].y) + (hf[d].z * hf[d].z + hf[d].w * hf[d].w); }
        const float rstd = rsqrtf(wave_sum(ss) * (1.f / 1024.f) + EPS);
#pragma unroll
        for (int d = 0; d < 4; ++d) { const int col = 256 * d + 4 * lane; const f32x4 fv = *(const f32x4*)(fg + col);
            *(f32x4*)(out + (size_t)t * 1024 + col) = hf[d] * rstd * fv; }
    }
}

__device__ __forceinline__ void p_gather_ref(const Ctx& C, const bf16_t* n2, const unsigned short* pidx, const float* pgate, const float* h, float* out) {
    const float* mod = C.f32p(WS_MOD); const float* fg = C.in[23]; const float* U = C.in[21]; const float* V = C.in[22];
    LAS float* xs = (LAS float*)C.lds;
    LAS float* part = xs + 1024;
    LAS float* cs = part + 512;
    LAS float* red = cs + 128;
    LAS int* es = (LAS int*)(red + 512);
    const int tid = C.tid;
    for (int t = C.bid; t < T; t += C.G) {
        const int b = t / SEQ;
        __syncthreads();
        xs[tid] = bf2f(n2[(size_t)t * 1024 + tid]); xs[tid + 512] = bf2f(n2[(size_t)t * 1024 + 512 + tid]);
        if (tid < 128) es[tid] = pidx[(size_t)t * 128 + tid];
        __syncthreads();
        { const int k = tid >> 2, qd = tid & 3; const float* ur = U + (size_t)es[k] * 1024 + qd * 256; float acc = 0.f;
          for (int d = 0; d < 256; ++d) acc += ur[d] * xs[qd * 256 + d];
          part[tid] = acc; }
        __syncthreads();
        if (tid < 128) { const float dsum = part[tid * 4] + part[tid * 4 + 1] + part[tid * 4 + 2] + part[tid * 4 + 3]; cs[tid] = gelu_f(dsum) * pgate[(size_t)t * 128 + tid]; }
        __syncthreads();
        float o0 = 0.f, o1 = 0.f;
        for (int k = 0; k < 128; ++k) { const float* vr = V + (size_t)es[k] * 1024; const float ck = cs[k]; o0 += ck * vr[tid]; o1 += ck * vr[tid + 512]; }
        const float h0 = h[(size_t)t * 1024 + tid] + mod[b * 6144 + 5120 + tid] * o0, h1 = h[(size_t)t * 1024 + 512 + tid] + mod[b * 6144 + 5120 + 512 + tid] * o1;
        red[tid] = h0 * h0 + h1 * h1;
        __syncthreads();
        for (int sft = 256; sft > 0; sft >>= 1) { if (tid < sft) red[tid] += red[tid + sft]; __syncthreads(); }
        const float rstd = rsqrtf(red[0] * (1.f / 1024.f) + EPS);
        out[(size_t)t * 1024 + tid] = h0 * rstd * fg[tid]; out[(size_t)t * 1024 + 512 + tid] = h1 * rstd * fg[tid + 512];
    }
}

namespace pg8 {
#define PG8_LAS __attribute__((address_space(3)))
typedef unsigned short bf16_t;
typedef short bf16x8 __attribute__((ext_vector_type(8)));
typedef float f32x4 __attribute__((ext_vector_type(4)));
typedef unsigned u32x4 __attribute__((ext_vector_type(4)));
constexpr int BM = 256, BK = 64, HALF = 128, HTB = HALF * BK * 2  , STAGE_BYTES = 8 * HTB, NXCD = 8, WGM = 8;

__host__ __device__ __forceinline__ int lds_byte(int r, int c) { const int st = (r >> 4) * 2 + (c >> 5), rr = r & 15, cc = c & 31, ob = rr * 64 + cc * 2; return st * 1024 + (ob ^ (((ob >> 9) & 1) << 5)); }
__host__ __device__ __forceinline__ void stage_rc(int b, int& R, int& C) { const int st = b / 1024, sb = b % 1024, swz = sb ^ (((sb >> 9) & 1) << 5); R = (st >> 1) * 16 + swz / 64; C = (st & 1) * 32 + (swz % 64) / 2; }
__host__ __device__ __forceinline__ int perm32(int rho) { const int n = rho >> 4, i = rho & 15; return 8 * (i >> 2) + 4 * n + (i & 3); }

struct Unit { int pm, pn, kind; };
struct Gemm { const bf16_t* A; const bf16_t* Bt; int M, N, K; const bf16_t *A1, *B1, *A2, *B2, *A3, *B3; };

struct StaticOrder {
    static constexpr bool MULTI = false;
    int nM, nN, nwg, G, c;
    __host__ __device__ void init(int M, int N, int G_, int c_) { nM = M / BM; nN = N / BM; nwg = nM * nN; G = G_; c = c_; }
    __host__ __device__ bool next(int i, Unit& u) const {
        const long L = (long)i * G + c; if (L >= nwg) return false;
        int wgid = (int)L; { const int q = nwg / NXCD, r = nwg % NXCD, xcd = wgid % NXCD, off = wgid / NXCD; wgid = (xcd < r ? xcd * (q + 1) : r * (q + 1) + (xcd - r) * q) + off; }
        const int nig = WGM * nN, gid = wgid / nig, fm = gid * WGM, gsz = (nM - fm) < WGM ? (nM - fm) : WGM;
        u.pm = fm + ((wgid % nig) % gsz); u.pn = (wgid % nig) / gsz; u.kind = 0; return true;
    }
    __device__ __forceinline__ void a_ready(const Unit&) const {}
    __device__ __forceinline__ void done(const Unit&) const {}
};

struct MultiOrder {
    static constexpr bool MULTI = true;
    StaticOrder b; int nk;
    __host__ __device__ bool next(int i, Unit& u) const { if (!b.next(i / nk, u)) return false; u.kind = i % nk; return true; }
    __device__ __forceinline__ void a_ready(const Unit&) const {}
    __device__ __forceinline__ void done(const Unit&) const {}
};

__device__ __forceinline__ unsigned cvt_pk_bf16(float lo, float hi) { return ::pk2(lo, hi); }
__device__ __forceinline__ float e_silu(float x) { return x / (1.f + __expf(-x)); }
__device__ __forceinline__ float e_sigm(float x) { return 1.f / (1.f + __expf(-x)); }
__device__ __forceinline__ float e_lo(unsigned v) { return __uint_as_float(v << 16); }
__device__ __forceinline__ float e_hi(unsigned v) { return __uint_as_float(v & 0xffff0000u); }
__device__ __forceinline__ u32x4 pack8(const f32x4 v0, const f32x4 v1) { u32x4 w; w.x = cvt_pk_bf16(v0[0], v0[1]); w.y = cvt_pk_bf16(v0[2], v0[3]); w.z = cvt_pk_bf16(v1[0], v1[1]); w.w = cvt_pk_bf16(v1[2], v1[3]); return w; }

struct EpiInProj {
    static constexpr bool PERM = true, AFTER_DRAIN = false;
    bf16_t *sz, *xbc, *q, *k, *v;
    __device__ __forceinline__ void operator()(const f32x4 (&acc)[2][2][4][2], const Unit& u, int wr, int wc, int fr, int fq) const {
        const int pn = u.pn; bf16_t* base; int ldc = 1024, colt, mode = 0;
        if (pn < 4) { base = sz; colt = pn * 256; mode = 1; }
        else if (pn < 12) { base = xbc; ldc = 2048; colt = (pn - 4) * 256; }
        else if (pn < 16) { base = q; colt = (pn - 12) * 256; mode = 2; }
        else if (pn < 20) { base = k; colt = (pn - 16) * 256; }
        else { base = v; colt = (pn - 20) * 256; }
        const int row0 = u.pm * BM + wr * 64 + fr, col0 = colt + wc * 32 + 8 * fq;
#pragma unroll
        for (int ai = 0; ai < 2; ++ai)
#pragma unroll
            for (int m = 0; m < 4; ++m) { bf16_t* rowp = base + (size_t)(row0 + ai * HALF + m * 16) * ldc + col0;
#pragma unroll
                for (int bj = 0; bj < 2; ++bj) { f32x4 v0 = acc[ai][bj][m][0], v1 = acc[ai][bj][m][1];
                    if (mode == 1) {
#pragma unroll
                        for (int i = 0; i < 4; ++i) { v0[i] = e_silu(v0[i]); v1[i] = e_silu(v1[i]); } }
                    else if (mode == 2) { v0 = v0 * 0.125f; v1 = v1 * 0.125f; }
                    *(u32x4*)(rowp + bj * HALF) = pack8(v0, v1); } }
    }
};
struct EpiGate {
    static constexpr bool PERM = true, AFTER_DRAIN = false;
    bf16_t* sg; size_t plane;
    __device__ __forceinline__ void operator()(const f32x4 (&acc)[2][2][4][2], const Unit& u, int wr, int wc, int fr, int fq) const {
        bf16_t* base = sg + (size_t)(u.pn >> 2) * plane; const int colt = (u.pn & 3) * 256;
        const int row0 = u.pm * BM + wr * 64 + fr, col0 = colt + wc * 32 + 8 * fq;
#pragma unroll
        for (int ai = 0; ai < 2; ++ai)
#pragma unroll
            for (int m = 0; m < 4; ++m) { bf16_t* rowp = base + (size_t)(row0 + ai * HALF + m * 16) * 1024 + col0;
#pragma unroll
                for (int bj = 0; bj < 2; ++bj) { f32x4 v0 = acc[ai][bj][m][0], v1 = acc[ai][bj][m][1];
#pragma unroll
                    for (int i = 0; i < 4; ++i) { v0[i] = e_sigm(v0[i]); v1[i] = e_sigm(v1[i]); }
                    *(u32x4*)(rowp + bj * HALF) = pack8(v0, v1); } }
    }
};
struct EpiD1 {
    static constexpr bool PERM = true, AFTER_DRAIN = false;
    bf16_t* p1; const bf16_t* sg1; const float* rstd;
    __device__ __forceinline__ void operator()(const f32x4 (&acc)[2][2][4][2], const Unit& u, int wr, int wc, int fr, int fq) const {
        const int row0 = u.pm * BM + wr * 64 + fr, col0 = u.pn * BM + wc * 32 + 8 * fq;
#pragma unroll
        for (int ai = 0; ai < 2; ++ai)
#pragma unroll
            for (int m = 0; m < 4; ++m) { const int row = row0 + ai * HALF + m * 16; const float rs = rstd[row]; const size_t off = (size_t)row * 1024 + col0;
#pragma unroll
                for (int bj = 0; bj < 2; ++bj) { f32x4 v0 = acc[ai][bj][m][0] * rs, v1 = acc[ai][bj][m][1] * rs;
                    const u32x4 g = *(const u32x4*)(sg1 + off + bj * HALF);
                    v0[0] *= e_lo(g.x); v0[1] *= e_hi(g.x); v0[2] *= e_lo(g.y); v0[3] *= e_hi(g.y); v1[0] *= e_lo(g.z); v1[1] *= e_hi(g.z); v1[2] *= e_lo(g.w); v1[3] *= e_hi(g.w);
                    *(u32x4*)(p1 + off + bj * HALF) = pack8(v0, v1); } }
    }
};
struct EpiD2 {
    static constexpr bool PERM = true, AFTER_DRAIN = false;
    bf16_t* mixed; const bf16_t *p1, *sg2;
    __device__ __forceinline__ void operator()(const f32x4 (&acc)[2][2][4][2], const Unit& u, int wr, int wc, int fr, int fq) const {
        const int row0 = u.pm * BM + wr * 64 + fr, col0 = u.pn * BM + wc * 32 + 8 * fq;
#pragma unroll
        for (int ai = 0; ai < 2; ++ai)
#pragma unroll
            for (int m = 0; m < 4; ++m) { const int row = row0 + ai * HALF + m * 16; const size_t off = (size_t)row * 1024 + col0;
#pragma unroll
                for (int bj = 0; bj < 2; ++bj) { f32x4 v0 = acc[ai][bj][m][0], v1 = acc[ai][bj][m][1];
                    const u32x4 g = *(const u32x4*)(sg2 + off + bj * HALF), p = *(const u32x4*)(p1 + off + bj * HALF);
                    v0[0] = e_lo(p.x) + v0[0] * e_lo(g.x); v0[1] = e_hi(p.x) + v0[1] * e_hi(g.x); v0[2] = e_lo(p.y) + v0[2] * e_lo(g.y); v0[3] = e_hi(p.y) + v0[3] * e_hi(g.y);
                    v1[0] = e_lo(p.z) + v1[0] * e_lo(g.z); v1[1] = e_hi(p.z) + v1[1] * e_hi(g.z); v1[2] = e_lo(p.w) + v1[2] * e_lo(g.w); v1[3] = e_hi(p.w) + v1[3] * e_hi(g.w);
                    *(u32x4*)(mixed + off + bj * HALF) = pack8(v0, v1); } }
    }
};

struct EpiMix {
    static constexpr bool PERM = true, AFTER_DRAIN = false;
    bf16_t *sg1, *sg2, *mixed; const float* rstd;
    __device__ __forceinline__ bool operator()(f32x4 (&acc)[2][2][4][2], const Unit& u, int wr, int wc, int fr, int fq) const {
        const int row0 = u.pm * BM + wr * 64 + fr, col0 = u.pn * BM + wc * 32 + 8 * fq; const int kind = u.kind;
#pragma unroll
        for (int ai = 0; ai < 2; ++ai)
#pragma unroll
            for (int m = 0; m < 4; ++m) { const int row = row0 + ai * HALF + m * 16; const size_t off = (size_t)row * 1024 + col0;
                const float rs = (kind == 2) ? rstd[row] : 1.f;
#pragma unroll
                for (int bj = 0; bj < 2; ++bj) { f32x4 v0 = acc[ai][bj][m][0], v1 = acc[ai][bj][m][1];
                    if (kind < 2) {
#pragma unroll
                        for (int i = 0; i < 4; ++i) { v0[i] = e_sigm(v0[i]); v1[i] = e_sigm(v1[i]); }
                        *(u32x4*)((kind == 0 ? sg1 : sg2) + off + bj * HALF) = pack8(v0, v1);
                    } else if (kind == 2) {
                        const u32x4 a = *(const u32x4*)(sg1 + off + bj * HALF), b = *(const u32x4*)(sg2 + off + bj * HALF);
                        v0[0] *= rs * e_lo(a.x) / fmaxf(e_lo(b.x), 1e-30f); v0[1] *= rs * e_hi(a.x) / fmaxf(e_hi(b.x), 1e-30f); v0[2] *= rs * e_lo(a.y) / fmaxf(e_lo(b.y), 1e-30f); v0[3] *= rs * e_hi(a.y) / fmaxf(e_hi(b.y), 1e-30f);
                        v1[0] *= rs * e_lo(a.z) / fmaxf(e_lo(b.z), 1e-30f); v1[1] *= rs * e_hi(a.z) / fmaxf(e_hi(b.z), 1e-30f); v1[2] *= rs * e_lo(a.w) / fmaxf(e_lo(b.w), 1e-30f); v1[3] *= rs * e_hi(a.w) / fmaxf(e_hi(b.w), 1e-30f);
                        acc[ai][bj][m][0] = v0; acc[ai][bj][m][1] = v1;
                    } else {
                        const u32x4 b = *(const u32x4*)(sg2 + off + bj * HALF);
                        v0[0] *= e_lo(b.x); v0[1] *= e_hi(b.x); v0[2] *= e_lo(b.y); v0[3] *= e_hi(b.y); v1[0] *= e_lo(b.z); v1[1] *= e_hi(b.z); v1[2] *= e_lo(b.w); v1[3] *= e_hi(b.w);
                        *(u32x4*)(mixed + off + bj * HALF) = pack8(v0, v1);
                    } } }
        return kind == 2;
    }
};
struct EpiD3 {
    static constexpr bool PERM = false, AFTER_DRAIN = false;
    float* h; const float* x; const float* mod;
    __device__ __forceinline__ void operator()(const f32x4 (&acc)[2][2][4][2], const Unit& u, int wr, int wc, int fr, int fq) const {
        const int row0 = u.pm * BM + wr * 64 + fr, col0 = u.pn * BM + wc * 32 + 4 * fq;
        const float* g1 = mod + (size_t)((u.pm * BM) >> 12) * 6144 + 2048;
#pragma unroll
        for (int ai = 0; ai < 2; ++ai)
#pragma unroll
            for (int m = 0; m < 4; ++m) { const size_t off = (size_t)(row0 + ai * HALF + m * 16) * 1024 + col0;
#pragma unroll
                for (int bj = 0; bj < 2; ++bj)
#pragma unroll
                    for (int n = 0; n < 2; ++n) { const int c = bj * HALF + n * 16; const f32x4 xv = *(const f32x4*)(x + off + c), gv = *(const f32x4*)(g1 + col0 + c);
                        *(f32x4*)(h + off + c) = xv + gv * acc[ai][bj][m][n]; } }
    }
};
struct EpiQp {
    static constexpr bool PERM = true, AFTER_DRAIN = false;
    bf16_t* qp;
    __device__ __forceinline__ void operator()(const f32x4 (&acc)[2][2][4][2], const Unit& u, int wr, int wc, int fr, int fq) const {
        const int row0 = u.pm * BM + wr * 64 + fr, col0 = u.pn * BM + wc * 32 + 8 * fq;
#pragma unroll
        for (int ai = 0; ai < 2; ++ai)
#pragma unroll
            for (int m = 0; m < 4; ++m) { bf16_t* rowp = qp + (size_t)(row0 + ai * HALF + m * 16) * 2048 + col0;
#pragma unroll
                for (int bj = 0; bj < 2; ++bj) *(u32x4*)(rowp + bj * HALF) = pack8(acc[ai][bj][m][0], acc[ai][bj][m][1]); }
    }
};

template <class Epi, class Sched, bool ALIGN_EPI = false, bool SP2 = false>
__device__ __forceinline__ void gemm_phase(PG8_LAS unsigned char* lds, const Gemm g, const Sched& S, const Epi& E) {
    const int tid = threadIdx.x, wid = __builtin_amdgcn_readfirstlane(tid >> 6), lane = tid & 63, wr = wid >> 2, wc = wid & 3, fr = lane & 15, fq = lane >> 4;
    const int K = g.K, nt = K / BK;
    unsigned voffA[2], voffB[2];
#pragma unroll
    for (int i = 0; i < 2; ++i) { int R, C; stage_rc(tid * 16 + i * 8192, R, C); const int Rb = Epi::PERM ? ((R & ~31) + perm32(R & 31)) : R;
        voffA[i] = (unsigned)(R * K + C) * 2u; voffB[i] = (unsigned)(Rb * K + C) * 2u; }
    const size_t kstep = (size_t)(BK * 2);
    const size_t hstep = (size_t)HALF * K * 2;
    const size_t tstep = 2 * hstep;
    const unsigned ldsw = (unsigned)wid * 1024u;
    const int aoff = lds_byte(wr * 64 + fr, fq * 8), boff = lds_byte(wc * 32 + fr, fq * 8);
#define PG8_SA(b, h) (((b) * 2 + (h)) * HTB)
#define PG8_SB(b, h) ((4 + (b) * 2 + (h)) * HTB)
#define PG8_STAGE(bufoff, gbase, voff) do { _Pragma("unroll") for (int _i = 0; _i < 2; ++_i) \
        __builtin_amdgcn_global_load_lds((const unsigned*)((const char*)(gbase) + (voff)[_i]), (PG8_LAS unsigned*)(lds + (bufoff) + ldsw + _i * 8192), 16, 0, 0); } while (0)
#define PG8_LDA(dst, b, h) do { _Pragma("unroll") for (int m = 0; m < 4; ++m) _Pragma("unroll") for (int k = 0; k < 2; ++k) dst[m][k] = *(const PG8_LAS bf16x8*)(lds + PG8_SA(b, h) + aoff + m * 2048 + k * 1024); } while (0)
#define PG8_LDB(dst, b, h) do { _Pragma("unroll") for (int n = 0; n < 2; ++n) _Pragma("unroll") for (int k = 0; k < 2; ++k) dst[n][k] = *(const PG8_LAS bf16x8*)(lds + PG8_SB(b, h) + boff + n * 2048 + k * 1024); } while (0)
#define PG8_MMA(ai, bj, At, Bt) do { __builtin_amdgcn_s_setprio(1); _Pragma("unroll") for (int m = 0; m < 4; ++m) _Pragma("unroll") for (int n = 0; n < 2; ++n) _Pragma("unroll") for (int k = 0; k < 2; ++k) \
        acc[ai][bj][m][n] = __builtin_amdgcn_mfma_f32_16x16x32_bf16(Bt[n][k], At[m][k], acc[ai][bj][m][n], 0, 0, 0); __builtin_amdgcn_s_setprio(0); } while (0)
#define PG8_WAIT_V(n) asm volatile("s_waitcnt vmcnt(" #n ")" ::: "memory")
#define PG8_WAIT_L(n) asm volatile("s_waitcnt lgkmcnt(" #n ")" ::: "memory")
#define PG8_BAR __builtin_amdgcn_s_barrier()
#define PG8_SCHED __builtin_amdgcn_sched_barrier(0)
    Unit cur, nxt; int ui = 0;
    if (!S.next(0, cur)) return;
    f32x4 acc[2][2][4][2];
#pragma unroll
    for (int a = 0; a < 2; ++a)
#pragma unroll
        for (int b = 0; b < 2; ++b)
#pragma unroll
            for (int m = 0; m < 4; ++m)
#pragma unroll
                for (int n = 0; n < 2; ++n) acc[a][b][m][n] = (f32x4){0.f, 0.f, 0.f, 0.f};
    bf16x8 At[4][2], B0[2][2], B1[2][2];
#define PG8_AB(u_) (Sched::MULTI ? (const char*)((u_).kind == 0 ? g.A : (u_).kind == 1 ? g.A1 : (u_).kind == 2 ? g.A2 : g.A3) : (const char*)g.A)
#define PG8_BB(u_) (Sched::MULTI ? (const char*)((u_).kind == 0 ? g.Bt : (u_).kind == 1 ? g.B1 : (u_).kind == 2 ? g.B2 : g.B3) : (const char*)g.Bt)
    const char* cA = PG8_AB(cur) + (size_t)cur.pm * tstep; const char* cB = PG8_BB(cur) + (size_t)cur.pn * tstep;
    S.a_ready(cur);
    if constexpr (SP2) {
        PG8_STAGE(PG8_SB(0, 0), cB, voffB); PG8_STAGE(PG8_SB(0, 1), cB + hstep, voffB); PG8_STAGE(PG8_SA(0, 0), cA, voffA); PG8_STAGE(PG8_SA(0, 1), cA + hstep, voffA);
        if (wr == 1) PG8_BAR;
        PG8_WAIT_V(2); PG8_BAR;
        PG8_STAGE(PG8_SB(1, 0), cB + kstep, voffB); PG8_STAGE(PG8_SA(1, 0), cA + kstep, voffA); PG8_STAGE(PG8_SB(1, 1), cB + hstep + kstep, voffB);
        PG8_WAIT_V(6); PG8_BAR;
    } else {
        PG8_STAGE(PG8_SB(0, 0), cB, voffB); PG8_STAGE(PG8_SA(0, 0), cA, voffA); PG8_STAGE(PG8_SB(0, 1), cB + hstep, voffB); PG8_STAGE(PG8_SA(0, 1), cA + hstep, voffA);
        if (wr == 1) PG8_BAR;
        PG8_WAIT_V(4); PG8_BAR;
        PG8_STAGE(PG8_SB(1, 0), cB + kstep, voffB); PG8_STAGE(PG8_SA(1, 0), cA + kstep, voffA); PG8_STAGE(PG8_SB(1, 1), cB + hstep + kstep, voffB);
        PG8_WAIT_V(6); PG8_BAR;
    }
    for (;;) {
        const bool has_next = S.next(ui + 1, nxt);
        const char* nA = has_next ? PG8_AB(nxt) + (size_t)nxt.pm * tstep : cA; const char* nB = has_next ? PG8_BB(nxt) + (size_t)nxt.pn * tstep : cB;
        for (int t = 0; t < nt; t += 2) {
            const bool last = (t == nt - 2);
            const char* a1 = cA + (size_t)(t + 1) * kstep;
            const char* a2 = last ? nA : cA + (size_t)(t + 2) * kstep; const char* b2 = last ? nB : cB + (size_t)(t + 2) * kstep;
            const char* a3 = a2 + kstep; const char* b3 = b2 + kstep;
            if (last && has_next) S.a_ready(nxt);
            if constexpr (SP2) {
            PG8_LDB(B0, 0, 0); PG8_LDB(B1, 0, 1); PG8_SCHED; PG8_LDA(At, 0, 0); PG8_STAGE(PG8_SA(1, 1), a1 + hstep, voffA);
            PG8_WAIT_V(8); PG8_WAIT_L(0); PG8_BAR; PG8_MMA(0, 0, At, B0); PG8_MMA(0, 1, At, B1); PG8_BAR; PG8_SCHED;
            PG8_LDA(At, 0, 1); PG8_STAGE(PG8_SB(0, 0), b2, voffB); PG8_STAGE(PG8_SB(0, 1), b2 + hstep, voffB); PG8_STAGE(PG8_SA(0, 0), a2, voffA);
            PG8_WAIT_V(8); PG8_WAIT_L(0); PG8_BAR; PG8_MMA(1, 0, At, B0); PG8_MMA(1, 1, At, B1); PG8_BAR; PG8_SCHED;
            PG8_LDB(B0, 1, 0); PG8_LDB(B1, 1, 1); PG8_SCHED; PG8_LDA(At, 1, 0); PG8_STAGE(PG8_SA(0, 1), a2 + hstep, voffA);
            PG8_WAIT_V(8); PG8_WAIT_L(0); PG8_BAR; PG8_MMA(0, 0, At, B0); PG8_MMA(0, 1, At, B1); PG8_BAR; PG8_SCHED;
            PG8_LDA(At, 1, 1); PG8_STAGE(PG8_SB(1, 0), b3, voffB); PG8_STAGE(PG8_SB(1, 1), b3 + hstep, voffB); PG8_STAGE(PG8_SA(1, 0), a3, voffA);
            PG8_WAIT_V(8); PG8_WAIT_L(0); PG8_BAR; PG8_MMA(1, 0, At, B0); PG8_MMA(1, 1, At, B1); PG8_BAR; PG8_SCHED;
            } else {
            PG8_LDB(B0, 0, 0); PG8_SCHED; PG8_LDA(At, 0, 0); PG8_STAGE(PG8_SA(1, 1), a1 + hstep, voffA);
            PG8_WAIT_L(8); PG8_BAR; PG8_WAIT_L(0); PG8_MMA(0, 0, At, B0); PG8_BAR; PG8_SCHED;
            PG8_LDB(B1, 0, 1); PG8_STAGE(PG8_SB(0, 0), b2, voffB);
            PG8_BAR; PG8_WAIT_L(0); PG8_MMA(0, 1, At, B1); PG8_BAR;
            PG8_LDA(At, 0, 1); PG8_STAGE(PG8_SA(0, 0), a2, voffA);
            PG8_BAR; PG8_WAIT_L(0); PG8_MMA(1, 0, At, B0); PG8_BAR; PG8_SCHED;
            PG8_STAGE(PG8_SB(0, 1), b2 + hstep, voffB);
            PG8_WAIT_V(6); PG8_BAR; PG8_MMA(1, 1, At, B1); PG8_BAR;
            PG8_LDB(B0, 1, 0); PG8_SCHED; PG8_LDA(At, 1, 0); PG8_STAGE(PG8_SA(0, 1), a2 + hstep, voffA);
            PG8_WAIT_L(8); PG8_BAR; PG8_WAIT_L(0); PG8_MMA(0, 0, At, B0); PG8_BAR; PG8_SCHED;
            PG8_LDB(B1, 1, 1); PG8_STAGE(PG8_SB(1, 0), b3, voffB);
            PG8_BAR; PG8_WAIT_L(0); PG8_MMA(0, 1, At, B1); PG8_BAR;
            PG8_LDA(At, 1, 1); PG8_STAGE(PG8_SA(1, 0), a3, voffA);
            PG8_BAR; PG8_WAIT_L(0); PG8_MMA(1, 0, At, B0); PG8_BAR; PG8_SCHED;
            PG8_STAGE(PG8_SB(1, 1), b3 + hstep, voffB);
            PG8_WAIT_V(6); PG8_BAR; PG8_MMA(1, 1, At, B1); PG8_BAR;
            }
        }
        if constexpr (ALIGN_EPI) { if (wr == 0) PG8_BAR; }
        bool keep_acc = false;
        if constexpr (!Epi::AFTER_DRAIN) { if constexpr (Sched::MULTI) keep_acc = E(acc, cur, wr, wc, fr, fq); else E(acc, cur, wr, wc, fr, fq); S.done(cur); }
        if (!has_next) break;
        if (!keep_acc) {
#pragma unroll
        for (int a = 0; a < 2; ++a)
#pragma unroll
            for (int b = 0; b < 2; ++b)
#pragma unroll
                for (int m = 0; m < 4; ++m)
#pragma unroll
                    for (int n = 0; n < 2; ++n) acc[a][b][m][n] = (f32x4){0.f, 0.f, 0.f, 0.f};
        }
        cur = nxt; cA = nA; cB = nB; ++ui;
        if constexpr (ALIGN_EPI) { if (wr == 1) PG8_BAR; }
    }
    PG8_WAIT_V(0);
    if constexpr (!ALIGN_EPI) { if (wr == 0) PG8_BAR; }
    PG8_BAR;
    if constexpr (Epi::AFTER_DRAIN) { E.fused(acc, cur, wr, wc, fr, fq, lds, wid, lane); S.done(cur); }
#undef PG8_AB
#undef PG8_BB
#undef PG8_SA
#undef PG8_SB
#undef PG8_STAGE
#undef PG8_LDA
#undef PG8_LDB
#undef PG8_MMA
#undef PG8_WAIT_V
#undef PG8_WAIT_L
#undef PG8_BAR
#undef PG8_SCHED
}
}


__device__ __forceinline__ void p_diag_cmp(const Ctx& C, const bf16_t* a, const bf16_t* b, size_t n, unsigned* res) {
    const size_t gt = (size_t)C.bid * NTHR + C.tid, NT = (size_t)C.G * NTHR;
    float md = 0.f, mr = 0.f;
    for (size_t i = gt; i < n; i += NT) { const float x = bf2f(a[i]), y = bf2f(b[i]); const float d = x - y; md += (d == d ? d * d : 1e30f); mr += x * x; }
#pragma unroll
    for (int o = 1; o < 64; o <<= 1) { md += __shfl_xor(md, o); mr += __shfl_xor(mr, o); }
    if (C.lane == 0) { atomicAdd((float*)res, md); atomicAdd((float*)res + 1, mr); }
}
__device__ __forceinline__ void p_diag_out(const Ctx& C, const unsigned* res, float* out) {
    const size_t gt = (size_t)C.bid * NTHR + C.tid, NT = (size_t)C.G * NTHR;
    for (size_t i = gt; i < (size_t)T * 1024; i += NT) out[i] = 0.f;
    __syncthreads();
    if (C.bid == 0 && C.tid == 0) { const float md = __uint_as_float(res[0]), mr = __uint_as_float(res[1]); const float rel = sqrtf(md / fmaxf(mr, 1e-30f));
        out[0] = 1.0e4f * (13.f + log10f(rel + 1e-12f)); }
}

#define GAS __attribute__((address_space(1)))
typedef GAS unsigned gu32;
#define RLX_AGENT __ATOMIC_RELAXED, __HIP_MEMORY_SCOPE_AGENT
#define XB_TMO      128
#define XB_XCNT(j)  (256  + 64 * (j))
#define XB_XSUB(j)  (1280 + 64 * (j))
#define XB_XGEN(j)  (2304 + 64 * (j))
#define XB_TOP      3328
#define XB_TOPGEN   3392
#define XCD_BAR_WORDS 3456
#define XB_SPIN_CAP (1u << 18)

__device__ __forceinline__ unsigned xb_ld(unsigned* p)              { return __hip_atomic_load(p, __ATOMIC_RELAXED, __HIP_MEMORY_SCOPE_AGENT); }
__device__ __forceinline__ unsigned xb_add(unsigned* p, unsigned v) { return __hip_atomic_fetch_add(p, v, __ATOMIC_RELAXED, __HIP_MEMORY_SCOPE_AGENT); }
__device__ __forceinline__ unsigned xb_xcc_id() { return (unsigned)__builtin_amdgcn_s_getreg((3 << 11) | 20) & 0xFu; }
#define XB_SPIN(cond, bar) do { unsigned _sp = 0; while (cond) { __builtin_amdgcn_s_sleep(1); \
    if ((++_sp & 255u) == 0u) { if (xb_ld(&(bar)[XB_TMO])) break; if (_sp > XB_SPIN_CAP) { atomicAdd(&(bar)[XB_TMO], 1u); break; } } } } while (0)

struct XcdBarrier {
    unsigned* bar; unsigned x;
    volatile LAS unsigned* st;
};

__device__ __forceinline__ XcdBarrier xcd_barrier_post(unsigned* bar, volatile LAS unsigned* st) {
    XcdBarrier b; b.bar = bar; b.x = xb_xcc_id(); b.st = st;
    if (threadIdx.x == 0) (void)xb_add(&bar[XB_XCNT(b.x)], 1u);
    return b;
}
__device__ __forceinline__ void xcd_barrier_complete(unsigned* bar, unsigned x, unsigned& nloc, unsigned& nx) {
    const unsigned G = gridDim.x * gridDim.y * gridDim.z;
    unsigned sum, cnt, mine, sp = 0u;
    for (;;) {
        sum = 0u; cnt = 0u; mine = 0u;
#pragma unroll
        for (unsigned j = 0; j < 16; ++j) { const unsigned c = xb_ld(&bar[XB_XCNT(j)]); sum += c; cnt += (c > 0u) ? 1u : 0u; mine = (j == x) ? c : mine; }
        if (sum == G) break;
        __builtin_amdgcn_s_sleep(1);
        if ((++sp & 255u) == 0u) { if (xb_ld(&bar[XB_TMO])) break; if (sp > XB_SPIN_CAP) { atomicAdd(&bar[XB_TMO], 1u); break; } }
    }
    nloc = mine > 0u ? mine : 1u; nx = cnt > 0u ? cnt : 1u;
}

__device__ __forceinline__ void xcd_barrier(const XcdBarrier& b) {
    asm volatile("s_waitcnt vmcnt(0)" ::: "memory");
    __syncthreads();
    if (threadIdx.x == 0) {
        unsigned* bar = b.bar;
        __builtin_amdgcn_s_waitcnt(0);
        unsigned nloc = b.st[0], nx = b.st[1];
        if (nloc == 0u) { xcd_barrier_complete(bar, b.x, nloc, nx); b.st[0] = nloc; b.st[1] = nx; }
        const unsigned old = xb_add(&bar[XB_XSUB(b.x)], 1u);
        const unsigned gen = old / nloc;
        if (old + 1u == (gen + 1u) * nloc) {
            __builtin_amdgcn_fence(__ATOMIC_RELEASE, "agent");
            asm volatile("s_waitcnt vmcnt(0)" ::: "memory");
            const unsigned og = xb_add(&bar[XB_TOP], 1u);
            const unsigned tg = og / nx;
            if (og + 1u == (tg + 1u) * nx) xb_add(&bar[XB_TOPGEN], 1u);
            else XB_SPIN(xb_ld(&bar[XB_TOPGEN]) == tg, bar);
            __builtin_amdgcn_fence(__ATOMIC_ACQUIRE, "agent");
            xb_add(&bar[XB_XGEN(b.x)], 1u);
            asm volatile("s_waitcnt vmcnt(0)" ::: "memory");
        } else {
            XB_SPIN(xb_ld(&bar[XB_XGEN(b.x)]) == gen, bar);
            __builtin_amdgcn_fence(__ATOMIC_ACQUIRE, "agent");
            asm volatile("s_waitcnt vmcnt(0)" ::: "memory");
        }
    }
    __syncthreads();
}


constexpr int N_PHASES = 15;
constexpr int CW_BAR = 4096;
constexpr size_t CTL_ZERO_BYTES = 64 * 1024;
constexpr int MISC_OFF = LDS_BYTES - 256;

template <int PH>
__device__ __forceinline__ void run_phase(const Ctx& C, const Args& a) {
    bf16_t* R0 = C.bfp(WS_R0); bf16_t* R1 = C.bfp(WS_R1); bf16_t* R2 = C.bfp(WS_R2); bf16_t* R3 = C.bfp(WS_R3);
    bf16_t* OB = (bf16_t*)a.out;
    const size_t TD = (size_t)T * 1024;
    if constexpr (PH == 0) p_prep(C);
    if constexpr (PH == 1) p_rownorm(C, C.in[0], C.in[4], 0, 1024, R0);
    if constexpr (PH == 2) {
        { pg8::Gemm g{R0, C.bfp(WS_WIN_T), T, 6144, 1024}; pg8::StaticOrder S; S.init(T, 6144, C.G, C.bid);
          pg8::EpiInProj e{R1, R2, R3, R3 + TD, R3 + 2 * TD};
          pg8::gemm_phase<pg8::EpiInProj, pg8::StaticOrder, true, true>(C.lds, g, S, e); }
        p_dt(C, R0, C.bfp(WS_WDT_T), C.f32p(WS_DT));
    }
    if constexpr (PH == 3) { p_conv(C, R2, OB); p_na(C, R3, R3 + TD, R3 + 2 * TD); }
    if constexpr (PH == 4) p_ssd(C, OB, C.f32p(WS_DT), R2, R2 + TD);
    if constexpr (PH == 5) p_combine(C, R2, R2 + TD, R1, C.f32p(WS_RSTD));
    if constexpr (PH == 6) {
        pg8::MultiOrder S; S.b.init(T, 1024, C.G, C.bid); S.nk = 4;
        pg8::Gemm g{R0, C.bfp(WS_WG_T), T, 1024, 1024, R0, C.bfp(WS_WG_T) + (size_t)1024 * 1024, R1, C.bfp(WS_WSSD_T), R3, C.bfp(WS_WNA_T)};
        pg8::EpiMix e{OB, OB + TD, R2 + TD, C.f32p(WS_RSTD)};
        pg8::gemm_phase<pg8::EpiMix, pg8::MultiOrder, true, true>(C.lds, g, S, e);
    }
    if constexpr (PH == 7) { pg8::Gemm g{R2 + TD, C.bfp(WS_WOUT_T), T, 1024, 1024}; pg8::StaticOrder S; S.init(T, 1024, C.G, C.bid);
        pg8::EpiD3 e{(float*)(R3 + TD), C.in[0], C.f32p(WS_MOD)}; pg8::gemm_phase<pg8::EpiD3, pg8::StaticOrder, true, true>(C.lds, g, S, e); }
    if constexpr (PH == 8) { p_rownorm(C, (const float*)(R3 + TD), C.in[18], 3072, 4096, R0); p_cvt_tables8(C, (unsigned char*)R2, (unsigned char*)R2 + (size_t)16384 * 1024); }
    if constexpr (PH == 9) { pg8::Gemm g{R0, C.bfp(WS_WPQ_T), T, 2048, 1024}; pg8::StaticOrder S; S.init(T, 2048, C.G, C.bid);
        pg8::EpiQp e{OB}; pg8::gemm_phase<pg8::EpiQp, pg8::StaticOrder, true, true>(C.lds, g, S, e); }
    if constexpr (PH == 10) p_topk(C, OB, C.bfp(WS_KEYS), (unsigned short*)R1, (float*)(R1 + 4 * MiB));
    if constexpr (PH == 11) p_gu(C, R0, (const unsigned short*)R1, (const unsigned char*)R2, a.out);
    if constexpr (PH == 12) p_gc(C, a.out, (const float*)(R1 + 4 * MiB), (float*)((unsigned char*)R2 + 32 * MiB));
    if constexpr (PH == 13) p_gv(C, (const float*)((unsigned char*)R2 + 32 * MiB), (const unsigned short*)R1, (const unsigned char*)R2 + (size_t)16384 * 1024, R3);
    if constexpr (PH == 14) p_gf(C, (const float*)(R3 + TD), R3, a.out);
}

template <int PH> struct PhaseLoop {
    static __device__ __forceinline__ void run(const Ctx& C, const Args& a, const XcdBarrier& bar) {
        if (PH >= a.ph_lo && PH < a.ph_hi) { run_phase<PH>(C, a);
#ifdef REP_PHASE
            if (PH == REP_PHASE) { xcd_barrier(bar); run_phase<PH>(C, a); }
#endif
            if (PH + 1 < a.ph_hi) xcd_barrier(bar); }
        PhaseLoop<PH + 1>::run(C, a, bar);
    }
};
template <> struct PhaseLoop<N_PHASES> { static __device__ __forceinline__ void run(const Ctx&, const Args&, const XcdBarrier&) {} };

__global__ void __launch_bounds__(NTHR, 2) mega(Args a) {
    extern __shared__ __attribute__((aligned(16))) unsigned char lds_raw[];
    Ctx C; C.in = a.in; C.out = a.out; C.ws = a.ws; C.tid = threadIdx.x; C.lane = C.tid & 63; C.wave = __builtin_amdgcn_readfirstlane(C.tid >> 6);
    C.G = gridDim.x; C.bid = blockIdx.x; C.lds = (LAS unsigned char*)lds_raw;
    volatile LAS unsigned* MISC = (volatile LAS unsigned*)(C.lds + MISC_OFF);
    if (C.tid < 64) MISC[C.tid] = 0u;
    __syncthreads();
    XcdBarrier bar; bar.bar = (unsigned*)(a.ws + WS_CTL) + CW_BAR; bar.x = 0; bar.st = nullptr;
    if (a.ph_hi - a.ph_lo > 1) bar = xcd_barrier_post((unsigned*)(a.ws + WS_CTL) + CW_BAR, MISC + 8);
    PhaseLoop<0>::run(C, a, bar);
}

extern "C" void kernel_launch(void* const* d_in, const int* in_sizes, int n_in, void* d_out, int out_size, void* d_ws, size_t ws_size, hipStream_t stream) {
    static int grid = 0;
    if (grid == 0) {
        if (n_in != 24 || out_size != T * D || ws_size < WS_END) { fprintf(stderr, "kernel_launch: unexpected shapes n_in %d out %d ws %zu\n", n_in, out_size, ws_size); grid = -1; return; }
        int dev = 0, cus = 0;
        if (hipGetDevice(&dev) != hipSuccess || hipDeviceGetAttribute(&cus, hipDeviceAttributeMultiprocessorCount, dev) != hipSuccess) { grid = -1; return; }
        if (hipFuncSetAttribute((const void*)mega, hipFuncAttributeMaxDynamicSharedMemorySize, LDS_BYTES) != hipSuccess) { grid = -1; return; }
        grid = cus;
    }
    if (grid < 0) return;
    (void)hipMemsetAsync((char*)d_ws + WS_CTL, 0, CTL_ZERO_BYTES, stream);
    Args a{};
    for (int i = 0; i < 24; ++i) a.in[i] = (const float*)d_in[i];
    a.out = (float*)d_out; a.ws = (unsigned char*)d_ws;
    a.ph_lo = 0; a.ph_hi = N_PHASES;
    hipLaunchKernelGGL(mega, dim3(grid), dim3(NTHR), LDS_BYTES, stream, a);
}
```

```cpp
#include <hip/hip_runtime.h>
#include <cstdio>
#include <cstdint>

#define LAS __attribute__((address_space(3)))
typedef unsigned short bf16_t;
typedef float f32x4 __attribute__((ext_vector_type(4)));
typedef unsigned u32x4 __attribute__((ext_vector_type(4)));
typedef unsigned u32x2 __attribute__((ext_vector_type(2)));
typedef __bf16 bf16x2_t __attribute__((ext_vector_type(2)));

constexpr int T = 32768, D = 1024, NB = 8, SEQ = 4096;
constexpr int NWAVES = 8, NTHR = 512;
constexpr float EPS = 1e-6f;
constexpr int OFF_Z = 0, OFF_XBC = 1024, OFF_DTF = 3072, OFF_DTB = 3088, OFF_QKV = 3104, OFF_GS = 6176, OFF_GN = 7200, D_IN = 8224;

constexpr size_t MiB = 1u << 20;
constexpr size_t WS_CTL = 0;
constexpr size_t WS_MOD = 1 * MiB;
constexpr size_t WS_RSTD = 1 * MiB + 512 * 1024;
constexpr size_t WS_DT = 2 * MiB;
constexpr size_t WS_WIN_T = 6 * MiB;
constexpr size_t WS_WG_T = 18 * MiB;
constexpr size_t WS_WDT_T = 22 * MiB;
constexpr size_t WS_KEYS = 22 * MiB + 512 * 1024;
constexpr size_t WS_WSSD_T = 23 * MiB, WS_WNA_T = 25 * MiB, WS_WOUT_T = 27 * MiB, WS_WPQ_T = 29 * MiB;
constexpr size_t WS_R0 = 40 * MiB, WS_R1 = 104 * MiB, WS_R2 = 168 * MiB, WS_R3 = 296 * MiB, WS_END = 488 * MiB;

constexpr int LDS_BYTES = 163840;

struct Args { const float* in[24]; float* out; unsigned char* ws; int ph_lo, ph_hi; };

__device__ __forceinline__ float bf2f(unsigned v) { return __uint_as_float(v << 16); }
__device__ __forceinline__ float bflo(unsigned v) { return __uint_as_float(v << 16); }
__device__ __forceinline__ float bfhi(unsigned v) { return __uint_as_float(v & 0xffff0000u); }
__device__ __forceinline__ unsigned f2bf(float f) { unsigned u = __float_as_uint(f); return (u + 0x7fffu + ((u >> 16) & 1u)) >> 16; }
typedef float f32x2_t __attribute__((ext_vector_type(2)));
__device__ __forceinline__ unsigned pk2(float lo, float hi) { f32x2_t v = {lo, hi}; bf16x2_t b = __builtin_convertvector(v, bf16x2_t); return __builtin_bit_cast(unsigned, b); }
__device__ __forceinline__ float wave_sum(float v) {
#pragma unroll
    for (int o = 1; o < 64; o <<= 1) v += __shfl_xor(v, o);
    return v;
}
__device__ __forceinline__ float silu_f(float x) { return x / (1.f + __expf(-x)); }
__device__ __forceinline__ float sigmoid_f(float x) { return 1.f / (1.f + __expf(-x)); }
__device__ __forceinline__ float softplus_f(float x) { return x > 20.f ? x : log1pf(__expf(x)); }
__device__ __forceinline__ float gelu_f(float x) { return 0.5f * x * (1.f + erff(x * 0.70710678118654752f)); }

struct Ctx {
    const float* const* in; float* out; unsigned char* ws;
    int tid, lane, wave, G, bid;
    LAS unsigned char* lds;
    __device__ __forceinline__ float* f32p(size_t off) const { return (float*)(ws + off); }
    __device__ __forceinline__ bf16_t* bfp(size_t off) const { return (bf16_t*)(ws + off); }
};

__device__ __forceinline__ void tr_item(const float* W, int ldw, int col0, int K, bf16_t* WT, int row_off, LAS float* scr, int item, int nblk, int lane, const float* kscale) {
    const int kb = item / nblk, nb = item % nblk, k0 = 64 * kb, n0 = 32 * nb;
#pragma unroll 8
    for (int i = 0; i < 32; ++i) { const int kk = 2 * i + (lane >> 5); float x = W[(size_t)(k0 + kk) * ldw + col0 + n0 + (lane & 31)]; if (kscale) x *= kscale[k0 + kk]; scr[kk * 33 + (lane & 31)] = x; }
    asm volatile("s_waitcnt lgkmcnt(0)" ::: "memory");
    const int c = lane & 7;
#pragma unroll
    for (int j = 0; j < 4; ++j) { const int n = (lane >> 3) + 8 * j; const LAS float* sp = scr + (8 * c) * 33 + n;
        u32x4 o; o.x = pk2(sp[0 * 33], sp[1 * 33]); o.y = pk2(sp[2 * 33], sp[3 * 33]); o.z = pk2(sp[4 * 33], sp[5 * 33]); o.w = pk2(sp[6 * 33], sp[7 * 33]);
        *(u32x4*)(WT + (size_t)(row_off + n0 + n) * K + k0 + 8 * c) = o; }
    asm volatile("s_waitcnt lgkmcnt(0)" ::: "memory");
}
__device__ __forceinline__ void p_prep(const Ctx& C) {
    const float* c = C.in[1]; const float* w_ada = C.in[2]; const float* b_ada = C.in[3];
    float* mod = C.f32p(WS_MOD);
    LAS float* sc = (LAS float*)C.lds;
    LAS float* red = sc + 8192;
    for (int i = C.tid; i < 8192; i += NTHR) sc[i] = silu_f(c[i]);
    __syncthreads();
    for (int jb = C.bid; jb < 256; jb += C.G) {
        const int j0 = jb * 24, jl = C.tid % 24, kq = C.tid / 24;
        if (C.tid < 504) { float acc[8];
#pragma unroll
            for (int b = 0; b < 8; ++b) acc[b] = 0.f;
            for (int k = kq; k < 1024; k += 21) { const float w = w_ada[(size_t)k * 6144 + j0 + jl];
#pragma unroll
                for (int b = 0; b < 8; ++b) acc[b] += sc[b * 1024 + k] * w; }
#pragma unroll
            for (int b = 0; b < 8; ++b) red[(kq * 24 + jl) * 8 + b] = acc[b]; }
        __syncthreads();
        if (C.tid < 192) { const int jl2 = C.tid % 24, b2 = C.tid / 24; float sacc = b_ada[j0 + jl2];
            for (int kq2 = 0; kq2 < 21; ++kq2) sacc += red[(kq2 * 24 + jl2) * 8 + b2];
            mod[b2 * 6144 + j0 + jl2] = sacc; }
        __syncthreads();
    }
    LAS float* scr = (LAS float*)(C.lds + 65536 + C.wave * 8448);
    const int gw = C.bid * NWAVES + C.wave, NGW = C.G * NWAVES;
    const float* w_in = C.in[5];
    constexpr int I_A = 16 * 96, I_B = 16 * 96, I_G = 16 * 64, I_DT = 16, I_S = 16 * 32, I_PQ = 16 * 64;
    constexpr int NIT = I_A + I_B + I_G + I_DT + 3 * I_S + I_PQ;
    for (int it = gw; it < NIT; it += NGW) {
        int r = it;
        if (r < I_A) { tr_item(w_in, D_IN, 0, D, C.bfp(WS_WIN_T), 0, scr, r, 96, C.lane, nullptr); continue; } r -= I_A;
        if (r < I_B) { tr_item(w_in, D_IN, OFF_QKV, D, C.bfp(WS_WIN_T), 3072, scr, r, 96, C.lane, nullptr); continue; } r -= I_B;
        if (r < I_G) { tr_item(w_in, D_IN, OFF_GS, D, C.bfp(WS_WG_T), 0, scr, r, 64, C.lane, nullptr); continue; } r -= I_G;
        if (r < I_DT) { tr_item(w_in, D_IN, OFF_DTF, D, C.bfp(WS_WDT_T), 0, scr, r, 1, C.lane, nullptr); continue; } r -= I_DT;
        if (r < I_S) { tr_item(C.in[14], D, 0, D, C.bfp(WS_WSSD_T), 0, scr, r, 32, C.lane, C.in[13]); continue; } r -= I_S;
        if (r < I_S) { tr_item(C.in[16], D, 0, D, C.bfp(WS_WNA_T), 0, scr, r, 32, C.lane, nullptr); continue; } r -= I_S;
        if (r < I_S) { tr_item(C.in[17], D, 0, D, C.bfp(WS_WOUT_T), 0, scr, r, 32, C.lane, nullptr); continue; } r -= I_S;
        tr_item(C.in[19], 2048, 0, D, C.bfp(WS_WPQ_T), 0, scr, r, 64, C.lane, nullptr);
    }
    { const int gt = C.bid * NTHR + C.tid, NT = C.G * NTHR; const float* kf = C.in[20]; bf16_t* kb = C.bfp(WS_KEYS);
      for (int i = gt; i < 2 * 128 * 128; i += NT) kb[i] = (bf16_t)f2bf(kf[i]); }
    __syncthreads();
}

__device__ __forceinline__ void p_rownorm(const Ctx& C, const float* X, const float* gamma, int sh_off, int sc_off, bf16_t* dst) {
    const float* mod = C.f32p(WS_MOD);
    const int gw = C.bid * NWAVES + C.wave, NGW = C.G * NWAVES;
    for (int row = gw; row < T; row += NGW) {
        const int b = row / SEQ;
        const f32x4* xr = (const f32x4*)(X + (size_t)row * D) + C.lane;
        f32x4 v[4]; float s = 0.f;
#pragma unroll
        for (int j = 0; j < 4; ++j) { v[j] = xr[64 * j]; s += (v[j].x * v[j].x + v[j].y * v[j].y) + (v[j].z * v[j].z + v[j].w * v[j].w); }
        const float rstd = rsqrtf(wave_sum(s) * (1.f / D) + EPS);
        u32x2* o8 = (u32x2*)(dst + (size_t)row * D) + C.lane;
#pragma unroll
        for (int j = 0; j < 4; ++j) {
            const int col = 4 * C.lane + 256 * j;
            const f32x4 g = *(const f32x4*)(gamma + col), sh = *(const f32x4*)(mod + b * 6144 + sh_off + col), sc = *(const f32x4*)(mod + b * 6144 + sc_off + col);
            f32x4 y = v[j] * rstd * g * (sc + 1.f) + sh;
            u32x2 w; w.x = pk2(y.x, y.y); w.y = pk2(y.z, y.w); o8[64 * j] = w;
        }
    }
}


__device__ __forceinline__ void p_rownorm_b(const Ctx& C, const bf16_t* X, const float* gamma, int sh_off, int sc_off, bf16_t* dst) {
    const float* mod = C.f32p(WS_MOD);
    const int gw = C.bid * NWAVES + C.wave, NGW = C.G * NWAVES;
    for (int row = gw; row < T; row += NGW) {
        const int b = row / SEQ;
        f32x4 v[4]; float s = 0.f;
#pragma unroll
        for (int j = 0; j < 4; ++j) { const u32x2 w = *((const u32x2*)(X + (size_t)row * D) + C.lane + 64 * j); v[j].x = bflo(w.x); v[j].y = bfhi(w.x); v[j].z = bflo(w.y); v[j].w = bfhi(w.y);
            s += (v[j].x * v[j].x + v[j].y * v[j].y) + (v[j].z * v[j].z + v[j].w * v[j].w); }
        const float rstd = rsqrtf(wave_sum(s) * (1.f / D) + EPS);
        u32x2* o8 = (u32x2*)(dst + (size_t)row * D) + C.lane;
#pragma unroll
        for (int j = 0; j < 4; ++j) {
            const int col = 4 * C.lane + 256 * j;
            const f32x4 g = *(const f32x4*)(gamma + col), sh = *(const f32x4*)(mod + b * 6144 + sh_off + col), sc = *(const f32x4*)(mod + b * 6144 + sc_off + col);
            f32x4 y = v[j] * rstd * g * (sc + 1.f) + sh;
            u32x2 w; w.x = pk2(y.x, y.y); w.y = pk2(y.z, y.w); o8[64 * j] = w;
        }
    }
}

template <class Epi>
__device__ __forceinline__ void naive_gemm(const Ctx& C, const bf16_t* A, const bf16_t* Bt, int M, int N, int K, const Epi& E) {
    LAS float* As = (LAS float*)C.lds;
    LAS float* Bs = (LAS float*)(C.lds + 32 * 132 * 4);
    const int tilesN = (N + 63) / 64, tilesM = M / 128, ntiles = tilesM * tilesN;
    const int ty = C.tid >> 4, tx = C.tid & 15;
    for (int tile = C.bid; tile < ntiles; tile += C.G) {
        const int tm = tile / tilesN, tn = tile % tilesN, m0 = tm * 128, n0 = tn * 64;
        float acc[4][4];
#pragma unroll
        for (int i = 0; i < 4; ++i)
#pragma unroll
            for (int j = 0; j < 4; ++j) acc[i][j] = 0.f;
        for (int k0 = 0; k0 < K; k0 += 32) {
            __syncthreads();
            {
                const int r = C.tid >> 2, kc = (C.tid & 3) * 8;
                const u32x4 v = *(const u32x4*)(A + (size_t)(m0 + r) * K + k0 + kc);
                As[(kc + 0) * 132 + r] = bflo(v.x); As[(kc + 1) * 132 + r] = bfhi(v.x); As[(kc + 2) * 132 + r] = bflo(v.y); As[(kc + 3) * 132 + r] = bfhi(v.y);
                As[(kc + 4) * 132 + r] = bflo(v.z); As[(kc + 5) * 132 + r] = bfhi(v.z); As[(kc + 6) * 132 + r] = bflo(v.w); As[(kc + 7) * 132 + r] = bfhi(v.w);
            }
            if (C.tid < 256) {
                const int r = C.tid >> 2, kc = (C.tid & 3) * 8;
                u32x4 v = (u32x4){0u, 0u, 0u, 0u};
                if (n0 + r < N) v = *(const u32x4*)(Bt + (size_t)(n0 + r) * K + k0 + kc);
                Bs[(kc + 0) * 68 + r] = bflo(v.x); Bs[(kc + 1) * 68 + r] = bfhi(v.x); Bs[(kc + 2) * 68 + r] = bflo(v.y); Bs[(kc + 3) * 68 + r] = bfhi(v.y);
                Bs[(kc + 4) * 68 + r] = bflo(v.z); Bs[(kc + 5) * 68 + r] = bfhi(v.z); Bs[(kc + 6) * 68 + r] = bflo(v.w); Bs[(kc + 7) * 68 + r] = bfhi(v.w);
            }
            __syncthreads();
#pragma unroll 8
            for (int k = 0; k < 32; ++k) {
                const f32x4 a = *(const LAS f32x4*)(As + k * 132 + ty * 4);
                const f32x4 b = *(const LAS f32x4*)(Bs + k * 68 + tx * 4);
#pragma unroll
                for (int i = 0; i < 4; ++i)
#pragma unroll
                    for (int j = 0; j < 4; ++j) acc[i][j] += a[i] * b[j];
            }
        }
#pragma unroll
        for (int i = 0; i < 4; ++i)
#pragma unroll
            for (int j = 0; j < 4; ++j) { const int col = n0 + tx * 4 + j; if (col < N) E(m0 + ty * 4 + i, col, acc[i][j]); }
    }
    __syncthreads();
}

struct EInProj { bf16_t *sz, *xbc, *q, *k, *v;
    __device__ __forceinline__ void operator()(int r, int c, float x) const {
        if (c < 1024) sz[(size_t)r * 1024 + c] = (bf16_t)f2bf(silu_f(x));
        else if (c < 3072) xbc[(size_t)r * 2048 + (c - 1024)] = (bf16_t)f2bf(x);
        else if (c < 4096) q[(size_t)r * 1024 + (c - 3072)] = (bf16_t)f2bf(x * 0.125f);
        else if (c < 5120) k[(size_t)r * 1024 + (c - 4096)] = (bf16_t)f2bf(x);
        else v[(size_t)r * 1024 + (c - 5120)] = (bf16_t)f2bf(x);
    } };
struct EDt { float* dt; const float *bf, *bb;
    __device__ __forceinline__ void operator()(int r, int c, float x) const { const float bias = c < 16 ? bf[c] : bb[c - 16]; dt[(size_t)r * 32 + c] = softplus_f(x + bias); } };
struct EGate { bf16_t* sg;
    __device__ __forceinline__ void operator()(int r, int c, float x) const { sg[(size_t)(c >> 10) * T * 1024 + (size_t)r * 1024 + (c & 1023)] = (bf16_t)f2bf(sigmoid_f(x)); } };
struct ED1 { bf16_t* p1; const bf16_t* sg1; const float* rstd;
    __device__ __forceinline__ void operator()(int r, int c, float x) const { const size_t i = (size_t)r * 1024 + c; p1[i] = (bf16_t)f2bf(x * rstd[r] * bf2f(sg1[i])); } };
struct ED2 { bf16_t* mixed; const bf16_t *p1, *sg2;
    __device__ __forceinline__ void operator()(int r, int c, float x) const { const size_t i = (size_t)r * 1024 + c; mixed[i] = (bf16_t)f2bf(bf2f(p1[i]) + bf2f(sg2[i]) * x); } };
struct ED3 { float* h; const float* x; const float* mod;
    __device__ __forceinline__ void operator()(int r, int c, float v) const { const size_t i = (size_t)r * 1024 + c; h[i] = x[i] + mod[(r / SEQ) * 6144 + 2048 + c] * v; } };
struct EQp { bf16_t* qp;
    __device__ __forceinline__ void operator()(int r, int c, float v) const { qp[(size_t)r * 2048 + c] = (bf16_t)f2bf(v); } };


__device__ __forceinline__ void p_dt(const Ctx& C, const bf16_t* n1, const bf16_t* wdt, float* dt) {
    typedef short bf16x8 __attribute__((ext_vector_type(8)));
    const float* bf = C.in[8]; const float* bb = C.in[9];
    const int gw = C.bid * NWAVES + C.wave, NGW = C.G * NWAVES, lane = C.lane, g = lane >> 4, i16 = lane & 15;
    for (int tile = gw; tile < T / 16; tile += NGW) {
        const size_t t0 = (size_t)tile * 16;
        f32x4 a0 = (f32x4){0.f, 0.f, 0.f, 0.f}, a1 = a0;
#pragma unroll 8
        for (int ks = 0; ks < 32; ++ks) {
            const bf16x8 av = *(const bf16x8*)(n1 + (t0 + i16) * 1024 + ks * 32 + g * 8);
            const bf16x8 b0 = *(const bf16x8*)(wdt + (size_t)i16 * 1024 + ks * 32 + g * 8), b1 = *(const bf16x8*)(wdt + (size_t)(16 + i16) * 1024 + ks * 32 + g * 8);
            a0 = __builtin_amdgcn_mfma_f32_16x16x32_bf16(av, b0, a0, 0, 0, 0); a1 = __builtin_amdgcn_mfma_f32_16x16x32_bf16(av, b1, a1, 0, 0, 0); }
        const float bias0 = bf[i16], bias1 = bb[i16];
#pragma unroll
        for (int r = 0; r < 4; ++r) { dt[(t0 + 4 * g + r) * 32 + i16] = softplus_f(a0[r] + bias0); dt[(t0 + 4 * g + r) * 32 + 16 + i16] = softplus_f(a1[r] + bias1); }
    }
}

__device__ __forceinline__ void p_conv(const Ctx& C, const bf16_t* xbc, bf16_t* xc) {
    const float* cw = C.in[6]; const float* cb = C.in[7];
    const int gt = C.bid * NTHR + C.tid, NT = C.G * NTHR;
    for (int i = gt; i < (T / 8) * 256; i += NT) {
        const int cg = i & 255, run = i >> 8, t0 = run * 8, l0 = t0 & (SEQ - 1), ch = cg * 8;
        float w[5][8], acc[8][8];
#pragma unroll
        for (int j = 0; j < 5; ++j) { const f32x4 w0 = *(const f32x4*)(cw + j * 2048 + ch), w1 = *(const f32x4*)(cw + j * 2048 + ch + 4);
            w[j][0] = w0.x; w[j][1] = w0.y; w[j][2] = w0.z; w[j][3] = w0.w; w[j][4] = w1.x; w[j][5] = w1.y; w[j][6] = w1.z; w[j][7] = w1.w; }
        { const f32x4 b0 = *(const f32x4*)(cb + ch), b1 = *(const f32x4*)(cb + ch + 4);
#pragma unroll
          for (int o = 0; o < 8; ++o) { acc[o][0] = b0.x; acc[o][1] = b0.y; acc[o][2] = b0.z; acc[o][3] = b0.w; acc[o][4] = b1.x; acc[o][5] = b1.y; acc[o][6] = b1.z; acc[o][7] = b1.w; } }
        u32x4 rw[12];
#pragma unroll
        for (int rr = 0; rr < 12; ++rr) { const int ll = l0 + rr - 2; rw[rr] = (u32x4){0u, 0u, 0u, 0u};
            if (ll >= 0 && ll < SEQ) rw[rr] = *(const u32x4*)(xbc + (size_t)(t0 + rr - 2) * 2048 + ch); }
#pragma unroll
        for (int rr = 0; rr < 12; ++rr) {
            const float x[8] = {bflo(rw[rr].x), bfhi(rw[rr].x), bflo(rw[rr].y), bfhi(rw[rr].y), bflo(rw[rr].z), bfhi(rw[rr].z), bflo(rw[rr].w), bfhi(rw[rr].w)};
#pragma unroll
            for (int j = 0; j < 5; ++j) { const int o = rr - j; if (o >= 0 && o < 8) {
#pragma unroll
                for (int q = 0; q < 8; ++q) acc[o][q] += w[j][q] * x[q]; } }
        }
#pragma unroll
        for (int o = 0; o < 8; ++o) { u32x4 ov; ov.x = pk2(silu_f(acc[o][0]), silu_f(acc[o][1])); ov.y = pk2(silu_f(acc[o][2]), silu_f(acc[o][3])); ov.z = pk2(silu_f(acc[o][4]), silu_f(acc[o][5])); ov.w = pk2(silu_f(acc[o][6]), silu_f(acc[o][7]));
            *(u32x4*)(xc + (size_t)(t0 + o) * 2048 + ch) = ov; }
    }
}

__device__ __forceinline__ void p_ssd_naive(const Ctx& C, const bf16_t* xc, const float* dtb, bf16_t* yf, bf16_t* yb) {
    if (C.wave == 0)
    for (int unit = C.bid; unit < 256; unit += C.G) {
        const int dir = unit & 1, hd = (unit >> 1) & 15, b = unit >> 5, g = hd >> 2, p = C.lane;
        const float a = -__expf((dir ? C.in[11] : C.in[10])[hd]);
        const float dsk = C.in[12][hd];
        float h[128];
#pragma unroll
        for (int n = 0; n < 128; ++n) h[n] = 0.f;
        for (int s = 0; s < SEQ; ++s) {
#ifdef DIAG_LOCAL
            if ((s & 127) == 0) {
#pragma unroll
                for (int n = 0; n < 128; ++n) h[n] = 0.f; }
#endif
            const int t = dir ? (SEQ - 1 - s) : s; const size_t row = (size_t)b * SEQ + t;
            const float dt = dtb[row * 32 + dir * 16 + hd];
            const float dA = __expf(dt * a);
            const float x = bf2f(xc[row * 2048 + hd * 64 + p]);
            const float xdt = x * dt;
            const u32x4* Bp = (const u32x4*)(xc + row * 2048 + 1024 + g * 128);
            const u32x4* Cp = (const u32x4*)(xc + row * 2048 + 1536 + g * 128);
            float y = 0.f;
#pragma unroll
            for (int n8 = 0; n8 < 16; ++n8) {
                const u32x4 bv = Bp[n8], cv = Cp[n8];
                const float bb[8] = {bflo(bv.x), bfhi(bv.x), bflo(bv.y), bfhi(bv.y), bflo(bv.z), bfhi(bv.z), bflo(bv.w), bfhi(bv.w)};
                const float cc[8] = {bflo(cv.x), bfhi(cv.x), bflo(cv.y), bfhi(cv.y), bflo(cv.z), bfhi(cv.z), bflo(cv.w), bfhi(cv.w)};
#pragma unroll
                for (int q = 0; q < 8; ++q) { const int n = n8 * 8 + q; h[n] = dA * h[n] + xdt * bb[q]; y += cc[q] * h[n]; }
            }
            if (dir == 0) yf[row * 1024 + hd * 64 + p] = (bf16_t)f2bf(y + dsk * x);
            else yb[row * 1024 + hd * 64 + p] = (bf16_t)f2bf(y);
        }
    }
}


namespace ssd {
typedef short bf16x8 __attribute__((ext_vector_type(8)));
typedef short s16x4 __attribute__((ext_vector_type(4)));
constexpr int RS = 272, RSX = 144;
constexpr int CN = 0, BN = 34816, BS = 69632, SL = 104448, SLB = 17408, XN = 139264, CSB = 157696;
__device__ __forceinline__ bf16x8 trfrag(LAS unsigned char* base, int stride, int ks, int c, int g, int q, int pp) {
    LAS unsigned char* a0 = base + (32 * ks + 8 * g + q) * stride + 32 * c + 8 * pp;
    const s16x4 v0 = __builtin_amdgcn_ds_read_tr16_b64_v4i16((LAS s16x4*)a0);
    const s16x4 v1 = __builtin_amdgcn_ds_read_tr16_b64_v4i16((LAS s16x4*)(a0 + 4 * stride));
    bf16x8 r; r[0] = v0[0]; r[1] = v0[1]; r[2] = v0[2]; r[3] = v0[3]; r[4] = v1[0]; r[5] = v1[1]; r[6] = v1[2]; r[7] = v1[3]; return r;
}
__device__ __forceinline__ unsigned pkbf(float lo, float hi) { return pk2(lo, hi); }
__device__ __forceinline__ bf16x8 trfrag_p(LAS unsigned char* base, int stride, int ks, int c, int g, int q, int pp) {
    LAS unsigned char* a0 = base + (32 * ks + 4 * g + q) * stride + 32 * c + 8 * pp;
    const s16x4 v0 = __builtin_amdgcn_ds_read_tr16_b64_v4i16((LAS s16x4*)a0);
    const s16x4 v1 = __builtin_amdgcn_ds_read_tr16_b64_v4i16((LAS s16x4*)(a0 + 16 * stride));
    bf16x8 r; r[0] = v0[0]; r[1] = v0[1]; r[2] = v0[2]; r[3] = v0[3]; r[4] = v1[0]; r[5] = v1[1]; r[6] = v1[2]; r[7] = v1[3]; return r;
}
}
__device__ __forceinline__ void p_ssd(const Ctx& C, const bf16_t* xc, const float* dtb, bf16_t* yf, bf16_t* yb) {
    using namespace ssd;
    LAS unsigned char* L = C.lds;
    const int tid = C.tid, lane = C.lane, w = C.wave, g = lane >> 4, i16 = lane & 15, q = (lane >> 2) & 3, pp = lane & 3;
    for (int unit = C.bid; unit < 256; unit += C.G) {
        const int dir = unit & 1, hd = (unit >> 1) & 15, b = unit >> 5, grp = hd >> 2;
        const float a = -__expf((dir ? C.in[11] : C.in[10])[hd]);
        const float dsk = dir ? 0.f : C.in[12][hd];
        bf16_t* yout = dir ? yb : yf;
        f32x4 sacc[4];
#pragma unroll
        for (int pt = 0; pt < 4; ++pt) sacc[pt] = (f32x4){0.f, 0.f, 0.f, 0.f};
        __syncthreads();
        for (int i = tid; i < 2 * SLB / 4; i += NTHR) ((LAS unsigned*)(L + SL))[i] = 0u;
        u32x4 pfC[4], pfB[4], pfX[2]; float pfd0 = 0.f, pfd1 = 0.f;
#define SSD_ISSUE(ci_) do { const int c_ = dir ? (31 - (ci_)) : (ci_); const size_t t0_ = (size_t)b * SEQ + (size_t)c_ * 128; \
            _Pragma("unroll") for (int i_ = 0; i_ < 4; ++i_) { const int idx_ = tid + NTHR * i_, l_ = idx_ >> 4, cc_ = idx_ & 15; const bf16_t* rp_ = xc + (t0_ + l_) * 2048 + grp * 128 + cc_ * 8; \
                pfB[i_] = *(const u32x4*)(rp_ + 1024); pfC[i_] = *(const u32x4*)(rp_ + 1536); } \
            _Pragma("unroll") for (int i_ = 0; i_ < 2; ++i_) { const int idx_ = tid + NTHR * i_, l_ = idx_ >> 3, cc_ = idx_ & 7; pfX[i_] = *(const u32x4*)(xc + (t0_ + l_) * 2048 + hd * 64 + cc_ * 8); } \
            if (w == 0) { const int l0_ = dir ? (127 - 2 * lane) : (2 * lane), l1_ = dir ? (126 - 2 * lane) : (2 * lane + 1); \
                pfd0 = dtb[(t0_ + l0_) * 32 + dir * 16 + hd]; pfd1 = dtb[(t0_ + l1_) * 32 + dir * 16 + hd]; } } while (0)
#define SSD_SCAN(buf_) do { if (w == 0) { const float da0_ = pfd0 * a, da1_ = pfd1 * a; const float p1_ = da0_ + da1_; float s_ = p1_; \
            _Pragma("unroll") for (int o_ = 1; o_ < 64; o_ <<= 1) { const float t_ = __shfl_up(s_, o_); if (lane >= o_) s_ += t_; } \
            const float ex_ = s_ - p1_, cs0_ = ex_ + da0_, cs1_ = ex_ + p1_, tot_ = __shfl(s_, 63); \
            const int l0_ = dir ? (127 - 2 * lane) : (2 * lane), l1_ = dir ? (126 - 2 * lane) : (2 * lane + 1); \
            LAS float* cb_ = (LAS float*)(L + CSB + (buf_) * 1536); \
            cb_[l0_] = cs0_; cb_[l1_] = cs1_; cb_[128 + l0_] = pfd0; cb_[128 + l1_] = pfd1; cb_[256 + l0_] = pfd0 * __expf(tot_ - cs0_); cb_[256 + l1_] = pfd1 * __expf(tot_ - cs1_); \
            if (lane == 0) *(LAS float*)(L + CSB + 3072 + 8 * (buf_)) = tot_; } } while (0)
#define SSD_WRITE(buf_) do { const LAS float* dw_ = (const LAS float*)(L + CSB + (buf_) * 1536 + 1024); \
            _Pragma("unroll") for (int i_ = 0; i_ < 4; ++i_) { const int idx_ = tid + NTHR * i_, l_ = idx_ >> 4, cc_ = idx_ & 15; \
                *(LAS u32x4*)(L + CN + l_ * RS + cc_ * 16) = pfC[i_]; *(LAS u32x4*)(L + BN + l_ * RS + cc_ * 16) = pfB[i_]; \
                const float sc_ = dw_[l_]; const u32x4 v_ = pfB[i_]; u32x4 o_; \
                o_.x = pkbf(bflo(v_.x) * sc_, bfhi(v_.x) * sc_); o_.y = pkbf(bflo(v_.y) * sc_, bfhi(v_.y) * sc_); o_.z = pkbf(bflo(v_.z) * sc_, bfhi(v_.z) * sc_); o_.w = pkbf(bflo(v_.w) * sc_, bfhi(v_.w) * sc_); \
                *(LAS u32x4*)(L + BS + l_ * RS + cc_ * 16) = o_; } \
            _Pragma("unroll") for (int i_ = 0; i_ < 2; ++i_) { const int idx_ = tid + NTHR * i_, l_ = idx_ >> 3, cc_ = idx_ & 7; *(LAS u32x4*)(L + XN + l_ * RSX + cc_ * 16) = pfX[i_]; } } while (0)
        SSD_ISSUE(0);
        SSD_SCAN(0);
        __syncthreads();
        SSD_WRITE(0);
        __syncthreads();
        for (int ci = 0; ci < 32; ++ci) {
            const int buf = ci & 1;
            const int c = dir ? (31 - ci) : ci; const size_t t0 = (size_t)b * SEQ + (size_t)c * 128;
            if (ci + 1 < 32) SSD_ISSUE(ci + 1);
            const LAS float* csb = (const LAS float*)(L + CSB + buf * 1536);
            const float cs_l = csb[16 * w + i16];
            const float cs_end = *(const LAS float*)(L + CSB + 3072 + 8 * buf);
            bf16x8 cfrag[4];
#pragma unroll
            for (int ks = 0; ks < 4; ++ks) cfrag[ks] = *(const LAS bf16x8*)(L + CN + (16 * w + i16) * RS + ks * 64 + g * 16);
            u32x2 mreg[8];
            const int lrow = 16 * w + i16;
#pragma unroll
            for (int st = 0; st < 8; ++st) {
                f32x4 acc = (f32x4){0.f, 0.f, 0.f, 0.f};
#pragma unroll
                for (int ks = 0; ks < 4; ++ks) { const bf16x8 af = *(const LAS bf16x8*)(L + BN + (16 * st + i16) * RS + ks * 64 + g * 16);
                    acc = __builtin_amdgcn_mfma_f32_16x16x32_bf16(af, cfrag[ks], acc, 0, 0, 0); }
                const f32x4 cs_s = *(const LAS f32x4*)(csb + 16 * st + 4 * g), dt_s = *(const LAS f32x4*)(csb + 128 + 16 * st + 4 * g);
                float mv[4];
#pragma unroll
                for (int r = 0; r < 4; ++r) { const int srow = 16 * st + 4 * g + r; const bool valid = dir ? (srow >= lrow) : (srow <= lrow);
                    const float e = valid ? __expf(cs_l - cs_s[r]) : 0.f; mv[r] = acc[r] * dt_s[r] * e; }
                mreg[st].x = pkbf(mv[0], mv[1]); mreg[st].y = pkbf(mv[2], mv[3]);
            }
            f32x4 yacc[4];
            const float el = __expf(cs_l);
#pragma unroll
            for (int pt = 0; pt < 4; ++pt) { f32x4 acc = (f32x4){0.f, 0.f, 0.f, 0.f};
#pragma unroll
                for (int ks = 0; ks < 4; ++ks) { const bf16x8 af = *(const LAS bf16x8*)(L + SL + buf * SLB + (16 * pt + i16) * RS + ks * 64 + g * 16);
                    acc = __builtin_amdgcn_mfma_f32_16x16x32_bf16(af, cfrag[ks], acc, 0, 0, 0); }
                yacc[pt] = acc * el; }
#pragma unroll
            for (int ks = 0; ks < 4; ++ks) { u32x4 mw; mw.x = mreg[2 * ks].x; mw.y = mreg[2 * ks].y; mw.z = mreg[2 * ks + 1].x; mw.w = mreg[2 * ks + 1].y;
                const bf16x8 mf = __builtin_bit_cast(bf16x8, mw);
#pragma unroll
                for (int pt = 0; pt < 4; ++pt) { const bf16x8 xf = trfrag_p(L + XN, RSX, ks, pt, g, q, pp); yacc[pt] = __builtin_amdgcn_mfma_f32_16x16x32_bf16(xf, mf, yacc[pt], 0, 0, 0); } }
#pragma unroll
            for (int pt = 0; pt < 4; ++pt) { const u32x2 xv = *(const LAS u32x2*)(L + XN + lrow * RSX + (16 * pt + 4 * g) * 2);
                u32x2 o; o.x = pkbf(yacc[pt][0] + dsk * bflo(xv.x), yacc[pt][1] + dsk * bfhi(xv.x)); o.y = pkbf(yacc[pt][2] + dsk * bflo(xv.y), yacc[pt][3] + dsk * bfhi(xv.y));
                *(u32x2*)(yout + (t0 + lrow) * 1024 + hd * 64 + 16 * pt + 4 * g) = o; }
            { const float dec = __expf(cs_end);
#pragma unroll
              for (int pt = 0; pt < 4; ++pt) sacc[pt] = sacc[pt] * dec; }
#pragma unroll
            for (int ks = 0; ks < 4; ++ks) { const bf16x8 bf = trfrag_p(L + BS, RS, ks, w, g, q, pp);
#pragma unroll
                for (int pt = 0; pt < 4; ++pt) { const bf16x8 xf = trfrag_p(L + XN, RSX, ks, pt, g, q, pp); sacc[pt] = __builtin_amdgcn_mfma_f32_16x16x32_bf16(bf, xf, sacc[pt], 0, 0, 0); } }
#ifdef DIAG_LOCAL
#pragma unroll
            for (int pt = 0; pt < 4; ++pt) sacc[pt] = (f32x4){0.f, 0.f, 0.f, 0.f};
#endif
#pragma unroll
            for (int pt = 0; pt < 4; ++pt) { u32x2 o; o.x = pkbf(sacc[pt][0], sacc[pt][1]); o.y = pkbf(sacc[pt][2], sacc[pt][3]);
                *(LAS u32x2*)(L + SL + (buf ^ 1) * SLB + (16 * pt + i16) * RS + (16 * w + 4 * g) * 2) = o; }
            if (ci + 1 < 32) SSD_SCAN(buf ^ 1);
            __syncthreads();
            if (ci + 1 < 32) SSD_WRITE(buf ^ 1);
            __syncthreads();
        }
#undef SSD_ISSUE
#undef SSD_SCAN
#undef SSD_WRITE
    }
}

__device__ __forceinline__ void p_na_naive(const Ctx& C, bf16_t* q, const bf16_t* k, const bf16_t* v) {
    const float* rpb = C.in[15];
    const int gt = C.bid * NTHR + C.tid, NT = C.G * NTHR;
    for (int i = gt; i < T * 16; i += NT) {
        const int hh = i & 15, tok = i >> 4, b = tok >> 12, l = tok & 4095, r = l >> 6, col = l & 63;
        int rs = r - 4; rs = rs < 0 ? 0 : (rs > 56 ? 56 : rs);
        int wsx = col - 8; wsx = wsx < 0 ? 0 : (wsx > 48 ? 48 : wsx);
        float qv[64], o[64];
        {
            const u32x4* qp = (const u32x4*)(q + (size_t)tok * 1024 + hh * 64);
#pragma unroll
            for (int d8 = 0; d8 < 8; ++d8) { const u32x4 w = qp[d8]; qv[d8 * 8 + 0] = bflo(w.x); qv[d8 * 8 + 1] = bfhi(w.x); qv[d8 * 8 + 2] = bflo(w.y); qv[d8 * 8 + 3] = bfhi(w.y);
                qv[d8 * 8 + 4] = bflo(w.z); qv[d8 * 8 + 5] = bfhi(w.z); qv[d8 * 8 + 6] = bflo(w.w); qv[d8 * 8 + 7] = bfhi(w.w); }
        }
#pragma unroll
        for (int d = 0; d < 64; ++d) o[d] = 0.f;
        float m = -1e30f, lsum = 0.f;
        for (int ii = 0; ii < 8; ++ii)
            for (int jj = 0; jj < 16; ++jj) {
                const int kr = rs + ii, kc = wsx + jj; const size_t kt = (size_t)b * SEQ + kr * 64 + kc;
                const u32x4* kp = (const u32x4*)(k + kt * 1024 + hh * 64);
                float s = 0.f;
#pragma unroll
                for (int d8 = 0; d8 < 8; ++d8) { const u32x4 w = kp[d8];
                    s += qv[d8 * 8 + 0] * bflo(w.x) + qv[d8 * 8 + 1] * bfhi(w.x) + qv[d8 * 8 + 2] * bflo(w.y) + qv[d8 * 8 + 3] * bfhi(w.y)
                       + qv[d8 * 8 + 4] * bflo(w.z) + qv[d8 * 8 + 5] * bfhi(w.z) + qv[d8 * 8 + 6] * bflo(w.w) + qv[d8 * 8 + 7] * bfhi(w.w); }
                s += rpb[hh * 15 * 31 + (kr - r + 7) * 31 + (kc - col + 15)];
                const float mn = fmaxf(m, s), al = __expf(m - mn), pe = __expf(s - mn);
                lsum = lsum * al + pe; m = mn;
                const u32x4* vp = (const u32x4*)(v + kt * 1024 + hh * 64);
#pragma unroll
                for (int d8 = 0; d8 < 8; ++d8) { const u32x4 w = vp[d8];
                    o[d8 * 8 + 0] = o[d8 * 8 + 0] * al + pe * bflo(w.x); o[d8 * 8 + 1] = o[d8 * 8 + 1] * al + pe * bfhi(w.x);
                    o[d8 * 8 + 2] = o[d8 * 8 + 2] * al + pe * bflo(w.y); o[d8 * 8 + 3] = o[d8 * 8 + 3] * al + pe * bfhi(w.y);
                    o[d8 * 8 + 4] = o[d8 * 8 + 4] * al + pe * bflo(w.z); o[d8 * 8 + 5] = o[d8 * 8 + 5] * al + pe * bfhi(w.z);
                    o[d8 * 8 + 6] = o[d8 * 8 + 6] * al + pe * bflo(w.w); o[d8 * 8 + 7] = o[d8 * 8 + 7] * al + pe * bfhi(w.w); }
            }
        const float inv = 1.f / lsum;
        u32x4* op = (u32x4*)(q + (size_t)tok * 1024 + hh * 64);
#pragma unroll
        for (int d8 = 0; d8 < 8; ++d8) { u32x4 w; w.x = pk2(o[d8 * 8 + 0] * inv, o[d8 * 8 + 1] * inv); w.y = pk2(o[d8 * 8 + 2] * inv, o[d8 * 8 + 3] * inv);
            w.z = pk2(o[d8 * 8 + 4] * inv, o[d8 * 8 + 5] * inv); w.w = pk2(o[d8 * 8 + 6] * inv, o[d8 * 8 + 7] * inv); op[d8] = w; }
    }
}


namespace nat {
typedef short bf16x8 __attribute__((ext_vector_type(8)));
typedef short s16x4 __attribute__((ext_vector_type(4)));
constexpr int VH = 65536, RPB = 131072;
__device__ __forceinline__ int voff(int ks, int d) { return ks * 128 + ((((d >> 3) ^ (ks & 7))) << 4) + (d & 7) * 2; }
__device__ __forceinline__ int clampi(int x, int lo, int hi) { return x < lo ? lo : (x > hi ? hi : x); }
}
__device__ __forceinline__ void p_na(const Ctx& C, bf16_t* q, const bf16_t* k, const bf16_t* v) {
    using namespace nat;
    LAS unsigned char* L = C.lds;
    const float* rpb = C.in[15];
    const int tid = C.tid, lane = C.lane, w = C.wave, g = lane >> 4, i16 = lane & 15, qq = (lane >> 2) & 3, pp = lane & 3;
    const int hl = w >> 2, m = w & 3;
    const int bs = (m == 0) ? 0 : (m == 1) ? 8 : (m == 2) ? 24 : 32;
    const int qc = 16 * m + i16, wsx = clampi(qc - 8, 0, 48);
    unsigned vmask = 0u; int dcol[8];
#pragma unroll
    for (int c = 0; c < 8; ++c) { const int kc = bs + (c >> 2) * 16 + 4 * g + (c & 3); if (kc >= wsx && kc < wsx + 16) vmask |= (1u << c); dcol[c] = clampi(kc - qc + 15, 0, 30); }
    for (int unit = C.bid; unit < 256; unit += C.G) {
        const int rseg = unit & 3, hp = (unit >> 2) & 7, b = unit >> 5, h = 2 * hp + hl;
        __syncthreads();
        for (int i = tid; i < 930; i += NTHR) ((LAS float*)(L + RPB))[i] = rpb[(2 * hp) * 465 + i];
#define NA_LOAD_ROW(row_) do { _Pragma("unroll") for (int i_ = 0; i_ < 2; ++i_) { const int idx_ = tid + NTHR * i_, hl_ = idx_ >> 9, col_ = (idx_ >> 3) & 63, dch_ = idx_ & 7; \
            const u32x4 val_ = *(const u32x4*)(v + ((size_t)b * SEQ + (size_t)(row_) * 64 + col_) * 1024 + (2 * hp + hl_) * 64 + dch_ * 8); \
            *(LAS u32x4*)(L + hl_ * VH + voff(((row_) & 7) * 64 + col_, dch_ * 8)) = val_; } } while (0)
        const int r0 = 16 * rseg; int rs_prev = clampi(r0 - 4, 0, 56);
        for (int rr = 0; rr < 8; ++rr) NA_LOAD_ROW(rs_prev + rr);
        __syncthreads();
        const LAS float* rpbl = (const LAS float*)(L + RPB) + hl * 465;
        for (int s = 0; s < 16; ++s) {
            const int r = r0 + s, rs = clampi(r - 4, 0, 56);
            if (rs != rs_prev) { __syncthreads(); NA_LOAD_ROW(rs + 7); __syncthreads(); rs_prev = rs; }
            const size_t tokq = (size_t)b * SEQ + (size_t)r * 64 + qc;
            bf16x8 qf[2];
#pragma unroll
            for (int ks = 0; ks < 2; ++ks) qf[ks] = *(const bf16x8*)(q + tokq * 1024 + h * 64 + ks * 32 + g * 8);
            f32x4 sc[16];
#pragma unroll
            for (int kt = 0; kt < 16; ++kt) { const size_t tokk = (size_t)b * SEQ + (size_t)(rs + (kt >> 1)) * 64 + bs + (kt & 1) * 16 + i16;
                f32x4 acc = (f32x4){0.f, 0.f, 0.f, 0.f};
#pragma unroll
                for (int ks = 0; ks < 2; ++ks) { const bf16x8 kf = *(const bf16x8*)(k + tokk * 1024 + h * 64 + ks * 32 + g * 8); acc = __builtin_amdgcn_mfma_f32_16x16x32_bf16(kf, qf[ks], acc, 0, 0, 0); }
                sc[kt] = acc; }
            float mx = -1.0e30f;
#pragma unroll
            for (int kt = 0; kt < 16; ++kt) { const int drow = rs + (kt >> 1) - r + 7;
#pragma unroll
                for (int e = 0; e < 4; ++e) { const int c = (kt & 1) * 4 + e; const float bias = rpbl[drow * 31 + dcol[c]];
                    const float val = ((vmask >> c) & 1u) ? sc[kt][e] + bias : -1.0e30f; sc[kt][e] = val; mx = fmaxf(mx, val); } }
            mx = fmaxf(mx, __shfl_xor(mx, 16)); mx = fmaxf(mx, __shfl_xor(mx, 32));
            float sum = 0.f;
#pragma unroll
            for (int kt = 0; kt < 16; ++kt)
#pragma unroll
                for (int e = 0; e < 4; ++e) { const float p = __expf(sc[kt][e] - mx); sc[kt][e] = p; sum += p; }
            sum += __shfl_xor(sum, 16); sum += __shfl_xor(sum, 32);
            f32x4 o[4];
#pragma unroll
            for (int dt = 0; dt < 4; ++dt) o[dt] = (f32x4){0.f, 0.f, 0.f, 0.f};
#pragma unroll
            for (int kk = 0; kk < 8; ++kk) {
                u32x4 pw; pw.x = pk2(sc[2 * kk][0], sc[2 * kk][1]); pw.y = pk2(sc[2 * kk][2], sc[2 * kk][3]); pw.z = pk2(sc[2 * kk + 1][0], sc[2 * kk + 1][1]); pw.w = pk2(sc[2 * kk + 1][2], sc[2 * kk + 1][3]);
                const bf16x8 pf = __builtin_bit_cast(bf16x8, pw);
                const int ks0 = ((rs + kk) & 7) * 64 + bs + 4 * g + qq, ks1 = ks0 + 16;
#pragma unroll
                for (int dt = 0; dt < 4; ++dt) {
                    const s16x4 v0 = __builtin_amdgcn_ds_read_tr16_b64_v4i16((LAS s16x4*)(L + hl * VH + voff(ks0, 16 * dt + 4 * pp)));
                    const s16x4 v1 = __builtin_amdgcn_ds_read_tr16_b64_v4i16((LAS s16x4*)(L + hl * VH + voff(ks1, 16 * dt + 4 * pp)));
                    bf16x8 vf; vf[0] = v0[0]; vf[1] = v0[1]; vf[2] = v0[2]; vf[3] = v0[3]; vf[4] = v1[0]; vf[5] = v1[1]; vf[6] = v1[2]; vf[7] = v1[3];
                    o[dt] = __builtin_amdgcn_mfma_f32_16x16x32_bf16(vf, pf, o[dt], 0, 0, 0); }
            }
            const float inv = 1.f / sum;
#pragma unroll
            for (int dt = 0; dt < 4; ++dt) { u32x2 ov; ov.x = pk2(o[dt][0] * inv, o[dt][1] * inv); ov.y = pk2(o[dt][2] * inv, o[dt][3] * inv);
                *(u32x2*)(q + tokq * 1024 + h * 64 + 16 * dt + 4 * g) = ov; }
        }
#undef NA_LOAD_ROW
    }
    __syncthreads();
}

__device__ __forceinline__ void p_combine(const Ctx& C, const bf16_t* yf, const bf16_t* yb, bf16_t* szu, float* rstd) {
    const int gw = C.bid * NWAVES + C.wave, NGW = C.G * NWAVES;
    for (int row = gw; row < T; row += NGW) {
        const size_t base = (size_t)row * 1024;
        float s = 0.f; u32x4 outv[2];
#pragma unroll
        for (int j = 0; j < 2; ++j) {
            const size_t off = base + j * 512 + C.lane * 8;
            const u32x4 a = *(const u32x4*)(yf + off), b = *(const u32x4*)(yb + off), z = *(const u32x4*)(szu + off);
            float u[8];
            u[0] = (bflo(a.x) + bflo(b.x)) * bflo(z.x); u[1] = (bfhi(a.x) + bfhi(b.x)) * bfhi(z.x);
            u[2] = (bflo(a.y) + bflo(b.y)) * bflo(z.y); u[3] = (bfhi(a.y) + bfhi(b.y)) * bfhi(z.y);
            u[4] = (bflo(a.z) + bflo(b.z)) * bflo(z.z); u[5] = (bfhi(a.z) + bfhi(b.z)) * bfhi(z.z);
            u[6] = (bflo(a.w) + bflo(b.w)) * bflo(z.w); u[7] = (bfhi(a.w) + bfhi(b.w)) * bfhi(z.w);
#pragma unroll
            for (int q = 0; q < 8; ++q) s += u[q] * u[q];
            outv[j].x = pk2(u[0], u[1]); outv[j].y = pk2(u[2], u[3]); outv[j].z = pk2(u[4], u[5]); outv[j].w = pk2(u[6], u[7]);
        }
        s = wave_sum(s);
#pragma unroll
        for (int j = 0; j < 2; ++j) *(u32x4*)(szu + base + j * 512 + C.lane * 8) = outv[j];
        if (C.lane == 0) rstd[row] = rsqrtf(s * (1.f / 1024.f) + EPS);
    }
}

__device__ __forceinline__ void p_cvt_tables(const Ctx& C, bf16_t* ub, bf16_t* vb) {
    const int gt = C.bid * NTHR + C.tid, NT = C.G * NTHR;
    const float* u = C.in[21]; const float* v = C.in[22];
    for (int i = gt; i < 16384 * 1024 / 8; i += NT) {
        const f32x4 a0 = *(const f32x4*)(u + (size_t)i * 8), a1 = *(const f32x4*)(u + (size_t)i * 8 + 4);
        u32x4 o; o.x = pk2(a0.x, a0.y); o.y = pk2(a0.z, a0.w); o.z = pk2(a1.x, a1.y); o.w = pk2(a1.z, a1.w);
        *(u32x4*)(ub + (size_t)i * 8) = o;
        const f32x4 b0 = *(const f32x4*)(v + (size_t)i * 8), b1 = *(const f32x4*)(v + (size_t)i * 8 + 4);
        u32x4 p; p.x = pk2(b0.x, b0.y); p.y = pk2(b0.z, b0.w); p.z = pk2(b1.x, b1.y); p.w = pk2(b1.z, b1.w);
        *(u32x4*)(vb + (size_t)i * 8) = p;
    }
}

__device__ __forceinline__ void p_topk_naive(const Ctx& C, const bf16_t* qp, const bf16_t* keys, unsigned short* pidx, float* pgate) {
    constexpr int NTK = 64;
    LAS float* S = (LAS float*)C.lds;
    LAS float* TV = (LAS float*)(C.lds + 256 * NTK * 4);
    LAS int* TI = (LAS int*)(C.lds + 256 * NTK * 4 + 32 * NTK * 4);
    const int tl = C.tid;
    if (C.tid < 64)
    for (int item = C.bid * NTK + tl; item < T * 8; item += C.G * NTK) {
        const int t = item >> 3, hh = item & 7;
        for (int z = 0; z < 2; ++z) {
            unsigned qv[64];
            const u32x4* qptr = (const u32x4*)(qp + (size_t)t * 2048 + hh * 256 + z * 128);
#pragma unroll
            for (int d8 = 0; d8 < 16; ++d8) { const u32x4 w = qptr[d8]; qv[d8 * 4 + 0] = w.x; qv[d8 * 4 + 1] = w.y; qv[d8 * 4 + 2] = w.z; qv[d8 * 4 + 3] = w.w; }
            for (int n = 0; n < 128; ++n) {
                const u32x4* kp = (const u32x4*)(keys + (size_t)(z * 128 + n) * 128);
                float acc = 0.f;
#pragma unroll
                for (int d8 = 0; d8 < 16; ++d8) { const u32x4 w = kp[d8];
                    acc += bflo(qv[d8 * 4 + 0]) * bflo(w.x) + bfhi(qv[d8 * 4 + 0]) * bfhi(w.x) + bflo(qv[d8 * 4 + 1]) * bflo(w.y) + bfhi(qv[d8 * 4 + 1]) * bfhi(w.y)
                         + bflo(qv[d8 * 4 + 2]) * bflo(w.z) + bfhi(qv[d8 * 4 + 2]) * bfhi(w.z) + bflo(qv[d8 * 4 + 3]) * bflo(w.w) + bfhi(qv[d8 * 4 + 3]) * bfhi(w.w); }
                S[(z * 128 + n) * NTK + tl] = acc;
            }
            float pv = 3.0e38f; int pi = -1;
            for (int r = 0; r < 16; ++r) {
                float best = -3.0e38f; int bi = 0;
                for (int n = 0; n < 128; ++n) { const float x = S[(z * 128 + n) * NTK + tl];
                    const bool elig = (x < pv) || (x == pv && n > pi);
                    if (elig && x > best) { best = x; bi = n; } }
                TV[(z * 16 + r) * NTK + tl] = best; TI[(z * 16 + r) * NTK + tl] = bi; pv = best; pi = bi;
            }
        }
        float pv = 3.0e38f; int pi = -1; float top[16]; int ei[16];
#pragma unroll
        for (int r = 0; r < 16; ++r) {
            float best = -3.0e38f; int bi = 0;
            for (int c = 0; c < 256; ++c) { const float x = TV[(c >> 4) * NTK + tl] + TV[(16 + (c & 15)) * NTK + tl];
                const bool elig = (x < pv) || (x == pv && c > pi);
                if (elig && x > best) { best = x; bi = c; } }
            top[r] = best; ei[r] = TI[(bi >> 4) * NTK + tl] * 128 + TI[(16 + (bi & 15)) * NTK + tl]; pv = best; pi = bi;
        }
        float den = 0.f, e[16];
#pragma unroll
        for (int r = 0; r < 16; ++r) { e[r] = __expf(top[r] - top[0]); den += e[r]; }
        const float inv = 1.f / den;
#pragma unroll
        for (int r = 0; r < 16; ++r) { pidx[(size_t)t * 128 + hh * 16 + r] = (unsigned short)ei[r]; pgate[(size_t)t * 128 + hh * 16 + r] = e[r] * inv; }
    }
}


namespace tk {
typedef short bf16x8 __attribute__((ext_vector_type(8)));
constexpr int RSK = 272, TAB = 69632, TABW = 33 * 16 * 4, IJT = TAB + 8 * TABW;
__device__ __forceinline__ void ce(float& a, float& b) { const float hi = __builtin_fmaxf(a, b), lo = __builtin_fminf(a, b); a = hi; b = lo; }
__device__ __forceinline__ void sort16(float (&v)[16]) {
#pragma unroll
    for (int k = 2; k <= 16; k <<= 1)
#pragma unroll
        for (int j = k >> 1; j > 0; j >>= 1)
#pragma unroll
            for (int i = 0; i < 16; ++i) { const int l = i ^ j; if (l > i) { if ((i & k) == 0) ce(v[i], v[l]); else ce(v[l], v[i]); } }
}
__device__ __forceinline__ void merge16(float (&a)[16], const float (&b)[16]) {
#pragma unroll
    for (int i = 0; i < 16; ++i) a[i] = __builtin_fmaxf(a[i], b[15 - i]);
#pragma unroll
    for (int j = 8; j > 0; j >>= 1)
#pragma unroll
        for (int i = 0; i < 16; ++i) { const int l = i ^ j; if (l > i) ce(a[i], a[l]); }
}
__device__ __forceinline__ void xmerge(float (&a)[16], int mask) { float b[16];
#pragma unroll
    for (int i = 0; i < 16; ++i) b[i] = __shfl_xor(a[i], mask);
    merge16(a, b); }
}
__device__ __forceinline__ void p_topk(const Ctx& C, const bf16_t* qp, const bf16_t* keys, unsigned short* pidx, float* pgate) {
    using namespace tk;
    LAS unsigned char* L = C.lds;
    const int tid = C.tid, lane = C.lane, w = C.wave, g = lane >> 4, i16 = lane & 15;
    __syncthreads();
    for (int i = tid; i < 4096; i += NTHR) { const int r = i >> 4, cc = i & 15; *(LAS u32x4*)(L + r * RSK + cc * 16) = *(const u32x4*)(keys + (size_t)r * 128 + cc * 8); }
    if (tid < 64) { int cnt = 0, fi = 0, fj = 0;
        for (int i = 0; i < 16; ++i) for (int j = 0; j < 16; ++j) if ((i + 1) * (j + 1) <= 16) { if (cnt == tid) { fi = i; fj = j; } ++cnt; }
        ((LAS unsigned*)(L + IJT))[tid] = (unsigned)(fi | (fj << 4)); }
    __syncthreads();
    LAS unsigned* tab = (LAS unsigned*)(L + TAB + w * TABW) + i16 * 33;
    const LAS unsigned* ijt = (const LAS unsigned*)(L + IJT);
    const float NEGV = -1.0e30f;
    const int gw = C.bid * NWAVES + w, NGW = C.G * NWAVES;
    for (int unit = gw; unit < (T / 16) * 8; unit += NGW) {
        const int tg = unit >> 3, hh = unit & 7; const size_t t0 = (size_t)tg * 16;
        float s1[16], s2[16];
#pragma unroll
        for (int z = 0; z < 2; ++z) {
            bf16x8 qf[4];
#pragma unroll
            for (int ks = 0; ks < 4; ++ks) qf[ks] = *(const bf16x8*)(qp + (t0 + i16) * 2048 + hh * 256 + z * 128 + ks * 32 + g * 8);
            float lo[16], hi[16];
#pragma unroll
            for (int nt = 0; nt < 8; ++nt) { f32x4 acc = (f32x4){0.f, 0.f, 0.f, 0.f};
#pragma unroll
                for (int ks = 0; ks < 4; ++ks) { const bf16x8 kf = *(const LAS bf16x8*)(L + (z * 128 + 16 * nt + i16) * RSK + ks * 64 + g * 16);
                    acc = __builtin_amdgcn_mfma_f32_16x16x32_bf16(kf, qf[ks], acc, 0, 0, 0); }
#pragma unroll
                for (int r = 0; r < 4; ++r) { const float pv = __uint_as_float((__float_as_uint(acc[r]) & 0xFFFFFF80u) | (unsigned)(16 * nt + 4 * g + r));
                    if (nt < 4) lo[nt * 4 + r] = pv; else hi[(nt - 4) * 4 + r] = pv; } }
            sort16(lo); sort16(hi); merge16(lo, hi);
            xmerge(lo, 16); xmerge(lo, 32);
#pragma unroll
            for (int i = 0; i < 16; ++i) { if (z == 0) s1[i] = lo[i]; else s2[i] = lo[i]; }
        }
#pragma unroll
        for (int i = 0; i < 16; ++i) { tab[i] = __float_as_uint(s1[i]); tab[16 + i] = __float_as_uint(s2[i]); }
        float cand[16];
            { const float a_ = (g == 0 ? s1[0] : g == 1 ? s1[1] : g == 2 ? s1[3] : s1[14]), b_ = (g == 0 ? s2[0] : g == 1 ? s2[0] : g == 2 ? s2[3] : s2[0]); cand[0] = __uint_as_float((__float_as_uint(a_ + b_) & 0xFFFFFFC0u) | (unsigned)(16 * g + 0)); }
            { const float a_ = (g == 0 ? s1[0] : g == 1 ? s1[1] : g == 2 ? s1[4] : s1[15]), b_ = (g == 0 ? s2[1] : g == 1 ? s2[1] : g == 2 ? s2[0] : s2[0]); cand[1] = __uint_as_float((__float_as_uint(a_ + b_) & 0xFFFFFFC0u) | (unsigned)(16 * g + 1)); }
            { const float a_ = (g == 0 ? s1[0] : g == 1 ? s1[1] : g == 2 ? s1[4] : NEGV), b_ = (g == 0 ? s2[2] : g == 1 ? s2[2] : g == 2 ? s2[1] : NEGV); cand[2] = __uint_as_float((__float_as_uint(a_ + b_) & 0xFFFFFFC0u) | (unsigned)(16 * g + 2)); }
            { const float a_ = (g == 0 ? s1[0] : g == 1 ? s1[1] : g == 2 ? s1[4] : NEGV), b_ = (g == 0 ? s2[3] : g == 1 ? s2[3] : g == 2 ? s2[2] : NEGV); cand[3] = __uint_as_float((__float_as_uint(a_ + b_) & 0xFFFFFFC0u) | (unsigned)(16 * g + 3)); }
            { const float a_ = (g == 0 ? s1[0] : g == 1 ? s1[1] : g == 2 ? s1[5] : NEGV), b_ = (g == 0 ? s2[4] : g == 1 ? s2[4] : g == 2 ? s2[0] : NEGV); cand[4] = __uint_as_float((__float_as_uint(a_ + b_) & 0xFFFFFFC0u) | (unsigned)(16 * g + 4)); }
            { const float a_ = (g == 0 ? s1[0] : g == 1 ? s1[1] : g == 2 ? s1[5] : NEGV), b_ = (g == 0 ? s2[5] : g == 1 ? s2[5] : g == 2 ? s2[1] : NEGV); cand[5] = __uint_as_float((__float_as_uint(a_ + b_) & 0xFFFFFFC0u) | (unsigned)(16 * g + 5)); }
            { const float a_ = (g == 0 ? s1[0] : g == 1 ? s1[1] : g == 2 ? s1[6] : NEGV), b_ = (g == 0 ? s2[6] : g == 1 ? s2[6] : g == 2 ? s2[0] : NEGV); cand[6] = __uint_as_float((__float_as_uint(a_ + b_) & 0xFFFFFFC0u) | (unsigned)(16 * g + 6)); }
            { const float a_ = (g == 0 ? s1[0] : g == 1 ? s1[1] : g == 2 ? s1[6] : NEGV), b_ = (g == 0 ? s2[7] : g == 1 ? s2[7] : g == 2 ? s2[1] : NEGV); cand[7] = __uint_as_float((__float_as_uint(a_ + b_) & 0xFFFFFFC0u) | (unsigned)(16 * g + 7)); }
            { const float a_ = (g == 0 ? s1[0] : g == 1 ? s1[2] : g == 2 ? s1[7] : NEGV), b_ = (g == 0 ? s2[8] : g == 1 ? s2[0] : g == 2 ? s2[0] : NEGV); cand[8] = __uint_as_float((__float_as_uint(a_ + b_) & 0xFFFFFFC0u) | (unsigned)(16 * g + 8)); }
            { const float a_ = (g == 0 ? s1[0] : g == 1 ? s1[2] : g == 2 ? s1[7] : NEGV), b_ = (g == 0 ? s2[9] : g == 1 ? s2[1] : g == 2 ? s2[1] : NEGV); cand[9] = __uint_as_float((__float_as_uint(a_ + b_) & 0xFFFFFFC0u) | (unsigned)(16 * g + 9)); }
            { const float a_ = (g == 0 ? s1[0] : g == 1 ? s1[2] : g == 2 ? s1[8] : NEGV), b_ = (g == 0 ? s2[10] : g == 1 ? s2[2] : g == 2 ? s2[0] : NEGV); cand[10] = __uint_as_float((__float_as_uint(a_ + b_) & 0xFFFFFFC0u) | (unsigned)(16 * g + 10)); }
            { const float a_ = (g == 0 ? s1[0] : g == 1 ? s1[2] : g == 2 ? s1[9] : NEGV), b_ = (g == 0 ? s2[11] : g == 1 ? s2[3] : g == 2 ? s2[0] : NEGV); cand[11] = __uint_as_float((__float_as_uint(a_ + b_) & 0xFFFFFFC0u) | (unsigned)(16 * g + 11)); }
            { const float a_ = (g == 0 ? s1[0] : g == 1 ? s1[2] : g == 2 ? s1[10] : NEGV), b_ = (g == 0 ? s2[12] : g == 1 ? s2[4] : g == 2 ? s2[0] : NEGV); cand[12] = __uint_as_float((__float_as_uint(a_ + b_) & 0xFFFFFFC0u) | (unsigned)(16 * g + 12)); }
            { const float a_ = (g == 0 ? s1[0] : g == 1 ? s1[3] : g == 2 ? s1[11] : NEGV), b_ = (g == 0 ? s2[13] : g == 1 ? s2[0] : g == 2 ? s2[0] : NEGV); cand[13] = __uint_as_float((__float_as_uint(a_ + b_) & 0xFFFFFFC0u) | (unsigned)(16 * g + 13)); }
            { const float a_ = (g == 0 ? s1[0] : g == 1 ? s1[3] : g == 2 ? s1[12] : NEGV), b_ = (g == 0 ? s2[14] : g == 1 ? s2[1] : g == 2 ? s2[0] : NEGV); cand[14] = __uint_as_float((__float_as_uint(a_ + b_) & 0xFFFFFFC0u) | (unsigned)(16 * g + 14)); }
            { const float a_ = (g == 0 ? s1[0] : g == 1 ? s1[3] : g == 2 ? s1[13] : NEGV), b_ = (g == 0 ? s2[15] : g == 1 ? s2[2] : g == 2 ? s2[0] : NEGV); cand[15] = __uint_as_float((__float_as_uint(a_ + b_) & 0xFFFFFFC0u) | (unsigned)(16 * g + 15)); }
        sort16(cand);
        xmerge(cand, 16); xmerge(cand, 32);
        float den = 0.f, ex[16];
#pragma unroll
        for (int i = 0; i < 16; ++i) { ex[i] = __expf(cand[i] - cand[0]); den += ex[i]; }
        const float inv = 1.f / den;
        unsigned short eo[4]; float go[4];
#pragma unroll
        for (int e = 0; e < 4; ++e) {
            const float cv = (g == 0 ? cand[e] : g == 1 ? cand[4 + e] : g == 2 ? cand[8 + e] : cand[12 + e]);
            const float gv = (g == 0 ? ex[e] : g == 1 ? ex[4 + e] : g == 2 ? ex[8 + e] : ex[12 + e]);
            const unsigned code = __float_as_uint(cv) & 63u; const unsigned ij = ijt[code];
            const unsigned p1 = tab[ij & 15u], p2 = tab[16 + (ij >> 4)];
            eo[e] = (unsigned short)((p1 & 127u) * 128u + (p2 & 127u)); go[e] = gv * inv; }
        u32x2 ov; ov.x = (unsigned)eo[0] | ((unsigned)eo[1] << 16); ov.y = (unsigned)eo[2] | ((unsigned)eo[3] << 16);
        *(u32x2*)(pidx + (t0 + i16) * 128 + hh * 16 + 4 * g) = ov;
        *(f32x4*)(pgate + (t0 + i16) * 128 + hh * 16 + 4 * g) = (f32x4){go[0], go[1], go[2], go[3]};
    }
    __syncthreads();
}

__device__ __forceinline__ float dot2u(unsigned a, unsigned x, float acc) {
    return __builtin_amdgcn_fdot2_f32_bf16(__builtin_bit_cast(bf16x2_t, a), __builtin_bit_cast(bf16x2_t, x), acc, false);
}
__device__ __forceinline__ float dot8(const u32x4 a, const u32x4 x, float acc) {
    const unsigned a0 = a.x, a1 = a.y, a2 = a.z, a3 = a.w, x0 = x.x, x1 = x.y, x2 = x.z, x3 = x.w;
    acc = dot2u(a0, x0, acc); acc = dot2u(a1, x1, acc); acc = dot2u(a2, x2, acc); acc = dot2u(a3, x3, acc);
    return acc;
}
__device__ __forceinline__ void p_gather(const Ctx& C, const bf16_t* n2, const unsigned short* pidx, const float* pgate, const bf16_t* ub, const bf16_t* vb, const float* h, float* out) {
    const float* mod = C.f32p(WS_MOD); const float* fg = C.in[23];
    LAS float* cbuf = (LAS float*)C.lds + C.wave * 128;
    const int gw = C.bid * NWAVES + C.wave, NGW = C.G * NWAVES, lane = C.lane;
    for (int t = gw; t < T; t += NGW) {
        const int b = t / SEQ;
        const u32x4 x0 = *(const u32x4*)(n2 + (size_t)t * 1024 + lane * 8), x1 = *(const u32x4*)(n2 + (size_t)t * 1024 + 512 + lane * 8);
        const int id0 = pidx[(size_t)t * 128 + lane], id1 = pidx[(size_t)t * 128 + 64 + lane];
        const float g0 = pgate[(size_t)t * 128 + lane], g1 = pgate[(size_t)t * 128 + 64 + lane];
#pragma unroll 1
        for (int grp = 0; grp < 8; ++grp) {
            const int idv = grp < 4 ? id0 : id1; const int lbase = (grp & 3) * 16;
            float part[16];
#pragma unroll
            for (int j = 0; j < 16; ++j) {
                const int e = __shfl(idv, lbase + j);
                const bf16_t* rowp = ub + (size_t)e * 1024;
                const u32x4 a0 = *(const u32x4*)(rowp + lane * 8), a1 = *(const u32x4*)(rowp + 512 + lane * 8);
                part[j] = dot8(a1, x1, dot8(a0, x0, 0.f));
            }
            float p8[8];
            { const bool hi = (lane & 32) != 0;
#pragma unroll
              for (int j = 0; j < 8; ++j) { const float keep = hi ? part[j + 8] : part[j], send = hi ? part[j] : part[j + 8]; p8[j] = keep + __shfl_xor(send, 32); } }
            float p4[4];
            { const bool hi = (lane & 16) != 0;
#pragma unroll
              for (int j = 0; j < 4; ++j) { const float keep = hi ? p8[j + 4] : p8[j], send = hi ? p8[j] : p8[j + 4]; p4[j] = keep + __shfl_xor(send, 16); } }
            float p2[2];
            { const bool hi = (lane & 8) != 0;
#pragma unroll
              for (int j = 0; j < 2; ++j) { const float keep = hi ? p4[j + 2] : p4[j], send = hi ? p4[j] : p4[j + 2]; p2[j] = keep + __shfl_xor(send, 8); } }
            float p1;
            { const bool hi = (lane & 4) != 0; const float keep = hi ? p2[1] : p2[0], send = hi ? p2[0] : p2[1]; p1 = keep + __shfl_xor(send, 4); }
            p1 += __shfl_xor(p1, 2); p1 += __shfl_xor(p1, 1);
            const int E = ((lane >> 5) & 1) * 8 + ((lane >> 4) & 1) * 4 + ((lane >> 3) & 1) * 2 + ((lane >> 2) & 1);
            if ((lane & 3) == 0) cbuf[grp * 16 + E] = gelu_f(p1);
        }
        asm volatile("s_waitcnt lgkmcnt(0)" ::: "memory");
        const float c0 = cbuf[lane] * g0, c1 = cbuf[64 + lane] * g1;
        asm volatile("s_waitcnt lgkmcnt(0)" ::: "memory");
        float acc[16];
#pragma unroll
        for (int i = 0; i < 16; ++i) acc[i] = 0.f;
#pragma unroll 1
        for (int kb = 0; kb < 128; kb += 8) {
            const int idv = kb < 64 ? id0 : id1; const float cv = kb < 64 ? c0 : c1;
#pragma unroll
            for (int j = 0; j < 8; ++j) {
                const int e = __shfl(idv, (kb & 63) + j); const float ck = __shfl(cv, (kb & 63) + j);
                const bf16_t* rowp = vb + (size_t)e * 1024;
                const u32x4 a0 = *(const u32x4*)(rowp + lane * 8), a1 = *(const u32x4*)(rowp + 512 + lane * 8);
                acc[0] += ck * bflo(a0.x); acc[1] += ck * bfhi(a0.x); acc[2] += ck * bflo(a0.y); acc[3] += ck * bfhi(a0.y);
                acc[4] += ck * bflo(a0.z); acc[5] += ck * bfhi(a0.z); acc[6] += ck * bflo(a0.w); acc[7] += ck * bfhi(a0.w);
                acc[8] += ck * bflo(a1.x); acc[9] += ck * bfhi(a1.x); acc[10] += ck * bflo(a1.y); acc[11] += ck * bfhi(a1.y);
                acc[12] += ck * bflo(a1.z); acc[13] += ck * bfhi(a1.z); acc[14] += ck * bflo(a1.w); acc[15] += ck * bfhi(a1.w);
            }
        }
        float hf[16]; float ss = 0.f;
#pragma unroll
        for (int half = 0; half < 2; ++half) {
            const int col = half * 512 + lane * 8;
            const f32x4 h0 = *(const f32x4*)(h + (size_t)t * 1024 + col), h1 = *(const f32x4*)(h + (size_t)t * 1024 + col + 4);
            const f32x4 m0 = *(const f32x4*)(mod + b * 6144 + 5120 + col), m1 = *(const f32x4*)(mod + b * 6144 + 5120 + col + 4);
            hf[half * 8 + 0] = h0.x + m0.x * acc[half * 8 + 0]; hf[half * 8 + 1] = h0.y + m0.y * acc[half * 8 + 1];
            hf[half * 8 + 2] = h0.z + m0.z * acc[half * 8 + 2]; hf[half * 8 + 3] = h0.w + m0.w * acc[half * 8 + 3];
            hf[half * 8 + 4] = h1.x + m1.x * acc[half * 8 + 4]; hf[half * 8 + 5] = h1.y + m1.y * acc[half * 8 + 5];
            hf[half * 8 + 6] = h1.z + m1.z * acc[half * 8 + 6]; hf[half * 8 + 7] = h1.w + m1.w * acc[half * 8 + 7];
        }
#pragma unroll
        for (int i = 0; i < 16; ++i) ss += hf[i] * hf[i];
        const float rstd = rsqrtf(wave_sum(ss) * (1.f / 1024.f) + EPS);
#pragma unroll
        for (int half = 0; half < 2; ++half) {
            const int col = half * 512 + lane * 8;
            const f32x4 f0 = *(const f32x4*)(fg + col), f1 = *(const f32x4*)(fg + col + 4);
            f32x4 o0, o1;
            o0.x = hf[half * 8 + 0] * rstd * f0.x; o0.y = hf[half * 8 + 1] * rstd * f0.y; o0.z = hf[half * 8 + 2] * rstd * f0.z; o0.w = hf[half * 8 + 3] * rstd * f0.w;
            o1.x = hf[half * 8 + 4] * rstd * f1.x; o1.y = hf[half * 8 + 5] * rstd * f1.y; o1.z = hf[half * 8 + 6] * rstd * f1.z; o1.w = hf[half * 8 + 7] * rstd * f1.w;
            *(f32x4*)(out + (size_t)t * 1024 + col) = o0; *(f32x4*)(out + (size_t)t * 1024 + col + 4) = o1;
        }
    }
}


__device__ __forceinline__ void p_cvt_tables8(const Ctx& C, unsigned char* u8, unsigned char* v8) {
    const int gt = C.bid * NTHR + C.tid, NT = C.G * NTHR;
    const float* u = C.in[21]; const float* v = C.in[22];
    constexpr int N4 = 16384 * 1024 / 4;
    for (int i0 = gt; i0 < N4; i0 += 4 * NT) {
        f32x4 a[4], b[4];
#pragma unroll
        for (int r = 0; r < 4; ++r) { const int i = i0 + r * NT; if (i < N4) { a[r] = *(const f32x4*)(u + (size_t)i * 4); b[r] = *(const f32x4*)(v + (size_t)i * 4); } }
#pragma unroll
        for (int r = 0; r < 4; ++r) { const int i = i0 + r * NT; if (i < N4) {
            const f32x4 av = a[r] * 256.f, bv = b[r] * 64.f; unsigned x = 0u, y = 0u;
            x = __builtin_amdgcn_cvt_pk_fp8_f32(av.x, av.y, x, false); x = __builtin_amdgcn_cvt_pk_fp8_f32(av.z, av.w, x, true);
            y = __builtin_amdgcn_cvt_pk_fp8_f32(bv.x, bv.y, y, false); y = __builtin_amdgcn_cvt_pk_fp8_f32(bv.z, bv.w, y, true);
            *(unsigned*)(u8 + (size_t)i * 4) = x; *(unsigned*)(v8 + (size_t)i * 4) = y; } }
    }
}

__device__ __forceinline__ void p_gather8(const Ctx& C, const bf16_t* n2, const unsigned short* pidx, const float* pgate, const unsigned char* u8, const unsigned char* v8, const float* h, float* out) {
    const float* mod = C.f32p(WS_MOD); const float* fg = C.in[23];
    LAS float* cbuf = (LAS float*)C.lds + C.wave * 128;
    const int gw = C.bid * NWAVES + C.wave, NGW = C.G * NWAVES, lane = C.lane;
    for (int t = gw; t < T; t += NGW) {
        const int b = t / SEQ;
        unsigned xp[8];
        { const u32x4 x0 = *(const u32x4*)(n2 + (size_t)t * 1024 + lane * 16), x1 = *(const u32x4*)(n2 + (size_t)t * 1024 + lane * 16 + 8);
          xp[0] = x0.x; xp[1] = x0.y; xp[2] = x0.z; xp[3] = x0.w; xp[4] = x1.x; xp[5] = x1.y; xp[6] = x1.z; xp[7] = x1.w; }
        const int id0 = pidx[(size_t)t * 128 + lane], id1 = pidx[(size_t)t * 128 + 64 + lane];
        const float g0 = pgate[(size_t)t * 128 + lane], g1 = pgate[(size_t)t * 128 + 64 + lane];
        u32x4 bufA[8], bufB[8];
#define G8_LOAD8(buf_, tab_, slot0_) do { const int idv_ = (slot0_) < 64 ? id0 : id1; _Pragma("unroll") for (int j_ = 0; j_ < 8; ++j_) { const int e_ = __builtin_amdgcn_readlane(idv_, ((slot0_) & 63) + j_); \
            buf_[j_] = *(const u32x4*)((tab_) + (size_t)e_ * 1024 + lane * 16); } } while (0)
#define G8_UDOT8(buf_, off_) do { _Pragma("unroll") for (int j_ = 0; j_ < 8; ++j_) { float acc_ = 0.f; \
                _Pragma("unroll") for (int d_ = 0; d_ < 4; ++d_) { const unsigned wv_ = buf_[j_][d_]; \
                    const bf16x2_t lo_ = __builtin_amdgcn_cvt_scalef32_pk_bf16_fp8(wv_, 0.00390625f, false), hi_ = __builtin_amdgcn_cvt_scalef32_pk_bf16_fp8(wv_, 0.00390625f, true); \
                    const unsigned xa_ = xp[2 * d_], xb_ = xp[2 * d_ + 1]; \
                    acc_ = __builtin_amdgcn_fdot2_f32_bf16(lo_, __builtin_bit_cast(bf16x2_t, xa_), acc_, false); acc_ = __builtin_amdgcn_fdot2_f32_bf16(hi_, __builtin_bit_cast(bf16x2_t, xb_), acc_, false); } \
                part[(off_) + j_] = acc_; __builtin_amdgcn_sched_barrier(0); } } while (0)
#define G8_REDUCE(grp_) do { \
            float p8[8]; { const bool hi = (lane & 32) != 0; \
              _Pragma("unroll") for (int j_ = 0; j_ < 8; ++j_) { const float keep = hi ? part[j_ + 8] : part[j_], send = hi ? part[j_] : part[j_ + 8]; p8[j_] = keep + __shfl_xor(send, 32); } } \
            float p4[4]; { const bool hi = (lane & 16) != 0; \
              _Pragma("unroll") for (int j_ = 0; j_ < 4; ++j_) { const float keep = hi ? p8[j_ + 4] : p8[j_], send = hi ? p8[j_] : p8[j_ + 4]; p4[j_] = keep + __shfl_xor(send, 16); } } \
            float p2[2]; { const bool hi = (lane & 8) != 0; \
              _Pragma("unroll") for (int j_ = 0; j_ < 2; ++j_) { const float keep = hi ? p4[j_ + 2] : p4[j_], send = hi ? p4[j_] : p4[j_ + 2]; p2[j_] = keep + __shfl_xor(send, 8); } } \
            float p1; { const bool hi = (lane & 4) != 0; const float keep = hi ? p2[1] : p2[0], send = hi ? p2[0] : p2[1]; p1 = keep + __shfl_xor(send, 4); } \
            p1 += __shfl_xor(p1, 2); p1 += __shfl_xor(p1, 1); \
            const int E_ = ((lane >> 5) & 1) * 8 + ((lane >> 4) & 1) * 4 + ((lane >> 3) & 1) * 2 + ((lane >> 2) & 1); \
            if ((lane & 3) == 0) cbuf[(grp_) * 16 + E_] = gelu_f(p1); } while (0)
        G8_LOAD8(bufA, u8, 0); G8_LOAD8(bufB, u8, 8);
#pragma unroll 1
        for (int grp = 0; grp < 8; ++grp) {
            float part[16];
            G8_UDOT8(bufA, 0);
            if (grp < 7) G8_LOAD8(bufA, u8, 16 * (grp + 1)); else G8_LOAD8(bufA, v8, 0);
            G8_UDOT8(bufB, 8);
            if (grp < 7) G8_LOAD8(bufB, u8, 16 * (grp + 1) + 8); else G8_LOAD8(bufB, v8, 8);
            G8_REDUCE(grp);
        }
        asm volatile("s_waitcnt lgkmcnt(0)" ::: "memory");
        const float c0 = cbuf[lane] * g0 * 0.015625f, c1 = cbuf[64 + lane] * g1 * 0.015625f;
        asm volatile("s_waitcnt lgkmcnt(0)" ::: "memory");
        float acc[16];
#pragma unroll
        for (int i = 0; i < 16; ++i) acc[i] = 0.f;
#define G8_VCOMP8(buf_, slot0_) do { const float cv_ = (slot0_) < 64 ? c0 : c1; _Pragma("unroll") for (int j_ = 0; j_ < 8; ++j_) { const float ck_ = __int_as_float(__builtin_amdgcn_readlane(__float_as_int(cv_), ((slot0_) & 63) + j_)); \
            _Pragma("unroll") for (int d_ = 0; d_ < 4; ++d_) { const unsigned wv_ = buf_[j_][d_]; const f32x2_t lo_ = __builtin_amdgcn_cvt_pk_f32_fp8(wv_, false), hi_ = __builtin_amdgcn_cvt_pk_f32_fp8(wv_, true); \
                acc[4 * d_ + 0] += ck_ * lo_.x; acc[4 * d_ + 1] += ck_ * lo_.y; acc[4 * d_ + 2] += ck_ * hi_.x; acc[4 * d_ + 3] += ck_ * hi_.y; } \
            asm volatile("" : "+v"(acc[0]), "+v"(acc[1]), "+v"(acc[2]), "+v"(acc[3]), "+v"(acc[4]), "+v"(acc[5]), "+v"(acc[6]), "+v"(acc[7]), "+v"(acc[8]), "+v"(acc[9]), "+v"(acc[10]), "+v"(acc[11]), "+v"(acc[12]), "+v"(acc[13]), "+v"(acc[14]), "+v"(acc[15])); } } while (0)
#pragma unroll 1
        for (int grp = 0; grp < 8; ++grp) {
            G8_VCOMP8(bufA, 16 * grp);
            if (grp < 7) G8_LOAD8(bufA, v8, 16 * (grp + 1));
            G8_VCOMP8(bufB, 16 * grp + 8);
            if (grp < 7) G8_LOAD8(bufB, v8, 16 * (grp + 1) + 8);
        }
#undef G8_LOAD8
#undef G8_UDOT8
#undef G8_REDUCE
#undef G8_VCOMP8
        float hf[16]; float ss = 0.f;
#pragma unroll
        for (int d = 0; d < 4; ++d) { const int col = lane * 16 + d * 4;
            const f32x4 hv = *(const f32x4*)(h + (size_t)t * 1024 + col), mv = *(const f32x4*)(mod + b * 6144 + 5120 + col);
            hf[4 * d + 0] = hv.x + mv.x * acc[4 * d + 0]; hf[4 * d + 1] = hv.y + mv.y * acc[4 * d + 1]; hf[4 * d + 2] = hv.z + mv.z * acc[4 * d + 2]; hf[4 * d + 3] = hv.w + mv.w * acc[4 * d + 3]; }
#pragma unroll
        for (int i = 0; i < 16; ++i) ss += hf[i] * hf[i];
        const float rstd = rsqrtf(wave_sum(ss) * (1.f / 1024.f) + EPS);
#pragma unroll
        for (int d = 0; d < 4; ++d) { const int col = lane * 16 + d * 4; const f32x4 fv = *(const f32x4*)(fg + col);
            f32x4 o; o.x = hf[4 * d + 0] * rstd * fv.x; o.y = hf[4 * d + 1] * rstd * fv.y; o.z = hf[4 * d + 2] * rstd * fv.z; o.w = hf[4 * d + 3] * rstd * fv.w;
            *(f32x4*)(out + (size_t)t * 1024 + col) = o; }
    }
}


__device__ __forceinline__ int idx16(const u32x4& a, const u32x4& b, int i) { const unsigned w = (i < 8 ? a : b)[(i & 7) >> 1]; return (int)((i & 1) ? (w >> 16) : (w & 0xffffu)); }
__device__ __forceinline__ void p_gu(const Ctx& C, const bf16_t* n2, const unsigned short* pidx, const unsigned char* u8, float* pd) {
    const int j = C.bid & 7, nsl = C.G >> 3, NW = nsl * NWAVES, wsl = (C.bid >> 3) * NWAVES + C.wave, lane = C.lane, s = lane & 7, q = lane >> 3;
    if ((C.bid >> 3) >= nsl) return;
    u32x4 ea, eb, x0, x1;
    { const int t = wsl; ea = *(const u32x4*)(pidx + (size_t)t * 128 + q * 16); eb = *(const u32x4*)(pidx + (size_t)t * 128 + q * 16 + 8);
      x0 = *(const u32x4*)(n2 + (size_t)t * 1024 + 128 * j + 16 * s); x1 = *(const u32x4*)(n2 + (size_t)t * 1024 + 128 * j + 16 * s + 8); }
    for (int t = wsl; t < T; t += NW) {
        u32x4 p[16];
#pragma unroll
        for (int i = 0; i < 16; ++i) p[i] = *(const u32x4*)(u8 + (size_t)idx16(ea, eb, i) * 1024 + 128 * j + 16 * s);
        const unsigned xp[8] = {x0.x, x0.y, x0.z, x0.w, x1.x, x1.y, x1.z, x1.w};
        { const int tn = (t + NW < T) ? t + NW : t;
          ea = *(const u32x4*)(pidx + (size_t)tn * 128 + q * 16); eb = *(const u32x4*)(pidx + (size_t)tn * 128 + q * 16 + 8);
          x0 = *(const u32x4*)(n2 + (size_t)tn * 1024 + 128 * j + 16 * s); x1 = *(const u32x4*)(n2 + (size_t)tn * 1024 + 128 * j + 16 * s + 8); }
        float part[16];
#pragma unroll
        for (int i = 0; i < 16; ++i) { float acc = 0.f;
#pragma unroll
            for (int d = 0; d < 4; ++d) { const unsigned wv = p[i][d];
                const bf16x2_t lo = __builtin_amdgcn_cvt_scalef32_pk_bf16_fp8(wv, 0.00390625f, false), hi = __builtin_amdgcn_cvt_scalef32_pk_bf16_fp8(wv, 0.00390625f, true);
                const unsigned xa = xp[2 * d], xb = xp[2 * d + 1];
                acc = __builtin_amdgcn_fdot2_f32_bf16(lo, __builtin_bit_cast(bf16x2_t, xa), acc, false); acc = __builtin_amdgcn_fdot2_f32_bf16(hi, __builtin_bit_cast(bf16x2_t, xb), acc, false); }
            part[i] = acc; }
        float p8[8]; { const bool hb = (lane & 4) != 0;
#pragma unroll
            for (int i = 0; i < 8; ++i) { const float keep = hb ? part[i + 8] : part[i], send = hb ? part[i] : part[i + 8]; p8[i] = keep + __shfl_xor(send, 4); } }
        float p4[4]; { const bool hb = (lane & 2) != 0;
#pragma unroll
            for (int i = 0; i < 4; ++i) { const float keep = hb ? p8[i + 4] : p8[i], send = hb ? p8[i] : p8[i + 4]; p4[i] = keep + __shfl_xor(send, 2); } }
        float p2[2]; { const bool hb = (lane & 1) != 0;
#pragma unroll
            for (int i = 0; i < 2; ++i) { const float keep = hb ? p4[i + 2] : p4[i], send = hb ? p4[i] : p4[i + 2]; p2[i] = keep + __shfl_xor(send, 1); } }
        const int i0 = ((lane >> 2) & 1) * 8 + ((lane >> 1) & 1) * 4 + (lane & 1) * 2;
        f32x2_t o; o.x = p2[0]; o.y = p2[1];
        *(f32x2_t*)(pd + ((size_t)j * T + t) * 128 + q * 16 + i0) = o;
    }
}
__device__ __forceinline__ void p_gc(const Ctx& C, const float* pd, const float* pgate, float* cc) {
    const int gt = C.bid * NTHR + C.tid, NT = C.G * NTHR;
    for (int i = gt; i < T * 128; i += NT) { const int t = i >> 7, k = i & 127;
        float sdot = 0.f;
#pragma unroll
        for (int j = 0; j < 8; ++j) sdot += pd[((size_t)j * T + t) * 128 + k];
        cc[i] = gelu_f(sdot) * pgate[i] * 0.015625f; }
}
__device__ __forceinline__ void p_gv(const Ctx& C, const float* cc, const unsigned short* pidx, const unsigned char* v8, bf16_t* op) {
    const int j = C.bid & 7, nsl = C.G >> 3, NW = nsl * NWAVES, wsl = (C.bid >> 3) * NWAVES + C.wave, lane = C.lane, s = lane & 7, q = lane >> 3;
    if ((C.bid >> 3) >= nsl) return;
    u32x4 ea, eb; f32x4 c4[4];
    { const int t = wsl; ea = *(const u32x4*)(pidx + (size_t)t * 128 + q * 16); eb = *(const u32x4*)(pidx + (size_t)t * 128 + q * 16 + 8);
#pragma unroll
      for (int d = 0; d < 4; ++d) c4[d] = *(const f32x4*)(cc + (size_t)t * 128 + q * 16 + 4 * d); }
    for (int t = wsl; t < T; t += NW) {
        u32x4 p[16];
#pragma unroll
        for (int i = 0; i < 16; ++i) p[i] = *(const u32x4*)(v8 + (size_t)idx16(ea, eb, i) * 1024 + 128 * j + 16 * s);
        float cv[16];
#pragma unroll
        for (int d = 0; d < 4; ++d) { cv[4 * d] = c4[d].x; cv[4 * d + 1] = c4[d].y; cv[4 * d + 2] = c4[d].z; cv[4 * d + 3] = c4[d].w; }
        { const int tn = (t + NW < T) ? t + NW : t;
          ea = *(const u32x4*)(pidx + (size_t)tn * 128 + q * 16); eb = *(const u32x4*)(pidx + (size_t)tn * 128 + q * 16 + 8);
#pragma unroll
          for (int d = 0; d < 4; ++d) c4[d] = *(const f32x4*)(cc + (size_t)tn * 128 + q * 16 + 4 * d); }
        float acc[16];
#pragma unroll
        for (int c = 0; c < 16; ++c) acc[c] = 0.f;
#pragma unroll
        for (int i = 0; i < 16; ++i) { const float ck = cv[i];
#pragma unroll
            for (int d = 0; d < 4; ++d) { const unsigned wv = p[i][d]; const f32x2_t lo = __builtin_amdgcn_cvt_pk_f32_fp8(wv, false), hi = __builtin_amdgcn_cvt_pk_f32_fp8(wv, true);
                acc[4 * d + 0] += ck * lo.x; acc[4 * d + 1] += ck * lo.y; acc[4 * d + 2] += ck * hi.x; acc[4 * d + 3] += ck * hi.y; }
            asm volatile("" : "+v"(acc[0]), "+v"(acc[1]), "+v"(acc[2]), "+v"(acc[3]), "+v"(acc[4]), "+v"(acc[5]), "+v"(acc[6]), "+v"(acc[7]), "+v"(acc[8]), "+v"(acc[9]), "+v"(acc[10]), "+v"(acc[11]), "+v"(acc[12]), "+v"(acc[13]), "+v"(acc[14]), "+v"(acc[15])); }
        float p8[8]; { const bool hb = (lane & 32) != 0;
#pragma unroll
            for (int i = 0; i < 8; ++i) { const float keep = hb ? acc[i + 8] : acc[i], send = hb ? acc[i] : acc[i + 8]; p8[i] = keep + __shfl_xor(send, 32); } }
        float p4[4]; { const bool hb = (lane & 16) != 0;
#pragma unroll
            for (int i = 0; i < 4; ++i) { const float keep = hb ? p8[i + 4] : p8[i], send = hb ? p8[i] : p8[i + 4]; p4[i] = keep + __shfl_xor(send, 16); } }
        float p2[2]; { const bool hb = (lane & 8) != 0;
#pragma unroll
            for (int i = 0; i < 2; ++i) { const float keep = hb ? p4[i + 2] : p4[i], send = hb ? p4[i] : p4[i + 2]; p2[i] = keep + __shfl_xor(send, 8); } }
        const int c0 = ((lane >> 5) & 1) * 8 + ((lane >> 4) & 1) * 4 + ((lane >> 3) & 1) * 2;
        *(unsigned*)(op + (size_t)t * 1024 + 128 * j + 16 * s + c0) = pk2(p2[0], p2[1]);
    }
}
__device__ __forceinline__ void p_gf(const Ctx& C, const bf16_t* h, const bf16_t* op, float* out) {
    const float* mod = C.f32p(WS_MOD); const float* fg = C.in[23];
    const int gw = C.bid * NWAVES + C.wave, NGW = C.G * NWAVES, lane = C.lane;
    for (int t = gw; t < T; t += NGW) {
        const int b = t / SEQ;
        f32x4 hf[4]; float ss = 0.f;
#pragma unroll
        for (int d = 0; d < 4; ++d) { const int col = 256 * d + 4 * lane;
            const u32x2 ov = *(const u32x2*)(op + (size_t)t * 1024 + col);
            const u32x2 hw = *(const u32x2*)(h + (size_t)t * 1024 + col); f32x4 hv; hv.x = bflo(hw.x); hv.y = bfhi(hw.x); hv.z = bflo(hw.y); hv.w = bfhi(hw.y);
            const f32x4 mv = *(const f32x4*)(mod + b * 6144 + 5120 + col);
            f32x4 o4; o4.x = bflo(ov.x); o4.y = bfhi(ov.x); o4.z = bflo(ov.y); o4.w = bfhi(ov.y);
            hf[d] = hv + mv * o4; ss += (hf[d].x * hf[d].x + hf[d].y * hf[d].y) + (hf[d].z * hf[d].z + hf[d].w * hf[d].w); }
        const float rstd = rsqrtf(wave_sum(ss) * (1.f / 1024.f) + EPS);
#pragma unroll
        for (int d = 0; d < 4; ++d) { const int col = 256 * d + 4 * lane; const f32x4 fv = *(const f32x4*)(fg + col);
            *(f32x4*)(out + (size_t)t * 1024 + col) = hf[d] * rstd * fv; }
    }
}

__device__ __forceinline__ void p_gather_ref(const Ctx& C, const bf16_t* n2, const unsigned short* pidx, const float* pgate, const float* h, float* out) {
    const float* mod = C.f32p(WS_MOD); const float* fg = C.in[23]; const float* U = C.in[21]; const float* V = C.in[22];
    LAS float* xs = (LAS float*)C.lds;
    LAS float* part = xs + 1024;
    LAS float* cs = part + 512;
    LAS float* red = cs + 128;
    LAS int* es = (LAS int*)(red + 512);
    const int tid = C.tid;
    for (int t = C.bid; t < T; t += C.G) {
        const int b = t / SEQ;
        __syncthreads();
        xs[tid] = bf2f(n2[(size_t)t * 1024 + tid]); xs[tid + 512] = bf2f(n2[(size_t)t * 1024 + 512 + tid]);
        if (tid < 128) es[tid] = pidx[(size_t)t * 128 + tid];
        __syncthreads();
        { const int k = tid >> 2, qd = tid & 3; const float* ur = U + (size_t)es[k] * 1024 + qd * 256; float acc = 0.f;
          for (int d = 0; d < 256; ++d) acc += ur[d] * xs[qd * 256 + d];
          part[tid] = acc; }
        __syncthreads();
        if (tid < 128) { const float dsum = part[tid * 4] + part[tid * 4 + 1] + part[tid * 4 + 2] + part[tid * 4 + 3]; cs[tid] = gelu_f(dsum) * pgate[(size_t)t * 128 + tid]; }
        __syncthreads();
        float o0 = 0.f, o1 = 0.f;
        for (int k = 0; k < 128; ++k) { const float* vr = V + (size_t)es[k] * 1024; const float ck = cs[k]; o0 += ck * vr[tid]; o1 += ck * vr[tid + 512]; }
        const float h0 = h[(size_t)t * 1024 + tid] + mod[b * 6144 + 5120 + tid] * o0, h1 = h[(size_t)t * 1024 + 512 + tid] + mod[b * 6144 + 5120 + 512 + tid] * o1;
        red[tid] = h0 * h0 + h1 * h1;
        __syncthreads();
        for (int sft = 256; sft > 0; sft >>= 1) { if (tid < sft) red[tid] += red[tid + sft]; __syncthreads(); }
        const float rstd = rsqrtf(red[0] * (1.f / 1024.f) + EPS);
        out[(size_t)t * 1024 + tid] = h0 * rstd * fg[tid]; out[(size_t)t * 1024 + 512 + tid] = h1 * rstd * fg[tid + 512];
    }
}

namespace pg8 {
#define PG8_LAS __attribute__((address_space(3)))
typedef unsigned short bf16_t;
typedef short bf16x8 __attribute__((ext_vector_type(8)));
typedef float f32x4 __attribute__((ext_vector_type(4)));
typedef unsigned u32x4 __attribute__((ext_vector_type(4)));
constexpr int BM = 256, BK = 64, HALF = 128, HTB = HALF * BK * 2  , STAGE_BYTES = 8 * HTB, NXCD = 8, WGM = 8;

__host__ __device__ __forceinline__ int lds_byte(int r, int c) { const int st = (r >> 4) * 2 + (c >> 5), rr = r & 15, cc = c & 31, ob = rr * 64 + cc * 2; return st * 1024 + (ob ^ (((ob >> 9) & 1) << 5)); }
__host__ __device__ __forceinline__ void stage_rc(int b, int& R, int& C) { const int st = b / 1024, sb = b % 1024, swz = sb ^ (((sb >> 9) & 1) << 5); R = (st >> 1) * 16 + swz / 64; C = (st & 1) * 32 + (swz % 64) / 2; }
__host__ __device__ __forceinline__ int perm32(int rho) { const int n = rho >> 4, i = rho & 15; return 8 * (i >> 2) + 4 * n + (i & 3); }

struct Unit { int pm, pn, kind; };
struct Gemm { const bf16_t* A; const bf16_t* Bt; int M, N, K; const bf16_t *A1, *B1, *A2, *B2, *A3, *B3; };

struct StaticOrder {
    static constexpr bool MULTI = false;
    int nM, nN, nwg, G, c;
    __host__ __device__ void init(int M, int N, int G_, int c_) { nM = M / BM; nN = N / BM; nwg = nM * nN; G = G_; c = c_; }
    __host__ __device__ bool next(int i, Unit& u) const {
        const long L = (long)i * G + c; if (L >= nwg) return false;
        int wgid = (int)L; { const int q = nwg / NXCD, r = nwg % NXCD, xcd = wgid % NXCD, off = wgid / NXCD; wgid = (xcd < r ? xcd * (q + 1) : r * (q + 1) + (xcd - r) * q) + off; }
        const int nig = WGM * nN, gid = wgid / nig, fm = gid * WGM, gsz = (nM - fm) < WGM ? (nM - fm) : WGM;
        u.pm = fm + ((wgid % nig) % gsz); u.pn = (wgid % nig) / gsz; u.kind = 0; return true;
    }
    __device__ __forceinline__ void a_ready(const Unit&) const {}
    __device__ __forceinline__ void done(const Unit&) const {}
};

struct MultiOrder {
    static constexpr bool MULTI = true;
    StaticOrder b; int nk;
    __host__ __device__ bool next(int i, Unit& u) const { if (!b.next(i / nk, u)) return false; u.kind = i % nk; return true; }
    __device__ __forceinline__ void a_ready(const Unit&) const {}
    __device__ __forceinline__ void done(const Unit&) const {}
};

__device__ __forceinline__ unsigned cvt_pk_bf16(float lo, float hi) { return ::pk2(lo, hi); }
__device__ __forceinline__ float e_silu(float x) { return x / (1.f + __expf(-x)); }
__device__ __forceinline__ float e_sigm(float x) { return 1.f / (1.f + __expf(-x)); }
__device__ __forceinline__ float e_lo(unsigned v) { return __uint_as_float(v << 16); }
__device__ __forceinline__ float e_hi(unsigned v) { return __uint_as_float(v & 0xffff0000u); }
__device__ __forceinline__ u32x4 pack8(const f32x4 v0, const f32x4 v1) { u32x4 w; w.x = cvt_pk_bf16(v0[0], v0[1]); w.y = cvt_pk_bf16(v0[2], v0[3]); w.z = cvt_pk_bf16(v1[0], v1[1]); w.w = cvt_pk_bf16(v1[2], v1[3]); return w; }

struct EpiInProj {
    static constexpr bool PERM = true, AFTER_DRAIN = false;
    bf16_t *sz, *xbc, *q, *k, *v;
    __device__ __forceinline__ void operator()(const f32x4 (&acc)[2][2][4][2], const Unit& u, int wr, int wc, int fr, int fq) const {
        const int pn = u.pn; bf16_t* base; int ldc = 1024, colt, mode = 0;
        if (pn < 4) { base = sz; colt = pn * 256; mode = 1; }
        else if (pn < 12) { base = xbc; ldc = 2048; colt = (pn - 4) * 256; }
        else if (pn < 16) { base = q; colt = (pn - 12) * 256; mode = 2; }
        else if (pn < 20) { base = k; colt = (pn - 16) * 256; }
        else { base = v; colt = (pn - 20) * 256; }
        const int row0 = u.pm * BM + wr * 64 + fr, col0 = colt + wc * 32 + 8 * fq;
#pragma unroll
        for (int ai = 0; ai < 2; ++ai)
#pragma unroll
            for (int m = 0; m < 4; ++m) { bf16_t* rowp = base + (size_t)(row0 + ai * HALF + m * 16) * ldc + col0;
#pragma unroll
                for (int bj = 0; bj < 2; ++bj) { f32x4 v0 = acc[ai][bj][m][0], v1 = acc[ai][bj][m][1];
                    if (mode == 1) {
#pragma unroll
                        for (int i = 0; i < 4; ++i) { v0[i] = e_silu(v0[i]); v1[i] = e_silu(v1[i]); } }
                    else if (mode == 2) { v0 = v0 * 0.125f; v1 = v1 * 0.125f; }
                    *(u32x4*)(rowp + bj * HALF) = pack8(v0, v1); } }
    }
};
struct EpiGate {
    static constexpr bool PERM = true, AFTER_DRAIN = false;
    bf16_t* sg; size_t plane;
    __device__ __forceinline__ void operator()(const f32x4 (&acc)[2][2][4][2], const Unit& u, int wr, int wc, int fr, int fq) const {
        bf16_t* base = sg + (size_t)(u.pn >> 2) * plane; const int colt = (u.pn & 3) * 256;
        const int row0 = u.pm * BM + wr * 64 + fr, col0 = colt + wc * 32 + 8 * fq;
#pragma unroll
        for (int ai = 0; ai < 2; ++ai)
#pragma unroll
            for (int m = 0; m < 4; ++m) { bf16_t* rowp = base + (size_t)(row0 + ai * HALF + m * 16) * 1024 + col0;
#pragma unroll
                for (int bj = 0; bj < 2; ++bj) { f32x4 v0 = acc[ai][bj][m][0], v1 = acc[ai][bj][m][1];
#pragma unroll
                    for (int i = 0; i < 4; ++i) { v0[i] = e_sigm(v0[i]); v1[i] = e_sigm(v1[i]); }
                    *(u32x4*)(rowp + bj * HALF) = pack8(v0, v1); } }
    }
};
struct EpiD1 {
    static constexpr bool PERM = true, AFTER_DRAIN = false;
    bf16_t* p1; const bf16_t* sg1; const float* rstd;
    __device__ __forceinline__ void operator()(const f32x4 (&acc)[2][2][4][2], const Unit& u, int wr, int wc, int fr, int fq) const {
        const int row0 = u.pm * BM + wr * 64 + fr, col0 = u.pn * BM + wc * 32 + 8 * fq;
#pragma unroll
        for (int ai = 0; ai < 2; ++ai)
#pragma unroll
            for (int m = 0; m < 4; ++m) { const int row = row0 + ai * HALF + m * 16; const float rs = rstd[row]; const size_t off = (size_t)row * 1024 + col0;
#pragma unroll
                for (int bj = 0; bj < 2; ++bj) { f32x4 v0 = acc[ai][bj][m][0] * rs, v1 = acc[ai][bj][m][1] * rs;
                    const u32x4 g = *(const u32x4*)(sg1 + off + bj * HALF);
                    v0[0] *= e_lo(g.x); v0[1] *= e_hi(g.x); v0[2] *= e_lo(g.y); v0[3] *= e_hi(g.y); v1[0] *= e_lo(g.z); v1[1] *= e_hi(g.z); v1[2] *= e_lo(g.w); v1[3] *= e_hi(g.w);
                    *(u32x4*)(p1 + off + bj * HALF) = pack8(v0, v1); } }
    }
};
struct EpiD2 {
    static constexpr bool PERM = true, AFTER_DRAIN = false;
    bf16_t* mixed; const bf16_t *p1, *sg2;
    __device__ __forceinline__ void operator()(const f32x4 (&acc)[2][2][4][2], const Unit& u, int wr, int wc, int fr, int fq) const {
        const int row0 = u.pm * BM + wr * 64 + fr, col0 = u.pn * BM + wc * 32 + 8 * fq;
#pragma unroll
        for (int ai = 0; ai < 2; ++ai)
#pragma unroll
            for (int m = 0; m < 4; ++m) { const int row = row0 + ai * HALF + m * 16; const size_t off = (size_t)row * 1024 + col0;
#pragma unroll
                for (int bj = 0; bj < 2; ++bj) { f32x4 v0 = acc[ai][bj][m][0], v1 = acc[ai][bj][m][1];
                    const u32x4 g = *(const u32x4*)(sg2 + off + bj * HALF), p = *(const u32x4*)(p1 + off + bj * HALF);
                    v0[0] = e_lo(p.x) + v0[0] * e_lo(g.x); v0[1] = e_hi(p.x) + v0[1] * e_hi(g.x); v0[2] = e_lo(p.y) + v0[2] * e_lo(g.y); v0[3] = e_hi(p.y) + v0[3] * e_hi(g.y);
                    v1[0] = e_lo(p.z) + v1[0] * e_lo(g.z); v1[1] = e_hi(p.z) + v1[1] * e_hi(g.z); v1[2] = e_lo(p.w) + v1[2] * e_lo(g.w); v1[3] = e_hi(p.w) + v1[3] * e_hi(g.w);
                    *(u32x4*)(mixed + off + bj * HALF) = pack8(v0, v1); } }
    }
};

struct EpiMix {
    static constexpr bool PERM = true, AFTER_DRAIN = false;
    bf16_t *sg1, *sg2, *mixed; const float* rstd;
    __device__ __forceinline__ bool operator()(f32x4 (&acc)[2][2][4][2], const Unit& u, int wr, int wc, int fr, int fq) const {
        const int row0 = u.pm * BM + wr * 64 + fr, col0 = u.pn * BM + wc * 32 + 8 * fq; const int kind = u.kind;
#pragma unroll
        for (int ai = 0; ai < 2; ++ai)
#pragma unroll
            for (int m = 0; m < 4; ++m) { const int row = row0 + ai * HALF + m * 16; const size_t off = (size_t)row * 1024 + col0;
                const float rs = (kind == 2) ? rstd[row] : 1.f;
#pragma unroll
                for (int bj = 0; bj < 2; ++bj) { f32x4 v0 = acc[ai][bj][m][0], v1 = acc[ai][bj][m][1];
                    if (kind < 2) {
#pragma unroll
                        for (int i = 0; i < 4; ++i) { v0[i] = e_sigm(v0[i]); v1[i] = e_sigm(v1[i]); }
                        *(u32x4*)((kind == 0 ? sg1 : sg2) + off + bj * HALF) = pack8(v0, v1);
                    } else if (kind == 2) {
                        const u32x4 a = *(const u32x4*)(sg1 + off + bj * HALF), b = *(const u32x4*)(sg2 + off + bj * HALF);
                        v0[0] *= rs * e_lo(a.x) / fmaxf(e_lo(b.x), 1e-30f); v0[1] *= rs * e_hi(a.x) / fmaxf(e_hi(b.x), 1e-30f); v0[2] *= rs * e_lo(a.y) / fmaxf(e_lo(b.y), 1e-30f); v0[3] *= rs * e_hi(a.y) / fmaxf(e_hi(b.y), 1e-30f);
                        v1[0] *= rs * e_lo(a.z) / fmaxf(e_lo(b.z), 1e-30f); v1[1] *= rs * e_hi(a.z) / fmaxf(e_hi(b.z), 1e-30f); v1[2] *= rs * e_lo(a.w) / fmaxf(e_lo(b.w), 1e-30f); v1[3] *= rs * e_hi(a.w) / fmaxf(e_hi(b.w), 1e-30f);
                        acc[ai][bj][m][0] = v0; acc[ai][bj][m][1] = v1;
                    } else {
                        const u32x4 b = *(const u32x4*)(sg2 + off + bj * HALF);
                        v0[0] *= e_lo(b.x); v0[1] *= e_hi(b.x); v0[2] *= e_lo(b.y); v0[3] *= e_hi(b.y); v1[0] *= e_lo(b.z); v1[1] *= e_hi(b.z); v1[2] *= e_lo(b.w); v1[3] *= e_hi(b.w);
                        *(u32x4*)(mixed + off + bj * HALF) = pack8(v0, v1);
                    } } }
        return kind == 2;
    }
};
struct EpiD3 {
    static constexpr bool PERM = true, AFTER_DRAIN = false;
    bf16_t* h; const float* x; const float* mod;
    __device__ __forceinline__ void operator()(const f32x4 (&acc)[2][2][4][2], const Unit& u, int wr, int wc, int fr, int fq) const {
        const int row0 = u.pm * BM + wr * 64 + fr, col0 = u.pn * BM + wc * 32 + 8 * fq;
        const float* g1 = mod + (size_t)((u.pm * BM) >> 12) * 6144 + 2048;
#pragma unroll
        for (int ai = 0; ai < 2; ++ai)
#pragma unroll
            for (int m = 0; m < 4; ++m) { const size_t off = (size_t)(row0 + ai * HALF + m * 16) * 1024 + col0;
#pragma unroll
                for (int bj = 0; bj < 2; ++bj) { const int c = bj * HALF;
                    const f32x4 x0 = *(const f32x4*)(x + off + c), x1 = *(const f32x4*)(x + off + c + 4), g0 = *(const f32x4*)(g1 + col0 + c), g4 = *(const f32x4*)(g1 + col0 + c + 4);
                    *(u32x4*)(h + off + c) = pack8(x0 + g0 * acc[ai][bj][m][0], x1 + g4 * acc[ai][bj][m][1]); } }
    }
};
struct EpiQp {
    static constexpr bool PERM = true, AFTER_DRAIN = false;
    bf16_t* qp;
    __device__ __forceinline__ void operator()(const f32x4 (&acc)[2][2][4][2], const Unit& u, int wr, int wc, int fr, int fq) const {
        const int row0 = u.pm * BM + wr * 64 + fr, col0 = u.pn * BM + wc * 32 + 8 * fq;
#pragma unroll
        for (int ai = 0; ai < 2; ++ai)
#pragma unroll
            for (int m = 0; m < 4; ++m) { bf16_t* rowp = qp + (size_t)(row0 + ai * HALF + m * 16) * 2048 + col0;
#pragma unroll
                for (int bj = 0; bj < 2; ++bj) *(u32x4*)(rowp + bj * HALF) = pack8(acc[ai][bj][m][0], acc[ai][bj][m][1]); }
    }
};

template <class Epi, class Sched, bool ALIGN_EPI = false, bool SP2 = false>
__device__ __forceinline__ void gemm_phase(PG8_LAS unsigned char* lds, const Gemm g, const Sched& S, const Epi& E) {
    const int tid = threadIdx.x, wid = __builtin_amdgcn_readfirstlane(tid >> 6), lane = tid & 63, wr = wid >> 2, wc = wid & 3, fr = lane & 15, fq = lane >> 4;
    const int K = g.K, nt = K / BK;
    unsigned voffA[2], voffB[2];
#pragma unroll
    for (int i = 0; i < 2; ++i) { int R, C; stage_rc(tid * 16 + i * 8192, R, C); const int Rb = Epi::PERM ? ((R & ~31) + perm32(R & 31)) : R;
        voffA[i] = (unsigned)(R * K + C) * 2u; voffB[i] = (unsigned)(Rb * K + C) * 2u; }
    const size_t kstep = (size_t)(BK * 2);
    const size_t hstep = (size_t)HALF * K * 2;
    const size_t tstep = 2 * hstep;
    const unsigned ldsw = (unsigned)wid * 1024u;
    const int aoff = lds_byte(wr * 64 + fr, fq * 8), boff = lds_byte(wc * 32 + fr, fq * 8);
#define PG8_SA(b, h) (((b) * 2 + (h)) * HTB)
#define PG8_SB(b, h) ((4 + (b) * 2 + (h)) * HTB)
#define PG8_STAGE(bufoff, gbase, voff) do { _Pragma("unroll") for (int _i = 0; _i < 2; ++_i) \
        __builtin_amdgcn_global_load_lds((const unsigned*)((const char*)(gbase) + (voff)[_i]), (PG8_LAS unsigned*)(lds + (bufoff) + ldsw + _i * 8192), 16, 0, 0); } while (0)
#define PG8_LDA(dst, b, h) do { _Pragma("unroll") for (int m = 0; m < 4; ++m) _Pragma("unroll") for (int k = 0; k < 2; ++k) dst[m][k] = *(const PG8_LAS bf16x8*)(lds + PG8_SA(b, h) + aoff + m * 2048 + k * 1024); } while (0)
#define PG8_LDB(dst, b, h) do { _Pragma("unroll") for (int n = 0; n < 2; ++n) _Pragma("unroll") for (int k = 0; k < 2; ++k) dst[n][k] = *(const PG8_LAS bf16x8*)(lds + PG8_SB(b, h) + boff + n * 2048 + k * 1024); } while (0)
#define PG8_MMA(ai, bj, At, Bt) do { __builtin_amdgcn_s_setprio(1); _Pragma("unroll") for (int m = 0; m < 4; ++m) _Pragma("unroll") for (int n = 0; n < 2; ++n) _Pragma("unroll") for (int k = 0; k < 2; ++k) \
        acc[ai][bj][m][n] = __builtin_amdgcn_mfma_f32_16x16x32_bf16(Bt[n][k], At[m][k], acc[ai][bj][m][n], 0, 0, 0); __builtin_amdgcn_s_setprio(0); } while (0)
#define PG8_WAIT_V(n) asm volatile("s_waitcnt vmcnt(" #n ")" ::: "memory")
#define PG8_WAIT_L(n) asm volatile("s_waitcnt lgkmcnt(" #n ")" ::: "memory")
#define PG8_BAR __builtin_amdgcn_s_barrier()
#define PG8_SCHED __builtin_amdgcn_sched_barrier(0)
    Unit cur, nxt; int ui = 0;
    if (!S.next(0, cur)) return;
    f32x4 acc[2][2][4][2];
#pragma unroll
    for (int a = 0; a < 2; ++a)
#pragma unroll
        for (int b = 0; b < 2; ++b)
#pragma unroll
            for (int m = 0; m < 4; ++m)
#pragma unroll
                for (int n = 0; n < 2; ++n) acc[a][b][m][n] = (f32x4){0.f, 0.f, 0.f, 0.f};
    bf16x8 At[4][2], B0[2][2], B1[2][2];
#define PG8_AB(u_) (Sched::MULTI ? (const char*)((u_).kind == 0 ? g.A : (u_).kind == 1 ? g.A1 : (u_).kind == 2 ? g.A2 : g.A3) : (const char*)g.A)
#define PG8_BB(u_) (Sched::MULTI ? (const char*)((u_).kind == 0 ? g.Bt : (u_).kind == 1 ? g.B1 : (u_).kind == 2 ? g.B2 : g.B3) : (const char*)g.Bt)
    const char* cA = PG8_AB(cur) + (size_t)cur.pm * tstep; const char* cB = PG8_BB(cur) + (size_t)cur.pn * tstep;
    S.a_ready(cur);
    if constexpr (SP2) {
        PG8_STAGE(PG8_SB(0, 0), cB, voffB); PG8_STAGE(PG8_SB(0, 1), cB + hstep, voffB); PG8_STAGE(PG8_SA(0, 0), cA, voffA); PG8_STAGE(PG8_SA(0, 1), cA + hstep, voffA);
        if (wr == 1) PG8_BAR;
        PG8_WAIT_V(2); PG8_BAR;
        PG8_STAGE(PG8_SB(1, 0), cB + kstep, voffB); PG8_STAGE(PG8_SA(1, 0), cA + kstep, voffA); PG8_STAGE(PG8_SB(1, 1), cB + hstep + kstep, voffB);
        PG8_WAIT_V(6); PG8_BAR;
    } else {
        PG8_STAGE(PG8_SB(0, 0), cB, voffB); PG8_STAGE(PG8_SA(0, 0), cA, voffA); PG8_STAGE(PG8_SB(0, 1), cB + hstep, voffB); PG8_STAGE(PG8_SA(0, 1), cA + hstep, voffA);
        if (wr == 1) PG8_BAR;
        PG8_WAIT_V(4); PG8_BAR;
        PG8_STAGE(PG8_SB(1, 0), cB + kstep, voffB); PG8_STAGE(PG8_SA(1, 0), cA + kstep, voffA); PG8_STAGE(PG8_SB(1, 1), cB + hstep + kstep, voffB);
        PG8_WAIT_V(6); PG8_BAR;
    }
    for (;;) {
        const bool has_next = S.next(ui + 1, nxt);
        const char* nA = has_next ? PG8_AB(nxt) + (size_t)nxt.pm * tstep : cA; const char* nB = has_next ? PG8_BB(nxt) + (size_t)nxt.pn * tstep : cB;
        for (int t = 0; t < nt; t += 2) {
            const bool last = (t == nt - 2);
            const char* a1 = cA + (size_t)(t + 1) * kstep;
            const char* a2 = last ? nA : cA + (size_t)(t + 2) * kstep; const char* b2 = last ? nB : cB + (size_t)(t + 2) * kstep;
            const char* a3 = a2 + kstep; const char* b3 = b2 + kstep;
            if (last && has_next) S.a_ready(nxt);
            if constexpr (SP2) {
            PG8_LDB(B0, 0, 0); PG8_LDB(B1, 0, 1); PG8_SCHED; PG8_LDA(At, 0, 0); PG8_STAGE(PG8_SA(1, 1), a1 + hstep, voffA);
            PG8_WAIT_V(8); PG8_WAIT_L(0); PG8_BAR; PG8_MMA(0, 0, At, B0); PG8_MMA(0, 1, At, B1); PG8_BAR; PG8_SCHED;
            PG8_LDA(At, 0, 1); PG8_STAGE(PG8_SB(0, 0), b2, voffB); PG8_STAGE(PG8_SB(0, 1), b2 + hstep, voffB); PG8_STAGE(PG8_SA(0, 0), a2, voffA);
            PG8_WAIT_V(8); PG8_WAIT_L(0); PG8_BAR; PG8_MMA(1, 0, At, B0); PG8_MMA(1, 1, At, B1); PG8_BAR; PG8_SCHED;
            PG8_LDB(B0, 1, 0); PG8_LDB(B1, 1, 1); PG8_SCHED; PG8_LDA(At, 1, 0); PG8_STAGE(PG8_SA(0, 1), a2 + hstep, voffA);
            PG8_WAIT_V(8); PG8_WAIT_L(0); PG8_BAR; PG8_MMA(0, 0, At, B0); PG8_MMA(0, 1, At, B1); PG8_BAR; PG8_SCHED;
            PG8_LDA(At, 1, 1); PG8_STAGE(PG8_SB(1, 0), b3, voffB); PG8_STAGE(PG8_SB(1, 1), b3 + hstep, voffB); PG8_STAGE(PG8_SA(1, 0), a3, voffA);
            PG8_WAIT_V(8); PG8_WAIT_L(0); PG8_BAR; PG8_MMA(1, 0, At, B0); PG8_MMA(1, 1, At, B1); PG8_BAR; PG8_SCHED;
            } else {
            PG8_LDB(B0, 0, 0); PG8_SCHED; PG8_LDA(At, 0, 0); PG8_STAGE(PG8_SA(1, 1), a1 + hstep, voffA);
            PG8_WAIT_L(8); PG8_BAR; PG8_WAIT_L(0); PG8_MMA(0, 0, At, B0); PG8_BAR; PG8_SCHED;
            PG8_LDB(B1, 0, 1); PG8_STAGE(PG8_SB(0, 0), b2, voffB);
            PG8_BAR; PG8_WAIT_L(0); PG8_MMA(0, 1, At, B1); PG8_BAR;
            PG8_LDA(At, 0, 1); PG8_STAGE(PG8_SA(0, 0), a2, voffA);
            PG8_BAR; PG8_WAIT_L(0); PG8_MMA(1, 0, At, B0); PG8_BAR; PG8_SCHED;
            PG8_STAGE(PG8_SB(0, 1), b2 + hstep, voffB);
            PG8_WAIT_V(6); PG8_BAR; PG8_MMA(1, 1, At, B1); PG8_BAR;
            PG8_LDB(B0, 1, 0); PG8_SCHED; PG8_LDA(At, 1, 0); PG8_STAGE(PG8_SA(0, 1), a2 + hstep, voffA);
            PG8_WAIT_L(8); PG8_BAR; PG8_WAIT_L(0); PG8_MMA(0, 0, At, B0); PG8_BAR; PG8_SCHED;
            PG8_LDB(B1, 1, 1); PG8_STAGE(PG8_SB(1, 0), b3, voffB);
            PG8_BAR; PG8_WAIT_L(0); PG8_MMA(0, 1, At, B1); PG8_BAR;
            PG8_LDA(At, 1, 1); PG8_STAGE(PG8_SA(1, 0), a3, voffA);
            PG8_BAR; PG8_WAIT_L(0); PG8_MMA(1, 0, At, B0); PG8_BAR; PG8_SCHED;
            PG8_STAGE(PG8_SB(1, 1), b3 + hstep, voffB);
            PG8_WAIT_V(6); PG8_BAR; PG8_MMA(1, 1, At, B1); PG8_BAR;
            }
        }
        if constexpr (ALIGN_EPI) { if (wr == 0) PG8_BAR; }
        bool keep_acc = false;
        if constexpr (!Epi::AFTER_DRAIN) { if constexpr (Sched::MULTI) keep_acc = E(acc, cur, wr, wc, fr, fq); else E(acc, cur, wr, wc, fr, fq); S.done(cur); }
        if (!has_next) break;
        if (!keep_acc) {
#pragma unroll
        for (int a = 0; a < 2; ++a)
#pragma unroll
            for (int b = 0; b < 2; ++b)
#pragma unroll
                for (int m = 0; m < 4; ++m)
#pragma unroll
                    for (int n = 0; n < 2; ++n) acc[a][b][m][n] = (f32x4){0.f, 0.f, 0.f, 0.f};
        }
        cur = nxt; cA = nA; cB = nB; ++ui;
        if constexpr (ALIGN_EPI) { if (wr == 1) PG8_BAR; }
    }
    PG8_WAIT_V(0);
    if constexpr (!ALIGN_EPI) { if (wr == 0) PG8_BAR; }
    PG8_BAR;
    if constexpr (Epi::AFTER_DRAIN) { E.fused(acc, cur, wr, wc, fr, fq, lds, wid, lane); S.done(cur); }
#undef PG8_AB
#undef PG8_BB
#undef PG8_SA
#undef PG8_SB
#undef PG8_STAGE
#undef PG8_LDA
#undef PG8_LDB
#undef PG8_MMA
#undef PG8_WAIT_V
#undef PG8_WAIT_L
#undef PG8_BAR
#undef PG8_SCHED
}
}


__device__ __forceinline__ void p_diag_cmp(const Ctx& C, const bf16_t* a, const bf16_t* b, size_t n, unsigned* res) {
    const size_t gt = (size_t)C.bid * NTHR + C.tid, NT = (size_t)C.G * NTHR;
    float md = 0.f, mr = 0.f;
    for (size_t i = gt; i < n; i += NT) { const float x = bf2f(a[i]), y = bf2f(b[i]); const float d = x - y; md += (d == d ? d * d : 1e30f); mr += x * x; }
#pragma unroll
    for (int o = 1; o < 64; o <<= 1) { md += __shfl_xor(md, o); mr += __shfl_xor(mr, o); }
    if (C.lane == 0) { atomicAdd((float*)res, md); atomicAdd((float*)res + 1, mr); }
}
__device__ __forceinline__ void p_diag_out(const Ctx& C, const unsigned* res, float* out) {
    const size_t gt = (size_t)C.bid * NTHR + C.tid, NT = (size_t)C.G * NTHR;
    for (size_t i = gt; i < (size_t)T * 1024; i += NT) out[i] = 0.f;
    __syncthreads();
    if (C.bid == 0 && C.tid == 0) { const float md = __uint_as_float(res[0]), mr = __uint_as_float(res[1]); const float rel = sqrtf(md / fmaxf(mr, 1e-30f));
        out[0] = 1.0e4f * (13.f + log10f(rel + 1e-12f)); }
}

#define GAS __attribute__((address_space(1)))
typedef GAS unsigned gu32;
#define RLX_AGENT __ATOMIC_RELAXED, __HIP_MEMORY_SCOPE_AGENT
#define XB_TMO      128
#define XB_XCNT(j)  (256  + 64 * (j))
#define XB_XSUB(j)  (1280 + 64 * (j))
#define XB_XGEN(j)  (2304 + 64 * (j))
#define XB_TOP      3328
#define XB_TOPGEN   3392
#define XCD_BAR_WORDS 3456
#define XB_SPIN_CAP (1u << 18)

__device__ __forceinline__ unsigned xb_ld(unsigned* p)              { return __hip_atomic_load(p, __ATOMIC_RELAXED, __HIP_MEMORY_SCOPE_AGENT); }
__device__ __forceinline__ unsigned xb_add(unsigned* p, unsigned v) { return __hip_atomic_fetch_add(p, v, __ATOMIC_RELAXED, __HIP_MEMORY_SCOPE_AGENT); }
__device__ __forceinline__ unsigned xb_xcc_id() { return (unsigned)__builtin_amdgcn_s_getreg((3 << 11) | 20) & 0xFu; }
#define XB_SPIN(cond, bar) do { unsigned _sp = 0; while (cond) { __builtin_amdgcn_s_sleep(1); \
    if ((++_sp & 255u) == 0u) { if (xb_ld(&(bar)[XB_TMO])) break; if (_sp > XB_SPIN_CAP) { atomicAdd(&(bar)[XB_TMO], 1u); break; } } } } while (0)

struct XcdBarrier {
    unsigned* bar; unsigned x;
    volatile LAS unsigned* st;
};

__device__ __forceinline__ XcdBarrier xcd_barrier_post(unsigned* bar, volatile LAS unsigned* st) {
    XcdBarrier b; b.bar = bar; b.x = xb_xcc_id(); b.st = st;
    if (threadIdx.x == 0) (void)xb_add(&bar[XB_XCNT(b.x)], 1u);
    return b;
}
__device__ __forceinline__ void xcd_barrier_complete(unsigned* bar, unsigned x, unsigned& nloc, unsigned& nx) {
    const unsigned G = gridDim.x * gridDim.y * gridDim.z;
    unsigned sum, cnt, mine, sp = 0u;
    for (;;) {
        sum = 0u; cnt = 0u; mine = 0u;
#pragma unroll
        for (unsigned j = 0; j < 16; ++j) { const unsigned c = xb_ld(&bar[XB_XCNT(j)]); sum += c; cnt += (c > 0u) ? 1u : 0u; mine = (j == x) ? c : mine; }
        if (sum == G) break;
        __builtin_amdgcn_s_sleep(1);
        if ((++sp & 255u) == 0u) { if (xb_ld(&bar[XB_TMO])) break; if (sp > XB_SPIN_CAP) { atomicAdd(&bar[XB_TMO], 1u); break; } }
    }
    nloc = mine > 0u ? mine : 1u; nx = cnt > 0u ? cnt : 1u;
}

__device__ __forceinline__ void xcd_barrier(const XcdBarrier& b) {
    asm volatile("s_waitcnt vmcnt(0)" ::: "memory");
    __syncthreads();
    if (threadIdx.x == 0) {
        unsigned* bar = b.bar;
        __builtin_amdgcn_s_waitcnt(0);
        unsigned nloc = b.st[0], nx = b.st[1];
        if (nloc == 0u) { xcd_barrier_complete(bar, b.x, nloc, nx); b.st[0] = nloc; b.st[1] = nx; }
        const unsigned old = xb_add(&bar[XB_XSUB(b.x)], 1u);
        const unsigned gen = old / nloc;
        if (old + 1u == (gen + 1u) * nloc) {
            __builtin_amdgcn_fence(__ATOMIC_RELEASE, "agent");
            asm volatile("s_waitcnt vmcnt(0)" ::: "memory");
            const unsigned og = xb_add(&bar[XB_TOP], 1u);
            const unsigned tg = og / nx;
            if (og + 1u == (tg + 1u) * nx) xb_add(&bar[XB_TOPGEN], 1u);
            else XB_SPIN(xb_ld(&bar[XB_TOPGEN]) == tg, bar);
            __builtin_amdgcn_fence(__ATOMIC_ACQUIRE, "agent");
            xb_add(&bar[XB_XGEN(b.x)], 1u);
            asm volatile("s_waitcnt vmcnt(0)" ::: "memory");
        } else {
            XB_SPIN(xb_ld(&bar[XB_XGEN(b.x)]) == gen, bar);
            __builtin_amdgcn_fence(__ATOMIC_ACQUIRE, "agent");
            asm volatile("s_waitcnt vmcnt(0)" ::: "memory");
        }
    }
    __syncthreads();
}


constexpr int N_PHASES = 15;
constexpr int CW_BAR = 4096;
constexpr size_t CTL_ZERO_BYTES = 64 * 1024;
constexpr int MISC_OFF = LDS_BYTES - 256;

template <int PH>
__device__ __forceinline__ void run_phase(const Ctx& C, const Args& a) {
    bf16_t* R0 = C.bfp(WS_R0); bf16_t* R1 = C.bfp(WS_R1); bf16_t* R2 = C.bfp(WS_R2); bf16_t* R3 = C.bfp(WS_R3);
    bf16_t* OB = (bf16_t*)a.out;
    const size_t TD = (size_t)T * 1024;
    if constexpr (PH == 0) p_prep(C);
    if constexpr (PH == 1) p_rownorm(C, C.in[0], C.in[4], 0, 1024, R0);
    if constexpr (PH == 2) {
        { pg8::Gemm g{R0, C.bfp(WS_WIN_T), T, 6144, 1024}; pg8::StaticOrder S; S.init(T, 6144, C.G, C.bid);
          pg8::EpiInProj e{R1, R2, R3, R3 + TD, R3 + 2 * TD};
          pg8::gemm_phase<pg8::EpiInProj, pg8::StaticOrder, true, true>(C.lds, g, S, e); }
        p_dt(C, R0, C.bfp(WS_WDT_T), C.f32p(WS_DT));
    }
    if constexpr (PH == 3) { p_conv(C, R2, OB); p_na(C, R3, R3 + TD, R3 + 2 * TD); }
    if constexpr (PH == 4) p_ssd(C, OB, C.f32p(WS_DT), R2, R2 + TD);
    if constexpr (PH == 5) p_combine(C, R2, R2 + TD, R1, C.f32p(WS_RSTD));
    if constexpr (PH == 6) {
        pg8::MultiOrder S; S.b.init(T, 1024, C.G, C.bid); S.nk = 4;
        pg8::Gemm g{R0, C.bfp(WS_WG_T), T, 1024, 1024, R0, C.bfp(WS_WG_T) + (size_t)1024 * 1024, R1, C.bfp(WS_WSSD_T), R3, C.bfp(WS_WNA_T)};
        pg8::EpiMix e{OB, OB + TD, R2 + TD, C.f32p(WS_RSTD)};
        pg8::gemm_phase<pg8::EpiMix, pg8::MultiOrder, true, true>(C.lds, g, S, e);
    }
    if constexpr (PH == 7) { pg8::Gemm g{R2 + TD, C.bfp(WS_WOUT_T), T, 1024, 1024}; pg8::StaticOrder S; S.init(T, 1024, C.G, C.bid);
        pg8::EpiD3 e{R3 + TD, C.in[0], C.f32p(WS_MOD)}; pg8::gemm_phase<pg8::EpiD3, pg8::StaticOrder, true, true>(C.lds, g, S, e); }
    if constexpr (PH == 8) { p_rownorm_b(C, R3 + TD, C.in[18], 3072, 4096, R0); p_cvt_tables8(C, (unsigned char*)R2, (unsigned char*)R2 + (size_t)16384 * 1024); }
    if constexpr (PH == 9) { pg8::Gemm g{R0, C.bfp(WS_WPQ_T), T, 2048, 1024}; pg8::StaticOrder S; S.init(T, 2048, C.G, C.bid);
        pg8::EpiQp e{OB}; pg8::gemm_phase<pg8::EpiQp, pg8::StaticOrder, true, true>(C.lds, g, S, e); }
    if constexpr (PH == 10) p_topk(C, OB, C.bfp(WS_KEYS), (unsigned short*)R1, (float*)(R1 + 4 * MiB));
    if constexpr (PH == 11) p_gu(C, R0, (const unsigned short*)R1, (const unsigned char*)R2, a.out);
    if constexpr (PH == 12) p_gc(C, a.out, (const float*)(R1 + 4 * MiB), (float*)((unsigned char*)R2 + 32 * MiB));
    if constexpr (PH == 13) p_gv(C, (const float*)((unsigned char*)R2 + 32 * MiB), (const unsigned short*)R1, (const unsigned char*)R2 + (size_t)16384 * 1024, R3);
    if constexpr (PH == 14) p_gf(C, R3 + TD, R3, a.out);
}

template <int PH> struct PhaseLoop {
    static __device__ __forceinline__ void run(const Ctx& C, const Args& a, const XcdBarrier& bar) {
        if (PH >= a.ph_lo && PH < a.ph_hi) { run_phase<PH>(C, a);
#ifdef REP_PHASE
            if (PH == REP_PHASE) { xcd_barrier(bar); run_phase<PH>(C, a); }
#endif
            if (PH + 1 < a.ph_hi) xcd_barrier(bar); }
        PhaseLoop<PH + 1>::run(C, a, bar);
    }
};
template <> struct PhaseLoop<N_PHASES> { static __device__ __forceinline__ void run(const Ctx&, const Args&, const XcdBarrier&) {} };

__global__ void __launch_bounds__(NTHR, 2) mega(Args a) {
    extern __shared__ __attribute__((aligned(16))) unsigned char lds_raw[];
    Ctx C; C.in = a.in; C.out = a.out; C.ws = a.ws; C.tid = threadIdx.x; C.lane = C.tid & 63; C.wave = __builtin_amdgcn_readfirstlane(C.tid >> 6);
    C.G = gridDim.x; C.bid = blockIdx.x; C.lds = (LAS unsigned char*)lds_raw;
    volatile LAS unsigned* MISC = (volatile LAS unsigned*)(C.lds + MISC_OFF);
    if (C.tid < 64) MISC[C.tid] = 0u;
    __syncthreads();
    XcdBarrier bar; bar.bar = (unsigned*)(a.ws + WS_CTL) + CW_BAR; bar.x = 0; bar.st = nullptr;
    if (a.ph_hi - a.ph_lo > 1) bar = xcd_barrier_post((unsigned*)(a.ws + WS_CTL) + CW_BAR, MISC + 8);
    PhaseLoop<0>::run(C, a, bar);
}

extern "C" void kernel_launch(void* const* d_in, const int* in_sizes, int n_in, void* d_out, int out_size, void* d_ws, size_t ws_size, hipStream_t stream) {
    static int grid = 0;
    if (grid == 0) {
        if (n_in != 24 || out_size != T * D || ws_size < WS_END) { fprintf(stderr, "kernel_launch: unexpected shapes n_in %d out %d ws %zu\n", n_in, out_size, ws_size); grid = -1; return; }
        int dev = 0, cus = 0;
        if (hipGetDevice(&dev) != hipSuccess || hipDeviceGetAttribute(&cus, hipDeviceAttributeMultiprocessorCount, dev) != hipSuccess) { grid = -1; return; }
        if (hipFuncSetAttribute((const void*)mega, hipFuncAttributeMaxDynamicSharedMemorySize, LDS_BYTES) != hipSuccess) { grid = -1; return; }
        grid = cus;
    }
    if (grid < 0) return;
    (void)hipMemsetAsync((char*)d_ws + WS_CTL, 0, CTL_ZERO_BYTES, stream);
    Args a{};
    for (int i = 0; i < 24; ++i) a.in[i] = (const float*)d_in[i];
    a.out = (float*)d_out; a.ws = (unsigned char*)d_ws;
    a.ph_lo = 0; a.ph_hi = N_PHASES;
    hipLaunchKernelGGL(mega, dim3(grid), dim3(NTHR), LDS_BYTES, stream, a);
}
```

```cpp
#include <hip/hip_runtime.h>
#include <cstdio>
#include <cstdint>

#define LAS __attribute__((address_space(3)))
typedef unsigned short bf16_t;
typedef float f32x4 __attribute__((ext_vector_type(4)));
typedef unsigned u32x4 __attribute__((ext_vector_type(4)));
typedef unsigned u32x2 __attribute__((ext_vector_type(2)));
typedef __bf16 bf16x2_t __attribute__((ext_vector_type(2)));

constexpr int T = 32768, D = 1024, NB = 8, SEQ = 4096;
constexpr int NWAVES = 8, NTHR = 512;
constexpr float EPS = 1e-6f;
constexpr int OFF_Z = 0, OFF_XBC = 1024, OFF_DTF = 3072, OFF_DTB = 3088, OFF_QKV = 3104, OFF_GS = 6176, OFF_GN = 7200, D_IN = 8224;

constexpr size_t MiB = 1u << 20;
constexpr size_t WS_CTL = 0;
constexpr size_t WS_MOD = 1 * MiB;
constexpr size_t WS_RSTD = 1 * MiB + 512 * 1024;
constexpr size_t WS_DT = 2 * MiB;
constexpr size_t WS_WIN_T = 6 * MiB;
constexpr size_t WS_WG_T = 18 * MiB;
constexpr size_t WS_WDT_T = 22 * MiB;
constexpr size_t WS_KEYS = 22 * MiB + 512 * 1024;
constexpr size_t WS_WSSD_T = 23 * MiB, WS_WNA_T = 25 * MiB, WS_WOUT_T = 27 * MiB, WS_WPQ_T = 29 * MiB;
constexpr size_t WS_R0 = 40 * MiB, WS_R1 = 104 * MiB, WS_R2 = 168 * MiB, WS_R3 = 296 * MiB, WS_END = 488 * MiB;

constexpr int LDS_BYTES = 163840;

struct Args { const float* in[24]; float* out; unsigned char* ws; int ph_lo, ph_hi; };

__device__ __forceinline__ float bf2f(unsigned v) { return __uint_as_float(v << 16); }
__device__ __forceinline__ float bflo(unsigned v) { return __uint_as_float(v << 16); }
__device__ __forceinline__ float bfhi(unsigned v) { return __uint_as_float(v & 0xffff0000u); }
__device__ __forceinline__ unsigned f2bf(float f) { unsigned u = __float_as_uint(f); return (u + 0x7fffu + ((u >> 16) & 1u)) >> 16; }
typedef float f32x2_t __attribute__((ext_vector_type(2)));
__device__ __forceinline__ unsigned pk2(float lo, float hi) { f32x2_t v = {lo, hi}; bf16x2_t b = __builtin_convertvector(v, bf16x2_t); return __builtin_bit_cast(unsigned, b); }
__device__ __forceinline__ float wave_sum(float v) {
#pragma unroll
    for (int o = 1; o < 64; o <<= 1) v += __shfl_xor(v, o);
    return v;
}
__device__ __forceinline__ float silu_f(float x) { return x / (1.f + __expf(-x)); }
__device__ __forceinline__ float sigmoid_f(float x) { return 1.f / (1.f + __expf(-x)); }
__device__ __forceinline__ float softplus_f(float x) { return x > 20.f ? x : log1pf(__expf(x)); }
__device__ __forceinline__ float gelu_f(float x) { return 0.5f * x * (1.f + erff(x * 0.70710678118654752f)); }

struct Ctx {
    const float* const* in; float* out; unsigned char* ws;
    int tid, lane, wave, G, bid;
    LAS unsigned char* lds;
    __device__ __forceinline__ float* f32p(size_t off) const { return (float*)(ws + off); }
    __device__ __forceinline__ bf16_t* bfp(size_t off) const { return (bf16_t*)(ws + off); }
};

__device__ __forceinline__ void tr_item(const float* W, int ldw, int col0, int K, bf16_t* WT, int row_off, LAS float* scr, int item, int nblk, int lane, const float* kscale) {
    const int kb = item / nblk, nb = item % nblk, k0 = 64 * kb, n0 = 32 * nb;
#pragma unroll 8
    for (int i = 0; i < 32; ++i) { const int kk = 2 * i + (lane >> 5); float x = W[(size_t)(k0 + kk) * ldw + col0 + n0 + (lane & 31)]; if (kscale) x *= kscale[k0 + kk]; scr[kk * 33 + (lane & 31)] = x; }
    asm volatile("s_waitcnt lgkmcnt(0)" ::: "memory");
    const int c = lane & 7;
#pragma unroll
    for (int j = 0; j < 4; ++j) { const int n = (lane >> 3) + 8 * j; const LAS float* sp = scr + (8 * c) * 33 + n;
        u32x4 o; o.x = pk2(sp[0 * 33], sp[1 * 33]); o.y = pk2(sp[2 * 33], sp[3 * 33]); o.z = pk2(sp[4 * 33], sp[5 * 33]); o.w = pk2(sp[6 * 33], sp[7 * 33]);
        *(u32x4*)(WT + (size_t)(row_off + n0 + n) * K + k0 + 8 * c) = o; }
    asm volatile("s_waitcnt lgkmcnt(0)" ::: "memory");
}
__device__ __forceinline__ void p_prep(const Ctx& C) {
    const float* c = C.in[1]; const float* w_ada = C.in[2]; const float* b_ada = C.in[3];
    float* mod = C.f32p(WS_MOD);
    LAS float* sc = (LAS float*)C.lds;
    LAS float* red = sc + 8192;
    for (int i = C.tid; i < 8192; i += NTHR) sc[i] = silu_f(c[i]);
    __syncthreads();
    for (int jb = C.bid; jb < 256; jb += C.G) {
        const int j0 = jb * 24, jl = C.tid % 24, kq = C.tid / 24;
        if (C.tid < 504) { float acc[8];
#pragma unroll
            for (int b = 0; b < 8; ++b) acc[b] = 0.f;
            for (int k = kq; k < 1024; k += 21) { const float w = w_ada[(size_t)k * 6144 + j0 + jl];
#pragma unroll
                for (int b = 0; b < 8; ++b) acc[b] += sc[b * 1024 + k] * w; }
#pragma unroll
            for (int b = 0; b < 8; ++b) red[(kq * 24 + jl) * 8 + b] = acc[b]; }
        __syncthreads();
        if (C.tid < 192) { const int jl2 = C.tid % 24, b2 = C.tid / 24; float sacc = b_ada[j0 + jl2];
            for (int kq2 = 0; kq2 < 21; ++kq2) sacc += red[(kq2 * 24 + jl2) * 8 + b2];
            mod[b2 * 6144 + j0 + jl2] = sacc; }
        __syncthreads();
    }
    LAS float* scr = (LAS float*)(C.lds + 65536 + C.wave * 8448);
    const int gw = C.bid * NWAVES + C.wave, NGW = C.G * NWAVES;
    const float* w_in = C.in[5];
    constexpr int I_A = 16 * 96, I_B = 16 * 96, I_G = 16 * 64, I_DT = 16, I_S = 16 * 32, I_PQ = 16 * 64;
    constexpr int NIT = I_A + I_B + I_G + I_DT + 3 * I_S + I_PQ;
    for (int it = gw; it < NIT; it += NGW) {
        int r = it;
        if (r < I_A) { tr_item(w_in, D_IN, 0, D, C.bfp(WS_WIN_T), 0, scr, r, 96, C.lane, nullptr); continue; } r -= I_A;
        if (r < I_B) { tr_item(w_in, D_IN, OFF_QKV, D, C.bfp(WS_WIN_T), 3072, scr, r, 96, C.lane, nullptr); continue; } r -= I_B;
        if (r < I_G) { tr_item(w_in, D_IN, OFF_GS, D, C.bfp(WS_WG_T), 0, scr, r, 64, C.lane, nullptr); continue; } r -= I_G;
        if (r < I_DT) { tr_item(w_in, D_IN, OFF_DTF, D, C.bfp(WS_WDT_T), 0, scr, r, 1, C.lane, nullptr); continue; } r -= I_DT;
        if (r < I_S) { tr_item(C.in[14], D, 0, D, C.bfp(WS_WSSD_T), 0, scr, r, 32, C.lane, C.in[13]); continue; } r -= I_S;
        if (r < I_S) { tr_item(C.in[16], D, 0, D, C.bfp(WS_WNA_T), 0, scr, r, 32, C.lane, nullptr); continue; } r -= I_S;
        if (r < I_S) { tr_item(C.in[17], D, 0, D, C.bfp(WS_WOUT_T), 0, scr, r, 32, C.lane, nullptr); continue; } r -= I_S;
        tr_item(C.in[19], 2048, 0, D, C.bfp(WS_WPQ_T), 0, scr, r, 64, C.lane, nullptr);
    }
    { const int gt = C.bid * NTHR + C.tid, NT = C.G * NTHR; const float* kf = C.in[20]; bf16_t* kb = C.bfp(WS_KEYS);
      for (int i = gt; i < 2 * 128 * 128; i += NT) kb[i] = (bf16_t)f2bf(kf[i]); }
    __syncthreads();
}

__device__ __forceinline__ void p_rownorm(const Ctx& C, const float* X, const float* gamma, int sh_off, int sc_off, bf16_t* dst) {
    const float* mod = C.f32p(WS_MOD);
    const int gw = C.bid * NWAVES + C.wave, NGW = C.G * NWAVES;
    for (int row0 = gw * 4; row0 < T; row0 += NGW * 4) {
        const int b = row0 / SEQ;
        f32x4 v[4][4]; float s[4];
#pragma unroll
        for (int r = 0; r < 4; ++r) { const f32x4* xr = (const f32x4*)(X + (size_t)(row0 + r) * D) + C.lane;
#pragma unroll
            for (int j = 0; j < 4; ++j) v[r][j] = xr[64 * j]; }
#pragma unroll
        for (int r = 0; r < 4; ++r) { float a = 0.f;
#pragma unroll
            for (int j = 0; j < 4; ++j) a += (v[r][j].x * v[r][j].x + v[r][j].y * v[r][j].y) + (v[r][j].z * v[r][j].z + v[r][j].w * v[r][j].w);
            s[r] = rsqrtf(wave_sum(a) * (1.f / D) + EPS); }
#pragma unroll
        for (int j = 0; j < 4; ++j) {
            const int col = 4 * C.lane + 256 * j;
            const f32x4 g = *(const f32x4*)(gamma + col), sh = *(const f32x4*)(mod + b * 6144 + sh_off + col), sc = *(const f32x4*)(mod + b * 6144 + sc_off + col);
            const f32x4 gs = g * (sc + 1.f);
#pragma unroll
            for (int r = 0; r < 4; ++r) { const f32x4 y = v[r][j] * s[r] * gs + sh; u32x2 w; w.x = pk2(y.x, y.y); w.y = pk2(y.z, y.w);
                *((u32x2*)(dst + (size_t)(row0 + r) * D) + C.lane + 64 * j) = w; }
        }
    }
}

__device__ __forceinline__ void p_rownorm_b(const Ctx& C, const bf16_t* X, const float* gamma, int sh_off, int sc_off, bf16_t* dst) {
    const float* mod = C.f32p(WS_MOD);
    const int gw = C.bid * NWAVES + C.wave, NGW = C.G * NWAVES;
    for (int row0 = gw * 4; row0 < T; row0 += NGW * 4) {
        const int b = row0 / SEQ;
        u32x2 w[4][4]; float s[4];
#pragma unroll
        for (int r = 0; r < 4; ++r)
#pragma unroll
            for (int j = 0; j < 4; ++j) w[r][j] = *((const u32x2*)(X + (size_t)(row0 + r) * D) + C.lane + 64 * j);
        f32x4 v[4][4];
#pragma unroll
        for (int r = 0; r < 4; ++r) { float a = 0.f;
#pragma unroll
            for (int j = 0; j < 4; ++j) { v[r][j].x = bflo(w[r][j].x); v[r][j].y = bfhi(w[r][j].x); v[r][j].z = bflo(w[r][j].y); v[r][j].w = bfhi(w[r][j].y);
                a += (v[r][j].x * v[r][j].x + v[r][j].y * v[r][j].y) + (v[r][j].z * v[r][j].z + v[r][j].w * v[r][j].w); }
            s[r] = rsqrtf(wave_sum(a) * (1.f / D) + EPS); }
#pragma unroll
        for (int j = 0; j < 4; ++j) {
            const int col = 4 * C.lane + 256 * j;
            const f32x4 g = *(const f32x4*)(gamma + col), sh = *(const f32x4*)(mod + b * 6144 + sh_off + col), sc = *(const f32x4*)(mod + b * 6144 + sc_off + col);
            const f32x4 gs = g * (sc + 1.f);
#pragma unroll
            for (int r = 0; r < 4; ++r) { const f32x4 y = v[r][j] * s[r] * gs + sh; u32x2 o; o.x = pk2(y.x, y.y); o.y = pk2(y.z, y.w);
                *((u32x2*)(dst + (size_t)(row0 + r) * D) + C.lane + 64 * j) = o; }
        }
    }
}

template <class Epi>
__device__ __forceinline__ void naive_gemm(const Ctx& C, const bf16_t* A, const bf16_t* Bt, int M, int N, int K, const Epi& E) {
    LAS float* As = (LAS float*)C.lds;
    LAS float* Bs = (LAS float*)(C.lds + 32 * 132 * 4);
    const int tilesN = (N + 63) / 64, tilesM = M / 128, ntiles = tilesM * tilesN;
    const int ty = C.tid >> 4, tx = C.tid & 15;
    for (int tile = C.bid; tile < ntiles; tile += C.G) {
        const int tm = tile / tilesN, tn = tile % tilesN, m0 = tm * 128, n0 = tn * 64;
        float acc[4][4];
#pragma unroll
        for (int i = 0; i < 4; ++i)
#pragma unroll
            for (int j = 0; j < 4; ++j) acc[i][j] = 0.f;
        for (int k0 = 0; k0 < K; k0 += 32) {
            __syncthreads();
            {
                const int r = C.tid >> 2, kc = (C.tid & 3) * 8;
                const u32x4 v = *(const u32x4*)(A + (size_t)(m0 + r) * K + k0 + kc);
                As[(kc + 0) * 132 + r] = bflo(v.x); As[(kc + 1) * 132 + r] = bfhi(v.x); As[(kc + 2) * 132 + r] = bflo(v.y); As[(kc + 3) * 132 + r] = bfhi(v.y);
                As[(kc + 4) * 132 + r] = bflo(v.z); As[(kc + 5) * 132 + r] = bfhi(v.z); As[(kc + 6) * 132 + r] = bflo(v.w); As[(kc + 7) * 132 + r] = bfhi(v.w);
            }
            if (C.tid < 256) {
                const int r = C.tid >> 2, kc = (C.tid & 3) * 8;
                u32x4 v = (u32x4){0u, 0u, 0u, 0u};
                if (n0 + r < N) v = *(const u32x4*)(Bt + (size_t)(n0 + r) * K + k0 + kc);
                Bs[(kc + 0) * 68 + r] = bflo(v.x); Bs[(kc + 1) * 68 + r] = bfhi(v.x); Bs[(kc + 2) * 68 + r] = bflo(v.y); Bs[(kc + 3) * 68 + r] = bfhi(v.y);
                Bs[(kc + 4) * 68 + r] = bflo(v.z); Bs[(kc + 5) * 68 + r] = bfhi(v.z); Bs[(kc + 6) * 68 + r] = bflo(v.w); Bs[(kc + 7) * 68 + r] = bfhi(v.w);
            }
            __syncthreads();
#pragma unroll 8
            for (int k = 0; k < 32; ++k) {
                const f32x4 a = *(const LAS f32x4*)(As + k * 132 + ty * 4);
                const f32x4 b = *(const LAS f32x4*)(Bs + k * 68 + tx * 4);
#pragma unroll
                for (int i = 0; i < 4; ++i)
#pragma unroll
                    for (int j = 0; j < 4; ++j) acc[i][j] += a[i] * b[j];
            }
        }
#pragma unroll
        for (int i = 0; i < 4; ++i)
#pragma unroll
            for (int j = 0; j < 4; ++j) { const int col = n0 + tx * 4 + j; if (col < N) E(m0 + ty * 4 + i, col, acc[i][j]); }
    }
    __syncthreads();
}

struct EInProj { bf16_t *sz, *xbc, *q, *k, *v;
    __device__ __forceinline__ void operator()(int r, int c, float x) const {
        if (c < 1024) sz[(size_t)r * 1024 + c] = (bf16_t)f2bf(silu_f(x));
        else if (c < 3072) xbc[(size_t)r * 2048 + (c - 1024)] = (bf16_t)f2bf(x);
        else if (c < 4096) q[(size_t)r * 1024 + (c - 3072)] = (bf16_t)f2bf(x * 0.125f);
        else if (c < 5120) k[(size_t)r * 1024 + (c - 4096)] = (bf16_t)f2bf(x);
        else v[(size_t)r * 1024 + (c - 5120)] = (bf16_t)f2bf(x);
    } };
struct EDt { float* dt; const float *bf, *bb;
    __device__ __forceinline__ void operator()(int r, int c, float x) const { const float bias = c < 16 ? bf[c] : bb[c - 16]; dt[(size_t)r * 32 + c] = softplus_f(x + bias); } };
struct EGate { bf16_t* sg;
    __device__ __forceinline__ void operator()(int r, int c, float x) const { sg[(size_t)(c >> 10) * T * 1024 + (size_t)r * 1024 + (c & 1023)] = (bf16_t)f2bf(sigmoid_f(x)); } };
struct ED1 { bf16_t* p1; const bf16_t* sg1; const float* rstd;
    __device__ __forceinline__ void operator()(int r, int c, float x) const { const size_t i = (size_t)r * 1024 + c; p1[i] = (bf16_t)f2bf(x * rstd[r] * bf2f(sg1[i])); } };
struct ED2 { bf16_t* mixed; const bf16_t *p1, *sg2;
    __device__ __forceinline__ void operator()(int r, int c, float x) const { const size_t i = (size_t)r * 1024 + c; mixed[i] = (bf16_t)f2bf(bf2f(p1[i]) + bf2f(sg2[i]) * x); } };
struct ED3 { float* h; const float* x; const float* mod;
    __device__ __forceinline__ void operator()(int r, int c, float v) const { const size_t i = (size_t)r * 1024 + c; h[i] = x[i] + mod[(r / SEQ) * 6144 + 2048 + c] * v; } };
struct EQp { bf16_t* qp;
    __device__ __forceinline__ void operator()(int r, int c, float v) const { qp[(size_t)r * 2048 + c] = (bf16_t)f2bf(v); } };


__device__ __forceinline__ void p_dt(const Ctx& C, const bf16_t* n1, const bf16_t* wdt, float* dt) {
    typedef short bf16x8 __attribute__((ext_vector_type(8)));
    const float* bf = C.in[8]; const float* bb = C.in[9];
    const int gw = C.bid * NWAVES + C.wave, NGW = C.G * NWAVES, lane = C.lane, g = lane >> 4, i16 = lane & 15;
    for (int tile = gw; tile < T / 16; tile += NGW) {
        const size_t t0 = (size_t)tile * 16;
        f32x4 a0 = (f32x4){0.f, 0.f, 0.f, 0.f}, a1 = a0;
#pragma unroll 8
        for (int ks = 0; ks < 32; ++ks) {
            const bf16x8 av = *(const bf16x8*)(n1 + (t0 + i16) * 1024 + ks * 32 + g * 8);
            const bf16x8 b0 = *(const bf16x8*)(wdt + (size_t)i16 * 1024 + ks * 32 + g * 8), b1 = *(const bf16x8*)(wdt + (size_t)(16 + i16) * 1024 + ks * 32 + g * 8);
            a0 = __builtin_amdgcn_mfma_f32_16x16x32_bf16(av, b0, a0, 0, 0, 0); a1 = __builtin_amdgcn_mfma_f32_16x16x32_bf16(av, b1, a1, 0, 0, 0); }
        const float bias0 = bf[i16], bias1 = bb[i16];
#pragma unroll
        for (int r = 0; r < 4; ++r) { dt[(t0 + 4 * g + r) * 32 + i16] = softplus_f(a0[r] + bias0); dt[(t0 + 4 * g + r) * 32 + 16 + i16] = softplus_f(a1[r] + bias1); }
    }
}

__device__ __forceinline__ void p_conv(const Ctx& C, const bf16_t* xbc, bf16_t* xc) {
    const float* cw = C.in[6]; const float* cb = C.in[7];
    const int gt = C.bid * NTHR + C.tid, NT = C.G * NTHR;
    for (int i = gt; i < (T / 8) * 256; i += NT) {
        const int cg = i & 255, run = i >> 8, t0 = run * 8, l0 = t0 & (SEQ - 1), ch = cg * 8;
        float w[5][8], acc[8][8];
#pragma unroll
        for (int j = 0; j < 5; ++j) { const f32x4 w0 = *(const f32x4*)(cw + j * 2048 + ch), w1 = *(const f32x4*)(cw + j * 2048 + ch + 4);
            w[j][0] = w0.x; w[j][1] = w0.y; w[j][2] = w0.z; w[j][3] = w0.w; w[j][4] = w1.x; w[j][5] = w1.y; w[j][6] = w1.z; w[j][7] = w1.w; }
        { const f32x4 b0 = *(const f32x4*)(cb + ch), b1 = *(const f32x4*)(cb + ch + 4);
#pragma unroll
          for (int o = 0; o < 8; ++o) { acc[o][0] = b0.x; acc[o][1] = b0.y; acc[o][2] = b0.z; acc[o][3] = b0.w; acc[o][4] = b1.x; acc[o][5] = b1.y; acc[o][6] = b1.z; acc[o][7] = b1.w; } }
        u32x4 rw[12];
#pragma unroll
        for (int rr = 0; rr < 12; ++rr) { const int ll = l0 + rr - 2; rw[rr] = (u32x4){0u, 0u, 0u, 0u};
            if (ll >= 0 && ll < SEQ) rw[rr] = *(const u32x4*)(xbc + (size_t)(t0 + rr - 2) * 2048 + ch); }
#pragma unroll
        for (int rr = 0; rr < 12; ++rr) {
            const float x[8] = {bflo(rw[rr].x), bfhi(rw[rr].x), bflo(rw[rr].y), bfhi(rw[rr].y), bflo(rw[rr].z), bfhi(rw[rr].z), bflo(rw[rr].w), bfhi(rw[rr].w)};
#pragma unroll
            for (int j = 0; j < 5; ++j) { const int o = rr - j; if (o >= 0 && o < 8) {
#pragma unroll
                for (int q = 0; q < 8; ++q) acc[o][q] += w[j][q] * x[q]; } }
        }
#pragma unroll
        for (int o = 0; o < 8; ++o) { u32x4 ov; ov.x = pk2(silu_f(acc[o][0]), silu_f(acc[o][1])); ov.y = pk2(silu_f(acc[o][2]), silu_f(acc[o][3])); ov.z = pk2(silu_f(acc[o][4]), silu_f(acc[o][5])); ov.w = pk2(silu_f(acc[o][6]), silu_f(acc[o][7]));
            *(u32x4*)(xc + (size_t)(t0 + o) * 2048 + ch) = ov; }
    }
}

__device__ __forceinline__ void p_ssd_naive(const Ctx& C, const bf16_t* xc, const float* dtb, bf16_t* yf, bf16_t* yb) {
    if (C.wave == 0)
    for (int unit = C.bid; unit < 256; unit += C.G) {
        const int dir = unit & 1, hd = (unit >> 1) & 15, b = unit >> 5, g = hd >> 2, p = C.lane;
        const float a = -__expf((dir ? C.in[11] : C.in[10])[hd]);
        const float dsk = C.in[12][hd];
        float h[128];
#pragma unroll
        for (int n = 0; n < 128; ++n) h[n] = 0.f;
        for (int s = 0; s < SEQ; ++s) {
#ifdef DIAG_LOCAL
            if ((s & 127) == 0) {
#pragma unroll
                for (int n = 0; n < 128; ++n) h[n] = 0.f; }
#endif
            const int t = dir ? (SEQ - 1 - s) : s; const size_t row = (size_t)b * SEQ + t;
            const float dt = dtb[row * 32 + dir * 16 + hd];
            const float dA = __expf(dt * a);
            const float x = bf2f(xc[row * 2048 + hd * 64 + p]);
            const float xdt = x * dt;
            const u32x4* Bp = (const u32x4*)(xc + row * 2048 + 1024 + g * 128);
            const u32x4* Cp = (const u32x4*)(xc + row * 2048 + 1536 + g * 128);
            float y = 0.f;
#pragma unroll
            for (int n8 = 0; n8 < 16; ++n8) {
                const u32x4 bv = Bp[n8], cv = Cp[n8];
                const float bb[8] = {bflo(bv.x), bfhi(bv.x), bflo(bv.y), bfhi(bv.y), bflo(bv.z), bfhi(bv.z), bflo(bv.w), bfhi(bv.w)};
                const float cc[8] = {bflo(cv.x), bfhi(cv.x), bflo(cv.y), bfhi(cv.y), bflo(cv.z), bfhi(cv.z), bflo(cv.w), bfhi(cv.w)};
#pragma unroll
                for (int q = 0; q < 8; ++q) { const int n = n8 * 8 + q; h[n] = dA * h[n] + xdt * bb[q]; y += cc[q] * h[n]; }
            }
            if (dir == 0) yf[row * 1024 + hd * 64 + p] = (bf16_t)f2bf(y + dsk * x);
            else yb[row * 1024 + hd * 64 + p] = (bf16_t)f2bf(y);
        }
    }
}


namespace ssd {
typedef short bf16x8 __attribute__((ext_vector_type(8)));
typedef short s16x4 __attribute__((ext_vector_type(4)));
constexpr int RS = 272, RSX = 144;
constexpr int CN = 0, BN = 34816, BS = 69632, SL = 104448, SLB = 17408, XN = 139264, CSB = 157696;
__device__ __forceinline__ bf16x8 trfrag(LAS unsigned char* base, int stride, int ks, int c, int g, int q, int pp) {
    LAS unsigned char* a0 = base + (32 * ks + 8 * g + q) * stride + 32 * c + 8 * pp;
    const s16x4 v0 = __builtin_amdgcn_ds_read_tr16_b64_v4i16((LAS s16x4*)a0);
    const s16x4 v1 = __builtin_amdgcn_ds_read_tr16_b64_v4i16((LAS s16x4*)(a0 + 4 * stride));
    bf16x8 r; r[0] = v0[0]; r[1] = v0[1]; r[2] = v0[2]; r[3] = v0[3]; r[4] = v1[0]; r[5] = v1[1]; r[6] = v1[2]; r[7] = v1[3]; return r;
}
__device__ __forceinline__ unsigned pkbf(float lo, float hi) { return pk2(lo, hi); }
__device__ __forceinline__ bf16x8 trfrag_p(LAS unsigned char* base, int stride, int ks, int c, int g, int q, int pp) {
    LAS unsigned char* a0 = base + (32 * ks + 4 * g + q) * stride + 32 * c + 8 * pp;
    const s16x4 v0 = __builtin_amdgcn_ds_read_tr16_b64_v4i16((LAS s16x4*)a0);
    const s16x4 v1 = __builtin_amdgcn_ds_read_tr16_b64_v4i16((LAS s16x4*)(a0 + 16 * stride));
    bf16x8 r; r[0] = v0[0]; r[1] = v0[1]; r[2] = v0[2]; r[3] = v0[3]; r[4] = v1[0]; r[5] = v1[1]; r[6] = v1[2]; r[7] = v1[3]; return r;
}
}
__device__ __forceinline__ void p_ssd(const Ctx& C, const bf16_t* xc, const float* dtb, bf16_t* yf, bf16_t* yb) {
    using namespace ssd;
    LAS unsigned char* L = C.lds;
    const int tid = C.tid, lane = C.lane, w = C.wave, g = lane >> 4, i16 = lane & 15, q = (lane >> 2) & 3, pp = lane & 3;
    for (int unit = C.bid; unit < 256; unit += C.G) {
        const int dir = unit & 1, hd = (unit >> 1) & 15, b = unit >> 5, grp = hd >> 2;
        const float a = -__expf((dir ? C.in[11] : C.in[10])[hd]);
        const float dsk = dir ? 0.f : C.in[12][hd];
        bf16_t* yout = dir ? yb : yf;
        f32x4 sacc[4];
#pragma unroll
        for (int pt = 0; pt < 4; ++pt) sacc[pt] = (f32x4){0.f, 0.f, 0.f, 0.f};
        __syncthreads();
        for (int i = tid; i < 2 * SLB / 4; i += NTHR) ((LAS unsigned*)(L + SL))[i] = 0u;
        u32x4 pfC[4], pfB[4], pfX[2]; float pfd0 = 0.f, pfd1 = 0.f;
#define SSD_ISSUE(ci_) do { const int c_ = dir ? (31 - (ci_)) : (ci_); const size_t t0_ = (size_t)b * SEQ + (size_t)c_ * 128; \
            _Pragma("unroll") for (int i_ = 0; i_ < 4; ++i_) { const int idx_ = tid + NTHR * i_, l_ = idx_ >> 4, cc_ = idx_ & 15; const bf16_t* rp_ = xc + (t0_ + l_) * 2048 + grp * 128 + cc_ * 8; \
                pfB[i_] = *(const u32x4*)(rp_ + 1024); pfC[i_] = *(const u32x4*)(rp_ + 1536); } \
            _Pragma("unroll") for (int i_ = 0; i_ < 2; ++i_) { const int idx_ = tid + NTHR * i_, l_ = idx_ >> 3, cc_ = idx_ & 7; pfX[i_] = *(const u32x4*)(xc + (t0_ + l_) * 2048 + hd * 64 + cc_ * 8); } \
            if (w == 0) { const int l0_ = dir ? (127 - 2 * lane) : (2 * lane), l1_ = dir ? (126 - 2 * lane) : (2 * lane + 1); \
                pfd0 = dtb[(t0_ + l0_) * 32 + dir * 16 + hd]; pfd1 = dtb[(t0_ + l1_) * 32 + dir * 16 + hd]; } } while (0)
#define SSD_SCAN(buf_) do { if (w == 0) { const float da0_ = pfd0 * a, da1_ = pfd1 * a; const float p1_ = da0_ + da1_; float s_ = p1_; \
            _Pragma("unroll") for (int o_ = 1; o_ < 64; o_ <<= 1) { const float t_ = __shfl_up(s_, o_); if (lane >= o_) s_ += t_; } \
            const float ex_ = s_ - p1_, cs0_ = ex_ + da0_, cs1_ = ex_ + p1_, tot_ = __shfl(s_, 63); \
            const int l0_ = dir ? (127 - 2 * lane) : (2 * lane), l1_ = dir ? (126 - 2 * lane) : (2 * lane + 1); \
            LAS float* cb_ = (LAS float*)(L + CSB + (buf_) * 1536); \
            cb_[l0_] = cs0_; cb_[l1_] = cs1_; cb_[128 + l0_] = pfd0; cb_[128 + l1_] = pfd1; cb_[256 + l0_] = pfd0 * __expf(tot_ - cs0_); cb_[256 + l1_] = pfd1 * __expf(tot_ - cs1_); \
            if (lane == 0) *(LAS float*)(L + CSB + 3072 + 8 * (buf_)) = tot_; } } while (0)
#define SSD_WRITE(buf_) do { const LAS float* dw_ = (const LAS float*)(L + CSB + (buf_) * 1536 + 1024); \
            _Pragma("unroll") for (int i_ = 0; i_ < 4; ++i_) { const int idx_ = tid + NTHR * i_, l_ = idx_ >> 4, cc_ = idx_ & 15; \
                *(LAS u32x4*)(L + CN + l_ * RS + cc_ * 16) = pfC[i_]; *(LAS u32x4*)(L + BN + l_ * RS + cc_ * 16) = pfB[i_]; \
                const float sc_ = dw_[l_]; const u32x4 v_ = pfB[i_]; u32x4 o_; \
                o_.x = pkbf(bflo(v_.x) * sc_, bfhi(v_.x) * sc_); o_.y = pkbf(bflo(v_.y) * sc_, bfhi(v_.y) * sc_); o_.z = pkbf(bflo(v_.z) * sc_, bfhi(v_.z) * sc_); o_.w = pkbf(bflo(v_.w) * sc_, bfhi(v_.w) * sc_); \
                *(LAS u32x4*)(L + BS + l_ * RS + cc_ * 16) = o_; } \
            _Pragma("unroll") for (int i_ = 0; i_ < 2; ++i_) { const int idx_ = tid + NTHR * i_, l_ = idx_ >> 3, cc_ = idx_ & 7; *(LAS u32x4*)(L + XN + l_ * RSX + cc_ * 16) = pfX[i_]; } } while (0)
        SSD_ISSUE(0);
        SSD_SCAN(0);
        __syncthreads();
        SSD_WRITE(0);
        __syncthreads();
        for (int ci = 0; ci < 32; ++ci) {
            const int buf = ci & 1;
            const int c = dir ? (31 - ci) : ci; const size_t t0 = (size_t)b * SEQ + (size_t)c * 128;
            if (ci + 1 < 32) SSD_ISSUE(ci + 1);
            const LAS float* csb = (const LAS float*)(L + CSB + buf * 1536);
            const float cs_l = csb[16 * w + i16];
            const float cs_end = *(const LAS float*)(L + CSB + 3072 + 8 * buf);
            bf16x8 cfrag[4];
#pragma unroll
            for (int ks = 0; ks < 4; ++ks) cfrag[ks] = *(const LAS bf16x8*)(L + CN + (16 * w + i16) * RS + ks * 64 + g * 16);
            u32x2 mreg[8];
            const int lrow = 16 * w + i16;
#pragma unroll
            for (int st = 0; st < 8; ++st) {
                f32x4 acc = (f32x4){0.f, 0.f, 0.f, 0.f};
#pragma unroll
                for (int ks = 0; ks < 4; ++ks) { const bf16x8 af = *(const LAS bf16x8*)(L + BN + (16 * st + i16) * RS + ks * 64 + g * 16);
                    acc = __builtin_amdgcn_mfma_f32_16x16x32_bf16(af, cfrag[ks], acc, 0, 0, 0); }
                const f32x4 cs_s = *(const LAS f32x4*)(csb + 16 * st + 4 * g), dt_s = *(const LAS f32x4*)(csb + 128 + 16 * st + 4 * g);
                float mv[4];
#pragma unroll
                for (int r = 0; r < 4; ++r) { const int srow = 16 * st + 4 * g + r; const bool valid = dir ? (srow >= lrow) : (srow <= lrow);
                    const float e = valid ? __expf(cs_l - cs_s[r]) : 0.f; mv[r] = acc[r] * dt_s[r] * e; }
                mreg[st].x = pkbf(mv[0], mv[1]); mreg[st].y = pkbf(mv[2], mv[3]);
            }
            f32x4 yacc[4];
            const float el = __expf(cs_l);
#pragma unroll
            for (int pt = 0; pt < 4; ++pt) { f32x4 acc = (f32x4){0.f, 0.f, 0.f, 0.f};
#pragma unroll
                for (int ks = 0; ks < 4; ++ks) { const bf16x8 af = *(const LAS bf16x8*)(L + SL + buf * SLB + (16 * pt + i16) * RS + ks * 64 + g * 16);
                    acc = __builtin_amdgcn_mfma_f32_16x16x32_bf16(af, cfrag[ks], acc, 0, 0, 0); }
                yacc[pt] = acc * el; }
#pragma unroll
            for (int ks = 0; ks < 4; ++ks) { u32x4 mw; mw.x = mreg[2 * ks].x; mw.y = mreg[2 * ks].y; mw.z = mreg[2 * ks + 1].x; mw.w = mreg[2 * ks + 1].y;
                const bf16x8 mf = __builtin_bit_cast(bf16x8, mw);
#pragma unroll
                for (int pt = 0; pt < 4; ++pt) { const bf16x8 xf = trfrag_p(L + XN, RSX, ks, pt, g, q, pp); yacc[pt] = __builtin_amdgcn_mfma_f32_16x16x32_bf16(xf, mf, yacc[pt], 0, 0, 0); } }
#pragma unroll
            for (int pt = 0; pt < 4; ++pt) { const u32x2 xv = *(const LAS u32x2*)(L + XN + lrow * RSX + (16 * pt + 4 * g) * 2);
                u32x2 o; o.x = pkbf(yacc[pt][0] + dsk * bflo(xv.x), yacc[pt][1] + dsk * bfhi(xv.x)); o.y = pkbf(yacc[pt][2] + dsk * bflo(xv.y), yacc[pt][3] + dsk * bfhi(xv.y));
                *(u32x2*)(yout + (t0 + lrow) * 1024 + hd * 64 + 16 * pt + 4 * g) = o; }
            { const float dec = __expf(cs_end);
#pragma unroll
              for (int pt = 0; pt < 4; ++pt) sacc[pt] = sacc[pt] * dec; }
#pragma unroll
            for (int ks = 0; ks < 4; ++ks) { const bf16x8 bf = trfrag_p(L + BS, RS, ks, w, g, q, pp);
#pragma unroll
                for (int pt = 0; pt < 4; ++pt) { const bf16x8 xf = trfrag_p(L + XN, RSX, ks, pt, g, q, pp); sacc[pt] = __builtin_amdgcn_mfma_f32_16x16x32_bf16(bf, xf, sacc[pt], 0, 0, 0); } }
#ifdef DIAG_LOCAL
#pragma unroll
            for (int pt = 0; pt < 4; ++pt) sacc[pt] = (f32x4){0.f, 0.f, 0.f, 0.f};
#endif
#pragma unroll
            for (int pt = 0; pt < 4; ++pt) { u32x2 o; o.x = pkbf(sacc[pt][0], sacc[pt][1]); o.y = pkbf(sacc[pt][2], sacc[pt][3]);
                *(LAS u32x2*)(L + SL + (buf ^ 1) * SLB + (16 * pt + i16) * RS + (16 * w + 4 * g) * 2) = o; }
            if (ci + 1 < 32) SSD_SCAN(buf ^ 1);
            __syncthreads();
            if (ci + 1 < 32) SSD_WRITE(buf ^ 1);
            __syncthreads();
        }
#undef SSD_ISSUE
#undef SSD_SCAN
#undef SSD_WRITE
    }
}

__device__ __forceinline__ void p_na_naive(const Ctx& C, bf16_t* q, const bf16_t* k, const bf16_t* v) {
    const float* rpb = C.in[15];
    const int gt = C.bid * NTHR + C.tid, NT = C.G * NTHR;
    for (int i = gt; i < T * 16; i += NT) {
        const int hh = i & 15, tok = i >> 4, b = tok >> 12, l = tok & 4095, r = l >> 6, col = l & 63;
        int rs = r - 4; rs = rs < 0 ? 0 : (rs > 56 ? 56 : rs);
        int wsx = col - 8; wsx = wsx < 0 ? 0 : (wsx > 48 ? 48 : wsx);
        float qv[64], o[64];
        {
            const u32x4* qp = (const u32x4*)(q + (size_t)tok * 1024 + hh * 64);
#pragma unroll
            for (int d8 = 0; d8 < 8; ++d8) { const u32x4 w = qp[d8]; qv[d8 * 8 + 0] = bflo(w.x); qv[d8 * 8 + 1] = bfhi(w.x); qv[d8 * 8 + 2] = bflo(w.y); qv[d8 * 8 + 3] = bfhi(w.y);
                qv[d8 * 8 + 4] = bflo(w.z); qv[d8 * 8 + 5] = bfhi(w.z); qv[d8 * 8 + 6] = bflo(w.w); qv[d8 * 8 + 7] = bfhi(w.w); }
        }
#pragma unroll
        for (int d = 0; d < 64; ++d) o[d] = 0.f;
        float m = -1e30f, lsum = 0.f;
        for (int ii = 0; ii < 8; ++ii)
            for (int jj = 0; jj < 16; ++jj) {
                const int kr = rs + ii, kc = wsx + jj; const size_t kt = (size_t)b * SEQ + kr * 64 + kc;
                const u32x4* kp = (const u32x4*)(k + kt * 1024 + hh * 64);
                float s = 0.f;
#pragma unroll
                for (int d8 = 0; d8 < 8; ++d8) { const u32x4 w = kp[d8];
                    s += qv[d8 * 8 + 0] * bflo(w.x) + qv[d8 * 8 + 1] * bfhi(w.x) + qv[d8 * 8 + 2] * bflo(w.y) + qv[d8 * 8 + 3] * bfhi(w.y)
                       + qv[d8 * 8 + 4] * bflo(w.z) + qv[d8 * 8 + 5] * bfhi(w.z) + qv[d8 * 8 + 6] * bflo(w.w) + qv[d8 * 8 + 7] * bfhi(w.w); }
                s += rpb[hh * 15 * 31 + (kr - r + 7) * 31 + (kc - col + 15)];
                const float mn = fmaxf(m, s), al = __expf(m - mn), pe = __expf(s - mn);
                lsum = lsum * al + pe; m = mn;
                const u32x4* vp = (const u32x4*)(v + kt * 1024 + hh * 64);
#pragma unroll
                for (int d8 = 0; d8 < 8; ++d8) { const u32x4 w = vp[d8];
                    o[d8 * 8 + 0] = o[d8 * 8 + 0] * al + pe * bflo(w.x); o[d8 * 8 + 1] = o[d8 * 8 + 1] * al + pe * bfhi(w.x);
                    o[d8 * 8 + 2] = o[d8 * 8 + 2] * al + pe * bflo(w.y); o[d8 * 8 + 3] = o[d8 * 8 + 3] * al + pe * bfhi(w.y);
                    o[d8 * 8 + 4] = o[d8 * 8 + 4] * al + pe * bflo(w.z); o[d8 * 8 + 5] = o[d8 * 8 + 5] * al + pe * bfhi(w.z);
                    o[d8 * 8 + 6] = o[d8 * 8 + 6] * al + pe * bflo(w.w); o[d8 * 8 + 7] = o[d8 * 8 + 7] * al + pe * bfhi(w.w); }
            }
        const float inv = 1.f / lsum;
        u32x4* op = (u32x4*)(q + (size_t)tok * 1024 + hh * 64);
#pragma unroll
        for (int d8 = 0; d8 < 8; ++d8) { u32x4 w; w.x = pk2(o[d8 * 8 + 0] * inv, o[d8 * 8 + 1] * inv); w.y = pk2(o[d8 * 8 + 2] * inv, o[d8 * 8 + 3] * inv);
            w.z = pk2(o[d8 * 8 + 4] * inv, o[d8 * 8 + 5] * inv); w.w = pk2(o[d8 * 8 + 6] * inv, o[d8 * 8 + 7] * inv); op[d8] = w; }
    }
}


namespace nat {
typedef short bf16x8 __attribute__((ext_vector_type(8)));
typedef short s16x4 __attribute__((ext_vector_type(4)));
constexpr int VH = 65536, RPB = 131072;
__device__ __forceinline__ int voff(int ks, int d) { return ks * 128 + ((((d >> 3) ^ (ks & 7))) << 4) + (d & 7) * 2; }
__device__ __forceinline__ int clampi(int x, int lo, int hi) { return x < lo ? lo : (x > hi ? hi : x); }
}
__device__ __forceinline__ void p_na(const Ctx& C, bf16_t* q, const bf16_t* k, const bf16_t* v) {
    using namespace nat;
    LAS unsigned char* L = C.lds;
    const float* rpb = C.in[15];
    const int tid = C.tid, lane = C.lane, w = C.wave, g = lane >> 4, i16 = lane & 15, qq = (lane >> 2) & 3, pp = lane & 3;
    const int hl = w >> 2, m = w & 3;
    const int bs = (m == 0) ? 0 : (m == 1) ? 8 : (m == 2) ? 24 : 32;
    const int qc = 16 * m + i16, wsx = clampi(qc - 8, 0, 48);
    unsigned vmask = 0u; int dcol[8];
#pragma unroll
    for (int c = 0; c < 8; ++c) { const int kc = bs + (c >> 2) * 16 + 4 * g + (c & 3); if (kc >= wsx && kc < wsx + 16) vmask |= (1u << c); dcol[c] = clampi(kc - qc + 15, 0, 30); }
    for (int unit = C.bid; unit < 256; unit += C.G) {
        const int rseg = unit & 3, hp = (unit >> 2) & 7, b = unit >> 5, h = 2 * hp + hl;
        __syncthreads();
        for (int i = tid; i < 930; i += NTHR) ((LAS float*)(L + RPB))[i] = rpb[(2 * hp) * 465 + i];
#define NA_LOAD_ROW(row_) do { _Pragma("unroll") for (int i_ = 0; i_ < 2; ++i_) { const int idx_ = tid + NTHR * i_, hl_ = idx_ >> 9, col_ = (idx_ >> 3) & 63, dch_ = idx_ & 7; \
            const u32x4 val_ = *(const u32x4*)(v + ((size_t)b * SEQ + (size_t)(row_) * 64 + col_) * 1024 + (2 * hp + hl_) * 64 + dch_ * 8); \
            *(LAS u32x4*)(L + hl_ * VH + voff(((row_) & 7) * 64 + col_, dch_ * 8)) = val_; } } while (0)
        const int r0 = 16 * rseg; int rs_prev = clampi(r0 - 4, 0, 56);
        for (int rr = 0; rr < 8; ++rr) NA_LOAD_ROW(rs_prev + rr);
        __syncthreads();
        const LAS float* rpbl = (const LAS float*)(L + RPB) + hl * 465;
        for (int s = 0; s < 16; ++s) {
            const int r = r0 + s, rs = clampi(r - 4, 0, 56);
            if (rs != rs_prev) { __syncthreads(); NA_LOAD_ROW(rs + 7); __syncthreads(); rs_prev = rs; }
            const size_t tokq = (size_t)b * SEQ + (size_t)r * 64 + qc;
            bf16x8 qf[2];
#pragma unroll
            for (int ks = 0; ks < 2; ++ks) qf[ks] = *(const bf16x8*)(q + tokq * 1024 + h * 64 + ks * 32 + g * 8);
            f32x4 sc[16];
#pragma unroll
            for (int kt = 0; kt < 16; ++kt) { const size_t tokk = (size_t)b * SEQ + (size_t)(rs + (kt >> 1)) * 64 + bs + (kt & 1) * 16 + i16;
                f32x4 acc = (f32x4){0.f, 0.f, 0.f, 0.f};
#pragma unroll
                for (int ks = 0; ks < 2; ++ks) { const bf16x8 kf = *(const bf16x8*)(k + tokk * 1024 + h * 64 + ks * 32 + g * 8); acc = __builtin_amdgcn_mfma_f32_16x16x32_bf16(kf, qf[ks], acc, 0, 0, 0); }
                sc[kt] = acc; }
            float mx = -1.0e30f;
#pragma unroll
            for (int kt = 0; kt < 16; ++kt) { const int drow = rs + (kt >> 1) - r + 7;
#pragma unroll
                for (int e = 0; e < 4; ++e) { const int c = (kt & 1) * 4 + e; const float bias = rpbl[drow * 31 + dcol[c]];
                    const float val = ((vmask >> c) & 1u) ? sc[kt][e] + bias : -1.0e30f; sc[kt][e] = val; mx = fmaxf(mx, val); } }
            mx = fmaxf(mx, __shfl_xor(mx, 16)); mx = fmaxf(mx, __shfl_xor(mx, 32));
            float sum = 0.f;
#pragma unroll
            for (int kt = 0; kt < 16; ++kt)
#pragma unroll
                for (int e = 0; e < 4; ++e) { const float p = __expf(sc[kt][e] - mx); sc[kt][e] = p; sum += p; }
            sum += __shfl_xor(sum, 16); sum += __shfl_xor(sum, 32);
            f32x4 o[4];
#pragma unroll
            for (int dt = 0; dt < 4; ++dt) o[dt] = (f32x4){0.f, 0.f, 0.f, 0.f};
#pragma unroll
            for (int kk = 0; kk < 8; ++kk) {
                u32x4 pw; pw.x = pk2(sc[2 * kk][0], sc[2 * kk][1]); pw.y = pk2(sc[2 * kk][2], sc[2 * kk][3]); pw.z = pk2(sc[2 * kk + 1][0], sc[2 * kk + 1][1]); pw.w = pk2(sc[2 * kk + 1][2], sc[2 * kk + 1][3]);
                const bf16x8 pf = __builtin_bit_cast(bf16x8, pw);
                const int ks0 = ((rs + kk) & 7) * 64 + bs + 4 * g + qq, ks1 = ks0 + 16;
#pragma unroll
                for (int dt = 0; dt < 4; ++dt) {
                    const s16x4 v0 = __builtin_amdgcn_ds_read_tr16_b64_v4i16((LAS s16x4*)(L + hl * VH + voff(ks0, 16 * dt + 4 * pp)));
                    const s16x4 v1 = __builtin_amdgcn_ds_read_tr16_b64_v4i16((LAS s16x4*)(L + hl * VH + voff(ks1, 16 * dt + 4 * pp)));
                    bf16x8 vf; vf[0] = v0[0]; vf[1] = v0[1]; vf[2] = v0[2]; vf[3] = v0[3]; vf[4] = v1[0]; vf[5] = v1[1]; vf[6] = v1[2]; vf[7] = v1[3];
                    o[dt] = __builtin_amdgcn_mfma_f32_16x16x32_bf16(vf, pf, o[dt], 0, 0, 0); }
            }
            const float inv = 1.f / sum;
#pragma unroll
            for (int dt = 0; dt < 4; ++dt) { u32x2 ov; ov.x = pk2(o[dt][0] * inv, o[dt][1] * inv); ov.y = pk2(o[dt][2] * inv, o[dt][3] * inv);
                *(u32x2*)(q + tokq * 1024 + h * 64 + 16 * dt + 4 * g) = ov; }
        }
#undef NA_LOAD_ROW
    }
    __syncthreads();
}

__device__ __forceinline__ void p_combine(const Ctx& C, const bf16_t* yf, const bf16_t* yb, bf16_t* szu, float* rstd) {
    const int gw = C.bid * NWAVES + C.wave, NGW = C.G * NWAVES;
    for (int row0 = gw * 2; row0 < T; row0 += NGW * 2) {
        u32x4 a[2][2], b[2][2], z[2][2];
#pragma unroll
        for (int r = 0; r < 2; ++r)
#pragma unroll
            for (int j = 0; j < 2; ++j) { const size_t off = (size_t)(row0 + r) * 1024 + j * 512 + C.lane * 8;
                a[r][j] = *(const u32x4*)(yf + off); b[r][j] = *(const u32x4*)(yb + off); z[r][j] = *(const u32x4*)(szu + off); }
#pragma unroll
        for (int r = 0; r < 2; ++r) { float s = 0.f; u32x4 outv[2];
#pragma unroll
            for (int j = 0; j < 2; ++j) { const u32x4 av = a[r][j], bv = b[r][j], zv = z[r][j]; float u[8];
                u[0] = (bflo(av.x) + bflo(bv.x)) * bflo(zv.x); u[1] = (bfhi(av.x) + bfhi(bv.x)) * bfhi(zv.x);
                u[2] = (bflo(av.y) + bflo(bv.y)) * bflo(zv.y); u[3] = (bfhi(av.y) + bfhi(bv.y)) * bfhi(zv.y);
                u[4] = (bflo(av.z) + bflo(bv.z)) * bflo(zv.z); u[5] = (bfhi(av.z) + bfhi(bv.z)) * bfhi(zv.z);
                u[6] = (bflo(av.w) + bflo(bv.w)) * bflo(zv.w); u[7] = (bfhi(av.w) + bfhi(bv.w)) * bfhi(zv.w);
#pragma unroll
                for (int q = 0; q < 8; ++q) s += u[q] * u[q];
                outv[j].x = pk2(u[0], u[1]); outv[j].y = pk2(u[2], u[3]); outv[j].z = pk2(u[4], u[5]); outv[j].w = pk2(u[6], u[7]); }
            s = wave_sum(s);
#pragma unroll
            for (int j = 0; j < 2; ++j) *(u32x4*)(szu + (size_t)(row0 + r) * 1024 + j * 512 + C.lane * 8) = outv[j];
            if (C.lane == 0) rstd[row0 + r] = rsqrtf(s * (1.f / 1024.f) + EPS); }
    }
}

__device__ __forceinline__ void p_cvt_tables(const Ctx& C, bf16_t* ub, bf16_t* vb) {
    const int gt = C.bid * NTHR + C.tid, NT = C.G * NTHR;
    const float* u = C.in[21]; const float* v = C.in[22];
    for (int i = gt; i < 16384 * 1024 / 8; i += NT) {
        const f32x4 a0 = *(const f32x4*)(u + (size_t)i * 8), a1 = *(const f32x4*)(u + (size_t)i * 8 + 4);
        u32x4 o; o.x = pk2(a0.x, a0.y); o.y = pk2(a0.z, a0.w); o.z = pk2(a1.x, a1.y); o.w = pk2(a1.z, a1.w);
        *(u32x4*)(ub + (size_t)i * 8) = o;
        const f32x4 b0 = *(const f32x4*)(v + (size_t)i * 8), b1 = *(const f32x4*)(v + (size_t)i * 8 + 4);
        u32x4 p; p.x = pk2(b0.x, b0.y); p.y = pk2(b0.z, b0.w); p.z = pk2(b1.x, b1.y); p.w = pk2(b1.z, b1.w);
        *(u32x4*)(vb + (size_t)i * 8) = p;
    }
}

__device__ __forceinline__ void p_topk_naive(const Ctx& C, const bf16_t* qp, const bf16_t* keys, unsigned short* pidx, float* pgate) {
    constexpr int NTK = 64;
    LAS float* S = (LAS float*)C.lds;
    LAS float* TV = (LAS float*)(C.lds + 256 * NTK * 4);
    LAS int* TI = (LAS int*)(C.lds + 256 * NTK * 4 + 32 * NTK * 4);
    const int tl = C.tid;
    if (C.tid < 64)
    for (int item = C.bid * NTK + tl; item < T * 8; item += C.G * NTK) {
        const int t = item >> 3, hh = item & 7;
        for (int z = 0; z < 2; ++z) {
            unsigned qv[64];
            const u32x4* qptr = (const u32x4*)(qp + (size_t)t * 2048 + hh * 256 + z * 128);
#pragma unroll
            for (int d8 = 0; d8 < 16; ++d8) { const u32x4 w = qptr[d8]; qv[d8 * 4 + 0] = w.x; qv[d8 * 4 + 1] = w.y; qv[d8 * 4 + 2] = w.z; qv[d8 * 4 + 3] = w.w; }
            for (int n = 0; n < 128; ++n) {
                const u32x4* kp = (const u32x4*)(keys + (size_t)(z * 128 + n) * 128);
                float acc = 0.f;
#pragma unroll
                for (int d8 = 0; d8 < 16; ++d8) { const u32x4 w = kp[d8];
                    acc += bflo(qv[d8 * 4 + 0]) * bflo(w.x) + bfhi(qv[d8 * 4 + 0]) * bfhi(w.x) + bflo(qv[d8 * 4 + 1]) * bflo(w.y) + bfhi(qv[d8 * 4 + 1]) * bfhi(w.y)
                         + bflo(qv[d8 * 4 + 2]) * bflo(w.z) + bfhi(qv[d8 * 4 + 2]) * bfhi(w.z) + bflo(qv[d8 * 4 + 3]) * bflo(w.w) + bfhi(qv[d8 * 4 + 3]) * bfhi(w.w); }
                S[(z * 128 + n) * NTK + tl] = acc;
            }
            float pv = 3.0e38f; int pi = -1;
            for (int r = 0; r < 16; ++r) {
                float best = -3.0e38f; int bi = 0;
                for (int n = 0; n < 128; ++n) { const float x = S[(z * 128 + n) * NTK + tl];
                    const bool elig = (x < pv) || (x == pv && n > pi);
                    if (elig && x > best) { best = x; bi = n; } }
                TV[(z * 16 + r) * NTK + tl] = best; TI[(z * 16 + r) * NTK + tl] = bi; pv = best; pi = bi;
            }
        }
        float pv = 3.0e38f; int pi = -1; float top[16]; int ei[16];
#pragma unroll
        for (int r = 0; r < 16; ++r) {
            float best = -3.0e38f; int bi = 0;
            for (int c = 0; c < 256; ++c) { const float x = TV[(c >> 4) * NTK + tl] + TV[(16 + (c & 15)) * NTK + tl];
                const bool elig = (x < pv) || (x == pv && c > pi);
                if (elig && x > best) { best = x; bi = c; } }
            top[r] = best; ei[r] = TI[(bi >> 4) * NTK + tl] * 128 + TI[(16 + (bi & 15)) * NTK + tl]; pv = best; pi = bi;
        }
        float den = 0.f, e[16];
#pragma unroll
        for (int r = 0; r < 16; ++r) { e[r] = __expf(top[r] - top[0]); den += e[r]; }
        const float inv = 1.f / den;
#pragma unroll
        for (int r = 0; r < 16; ++r) { pidx[(size_t)t * 128 + hh * 16 + r] = (unsigned short)ei[r]; pgate[(size_t)t * 128 + hh * 16 + r] = e[r] * inv; }
    }
}


namespace tk {
typedef short bf16x8 __attribute__((ext_vector_type(8)));
constexpr int RSK = 272, TAB = 69632, TABW = 33 * 16 * 4, IJT = TAB + 8 * TABW;
__device__ __forceinline__ void ce(float& a, float& b) { const float hi = __builtin_fmaxf(a, b), lo = __builtin_fminf(a, b); a = hi; b = lo; }
__device__ __forceinline__ void sort16(float (&v)[16]) {
#pragma unroll
    for (int k = 2; k <= 16; k <<= 1)
#pragma unroll
        for (int j = k >> 1; j > 0; j >>= 1)
#pragma unroll
            for (int i = 0; i < 16; ++i) { const int l = i ^ j; if (l > i) { if ((i & k) == 0) ce(v[i], v[l]); else ce(v[l], v[i]); } }
}
__device__ __forceinline__ void merge16(float (&a)[16], const float (&b)[16]) {
#pragma unroll
    for (int i = 0; i < 16; ++i) a[i] = __builtin_fmaxf(a[i], b[15 - i]);
#pragma unroll
    for (int j = 8; j > 0; j >>= 1)
#pragma unroll
        for (int i = 0; i < 16; ++i) { const int l = i ^ j; if (l > i) ce(a[i], a[l]); }
}
__device__ __forceinline__ void xmerge(float (&a)[16], int mask) { float b[16];
#pragma unroll
    for (int i = 0; i < 16; ++i) b[i] = __shfl_xor(a[i], mask);
    merge16(a, b); }
}
__device__ __forceinline__ void p_topk(const Ctx& C, const bf16_t* qp, const bf16_t* keys, unsigned short* pidx, float* pgate) {
    using namespace tk;
    LAS unsigned char* L = C.lds;
    const int tid = C.tid, lane = C.lane, w = C.wave, g = lane >> 4, i16 = lane & 15;
    __syncthreads();
    for (int i = tid; i < 4096; i += NTHR) { const int r = i >> 4, cc = i & 15; *(LAS u32x4*)(L + r * RSK + cc * 16) = *(const u32x4*)(keys + (size_t)r * 128 + cc * 8); }
    if (tid < 64) { int cnt = 0, fi = 0, fj = 0;
        for (int i = 0; i < 16; ++i) for (int j = 0; j < 16; ++j) if ((i + 1) * (j + 1) <= 16) { if (cnt == tid) { fi = i; fj = j; } ++cnt; }
        ((LAS unsigned*)(L + IJT))[tid] = (unsigned)(fi | (fj << 4)); }
    __syncthreads();
    LAS unsigned* tab = (LAS unsigned*)(L + TAB + w * TABW) + i16 * 33;
    const LAS unsigned* ijt = (const LAS unsigned*)(L + IJT);
    const float NEGV = -1.0e30f;
    const int gw = C.bid * NWAVES + w, NGW = C.G * NWAVES;
    for (int unit = gw; unit < (T / 16) * 8; unit += NGW) {
        const int tg = unit >> 3, hh = unit & 7; const size_t t0 = (size_t)tg * 16;
        float s1[16], s2[16];
#pragma unroll
        for (int z = 0; z < 2; ++z) {
            bf16x8 qf[4];
#pragma unroll
            for (int ks = 0; ks < 4; ++ks) qf[ks] = *(const bf16x8*)(qp + (t0 + i16) * 2048 + hh * 256 + z * 128 + ks * 32 + g * 8);
            float lo[16], hi[16];
#pragma unroll
            for (int nt = 0; nt < 8; ++nt) { f32x4 acc = (f32x4){0.f, 0.f, 0.f, 0.f};
#pragma unroll
                for (int ks = 0; ks < 4; ++ks) { const bf16x8 kf = *(const LAS bf16x8*)(L + (z * 128 + 16 * nt + i16) * RSK + ks * 64 + g * 16);
                    acc = __builtin_amdgcn_mfma_f32_16x16x32_bf16(kf, qf[ks], acc, 0, 0, 0); }
#pragma unroll
                for (int r = 0; r < 4; ++r) { const float pv = __uint_as_float((__float_as_uint(acc[r]) & 0xFFFFFF80u) | (unsigned)(16 * nt + 4 * g + r));
                    if (nt < 4) lo[nt * 4 + r] = pv; else hi[(nt - 4) * 4 + r] = pv; } }
            sort16(lo); sort16(hi); merge16(lo, hi);
            xmerge(lo, 16); xmerge(lo, 32);
#pragma unroll
            for (int i = 0; i < 16; ++i) { if (z == 0) s1[i] = lo[i]; else s2[i] = lo[i]; }
        }
#pragma unroll
        for (int i = 0; i < 16; ++i) { tab[i] = __float_as_uint(s1[i]); tab[16 + i] = __float_as_uint(s2[i]); }
        float cand[16];
            { const float a_ = (g == 0 ? s1[0] : g == 1 ? s1[1] : g == 2 ? s1[3] : s1[14]), b_ = (g == 0 ? s2[0] : g == 1 ? s2[0] : g == 2 ? s2[3] : s2[0]); cand[0] = __uint_as_float((__float_as_uint(a_ + b_) & 0xFFFFFFC0u) | (unsigned)(16 * g + 0)); }
            { const float a_ = (g == 0 ? s1[0] : g == 1 ? s1[1] : g == 2 ? s1[4] : s1[15]), b_ = (g == 0 ? s2[1] : g == 1 ? s2[1] : g == 2 ? s2[0] : s2[0]); cand[1] = __uint_as_float((__float_as_uint(a_ + b_) & 0xFFFFFFC0u) | (unsigned)(16 * g + 1)); }
            { const float a_ = (g == 0 ? s1[0] : g == 1 ? s1[1] : g == 2 ? s1[4] : NEGV), b_ = (g == 0 ? s2[2] : g == 1 ? s2[2] : g == 2 ? s2[1] : NEGV); cand[2] = __uint_as_float((__float_as_uint(a_ + b_) & 0xFFFFFFC0u) | (unsigned)(16 * g + 2)); }
            { const float a_ = (g == 0 ? s1[0] : g == 1 ? s1[1] : g == 2 ? s1[4] : NEGV), b_ = (g == 0 ? s2[3] : g == 1 ? s2[3] : g == 2 ? s2[2] : NEGV); cand[3] = __uint_as_float((__float_as_uint(a_ + b_) & 0xFFFFFFC0u) | (unsigned)(16 * g + 3)); }
            { const float a_ = (g == 0 ? s1[0] : g == 1 ? s1[1] : g == 2 ? s1[5] : NEGV), b_ = (g == 0 ? s2[4] : g == 1 ? s2[4] : g == 2 ? s2[0] : NEGV); cand[4] = __uint_as_float((__float_as_uint(a_ + b_) & 0xFFFFFFC0u) | (unsigned)(16 * g + 4)); }
            { const float a_ = (g == 0 ? s1[0] : g == 1 ? s1[1] : g == 2 ? s1[5] : NEGV), b_ = (g == 0 ? s2[5] : g == 1 ? s2[5] : g == 2 ? s2[1] : NEGV); cand[5] = __uint_as_float((__float_as_uint(a_ + b_) & 0xFFFFFFC0u) | (unsigned)(16 * g + 5)); }
            { const float a_ = (g == 0 ? s1[0] : g == 1 ? s1[1] : g == 2 ? s1[6] : NEGV), b_ = (g == 0 ? s2[6] : g == 1 ? s2[6] : g == 2 ? s2[0] : NEGV); cand[6] = __uint_as_float((__float_as_uint(a_ + b_) & 0xFFFFFFC0u) | (unsigned)(16 * g + 6)); }
            { const float a_ = (g == 0 ? s1[0] : g == 1 ? s1[1] : g == 2 ? s1[6] : NEGV), b_ = (g == 0 ? s2[7] : g == 1 ? s2[7] : g == 2 ? s2[1] : NEGV); cand[7] = __uint_as_float((__float_as_uint(a_ + b_) & 0xFFFFFFC0u) | (unsigned)(16 * g + 7)); }
            { const float a_ = (g == 0 ? s1[0] : g == 1 ? s1[2] : g == 2 ? s1[7] : NEGV), b_ = (g == 0 ? s2[8] : g == 1 ? s2[0] : g == 2 ? s2[0] : NEGV); cand[8] = __uint_as_float((__float_as_uint(a_ + b_) & 0xFFFFFFC0u) | (unsigned)(16 * g + 8)); }
            { const float a_ = (g == 0 ? s1[0] : g == 1 ? s1[2] : g == 2 ? s1[7] : NEGV), b_ = (g == 0 ? s2[9] : g == 1 ? s2[1] : g == 2 ? s2[1] : NEGV); cand[9] = __uint_as_float((__float_as_uint(a_ + b_) & 0xFFFFFFC0u) | (unsigned)(16 * g + 9)); }
            { const float a_ = (g == 0 ? s1[0] : g == 1 ? s1[2] : g == 2 ? s1[8] : NEGV), b_ = (g == 0 ? s2[10] : g == 1 ? s2[2] : g == 2 ? s2[0] : NEGV); cand[10] = __uint_as_float((__float_as_uint(a_ + b_) & 0xFFFFFFC0u) | (unsigned)(16 * g + 10)); }
            { const float a_ = (g == 0 ? s1[0] : g == 1 ? s1[2] : g == 2 ? s1[9] : NEGV), b_ = (g == 0 ? s2[11] : g == 1 ? s2[3] : g == 2 ? s2[0] : NEGV); cand[11] = __uint_as_float((__float_as_uint(a_ + b_) & 0xFFFFFFC0u) | (unsigned)(16 * g + 11)); }
            { const float a_ = (g == 0 ? s1[0] : g == 1 ? s1[2] : g == 2 ? s1[10] : NEGV), b_ = (g == 0 ? s2[12] : g == 1 ? s2[4] : g == 2 ? s2[0] : NEGV); cand[12] = __uint_as_float((__float_as_uint(a_ + b_) & 0xFFFFFFC0u) | (unsigned)(16 * g + 12)); }
            { const float a_ = (g == 0 ? s1[0] : g == 1 ? s1[3] : g == 2 ? s1[11] : NEGV), b_ = (g == 0 ? s2[13] : g == 1 ? s2[0] : g == 2 ? s2[0] : NEGV); cand[13] = __uint_as_float((__float_as_uint(a_ + b_) & 0xFFFFFFC0u) | (unsigned)(16 * g + 13)); }
            { const float a_ = (g == 0 ? s1[0] : g == 1 ? s1[3] : g == 2 ? s1[12] : NEGV), b_ = (g == 0 ? s2[14] : g == 1 ? s2[1] : g == 2 ? s2[0] : NEGV); cand[14] = __uint_as_float((__float_as_uint(a_ + b_) & 0xFFFFFFC0u) | (unsigned)(16 * g + 14)); }
            { const float a_ = (g == 0 ? s1[0] : g == 1 ? s1[3] : g == 2 ? s1[13] : NEGV), b_ = (g == 0 ? s2[15] : g == 1 ? s2[2] : g == 2 ? s2[0] : NEGV); cand[15] = __uint_as_float((__float_as_uint(a_ + b_) & 0xFFFFFFC0u) | (unsigned)(16 * g + 15)); }
        sort16(cand);
        xmerge(cand, 16); xmerge(cand, 32);
        float den = 0.f, ex[16];
#pragma unroll
        for (int i = 0; i < 16; ++i) { ex[i] = __expf(cand[i] - cand[0]); den += ex[i]; }
        const float inv = 1.f / den;
        unsigned short eo[4]; float go[4];
#pragma unroll
        for (int e = 0; e < 4; ++e) {
            const float cv = (g == 0 ? cand[e] : g == 1 ? cand[4 + e] : g == 2 ? cand[8 + e] : cand[12 + e]);
            const float gv = (g == 0 ? ex[e] : g == 1 ? ex[4 + e] : g == 2 ? ex[8 + e] : ex[12 + e]);
            const unsigned code = __float_as_uint(cv) & 63u; const unsigned ij = ijt[code];
            const unsigned p1 = tab[ij & 15u], p2 = tab[16 + (ij >> 4)];
            eo[e] = (unsigned short)((p1 & 127u) * 128u + (p2 & 127u)); go[e] = gv * inv; }
        u32x2 ov; ov.x = (unsigned)eo[0] | ((unsigned)eo[1] << 16); ov.y = (unsigned)eo[2] | ((unsigned)eo[3] << 16);
        *(u32x2*)(pidx + (t0 + i16) * 128 + hh * 16 + 4 * g) = ov;
        *(f32x4*)(pgate + (t0 + i16) * 128 + hh * 16 + 4 * g) = (f32x4){go[0], go[1], go[2], go[3]};
    }
    __syncthreads();
}

__device__ __forceinline__ float dot2u(unsigned a, unsigned x, float acc) {
    return __builtin_amdgcn_fdot2_f32_bf16(__builtin_bit_cast(bf16x2_t, a), __builtin_bit_cast(bf16x2_t, x), acc, false);
}
__device__ __forceinline__ float dot8(const u32x4 a, const u32x4 x, float acc) {
    const unsigned a0 = a.x, a1 = a.y, a2 = a.z, a3 = a.w, x0 = x.x, x1 = x.y, x2 = x.z, x3 = x.w;
    acc = dot2u(a0, x0, acc); acc = dot2u(a1, x1, acc); acc = dot2u(a2, x2, acc); acc = dot2u(a3, x3, acc);
    return acc;
}
__device__ __forceinline__ void p_gather(const Ctx& C, const bf16_t* n2, const unsigned short* pidx, const float* pgate, const bf16_t* ub, const bf16_t* vb, const float* h, float* out) {
    const float* mod = C.f32p(WS_MOD); const float* fg = C.in[23];
    LAS float* cbuf = (LAS float*)C.lds + C.wave * 128;
    const int gw = C.bid * NWAVES + C.wave, NGW = C.G * NWAVES, lane = C.lane;
    for (int t = gw; t < T; t += NGW) {
        const int b = t / SEQ;
        const u32x4 x0 = *(const u32x4*)(n2 + (size_t)t * 1024 + lane * 8), x1 = *(const u32x4*)(n2 + (size_t)t * 1024 + 512 + lane * 8);
        const int id0 = pidx[(size_t)t * 128 + lane], id1 = pidx[(size_t)t * 128 + 64 + lane];
        const float g0 = pgate[(size_t)t * 128 + lane], g1 = pgate[(size_t)t * 128 + 64 + lane];
#pragma unroll 1
        for (int grp = 0; grp < 8; ++grp) {
            const int idv = grp < 4 ? id0 : id1; const int lbase = (grp & 3) * 16;
            float part[16];
#pragma unroll
            for (int j = 0; j < 16; ++j) {
                const int e = __shfl(idv, lbase + j);
                const bf16_t* rowp = ub + (size_t)e * 1024;
                const u32x4 a0 = *(const u32x4*)(rowp + lane * 8), a1 = *(const u32x4*)(rowp + 512 + lane * 8);
                part[j] = dot8(a1, x1, dot8(a0, x0, 0.f));
            }
            float p8[8];
            { const bool hi = (lane & 32) != 0;
#pragma unroll
              for (int j = 0; j < 8; ++j) { const float keep = hi ? part[j + 8] : part[j], send = hi ? part[j] : part[j + 8]; p8[j] = keep + __shfl_xor(send, 32); } }
            float p4[4];
            { const bool hi = (lane & 16) != 0;
#pragma unroll
              for (int j = 0; j < 4; ++j) { const float keep = hi ? p8[j + 4] : p8[j], send = hi ? p8[j] : p8[j + 4]; p4[j] = keep + __shfl_xor(send, 16); } }
            float p2[2];
            { const bool hi = (lane & 8) != 0;
#pragma unroll
              for (int j = 0; j < 2; ++j) { const float keep = hi ? p4[j + 2] : p4[j], send = hi ? p4[j] : p4[j + 2]; p2[j] = keep + __shfl_xor(send, 8); } }
            float p1;
            { const bool hi = (lane & 4) != 0; const float keep = hi ? p2[1] : p2[0], send = hi ? p2[0] : p2[1]; p1 = keep + __shfl_xor(send, 4); }
            p1 += __shfl_xor(p1, 2); p1 += __shfl_xor(p1, 1);
            const int E = ((lane >> 5) & 1) * 8 + ((lane >> 4) & 1) * 4 + ((lane >> 3) & 1) * 2 + ((lane >> 2) & 1);
            if ((lane & 3) == 0) cbuf[grp * 16 + E] = gelu_f(p1);
        }
        asm volatile("s_waitcnt lgkmcnt(0)" ::: "memory");
        const float c0 = cbuf[lane] * g0, c1 = cbuf[64 + lane] * g1;
        asm volatile("s_waitcnt lgkmcnt(0)" ::: "memory");
        float acc[16];
#pragma unroll
        for (int i = 0; i < 16; ++i) acc[i] = 0.f;
#pragma unroll 1
        for (int kb = 0; kb < 128; kb += 8) {
            const int idv = kb < 64 ? id0 : id1; const float cv = kb < 64 ? c0 : c1;
#pragma unroll
            for (int j = 0; j < 8; ++j) {
                const int e = __shfl(idv, (kb & 63) + j); const float ck = __shfl(cv, (kb & 63) + j);
                const bf16_t* rowp = vb + (size_t)e * 1024;
                const u32x4 a0 = *(const u32x4*)(rowp + lane * 8), a1 = *(const u32x4*)(rowp + 512 + lane * 8);
                acc[0] += ck * bflo(a0.x); acc[1] += ck * bfhi(a0.x); acc[2] += ck * bflo(a0.y); acc[3] += ck * bfhi(a0.y);
                acc[4] += ck * bflo(a0.z); acc[5] += ck * bfhi(a0.z); acc[6] += ck * bflo(a0.w); acc[7] += ck * bfhi(a0.w);
                acc[8] += ck * bflo(a1.x); acc[9] += ck * bfhi(a1.x); acc[10] += ck * bflo(a1.y); acc[11] += ck * bfhi(a1.y);
                acc[12] += ck * bflo(a1.z); acc[13] += ck * bfhi(a1.z); acc[14] += ck * bflo(a1.w); acc[15] += ck * bfhi(a1.w);
            }
        }
        float hf[16]; float ss = 0.f;
#pragma unroll
        for (int half = 0; half < 2; ++half) {
            const int col = half * 512 + lane * 8;
            const f32x4 h0 = *(const f32x4*)(h + (size_t)t * 1024 + col), h1 = *(const f32x4*)(h + (size_t)t * 1024 + col + 4);
            const f32x4 m0 = *(const f32x4*)(mod + b * 6144 + 5120 + col), m1 = *(const f32x4*)(mod + b * 6144 + 5120 + col + 4);
            hf[half * 8 + 0] = h0.x + m0.x * acc[half * 8 + 0]; hf[half * 8 + 1] = h0.y + m0.y * acc[half * 8 + 1];
            hf[half * 8 + 2] = h0.z + m0.z * acc[half * 8 + 2]; hf[half * 8 + 3] = h0.w + m0.w * acc[half * 8 + 3];
            hf[half * 8 + 4] = h1.x + m1.x * acc[half * 8 + 4]; hf[half * 8 + 5] = h1.y + m1.y * acc[half * 8 + 5];
            hf[half * 8 + 6] = h1.z + m1.z * acc[half * 8 + 6]; hf[half * 8 + 7] = h1.w + m1.w * acc[half * 8 + 7];
        }
#pragma unroll
        for (int i = 0; i < 16; ++i) ss += hf[i] * hf[i];
        const float rstd = rsqrtf(wave_sum(ss) * (1.f / 1024.f) + EPS);
#pragma unroll
        for (int half = 0; half < 2; ++half) {
            const int col = half * 512 + lane * 8;
            const f32x4 f0 = *(const f32x4*)(fg + col), f1 = *(const f32x4*)(fg + col + 4);
            f32x4 o0, o1;
            o0.x = hf[half * 8 + 0] * rstd * f0.x; o0.y = hf[half * 8 + 1] * rstd * f0.y; o0.z = hf[half * 8 + 2] * rstd * f0.z; o0.w = hf[half * 8 + 3] * rstd * f0.w;
            o1.x = hf[half * 8 + 4] * rstd * f1.x; o1.y = hf[half * 8 + 5] * rstd * f1.y; o1.z = hf[half * 8 + 6] * rstd * f1.z; o1.w = hf[half * 8 + 7] * rstd * f1.w;
            *(f32x4*)(out + (size_t)t * 1024 + col) = o0; *(f32x4*)(out + (size_t)t * 1024 + col + 4) = o1;
        }
    }
}


__device__ __forceinline__ void p_cvt_tables8(const Ctx& C, unsigned char* u8, unsigned char* v8) {
    const int gt = C.bid * NTHR + C.tid, NT = C.G * NTHR;
    const float* u = C.in[21]; const float* v = C.in[22];
    constexpr int N4 = 16384 * 1024 / 4;
    for (int i0 = gt; i0 < N4; i0 += 4 * NT) {
        f32x4 a[4], b[4];
#pragma unroll
        for (int r = 0; r < 4; ++r) { const int i = i0 + r * NT; if (i < N4) { a[r] = *(const f32x4*)(u + (size_t)i * 4); b[r] = *(const f32x4*)(v + (size_t)i * 4); } }
#pragma unroll
        for (int r = 0; r < 4; ++r) { const int i = i0 + r * NT; if (i < N4) {
            const f32x4 av = a[r] * 256.f, bv = b[r] * 64.f; unsigned x = 0u, y = 0u;
            x = __builtin_amdgcn_cvt_pk_fp8_f32(av.x, av.y, x, false); x = __builtin_amdgcn_cvt_pk_fp8_f32(av.z, av.w, x, true);
            y = __builtin_amdgcn_cvt_pk_fp8_f32(bv.x, bv.y, y, false); y = __builtin_amdgcn_cvt_pk_fp8_f32(bv.z, bv.w, y, true);
            *(unsigned*)(u8 + (size_t)i * 4) = x; *(unsigned*)(v8 + (size_t)i * 4) = y; } }
    }
}

__device__ __forceinline__ void p_gather8(const Ctx& C, const bf16_t* n2, const unsigned short* pidx, const float* pgate, const unsigned char* u8, const unsigned char* v8, const float* h, float* out) {
    const float* mod = C.f32p(WS_MOD); const float* fg = C.in[23];
    LAS float* cbuf = (LAS float*)C.lds + C.wave * 128;
    const int gw = C.bid * NWAVES + C.wave, NGW = C.G * NWAVES, lane = C.lane;
    for (int t = gw; t < T; t += NGW) {
        const int b = t / SEQ;
        unsigned xp[8];
        { const u32x4 x0 = *(const u32x4*)(n2 + (size_t)t * 1024 + lane * 16), x1 = *(const u32x4*)(n2 + (size_t)t * 1024 + lane * 16 + 8);
          xp[0] = x0.x; xp[1] = x0.y; xp[2] = x0.z; xp[3] = x0.w; xp[4] = x1.x; xp[5] = x1.y; xp[6] = x1.z; xp[7] = x1.w; }
        const int id0 = pidx[(size_t)t * 128 + lane], id1 = pidx[(size_t)t * 128 + 64 + lane];
        const float g0 = pgate[(size_t)t * 128 + lane], g1 = pgate[(size_t)t * 128 + 64 + lane];
        u32x4 bufA[8], bufB[8];
#define G8_LOAD8(buf_, tab_, slot0_) do { const int idv_ = (slot0_) < 64 ? id0 : id1; _Pragma("unroll") for (int j_ = 0; j_ < 8; ++j_) { const int e_ = __builtin_amdgcn_readlane(idv_, ((slot0_) & 63) + j_); \
            buf_[j_] = *(const u32x4*)((tab_) + (size_t)e_ * 1024 + lane * 16); } } while (0)
#define G8_UDOT8(buf_, off_) do { _Pragma("unroll") for (int j_ = 0; j_ < 8; ++j_) { float acc_ = 0.f; \
                _Pragma("unroll") for (int d_ = 0; d_ < 4; ++d_) { const unsigned wv_ = buf_[j_][d_]; \
                    const bf16x2_t lo_ = __builtin_amdgcn_cvt_scalef32_pk_bf16_fp8(wv_, 0.00390625f, false), hi_ = __builtin_amdgcn_cvt_scalef32_pk_bf16_fp8(wv_, 0.00390625f, true); \
                    const unsigned xa_ = xp[2 * d_], xb_ = xp[2 * d_ + 1]; \
                    acc_ = __builtin_amdgcn_fdot2_f32_bf16(lo_, __builtin_bit_cast(bf16x2_t, xa_), acc_, false); acc_ = __builtin_amdgcn_fdot2_f32_bf16(hi_, __builtin_bit_cast(bf16x2_t, xb_), acc_, false); } \
                part[(off_) + j_] = acc_; __builtin_amdgcn_sched_barrier(0); } } while (0)
#define G8_REDUCE(grp_) do { \
            float p8[8]; { const bool hi = (lane & 32) != 0; \
              _Pragma("unroll") for (int j_ = 0; j_ < 8; ++j_) { const float keep = hi ? part[j_ + 8] : part[j_], send = hi ? part[j_] : part[j_ + 8]; p8[j_] = keep + __shfl_xor(send, 32); } } \
            float p4[4]; { const bool hi = (lane & 16) != 0; \
              _Pragma("unroll") for (int j_ = 0; j_ < 4; ++j_) { const float keep = hi ? p8[j_ + 4] : p8[j_], send = hi ? p8[j_] : p8[j_ + 4]; p4[j_] = keep + __shfl_xor(send, 16); } } \
            float p2[2]; { const bool hi = (lane & 8) != 0; \
              _Pragma("unroll") for (int j_ = 0; j_ < 2; ++j_) { const float keep = hi ? p4[j_ + 2] : p4[j_], send = hi ? p4[j_] : p4[j_ + 2]; p2[j_] = keep + __shfl_xor(send, 8); } } \
            float p1; { const bool hi = (lane & 4) != 0; const float keep = hi ? p2[1] : p2[0], send = hi ? p2[0] : p2[1]; p1 = keep + __shfl_xor(send, 4); } \
            p1 += __shfl_xor(p1, 2); p1 += __shfl_xor(p1, 1); \
            const int E_ = ((lane >> 5) & 1) * 8 + ((lane >> 4) & 1) * 4 + ((lane >> 3) & 1) * 2 + ((lane >> 2) & 1); \
            if ((lane & 3) == 0) cbuf[(grp_) * 16 + E_] = gelu_f(p1); } while (0)
        G8_LOAD8(bufA, u8, 0); G8_LOAD8(bufB, u8, 8);
#pragma unroll 1
        for (int grp = 0; grp < 8; ++grp) {
            float part[16];
            G8_UDOT8(bufA, 0);
            if (grp < 7) G8_LOAD8(bufA, u8, 16 * (grp + 1)); else G8_LOAD8(bufA, v8, 0);
            G8_UDOT8(bufB, 8);
            if (grp < 7) G8_LOAD8(bufB, u8, 16 * (grp + 1) + 8); else G8_LOAD8(bufB, v8, 8);
            G8_REDUCE(grp);
        }
        asm volatile("s_waitcnt lgkmcnt(0)" ::: "memory");
        const float c0 = cbuf[lane] * g0 * 0.015625f, c1 = cbuf[64 + lane] * g1 * 0.015625f;
        asm volatile("s_waitcnt lgkmcnt(0)" ::: "memory");
        float acc[16];
#pragma unroll
        for (int i = 0; i < 16; ++i) acc[i] = 0.f;
#define G8_VCOMP8(buf_, slot0_) do { const float cv_ = (slot0_) < 64 ? c0 : c1; _Pragma("unroll") for (int j_ = 0; j_ < 8; ++j_) { const float ck_ = __int_as_float(__builtin_amdgcn_readlane(__float_as_int(cv_), ((slot0_) & 63) + j_)); \
            _Pragma("unroll") for (int d_ = 0; d_ < 4; ++d_) { const unsigned wv_ = buf_[j_][d_]; const f32x2_t lo_ = __builtin_amdgcn_cvt_pk_f32_fp8(wv_, false), hi_ = __builtin_amdgcn_cvt_pk_f32_fp8(wv_, true); \
                acc[4 * d_ + 0] += ck_ * lo_.x; acc[4 * d_ + 1] += ck_ * lo_.y; acc[4 * d_ + 2] += ck_ * hi_.x; acc[4 * d_ + 3] += ck_ * hi_.y; } \
            asm volatile("" : "+v"(acc[0]), "+v"(acc[1]), "+v"(acc[2]), "+v"(acc[3]), "+v"(acc[4]), "+v"(acc[5]), "+v"(acc[6]), "+v"(acc[7]), "+v"(acc[8]), "+v"(acc[9]), "+v"(acc[10]), "+v"(acc[11]), "+v"(acc[12]), "+v"(acc[13]), "+v"(acc[14]), "+v"(acc[15])); } } while (0)
#pragma unroll 1
        for (int grp = 0; grp < 8; ++grp) {
            G8_VCOMP8(bufA, 16 * grp);
            if (grp < 7) G8_LOAD8(bufA, v8, 16 * (grp + 1));
            G8_VCOMP8(bufB, 16 * grp + 8);
            if (grp < 7) G8_LOAD8(bufB, v8, 16 * (grp + 1) + 8);
        }
#undef G8_LOAD8
#undef G8_UDOT8
#undef G8_REDUCE
#undef G8_VCOMP8
        float hf[16]; float ss = 0.f;
#pragma unroll
        for (int d = 0; d < 4; ++d) { const int col = lane * 16 + d * 4;
            const f32x4 hv = *(const f32x4*)(h + (size_t)t * 1024 + col), mv = *(const f32x4*)(mod + b * 6144 + 5120 + col);
            hf[4 * d + 0] = hv.x + mv.x * acc[4 * d + 0]; hf[4 * d + 1] = hv.y + mv.y * acc[4 * d + 1]; hf[4 * d + 2] = hv.z + mv.z * acc[4 * d + 2]; hf[4 * d + 3] = hv.w + mv.w * acc[4 * d + 3]; }
#pragma unroll
        for (int i = 0; i < 16; ++i) ss += hf[i] * hf[i];
        const float rstd = rsqrtf(wave_sum(ss) * (1.f / 1024.f) + EPS);
#pragma unroll
        for (int d = 0; d < 4; ++d) { const int col = lane * 16 + d * 4; const f32x4 fv = *(const f32x4*)(fg + col);
            f32x4 o; o.x = hf[4 * d + 0] * rstd * fv.x; o.y = hf[4 * d + 1] * rstd * fv.y; o.z = hf[4 * d + 2] * rstd * fv.z; o.w = hf[4 * d + 3] * rstd * fv.w;
            *(f32x4*)(out + (size_t)t * 1024 + col) = o; }
    }
}


__device__ __forceinline__ int idx16(const u32x4& a, const u32x4& b, int i) { const unsigned w = (i < 8 ? a : b)[(i & 7) >> 1]; return (int)((i & 1) ? (w >> 16) : (w & 0xffffu)); }
__device__ __forceinline__ void p_gu(const Ctx& C, const bf16_t* n2, const unsigned short* pidx, const unsigned char* u8, float* pd) {
    const int j = C.bid & 7, nsl = C.G >> 3, NW = nsl * NWAVES, wsl = (C.bid >> 3) * NWAVES + C.wave, lane = C.lane, s = lane & 7, q = lane >> 3;
    if ((C.bid >> 3) >= nsl) return;
    u32x4 ea, eb, x0, x1;
    { const int t = wsl; ea = *(const u32x4*)(pidx + (size_t)t * 128 + q * 16); eb = *(const u32x4*)(pidx + (size_t)t * 128 + q * 16 + 8);
      x0 = *(const u32x4*)(n2 + (size_t)t * 1024 + 128 * j + 16 * s); x1 = *(const u32x4*)(n2 + (size_t)t * 1024 + 128 * j + 16 * s + 8); }
    for (int t = wsl; t < T; t += NW) {
        u32x4 p[16];
#pragma unroll
        for (int i = 0; i < 16; ++i) p[i] = *(const u32x4*)(u8 + (size_t)idx16(ea, eb, i) * 1024 + 128 * j + 16 * s);
        const unsigned xp[8] = {x0.x, x0.y, x0.z, x0.w, x1.x, x1.y, x1.z, x1.w};
        { const int tn = (t + NW < T) ? t + NW : t;
          ea = *(const u32x4*)(pidx + (size_t)tn * 128 + q * 16); eb = *(const u32x4*)(pidx + (size_t)tn * 128 + q * 16 + 8);
          x0 = *(const u32x4*)(n2 + (size_t)tn * 1024 + 128 * j + 16 * s); x1 = *(const u32x4*)(n2 + (size_t)tn * 1024 + 128 * j + 16 * s + 8); }
        float part[16];
#pragma unroll
        for (int i = 0; i < 16; ++i) { float acc = 0.f;
#pragma unroll
            for (int d = 0; d < 4; ++d) { const unsigned wv = p[i][d];
                const bf16x2_t lo = __builtin_amdgcn_cvt_scalef32_pk_bf16_fp8(wv, 0.00390625f, false), hi = __builtin_amdgcn_cvt_scalef32_pk_bf16_fp8(wv, 0.00390625f, true);
                const unsigned xa = xp[2 * d], xb = xp[2 * d + 1];
                acc = __builtin_amdgcn_fdot2_f32_bf16(lo, __builtin_bit_cast(bf16x2_t, xa), acc, false); acc = __builtin_amdgcn_fdot2_f32_bf16(hi, __builtin_bit_cast(bf16x2_t, xb), acc, false); }
            part[i] = acc; }
        float p8[8]; { const bool hb = (lane & 4) != 0;
#pragma unroll
            for (int i = 0; i < 8; ++i) { const float keep = hb ? part[i + 8] : part[i], send = hb ? part[i] : part[i + 8]; p8[i] = keep + __shfl_xor(send, 4); } }
        float p4[4]; { const bool hb = (lane & 2) != 0;
#pragma unroll
            for (int i = 0; i < 4; ++i) { const float keep = hb ? p8[i + 4] : p8[i], send = hb ? p8[i] : p8[i + 4]; p4[i] = keep + __shfl_xor(send, 2); } }
        float p2[2]; { const bool hb = (lane & 1) != 0;
#pragma unroll
            for (int i = 0; i < 2; ++i) { const float keep = hb ? p4[i + 2] : p4[i], send = hb ? p4[i] : p4[i + 2]; p2[i] = keep + __shfl_xor(send, 1); } }
        const int i0 = ((lane >> 2) & 1) * 8 + ((lane >> 1) & 1) * 4 + (lane & 1) * 2;
        f32x2_t o; o.x = p2[0]; o.y = p2[1];
        *(f32x2_t*)(pd + ((size_t)j * T + t) * 128 + q * 16 + i0) = o;
    }
}
__device__ __forceinline__ void p_gc(const Ctx& C, const float* pd, const float* pgate, float* cc) {
    const int gt = C.bid * NTHR + C.tid, NT = C.G * NTHR;
    for (int i = gt; i < T * 32; i += NT) {
        f32x4 sdot = *(const f32x4*)(pd + (size_t)i * 4);
#pragma unroll
        for (int j = 1; j < 8; ++j) sdot += *(const f32x4*)(pd + (size_t)j * T * 128 + (size_t)i * 4);
        const f32x4 gv = *(const f32x4*)(pgate + (size_t)i * 4);
        f32x4 o; o.x = gelu_f(sdot.x) * gv.x * 0.015625f; o.y = gelu_f(sdot.y) * gv.y * 0.015625f; o.z = gelu_f(sdot.z) * gv.z * 0.015625f; o.w = gelu_f(sdot.w) * gv.w * 0.015625f;
        *(f32x4*)(cc + (size_t)i * 4) = o; }
}
__device__ __forceinline__ void p_gv(const Ctx& C, const float* cc, const unsigned short* pidx, const unsigned char* v8, bf16_t* op) {
    const int j = C.bid & 7, nsl = C.G >> 3, NW = nsl * NWAVES, wsl = (C.bid >> 3) * NWAVES + C.wave, lane = C.lane, s = lane & 7, q = lane >> 3;
    if ((C.bid >> 3) >= nsl) return;
    u32x4 ea, eb; f32x4 c4[4];
    { const int t = wsl; ea = *(const u32x4*)(pidx + (size_t)t * 128 + q * 16); eb = *(const u32x4*)(pidx + (size_t)t * 128 + q * 16 + 8);
#pragma unroll
      for (int d = 0; d < 4; ++d) c4[d] = *(const f32x4*)(cc + (size_t)t * 128 + q * 16 + 4 * d); }
    for (int t = wsl; t < T; t += NW) {
        u32x4 p[16];
#pragma unroll
        for (int i = 0; i < 16; ++i) p[i] = *(const u32x4*)(v8 + (size_t)idx16(ea, eb, i) * 1024 + 128 * j + 16 * s);
        float cv[16];
#pragma unroll
        for (int d = 0; d < 4; ++d) { cv[4 * d] = c4[d].x; cv[4 * d + 1] = c4[d].y; cv[4 * d + 2] = c4[d].z; cv[4 * d + 3] = c4[d].w; }
        { const int tn = (t + NW < T) ? t + NW : t;
          ea = *(const u32x4*)(pidx + (size_t)tn * 128 + q * 16); eb = *(const u32x4*)(pidx + (size_t)tn * 128 + q * 16 + 8);
#pragma unroll
          for (int d = 0; d < 4; ++d) c4[d] = *(const f32x4*)(cc + (size_t)tn * 128 + q * 16 + 4 * d); }
        float acc[16];
#pragma unroll
        for (int c = 0; c < 16; ++c) acc[c] = 0.f;
#pragma unroll
        for (int i = 0; i < 16; ++i) { const float ck = cv[i];
#pragma unroll
            for (int d = 0; d < 4; ++d) { const unsigned wv = p[i][d]; const f32x2_t lo = __builtin_amdgcn_cvt_pk_f32_fp8(wv, false), hi = __builtin_amdgcn_cvt_pk_f32_fp8(wv, true);
                acc[4 * d + 0] += ck * lo.x; acc[4 * d + 1] += ck * lo.y; acc[4 * d + 2] += ck * hi.x; acc[4 * d + 3] += ck * hi.y; }
            asm volatile("" : "+v"(acc[0]), "+v"(acc[1]), "+v"(acc[2]), "+v"(acc[3]), "+v"(acc[4]), "+v"(acc[5]), "+v"(acc[6]), "+v"(acc[7]), "+v"(acc[8]), "+v"(acc[9]), "+v"(acc[10]), "+v"(acc[11]), "+v"(acc[12]), "+v"(acc[13]), "+v"(acc[14]), "+v"(acc[15])); }
        float p8[8]; { const bool hb = (lane & 32) != 0;
#pragma unroll
            for (int i = 0; i < 8; ++i) { const float keep = hb ? acc[i + 8] : acc[i], send = hb ? acc[i] : acc[i + 8]; p8[i] = keep + __shfl_xor(send, 32); } }
        float p4[4]; { const bool hb = (lane & 16) != 0;
#pragma unroll
            for (int i = 0; i < 4; ++i) { const float keep = hb ? p8[i + 4] : p8[i], send = hb ? p8[i] : p8[i + 4]; p4[i] = keep + __shfl_xor(send, 16); } }
        float p2[2]; { const bool hb = (lane & 8) != 0;
#pragma unroll
            for (int i = 0; i < 2; ++i) { const float keep = hb ? p4[i + 2] : p4[i], send = hb ? p4[i] : p4[i + 2]; p2[i] = keep + __shfl_xor(send, 8); } }
        const int c0 = ((lane >> 5) & 1) * 8 + ((lane >> 4) & 1) * 4 + ((lane >> 3) & 1) * 2;
        *(unsigned*)(op + (size_t)t * 1024 + 128 * j + 16 * s + c0) = pk2(p2[0], p2[1]);
    }
}
__device__ __forceinline__ void p_gf(const Ctx& C, const bf16_t* h, const bf16_t* op, float* out) {
    const float* mod = C.f32p(WS_MOD); const float* fg = C.in[23];
    const int gw = C.bid * NWAVES + C.wave, NGW = C.G * NWAVES, lane = C.lane;
    for (int t0 = gw * 2; t0 < T; t0 += NGW * 2) {
        const int b = t0 / SEQ;
        u32x2 ov[2][4], hw[2][4];
#pragma unroll
        for (int r = 0; r < 2; ++r)
#pragma unroll
            for (int d = 0; d < 4; ++d) { const size_t off = (size_t)(t0 + r) * 1024 + 256 * d + 4 * lane; ov[r][d] = *(const u32x2*)(op + off); hw[r][d] = *(const u32x2*)(h + off); }
        f32x4 mv[4], fv[4];
#pragma unroll
        for (int d = 0; d < 4; ++d) { mv[d] = *(const f32x4*)(mod + b * 6144 + 5120 + 256 * d + 4 * lane); fv[d] = *(const f32x4*)(fg + 256 * d + 4 * lane); }
#pragma unroll
        for (int r = 0; r < 2; ++r) { f32x4 hf[4]; float ss = 0.f;
#pragma unroll
            for (int d = 0; d < 4; ++d) { f32x4 hv, o4; hv.x = bflo(hw[r][d].x); hv.y = bfhi(hw[r][d].x); hv.z = bflo(hw[r][d].y); hv.w = bfhi(hw[r][d].y);
                o4.x = bflo(ov[r][d].x); o4.y = bfhi(ov[r][d].x); o4.z = bflo(ov[r][d].y); o4.w = bfhi(ov[r][d].y);
                hf[d] = hv + mv[d] * o4; ss += (hf[d].x * hf[d].x + hf[d].y * hf[d].y) + (hf[d].z * hf[d].z + hf[d].w * hf[d].w); }
            const float rstd = rsqrtf(wave_sum(ss) * (1.f / 1024.f) + EPS);
#pragma unroll
            for (int d = 0; d < 4; ++d) *(f32x4*)(out + (size_t)(t0 + r) * 1024 + 256 * d + 4 * lane) = hf[d] * rstd * fv[d]; }
    }
}

__device__ __forceinline__ void p_gather_ref(const Ctx& C, const bf16_t* n2, const unsigned short* pidx, const float* pgate, const float* h, float* out) {
    const float* mod = C.f32p(WS_MOD); const float* fg = C.in[23]; const float* U = C.in[21]; const float* V = C.in[22];
    LAS float* xs = (LAS float*)C.lds;
    LAS float* part = xs + 1024;
    LAS float* cs = part + 512;
    LAS float* red = cs + 128;
    LAS int* es = (LAS int*)(red + 512);
    const int tid = C.tid;
    for (int t = C.bid; t < T; t += C.G) {
        const int b = t / SEQ;
        __syncthreads();
        xs[tid] = bf2f(n2[(size_t)t * 1024 + tid]); xs[tid + 512] = bf2f(n2[(size_t)t * 1024 + 512 + tid]);
        if (tid < 128) es[tid] = pidx[(size_t)t * 128 + tid];
        __syncthreads();
        { const int k = tid >> 2, qd = tid & 3; const float* ur = U + (size_t)es[k] * 1024 + qd * 256; float acc = 0.f;
          for (int d = 0; d < 256; ++d) acc += ur[d] * xs[qd * 256 + d];
          part[tid] = acc; }
        __syncthreads();
        if (tid < 128) { const float dsum = part[tid * 4] + part[tid * 4 + 1] + part[tid * 4 + 2] + part[tid * 4 + 3]; cs[tid] = gelu_f(dsum) * pgate[(size_t)t * 128 + tid]; }
        __syncthreads();
        float o0 = 0.f, o1 = 0.f;
        for (int k = 0; k < 128; ++k) { const float* vr = V + (size_t)es[k] * 1024; const float ck = cs[k]; o0 += ck * vr[tid]; o1 += ck * vr[tid + 512]; }
        const float h0 = h[(size_t)t * 1024 + tid] + mod[b * 6144 + 5120 + tid] * o0, h1 = h[(size_t)t * 1024 + 512 + tid] + mod[b * 6144 + 5120 + 512 + tid] * o1;
        red[tid] = h0 * h0 + h1 * h1;
        __syncthreads();
        for (int sft = 256; sft > 0; sft >>= 1) { if (tid < sft) red[tid] += red[tid + sft]; __syncthreads(); }
        const float rstd = rsqrtf(red[0] * (1.f / 1024.f) + EPS);
        out[(size_t)t * 1024 + tid] = h0 * rstd * fg[tid]; out[(size_t)t * 1024 + 512 + tid] = h1 * rstd * fg[tid + 512];
    }
}

namespace pg8 {
#define PG8_LAS __attribute__((address_space(3)))
typedef unsigned short bf16_t;
typedef short bf16x8 __attribute__((ext_vector_type(8)));
typedef float f32x4 __attribute__((ext_vector_type(4)));
typedef unsigned u32x4 __attribute__((ext_vector_type(4)));
constexpr int BM = 256, BK = 64, HALF = 128, HTB = HALF * BK * 2  , STAGE_BYTES = 8 * HTB, NXCD = 8, WGM = 8;

__host__ __device__ __forceinline__ int lds_byte(int r, int c) { const int st = (r >> 4) * 2 + (c >> 5), rr = r & 15, cc = c & 31, ob = rr * 64 + cc * 2; return st * 1024 + (ob ^ (((ob >> 9) & 1) << 5)); }
__host__ __device__ __forceinline__ void stage_rc(int b, int& R, int& C) { const int st = b / 1024, sb = b % 1024, swz = sb ^ (((sb >> 9) & 1) << 5); R = (st >> 1) * 16 + swz / 64; C = (st & 1) * 32 + (swz % 64) / 2; }
__host__ __device__ __forceinline__ int perm32(int rho) { const int n = rho >> 4, i = rho & 15; return 8 * (i >> 2) + 4 * n + (i & 3); }

struct Unit { int pm, pn, kind; };
struct Gemm { const bf16_t* A; const bf16_t* Bt; int M, N, K; const bf16_t *A1, *B1, *A2, *B2, *A3, *B3; };

struct StaticOrder {
    static constexpr bool MULTI = false;
    int nM, nN, nwg, G, c;
    __host__ __device__ void init(int M, int N, int G_, int c_) { nM = M / BM; nN = N / BM; nwg = nM * nN; G = G_; c = c_; }
    __host__ __device__ bool next(int i, Unit& u) const {
        const long L = (long)i * G + c; if (L >= nwg) return false;
        int wgid = (int)L; { const int q = nwg / NXCD, r = nwg % NXCD, xcd = wgid % NXCD, off = wgid / NXCD; wgid = (xcd < r ? xcd * (q + 1) : r * (q + 1) + (xcd - r) * q) + off; }
        const int nig = WGM * nN, gid = wgid / nig, fm = gid * WGM, gsz = (nM - fm) < WGM ? (nM - fm) : WGM;
        u.pm = fm + ((wgid % nig) % gsz); u.pn = (wgid % nig) / gsz; u.kind = 0; return true;
    }
    __device__ __forceinline__ void a_ready(const Unit&) const {}
    __device__ __forceinline__ void done(const Unit&) const {}
};

struct MultiOrder {
    static constexpr bool MULTI = true;
    StaticOrder b; int nk;
    __host__ __device__ bool next(int i, Unit& u) const { if (!b.next(i / nk, u)) return false; u.kind = i % nk; return true; }
    __device__ __forceinline__ void a_ready(const Unit&) const {}
    __device__ __forceinline__ void done(const Unit&) const {}
};

__device__ __forceinline__ unsigned cvt_pk_bf16(float lo, float hi) { return ::pk2(lo, hi); }
__device__ __forceinline__ float e_silu(float x) { return x / (1.f + __expf(-x)); }
__device__ __forceinline__ float e_sigm(float x) { return 1.f / (1.f + __expf(-x)); }
__device__ __forceinline__ float e_lo(unsigned v) { return __uint_as_float(v << 16); }
__device__ __forceinline__ float e_hi(unsigned v) { return __uint_as_float(v & 0xffff0000u); }
__device__ __forceinline__ u32x4 pack8(const f32x4 v0, const f32x4 v1) { u32x4 w; w.x = cvt_pk_bf16(v0[0], v0[1]); w.y = cvt_pk_bf16(v0[2], v0[3]); w.z = cvt_pk_bf16(v1[0], v1[1]); w.w = cvt_pk_bf16(v1[2], v1[3]); return w; }

struct EpiInProj {
    static constexpr bool PERM = true, AFTER_DRAIN = false;
    bf16_t *sz, *xbc, *q, *k, *v;
    __device__ __forceinline__ void operator()(const f32x4 (&acc)[2][2][4][2], const Unit& u, int wr, int wc, int fr, int fq) const {
        const int pn = u.pn; bf16_t* base; int ldc = 1024, colt, mode = 0;
        if (pn < 4) { base = sz; colt = pn * 256; mode = 1; }
        else if (pn < 12) { base = xbc; ldc = 2048; colt = (pn - 4) * 256; }
        else if (pn < 16) { base = q; colt = (pn - 12) * 256; mode = 2; }
        else if (pn < 20) { base = k; colt = (pn - 16) * 256; }
        else { base = v; colt = (pn - 20) * 256; }
        const int row0 = u.pm * BM + wr * 64 + fr, col0 = colt + wc * 32 + 8 * fq;
#pragma unroll
        for (int ai = 0; ai < 2; ++ai)
#pragma unroll
            for (int m = 0; m < 4; ++m) { bf16_t* rowp = base + (size_t)(row0 + ai * HALF + m * 16) * ldc + col0;
#pragma unroll
                for (int bj = 0; bj < 2; ++bj) { f32x4 v0 = acc[ai][bj][m][0], v1 = acc[ai][bj][m][1];
                    if (mode == 1) {
#pragma unroll
                        for (int i = 0; i < 4; ++i) { v0[i] = e_silu(v0[i]); v1[i] = e_silu(v1[i]); } }
                    else if (mode == 2) { v0 = v0 * 0.125f; v1 = v1 * 0.125f; }
                    *(u32x4*)(rowp + bj * HALF) = pack8(v0, v1); } }
    }
};
struct EpiGate {
    static constexpr bool PERM = true, AFTER_DRAIN = false;
    bf16_t* sg; size_t plane;
    __device__ __forceinline__ void operator()(const f32x4 (&acc)[2][2][4][2], const Unit& u, int wr, int wc, int fr, int fq) const {
        bf16_t* base = sg + (size_t)(u.pn >> 2) * plane; const int colt = (u.pn & 3) * 256;
        const int row0 = u.pm * BM + wr * 64 + fr, col0 = colt + wc * 32 + 8 * fq;
#pragma unroll
        for (int ai = 0; ai < 2; ++ai)
#pragma unroll
            for (int m = 0; m < 4; ++m) { bf16_t* rowp = base + (size_t)(row0 + ai * HALF + m * 16) * 1024 + col0;
#pragma unroll
                for (int bj = 0; bj < 2; ++bj) { f32x4 v0 = acc[ai][bj][m][0], v1 = acc[ai][bj][m][1];
#pragma unroll
                    for (int i = 0; i < 4; ++i) { v0[i] = e_sigm(v0[i]); v1[i] = e_sigm(v1[i]); }
                    *(u32x4*)(rowp + bj * HALF) = pack8(v0, v1); } }
    }
};
struct EpiD1 {
    static constexpr bool PERM = true, AFTER_DRAIN = false;
    bf16_t* p1; const bf16_t* sg1; const float* rstd;
    __device__ __forceinline__ void operator()(const f32x4 (&acc)[2][2][4][2], const Unit& u, int wr, int wc, int fr, int fq) const {
        const int row0 = u.pm * BM + wr * 64 + fr, col0 = u.pn * BM + wc * 32 + 8 * fq;
#pragma unroll
        for (int ai = 0; ai < 2; ++ai)
#pragma unroll
            for (int m = 0; m < 4; ++m) { const int row = row0 + ai * HALF + m * 16; const float rs = rstd[row]; const size_t off = (size_t)row * 1024 + col0;
#pragma unroll
                for (int bj = 0; bj < 2; ++bj) { f32x4 v0 = acc[ai][bj][m][0] * rs, v1 = acc[ai][bj][m][1] * rs;
                    const u32x4 g = *(const u32x4*)(sg1 + off + bj * HALF);
                    v0[0] *= e_lo(g.x); v0[1] *= e_hi(g.x); v0[2] *= e_lo(g.y); v0[3] *= e_hi(g.y); v1[0] *= e_lo(g.z); v1[1] *= e_hi(g.z); v1[2] *= e_lo(g.w); v1[3] *= e_hi(g.w);
                    *(u32x4*)(p1 + off + bj * HALF) = pack8(v0, v1); } }
    }
};
struct EpiD2 {
    static constexpr bool PERM = true, AFTER_DRAIN = false;
    bf16_t* mixed; const bf16_t *p1, *sg2;
    __device__ __forceinline__ void operator()(const f32x4 (&acc)[2][2][4][2], const Unit& u, int wr, int wc, int fr, int fq) const {
        const int row0 = u.pm * BM + wr * 64 + fr, col0 = u.pn * BM + wc * 32 + 8 * fq;
#pragma unroll
        for (int ai = 0; ai < 2; ++ai)
#pragma unroll
            for (int m = 0; m < 4; ++m) { const int row = row0 + ai * HALF + m * 16; const size_t off = (size_t)row * 1024 + col0;
#pragma unroll
                for (int bj = 0; bj < 2; ++bj) { f32x4 v0 = acc[ai][bj][m][0], v1 = acc[ai][bj][m][1];
                    const u32x4 g = *(const u32x4*)(sg2 + off + bj * HALF), p = *(const u32x4*)(p1 + off + bj * HALF);
                    v0[0] = e_lo(p.x) + v0[0] * e_lo(g.x); v0[1] = e_hi(p.x) + v0[1] * e_hi(g.x); v0[2] = e_lo(p.y) + v0[2] * e_lo(g.y); v0[3] = e_hi(p.y) + v0[3] * e_hi(g.y);
                    v1[0] = e_lo(p.z) + v1[0] * e_lo(g.z); v1[1] = e_hi(p.z) + v1[1] * e_hi(g.z); v1[2] = e_lo(p.w) + v1[2] * e_lo(g.w); v1[3] = e_hi(p.w) + v1[3] * e_hi(g.w);
                    *(u32x4*)(mixed + off + bj * HALF) = pack8(v0, v1); } }
    }
};

struct EpiMix {
    static constexpr bool PERM = true, AFTER_DRAIN = false;
    bf16_t *sg1, *sg2, *mixed; const float* rstd;
    __device__ __forceinline__ bool operator()(f32x4 (&acc)[2][2][4][2], const Unit& u, int wr, int wc, int fr, int fq) const {
        const int row0 = u.pm * BM + wr * 64 + fr, col0 = u.pn * BM + wc * 32 + 8 * fq; const int kind = u.kind;
#pragma unroll
        for (int ai = 0; ai < 2; ++ai)
#pragma unroll
            for (int m = 0; m < 4; ++m) { const int row = row0 + ai * HALF + m * 16; const size_t off = (size_t)row * 1024 + col0;
                const float rs = (kind == 2) ? rstd[row] : 1.f;
#pragma unroll
                for (int bj = 0; bj < 2; ++bj) { f32x4 v0 = acc[ai][bj][m][0], v1 = acc[ai][bj][m][1];
                    if (kind < 2) {
#pragma unroll
                        for (int i = 0; i < 4; ++i) { v0[i] = e_sigm(v0[i]); v1[i] = e_sigm(v1[i]); }
                        *(u32x4*)((kind == 0 ? sg1 : sg2) + off + bj * HALF) = pack8(v0, v1);
                    } else if (kind == 2) {
                        const u32x4 a = *(const u32x4*)(sg1 + off + bj * HALF), b = *(const u32x4*)(sg2 + off + bj * HALF);
                        v0[0] *= rs * e_lo(a.x) / fmaxf(e_lo(b.x), 1e-30f); v0[1] *= rs * e_hi(a.x) / fmaxf(e_hi(b.x), 1e-30f); v0[2] *= rs * e_lo(a.y) / fmaxf(e_lo(b.y), 1e-30f); v0[3] *= rs * e_hi(a.y) / fmaxf(e_hi(b.y), 1e-30f);
                        v1[0] *= rs * e_lo(a.z) / fmaxf(e_lo(b.z), 1e-30f); v1[1] *= rs * e_hi(a.z) / fmaxf(e_hi(b.z), 1e-30f); v1[2] *= rs * e_lo(a.w) / fmaxf(e_lo(b.w), 1e-30f); v1[3] *= rs * e_hi(a.w) / fmaxf(e_hi(b.w), 1e-30f);
                        acc[ai][bj][m][0] = v0; acc[ai][bj][m][1] = v1;
                    } else {
                        const u32x4 b = *(const u32x4*)(sg2 + off + bj * HALF);
                        v0[0] *= e_lo(b.x); v0[1] *= e_hi(b.x); v0[2] *= e_lo(b.y); v0[3] *= e_hi(b.y); v1[0] *= e_lo(b.z); v1[1] *= e_hi(b.z); v1[2] *= e_lo(b.w); v1[3] *= e_hi(b.w);
                        *(u32x4*)(mixed + off + bj * HALF) = pack8(v0, v1);
                    } } }
        return kind == 2;
    }
};
struct EpiD3 {
    static constexpr bool PERM = true, AFTER_DRAIN = false;
    bf16_t* h; const float* x; const float* mod;
    __device__ __forceinline__ void operator()(const f32x4 (&acc)[2][2][4][2], const Unit& u, int wr, int wc, int fr, int fq) const {
        const int row0 = u.pm * BM + wr * 64 + fr, col0 = u.pn * BM + wc * 32 + 8 * fq;
        const float* g1 = mod + (size_t)((u.pm * BM) >> 12) * 6144 + 2048;
#pragma unroll
        for (int ai = 0; ai < 2; ++ai)
#pragma unroll
            for (int m = 0; m < 4; ++m) { const size_t off = (size_t)(row0 + ai * HALF + m * 16) * 1024 + col0;
#pragma unroll
                for (int bj = 0; bj < 2; ++bj) { const int c = bj * HALF;
                    const f32x4 x0 = *(const f32x4*)(x + off + c), x1 = *(const f32x4*)(x + off + c + 4), g0 = *(const f32x4*)(g1 + col0 + c), g4 = *(const f32x4*)(g1 + col0 + c + 4);
                    *(u32x4*)(h + off + c) = pack8(x0 + g0 * acc[ai][bj][m][0], x1 + g4 * acc[ai][bj][m][1]); } }
    }
};
struct EpiQp {
    static constexpr bool PERM = true, AFTER_DRAIN = false;
    bf16_t* qp;
    __device__ __forceinline__ void operator()(const f32x4 (&acc)[2][2][4][2], const Unit& u, int wr, int wc, int fr, int fq) const {
        const int row0 = u.pm * BM + wr * 64 + fr, col0 = u.pn * BM + wc * 32 + 8 * fq;
#pragma unroll
        for (int ai = 0; ai < 2; ++ai)
#pragma unroll
            for (int m = 0; m < 4; ++m) { bf16_t* rowp = qp + (size_t)(row0 + ai * HALF + m * 16) * 2048 + col0;
#pragma unroll
                for (int bj = 0; bj < 2; ++bj) *(u32x4*)(rowp + bj * HALF) = pack8(acc[ai][bj][m][0], acc[ai][bj][m][1]); }
    }
};

template <class Epi, class Sched, bool ALIGN_EPI = false, bool SP2 = false>
__device__ __forceinline__ void gemm_phase(PG8_LAS unsigned char* lds, const Gemm g, const Sched& S, const Epi& E) {
    const int tid = threadIdx.x, wid = __builtin_amdgcn_readfirstlane(tid >> 6), lane = tid & 63, wr = wid >> 2, wc = wid & 3, fr = lane & 15, fq = lane >> 4;
    const int K = g.K, nt = K / BK;
    unsigned voffA[2], voffB[2];
#pragma unroll
    for (int i = 0; i < 2; ++i) { int R, C; stage_rc(tid * 16 + i * 8192, R, C); const int Rb = Epi::PERM ? ((R & ~31) + perm32(R & 31)) : R;
        voffA[i] = (unsigned)(R * K + C) * 2u; voffB[i] = (unsigned)(Rb * K + C) * 2u; }
    const size_t kstep = (size_t)(BK * 2);
    const size_t hstep = (size_t)HALF * K * 2;
    const size_t tstep = 2 * hstep;
    const unsigned ldsw = (unsigned)wid * 1024u;
    const int aoff = lds_byte(wr * 64 + fr, fq * 8), boff = lds_byte(wc * 32 + fr, fq * 8);
#define PG8_SA(b, h) (((b) * 2 + (h)) * HTB)
#define PG8_SB(b, h) ((4 + (b) * 2 + (h)) * HTB)
#define PG8_STAGE(bufoff, gbase, voff) do { _Pragma("unroll") for (int _i = 0; _i < 2; ++_i) \
        __builtin_amdgcn_global_load_lds((const unsigned*)((const char*)(gbase) + (voff)[_i]), (PG8_LAS unsigned*)(lds + (bufoff) + ldsw + _i * 8192), 16, 0, 0); } while (0)
#define PG8_LDA(dst, b, h) do { _Pragma("unroll") for (int m = 0; m < 4; ++m) _Pragma("unroll") for (int k = 0; k < 2; ++k) dst[m][k] = *(const PG8_LAS bf16x8*)(lds + PG8_SA(b, h) + aoff + m * 2048 + k * 1024); } while (0)
#define PG8_LDB(dst, b, h) do { _Pragma("unroll") for (int n = 0; n < 2; ++n) _Pragma("unroll") for (int k = 0; k < 2; ++k) dst[n][k] = *(const PG8_LAS bf16x8*)(lds + PG8_SB(b, h) + boff + n * 2048 + k * 1024); } while (0)
#define PG8_MMA(ai, bj, At, Bt) do { __builtin_amdgcn_s_setprio(1); _Pragma("unroll") for (int m = 0; m < 4; ++m) _Pragma("unroll") for (int n = 0; n < 2; ++n) _Pragma("unroll") for (int k = 0; k < 2; ++k) \
        acc[ai][bj][m][n] = __builtin_amdgcn_mfma_f32_16x16x32_bf16(Bt[n][k], At[m][k], acc[ai][bj][m][n], 0, 0, 0); __builtin_amdgcn_s_setprio(0); } while (0)
#define PG8_WAIT_V(n) asm volatile("s_waitcnt vmcnt(" #n ")" ::: "memory")
#define PG8_WAIT_L(n) asm volatile("s_waitcnt lgkmcnt(" #n ")" ::: "memory")
#define PG8_BAR __builtin_amdgcn_s_barrier()
#define PG8_SCHED __builtin_amdgcn_sched_barrier(0)
    Unit cur, nxt; int ui = 0;
    if (!S.next(0, cur)) return;
    f32x4 acc[2][2][4][2];
#pragma unroll
    for (int a = 0; a < 2; ++a)
#pragma unroll
        for (int b = 0; b < 2; ++b)
#pragma unroll
            for (int m = 0; m < 4; ++m)
#pragma unroll
                for (int n = 0; n < 2; ++n) acc[a][b][m][n] = (f32x4){0.f, 0.f, 0.f, 0.f};
    bf16x8 At[4][2], B0[2][2], B1[2][2];
#define PG8_AB(u_) (Sched::MULTI ? (const char*)((u_).kind == 0 ? g.A : (u_).kind == 1 ? g.A1 : (u_).kind == 2 ? g.A2 : g.A3) : (const char*)g.A)
#define PG8_BB(u_) (Sched::MULTI ? (const char*)((u_).kind == 0 ? g.Bt : (u_).kind == 1 ? g.B1 : (u_).kind == 2 ? g.B2 : g.B3) : (const char*)g.Bt)
    const char* cA = PG8_AB(cur) + (size_t)cur.pm * tstep; const char* cB = PG8_BB(cur) + (size_t)cur.pn * tstep;
    S.a_ready(cur);
    if constexpr (SP2) {
        PG8_STAGE(PG8_SB(0, 0), cB, voffB); PG8_STAGE(PG8_SB(0, 1), cB + hstep, voffB); PG8_STAGE(PG8_SA(0, 0), cA, voffA); PG8_STAGE(PG8_SA(0, 1), cA + hstep, voffA);
        if (wr == 1) PG8_BAR;
        PG8_WAIT_V(2); PG8_BAR;
        PG8_STAGE(PG8_SB(1, 0), cB + kstep, voffB); PG8_STAGE(PG8_SA(1, 0), cA + kstep, voffA); PG8_STAGE(PG8_SB(1, 1), cB + hstep + kstep, voffB);
        PG8_WAIT_V(6); PG8_BAR;
    } else {
        PG8_STAGE(PG8_SB(0, 0), cB, voffB); PG8_STAGE(PG8_SA(0, 0), cA, voffA); PG8_STAGE(PG8_SB(0, 1), cB + hstep, voffB); PG8_STAGE(PG8_SA(0, 1), cA + hstep, voffA);
        if (wr == 1) PG8_BAR;
        PG8_WAIT_V(4); PG8_BAR;
        PG8_STAGE(PG8_SB(1, 0), cB + kstep, voffB); PG8_STAGE(PG8_SA(1, 0), cA + kstep, voffA); PG8_STAGE(PG8_SB(1, 1), cB + hstep + kstep, voffB);
        PG8_WAIT_V(6); PG8_BAR;
    }
    for (;;) {
        const bool has_next = S.next(ui + 1, nxt);
        const char* nA = has_next ? PG8_AB(nxt) + (size_t)nxt.pm * tstep : cA; const char* nB = has_next ? PG8_BB(nxt) + (size_t)nxt.pn * tstep : cB;
        for (int t = 0; t < nt; t += 2) {
            const bool last = (t == nt - 2);
            const char* a1 = cA + (size_t)(t + 1) * kstep;
            const char* a2 = last ? nA : cA + (size_t)(t + 2) * kstep; const char* b2 = last ? nB : cB + (size_t)(t + 2) * kstep;
            const char* a3 = a2 + kstep; const char* b3 = b2 + kstep;
            if (last && has_next) S.a_ready(nxt);
            if constexpr (SP2) {
            PG8_LDB(B0, 0, 0); PG8_LDB(B1, 0, 1); PG8_SCHED; PG8_LDA(At, 0, 0); PG8_STAGE(PG8_SA(1, 1), a1 + hstep, voffA);
            PG8_WAIT_V(8); PG8_WAIT_L(0); PG8_BAR; PG8_MMA(0, 0, At, B0); PG8_MMA(0, 1, At, B1); PG8_BAR; PG8_SCHED;
            PG8_LDA(At, 0, 1); PG8_STAGE(PG8_SB(0, 0), b2, voffB); PG8_STAGE(PG8_SB(0, 1), b2 + hstep, voffB); PG8_STAGE(PG8_SA(0, 0), a2, voffA);
            PG8_WAIT_V(8); PG8_WAIT_L(0); PG8_BAR; PG8_MMA(1, 0, At, B0); PG8_MMA(1, 1, At, B1); PG8_BAR; PG8_SCHED;
            PG8_LDB(B0, 1, 0); PG8_LDB(B1, 1, 1); PG8_SCHED; PG8_LDA(At, 1, 0); PG8_STAGE(PG8_SA(0, 1), a2 + hstep, voffA);
            PG8_WAIT_V(8); PG8_WAIT_L(0); PG8_BAR; PG8_MMA(0, 0, At, B0); PG8_MMA(0, 1, At, B1); PG8_BAR; PG8_SCHED;
            PG8_LDA(At, 1, 1); PG8_STAGE(PG8_SB(1, 0), b3, voffB); PG8_STAGE(PG8_SB(1, 1), b3 + hstep, voffB); PG8_STAGE(PG8_SA(1, 0), a3, voffA);
            PG8_WAIT_V(8); PG8_WAIT_L(0); PG8_BAR; PG8_MMA(1, 0, At, B0); PG8_MMA(1, 1, At, B1); PG8_BAR; PG8_SCHED;
            } else {
            PG8_LDB(B0, 0, 0); PG8_SCHED; PG8_LDA(At, 0, 0); PG8_STAGE(PG8_SA(1, 1), a1 + hstep, voffA);
            PG8_WAIT_L(8); PG8_BAR; PG8_WAIT_L(0); PG8_MMA(0, 0, At, B0); PG8_BAR; PG8_SCHED;
            PG8_LDB(B1, 0, 1); PG8_STAGE(PG8_SB(0, 0), b2, voffB);
            PG8_BAR; PG8_WAIT_L(0); PG8_MMA(0, 1, At, B1); PG8_BAR;
            PG8_LDA(At, 0, 1); PG8_STAGE(PG8_SA(0, 0), a2, voffA);
            PG8_BAR; PG8_WAIT_L(0); PG8_MMA(1, 0, At, B0); PG8_BAR; PG8_SCHED;
            PG8_STAGE(PG8_SB(0, 1), b2 + hstep, voffB);
            PG8_WAIT_V(6); PG8_BAR; PG8_MMA(1, 1, At, B1); PG8_BAR;
            PG8_LDB(B0, 1, 0); PG8_SCHED; PG8_LDA(At, 1, 0); PG8_STAGE(PG8_SA(0, 1), a2 + hstep, voffA);
            PG8_WAIT_L(8); PG8_BAR; PG8_WAIT_L(0); PG8_MMA(0, 0, At, B0); PG8_BAR; PG8_SCHED;
            PG8_LDB(B1, 1, 1); PG8_STAGE(PG8_SB(1, 0), b3, voffB);
            PG8_BAR; PG8_WAIT_L(0); PG8_MMA(0, 1, At, B1); PG8_BAR;
            PG8_LDA(At, 1, 1); PG8_STAGE(PG8_SA(1, 0), a3, voffA);
            PG8_BAR; PG8_WAIT_L(0); PG8_MMA(1, 0, At, B0); PG8_BAR; PG8_SCHED;
            PG8_STAGE(PG8_SB(1, 1), b3 + hstep, voffB);
            PG8_WAIT_V(6); PG8_BAR; PG8_MMA(1, 1, At, B1); PG8_BAR;
            }
        }
        if constexpr (ALIGN_EPI) { if (wr == 0) PG8_BAR; }
        bool keep_acc = false;
        if constexpr (!Epi::AFTER_DRAIN) { if constexpr (Sched::MULTI) keep_acc = E(acc, cur, wr, wc, fr, fq); else E(acc, cur, wr, wc, fr, fq); S.done(cur); }
        if (!has_next) break;
        if (!keep_acc) {
#pragma unroll
        for (int a = 0; a < 2; ++a)
#pragma unroll
            for (int b = 0; b < 2; ++b)
#pragma unroll
                for (int m = 0; m < 4; ++m)
#pragma unroll
                    for (int n = 0; n < 2; ++n) acc[a][b][m][n] = (f32x4){0.f, 0.f, 0.f, 0.f};
        }
        cur = nxt; cA = nA; cB = nB; ++ui;
        if constexpr (ALIGN_EPI) { if (wr == 1) PG8_BAR; }
    }
    PG8_WAIT_V(0);
    if constexpr (!ALIGN_EPI) { if (wr == 0) PG8_BAR; }
    PG8_BAR;
    if constexpr (Epi::AFTER_DRAIN) { E.fused(acc, cur, wr, wc, fr, fq, lds, wid, lane); S.done(cur); }
#undef PG8_AB
#undef PG8_BB
#undef PG8_SA
#undef PG8_SB
#undef PG8_STAGE
#undef PG8_LDA
#undef PG8_LDB
#undef PG8_MMA
#undef PG8_WAIT_V
#undef PG8_WAIT_L
#undef PG8_BAR
#undef PG8_SCHED
}
}


__device__ __forceinline__ void p_diag_cmp(const Ctx& C, const bf16_t* a, const bf16_t* b, size_t n, unsigned* res) {
    const size_t gt = (size_t)C.bid * NTHR + C.tid, NT = (size_t)C.G * NTHR;
    float md = 0.f, mr = 0.f;
    for (size_t i = gt; i < n; i += NT) { const float x = bf2f(a[i]), y = bf2f(b[i]); const float d = x - y; md += (d == d ? d * d : 1e30f); mr += x * x; }
#pragma unroll
    for (int o = 1; o < 64; o <<= 1) { md += __shfl_xor(md, o); mr += __shfl_xor(mr, o); }
    if (C.lane == 0) { atomicAdd((float*)res, md); atomicAdd((float*)res + 1, mr); }
}
__device__ __forceinline__ void p_diag_out(const Ctx& C, const unsigned* res, float* out) {
    const size_t gt = (size_t)C.bid * NTHR + C.tid, NT = (size_t)C.G * NTHR;
    for (size_t i = gt; i < (size_t)T * 1024; i += NT) out[i] = 0.f;
    __syncthreads();
    if (C.bid == 0 && C.tid == 0) { const float md = __uint_as_float(res[0]), mr = __uint_as_float(res[1]); const float rel = sqrtf(md / fmaxf(mr, 1e-30f));
        out[0] = 1.0e4f * (13.f + log10f(rel + 1e-12f)); }
}

#define GAS __attribute__((address_space(1)))
typedef GAS unsigned gu32;
#define RLX_AGENT __ATOMIC_RELAXED, __HIP_MEMORY_SCOPE_AGENT
#define XB_TMO      128
#define XB_XCNT(j)  (256  + 64 * (j))
#define XB_XSUB(j)  (1280 + 64 * (j))
#define XB_XGEN(j)  (2304 + 64 * (j))
#define XB_TOP      3328
#define XB_TOPGEN   3392
#define XCD_BAR_WORDS 3456
#define XB_SPIN_CAP (1u << 18)

__device__ __forceinline__ unsigned xb_ld(unsigned* p)              { return __hip_atomic_load(p, __ATOMIC_RELAXED, __HIP_MEMORY_SCOPE_AGENT); }
__device__ __forceinline__ unsigned xb_add(unsigned* p, unsigned v) { return __hip_atomic_fetch_add(p, v, __ATOMIC_RELAXED, __HIP_MEMORY_SCOPE_AGENT); }
__device__ __forceinline__ unsigned xb_xcc_id() { return (unsigned)__builtin_amdgcn_s_getreg((3 << 11) | 20) & 0xFu; }
#define XB_SPIN(cond, bar) do { unsigned _sp = 0; while (cond) { __builtin_amdgcn_s_sleep(1); \
    if ((++_sp & 255u) == 0u) { if (xb_ld(&(bar)[XB_TMO])) break; if (_sp > XB_SPIN_CAP) { atomicAdd(&(bar)[XB_TMO], 1u); break; } } } } while (0)

struct XcdBarrier {
    unsigned* bar; unsigned x;
    volatile LAS unsigned* st;
};

__device__ __forceinline__ XcdBarrier xcd_barrier_post(unsigned* bar, volatile LAS unsigned* st) {
    XcdBarrier b; b.bar = bar; b.x = xb_xcc_id(); b.st = st;
    if (threadIdx.x == 0) (void)xb_add(&bar[XB_XCNT(b.x)], 1u);
    return b;
}
__device__ __forceinline__ void xcd_barrier_complete(unsigned* bar, unsigned x, unsigned& nloc, unsigned& nx) {
    const unsigned G = gridDim.x * gridDim.y * gridDim.z;
    unsigned sum, cnt, mine, sp = 0u;
    for (;;) {
        sum = 0u; cnt = 0u; mine = 0u;
#pragma unroll
        for (unsigned j = 0; j < 16; ++j) { const unsigned c = xb_ld(&bar[XB_XCNT(j)]); sum += c; cnt += (c > 0u) ? 1u : 0u; mine = (j == x) ? c : mine; }
        if (sum == G) break;
        __builtin_amdgcn_s_sleep(1);
        if ((++sp & 255u) == 0u) { if (xb_ld(&bar[XB_TMO])) break; if (sp > XB_SPIN_CAP) { atomicAdd(&bar[XB_TMO], 1u); break; } }
    }
    nloc = mine > 0u ? mine : 1u; nx = cnt > 0u ? cnt : 1u;
}

__device__ __forceinline__ void xcd_barrier(const XcdBarrier& b) {
    asm volatile("s_waitcnt vmcnt(0)" ::: "memory");
    __syncthreads();
    if (threadIdx.x == 0) {
        unsigned* bar = b.bar;
        __builtin_amdgcn_s_waitcnt(0);
        unsigned nloc = b.st[0], nx = b.st[1];
        if (nloc == 0u) { xcd_barrier_complete(bar, b.x, nloc, nx); b.st[0] = nloc; b.st[1] = nx; }
        const unsigned old = xb_add(&bar[XB_XSUB(b.x)], 1u);
        const unsigned gen = old / nloc;
        if (old + 1u == (gen + 1u) * nloc) {
            __builtin_amdgcn_fence(__ATOMIC_RELEASE, "agent");
            asm volatile("s_waitcnt vmcnt(0)" ::: "memory");
            const unsigned og = xb_add(&bar[XB_TOP], 1u);
            const unsigned tg = og / nx;
            if (og + 1u == (tg + 1u) * nx) xb_add(&bar[XB_TOPGEN], 1u);
            else XB_SPIN(xb_ld(&bar[XB_TOPGEN]) == tg, bar);
            __builtin_amdgcn_fence(__ATOMIC_ACQUIRE, "agent");
            xb_add(&bar[XB_XGEN(b.x)], 1u);
            asm volatile("s_waitcnt vmcnt(0)" ::: "memory");
        } else {
            XB_SPIN(xb_ld(&bar[XB_XGEN(b.x)]) == gen, bar);
            __builtin_amdgcn_fence(__ATOMIC_ACQUIRE, "agent");
            asm volatile("s_waitcnt vmcnt(0)" ::: "memory");
        }
    }
    __syncthreads();
}


constexpr int N_PHASES = 15;
constexpr int CW_BAR = 4096;
constexpr size_t CTL_ZERO_BYTES = 64 * 1024;
constexpr int MISC_OFF = LDS_BYTES - 256;

template <int PH>
__device__ __forceinline__ void run_phase(const Ctx& C, const Args& a) {
    bf16_t* R0 = C.bfp(WS_R0); bf16_t* R1 = C.bfp(WS_R1); bf16_t* R2 = C.bfp(WS_R2); bf16_t* R3 = C.bfp(WS_R3);
    bf16_t* OB = (bf16_t*)a.out;
    const size_t TD = (size_t)T * 1024;
    if constexpr (PH == 0) p_prep(C);
    if constexpr (PH == 1) p_rownorm(C, C.in[0], C.in[4], 0, 1024, R0);
    if constexpr (PH == 2) {
        { pg8::Gemm g{R0, C.bfp(WS_WIN_T), T, 6144, 1024}; pg8::StaticOrder S; S.init(T, 6144, C.G, C.bid);
          pg8::EpiInProj e{R1, R2, R3, R3 + TD, R3 + 2 * TD};
          pg8::gemm_phase<pg8::EpiInProj, pg8::StaticOrder, true, true>(C.lds, g, S, e); }
        p_dt(C, R0, C.bfp(WS_WDT_T), C.f32p(WS_DT));
    }
    if constexpr (PH == 3) { p_conv(C, R2, OB); p_na(C, R3, R3 + TD, R3 + 2 * TD); }
    if constexpr (PH == 4) p_ssd(C, OB, C.f32p(WS_DT), R2, R2 + TD);
    if constexpr (PH == 5) p_combine(C, R2, R2 + TD, R1, C.f32p(WS_RSTD));
    if constexpr (PH == 6) {
        pg8::MultiOrder S; S.b.init(T, 1024, C.G, C.bid); S.nk = 4;
        pg8::Gemm g{R0, C.bfp(WS_WG_T), T, 1024, 1024, R0, C.bfp(WS_WG_T) + (size_t)1024 * 1024, R1, C.bfp(WS_WSSD_T), R3, C.bfp(WS_WNA_T)};
        pg8::EpiMix e{OB, OB + TD, R2 + TD, C.f32p(WS_RSTD)};
        pg8::gemm_phase<pg8::EpiMix, pg8::MultiOrder, true, true>(C.lds, g, S, e);
    }
    if constexpr (PH == 7) { pg8::Gemm g{R2 + TD, C.bfp(WS_WOUT_T), T, 1024, 1024}; pg8::StaticOrder S; S.init(T, 1024, C.G, C.bid);
        pg8::EpiD3 e{R3 + TD, C.in[0], C.f32p(WS_MOD)}; pg8::gemm_phase<pg8::EpiD3, pg8::StaticOrder, true, true>(C.lds, g, S, e); }
    if constexpr (PH == 8) { p_rownorm_b(C, R3 + TD, C.in[18], 3072, 4096, R0); p_cvt_tables8(C, (unsigned char*)R2, (unsigned char*)R2 + (size_t)16384 * 1024); }
    if constexpr (PH == 9) { pg8::Gemm g{R0, C.bfp(WS_WPQ_T), T, 2048, 1024}; pg8::StaticOrder S; S.init(T, 2048, C.G, C.bid);
        pg8::EpiQp e{OB}; pg8::gemm_phase<pg8::EpiQp, pg8::StaticOrder, true, true>(C.lds, g, S, e); }
    if constexpr (PH == 10) p_topk(C, OB, C.bfp(WS_KEYS), (unsigned short*)R1, (float*)(R1 + 4 * MiB));
    if constexpr (PH == 11) p_gu(C, R0, (const unsigned short*)R1, (const unsigned char*)R2, a.out);
    if constexpr (PH == 12) p_gc(C, a.out, (const float*)(R1 + 4 * MiB), (float*)((unsigned char*)R2 + 32 * MiB));
    if constexpr (PH == 13) p_gv(C, (const float*)((unsigned char*)R2 + 32 * MiB), (const unsigned short*)R1, (const unsigned char*)R2 + (size_t)16384 * 1024, R3);
    if constexpr (PH == 14) p_gf(C, R3 + TD, R3, a.out);
}

template <int PH> struct PhaseLoop {
    static __device__ __forceinline__ void run(const Ctx& C, const Args& a, const XcdBarrier& bar) {
        if (PH >= a.ph_lo && PH < a.ph_hi) { run_phase<PH>(C, a);
#ifdef REP_PHASE
            if (PH == REP_PHASE) { xcd_barrier(bar); run_phase<PH>(C, a); }
#endif
            if (PH + 1 < a.ph_hi) xcd_barrier(bar); }
        PhaseLoop<PH + 1>::run(C, a, bar);
    }
};
template <> struct PhaseLoop<N_PHASES> { static __device__ __forceinline__ void run(const Ctx&, const Args&, const XcdBarrier&) {} };

__global__ void __launch_bounds__(NTHR, 2) mega(Args a) {
    extern __shared__ __attribute__((aligned(16))) unsigned char lds_raw[];
    Ctx C; C.in = a.in; C.out = a.out; C.ws = a.ws; C.tid = threadIdx.x; C.lane = C.tid & 63; C.wave = __builtin_amdgcn_readfirstlane(C.tid >> 6);
    C.G = gridDim.x; C.bid = blockIdx.x; C.lds = (LAS unsigned char*)lds_raw;
    volatile LAS unsigned* MISC = (volatile LAS unsigned*)(C.lds + MISC_OFF);
    if (C.tid < 64) MISC[C.tid] = 0u;
    __syncthreads();
    XcdBarrier bar; bar.bar = (unsigned*)(a.ws + WS_CTL) + CW_BAR; bar.x = 0; bar.st = nullptr;
    if (a.ph_hi - a.ph_lo > 1) bar = xcd_barrier_post((unsigned*)(a.ws + WS_CTL) + CW_BAR, MISC + 8);
    PhaseLoop<0>::run(C, a, bar);
}

extern "C" void kernel_launch(void* const* d_in, const int* in_sizes, int n_in, void* d_out, int out_size, void* d_ws, size_t ws_size, hipStream_t stream) {
    static int grid = 0;
    if (grid == 0) {
        if (n_in != 24 || out_size != T * D || ws_size < WS_END) { fprintf(stderr, "kernel_launch: unexpected shapes n_in %d out %d ws %zu\n", n_in, out_size, ws_size); grid = -1; return; }
        int dev = 0, cus = 0;
        if (hipGetDevice(&dev) != hipSuccess || hipDeviceGetAttribute(&cus, hipDeviceAttributeMultiprocessorCount, dev) != hipSuccess) { grid = -1; return; }
        if (hipFuncSetAttribute((const void*)mega, hipFuncAttributeMaxDynamicSharedMemorySize, LDS_BYTES) != hipSuccess) { grid = -1; return; }
        grid = cus;
    }
    if (grid < 0) return;
    (void)hipMemsetAsync((char*)d_ws + WS_CTL, 0, CTL_ZERO_BYTES, stream);
    Args a{};
    for (int i = 0; i < 24; ++i) a.in[i] = (const float*)d_in[i];
    a.out = (float*)d_out; a.ws = (unsigned char*)d_ws;
    a.ph_lo = 0; a.ph_hi = N_PHASES;
    hipLaunchKernelGGL(mega, dim3(grid), dim3(NTHR), LDS_BYTES, stream, a);
}
```

```cpp
#include <hip/hip_runtime.h>
#include <cstdio>
#include <cstdint>

#define LAS __attribute__((address_space(3)))
typedef unsigned short bf16_t;
typedef float f32x4 __attribute__((ext_vector_type(4)));
typedef unsigned u32x4 __attribute__((ext_vector_type(4)));
typedef unsigned u32x2 __attribute__((ext_vector_type(2)));
typedef __bf16 bf16x2_t __attribute__((ext_vector_type(2)));

constexpr int T = 32768, D = 1024, NB = 8, SEQ = 4096;
constexpr int NWAVES = 8, NTHR = 512;
constexpr float EPS = 1e-6f;
constexpr int OFF_Z = 0, OFF_XBC = 1024, OFF_DTF = 3072, OFF_DTB = 3088, OFF_QKV = 3104, OFF_GS = 6176, OFF_GN = 7200, D_IN = 8224;

constexpr size_t MiB = 1u << 20;
constexpr size_t WS_CTL = 0;
constexpr size_t WS_MOD = 1 * MiB;
constexpr size_t WS_RSTD = 1 * MiB + 512 * 1024;
constexpr size_t WS_DT = 2 * MiB;
constexpr size_t WS_WIN_T = 6 * MiB;
constexpr size_t WS_WG_T = 18 * MiB;
constexpr size_t WS_WDT_T = 22 * MiB;
constexpr size_t WS_KEYS = 22 * MiB + 512 * 1024;
constexpr size_t WS_WSSD_T = 23 * MiB, WS_WNA_T = 25 * MiB, WS_WOUT_T = 27 * MiB, WS_WPQ_T = 29 * MiB;
constexpr size_t WS_R0 = 40 * MiB, WS_R1 = 104 * MiB, WS_R2 = 168 * MiB, WS_R3 = 296 * MiB, WS_END = 488 * MiB;

constexpr int LDS_BYTES = 163840;

struct Args { const float* in[24]; float* out; unsigned char* ws; int ph_lo, ph_hi; };

__device__ __forceinline__ float bf2f(unsigned v) { return __uint_as_float(v << 16); }
__device__ __forceinline__ float bflo(unsigned v) { return __uint_as_float(v << 16); }
__device__ __forceinline__ float bfhi(unsigned v) { return __uint_as_float(v & 0xffff0000u); }
__device__ __forceinline__ unsigned f2bf(float f) { unsigned u = __float_as_uint(f); return (u + 0x7fffu + ((u >> 16) & 1u)) >> 16; }
typedef float f32x2_t __attribute__((ext_vector_type(2)));
__device__ __forceinline__ unsigned pk2(float lo, float hi) { f32x2_t v = {lo, hi}; bf16x2_t b = __builtin_convertvector(v, bf16x2_t); return __builtin_bit_cast(unsigned, b); }
__device__ __forceinline__ float wave_sum(float v) {
#pragma unroll
    for (int o = 1; o < 64; o <<= 1) v += __shfl_xor(v, o);
    return v;
}
__device__ __forceinline__ float silu_f(float x) { return x / (1.f + __expf(-x)); }
__device__ __forceinline__ float sigmoid_f(float x) { return 1.f / (1.f + __expf(-x)); }
__device__ __forceinline__ float softplus_f(float x) { return x > 20.f ? x : log1pf(__expf(x)); }
__device__ __forceinline__ float gelu_f(float x) { return 0.5f * x * (1.f + erff(x * 0.70710678118654752f)); }

struct Ctx {
    const float* const* in; float* out; unsigned char* ws;
    int tid, lane, wave, G, bid;
    LAS unsigned char* lds;
    __device__ __forceinline__ float* f32p(size_t off) const { return (float*)(ws + off); }
    __device__ __forceinline__ bf16_t* bfp(size_t off) const { return (bf16_t*)(ws + off); }
};

__device__ __forceinline__ void tr_item(const float* W, int ldw, int col0, int K, bf16_t* WT, int row_off, LAS float* scr, int item, int nblk, int lane, const float* kscale) {
    const int kb = item / nblk, nb = item % nblk, k0 = 64 * kb, n0 = 32 * nb;
#pragma unroll 8
    for (int i = 0; i < 32; ++i) { const int kk = 2 * i + (lane >> 5); float x = W[(size_t)(k0 + kk) * ldw + col0 + n0 + (lane & 31)]; if (kscale) x *= kscale[k0 + kk]; scr[kk * 33 + (lane & 31)] = x; }
    asm volatile("s_waitcnt lgkmcnt(0)" ::: "memory");
    const int c = lane & 7;
#pragma unroll
    for (int j = 0; j < 4; ++j) { const int n = (lane >> 3) + 8 * j; const LAS float* sp = scr + (8 * c) * 33 + n;
        u32x4 o; o.x = pk2(sp[0 * 33], sp[1 * 33]); o.y = pk2(sp[2 * 33], sp[3 * 33]); o.z = pk2(sp[4 * 33], sp[5 * 33]); o.w = pk2(sp[6 * 33], sp[7 * 33]);
        *(u32x4*)(WT + (size_t)(row_off + n0 + n) * K + k0 + 8 * c) = o; }
    asm volatile("s_waitcnt lgkmcnt(0)" ::: "memory");
}
__device__ __forceinline__ void p_prep(const Ctx& C) {
    const float* c = C.in[1]; const float* w_ada = C.in[2]; const float* b_ada = C.in[3];
    float* mod = C.f32p(WS_MOD);
    LAS float* sc = (LAS float*)C.lds;
    LAS float* red = sc + 8192;
    for (int i = C.tid; i < 8192; i += NTHR) sc[i] = silu_f(c[i]);
    __syncthreads();
    for (int jb = C.bid; jb < 256; jb += C.G) {
        const int j0 = jb * 24, jl = C.tid % 24, kq = C.tid / 24;
        if (C.tid < 504) { float acc[8];
#pragma unroll
            for (int b = 0; b < 8; ++b) acc[b] = 0.f;
            for (int k = kq; k < 1024; k += 21) { const float w = w_ada[(size_t)k * 6144 + j0 + jl];
#pragma unroll
                for (int b = 0; b < 8; ++b) acc[b] += sc[b * 1024 + k] * w; }
#pragma unroll
            for (int b = 0; b < 8; ++b) red[(kq * 24 + jl) * 8 + b] = acc[b]; }
        __syncthreads();
        if (C.tid < 192) { const int jl2 = C.tid % 24, b2 = C.tid / 24; float sacc = b_ada[j0 + jl2];
            for (int kq2 = 0; kq2 < 21; ++kq2) sacc += red[(kq2 * 24 + jl2) * 8 + b2];
            mod[b2 * 6144 + j0 + jl2] = sacc; }
        __syncthreads();
    }
    LAS float* scr = (LAS float*)(C.lds + 65536 + C.wave * 8448);
    const int gw = C.bid * NWAVES + C.wave, NGW = C.G * NWAVES;
    const float* w_in = C.in[5];
    constexpr int I_A = 16 * 96, I_B = 16 * 96, I_G = 16 * 64, I_DT = 16, I_S = 16 * 32, I_PQ = 16 * 64;
    constexpr int NIT = I_A + I_B + I_G + I_DT + 3 * I_S + I_PQ;
    for (int it = gw; it < NIT; it += NGW) {
        int r = it;
        if (r < I_A) { tr_item(w_in, D_IN, 0, D, C.bfp(WS_WIN_T), 0, scr, r, 96, C.lane, nullptr); continue; } r -= I_A;
        if (r < I_B) { tr_item(w_in, D_IN, OFF_QKV, D, C.bfp(WS_WIN_T), 3072, scr, r, 96, C.lane, nullptr); continue; } r -= I_B;
        if (r < I_G) { tr_item(w_in, D_IN, OFF_GS, D, C.bfp(WS_WG_T), 0, scr, r, 64, C.lane, nullptr); continue; } r -= I_G;
        if (r < I_DT) { tr_item(w_in, D_IN, OFF_DTF, D, C.bfp(WS_WDT_T), 0, scr, r, 1, C.lane, nullptr); continue; } r -= I_DT;
        if (r < I_S) { tr_item(C.in[14], D, 0, D, C.bfp(WS_WSSD_T), 0, scr, r, 32, C.lane, C.in[13]); continue; } r -= I_S;
        if (r < I_S) { tr_item(C.in[16], D, 0, D, C.bfp(WS_WNA_T), 0, scr, r, 32, C.lane, nullptr); continue; } r -= I_S;
        if (r < I_S) { tr_item(C.in[17], D, 0, D, C.bfp(WS_WOUT_T), 0, scr, r, 32, C.lane, nullptr); continue; } r -= I_S;
        tr_item(C.in[19], 2048, 0, D, C.bfp(WS_WPQ_T), 0, scr, r, 64, C.lane, nullptr);
    }
    { const int gt = C.bid * NTHR + C.tid, NT = C.G * NTHR; const float* kf = C.in[20]; bf16_t* kb = C.bfp(WS_KEYS);
      for (int i = gt; i < 2 * 128 * 128; i += NT) kb[i] = (bf16_t)f2bf(kf[i]); }
    __syncthreads();
}

__device__ __forceinline__ void p_rownorm(const Ctx& C, const float* X, const float* gamma, int sh_off, int sc_off, bf16_t* dst) {
    const float* mod = C.f32p(WS_MOD);
    const int gw = C.bid * NWAVES + C.wave, NGW = C.G * NWAVES;
    for (int row0 = gw * 4; row0 < T; row0 += NGW * 4) {
        const int b = row0 / SEQ;
        f32x4 v[4][4]; float s[4];
#pragma unroll
        for (int r = 0; r < 4; ++r) { const f32x4* xr = (const f32x4*)(X + (size_t)(row0 + r) * D) + C.lane;
#pragma unroll
            for (int j = 0; j < 4; ++j) v[r][j] = xr[64 * j]; }
#pragma unroll
        for (int r = 0; r < 4; ++r) { float a = 0.f;
#pragma unroll
            for (int j = 0; j < 4; ++j) a += (v[r][j].x * v[r][j].x + v[r][j].y * v[r][j].y) + (v[r][j].z * v[r][j].z + v[r][j].w * v[r][j].w);
            s[r] = rsqrtf(wave_sum(a) * (1.f / D) + EPS); }
#pragma unroll
        for (int j = 0; j < 4; ++j) {
            const int col = 4 * C.lane + 256 * j;
            const f32x4 g = *(const f32x4*)(gamma + col), sh = *(const f32x4*)(mod + b * 6144 + sh_off + col), sc = *(const f32x4*)(mod + b * 6144 + sc_off + col);
            const f32x4 gs = g * (sc + 1.f);
#pragma unroll
            for (int r = 0; r < 4; ++r) { const f32x4 y = v[r][j] * s[r] * gs + sh; u32x2 w; w.x = pk2(y.x, y.y); w.y = pk2(y.z, y.w);
                *((u32x2*)(dst + (size_t)(row0 + r) * D) + C.lane + 64 * j) = w; }
        }
    }
}

__device__ __forceinline__ void p_rownorm_b(const Ctx& C, const bf16_t* X, const float* gamma, int sh_off, int sc_off, bf16_t* dst) {
    const float* mod = C.f32p(WS_MOD);
    const int gw = C.bid * NWAVES + C.wave, NGW = C.G * NWAVES;
    for (int row0 = gw * 4; row0 < T; row0 += NGW * 4) {
        const int b = row0 / SEQ;
        u32x2 w[4][4]; float s[4];
#pragma unroll
        for (int r = 0; r < 4; ++r)
#pragma unroll
            for (int j = 0; j < 4; ++j) w[r][j] = *((const u32x2*)(X + (size_t)(row0 + r) * D) + C.lane + 64 * j);
        f32x4 v[4][4];
#pragma unroll
        for (int r = 0; r < 4; ++r) { float a = 0.f;
#pragma unroll
            for (int j = 0; j < 4; ++j) { v[r][j].x = bflo(w[r][j].x); v[r][j].y = bfhi(w[r][j].x); v[r][j].z = bflo(w[r][j].y); v[r][j].w = bfhi(w[r][j].y);
                a += (v[r][j].x * v[r][j].x + v[r][j].y * v[r][j].y) + (v[r][j].z * v[r][j].z + v[r][j].w * v[r][j].w); }
            s[r] = rsqrtf(wave_sum(a) * (1.f / D) + EPS); }
#pragma unroll
        for (int j = 0; j < 4; ++j) {
            const int col = 4 * C.lane + 256 * j;
            const f32x4 g = *(const f32x4*)(gamma + col), sh = *(const f32x4*)(mod + b * 6144 + sh_off + col), sc = *(const f32x4*)(mod + b * 6144 + sc_off + col);
            const f32x4 gs = g * (sc + 1.f);
#pragma unroll
            for (int r = 0; r < 4; ++r) { const f32x4 y = v[r][j] * s[r] * gs + sh; u32x2 o; o.x = pk2(y.x, y.y); o.y = pk2(y.z, y.w);
                *((u32x2*)(dst + (size_t)(row0 + r) * D) + C.lane + 64 * j) = o; }
        }
    }
}

__device__ __forceinline__ void p_dt(const Ctx& C, const bf16_t* n1, const bf16_t* wdt, float* dt) {
    typedef short bf16x8 __attribute__((ext_vector_type(8)));
    const float* bf = C.in[8]; const float* bb = C.in[9];
    const int gw = C.bid * NWAVES + C.wave, NGW = C.G * NWAVES, lane = C.lane, g = lane >> 4, i16 = lane & 15;
    for (int tile = gw; tile < T / 16; tile += NGW) {
        const size_t t0 = (size_t)tile * 16;
        f32x4 a0 = (f32x4){0.f, 0.f, 0.f, 0.f}, a1 = a0;
#pragma unroll 8
        for (int ks = 0; ks < 32; ++ks) {
            const bf16x8 av = *(const bf16x8*)(n1 + (t0 + i16) * 1024 + ks * 32 + g * 8);
            const bf16x8 b0 = *(const bf16x8*)(wdt + (size_t)i16 * 1024 + ks * 32 + g * 8), b1 = *(const bf16x8*)(wdt + (size_t)(16 + i16) * 1024 + ks * 32 + g * 8);
            a0 = __builtin_amdgcn_mfma_f32_16x16x32_bf16(av, b0, a0, 0, 0, 0); a1 = __builtin_amdgcn_mfma_f32_16x16x32_bf16(av, b1, a1, 0, 0, 0); }
        const float bias0 = bf[i16], bias1 = bb[i16];
#pragma unroll
        for (int r = 0; r < 4; ++r) { dt[(t0 + 4 * g + r) * 32 + i16] = softplus_f(a0[r] + bias0); dt[(t0 + 4 * g + r) * 32 + 16 + i16] = softplus_f(a1[r] + bias1); }
    }
}

__device__ __forceinline__ void p_conv(const Ctx& C, const bf16_t* xbc, bf16_t* xc) {
    const float* cw = C.in[6]; const float* cb = C.in[7];
    const int gt = C.bid * NTHR + C.tid, NT = C.G * NTHR;
    for (int i = gt; i < (T / 8) * 256; i += NT) {
        const int cg = i & 255, run = i >> 8, t0 = run * 8, l0 = t0 & (SEQ - 1), ch = cg * 8;
        float w[5][8], acc[8][8];
#pragma unroll
        for (int j = 0; j < 5; ++j) { const f32x4 w0 = *(const f32x4*)(cw + j * 2048 + ch), w1 = *(const f32x4*)(cw + j * 2048 + ch + 4);
            w[j][0] = w0.x; w[j][1] = w0.y; w[j][2] = w0.z; w[j][3] = w0.w; w[j][4] = w1.x; w[j][5] = w1.y; w[j][6] = w1.z; w[j][7] = w1.w; }
        { const f32x4 b0 = *(const f32x4*)(cb + ch), b1 = *(const f32x4*)(cb + ch + 4);
#pragma unroll
          for (int o = 0; o < 8; ++o) { acc[o][0] = b0.x; acc[o][1] = b0.y; acc[o][2] = b0.z; acc[o][3] = b0.w; acc[o][4] = b1.x; acc[o][5] = b1.y; acc[o][6] = b1.z; acc[o][7] = b1.w; } }
        u32x4 rw[12];
#pragma unroll
        for (int rr = 0; rr < 12; ++rr) { const int ll = l0 + rr - 2; rw[rr] = (u32x4){0u, 0u, 0u, 0u};
            if (ll >= 0 && ll < SEQ) rw[rr] = *(const u32x4*)(xbc + (size_t)(t0 + rr - 2) * 2048 + ch); }
#pragma unroll
        for (int rr = 0; rr < 12; ++rr) {
            const float x[8] = {bflo(rw[rr].x), bfhi(rw[rr].x), bflo(rw[rr].y), bfhi(rw[rr].y), bflo(rw[rr].z), bfhi(rw[rr].z), bflo(rw[rr].w), bfhi(rw[rr].w)};
#pragma unroll
            for (int j = 0; j < 5; ++j) { const int o = rr - j; if (o >= 0 && o < 8) {
#pragma unroll
                for (int q = 0; q < 8; ++q) acc[o][q] += w[j][q] * x[q]; } }
        }
#pragma unroll
        for (int o = 0; o < 8; ++o) { u32x4 ov; ov.x = pk2(silu_f(acc[o][0]), silu_f(acc[o][1])); ov.y = pk2(silu_f(acc[o][2]), silu_f(acc[o][3])); ov.z = pk2(silu_f(acc[o][4]), silu_f(acc[o][5])); ov.w = pk2(silu_f(acc[o][6]), silu_f(acc[o][7]));
            *(u32x4*)(xc + (size_t)(t0 + o) * 2048 + ch) = ov; }
    }
}

namespace ssd {
typedef short bf16x8 __attribute__((ext_vector_type(8)));
typedef short s16x4 __attribute__((ext_vector_type(4)));
constexpr int RS = 272, RSX = 144;
constexpr int CN = 0, BN = 34816, BS = 69632, SL = 104448, SLB = 17408, XN = 139264, CSB = 157696;
__device__ __forceinline__ unsigned pkbf(float lo, float hi) { return pk2(lo, hi); }
__device__ __forceinline__ bf16x8 trfrag_p(LAS unsigned char* base, int stride, int ks, int c, int g, int q, int pp) {
    LAS unsigned char* a0 = base + (32 * ks + 4 * g + q) * stride + 32 * c + 8 * pp;
    const s16x4 v0 = __builtin_amdgcn_ds_read_tr16_b64_v4i16((LAS s16x4*)a0);
    const s16x4 v1 = __builtin_amdgcn_ds_read_tr16_b64_v4i16((LAS s16x4*)(a0 + 16 * stride));
    bf16x8 r; r[0] = v0[0]; r[1] = v0[1]; r[2] = v0[2]; r[3] = v0[3]; r[4] = v1[0]; r[5] = v1[1]; r[6] = v1[2]; r[7] = v1[3]; return r;
}
}
__device__ __forceinline__ void p_ssd(const Ctx& C, const bf16_t* xc, const float* dtb, bf16_t* yf, bf16_t* yb) {
    using namespace ssd;
    LAS unsigned char* L = C.lds;
    const int tid = C.tid, lane = C.lane, w = C.wave, g = lane >> 4, i16 = lane & 15, q = (lane >> 2) & 3, pp = lane & 3;
    for (int unit = C.bid; unit < 256; unit += C.G) {
        const int dir = unit & 1, hd = (unit >> 1) & 15, b = unit >> 5, grp = hd >> 2;
        const float a = -__expf((dir ? C.in[11] : C.in[10])[hd]);
        const float dsk = dir ? 0.f : C.in[12][hd];
        bf16_t* yout = dir ? yb : yf;
        f32x4 sacc[4];
#pragma unroll
        for (int pt = 0; pt < 4; ++pt) sacc[pt] = (f32x4){0.f, 0.f, 0.f, 0.f};
        __syncthreads();
        for (int i = tid; i < 2 * SLB / 4; i += NTHR) ((LAS unsigned*)(L + SL))[i] = 0u;
        u32x4 pfC[4], pfB[4], pfX[2]; float pfd0 = 0.f, pfd1 = 0.f;
#define SSD_ISSUE(ci_) do { const int c_ = dir ? (31 - (ci_)) : (ci_); const size_t t0_ = (size_t)b * SEQ + (size_t)c_ * 128; \
            _Pragma("unroll") for (int i_ = 0; i_ < 4; ++i_) { const int idx_ = tid + NTHR * i_, l_ = idx_ >> 4, cc_ = idx_ & 15; const bf16_t* rp_ = xc + (t0_ + l_) * 2048 + grp * 128 + cc_ * 8; \
                pfB[i_] = *(const u32x4*)(rp_ + 1024); pfC[i_] = *(const u32x4*)(rp_ + 1536); } \
            _Pragma("unroll") for (int i_ = 0; i_ < 2; ++i_) { const int idx_ = tid + NTHR * i_, l_ = idx_ >> 3, cc_ = idx_ & 7; pfX[i_] = *(const u32x4*)(xc + (t0_ + l_) * 2048 + hd * 64 + cc_ * 8); } \
            if (w == 0) { const int l0_ = dir ? (127 - 2 * lane) : (2 * lane), l1_ = dir ? (126 - 2 * lane) : (2 * lane + 1); \
                pfd0 = dtb[(t0_ + l0_) * 32 + dir * 16 + hd]; pfd1 = dtb[(t0_ + l1_) * 32 + dir * 16 + hd]; } } while (0)
#define SSD_SCAN(buf_) do { if (w == 0) { const float da0_ = pfd0 * a, da1_ = pfd1 * a; const float p1_ = da0_ + da1_; float s_ = p1_; \
            _Pragma("unroll") for (int o_ = 1; o_ < 64; o_ <<= 1) { const float t_ = __shfl_up(s_, o_); if (lane >= o_) s_ += t_; } \
            const float ex_ = s_ - p1_, cs0_ = ex_ + da0_, cs1_ = ex_ + p1_, tot_ = __shfl(s_, 63); \
            const int l0_ = dir ? (127 - 2 * lane) : (2 * lane), l1_ = dir ? (126 - 2 * lane) : (2 * lane + 1); \
            LAS float* cb_ = (LAS float*)(L + CSB + (buf_) * 1536); \
            cb_[l0_] = cs0_; cb_[l1_] = cs1_; cb_[128 + l0_] = pfd0; cb_[128 + l1_] = pfd1; cb_[256 + l0_] = pfd0 * __expf(tot_ - cs0_); cb_[256 + l1_] = pfd1 * __expf(tot_ - cs1_); \
            if (lane == 0) *(LAS float*)(L + CSB + 3072 + 8 * (buf_)) = tot_; } } while (0)
#define SSD_WRITE(buf_) do { const LAS float* dw_ = (const LAS float*)(L + CSB + (buf_) * 1536 + 1024); \
            _Pragma("unroll") for (int i_ = 0; i_ < 4; ++i_) { const int idx_ = tid + NTHR * i_, l_ = idx_ >> 4, cc_ = idx_ & 15; \
                *(LAS u32x4*)(L + CN + l_ * RS + cc_ * 16) = pfC[i_]; *(LAS u32x4*)(L + BN + l_ * RS + cc_ * 16) = pfB[i_]; \
                const float sc_ = dw_[l_]; const u32x4 v_ = pfB[i_]; u32x4 o_; \
                o_.x = pkbf(bflo(v_.x) * sc_, bfhi(v_.x) * sc_); o_.y = pkbf(bflo(v_.y) * sc_, bfhi(v_.y) * sc_); o_.z = pkbf(bflo(v_.z) * sc_, bfhi(v_.z) * sc_); o_.w = pkbf(bflo(v_.w) * sc_, bfhi(v_.w) * sc_); \
                *(LAS u32x4*)(L + BS + l_ * RS + cc_ * 16) = o_; } \
            _Pragma("unroll") for (int i_ = 0; i_ < 2; ++i_) { const int idx_ = tid + NTHR * i_, l_ = idx_ >> 3, cc_ = idx_ & 7; *(LAS u32x4*)(L + XN + l_ * RSX + cc_ * 16) = pfX[i_]; } } while (0)
        SSD_ISSUE(0);
        SSD_SCAN(0);
        __syncthreads();
        SSD_WRITE(0);
        __syncthreads();
        for (int ci = 0; ci < 32; ++ci) {
            const int buf = ci & 1;
            const int c = dir ? (31 - ci) : ci; const size_t t0 = (size_t)b * SEQ + (size_t)c * 128;
            if (ci + 1 < 32) SSD_ISSUE(ci + 1);
            const LAS float* csb = (const LAS float*)(L + CSB + buf * 1536);
            const float cs_l = csb[16 * w + i16];
            const float cs_end = *(const LAS float*)(L + CSB + 3072 + 8 * buf);
            bf16x8 cfrag[4];
#pragma unroll
            for (int ks = 0; ks < 4; ++ks) cfrag[ks] = *(const LAS bf16x8*)(L + CN + (16 * w + i16) * RS + ks * 64 + g * 16);
            u32x2 mreg[8];
            const int lrow = 16 * w + i16;
#pragma unroll
            for (int st = 0; st < 8; ++st) {
                f32x4 acc = (f32x4){0.f, 0.f, 0.f, 0.f};
#pragma unroll
                for (int ks = 0; ks < 4; ++ks) { const bf16x8 af = *(const LAS bf16x8*)(L + BN + (16 * st + i16) * RS + ks * 64 + g * 16);
                    acc = __builtin_amdgcn_mfma_f32_16x16x32_bf16(af, cfrag[ks], acc, 0, 0, 0); }
                const f32x4 cs_s = *(const LAS f32x4*)(csb + 16 * st + 4 * g), dt_s = *(const LAS f32x4*)(csb + 128 + 16 * st + 4 * g);
                float mv[4];
#pragma unroll
                for (int r = 0; r < 4; ++r) { const int srow = 16 * st + 4 * g + r; const bool valid = dir ? (srow >= lrow) : (srow <= lrow);
                    const float e = valid ? __expf(cs_l - cs_s[r]) : 0.f; mv[r] = acc[r] * dt_s[r] * e; }
                mreg[st].x = pkbf(mv[0], mv[1]); mreg[st].y = pkbf(mv[2], mv[3]);
            }
            f32x4 yacc[4];
            const float el = __expf(cs_l);
#pragma unroll
            for (int pt = 0; pt < 4; ++pt) { f32x4 acc = (f32x4){0.f, 0.f, 0.f, 0.f};
#pragma unroll
                for (int ks = 0; ks < 4; ++ks) { const bf16x8 af = *(const LAS bf16x8*)(L + SL + buf * SLB + (16 * pt + i16) * RS + ks * 64 + g * 16);
                    acc = __builtin_amdgcn_mfma_f32_16x16x32_bf16(af, cfrag[ks], acc, 0, 0, 0); }
                yacc[pt] = acc * el; }
#pragma unroll
            for (int ks = 0; ks < 4; ++ks) { u32x4 mw; mw.x = mreg[2 * ks].x; mw.y = mreg[2 * ks].y; mw.z = mreg[2 * ks + 1].x; mw.w = mreg[2 * ks + 1].y;
                const bf16x8 mf = __builtin_bit_cast(bf16x8, mw);
#pragma unroll
                for (int pt = 0; pt < 4; ++pt) { const bf16x8 xf = trfrag_p(L + XN, RSX, ks, pt, g, q, pp); yacc[pt] = __builtin_amdgcn_mfma_f32_16x16x32_bf16(xf, mf, yacc[pt], 0, 0, 0); } }
#pragma unroll
            for (int pt = 0; pt < 4; ++pt) { const u32x2 xv = *(const LAS u32x2*)(L + XN + lrow * RSX + (16 * pt + 4 * g) * 2);
                u32x2 o; o.x = pkbf(yacc[pt][0] + dsk * bflo(xv.x), yacc[pt][1] + dsk * bfhi(xv.x)); o.y = pkbf(yacc[pt][2] + dsk * bflo(xv.y), yacc[pt][3] + dsk * bfhi(xv.y));
                *(u32x2*)(yout + (t0 + lrow) * 1024 + hd * 64 + 16 * pt + 4 * g) = o; }
            { const float dec = __expf(cs_end);
#pragma unroll
              for (int pt = 0; pt < 4; ++pt) sacc[pt] = sacc[pt] * dec; }
#pragma unroll
            for (int ks = 0; ks < 4; ++ks) { const bf16x8 bf = trfrag_p(L + BS, RS, ks, w, g, q, pp);
#pragma unroll
                for (int pt = 0; pt < 4; ++pt) { const bf16x8 xf = trfrag_p(L + XN, RSX, ks, pt, g, q, pp); sacc[pt] = __builtin_amdgcn_mfma_f32_16x16x32_bf16(bf, xf, sacc[pt], 0, 0, 0); } }
#pragma unroll
            for (int pt = 0; pt < 4; ++pt) { u32x2 o; o.x = pkbf(sacc[pt][0], sacc[pt][1]); o.y = pkbf(sacc[pt][2], sacc[pt][3]);
                *(LAS u32x2*)(L + SL + (buf ^ 1) * SLB + (16 * pt + i16) * RS + (16 * w + 4 * g) * 2) = o; }
            if (ci + 1 < 32) SSD_SCAN(buf ^ 1);
            __syncthreads();
            if (ci + 1 < 32) SSD_WRITE(buf ^ 1);
            __syncthreads();
        }
#undef SSD_ISSUE
#undef SSD_SCAN
#undef SSD_WRITE
    }
}

namespace nat {
typedef short bf16x8 __attribute__((ext_vector_type(8)));
typedef short s16x4 __attribute__((ext_vector_type(4)));
constexpr int VH = 65536, RPB = 131072;
__device__ __forceinline__ int voff(int ks, int d) { return ks * 128 + ((((d >> 3) ^ (ks & 7))) << 4) + (d & 7) * 2; }
__device__ __forceinline__ int clampi(int x, int lo, int hi) { return x < lo ? lo : (x > hi ? hi : x); }
}
__device__ __forceinline__ void p_na(const Ctx& C, bf16_t* q, const bf16_t* k, const bf16_t* v) {
    using namespace nat;
    LAS unsigned char* L = C.lds;
    const float* rpb = C.in[15];
    const int tid = C.tid, lane = C.lane, w = C.wave, g = lane >> 4, i16 = lane & 15, qq = (lane >> 2) & 3, pp = lane & 3;
    const int hl = w >> 2, m = w & 3;
    const int bs = (m == 0) ? 0 : (m == 1) ? 8 : (m == 2) ? 24 : 32;
    const int qc = 16 * m + i16, wsx = clampi(qc - 8, 0, 48);
    unsigned vmask = 0u; int dcol[8];
#pragma unroll
    for (int c = 0; c < 8; ++c) { const int kc = bs + (c >> 2) * 16 + 4 * g + (c & 3); if (kc >= wsx && kc < wsx + 16) vmask |= (1u << c); dcol[c] = clampi(kc - qc + 15, 0, 30); }
    for (int unit = C.bid; unit < 256; unit += C.G) {
        const int rseg = unit & 3, hp = (unit >> 2) & 7, b = unit >> 5, h = 2 * hp + hl;
        __syncthreads();
        for (int i = tid; i < 930; i += NTHR) ((LAS float*)(L + RPB))[i] = rpb[(2 * hp) * 465 + i];
#define NA_LOAD_ROW(row_) do { _Pragma("unroll") for (int i_ = 0; i_ < 2; ++i_) { const int idx_ = tid + NTHR * i_, hl_ = idx_ >> 9, col_ = (idx_ >> 3) & 63, dch_ = idx_ & 7; \
            const u32x4 val_ = *(const u32x4*)(v + ((size_t)b * SEQ + (size_t)(row_) * 64 + col_) * 1024 + (2 * hp + hl_) * 64 + dch_ * 8); \
            *(LAS u32x4*)(L + hl_ * VH + voff(((row_) & 7) * 64 + col_, dch_ * 8)) = val_; } } while (0)
        const int r0 = 16 * rseg; int rs_prev = clampi(r0 - 4, 0, 56);
        for (int rr = 0; rr < 8; ++rr) NA_LOAD_ROW(rs_prev + rr);
        __syncthreads();
        const LAS float* rpbl = (const LAS float*)(L + RPB) + hl * 465;
        for (int s = 0; s < 16; ++s) {
            const int r = r0 + s, rs = clampi(r - 4, 0, 56);
            if (rs != rs_prev) { __syncthreads(); NA_LOAD_ROW(rs + 7); __syncthreads(); rs_prev = rs; }
            const size_t tokq = (size_t)b * SEQ + (size_t)r * 64 + qc;
            bf16x8 qf[2];
#pragma unroll
            for (int ks = 0; ks < 2; ++ks) qf[ks] = *(const bf16x8*)(q + tokq * 1024 + h * 64 + ks * 32 + g * 8);
            f32x4 sc[16];
#pragma unroll
            for (int kt = 0; kt < 16; ++kt) { const size_t tokk = (size_t)b * SEQ + (size_t)(rs + (kt >> 1)) * 64 + bs + (kt & 1) * 16 + i16;
                f32x4 acc = (f32x4){0.f, 0.f, 0.f, 0.f};
#pragma unroll
                for (int ks = 0; ks < 2; ++ks) { const bf16x8 kf = *(const bf16x8*)(k + tokk * 1024 + h * 64 + ks * 32 + g * 8); acc = __builtin_amdgcn_mfma_f32_16x16x32_bf16(kf, qf[ks], acc, 0, 0, 0); }
                sc[kt] = acc; }
            float mx = -1.0e30f;
#pragma unroll
            for (int kt = 0; kt < 16; ++kt) { const int drow = rs + (kt >> 1) - r + 7;
#pragma unroll
                for (int e = 0; e < 4; ++e) { const int c = (kt & 1) * 4 + e; const float bias = rpbl[drow * 31 + dcol[c]];
                    const float val = ((vmask >> c) & 1u) ? sc[kt][e] + bias : -1.0e30f; sc[kt][e] = val; mx = fmaxf(mx, val); } }
            mx = fmaxf(mx, __shfl_xor(mx, 16)); mx = fmaxf(mx, __shfl_xor(mx, 32));
            float sum = 0.f;
#pragma unroll
            for (int kt = 0; kt < 16; ++kt)
#pragma unroll
                for (int e = 0; e < 4; ++e) { const float p = __expf(sc[kt][e] - mx); sc[kt][e] = p; sum += p; }
            sum += __shfl_xor(sum, 16); sum += __shfl_xor(sum, 32);
            f32x4 o[4];
#pragma unroll
            for (int dt = 0; dt < 4; ++dt) o[dt] = (f32x4){0.f, 0.f, 0.f, 0.f};
#pragma unroll
            for (int kk = 0; kk < 8; ++kk) {
                u32x4 pw; pw.x = pk2(sc[2 * kk][0], sc[2 * kk][1]); pw.y = pk2(sc[2 * kk][2], sc[2 * kk][3]); pw.z = pk2(sc[2 * kk + 1][0], sc[2 * kk + 1][1]); pw.w = pk2(sc[2 * kk + 1][2], sc[2 * kk + 1][3]);
                const bf16x8 pf = __builtin_bit_cast(bf16x8, pw);
                const int ks0 = ((rs + kk) & 7) * 64 + bs + 4 * g + qq, ks1 = ks0 + 16;
#pragma unroll
                for (int dt = 0; dt < 4; ++dt) {
                    const s16x4 v0 = __builtin_amdgcn_ds_read_tr16_b64_v4i16((LAS s16x4*)(L + hl * VH + voff(ks0, 16 * dt + 4 * pp)));
                    const s16x4 v1 = __builtin_amdgcn_ds_read_tr16_b64_v4i16((LAS s16x4*)(L + hl * VH + voff(ks1, 16 * dt + 4 * pp)));
                    bf16x8 vf; vf[0] = v0[0]; vf[1] = v0[1]; vf[2] = v0[2]; vf[3] = v0[3]; vf[4] = v1[0]; vf[5] = v1[1]; vf[6] = v1[2]; vf[7] = v1[3];
                    o[dt] = __builtin_amdgcn_mfma_f32_16x16x32_bf16(vf, pf, o[dt], 0, 0, 0); }
            }
            const float inv = 1.f / sum;
#pragma unroll
            for (int dt = 0; dt < 4; ++dt) { u32x2 ov; ov.x = pk2(o[dt][0] * inv, o[dt][1] * inv); ov.y = pk2(o[dt][2] * inv, o[dt][3] * inv);
                *(u32x2*)(q + tokq * 1024 + h * 64 + 16 * dt + 4 * g) = ov; }
        }
#undef NA_LOAD_ROW
    }
    __syncthreads();
}

__device__ __forceinline__ void p_combine(const Ctx& C, const bf16_t* yf, const bf16_t* yb, bf16_t* szu, float* rstd) {
    const int gw = C.bid * NWAVES + C.wave, NGW = C.G * NWAVES;
    for (int row0 = gw * 2; row0 < T; row0 += NGW * 2) {
        u32x4 a[2][2], b[2][2], z[2][2];
#pragma unroll
        for (int r = 0; r < 2; ++r)
#pragma unroll
            for (int j = 0; j < 2; ++j) { const size_t off = (size_t)(row0 + r) * 1024 + j * 512 + C.lane * 8;
                a[r][j] = *(const u32x4*)(yf + off); b[r][j] = *(const u32x4*)(yb + off); z[r][j] = *(const u32x4*)(szu + off); }
#pragma unroll
        for (int r = 0; r < 2; ++r) { float s = 0.f; u32x4 outv[2];
#pragma unroll
            for (int j = 0; j < 2; ++j) { const u32x4 av = a[r][j], bv = b[r][j], zv = z[r][j]; float u[8];
                u[0] = (bflo(av.x) + bflo(bv.x)) * bflo(zv.x); u[1] = (bfhi(av.x) + bfhi(bv.x)) * bfhi(zv.x);
                u[2] = (bflo(av.y) + bflo(bv.y)) * bflo(zv.y); u[3] = (bfhi(av.y) + bfhi(bv.y)) * bfhi(zv.y);
                u[4] = (bflo(av.z) + bflo(bv.z)) * bflo(zv.z); u[5] = (bfhi(av.z) + bfhi(bv.z)) * bfhi(zv.z);
                u[6] = (bflo(av.w) + bflo(bv.w)) * bflo(zv.w); u[7] = (bfhi(av.w) + bfhi(bv.w)) * bfhi(zv.w);
#pragma unroll
                for (int q = 0; q < 8; ++q) s += u[q] * u[q];
                outv[j].x = pk2(u[0], u[1]); outv[j].y = pk2(u[2], u[3]); outv[j].z = pk2(u[4], u[5]); outv[j].w = pk2(u[6], u[7]); }
            s = wave_sum(s);
#pragma unroll
            for (int j = 0; j < 2; ++j) *(u32x4*)(szu + (size_t)(row0 + r) * 1024 + j * 512 + C.lane * 8) = outv[j];
            if (C.lane == 0) rstd[row0 + r] = rsqrtf(s * (1.f / 1024.f) + EPS); }
    }
}

namespace tk {
typedef short bf16x8 __attribute__((ext_vector_type(8)));
constexpr int RSK = 272, TAB = 69632, TABW = 33 * 16 * 4, IJT = TAB + 8 * TABW;
__device__ __forceinline__ void ce(float& a, float& b) { const float hi = __builtin_fmaxf(a, b), lo = __builtin_fminf(a, b); a = hi; b = lo; }
__device__ __forceinline__ void sort16(float (&v)[16]) {
#pragma unroll
    for (int k = 2; k <= 16; k <<= 1)
#pragma unroll
        for (int j = k >> 1; j > 0; j >>= 1)
#pragma unroll
            for (int i = 0; i < 16; ++i) { const int l = i ^ j; if (l > i) { if ((i & k) == 0) ce(v[i], v[l]); else ce(v[l], v[i]); } }
}
__device__ __forceinline__ void merge16(float (&a)[16], const float (&b)[16]) {
#pragma unroll
    for (int i = 0; i < 16; ++i) a[i] = __builtin_fmaxf(a[i], b[15 - i]);
#pragma unroll
    for (int j = 8; j > 0; j >>= 1)
#pragma unroll
        for (int i = 0; i < 16; ++i) { const int l = i ^ j; if (l > i) ce(a[i], a[l]); }
}
__device__ __forceinline__ void xmerge(float (&a)[16], int mask) { float b[16];
#pragma unroll
    for (int i = 0; i < 16; ++i) b[i] = __shfl_xor(a[i], mask);
    merge16(a, b); }
}
__device__ __forceinline__ void p_topk(const Ctx& C, const bf16_t* qp, const bf16_t* keys, unsigned short* pidx, float* pgate) {
    using namespace tk;
    LAS unsigned char* L = C.lds;
    const int tid = C.tid, lane = C.lane, w = C.wave, g = lane >> 4, i16 = lane & 15;
    __syncthreads();
    for (int i = tid; i < 4096; i += NTHR) { const int r = i >> 4, cc = i & 15; *(LAS u32x4*)(L + r * RSK + cc * 16) = *(const u32x4*)(keys + (size_t)r * 128 + cc * 8); }
    if (tid < 64) { int cnt = 0, fi = 0, fj = 0;
        for (int i = 0; i < 16; ++i) for (int j = 0; j < 16; ++j) if ((i + 1) * (j + 1) <= 16) { if (cnt == tid) { fi = i; fj = j; } ++cnt; }
        ((LAS unsigned*)(L + IJT))[tid] = (unsigned)(fi | (fj << 4)); }
    __syncthreads();
    LAS unsigned* tab = (LAS unsigned*)(L + TAB + w * TABW) + i16 * 33;
    const LAS unsigned* ijt = (const LAS unsigned*)(L + IJT);
    const float NEGV = -1.0e30f;
    const int gw = C.bid * NWAVES + w, NGW = C.G * NWAVES;
    for (int unit = gw; unit < (T / 16) * 8; unit += NGW) {
        const int tg = unit >> 3, hh = unit & 7; const size_t t0 = (size_t)tg * 16;
        float s1[16], s2[16];
#pragma unroll
        for (int z = 0; z < 2; ++z) {
            bf16x8 qf[4];
#pragma unroll
            for (int ks = 0; ks < 4; ++ks) qf[ks] = *(const bf16x8*)(qp + (t0 + i16) * 2048 + hh * 256 + z * 128 + ks * 32 + g * 8);
            float lo[16], hi[16];
#pragma unroll
            for (int nt = 0; nt < 8; ++nt) { f32x4 acc = (f32x4){0.f, 0.f, 0.f, 0.f};
#pragma unroll
                for (int ks = 0; ks < 4; ++ks) { const bf16x8 kf = *(const LAS bf16x8*)(L + (z * 128 + 16 * nt + i16) * RSK + ks * 64 + g * 16);
                    acc = __builtin_amdgcn_mfma_f32_16x16x32_bf16(kf, qf[ks], acc, 0, 0, 0); }
#pragma unroll
                for (int r = 0; r < 4; ++r) { const float pv = __uint_as_float((__float_as_uint(acc[r]) & 0xFFFFFF80u) | (unsigned)(16 * nt + 4 * g + r));
                    if (nt < 4) lo[nt * 4 + r] = pv; else hi[(nt - 4) * 4 + r] = pv; } }
            sort16(lo); sort16(hi); merge16(lo, hi);
            xmerge(lo, 16); xmerge(lo, 32);
#pragma unroll
            for (int i = 0; i < 16; ++i) { if (z == 0) s1[i] = lo[i]; else s2[i] = lo[i]; }
        }
#pragma unroll
        for (int i = 0; i < 16; ++i) { tab[i] = __float_as_uint(s1[i]); tab[16 + i] = __float_as_uint(s2[i]); }
        float cand[16];
            { const float a_ = (g == 0 ? s1[0] : g == 1 ? s1[1] : g == 2 ? s1[3] : s1[14]), b_ = (g == 0 ? s2[0] : g == 1 ? s2[0] : g == 2 ? s2[3] : s2[0]); cand[0] = __uint_as_float((__float_as_uint(a_ + b_) & 0xFFFFFFC0u) | (unsigned)(16 * g + 0)); }
            { const float a_ = (g == 0 ? s1[0] : g == 1 ? s1[1] : g == 2 ? s1[4] : s1[15]), b_ = (g == 0 ? s2[1] : g == 1 ? s2[1] : g == 2 ? s2[0] : s2[0]); cand[1] = __uint_as_float((__float_as_uint(a_ + b_) & 0xFFFFFFC0u) | (unsigned)(16 * g + 1)); }
            { const float a_ = (g == 0 ? s1[0] : g == 1 ? s1[1] : g == 2 ? s1[4] : NEGV), b_ = (g == 0 ? s2[2] : g == 1 ? s2[2] : g == 2 ? s2[1] : NEGV); cand[2] = __uint_as_float((__float_as_uint(a_ + b_) & 0xFFFFFFC0u) | (unsigned)(16 * g + 2)); }
            { const float a_ = (g == 0 ? s1[0] : g == 1 ? s1[1] : g == 2 ? s1[4] : NEGV), b_ = (g == 0 ? s2[3] : g == 1 ? s2[3] : g == 2 ? s2[2] : NEGV); cand[3] = __uint_as_float((__float_as_uint(a_ + b_) & 0xFFFFFFC0u) | (unsigned)(16 * g + 3)); }
            { const float a_ = (g == 0 ? s1[0] : g == 1 ? s1[1] : g == 2 ? s1[5] : NEGV), b_ = (g == 0 ? s2[4] : g == 1 ? s2[4] : g == 2 ? s2[0] : NEGV); cand[4] = __uint_as_float((__float_as_uint(a_ + b_) & 0xFFFFFFC0u) | (unsigned)(16 * g + 4)); }
            { const float a_ = (g == 0 ? s1[0] : g == 1 ? s1[1] : g == 2 ? s1[5] : NEGV), b_ = (g == 0 ? s2[5] : g == 1 ? s2[5] : g == 2 ? s2[1] : NEGV); cand[5] = __uint_as_float((__float_as_uint(a_ + b_) & 0xFFFFFFC0u) | (unsigned)(16 * g + 5)); }
            { const float a_ = (g == 0 ? s1[0] : g == 1 ? s1[1] : g == 2 ? s1[6] : NEGV), b_ = (g == 0 ? s2[6] : g == 1 ? s2[6] : g == 2 ? s2[0] : NEGV); cand[6] = __uint_as_float((__float_as_uint(a_ + b_) & 0xFFFFFFC0u) | (unsigned)(16 * g + 6)); }
            { const float a_ = (g == 0 ? s1[0] : g == 1 ? s1[1] : g == 2 ? s1[6] : NEGV), b_ = (g == 0 ? s2[7] : g == 1 ? s2[7] : g == 2 ? s2[1] : NEGV); cand[7] = __uint_as_float((__float_as_uint(a_ + b_) & 0xFFFFFFC0u) | (unsigned)(16 * g + 7)); }
            { const float a_ = (g == 0 ? s1[0] : g == 1 ? s1[2] : g == 2 ? s1[7] : NEGV), b_ = (g == 0 ? s2[8] : g == 1 ? s2[0] : g == 2 ? s2[0] : NEGV); cand[8] = __uint_as_float((__float_as_uint(a_ + b_) & 0xFFFFFFC0u) | (unsigned)(16 * g + 8)); }
            { const float a_ = (g == 0 ? s1[0] : g == 1 ? s1[2] : g == 2 ? s1[7] : NEGV), b_ = (g == 0 ? s2[9] : g == 1 ? s2[1] : g == 2 ? s2[1] : NEGV); cand[9] = __uint_as_float((__float_as_uint(a_ + b_) & 0xFFFFFFC0u) | (unsigned)(16 * g + 9)); }
            { const float a_ = (g == 0 ? s1[0] : g == 1 ? s1[2] : g == 2 ? s1[8] : NEGV), b_ = (g == 0 ? s2[10] : g == 1 ? s2[2] : g == 2 ? s2[0] : NEGV); cand[10] = __uint_as_float((__float_as_uint(a_ + b_) & 0xFFFFFFC0u) | (unsigned)(16 * g + 10)); }
            { const float a_ = (g == 0 ? s1[0] : g == 1 ? s1[2] : g == 2 ? s1[9] : NEGV), b_ = (g == 0 ? s2[11] : g == 1 ? s2[3] : g == 2 ? s2[0] : NEGV); cand[11] = __uint_as_float((__float_as_uint(a_ + b_) & 0xFFFFFFC0u) | (unsigned)(16 * g + 11)); }
            { const float a_ = (g == 0 ? s1[0] : g == 1 ? s1[2] : g == 2 ? s1[10] : NEGV), b_ = (g == 0 ? s2[12] : g == 1 ? s2[4] : g == 2 ? s2[0] : NEGV); cand[12] = __uint_as_float((__float_as_uint(a_ + b_) & 0xFFFFFFC0u) | (unsigned)(16 * g + 12)); }
            { const float a_ = (g == 0 ? s1[0] : g == 1 ? s1[3] : g == 2 ? s1[11] : NEGV), b_ = (g == 0 ? s2[13] : g == 1 ? s2[0] : g == 2 ? s2[0] : NEGV); cand[13] = __uint_as_float((__float_as_uint(a_ + b_) & 0xFFFFFFC0u) | (unsigned)(16 * g + 13)); }
            { const float a_ = (g == 0 ? s1[0] : g == 1 ? s1[3] : g == 2 ? s1[12] : NEGV), b_ = (g == 0 ? s2[14] : g == 1 ? s2[1] : g == 2 ? s2[0] : NEGV); cand[14] = __uint_as_float((__float_as_uint(a_ + b_) & 0xFFFFFFC0u) | (unsigned)(16 * g + 14)); }
            { const float a_ = (g == 0 ? s1[0] : g == 1 ? s1[3] : g == 2 ? s1[13] : NEGV), b_ = (g == 0 ? s2[15] : g == 1 ? s2[2] : g == 2 ? s2[0] : NEGV); cand[15] = __uint_as_float((__float_as_uint(a_ + b_) & 0xFFFFFFC0u) | (unsigned)(16 * g + 15)); }
        sort16(cand);
        xmerge(cand, 16); xmerge(cand, 32);
        float den = 0.f, ex[16];
#pragma unroll
        for (int i = 0; i < 16; ++i) { ex[i] = __expf(cand[i] - cand[0]); den += ex[i]; }
        const float inv = 1.f / den;
        unsigned short eo[4]; float go[4];
#pragma unroll
        for (int e = 0; e < 4; ++e) {
            const float cv = (g == 0 ? cand[e] : g == 1 ? cand[4 + e] : g == 2 ? cand[8 + e] : cand[12 + e]);
            const float gv = (g == 0 ? ex[e] : g == 1 ? ex[4 + e] : g == 2 ? ex[8 + e] : ex[12 + e]);
            const unsigned code = __float_as_uint(cv) & 63u; const unsigned ij = ijt[code];
            const unsigned p1 = tab[ij & 15u], p2 = tab[16 + (ij >> 4)];
            eo[e] = (unsigned short)((p1 & 127u) * 128u + (p2 & 127u)); go[e] = gv * inv; }
        u32x2 ov; ov.x = (unsigned)eo[0] | ((unsigned)eo[1] << 16); ov.y = (unsigned)eo[2] | ((unsigned)eo[3] << 16);
        *(u32x2*)(pidx + (t0 + i16) * 128 + hh * 16 + 4 * g) = ov;
        *(f32x4*)(pgate + (t0 + i16) * 128 + hh * 16 + 4 * g) = (f32x4){go[0], go[1], go[2], go[3]};
    }
    __syncthreads();
}

__device__ __forceinline__ void p_cvt_tables8(const Ctx& C, unsigned char* u8, unsigned char* v8) {
    const int gt = C.bid * NTHR + C.tid, NT = C.G * NTHR;
    const float* u = C.in[21]; const float* v = C.in[22];
    constexpr int N4 = 16384 * 1024 / 4;
    for (int i0 = gt; i0 < N4; i0 += 4 * NT) {
        f32x4 a[4], b[4];
#pragma unroll
        for (int r = 0; r < 4; ++r) { const int i = i0 + r * NT; if (i < N4) { a[r] = *(const f32x4*)(u + (size_t)i * 4); b[r] = *(const f32x4*)(v + (size_t)i * 4); } }
#pragma unroll
        for (int r = 0; r < 4; ++r) { const int i = i0 + r * NT; if (i < N4) {
            const f32x4 av = a[r] * 256.f, bv = b[r] * 64.f; unsigned x = 0u, y = 0u;
            x = __builtin_amdgcn_cvt_pk_fp8_f32(av.x, av.y, x, false); x = __builtin_amdgcn_cvt_pk_fp8_f32(av.z, av.w, x, true);
            y = __builtin_amdgcn_cvt_pk_fp8_f32(bv.x, bv.y, y, false); y = __builtin_amdgcn_cvt_pk_fp8_f32(bv.z, bv.w, y, true);
            *(unsigned*)(u8 + (size_t)i * 4) = x; *(unsigned*)(v8 + (size_t)i * 4) = y; } }
    }
}

__device__ __forceinline__ int idx16(const u32x4& a, const u32x4& b, int i) { const unsigned w = (i < 8 ? a : b)[(i & 7) >> 1]; return (int)((i & 1) ? (w >> 16) : (w & 0xffffu)); }
__device__ __forceinline__ void p_gu(const Ctx& C, const bf16_t* n2, const unsigned short* pidx, const unsigned char* u8, float* pd) {
    const int j = C.bid & 7, nsl = C.G >> 3, NW = nsl * NWAVES, wsl = (C.bid >> 3) * NWAVES + C.wave, lane = C.lane, s = lane & 7, q = lane >> 3;
    if ((C.bid >> 3) >= nsl) return;
    u32x4 ea, eb, x0, x1;
    { const int t = wsl; ea = *(const u32x4*)(pidx + (size_t)t * 128 + q * 16); eb = *(const u32x4*)(pidx + (size_t)t * 128 + q * 16 + 8);
      x0 = *(const u32x4*)(n2 + (size_t)t * 1024 + 128 * j + 16 * s); x1 = *(const u32x4*)(n2 + (size_t)t * 1024 + 128 * j + 16 * s + 8); }
    for (int t = wsl; t < T; t += NW) {
        u32x4 p[16];
#pragma unroll
        for (int i = 0; i < 16; ++i) p[i] = *(const u32x4*)(u8 + (size_t)idx16(ea, eb, i) * 1024 + 128 * j + 16 * s);
        const unsigned xp[8] = {x0.x, x0.y, x0.z, x0.w, x1.x, x1.y, x1.z, x1.w};
        { const int tn = (t + NW < T) ? t + NW : t;
          ea = *(const u32x4*)(pidx + (size_t)tn * 128 + q * 16); eb = *(const u32x4*)(pidx + (size_t)tn * 128 + q * 16 + 8);
          x0 = *(const u32x4*)(n2 + (size_t)tn * 1024 + 128 * j + 16 * s); x1 = *(const u32x4*)(n2 + (size_t)tn * 1024 + 128 * j + 16 * s + 8); }
        float part[16];
#pragma unroll
        for (int i = 0; i < 16; ++i) { float acc = 0.f;
#pragma unroll
            for (int d = 0; d < 4; ++d) { const unsigned wv = p[i][d];
                const bf16x2_t lo = __builtin_amdgcn_cvt_scalef32_pk_bf16_fp8(wv, 0.00390625f, false), hi = __builtin_amdgcn_cvt_scalef32_pk_bf16_fp8(wv, 0.00390625f, true);
                const unsigned xa = xp[2 * d], xb = xp[2 * d + 1];
                acc = __builtin_amdgcn_fdot2_f32_bf16(lo, __builtin_bit_cast(bf16x2_t, xa), acc, false); acc = __builtin_amdgcn_fdot2_f32_bf16(hi, __builtin_bit_cast(bf16x2_t, xb), acc, false); }
            part[i] = acc; }
        float p8[8]; { const bool hb = (lane & 4) != 0;
#pragma unroll
            for (int i = 0; i < 8; ++i) { const float keep = hb ? part[i + 8] : part[i], send = hb ? part[i] : part[i + 8]; p8[i] = keep + __shfl_xor(send, 4); } }
        float p4[4]; { const bool hb = (lane & 2) != 0;
#pragma unroll
            for (int i = 0; i < 4; ++i) { const float keep = hb ? p8[i + 4] : p8[i], send = hb ? p8[i] : p8[i + 4]; p4[i] = keep + __shfl_xor(send, 2); } }
        float p2[2]; { const bool hb = (lane & 1) != 0;
#pragma unroll
            for (int i = 0; i < 2; ++i) { const float keep = hb ? p4[i + 2] : p4[i], send = hb ? p4[i] : p4[i + 2]; p2[i] = keep + __shfl_xor(send, 1); } }
        const int i0 = ((lane >> 2) & 1) * 8 + ((lane >> 1) & 1) * 4 + (lane & 1) * 2;
        f32x2_t o; o.x = p2[0]; o.y = p2[1];
        *(f32x2_t*)(pd + ((size_t)j * T + t) * 128 + q * 16 + i0) = o;
    }
}
__device__ __forceinline__ void p_gc(const Ctx& C, const float* pd, const float* pgate, float* cc) {
    const int gt = C.bid * NTHR + C.tid, NT = C.G * NTHR;
    for (int i = gt; i < T * 32; i += NT) {
        f32x4 sdot = *(const f32x4*)(pd + (size_t)i * 4);
#pragma unroll
        for (int j = 1; j < 8; ++j) sdot += *(const f32x4*)(pd + (size_t)j * T * 128 + (size_t)i * 4);
        const f32x4 gv = *(const f32x4*)(pgate + (size_t)i * 4);
        f32x4 o; o.x = gelu_f(sdot.x) * gv.x * 0.015625f; o.y = gelu_f(sdot.y) * gv.y * 0.015625f; o.z = gelu_f(sdot.z) * gv.z * 0.015625f; o.w = gelu_f(sdot.w) * gv.w * 0.015625f;
        *(f32x4*)(cc + (size_t)i * 4) = o; }
}
__device__ __forceinline__ void p_gv(const Ctx& C, const float* cc, const unsigned short* pidx, const unsigned char* v8, bf16_t* op) {
    const int j = C.bid & 7, nsl = C.G >> 3, NW = nsl * NWAVES, wsl = (C.bid >> 3) * NWAVES + C.wave, lane = C.lane, s = lane & 7, q = lane >> 3;
    if ((C.bid >> 3) >= nsl) return;
    u32x4 ea, eb; f32x4 c4[4];
    { const int t = wsl; ea = *(const u32x4*)(pidx + (size_t)t * 128 + q * 16); eb = *(const u32x4*)(pidx + (size_t)t * 128 + q * 16 + 8);
#pragma unroll
      for (int d = 0; d < 4; ++d) c4[d] = *(const f32x4*)(cc + (size_t)t * 128 + q * 16 + 4 * d); }
    for (int t = wsl; t < T; t += NW) {
        u32x4 p[16];
#pragma unroll
        for (int i = 0; i < 16; ++i) p[i] = *(const u32x4*)(v8 + (size_t)idx16(ea, eb, i) * 1024 + 128 * j + 16 * s);
        float cv[16];
#pragma unroll
        for (int d = 0; d < 4; ++d) { cv[4 * d] = c4[d].x; cv[4 * d + 1] = c4[d].y; cv[4 * d + 2] = c4[d].z; cv[4 * d + 3] = c4[d].w; }
        { const int tn = (t + NW < T) ? t + NW : t;
          ea = *(const u32x4*)(pidx + (size_t)tn * 128 + q * 16); eb = *(const u32x4*)(pidx + (size_t)tn * 128 + q * 16 + 8);
#pragma unroll
          for (int d = 0; d < 4; ++d) c4[d] = *(const f32x4*)(cc + (size_t)tn * 128 + q * 16 + 4 * d); }
        float acc[16];
#pragma unroll
        for (int c = 0; c < 16; ++c) acc[c] = 0.f;
#pragma unroll
        for (int i = 0; i < 16; ++i) { const float ck = cv[i];
#pragma unroll
            for (int d = 0; d < 4; ++d) { const unsigned wv = p[i][d]; const f32x2_t lo = __builtin_amdgcn_cvt_pk_f32_fp8(wv, false), hi = __builtin_amdgcn_cvt_pk_f32_fp8(wv, true);
                acc[4 * d + 0] += ck * lo.x; acc[4 * d + 1] += ck * lo.y; acc[4 * d + 2] += ck * hi.x; acc[4 * d + 3] += ck * hi.y; }
            asm volatile("" : "+v"(acc[0]), "+v"(acc[1]), "+v"(acc[2]), "+v"(acc[3]), "+v"(acc[4]), "+v"(acc[5]), "+v"(acc[6]), "+v"(acc[7]), "+v"(acc[8]), "+v"(acc[9]), "+v"(acc[10]), "+v"(acc[11]), "+v"(acc[12]), "+v"(acc[13]), "+v"(acc[14]), "+v"(acc[15])); }
        float p8[8]; { const bool hb = (lane & 32) != 0;
#pragma unroll
            for (int i = 0; i < 8; ++i) { const float keep = hb ? acc[i + 8] : acc[i], send = hb ? acc[i] : acc[i + 8]; p8[i] = keep + __shfl_xor(send, 32); } }
        float p4[4]; { const bool hb = (lane & 16) != 0;
#pragma unroll
            for (int i = 0; i < 4; ++i) { const float keep = hb ? p8[i + 4] : p8[i], send = hb ? p8[i] : p8[i + 4]; p4[i] = keep + __shfl_xor(send, 16); } }
        float p2[2]; { const bool hb = (lane & 8) != 0;
#pragma unroll
            for (int i = 0; i < 2; ++i) { const float keep = hb ? p4[i + 2] : p4[i], send = hb ? p4[i] : p4[i + 2]; p2[i] = keep + __shfl_xor(send, 8); } }
        const int c0 = ((lane >> 5) & 1) * 8 + ((lane >> 4) & 1) * 4 + ((lane >> 3) & 1) * 2;
        *(unsigned*)(op + (size_t)t * 1024 + 128 * j + 16 * s + c0) = pk2(p2[0], p2[1]);
    }
}
__device__ __forceinline__ void p_gf(const Ctx& C, const bf16_t* h, const bf16_t* op, float* out) {
    const float* mod = C.f32p(WS_MOD); const float* fg = C.in[23];
    const int gw = C.bid * NWAVES + C.wave, NGW = C.G * NWAVES, lane = C.lane;
    for (int t0 = gw * 2; t0 < T; t0 += NGW * 2) {
        const int b = t0 / SEQ;
        u32x2 ov[2][4], hw[2][4];
#pragma unroll
        for (int r = 0; r < 2; ++r)
#pragma unroll
            for (int d = 0; d < 4; ++d) { const size_t off = (size_t)(t0 + r) * 1024 + 256 * d + 4 * lane; ov[r][d] = *(const u32x2*)(op + off); hw[r][d] = *(const u32x2*)(h + off); }
        f32x4 mv[4], fv[4];
#pragma unroll
        for (int d = 0; d < 4; ++d) { mv[d] = *(const f32x4*)(mod + b * 6144 + 5120 + 256 * d + 4 * lane); fv[d] = *(const f32x4*)(fg + 256 * d + 4 * lane); }
#pragma unroll
        for (int r = 0; r < 2; ++r) { f32x4 hf[4]; float ss = 0.f;
#pragma unroll
            for (int d = 0; d < 4; ++d) { f32x4 hv, o4; hv.x = bflo(hw[r][d].x); hv.y = bfhi(hw[r][d].x); hv.z = bflo(hw[r][d].y); hv.w = bfhi(hw[r][d].y);
                o4.x = bflo(ov[r][d].x); o4.y = bfhi(ov[r][d].x); o4.z = bflo(ov[r][d].y); o4.w = bfhi(ov[r][d].y);
                hf[d] = hv + mv[d] * o4; ss += (hf[d].x * hf[d].x + hf[d].y * hf[d].y) + (hf[d].z * hf[d].z + hf[d].w * hf[d].w); }
            const float rstd = rsqrtf(wave_sum(ss) * (1.f / 1024.f) + EPS);
#pragma unroll
            for (int d = 0; d < 4; ++d) *(f32x4*)(out + (size_t)(t0 + r) * 1024 + 256 * d + 4 * lane) = hf[d] * rstd * fv[d]; }
    }
}

namespace pg8 {
#define PG8_LAS __attribute__((address_space(3)))
typedef unsigned short bf16_t;
typedef short bf16x8 __attribute__((ext_vector_type(8)));
typedef float f32x4 __attribute__((ext_vector_type(4)));
typedef unsigned u32x4 __attribute__((ext_vector_type(4)));
constexpr int BM = 256, BK = 64, HALF = 128, HTB = HALF * BK * 2  , STAGE_BYTES = 8 * HTB, NXCD = 8, WGM = 8;

__host__ __device__ __forceinline__ int lds_byte(int r, int c) { const int st = (r >> 4) * 2 + (c >> 5), rr = r & 15, cc = c & 31, ob = rr * 64 + cc * 2; return st * 1024 + (ob ^ (((ob >> 9) & 1) << 5)); }
__host__ __device__ __forceinline__ void stage_rc(int b, int& R, int& C) { const int st = b / 1024, sb = b % 1024, swz = sb ^ (((sb >> 9) & 1) << 5); R = (st >> 1) * 16 + swz / 64; C = (st & 1) * 32 + (swz % 64) / 2; }
__host__ __device__ __forceinline__ int perm32(int rho) { const int n = rho >> 4, i = rho & 15; return 8 * (i >> 2) + 4 * n + (i & 3); }

struct Unit { int pm, pn, kind; };
struct Gemm { const bf16_t* A; const bf16_t* Bt; int M, N, K; const bf16_t *A1, *B1, *A2, *B2, *A3, *B3; };

struct StaticOrder {
    static constexpr bool MULTI = false;
    int nM, nN, nwg, G, c;
    __host__ __device__ void init(int M, int N, int G_, int c_) { nM = M / BM; nN = N / BM; nwg = nM * nN; G = G_; c = c_; }
    __host__ __device__ bool next(int i, Unit& u) const {
        const long L = (long)i * G + c; if (L >= nwg) return false;
        int wgid = (int)L; { const int q = nwg / NXCD, r = nwg % NXCD, xcd = wgid % NXCD, off = wgid / NXCD; wgid = (xcd < r ? xcd * (q + 1) : r * (q + 1) + (xcd - r) * q) + off; }
        const int nig = WGM * nN, gid = wgid / nig, fm = gid * WGM, gsz = (nM - fm) < WGM ? (nM - fm) : WGM;
        u.pm = fm + ((wgid % nig) % gsz); u.pn = (wgid % nig) / gsz; u.kind = 0; return true;
    }
    __device__ __forceinline__ void a_ready(const Unit&) const {}
    __device__ __forceinline__ void done(const Unit&) const {}
};

struct MultiOrder {
    static constexpr bool MULTI = true;
    StaticOrder b; int nk;
    __host__ __device__ bool next(int i, Unit& u) const { if (!b.next(i / nk, u)) return false; u.kind = i % nk; return true; }
    __device__ __forceinline__ void a_ready(const Unit&) const {}
    __device__ __forceinline__ void done(const Unit&) const {}
};

__device__ __forceinline__ unsigned cvt_pk_bf16(float lo, float hi) { return ::pk2(lo, hi); }
__device__ __forceinline__ float e_silu(float x) { return x / (1.f + __expf(-x)); }
__device__ __forceinline__ float e_sigm(float x) { return 1.f / (1.f + __expf(-x)); }
__device__ __forceinline__ float e_lo(unsigned v) { return __uint_as_float(v << 16); }
__device__ __forceinline__ float e_hi(unsigned v) { return __uint_as_float(v & 0xffff0000u); }
__device__ __forceinline__ u32x4 pack8(const f32x4 v0, const f32x4 v1) { u32x4 w; w.x = cvt_pk_bf16(v0[0], v0[1]); w.y = cvt_pk_bf16(v0[2], v0[3]); w.z = cvt_pk_bf16(v1[0], v1[1]); w.w = cvt_pk_bf16(v1[2], v1[3]); return w; }

struct EpiInProj {
    static constexpr bool PERM = true, AFTER_DRAIN = false;
    bf16_t *sz, *xbc, *q, *k, *v;
    __device__ __forceinline__ void operator()(const f32x4 (&acc)[2][2][4][2], const Unit& u, int wr, int wc, int fr, int fq) const {
        const int pn = u.pn; bf16_t* base; int ldc = 1024, colt, mode = 0;
        if (pn < 4) { base = sz; colt = pn * 256; mode = 1; }
        else if (pn < 12) { base = xbc; ldc = 2048; colt = (pn - 4) * 256; }
        else if (pn < 16) { base = q; colt = (pn - 12) * 256; mode = 2; }
        else if (pn < 20) { base = k; colt = (pn - 16) * 256; }
        else { base = v; colt = (pn - 20) * 256; }
        const int row0 = u.pm * BM + wr * 64 + fr, col0 = colt + wc * 32 + 8 * fq;
#pragma unroll
        for (int ai = 0; ai < 2; ++ai)
#pragma unroll
            for (int m = 0; m < 4; ++m) { bf16_t* rowp = base + (size_t)(row0 + ai * HALF + m * 16) * ldc + col0;
#pragma unroll
                for (int bj = 0; bj < 2; ++bj) { f32x4 v0 = acc[ai][bj][m][0], v1 = acc[ai][bj][m][1];
                    if (mode == 1) {
#pragma unroll
                        for (int i = 0; i < 4; ++i) { v0[i] = e_silu(v0[i]); v1[i] = e_silu(v1[i]); } }
                    else if (mode == 2) { v0 = v0 * 0.125f; v1 = v1 * 0.125f; }
                    *(u32x4*)(rowp + bj * HALF) = pack8(v0, v1); } }
    }
};
struct EpiMix {
    static constexpr bool PERM = true, AFTER_DRAIN = false;
    bf16_t *sg1, *sg2, *mixed; const float* rstd;
    __device__ __forceinline__ bool operator()(f32x4 (&acc)[2][2][4][2], const Unit& u, int wr, int wc, int fr, int fq) const {
        const int row0 = u.pm * BM + wr * 64 + fr, col0 = u.pn * BM + wc * 32 + 8 * fq; const int kind = u.kind;
#pragma unroll
        for (int ai = 0; ai < 2; ++ai)
#pragma unroll
            for (int m = 0; m < 4; ++m) { const int row = row0 + ai * HALF + m * 16; const size_t off = (size_t)row * 1024 + col0;
                const float rs = (kind == 2) ? rstd[row] : 1.f;
#pragma unroll
                for (int bj = 0; bj < 2; ++bj) { f32x4 v0 = acc[ai][bj][m][0], v1 = acc[ai][bj][m][1];
                    if (kind < 2) {
#pragma unroll
                        for (int i = 0; i < 4; ++i) { v0[i] = e_sigm(v0[i]); v1[i] = e_sigm(v1[i]); }
                        *(u32x4*)((kind == 0 ? sg1 : sg2) + off + bj * HALF) = pack8(v0, v1);
                    } else if (kind == 2) {
                        const u32x4 a = *(const u32x4*)(sg1 + off + bj * HALF), b = *(const u32x4*)(sg2 + off + bj * HALF);
                        v0[0] *= rs * e_lo(a.x) / fmaxf(e_lo(b.x), 1e-30f); v0[1] *= rs * e_hi(a.x) / fmaxf(e_hi(b.x), 1e-30f); v0[2] *= rs * e_lo(a.y) / fmaxf(e_lo(b.y), 1e-30f); v0[3] *= rs * e_hi(a.y) / fmaxf(e_hi(b.y), 1e-30f);
                        v1[0] *= rs * e_lo(a.z) / fmaxf(e_lo(b.z), 1e-30f); v1[1] *= rs * e_hi(a.z) / fmaxf(e_hi(b.z), 1e-30f); v1[2] *= rs * e_lo(a.w) / fmaxf(e_lo(b.w), 1e-30f); v1[3] *= rs * e_hi(a.w) / fmaxf(e_hi(b.w), 1e-30f);
                        acc[ai][bj][m][0] = v0; acc[ai][bj][m][1] = v1;
                    } else {
                        const u32x4 b = *(const u32x4*)(sg2 + off + bj * HALF);
                        v0[0] *= e_lo(b.x); v0[1] *= e_hi(b.x); v0[2] *= e_lo(b.y); v0[3] *= e_hi(b.y); v1[0] *= e_lo(b.z); v1[1] *= e_hi(b.z); v1[2] *= e_lo(b.w); v1[3] *= e_hi(b.w);
                        *(u32x4*)(mixed + off + bj * HALF) = pack8(v0, v1);
                    } } }
        return kind == 2;
    }
};
struct EpiD3 {
    static constexpr bool PERM = true, AFTER_DRAIN = false;
    bf16_t* h; const float* x; const float* mod;
    __device__ __forceinline__ void operator()(const f32x4 (&acc)[2][2][4][2], const Unit& u, int wr, int wc, int fr, int fq) const {
        const int row0 = u.pm * BM + wr * 64 + fr, col0 = u.pn * BM + wc * 32 + 8 * fq;
        const float* g1 = mod + (size_t)((u.pm * BM) >> 12) * 6144 + 2048;
#pragma unroll
        for (int ai = 0; ai < 2; ++ai)
#pragma unroll
            for (int m = 0; m < 4; ++m) { const size_t off = (size_t)(row0 + ai * HALF + m * 16) * 1024 + col0;
#pragma unroll
                for (int bj = 0; bj < 2; ++bj) { const int c = bj * HALF;
                    const f32x4 x0 = *(const f32x4*)(x + off + c), x1 = *(const f32x4*)(x + off + c + 4), g0 = *(const f32x4*)(g1 + col0 + c), g4 = *(const f32x4*)(g1 + col0 + c + 4);
                    *(u32x4*)(h + off + c) = pack8(x0 + g0 * acc[ai][bj][m][0], x1 + g4 * acc[ai][bj][m][1]); } }
    }
};
struct EpiQp {
    static constexpr bool PERM = true, AFTER_DRAIN = false;
    bf16_t* qp;
    __device__ __forceinline__ void operator()(const f32x4 (&acc)[2][2][4][2], const Unit& u, int wr, int wc, int fr, int fq) const {
        const int row0 = u.pm * BM + wr * 64 + fr, col0 = u.pn * BM + wc * 32 + 8 * fq;
#pragma unroll
        for (int ai = 0; ai < 2; ++ai)
#pragma unroll
            for (int m = 0; m < 4; ++m) { bf16_t* rowp = qp + (size_t)(row0 + ai * HALF + m * 16) * 2048 + col0;
#pragma unroll
                for (int bj = 0; bj < 2; ++bj) *(u32x4*)(rowp + bj * HALF) = pack8(acc[ai][bj][m][0], acc[ai][bj][m][1]); }
    }
};

template <class Epi, class Sched, bool ALIGN_EPI = false, bool SP2 = false>
__device__ __forceinline__ void gemm_phase(PG8_LAS unsigned char* lds, const Gemm g, const Sched& S, const Epi& E) {
    const int tid = threadIdx.x, wid = __builtin_amdgcn_readfirstlane(tid >> 6), lane = tid & 63, wr = wid >> 2, wc = wid & 3, fr = lane & 15, fq = lane >> 4;
    const int K = g.K, nt = K / BK;
    unsigned voffA[2], voffB[2];
#pragma unroll
    for (int i = 0; i < 2; ++i) { int R, C; stage_rc(tid * 16 + i * 8192, R, C); const int Rb = Epi::PERM ? ((R & ~31) + perm32(R & 31)) : R;
        voffA[i] = (unsigned)(R * K + C) * 2u; voffB[i] = (unsigned)(Rb * K + C) * 2u; }
    const size_t kstep = (size_t)(BK * 2);
    const size_t hstep = (size_t)HALF * K * 2;
    const size_t tstep = 2 * hstep;
    const unsigned ldsw = (unsigned)wid * 1024u;
    const int aoff = lds_byte(wr * 64 + fr, fq * 8), boff = lds_byte(wc * 32 + fr, fq * 8);
#define PG8_SA(b, h) (((b) * 2 + (h)) * HTB)
#define PG8_SB(b, h) ((4 + (b) * 2 + (h)) * HTB)
#define PG8_STAGE(bufoff, gbase, voff) do { _Pragma("unroll") for (int _i = 0; _i < 2; ++_i) \
        __builtin_amdgcn_global_load_lds((const unsigned*)((const char*)(gbase) + (voff)[_i]), (PG8_LAS unsigned*)(lds + (bufoff) + ldsw + _i * 8192), 16, 0, 0); } while (0)
#define PG8_LDA(dst, b, h) do { _Pragma("unroll") for (int m = 0; m < 4; ++m) _Pragma("unroll") for (int k = 0; k < 2; ++k) dst[m][k] = *(const PG8_LAS bf16x8*)(lds + PG8_SA(b, h) + aoff + m * 2048 + k * 1024); } while (0)
#define PG8_LDB(dst, b, h) do { _Pragma("unroll") for (int n = 0; n < 2; ++n) _Pragma("unroll") for (int k = 0; k < 2; ++k) dst[n][k] = *(const PG8_LAS bf16x8*)(lds + PG8_SB(b, h) + boff + n * 2048 + k * 1024); } while (0)
#define PG8_MMA(ai, bj, At, Bt) do { __builtin_amdgcn_s_setprio(1); _Pragma("unroll") for (int m = 0; m < 4; ++m) _Pragma("unroll") for (int n = 0; n < 2; ++n) _Pragma("unroll") for (int k = 0; k < 2; ++k) \
        acc[ai][bj][m][n] = __builtin_amdgcn_mfma_f32_16x16x32_bf16(Bt[n][k], At[m][k], acc[ai][bj][m][n], 0, 0, 0); __builtin_amdgcn_s_setprio(0); } while (0)
#define PG8_WAIT_V(n) asm volatile("s_waitcnt vmcnt(" #n ")" ::: "memory")
#define PG8_WAIT_L(n) asm volatile("s_waitcnt lgkmcnt(" #n ")" ::: "memory")
#define PG8_BAR __builtin_amdgcn_s_barrier()
#define PG8_SCHED __builtin_amdgcn_sched_barrier(0)
    Unit cur, nxt; int ui = 0;
    if (!S.next(0, cur)) return;
    f32x4 acc[2][2][4][2];
#pragma unroll
    for (int a = 0; a < 2; ++a)
#pragma unroll
        for (int b = 0; b < 2; ++b)
#pragma unroll
            for (int m = 0; m < 4; ++m)
#pragma unroll
                for (int n = 0; n < 2; ++n) acc[a][b][m][n] = (f32x4){0.f, 0.f, 0.f, 0.f};
    bf16x8 At[4][2], B0[2][2], B1[2][2];
#define PG8_AB(u_) (Sched::MULTI ? (const char*)((u_).kind == 0 ? g.A : (u_).kind == 1 ? g.A1 : (u_).kind == 2 ? g.A2 : g.A3) : (const char*)g.A)
#define PG8_BB(u_) (Sched::MULTI ? (const char*)((u_).kind == 0 ? g.Bt : (u_).kind == 1 ? g.B1 : (u_).kind == 2 ? g.B2 : g.B3) : (const char*)g.Bt)
    const char* cA = PG8_AB(cur) + (size_t)cur.pm * tstep; const char* cB = PG8_BB(cur) + (size_t)cur.pn * tstep;
    S.a_ready(cur);
    if constexpr (SP2) {
        PG8_STAGE(PG8_SB(0, 0), cB, voffB); PG8_STAGE(PG8_SB(0, 1), cB + hstep, voffB); PG8_STAGE(PG8_SA(0, 0), cA, voffA); PG8_STAGE(PG8_SA(0, 1), cA + hstep, voffA);
        if (wr == 1) PG8_BAR;
        PG8_WAIT_V(2); PG8_BAR;
        PG8_STAGE(PG8_SB(1, 0), cB + kstep, voffB); PG8_STAGE(PG8_SA(1, 0), cA + kstep, voffA); PG8_STAGE(PG8_SB(1, 1), cB + hstep + kstep, voffB);
        PG8_WAIT_V(6); PG8_BAR;
    } else {
        PG8_STAGE(PG8_SB(0, 0), cB, voffB); PG8_STAGE(PG8_SA(0, 0), cA, voffA); PG8_STAGE(PG8_SB(0, 1), cB + hstep, voffB); PG8_STAGE(PG8_SA(0, 1), cA + hstep, voffA);
        if (wr == 1) PG8_BAR;
        PG8_WAIT_V(4); PG8_BAR;
        PG8_STAGE(PG8_SB(1, 0), cB + kstep, voffB); PG8_STAGE(PG8_SA(1, 0), cA + kstep, voffA); PG8_STAGE(PG8_SB(1, 1), cB + hstep + kstep, voffB);
        PG8_WAIT_V(6); PG8_BAR;
    }
    for (;;) {
        const bool has_next = S.next(ui + 1, nxt);
        const char* nA = has_next ? PG8_AB(nxt) + (size_t)nxt.pm * tstep : cA; const char* nB = has_next ? PG8_BB(nxt) + (size_t)nxt.pn * tstep : cB;
        for (int t = 0; t < nt; t += 2) {
            const bool last = (t == nt - 2);
            const char* a1 = cA + (size_t)(t + 1) * kstep;
            const char* a2 = last ? nA : cA + (size_t)(t + 2) * kstep; const char* b2 = last ? nB : cB + (size_t)(t + 2) * kstep;
            const char* a3 = a2 + kstep; const char* b3 = b2 + kstep;
            if (last && has_next) S.a_ready(nxt);
            if constexpr (SP2) {
            PG8_LDB(B0, 0, 0); PG8_LDB(B1, 0, 1); PG8_SCHED; PG8_LDA(At, 0, 0); PG8_STAGE(PG8_SA(1, 1), a1 + hstep, voffA);
            PG8_WAIT_V(8); PG8_WAIT_L(0); PG8_BAR; PG8_MMA(0, 0, At, B0); PG8_MMA(0, 1, At, B1); PG8_BAR; PG8_SCHED;
            PG8_LDA(At, 0, 1); PG8_STAGE(PG8_SB(0, 0), b2, voffB); PG8_STAGE(PG8_SB(0, 1), b2 + hstep, voffB); PG8_STAGE(PG8_SA(0, 0), a2, voffA);
            PG8_WAIT_V(8); PG8_WAIT_L(0); PG8_BAR; PG8_MMA(1, 0, At, B0); PG8_MMA(1, 1, At, B1); PG8_BAR; PG8_SCHED;
            PG8_LDB(B0, 1, 0); PG8_LDB(B1, 1, 1); PG8_SCHED; PG8_LDA(At, 1, 0); PG8_STAGE(PG8_SA(0, 1), a2 + hstep, voffA);
            PG8_WAIT_V(8); PG8_WAIT_L(0); PG8_BAR; PG8_MMA(0, 0, At, B0); PG8_MMA(0, 1, At, B1); PG8_BAR; PG8_SCHED;
            PG8_LDA(At, 1, 1); PG8_STAGE(PG8_SB(1, 0), b3, voffB); PG8_STAGE(PG8_SB(1, 1), b3 + hstep, voffB); PG8_STAGE(PG8_SA(1, 0), a3, voffA);
            PG8_WAIT_V(8); PG8_WAIT_L(0); PG8_BAR; PG8_MMA(1, 0, At, B0); PG8_MMA(1, 1, At, B1); PG8_BAR; PG8_SCHED;
            } else {
            PG8_LDB(B0, 0, 0); PG8_SCHED; PG8_LDA(At, 0, 0); PG8_STAGE(PG8_SA(1, 1), a1 + hstep, voffA);
            PG8_WAIT_L(8); PG8_BAR; PG8_WAIT_L(0); PG8_MMA(0, 0, At, B0); PG8_BAR; PG8_SCHED;
            PG8_LDB(B1, 0, 1); PG8_STAGE(PG8_SB(0, 0), b2, voffB);
            PG8_BAR; PG8_WAIT_L(0); PG8_MMA(0, 1, At, B1); PG8_BAR;
            PG8_LDA(At, 0, 1); PG8_STAGE(PG8_SA(0, 0), a2, voffA);
            PG8_BAR; PG8_WAIT_L(0); PG8_MMA(1, 0, At, B0); PG8_BAR; PG8_SCHED;
            PG8_STAGE(PG8_SB(0, 1), b2 + hstep, voffB);
            PG8_WAIT_V(6); PG8_BAR; PG8_MMA(1, 1, At, B1); PG8_BAR;
            PG8_LDB(B0, 1, 0); PG8_SCHED; PG8_LDA(At, 1, 0); PG8_STAGE(PG8_SA(0, 1), a2 + hstep, voffA);
            PG8_WAIT_L(8); PG8_BAR; PG8_WAIT_L(0); PG8_MMA(0, 0, At, B0); PG8_BAR; PG8_SCHED;
            PG8_LDB(B1, 1, 1); PG8_STAGE(PG8_SB(1, 0), b3, voffB);
            PG8_BAR; PG8_WAIT_L(0); PG8_MMA(0, 1, At, B1); PG8_BAR;
            PG8_LDA(At, 1, 1); PG8_STAGE(PG8_SA(1, 0), a3, voffA);
            PG8_BAR; PG8_WAIT_L(0); PG8_MMA(1, 0, At, B0); PG8_BAR; PG8_SCHED;
            PG8_STAGE(PG8_SB(1, 1), b3 + hstep, voffB);
            PG8_WAIT_V(6); PG8_BAR; PG8_MMA(1, 1, At, B1); PG8_BAR;
            }
        }
        if constexpr (ALIGN_EPI) { if (wr == 0) PG8_BAR; }
        bool keep_acc = false;
        if constexpr (!Epi::AFTER_DRAIN) { if constexpr (Sched::MULTI) keep_acc = E(acc, cur, wr, wc, fr, fq); else E(acc, cur, wr, wc, fr, fq); S.done(cur); }
        if (!has_next) break;
        if (!keep_acc) {
#pragma unroll
        for (int a = 0; a < 2; ++a)
#pragma unroll
            for (int b = 0; b < 2; ++b)
#pragma unroll
                for (int m = 0; m < 4; ++m)
#pragma unroll
                    for (int n = 0; n < 2; ++n) acc[a][b][m][n] = (f32x4){0.f, 0.f, 0.f, 0.f};
        }
        cur = nxt; cA = nA; cB = nB; ++ui;
        if constexpr (ALIGN_EPI) { if (wr == 1) PG8_BAR; }
    }
    PG8_WAIT_V(0);
    if constexpr (!ALIGN_EPI) { if (wr == 0) PG8_BAR; }
    PG8_BAR;
    if constexpr (Epi::AFTER_DRAIN) { E.fused(acc, cur, wr, wc, fr, fq, lds, wid, lane); S.done(cur); }
#undef PG8_AB
#undef PG8_BB
#undef PG8_SA
#undef PG8_SB
#undef PG8_STAGE
#undef PG8_LDA
#undef PG8_LDB
#undef PG8_MMA
#undef PG8_WAIT_V
#undef PG8_WAIT_L
#undef PG8_BAR
#undef PG8_SCHED
}
}


#define GAS __attribute__((address_space(1)))
typedef GAS unsigned gu32;
#define RLX_AGENT __ATOMIC_RELAXED, __HIP_MEMORY_SCOPE_AGENT
#define XB_TMO      128
#define XB_XCNT(j)  (256  + 64 * (j))
#define XB_XSUB(j)  (1280 + 64 * (j))
#define XB_XGEN(j)  (2304 + 64 * (j))
#define XB_TOP      3328
#define XB_TOPGEN   3392
#define XCD_BAR_WORDS 3456
#define XB_SPIN_CAP (1u << 18)

__device__ __forceinline__ unsigned xb_ld(unsigned* p)              { return __hip_atomic_load(p, __ATOMIC_RELAXED, __HIP_MEMORY_SCOPE_AGENT); }
__device__ __forceinline__ unsigned xb_add(unsigned* p, unsigned v) { return __hip_atomic_fetch_add(p, v, __ATOMIC_RELAXED, __HIP_MEMORY_SCOPE_AGENT); }
__device__ __forceinline__ unsigned xb_xcc_id() { return (unsigned)__builtin_amdgcn_s_getreg((3 << 11) | 20) & 0xFu; }
#define XB_SPIN(cond, bar) do { unsigned _sp = 0; while (cond) { __builtin_amdgcn_s_sleep(1); \
    if ((++_sp & 255u) == 0u) { if (xb_ld(&(bar)[XB_TMO])) break; if (_sp > XB_SPIN_CAP) { atomicAdd(&(bar)[XB_TMO], 1u); break; } } } } while (0)

struct XcdBarrier {
    unsigned* bar; unsigned x;
    volatile LAS unsigned* st;
};

__device__ __forceinline__ XcdBarrier xcd_barrier_post(unsigned* bar, volatile LAS unsigned* st) {
    XcdBarrier b; b.bar = bar; b.x = xb_xcc_id(); b.st = st;
    if (threadIdx.x == 0) (void)xb_add(&bar[XB_XCNT(b.x)], 1u);
    return b;
}
__device__ __forceinline__ void xcd_barrier_complete(unsigned* bar, unsigned x, unsigned& nloc, unsigned& nx) {
    const unsigned G = gridDim.x * gridDim.y * gridDim.z;
    unsigned sum, cnt, mine, sp = 0u;
    for (;;) {
        sum = 0u; cnt = 0u; mine = 0u;
#pragma unroll
        for (unsigned j = 0; j < 16; ++j) { const unsigned c = xb_ld(&bar[XB_XCNT(j)]); sum += c; cnt += (c > 0u) ? 1u : 0u; mine = (j == x) ? c : mine; }
        if (sum == G) break;
        __builtin_amdgcn_s_sleep(1);
        if ((++sp & 255u) == 0u) { if (xb_ld(&bar[XB_TMO])) break; if (sp > XB_SPIN_CAP) { atomicAdd(&bar[XB_TMO], 1u); break; } }
    }
    nloc = mine > 0u ? mine : 1u; nx = cnt > 0u ? cnt : 1u;
}

__device__ __forceinline__ void xcd_barrier(const XcdBarrier& b) {
    asm volatile("s_waitcnt vmcnt(0)" ::: "memory");
    __syncthreads();
    if (threadIdx.x == 0) {
        unsigned* bar = b.bar;
        __builtin_amdgcn_s_waitcnt(0);
        unsigned nloc = b.st[0], nx = b.st[1];
        if (nloc == 0u) { xcd_barrier_complete(bar, b.x, nloc, nx); b.st[0] = nloc; b.st[1] = nx; }
        const unsigned old = xb_add(&bar[XB_XSUB(b.x)], 1u);
        const unsigned gen = old / nloc;
        if (old + 1u == (gen + 1u) * nloc) {
            __builtin_amdgcn_fence(__ATOMIC_RELEASE, "agent");
            asm volatile("s_waitcnt vmcnt(0)" ::: "memory");
            const unsigned og = xb_add(&bar[XB_TOP], 1u);
            const unsigned tg = og / nx;
            if (og + 1u == (tg + 1u) * nx) xb_add(&bar[XB_TOPGEN], 1u);
            else XB_SPIN(xb_ld(&bar[XB_TOPGEN]) == tg, bar);
            __builtin_amdgcn_fence(__ATOMIC_ACQUIRE, "agent");
            xb_add(&bar[XB_XGEN(b.x)], 1u);
            asm volatile("s_waitcnt vmcnt(0)" ::: "memory");
        } else {
            XB_SPIN(xb_ld(&bar[XB_XGEN(b.x)]) == gen, bar);
            __builtin_amdgcn_fence(__ATOMIC_ACQUIRE, "agent");
            asm volatile("s_waitcnt vmcnt(0)" ::: "memory");
        }
    }
    __syncthreads();
}


constexpr int N_PHASES = 15;
constexpr int CW_BAR = 4096;
constexpr size_t CTL_ZERO_BYTES = 64 * 1024;
constexpr int MISC_OFF = LDS_BYTES - 256;

template <int PH>
__device__ __forceinline__ void run_phase(const Ctx& C, const Args& a) {
    bf16_t* R0 = C.bfp(WS_R0); bf16_t* R1 = C.bfp(WS_R1); bf16_t* R2 = C.bfp(WS_R2); bf16_t* R3 = C.bfp(WS_R3);
    bf16_t* OB = (bf16_t*)a.out;
    const size_t TD = (size_t)T * 1024;
    if constexpr (PH == 0) p_prep(C);
    if constexpr (PH == 1) p_rownorm(C, C.in[0], C.in[4], 0, 1024, R0);
    if constexpr (PH == 2) {
        { pg8::Gemm g{R0, C.bfp(WS_WIN_T), T, 6144, 1024}; pg8::StaticOrder S; S.init(T, 6144, C.G, C.bid);
          pg8::EpiInProj e{R1, R2, R3, R3 + TD, R3 + 2 * TD};
          pg8::gemm_phase<pg8::EpiInProj, pg8::StaticOrder, true, true>(C.lds, g, S, e); }
        p_dt(C, R0, C.bfp(WS_WDT_T), C.f32p(WS_DT));
    }
    if constexpr (PH == 3) { p_conv(C, R2, OB); p_na(C, R3, R3 + TD, R3 + 2 * TD); }
    if constexpr (PH == 4) p_ssd(C, OB, C.f32p(WS_DT), R2, R2 + TD);
    if constexpr (PH == 5) p_combine(C, R2, R2 + TD, R1, C.f32p(WS_RSTD));
    if constexpr (PH == 6) {
        pg8::MultiOrder S; S.b.init(T, 1024, C.G, C.bid); S.nk = 4;
        pg8::Gemm g{R0, C.bfp(WS_WG_T), T, 1024, 1024, R0, C.bfp(WS_WG_T) + (size_t)1024 * 1024, R1, C.bfp(WS_WSSD_T), R3, C.bfp(WS_WNA_T)};
        pg8::EpiMix e{OB, OB + TD, R2 + TD, C.f32p(WS_RSTD)};
        pg8::gemm_phase<pg8::EpiMix, pg8::MultiOrder, true, true>(C.lds, g, S, e);
    }
    if constexpr (PH == 7) { pg8::Gemm g{R2 + TD, C.bfp(WS_WOUT_T), T, 1024, 1024}; pg8::StaticOrder S; S.init(T, 1024, C.G, C.bid);
        pg8::EpiD3 e{R3 + TD, C.in[0], C.f32p(WS_MOD)}; pg8::gemm_phase<pg8::EpiD3, pg8::StaticOrder, true, true>(C.lds, g, S, e); }
    if constexpr (PH == 8) { p_rownorm_b(C, R3 + TD, C.in[18], 3072, 4096, R0); p_cvt_tables8(C, (unsigned char*)R2, (unsigned char*)R2 + (size_t)16384 * 1024); }
    if constexpr (PH == 9) { pg8::Gemm g{R0, C.bfp(WS_WPQ_T), T, 2048, 1024}; pg8::StaticOrder S; S.init(T, 2048, C.G, C.bid);
        pg8::EpiQp e{OB}; pg8::gemm_phase<pg8::EpiQp, pg8::StaticOrder, true, true>(C.lds, g, S, e); }
    if constexpr (PH == 10) p_topk(C, OB, C.bfp(WS_KEYS), (unsigned short*)R1, (float*)(R1 + 4 * MiB));
    if constexpr (PH == 11) p_gu(C, R0, (const unsigned short*)R1, (const unsigned char*)R2, a.out);
    if constexpr (PH == 12) p_gc(C, a.out, (const float*)(R1 + 4 * MiB), (float*)((unsigned char*)R2 + 32 * MiB));
    if constexpr (PH == 13) p_gv(C, (const float*)((unsigned char*)R2 + 32 * MiB), (const unsigned short*)R1, (const unsigned char*)R2 + (size_t)16384 * 1024, R3);
    if constexpr (PH == 14) p_gf(C, R3 + TD, R3, a.out);
}

template <int PH> struct PhaseLoop {
    static __device__ __forceinline__ void run(const Ctx& C, const Args& a, const XcdBarrier& bar) {
        if (PH >= a.ph_lo && PH < a.ph_hi) { run_phase<PH>(C, a); if (PH + 1 < a.ph_hi) xcd_barrier(bar); }
        PhaseLoop<PH + 1>::run(C, a, bar);
    }
};
template <> struct PhaseLoop<N_PHASES> { static __device__ __forceinline__ void run(const Ctx&, const Args&, const XcdBarrier&) {} };

__global__ void __launch_bounds__(NTHR, 2) mega(Args a) {
    extern __shared__ __attribute__((aligned(16))) unsigned char lds_raw[];
    Ctx C; C.in = a.in; C.out = a.out; C.ws = a.ws; C.tid = threadIdx.x; C.lane = C.tid & 63; C.wave = __builtin_amdgcn_readfirstlane(C.tid >> 6);
    C.G = gridDim.x; C.bid = blockIdx.x; C.lds = (LAS unsigned char*)lds_raw;
    volatile LAS unsigned* MISC = (volatile LAS unsigned*)(C.lds + MISC_OFF);
    if (C.tid < 64) MISC[C.tid] = 0u;
    __syncthreads();
    XcdBarrier bar; bar.bar = (unsigned*)(a.ws + WS_CTL) + CW_BAR; bar.x = 0; bar.st = nullptr;
    if (a.ph_hi - a.ph_lo > 1) bar = xcd_barrier_post((unsigned*)(a.ws + WS_CTL) + CW_BAR, MISC + 8);
    PhaseLoop<0>::run(C, a, bar);
}

extern "C" void kernel_launch(void* const* d_in, const int* in_sizes, int n_in, void* d_out, int out_size, void* d_ws, size_t ws_size, hipStream_t stream) {
    static int grid = 0;
    if (grid == 0) {
        if (n_in != 24 || out_size != T * D || ws_size < WS_END) { fprintf(stderr, "kernel_launch: unexpected shapes n_in %d out %d ws %zu\n", n_in, out_size, ws_size); grid = -1; return; }
        int dev = 0, cus = 0;
        if (hipGetDevice(&dev) != hipSuccess || hipDeviceGetAttribute(&cus, hipDeviceAttributeMultiprocessorCount, dev) != hipSuccess) { grid = -1; return; }
        if (hipFuncSetAttribute((const void*)mega, hipFuncAttributeMaxDynamicSharedMemorySize, LDS_BYTES) != hipSuccess) { grid = -1; return; }
        grid = cus;
    }
    if (grid < 0) return;
    (void)hipMemsetAsync((char*)d_ws + WS_CTL, 0, CTL_ZERO_BYTES, stream);
    Args a{};
    for (int i = 0; i < 24; ++i) a.in[i] = (const float*)d_in[i];
    a.out = (float*)d_out; a.ws = (unsigned char*)d_ws;
    a.ph_lo = 0; a.ph_hi = N_PHASES;
    hipLaunchKernelGGL(mega, dim3(grid), dim3(NTHR), LDS_BYTES, stream, a);
}
```

```cpp
#include <hip/hip_runtime.h>
#include <cstdio>
#include <cstdint>

#define LAS __attribute__((address_space(3)))
typedef unsigned short bf16_t;
typedef float f32x4 __attribute__((ext_vector_type(4)));
typedef unsigned u32x4 __attribute__((ext_vector_type(4)));
typedef unsigned u32x2 __attribute__((ext_vector_type(2)));
typedef __bf16 bf16x2_t __attribute__((ext_vector_type(2)));

constexpr int T = 32768, D = 1024, NB = 8, SEQ = 4096;
constexpr int NWAVES = 8, NTHR = 512;
constexpr float EPS = 1e-6f;
constexpr int OFF_Z = 0, OFF_XBC = 1024, OFF_DTF = 3072, OFF_DTB = 3088, OFF_QKV = 3104, OFF_GS = 6176, OFF_GN = 7200, D_IN = 8224;

constexpr size_t MiB = 1u << 20;
constexpr size_t WS_CTL = 0;
constexpr size_t WS_MOD = 1 * MiB;
constexpr size_t WS_RSTD = 1 * MiB + 512 * 1024;
constexpr size_t WS_DT = 2 * MiB;
constexpr size_t WS_WIN_T = 6 * MiB;
constexpr size_t WS_WG_T = 18 * MiB;
constexpr size_t WS_WDT_T = 22 * MiB;
constexpr size_t WS_KEYS = 22 * MiB + 512 * 1024;
constexpr size_t WS_WSSD_T = 23 * MiB, WS_WNA_T = 25 * MiB, WS_WOUT_T = 27 * MiB, WS_WPQ_T = 29 * MiB;
constexpr size_t WS_R0 = 40 * MiB, WS_R1 = 104 * MiB, WS_R2 = 168 * MiB, WS_R3 = 296 * MiB, WS_END = 488 * MiB;

constexpr int LDS_BYTES = 163840;

struct Args { const float* in[24]; float* out; unsigned char* ws; int ph_lo, ph_hi; };

__device__ __forceinline__ float bf2f(unsigned v) { return __uint_as_float(v << 16); }
__device__ __forceinline__ float bflo(unsigned v) { return __uint_as_float(v << 16); }
__device__ __forceinline__ float bfhi(unsigned v) { return __uint_as_float(v & 0xffff0000u); }
__device__ __forceinline__ unsigned f2bf(float f) { unsigned u = __float_as_uint(f); return (u + 0x7fffu + ((u >> 16) & 1u)) >> 16; }
typedef float f32x2_t __attribute__((ext_vector_type(2)));
__device__ __forceinline__ unsigned pk2(float lo, float hi) { f32x2_t v = {lo, hi}; bf16x2_t b = __builtin_convertvector(v, bf16x2_t); return __builtin_bit_cast(unsigned, b); }
__device__ __forceinline__ float wave_sum(float v) {
#pragma unroll
    for (int o = 1; o < 64; o <<= 1) v += __shfl_xor(v, o);
    return v;
}
__device__ __forceinline__ float silu_f(float x) { return x / (1.f + __expf(-x)); }
__device__ __forceinline__ float sigmoid_f(float x) { return 1.f / (1.f + __expf(-x)); }
__device__ __forceinline__ float softplus_f(float x) { return x > 20.f ? x : log1pf(__expf(x)); }
__device__ __forceinline__ float gelu_f(float x) { return 0.5f * x * (1.f + erff(x * 0.70710678118654752f)); }

struct Ctx {
    const float* const* in; float* out; unsigned char* ws;
    int tid, lane, wave, G, bid;
    LAS unsigned char* lds;
    __device__ __forceinline__ float* f32p(size_t off) const { return (float*)(ws + off); }
    __device__ __forceinline__ bf16_t* bfp(size_t off) const { return (bf16_t*)(ws + off); }
};

__device__ __forceinline__ void tr_item(const float* W, int ldw, int col0, int K, bf16_t* WT, int row_off, LAS float* scr, int item, int nblk, int lane, const float* kscale) {
    const int kb = item / nblk, nb = item % nblk, k0 = 64 * kb, n0 = 32 * nb;
#pragma unroll 8
    for (int i = 0; i < 32; ++i) { const int kk = 2 * i + (lane >> 5); float x = W[(size_t)(k0 + kk) * ldw + col0 + n0 + (lane & 31)]; if (kscale) x *= kscale[k0 + kk]; scr[kk * 33 + (lane & 31)] = x; }
    asm volatile("s_waitcnt lgkmcnt(0)" ::: "memory");
    const int c = lane & 7;
#pragma unroll
    for (int j = 0; j < 4; ++j) { const int n = (lane >> 3) + 8 * j; const LAS float* sp = scr + (8 * c) * 33 + n;
        u32x4 o; o.x = pk2(sp[0 * 33], sp[1 * 33]); o.y = pk2(sp[2 * 33], sp[3 * 33]); o.z = pk2(sp[4 * 33], sp[5 * 33]); o.w = pk2(sp[6 * 33], sp[7 * 33]);
        *(u32x4*)(WT + (size_t)(row_off + n0 + n) * K + k0 + 8 * c) = o; }
    asm volatile("s_waitcnt lgkmcnt(0)" ::: "memory");
}
__device__ __forceinline__ void p_prep(const Ctx& C) {
    const float* c = C.in[1]; const float* w_ada = C.in[2]; const float* b_ada = C.in[3];
    float* mod = C.f32p(WS_MOD);
    LAS float* sc = (LAS float*)C.lds;
    LAS float* red = sc + 8192;
    for (int i = C.tid; i < 8192; i += NTHR) sc[i] = silu_f(c[i]);
    __syncthreads();
    for (int jb = C.bid; jb < 256; jb += C.G) {
        const int j0 = jb * 24, jl = C.tid % 24, kq = C.tid / 24;
        if (C.tid < 504) { float acc[8];
#pragma unroll
            for (int b = 0; b < 8; ++b) acc[b] = 0.f;
            for (int k = kq; k < 1024; k += 21) { const float w = w_ada[(size_t)k * 6144 + j0 + jl];
#pragma unroll
                for (int b = 0; b < 8; ++b) acc[b] += sc[b * 1024 + k] * w; }
#pragma unroll
            for (int b = 0; b < 8; ++b) red[(kq * 24 + jl) * 8 + b] = acc[b]; }
        __syncthreads();
        if (C.tid < 192) { const int jl2 = C.tid % 24, b2 = C.tid / 24; float sacc = b_ada[j0 + jl2];
            for (int kq2 = 0; kq2 < 21; ++kq2) sacc += red[(kq2 * 24 + jl2) * 8 + b2];
            mod[b2 * 6144 + j0 + jl2] = sacc; }
        __syncthreads();
    }
    LAS float* scr = (LAS float*)(C.lds + 65536 + C.wave * 8448);
    const int gw = C.bid * NWAVES + C.wave, NGW = C.G * NWAVES;
    const float* w_in = C.in[5];
    constexpr int I_A = 16 * 96, I_B = 16 * 96, I_G = 16 * 64, I_DT = 16, I_S = 16 * 32, I_PQ = 16 * 64;
    constexpr int NIT = I_A + I_B + I_G + I_DT + 3 * I_S + I_PQ;
    for (int it = gw; it < NIT; it += NGW) {
        int r = it;
        if (r < I_A) { tr_item(w_in, D_IN, 0, D, C.bfp(WS_WIN_T), 0, scr, r, 96, C.lane, nullptr); continue; } r -= I_A;
        if (r < I_B) { tr_item(w_in, D_IN, OFF_QKV, D, C.bfp(WS_WIN_T), 3072, scr, r, 96, C.lane, nullptr); continue; } r -= I_B;
        if (r < I_G) { tr_item(w_in, D_IN, OFF_GS, D, C.bfp(WS_WG_T), 0, scr, r, 64, C.lane, nullptr); continue; } r -= I_G;
        if (r < I_DT) { tr_item(w_in, D_IN, OFF_DTF, D, C.bfp(WS_WDT_T), 0, scr, r, 1, C.lane, nullptr); continue; } r -= I_DT;
        if (r < I_S) { tr_item(C.in[14], D, 0, D, C.bfp(WS_WSSD_T), 0, scr, r, 32, C.lane, C.in[13]); continue; } r -= I_S;
        if (r < I_S) { tr_item(C.in[16], D, 0, D, C.bfp(WS_WNA_T), 0, scr, r, 32, C.lane, nullptr); continue; } r -= I_S;
        if (r < I_S) { tr_item(C.in[17], D, 0, D, C.bfp(WS_WOUT_T), 0, scr, r, 32, C.lane, nullptr); continue; } r -= I_S;
        tr_item(C.in[19], 2048, 0, D, C.bfp(WS_WPQ_T), 0, scr, r, 64, C.lane, nullptr);
    }
    { const int gt = C.bid * NTHR + C.tid, NT = C.G * NTHR; const float* kf = C.in[20]; bf16_t* kb = C.bfp(WS_KEYS);
      for (int i = gt; i < 2 * 128 * 128; i += NT) kb[i] = (bf16_t)f2bf(kf[i]); }
    __syncthreads();
}

__device__ __forceinline__ void p_rownorm(const Ctx& C, const float* X, const float* gamma, int sh_off, int sc_off, bf16_t* dst) {
    const float* mod = C.f32p(WS_MOD);
    const int gw = C.bid * NWAVES + C.wave, NGW = C.G * NWAVES;
    for (int row0 = gw * 4; row0 < T; row0 += NGW * 4) {
        const int b = row0 / SEQ;
        f32x4 v[4][4]; float s[4];
#pragma unroll
        for (int r = 0; r < 4; ++r) { const f32x4* xr = (const f32x4*)(X + (size_t)(row0 + r) * D) + C.lane;
#pragma unroll
            for (int j = 0; j < 4; ++j) v[r][j] = xr[64 * j]; }
#pragma unroll
        for (int r = 0; r < 4; ++r) { float a = 0.f;
#pragma unroll
            for (int j = 0; j < 4; ++j) a += (v[r][j].x * v[r][j].x + v[r][j].y * v[r][j].y) + (v[r][j].z * v[r][j].z + v[r][j].w * v[r][j].w);
            s[r] = rsqrtf(wave_sum(a) * (1.f / D) + EPS); }
#pragma unroll
        for (int j = 0; j < 4; ++j) {
            const int col = 4 * C.lane + 256 * j;
            const f32x4 g = *(const f32x4*)(gamma + col), sh = *(const f32x4*)(mod + b * 6144 + sh_off + col), sc = *(const f32x4*)(mod + b * 6144 + sc_off + col);
            const f32x4 gs = g * (sc + 1.f);
#pragma unroll
            for (int r = 0; r < 4; ++r) { const f32x4 y = v[r][j] * s[r] * gs + sh; u32x2 w; w.x = pk2(y.x, y.y); w.y = pk2(y.z, y.w);
                *((u32x2*)(dst + (size_t)(row0 + r) * D) + C.lane + 64 * j) = w; }
        }
    }
}

__device__ __forceinline__ void p_rownorm_b(const Ctx& C, const bf16_t* X, const float* gamma, int sh_off, int sc_off, bf16_t* dst) {
    const float* mod = C.f32p(WS_MOD);
    const int gw = C.bid * NWAVES + C.wave, NGW = C.G * NWAVES;
    for (int row0 = gw * 4; row0 < T; row0 += NGW * 4) {
        const int b = row0 / SEQ;
        u32x2 w[4][4]; float s[4];
#pragma unroll
        for (int r = 0; r < 4; ++r)
#pragma unroll
            for (int j = 0; j < 4; ++j) w[r][j] = *((const u32x2*)(X + (size_t)(row0 + r) * D) + C.lane + 64 * j);
        f32x4 v[4][4];
#pragma unroll
        for (int r = 0; r < 4; ++r) { float a = 0.f;
#pragma unroll
            for (int j = 0; j < 4; ++j) { v[r][j].x = bflo(w[r][j].x); v[r][j].y = bfhi(w[r][j].x); v[r][j].z = bflo(w[r][j].y); v[r][j].w = bfhi(w[r][j].y);
                a += (v[r][j].x * v[r][j].x + v[r][j].y * v[r][j].y) + (v[r][j].z * v[r][j].z + v[r][j].w * v[r][j].w); }
            s[r] = rsqrtf(wave_sum(a) * (1.f / D) + EPS); }
#pragma unroll
        for (int j = 0; j < 4; ++j) {
            const int col = 4 * C.lane + 256 * j;
            const f32x4 g = *(const f32x4*)(gamma + col), sh = *(const f32x4*)(mod + b * 6144 + sh_off + col), sc = *(const f32x4*)(mod + b * 6144 + sc_off + col);
            const f32x4 gs = g * (sc + 1.f);
#pragma unroll
            for (int r = 0; r < 4; ++r) { const f32x4 y = v[r][j] * s[r] * gs + sh; u32x2 o; o.x = pk2(y.x, y.y); o.y = pk2(y.z, y.w);
                *((u32x2*)(dst + (size_t)(row0 + r) * D) + C.lane + 64 * j) = o; }
        }
    }
}

__device__ __forceinline__ void p_dt(const Ctx& C, const bf16_t* n1, const bf16_t* wdt, float* dt) {
    typedef short bf16x8 __attribute__((ext_vector_type(8)));
    const float* bf = C.in[8]; const float* bb = C.in[9];
    const int gw = C.bid * NWAVES + C.wave, NGW = C.G * NWAVES, lane = C.lane, g = lane >> 4, i16 = lane & 15;
    for (int tile = gw; tile < T / 16; tile += NGW) {
        const size_t t0 = (size_t)tile * 16;
        f32x4 a0 = (f32x4){0.f, 0.f, 0.f, 0.f}, a1 = a0;
#pragma unroll 8
        for (int ks = 0; ks < 32; ++ks) {
            const bf16x8 av = *(const bf16x8*)(n1 + (t0 + i16) * 1024 + ks * 32 + g * 8);
            const bf16x8 b0 = *(const bf16x8*)(wdt + (size_t)i16 * 1024 + ks * 32 + g * 8), b1 = *(const bf16x8*)(wdt + (size_t)(16 + i16) * 1024 + ks * 32 + g * 8);
            a0 = __builtin_amdgcn_mfma_f32_16x16x32_bf16(av, b0, a0, 0, 0, 0); a1 = __builtin_amdgcn_mfma_f32_16x16x32_bf16(av, b1, a1, 0, 0, 0); }
        const float bias0 = bf[i16], bias1 = bb[i16];
#pragma unroll
        for (int r = 0; r < 4; ++r) { dt[(t0 + 4 * g + r) * 32 + i16] = softplus_f(a0[r] + bias0); dt[(t0 + 4 * g + r) * 32 + 16 + i16] = softplus_f(a1[r] + bias1); }
    }
}

__device__ __forceinline__ void p_conv(const Ctx& C, const bf16_t* xbc, bf16_t* xc) {
    const float* cw = C.in[6]; const float* cb = C.in[7];
    const int gt = C.bid * NTHR + C.tid, NT = C.G * NTHR;
    for (int i = gt; i < (T / 8) * 256; i += NT) {
        const int cg = i & 255, run = i >> 8, t0 = run * 8, l0 = t0 & (SEQ - 1), ch = cg * 8;
        float w[5][8], acc[8][8];
#pragma unroll
        for (int j = 0; j < 5; ++j) { const f32x4 w0 = *(const f32x4*)(cw + j * 2048 + ch), w1 = *(const f32x4*)(cw + j * 2048 + ch + 4);
            w[j][0] = w0.x; w[j][1] = w0.y; w[j][2] = w0.z; w[j][3] = w0.w; w[j][4] = w1.x; w[j][5] = w1.y; w[j][6] = w1.z; w[j][7] = w1.w; }
        { const f32x4 b0 = *(const f32x4*)(cb + ch), b1 = *(const f32x4*)(cb + ch + 4);
#pragma unroll
          for (int o = 0; o < 8; ++o) { acc[o][0] = b0.x; acc[o][1] = b0.y; acc[o][2] = b0.z; acc[o][3] = b0.w; acc[o][4] = b1.x; acc[o][5] = b1.y; acc[o][6] = b1.z; acc[o][7] = b1.w; } }
        u32x4 rw[12];
#pragma unroll
        for (int rr = 0; rr < 12; ++rr) { const int ll = l0 + rr - 2; rw[rr] = (u32x4){0u, 0u, 0u, 0u};
            if (ll >= 0 && ll < SEQ) rw[rr] = *(const u32x4*)(xbc + (size_t)(t0 + rr - 2) * 2048 + ch); }
#pragma unroll
        for (int rr = 0; rr < 12; ++rr) {
            const float x[8] = {bflo(rw[rr].x), bfhi(rw[rr].x), bflo(rw[rr].y), bfhi(rw[rr].y), bflo(rw[rr].z), bfhi(rw[rr].z), bflo(rw[rr].w), bfhi(rw[rr].w)};
#pragma unroll
            for (int j = 0; j < 5; ++j) { const int o = rr - j; if (o >= 0 && o < 8) {
#pragma unroll
                for (int q = 0; q < 8; ++q) acc[o][q] += w[j][q] * x[q]; } }
        }
#pragma unroll
        for (int o = 0; o < 8; ++o) { u32x4 ov; ov.x = pk2(silu_f(acc[o][0]), silu_f(acc[o][1])); ov.y = pk2(silu_f(acc[o][2]), silu_f(acc[o][3])); ov.z = pk2(silu_f(acc[o][4]), silu_f(acc[o][5])); ov.w = pk2(silu_f(acc[o][6]), silu_f(acc[o][7]));
            *(u32x4*)(xc + (size_t)(t0 + o) * 2048 + ch) = ov; }
    }
}

namespace ssd {
typedef short bf16x8 __attribute__((ext_vector_type(8)));
typedef short s16x4 __attribute__((ext_vector_type(4)));
constexpr int RS = 272, RSX = 144;
constexpr int CN = 0, BN = 34816, BS = 69632, SL = 104448, SLB = 17408, XN = 139264, CSB = 157696;
__device__ __forceinline__ unsigned pkbf(float lo, float hi) { return pk2(lo, hi); }
__device__ __forceinline__ bf16x8 trfrag_p(LAS unsigned char* base, int stride, int ks, int c, int g, int q, int pp) {
    LAS unsigned char* a0 = base + (32 * ks + 4 * g + q) * stride + 32 * c + 8 * pp;
    const s16x4 v0 = __builtin_amdgcn_ds_read_tr16_b64_v4i16((LAS s16x4*)a0);
    const s16x4 v1 = __builtin_amdgcn_ds_read_tr16_b64_v4i16((LAS s16x4*)(a0 + 16 * stride));
    bf16x8 r; r[0] = v0[0]; r[1] = v0[1]; r[2] = v0[2]; r[3] = v0[3]; r[4] = v1[0]; r[5] = v1[1]; r[6] = v1[2]; r[7] = v1[3]; return r;
}
}
__device__ __forceinline__ void p_ssd(const Ctx& C, const bf16_t* xc, const float* dtb, bf16_t* yf, bf16_t* yb) {
    using namespace ssd;
    LAS unsigned char* L = C.lds;
    const int tid = C.tid, lane = C.lane, w = C.wave, g = lane >> 4, i16 = lane & 15, q = (lane >> 2) & 3, pp = lane & 3;
    for (int unit = C.bid; unit < 256; unit += C.G) {
        const int dir = unit & 1, hd = (unit >> 1) & 15, b = unit >> 5, grp = hd >> 2;
        const float a = -__expf((dir ? C.in[11] : C.in[10])[hd]);
        const float dsk = dir ? 0.f : C.in[12][hd];
        bf16_t* yout = dir ? yb : yf;
        f32x4 sacc[4];
#pragma unroll
        for (int pt = 0; pt < 4; ++pt) sacc[pt] = (f32x4){0.f, 0.f, 0.f, 0.f};
        __syncthreads();
        for (int i = tid; i < 2 * SLB / 4; i += NTHR) ((LAS unsigned*)(L + SL))[i] = 0u;
        u32x4 pfC[4], pfB[4], pfX[2]; float pfd0 = 0.f, pfd1 = 0.f;
#define SSD_ISSUE(ci_) do { const int c_ = dir ? (31 - (ci_)) : (ci_); const size_t t0_ = (size_t)b * SEQ + (size_t)c_ * 128; \
            _Pragma("unroll") for (int i_ = 0; i_ < 4; ++i_) { const int idx_ = tid + NTHR * i_, l_ = idx_ >> 4, cc_ = idx_ & 15; const bf16_t* rp_ = xc + (t0_ + l_) * 2048 + grp * 128 + cc_ * 8; \
                pfB[i_] = *(const u32x4*)(rp_ + 1024); pfC[i_] = *(const u32x4*)(rp_ + 1536); } \
            _Pragma("unroll") for (int i_ = 0; i_ < 2; ++i_) { const int idx_ = tid + NTHR * i_, l_ = idx_ >> 3, cc_ = idx_ & 7; pfX[i_] = *(const u32x4*)(xc + (t0_ + l_) * 2048 + hd * 64 + cc_ * 8); } \
            if (w == 0) { const int l0_ = dir ? (127 - 2 * lane) : (2 * lane), l1_ = dir ? (126 - 2 * lane) : (2 * lane + 1); \
                pfd0 = dtb[(t0_ + l0_) * 32 + dir * 16 + hd]; pfd1 = dtb[(t0_ + l1_) * 32 + dir * 16 + hd]; } } while (0)
#define SSD_SCAN(buf_) do { if (w == 0) { const float da0_ = pfd0 * a, da1_ = pfd1 * a; const float p1_ = da0_ + da1_; float s_ = p1_; \
            _Pragma("unroll") for (int o_ = 1; o_ < 64; o_ <<= 1) { const float t_ = __shfl_up(s_, o_); if (lane >= o_) s_ += t_; } \
            const float ex_ = s_ - p1_, cs0_ = ex_ + da0_, cs1_ = ex_ + p1_, tot_ = __shfl(s_, 63); \
            const int l0_ = dir ? (127 - 2 * lane) : (2 * lane), l1_ = dir ? (126 - 2 * lane) : (2 * lane + 1); \
            LAS float* cb_ = (LAS float*)(L + CSB + (buf_) * 1536); \
            cb_[l0_] = cs0_; cb_[l1_] = cs1_; cb_[128 + l0_] = pfd0; cb_[128 + l1_] = pfd1; cb_[256 + l0_] = pfd0 * __expf(tot_ - cs0_); cb_[256 + l1_] = pfd1 * __expf(tot_ - cs1_); \
            if (lane == 0) *(LAS float*)(L + CSB + 3072 + 8 * (buf_)) = tot_; } } while (0)
#define SSD_WRITE(buf_) do { const LAS float* dw_ = (const LAS float*)(L + CSB + (buf_) * 1536 + 1024); \
            _Pragma("unroll") for (int i_ = 0; i_ < 4; ++i_) { const int idx_ = tid + NTHR * i_, l_ = idx_ >> 4, cc_ = idx_ & 15; \
                *(LAS u32x4*)(L + CN + l_ * RS + cc_ * 16) = pfC[i_]; *(LAS u32x4*)(L + BN + l_ * RS + cc_ * 16) = pfB[i_]; \
                const float sc_ = dw_[l_]; const u32x4 v_ = pfB[i_]; u32x4 o_; \
                o_.x = pkbf(bflo(v_.x) * sc_, bfhi(v_.x) * sc_); o_.y = pkbf(bflo(v_.y) * sc_, bfhi(v_.y) * sc_); o_.z = pkbf(bflo(v_.z) * sc_, bfhi(v_.z) * sc_); o_.w = pkbf(bflo(v_.w) * sc_, bfhi(v_.w) * sc_); \
                *(LAS u32x4*)(L + BS + l_ * RS + cc_ * 16) = o_; } \
            _Pragma("unroll") for (int i_ = 0; i_ < 2; ++i_) { const int idx_ = tid + NTHR * i_, l_ = idx_ >> 3, cc_ = idx_ & 7; *(LAS u32x4*)(L + XN + l_ * RSX + cc_ * 16) = pfX[i_]; } } while (0)
        SSD_ISSUE(0);
        SSD_SCAN(0);
        __syncthreads();
        SSD_WRITE(0);
        __syncthreads();
        for (int ci = 0; ci < 32; ++ci) {
            const int buf = ci & 1;
            const int c = dir ? (31 - ci) : ci; const size_t t0 = (size_t)b * SEQ + (size_t)c * 128;
            if (ci + 1 < 32) SSD_ISSUE(ci + 1);
            const LAS float* csb = (const LAS float*)(L + CSB + buf * 1536);
            const float cs_l = csb[16 * w + i16];
            const float cs_end = *(const LAS float*)(L + CSB + 3072 + 8 * buf);
            bf16x8 cfrag[4];
#pragma unroll
            for (int ks = 0; ks < 4; ++ks) cfrag[ks] = *(const LAS bf16x8*)(L + CN + (16 * w + i16) * RS + ks * 64 + g * 16);
            u32x2 mreg[8];
            const int lrow = 16 * w + i16;
#pragma unroll
            for (int st = 0; st < 8; ++st) {
                f32x4 acc = (f32x4){0.f, 0.f, 0.f, 0.f};
#pragma unroll
                for (int ks = 0; ks < 4; ++ks) { const bf16x8 af = *(const LAS bf16x8*)(L + BN + (16 * st + i16) * RS + ks * 64 + g * 16);
                    acc = __builtin_amdgcn_mfma_f32_16x16x32_bf16(af, cfrag[ks], acc, 0, 0, 0); }
                const f32x4 cs_s = *(const LAS f32x4*)(csb + 16 * st + 4 * g), dt_s = *(const LAS f32x4*)(csb + 128 + 16 * st + 4 * g);
                float mv[4];
#pragma unroll
                for (int r = 0; r < 4; ++r) { const int srow = 16 * st + 4 * g + r; const bool valid = dir ? (srow >= lrow) : (srow <= lrow);
                    const float e = valid ? __expf(cs_l - cs_s[r]) : 0.f; mv[r] = acc[r] * dt_s[r] * e; }
                mreg[st].x = pkbf(mv[0], mv[1]); mreg[st].y = pkbf(mv[2], mv[3]);
            }
            f32x4 yacc[4];
            const float el = __expf(cs_l);
#pragma unroll
            for (int pt = 0; pt < 4; ++pt) { f32x4 acc = (f32x4){0.f, 0.f, 0.f, 0.f};
#pragma unroll
                for (int ks = 0; ks < 4; ++ks) { const bf16x8 af = *(const LAS bf16x8*)(L + SL + buf * SLB + (16 * pt + i16) * RS + ks * 64 + g * 16);
                    acc = __builtin_amdgcn_mfma_f32_16x16x32_bf16(af, cfrag[ks], acc, 0, 0, 0); }
                yacc[pt] = acc * el; }
#pragma unroll
            for (int ks = 0; ks < 4; ++ks) { u32x4 mw; mw.x = mreg[2 * ks].x; mw.y = mreg[2 * ks].y; mw.z = mreg[2 * ks + 1].x; mw.w = mreg[2 * ks + 1].y;
                const bf16x8 mf = __builtin_bit_cast(bf16x8, mw);
#pragma unroll
                for (int pt = 0; pt < 4; ++pt) { const bf16x8 xf = trfrag_p(L + XN, RSX, ks, pt, g, q, pp); yacc[pt] = __builtin_amdgcn_mfma_f32_16x16x32_bf16(xf, mf, yacc[pt], 0, 0, 0); } }
#pragma unroll
            for (int pt = 0; pt < 4; ++pt) { const u32x2 xv = *(const LAS u32x2*)(L + XN + lrow * RSX + (16 * pt + 4 * g) * 2);
                u32x2 o; o.x = pkbf(yacc[pt][0] + dsk * bflo(xv.x), yacc[pt][1] + dsk * bfhi(xv.x)); o.y = pkbf(yacc[pt][2] + dsk * bflo(xv.y), yacc[pt][3] + dsk * bfhi(xv.y));
                *(u32x2*)(yout + (t0 + lrow) * 1024 + hd * 64 + 16 * pt + 4 * g) = o; }
            { const float dec = __expf(cs_end);
#pragma unroll
              for (int pt = 0; pt < 4; ++pt) sacc[pt] = sacc[pt] * dec; }
#pragma unroll
            for (int ks = 0; ks < 4; ++ks) { const bf16x8 bf = trfrag_p(L + BS, RS, ks, w, g, q, pp);
#pragma unroll
                for (int pt = 0; pt < 4; ++pt) { const bf16x8 xf = trfrag_p(L + XN, RSX, ks, pt, g, q, pp); sacc[pt] = __builtin_amdgcn_mfma_f32_16x16x32_bf16(bf, xf, sacc[pt], 0, 0, 0); } }
#pragma unroll
            for (int pt = 0; pt < 4; ++pt) { u32x2 o; o.x = pkbf(sacc[pt][0], sacc[pt][1]); o.y = pkbf(sacc[pt][2], sacc[pt][3]);
                *(LAS u32x2*)(L + SL + (buf ^ 1) * SLB + (16 * pt + i16) * RS + (16 * w + 4 * g) * 2) = o; }
            if (ci + 1 < 32) SSD_SCAN(buf ^ 1);
            __syncthreads();
            if (ci + 1 < 32) SSD_WRITE(buf ^ 1);
            __syncthreads();
        }
#undef SSD_ISSUE
#undef SSD_SCAN
#undef SSD_WRITE
    }
}

namespace nat {
typedef short bf16x8 __attribute__((ext_vector_type(8)));
typedef short s16x4 __attribute__((ext_vector_type(4)));
constexpr int VH = 65536, RPB = 131072;
__device__ __forceinline__ int voff(int ks, int d) { return ks * 128 + ((((d >> 3) ^ (ks & 7))) << 4) + (d & 7) * 2; }
__device__ __forceinline__ int clampi(int x, int lo, int hi) { return x < lo ? lo : (x > hi ? hi : x); }
}
__device__ __forceinline__ void p_na(const Ctx& C, bf16_t* q, const bf16_t* k, const bf16_t* v) {
    using namespace nat;
    LAS unsigned char* L = C.lds;
    const float* rpb = C.in[15];
    const int tid = C.tid, lane = C.lane, w = C.wave, g = lane >> 4, i16 = lane & 15, qq = (lane >> 2) & 3, pp = lane & 3;
    const int hl = w >> 2, m = w & 3;
    const int bs = (m == 0) ? 0 : (m == 1) ? 8 : (m == 2) ? 24 : 32;
    const int qc = 16 * m + i16, wsx = clampi(qc - 8, 0, 48);
    unsigned vmask = 0u; int dcol[8];
#pragma unroll
    for (int c = 0; c < 8; ++c) { const int kc = bs + (c >> 2) * 16 + 4 * g + (c & 3); if (kc >= wsx && kc < wsx + 16) vmask |= (1u << c); dcol[c] = clampi(kc - qc + 15, 0, 30); }
    for (int unit = C.bid; unit < 256; unit += C.G) {
        const int rseg = unit & 3, hp = (unit >> 2) & 7, b = unit >> 5, h = 2 * hp + hl;
        __syncthreads();
        for (int i = tid; i < 930; i += NTHR) ((LAS float*)(L + RPB))[i] = rpb[(2 * hp) * 465 + i];
#define NA_LOAD_ROW(row_) do { _Pragma("unroll") for (int i_ = 0; i_ < 2; ++i_) { const int idx_ = tid + NTHR * i_, hl_ = idx_ >> 9, col_ = (idx_ >> 3) & 63, dch_ = idx_ & 7; \
            const u32x4 val_ = *(const u32x4*)(v + ((size_t)b * SEQ + (size_t)(row_) * 64 + col_) * 1024 + (2 * hp + hl_) * 64 + dch_ * 8); \
            *(LAS u32x4*)(L + hl_ * VH + voff(((row_) & 7) * 64 + col_, dch_ * 8)) = val_; } } while (0)
        const int r0 = 16 * rseg; int rs_prev = clampi(r0 - 4, 0, 56);
        for (int rr = 0; rr < 8; ++rr) NA_LOAD_ROW(rs_prev + rr);
        __syncthreads();
        const LAS float* rpbl = (const LAS float*)(L + RPB) + hl * 465;
        for (int s = 0; s < 16; ++s) {
            const int r = r0 + s, rs = clampi(r - 4, 0, 56);
            if (rs != rs_prev) { __syncthreads(); NA_LOAD_ROW(rs + 7); __syncthreads(); rs_prev = rs; }
            const size_t tokq = (size_t)b * SEQ + (size_t)r * 64 + qc;
            bf16x8 qf[2];
#pragma unroll
            for (int ks = 0; ks < 2; ++ks) qf[ks] = *(const bf16x8*)(q + tokq * 1024 + h * 64 + ks * 32 + g * 8);
            f32x4 sc[16];
#pragma unroll
            for (int kt = 0; kt < 16; ++kt) { const size_t tokk = (size_t)b * SEQ + (size_t)(rs + (kt >> 1)) * 64 + bs + (kt & 1) * 16 + i16;
                f32x4 acc = (f32x4){0.f, 0.f, 0.f, 0.f};
#pragma unroll
                for (int ks = 0; ks < 2; ++ks) { const bf16x8 kf = *(const bf16x8*)(k + tokk * 1024 + h * 64 + ks * 32 + g * 8); acc = __builtin_amdgcn_mfma_f32_16x16x32_bf16(kf, qf[ks], acc, 0, 0, 0); }
                sc[kt] = acc; }
            float mx = -1.0e30f;
#pragma unroll
            for (int kt = 0; kt < 16; ++kt) { const int drow = rs + (kt >> 1) - r + 7;
#pragma unroll
                for (int e = 0; e < 4; ++e) { const int c = (kt & 1) * 4 + e; const float bias = rpbl[drow * 31 + dcol[c]];
                    const float val = ((vmask >> c) & 1u) ? sc[kt][e] + bias : -1.0e30f; sc[kt][e] = val; mx = fmaxf(mx, val); } }
            mx = fmaxf(mx, __shfl_xor(mx, 16)); mx = fmaxf(mx, __shfl_xor(mx, 32));
            float sum = 0.f;
#pragma unroll
            for (int kt = 0; kt < 16; ++kt)
#pragma unroll
                for (int e = 0; e < 4; ++e) { const float p = __expf(sc[kt][e] - mx); sc[kt][e] = p; sum += p; }
            sum += __shfl_xor(sum, 16); sum += __shfl_xor(sum, 32);
            f32x4 o[4];
#pragma unroll
            for (int dt = 0; dt < 4; ++dt) o[dt] = (f32x4){0.f, 0.f, 0.f, 0.f};
#pragma unroll
            for (int kk = 0; kk < 8; ++kk) {
                u32x4 pw; pw.x = pk2(sc[2 * kk][0], sc[2 * kk][1]); pw.y = pk2(sc[2 * kk][2], sc[2 * kk][3]); pw.z = pk2(sc[2 * kk + 1][0], sc[2 * kk + 1][1]); pw.w = pk2(sc[2 * kk + 1][2], sc[2 * kk + 1][3]);
                const bf16x8 pf = __builtin_bit_cast(bf16x8, pw);
                const int ks0 = ((rs + kk) & 7) * 64 + bs + 4 * g + qq, ks1 = ks0 + 16;
#pragma unroll
                for (int dt = 0; dt < 4; ++dt) {
                    const s16x4 v0 = __builtin_amdgcn_ds_read_tr16_b64_v4i16((LAS s16x4*)(L + hl * VH + voff(ks0, 16 * dt + 4 * pp)));
                    const s16x4 v1 = __builtin_amdgcn_ds_read_tr16_b64_v4i16((LAS s16x4*)(L + hl * VH + voff(ks1, 16 * dt + 4 * pp)));
                    bf16x8 vf; vf[0] = v0[0]; vf[1] = v0[1]; vf[2] = v0[2]; vf[3] = v0[3]; vf[4] = v1[0]; vf[5] = v1[1]; vf[6] = v1[2]; vf[7] = v1[3];
                    o[dt] = __builtin_amdgcn_mfma_f32_16x16x32_bf16(vf, pf, o[dt], 0, 0, 0); }
            }
            const float inv = 1.f / sum;
#pragma unroll
            for (int dt = 0; dt < 4; ++dt) { u32x2 ov; ov.x = pk2(o[dt][0] * inv, o[dt][1] * inv); ov.y = pk2(o[dt][2] * inv, o[dt][3] * inv);
                *(u32x2*)(q + tokq * 1024 + h * 64 + 16 * dt + 4 * g) = ov; }
        }
#undef NA_LOAD_ROW
    }
    __syncthreads();
}

__device__ __forceinline__ void p_combine(const Ctx& C, const bf16_t* yf, const bf16_t* yb, bf16_t* szu, float* rstd) {
    const int gw = C.bid * NWAVES + C.wave, NGW = C.G * NWAVES;
    for (int row0 = gw * 2; row0 < T; row0 += NGW * 2) {
        u32x4 a[2][2], b[2][2], z[2][2];
#pragma unroll
        for (int r = 0; r < 2; ++r)
#pragma unroll
            for (int j = 0; j < 2; ++j) { const size_t off = (size_t)(row0 + r) * 1024 + j * 512 + C.lane * 8;
                a[r][j] = *(const u32x4*)(yf + off); b[r][j] = *(const u32x4*)(yb + off); z[r][j] = *(const u32x4*)(szu + off); }
#pragma unroll
        for (int r = 0; r < 2; ++r) { float s = 0.f; u32x4 outv[2];
#pragma unroll
            for (int j = 0; j < 2; ++j) { const u32x4 av = a[r][j], bv = b[r][j], zv = z[r][j]; float u[8];
                u[0] = (bflo(av.x) + bflo(bv.x)) * bflo(zv.x); u[1] = (bfhi(av.x) + bfhi(bv.x)) * bfhi(zv.x);
                u[2] = (bflo(av.y) + bflo(bv.y)) * bflo(zv.y); u[3] = (bfhi(av.y) + bfhi(bv.y)) * bfhi(zv.y);
                u[4] = (bflo(av.z) + bflo(bv.z)) * bflo(zv.z); u[5] = (bfhi(av.z) + bfhi(bv.z)) * bfhi(zv.z);
                u[6] = (bflo(av.w) + bflo(bv.w)) * bflo(zv.w); u[7] = (bfhi(av.w) + bfhi(bv.w)) * bfhi(zv.w);
#pragma unroll
                for (int q = 0; q < 8; ++q) s += u[q] * u[q];
                outv[j].x = pk2(u[0], u[1]); outv[j].y = pk2(u[2], u[3]); outv[j].z = pk2(u[4], u[5]); outv[j].w = pk2(u[6], u[7]); }
            s = wave_sum(s);
#pragma unroll
            for (int j = 0; j < 2; ++j) *(u32x4*)(szu + (size_t)(row0 + r) * 1024 + j * 512 + C.lane * 8) = outv[j];
            if (C.lane == 0) rstd[row0 + r] = rsqrtf(s * (1.f / 1024.f) + EPS); }
    }
}

__device__ __forceinline__ void p_cvt_tables8(const Ctx& C, unsigned char* u8, unsigned char* v8) {
    const int gt = C.bid * NTHR + C.tid, NT = C.G * NTHR;
    const float* u = C.in[21]; const float* v = C.in[22];
    constexpr int N4 = 16384 * 1024 / 4;
    for (int i0 = gt; i0 < N4; i0 += 4 * NT) {
        f32x4 a[4], b[4];
#pragma unroll
        for (int r = 0; r < 4; ++r) { const int i = i0 + r * NT; if (i < N4) { a[r] = *(const f32x4*)(u + (size_t)i * 4); b[r] = *(const f32x4*)(v + (size_t)i * 4); } }
#pragma unroll
        for (int r = 0; r < 4; ++r) { const int i = i0 + r * NT; if (i < N4) {
            const f32x4 av = a[r] * 256.f, bv = b[r] * 64.f; unsigned x = 0u, y = 0u;
            x = __builtin_amdgcn_cvt_pk_fp8_f32(av.x, av.y, x, false); x = __builtin_amdgcn_cvt_pk_fp8_f32(av.z, av.w, x, true);
            y = __builtin_amdgcn_cvt_pk_fp8_f32(bv.x, bv.y, y, false); y = __builtin_amdgcn_cvt_pk_fp8_f32(bv.z, bv.w, y, true);
            *(unsigned*)(u8 + (size_t)i * 4) = x; *(unsigned*)(v8 + (size_t)i * 4) = y; } }
    }
}

template <int CTRL> __device__ __forceinline__ float dppf(float x) { return __int_as_float(__builtin_amdgcn_update_dpp(0, __float_as_int(x), CTRL, 0xF, 0xF, false)); }
constexpr int DPP_HMIRROR = 0x141, DPP_XOR2 = 0x4E, DPP_XOR1 = 0xB1, DPP_ROR8 = 0x128;
__device__ __forceinline__ int idx16(const u32x4& a, const u32x4& b, int i) { const unsigned w = (i < 8 ? a : b)[(i & 7) >> 1]; return (int)((i & 1) ? (w >> 16) : (w & 0xffffu)); }
__device__ __forceinline__ int gslot(int R) { return 16 * (R & 7) + (R >> 3); }
#define GQ_DMA(tab_, qi_, mi_) do { const u32x2 iw_ = *(const LAS u32x2*)(meta + (mi_) * MSTRIDE + 32 * (lane >> 3) + 8 * (qi_)); \
        _Pragma("unroll") for (int k_ = 0; k_ < 4; ++k_) { const int kk_ = 4 * (qi_) + k_, R_ = 8 * kk_ + (lane >> 3); \
            const unsigned e_ = (k_ & 1) ? ((k_ < 2 ? iw_.x : iw_.y) >> 16) : ((k_ < 2 ? iw_.x : iw_.y) & 0xffffu); \
            const unsigned char* src_ = (tab_) + (size_t)e_ * 1024 + 128 * j + 16 * ((lane & 7) ^ ((R_ >> 1) & 7)); \
            __builtin_amdgcn_global_load_lds((const unsigned*)src_, (LAS unsigned*)(img + kk_ * 1024), 16, 0, 0); } } while (0)
#define GQ_WAIT(n_) asm volatile("s_waitcnt vmcnt(" #n_ ")" ::: "memory")
#define GQ_LWAIT() asm volatile("s_waitcnt lgkmcnt(0)" ::: "memory")
__device__ __forceinline__ void p_gu(const Ctx& C, const bf16_t* n2, const unsigned short* pidx, const unsigned char* u8, float* pd) {
    const int j = C.bid & 7, nsl = C.G >> 3, NW = nsl * NWAVES, wsl = (C.bid >> 3) * NWAVES + C.wave, lane = C.lane, i16 = lane & 15, g = lane >> 4;
    if ((C.bid >> 3) >= nsl) return;
    constexpr int MSTRIDE = 512;
    LAS unsigned char* img = C.lds + 16384 + C.wave * 16384;
    LAS unsigned char* meta = C.lds + 4096 + C.wave * (3 * MSTRIDE);
    LAS unsigned char* xq = C.lds + C.wave * 256;
#define GU_META(t_, mi_) do { const int tt_ = (t_) < T ? (t_) : wsl; \
        __builtin_amdgcn_global_load_lds((const unsigned*)((const unsigned char*)(pidx + (size_t)tt_ * 128) + 4 * lane), (LAS unsigned*)(meta + (mi_) * MSTRIDE), 4, 0, 0); \
        __builtin_amdgcn_global_load_lds((const unsigned*)((const unsigned char*)(n2 + (size_t)tt_ * 1024 + 128 * j) + 4 * lane), (LAS unsigned*)(meta + (mi_) * MSTRIDE + 256), 4, 0, 0); } while (0)
    GU_META(wsl, 0); GU_META(wsl + NW, 1);
    GQ_WAIT(0);
    GQ_DMA(u8, 0, 0); GQ_DMA(u8, 1, 0); GQ_DMA(u8, 2, 0); GQ_DMA(u8, 3, 0);
    GQ_WAIT(0);
    int mi = 0;
    for (int t = wsl; t < T; t += NW) {
        const int mi1 = mi == 2 ? 0 : mi + 1, mi2 = mi1 == 2 ? 0 : mi1 + 1;
        GU_META(t + 2 * NW, mi2);
        { const unsigned xcur = *(const LAS unsigned*)(meta + mi * MSTRIDE + 256 + 4 * lane);
          const float x0 = bflo(xcur) * 16.f, x1 = bfhi(xcur) * 16.f;
          const unsigned hw = __builtin_amdgcn_cvt_pk_fp8_f32(x0, x1, 0u, false);
          const f32x2_t h01 = __builtin_amdgcn_cvt_pk_f32_fp8(hw, false);
          const unsigned lw = __builtin_amdgcn_cvt_pk_fp8_f32((x0 - h01.x) * 16.f, (x1 - h01.y) * 16.f, 0u, false);
          *(LAS unsigned short*)(xq + 2 * lane) = (unsigned short)(hw & 0xffffu); *(LAS unsigned short*)(xq + 128 + 2 * lane) = (unsigned short)(lw & 0xffffu); }
        GQ_LWAIT();
        long bq[4];
#pragma unroll
        for (int ks = 0; ks < 4; ++ks) bq[ks] = *(const LAS long*)(xq + (i16 & 1) * 128 + 32 * ks + 8 * g);
        f32x4 o[8];
#pragma unroll
        for (int qi = 0; qi < 4; ++qi) {
            GQ_WAIT(22);
#pragma unroll
            for (int tl = 2 * qi; tl < 2 * qi + 2; ++tl) { const int R = 16 * tl + i16; f32x4 acc = (f32x4){0.f, 0.f, 0.f, 0.f};
#pragma unroll
                for (int ks = 0; ks < 4; ++ks) { const int sc = 2 * ks + (g >> 1);
                    const long av = *(const LAS long*)(img + R * 128 + ((sc ^ ((R >> 1) & 7)) << 4) + 8 * (g & 1));
                    acc = __builtin_amdgcn_mfma_f32_16x16x32_fp8_fp8(av, bq[ks], acc, 0, 0, 0); }
#pragma unroll
                for (int r = 0; r < 4; ++r) o[tl][r] = (acc[r] + dppf<DPP_XOR1>(acc[r]) * 0.0625f) * (1.f / 4096.f); }
            GQ_LWAIT();
            GQ_DMA(u8, qi, mi1);
        }
#pragma unroll
        for (int tl = 0; tl < 8; ++tl) { if (i16 == 0) *(f32x4*)(pd + ((size_t)j * T + t) * 128 + 16 * tl + 4 * g) = o[tl]; }
        mi = mi1;
    }
    GQ_WAIT(0);
#undef GU_META
}
__device__ __forceinline__ void p_gc(const Ctx& C, const float* pd, const float* pgate, float* cc) {
    const int gt = C.bid * NTHR + C.tid, NT = C.G * NTHR;
    for (int i = gt; i < T * 32; i += NT) {
        f32x4 sdot = *(const f32x4*)(pd + (size_t)i * 4);
#pragma unroll
        for (int j = 1; j < 8; ++j) sdot += *(const f32x4*)(pd + (size_t)j * T * 128 + (size_t)i * 4);
        const int t_ = i >> 5, R0 = (i & 31) * 4; const float* gp = pgate + (size_t)t_ * 128;
        f32x4 gv; gv.x = gp[gslot(R0)]; gv.y = gp[gslot(R0 + 1)]; gv.z = gp[gslot(R0 + 2)]; gv.w = gp[gslot(R0 + 3)];
        f32x4 o; o.x = gelu_f(sdot.x) * gv.x; o.y = gelu_f(sdot.y) * gv.y; o.z = gelu_f(sdot.z) * gv.z; o.w = gelu_f(sdot.w) * gv.w;
        *(f32x4*)(cc + (size_t)i * 4) = o; }
}
__device__ __forceinline__ void p_gv(const Ctx& C, const float* cc, const unsigned short* pidx, const unsigned char* v8, bf16_t* op) {
    typedef int i32x2 __attribute__((ext_vector_type(2)));
    const int j = C.bid & 7, nsl = C.G >> 3, NW = nsl * NWAVES, wsl = (C.bid >> 3) * NWAVES + C.wave, lane = C.lane, i16 = lane & 15, g = lane >> 4;
    if ((C.bid >> 3) >= nsl) return;
    constexpr int MSTRIDE = 768;
    LAS unsigned char* img = C.lds + 24576 + C.wave * 16384;
    LAS unsigned char* meta = C.lds + 4096 + C.wave * (3 * MSTRIDE);
    LAS unsigned char* cq = C.lds + C.wave * 256;
    const int tr_r = i16 >> 1, tr_c = i16 & 1;
#define GV_META(t_, mi_) do { const int tt_ = (t_) < T ? (t_) : wsl; \
        __builtin_amdgcn_global_load_lds((const unsigned*)((const unsigned char*)(pidx + (size_t)tt_ * 128) + 4 * lane), (LAS unsigned*)(meta + (mi_) * MSTRIDE), 4, 0, 0); \
        __builtin_amdgcn_global_load_lds((const unsigned*)(cc + (size_t)tt_ * 128 + lane), (LAS unsigned*)(meta + (mi_) * MSTRIDE + 256), 4, 0, 0); \
        __builtin_amdgcn_global_load_lds((const unsigned*)(cc + (size_t)tt_ * 128 + 64 + lane), (LAS unsigned*)(meta + (mi_) * MSTRIDE + 512), 4, 0, 0); } while (0)
    GV_META(wsl, 0); GV_META(wsl + NW, 1);
    GQ_WAIT(0);
    GQ_DMA(v8, 0, 0); GQ_DMA(v8, 1, 0); GQ_DMA(v8, 2, 0); GQ_DMA(v8, 3, 0);
    GQ_WAIT(0);
    int mi = 0;
    for (int t = wsl; t < T; t += NW) {
        const int mi1 = mi == 2 ? 0 : mi + 1, mi2 = mi1 == 2 ? 0 : mi1 + 1;
        GV_META(t + 2 * NW, mi2);
        { const f32x2_t ccur = *(const LAS f32x2_t*)(meta + mi * MSTRIDE + 256 + 8 * lane);
          const float c0 = ccur.x * 64.f, c1 = ccur.y * 64.f;
          const unsigned hw = __builtin_amdgcn_cvt_pk_fp8_f32(c0, c1, 0u, false);
          const f32x2_t h01 = __builtin_amdgcn_cvt_pk_f32_fp8(hw, false);
          const unsigned lw = __builtin_amdgcn_cvt_pk_fp8_f32((c0 - h01.x) * 16.f, (c1 - h01.y) * 16.f, 0u, false);
          *(LAS unsigned short*)(cq + 2 * lane) = (unsigned short)(hw & 0xffffu); *(LAS unsigned short*)(cq + 128 + 2 * lane) = (unsigned short)(lw & 0xffffu); }
        GQ_LWAIT();
        long aq[4];
#pragma unroll
        for (int ks = 0; ks < 4; ++ks) aq[ks] = *(const LAS long*)(cq + (i16 & 1) * 128 + 32 * ks + 8 * g);
        f32x4 acc[8];
#pragma unroll
        for (int ct = 0; ct < 8; ++ct) acc[ct] = (f32x4){0.f, 0.f, 0.f, 0.f};
#pragma unroll
        for (int ks = 0; ks < 4; ++ks) {
            GQ_WAIT(23);
            const int R = 32 * ks + 8 * g + tr_r;
#pragma unroll
            for (int ct = 0; ct < 8; ++ct) {
                const i32x2 bv = __builtin_amdgcn_ds_read_tr8_b64_v2i32((LAS i32x2*)(img + R * 128 + ((ct ^ ((R >> 1) & 7)) << 4) + 8 * tr_c));
                const long bl = (long)((unsigned long long)(unsigned)bv[0] | ((unsigned long long)(unsigned)bv[1] << 32));
                acc[ct] = __builtin_amdgcn_mfma_f32_16x16x32_fp8_fp8(aq[ks], bl, acc[ct], 0, 0, 0); }
            GQ_LWAIT();
            GQ_DMA(v8, ks, mi1);
        }
#pragma unroll
        for (int ct = 0; ct < 8; ++ct) { if (g == 0) op[(size_t)t * 1024 + 128 * j + 16 * ct + i16] = (bf16_t)f2bf((acc[ct][0] + acc[ct][1] * 0.0625f) * (1.f / 4096.f)); }
        mi = mi1;
    }
    GQ_WAIT(0);
#undef GV_META
}
__device__ __forceinline__ void p_gf(const Ctx& C, const bf16_t* h, const bf16_t* op, float* out) {
    const float* mod = C.f32p(WS_MOD); const float* fg = C.in[23];
    const int gw = C.bid * NWAVES + C.wave, NGW = C.G * NWAVES, lane = C.lane;
    for (int t0 = gw * 2; t0 < T; t0 += NGW * 2) {
        const int b = t0 / SEQ;
        u32x2 ov[2][4], hw[2][4];
#pragma unroll
        for (int r = 0; r < 2; ++r)
#pragma unroll
            for (int d = 0; d < 4; ++d) { const size_t off = (size_t)(t0 + r) * 1024 + 256 * d + 4 * lane; ov[r][d] = *(const u32x2*)(op + off); hw[r][d] = *(const u32x2*)(h + off); }
        f32x4 mv[4], fv[4];
#pragma unroll
        for (int d = 0; d < 4; ++d) { mv[d] = *(const f32x4*)(mod + b * 6144 + 5120 + 256 * d + 4 * lane); fv[d] = *(const f32x4*)(fg + 256 * d + 4 * lane); }
#pragma unroll
        for (int r = 0; r < 2; ++r) { f32x4 hf[4]; float ss = 0.f;
#pragma unroll
            for (int d = 0; d < 4; ++d) { f32x4 hv, o4; hv.x = bflo(hw[r][d].x); hv.y = bfhi(hw[r][d].x); hv.z = bflo(hw[r][d].y); hv.w = bfhi(hw[r][d].y);
                o4.x = bflo(ov[r][d].x); o4.y = bfhi(ov[r][d].x); o4.z = bflo(ov[r][d].y); o4.w = bfhi(ov[r][d].y);
                hf[d] = hv + mv[d] * o4; ss += (hf[d].x * hf[d].x + hf[d].y * hf[d].y) + (hf[d].z * hf[d].z + hf[d].w * hf[d].w); }
            const float rstd = rsqrtf(wave_sum(ss) * (1.f / 1024.f) + EPS);
#pragma unroll
            for (int d = 0; d < 4; ++d) *(f32x4*)(out + (size_t)(t0 + r) * 1024 + 256 * d + 4 * lane) = hf[d] * rstd * fv[d]; }
    }
}

namespace pg8 {
#define PG8_LAS __attribute__((address_space(3)))
typedef unsigned short bf16_t;
typedef short bf16x8 __attribute__((ext_vector_type(8)));
typedef float f32x4 __attribute__((ext_vector_type(4)));
typedef unsigned u32x4 __attribute__((ext_vector_type(4)));
constexpr int BM = 256, BK = 64, HALF = 128, HTB = HALF * BK * 2  , STAGE_BYTES = 8 * HTB, NXCD = 8, WGM = 8;

__host__ __device__ __forceinline__ int lds_byte(int r, int c) { const int st = (r >> 4) * 2 + (c >> 5), rr = r & 15, cc = c & 31, ob = rr * 64 + cc * 2; return st * 1024 + (ob ^ (((ob >> 9) & 1) << 5)); }
__host__ __device__ __forceinline__ void stage_rc(int b, int& R, int& C) { const int st = b / 1024, sb = b % 1024, swz = sb ^ (((sb >> 9) & 1) << 5); R = (st >> 1) * 16 + swz / 64; C = (st & 1) * 32 + (swz % 64) / 2; }
__host__ __device__ __forceinline__ int perm32(int rho) { const int n = rho >> 4, i = rho & 15; return 8 * (i >> 2) + 4 * n + (i & 3); }

struct Unit { int pm, pn, kind; };
struct Gemm { const bf16_t* A; const bf16_t* Bt; int M, N, K; const bf16_t *A1, *B1, *A2, *B2, *A3, *B3; };

struct StaticOrder {
    static constexpr bool MULTI = false;
    int nM, nN, nwg, G, c;
    __host__ __device__ void init(int M, int N, int G_, int c_) { nM = M / BM; nN = N / BM; nwg = nM * nN; G = G_; c = c_; }
    __host__ __device__ bool next(int i, Unit& u) const {
        const long L = (long)i * G + c; if (L >= nwg) return false;
        int wgid = (int)L; { const int q = nwg / NXCD, r = nwg % NXCD, xcd = wgid % NXCD, off = wgid / NXCD; wgid = (xcd < r ? xcd * (q + 1) : r * (q + 1) + (xcd - r) * q) + off; }
        const int nig = WGM * nN, gid = wgid / nig, fm = gid * WGM, gsz = (nM - fm) < WGM ? (nM - fm) : WGM;
        u.pm = fm + ((wgid % nig) % gsz); u.pn = (wgid % nig) / gsz; u.kind = 0; return true;
    }
    __device__ __forceinline__ void a_ready(const Unit&) const {}
    __device__ __forceinline__ void done(const Unit&) const {}
};

struct MultiOrder {
    static constexpr bool MULTI = true;
    StaticOrder b; int nk;
    __host__ __device__ bool next(int i, Unit& u) const { if (!b.next(i / nk, u)) return false; u.kind = i % nk; return true; }
    __device__ __forceinline__ void a_ready(const Unit&) const {}
    __device__ __forceinline__ void done(const Unit&) const {}
};

__device__ __forceinline__ unsigned cvt_pk_bf16(float lo, float hi) { return ::pk2(lo, hi); }
__device__ __forceinline__ float e_silu(float x) { return x / (1.f + __expf(-x)); }
__device__ __forceinline__ float e_sigm(float x) { return 1.f / (1.f + __expf(-x)); }
__device__ __forceinline__ float e_lo(unsigned v) { return __uint_as_float(v << 16); }
__device__ __forceinline__ float e_hi(unsigned v) { return __uint_as_float(v & 0xffff0000u); }
__device__ __forceinline__ u32x4 pack8(const f32x4 v0, const f32x4 v1) { u32x4 w; w.x = cvt_pk_bf16(v0[0], v0[1]); w.y = cvt_pk_bf16(v0[2], v0[3]); w.z = cvt_pk_bf16(v1[0], v1[1]); w.w = cvt_pk_bf16(v1[2], v1[3]); return w; }

struct EpiInProj {
    static constexpr bool PERM = true, AFTER_DRAIN = false;
    bf16_t *sz, *xbc, *q, *k, *v;
    __device__ __forceinline__ void operator()(const f32x4 (&acc)[2][2][4][2], const Unit& u, int wr, int wc, int fr, int fq) const {
        const int pn = u.pn; bf16_t* base; int ldc = 1024, colt, mode = 0;
        if (pn < 4) { base = sz; colt = pn * 256; mode = 1; }
        else if (pn < 12) { base = xbc; ldc = 2048; colt = (pn - 4) * 256; }
        else if (pn < 16) { base = q; colt = (pn - 12) * 256; mode = 2; }
        else if (pn < 20) { base = k; colt = (pn - 16) * 256; }
        else { base = v; colt = (pn - 20) * 256; }
        const int row0 = u.pm * BM + wr * 64 + fr, col0 = colt + wc * 32 + 8 * fq;
#pragma unroll
        for (int ai = 0; ai < 2; ++ai)
#pragma unroll
            for (int m = 0; m < 4; ++m) { bf16_t* rowp = base + (size_t)(row0 + ai * HALF + m * 16) * ldc + col0;
#pragma unroll
                for (int bj = 0; bj < 2; ++bj) { f32x4 v0 = acc[ai][bj][m][0], v1 = acc[ai][bj][m][1];
                    if (mode == 1) {
#pragma unroll
                        for (int i = 0; i < 4; ++i) { v0[i] = e_silu(v0[i]); v1[i] = e_silu(v1[i]); } }
                    else if (mode == 2) { v0 = v0 * 0.125f; v1 = v1 * 0.125f; }
                    *(u32x4*)(rowp + bj * HALF) = pack8(v0, v1); } }
    }
};
struct EpiMix {
    static constexpr bool PERM = true, AFTER_DRAIN = false;
    bf16_t *sg1, *sg2, *mixed; const float* rstd;
    __device__ __forceinline__ bool operator()(f32x4 (&acc)[2][2][4][2], const Unit& u, int wr, int wc, int fr, int fq) const {
        const int row0 = u.pm * BM + wr * 64 + fr, col0 = u.pn * BM + wc * 32 + 8 * fq; const int kind = u.kind;
#pragma unroll
        for (int ai = 0; ai < 2; ++ai)
#pragma unroll
            for (int m = 0; m < 4; ++m) { const int row = row0 + ai * HALF + m * 16; const size_t off = (size_t)row * 1024 + col0;
                const float rs = (kind == 2) ? rstd[row] : 1.f;
#pragma unroll
                for (int bj = 0; bj < 2; ++bj) { f32x4 v0 = acc[ai][bj][m][0], v1 = acc[ai][bj][m][1];
                    if (kind < 2) {
#pragma unroll
                        for (int i = 0; i < 4; ++i) { v0[i] = e_sigm(v0[i]); v1[i] = e_sigm(v1[i]); }
                        *(u32x4*)((kind == 0 ? sg1 : sg2) + off + bj * HALF) = pack8(v0, v1);
                    } else if (kind == 2) {
                        const u32x4 a = *(const u32x4*)(sg1 + off + bj * HALF), b = *(const u32x4*)(sg2 + off + bj * HALF);
                        v0[0] *= rs * e_lo(a.x) / fmaxf(e_lo(b.x), 1e-30f); v0[1] *= rs * e_hi(a.x) / fmaxf(e_hi(b.x), 1e-30f); v0[2] *= rs * e_lo(a.y) / fmaxf(e_lo(b.y), 1e-30f); v0[3] *= rs * e_hi(a.y) / fmaxf(e_hi(b.y), 1e-30f);
                        v1[0] *= rs * e_lo(a.z) / fmaxf(e_lo(b.z), 1e-30f); v1[1] *= rs * e_hi(a.z) / fmaxf(e_hi(b.z), 1e-30f); v1[2] *= rs * e_lo(a.w) / fmaxf(e_lo(b.w), 1e-30f); v1[3] *= rs * e_hi(a.w) / fmaxf(e_hi(b.w), 1e-30f);
                        acc[ai][bj][m][0] = v0; acc[ai][bj][m][1] = v1;
                    } else {
                        const u32x4 b = *(const u32x4*)(sg2 + off + bj * HALF);
                        v0[0] *= e_lo(b.x); v0[1] *= e_hi(b.x); v0[2] *= e_lo(b.y); v0[3] *= e_hi(b.y); v1[0] *= e_lo(b.z); v1[1] *= e_hi(b.z); v1[2] *= e_lo(b.w); v1[3] *= e_hi(b.w);
                        *(u32x4*)(mixed + off + bj * HALF) = pack8(v0, v1);
                    } } }
        return kind == 2;
    }
};
struct EpiD3 {
    static constexpr bool PERM = true, AFTER_DRAIN = false;
    bf16_t* h; const float* x; const float* mod;
    __device__ __forceinline__ void operator()(const f32x4 (&acc)[2][2][4][2], const Unit& u, int wr, int wc, int fr, int fq) const {
        const int row0 = u.pm * BM + wr * 64 + fr, col0 = u.pn * BM + wc * 32 + 8 * fq;
        const float* g1 = mod + (size_t)((u.pm * BM) >> 12) * 6144 + 2048;
#pragma unroll
        for (int ai = 0; ai < 2; ++ai)
#pragma unroll
            for (int m = 0; m < 4; ++m) { const size_t off = (size_t)(row0 + ai * HALF + m * 16) * 1024 + col0;
#pragma unroll
                for (int bj = 0; bj < 2; ++bj) { const int c = bj * HALF;
                    const f32x4 x0 = *(const f32x4*)(x + off + c), x1 = *(const f32x4*)(x + off + c + 4), g0 = *(const f32x4*)(g1 + col0 + c), g4 = *(const f32x4*)(g1 + col0 + c + 4);
                    *(u32x4*)(h + off + c) = pack8(x0 + g0 * acc[ai][bj][m][0], x1 + g4 * acc[ai][bj][m][1]); } }
    }
};
struct EpiQp {
    static constexpr bool PERM = true, AFTER_DRAIN = false;
    bf16_t* qp;
    __device__ __forceinline__ void operator()(const f32x4 (&acc)[2][2][4][2], const Unit& u, int wr, int wc, int fr, int fq) const {
        const int row0 = u.pm * BM + wr * 64 + fr, col0 = u.pn * BM + wc * 32 + 8 * fq;
#pragma unroll
        for (int ai = 0; ai < 2; ++ai)
#pragma unroll
            for (int m = 0; m < 4; ++m) { bf16_t* rowp = qp + (size_t)(row0 + ai * HALF + m * 16) * 2048 + col0;
#pragma unroll
                for (int bj = 0; bj < 2; ++bj) *(u32x4*)(rowp + bj * HALF) = pack8(acc[ai][bj][m][0], acc[ai][bj][m][1]); }
    }
};

template <class Epi, class Sched, bool ALIGN_EPI = false, bool SP2 = false>
__device__ __forceinline__ void gemm_phase(PG8_LAS unsigned char* lds, const Gemm g, const Sched& S, const Epi& E) {
    const int tid = threadIdx.x, wid = __builtin_amdgcn_readfirstlane(tid >> 6), lane = tid & 63, wr = wid >> 2, wc = wid & 3, fr = lane & 15, fq = lane >> 4;
    const int K = g.K, nt = K / BK;
    unsigned voffA[2], voffB[2];
#pragma unroll
    for (int i = 0; i < 2; ++i) { int R, C; stage_rc(tid * 16 + i * 8192, R, C); const int Rb = Epi::PERM ? ((R & ~31) + perm32(R & 31)) : R;
        voffA[i] = (unsigned)(R * K + C) * 2u; voffB[i] = (unsigned)(Rb * K + C) * 2u; }
    const size_t kstep = (size_t)(BK * 2);
    const size_t hstep = (size_t)HALF * K * 2;
    const size_t tstep = 2 * hstep;
    const unsigned ldsw = (unsigned)wid * 1024u;
    const int aoff = lds_byte(wr * 64 + fr, fq * 8), boff = lds_byte(wc * 32 + fr, fq * 8);
#define PG8_SA(b, h) (((b) * 2 + (h)) * HTB)
#define PG8_SB(b, h) ((4 + (b) * 2 + (h)) * HTB)
#define PG8_STAGE(bufoff, gbase, voff) do { _Pragma("unroll") for (int _i = 0; _i < 2; ++_i) \
        __builtin_amdgcn_global_load_lds((const unsigned*)((const char*)(gbase) + (voff)[_i]), (PG8_LAS unsigned*)(lds + (bufoff) + ldsw + _i * 8192), 16, 0, 0); } while (0)
#define PG8_LDA(dst, b, h) do { _Pragma("unroll") for (int m = 0; m < 4; ++m) _Pragma("unroll") for (int k = 0; k < 2; ++k) dst[m][k] = *(const PG8_LAS bf16x8*)(lds + PG8_SA(b, h) + aoff + m * 2048 + k * 1024); } while (0)
#define PG8_LDB(dst, b, h) do { _Pragma("unroll") for (int n = 0; n < 2; ++n) _Pragma("unroll") for (int k = 0; k < 2; ++k) dst[n][k] = *(const PG8_LAS bf16x8*)(lds + PG8_SB(b, h) + boff + n * 2048 + k * 1024); } while (0)
#define PG8_MMA(ai, bj, At, Bt) do { __builtin_amdgcn_s_setprio(1); _Pragma("unroll") for (int m = 0; m < 4; ++m) _Pragma("unroll") for (int n = 0; n < 2; ++n) _Pragma("unroll") for (int k = 0; k < 2; ++k) \
        acc[ai][bj][m][n] = __builtin_amdgcn_mfma_f32_16x16x32_bf16(Bt[n][k], At[m][k], acc[ai][bj][m][n], 0, 0, 0); __builtin_amdgcn_s_setprio(0); } while (0)
#define PG8_WAIT_V(n) asm volatile("s_waitcnt vmcnt(" #n ")" ::: "memory")
#define PG8_WAIT_L(n) asm volatile("s_waitcnt lgkmcnt(" #n ")" ::: "memory")
#define PG8_BAR __builtin_amdgcn_s_barrier()
#define PG8_SCHED __builtin_amdgcn_sched_barrier(0)
    Unit cur, nxt; int ui = 0;
    if (!S.next(0, cur)) return;
    f32x4 acc[2][2][4][2];
#pragma unroll
    for (int a = 0; a < 2; ++a)
#pragma unroll
        for (int b = 0; b < 2; ++b)
#pragma unroll
            for (int m = 0; m < 4; ++m)
#pragma unroll
                for (int n = 0; n < 2; ++n) acc[a][b][m][n] = (f32x4){0.f, 0.f, 0.f, 0.f};
    bf16x8 At[4][2], B0[2][2], B1[2][2];
#define PG8_AB(u_) (Sched::MULTI ? (const char*)((u_).kind == 0 ? g.A : (u_).kind == 1 ? g.A1 : (u_).kind == 2 ? g.A2 : g.A3) : (const char*)g.A)
#define PG8_BB(u_) (Sched::MULTI ? (const char*)((u_).kind == 0 ? g.Bt : (u_).kind == 1 ? g.B1 : (u_).kind == 2 ? g.B2 : g.B3) : (const char*)g.Bt)
    const char* cA = PG8_AB(cur) + (size_t)cur.pm * tstep; const char* cB = PG8_BB(cur) + (size_t)cur.pn * tstep;
    S.a_ready(cur);
    if constexpr (SP2) {
        PG8_STAGE(PG8_SB(0, 0), cB, voffB); PG8_STAGE(PG8_SB(0, 1), cB + hstep, voffB); PG8_STAGE(PG8_SA(0, 0), cA, voffA); PG8_STAGE(PG8_SA(0, 1), cA + hstep, voffA);
        if (wr == 1) PG8_BAR;
        PG8_WAIT_V(2); PG8_BAR;
        PG8_STAGE(PG8_SB(1, 0), cB + kstep, voffB); PG8_STAGE(PG8_SA(1, 0), cA + kstep, voffA); PG8_STAGE(PG8_SB(1, 1), cB + hstep + kstep, voffB);
        PG8_WAIT_V(6); PG8_BAR;
    } else {
        PG8_STAGE(PG8_SB(0, 0), cB, voffB); PG8_STAGE(PG8_SA(0, 0), cA, voffA); PG8_STAGE(PG8_SB(0, 1), cB + hstep, voffB); PG8_STAGE(PG8_SA(0, 1), cA + hstep, voffA);
        if (wr == 1) PG8_BAR;
        PG8_WAIT_V(4); PG8_BAR;
        PG8_STAGE(PG8_SB(1, 0), cB + kstep, voffB); PG8_STAGE(PG8_SA(1, 0), cA + kstep, voffA); PG8_STAGE(PG8_SB(1, 1), cB + hstep + kstep, voffB);
        PG8_WAIT_V(6); PG8_BAR;
    }
    for (;;) {
        const bool has_next = S.next(ui + 1, nxt);
        const char* nA = has_next ? PG8_AB(nxt) + (size_t)nxt.pm * tstep : cA; const char* nB = has_next ? PG8_BB(nxt) + (size_t)nxt.pn * tstep : cB;
        for (int t = 0; t < nt; t += 2) {
            const bool last = (t == nt - 2);
            const char* a1 = cA + (size_t)(t + 1) * kstep;
            const char* a2 = last ? nA : cA + (size_t)(t + 2) * kstep; const char* b2 = last ? nB : cB + (size_t)(t + 2) * kstep;
            const char* a3 = a2 + kstep; const char* b3 = b2 + kstep;
            if (last && has_next) S.a_ready(nxt);
            if constexpr (SP2) {
            PG8_LDB(B0, 0, 0); PG8_LDB(B1, 0, 1); PG8_SCHED; PG8_LDA(At, 0, 0); PG8_STAGE(PG8_SA(1, 1), a1 + hstep, voffA);
            PG8_WAIT_V(8); PG8_WAIT_L(0); PG8_BAR; PG8_MMA(0, 0, At, B0); PG8_MMA(0, 1, At, B1); PG8_BAR; PG8_SCHED;
            PG8_LDA(At, 0, 1); PG8_STAGE(PG8_SB(0, 0), b2, voffB); PG8_STAGE(PG8_SB(0, 1), b2 + hstep, voffB); PG8_STAGE(PG8_SA(0, 0), a2, voffA);
            PG8_WAIT_V(8); PG8_WAIT_L(0); PG8_BAR; PG8_MMA(1, 0, At, B0); PG8_MMA(1, 1, At, B1); PG8_BAR; PG8_SCHED;
            PG8_LDB(B0, 1, 0); PG8_LDB(B1, 1, 1); PG8_SCHED; PG8_LDA(At, 1, 0); PG8_STAGE(PG8_SA(0, 1), a2 + hstep, voffA);
            PG8_WAIT_V(8); PG8_WAIT_L(0); PG8_BAR; PG8_MMA(0, 0, At, B0); PG8_MMA(0, 1, At, B1); PG8_BAR; PG8_SCHED;
            PG8_LDA(At, 1, 1); PG8_STAGE(PG8_SB(1, 0), b3, voffB); PG8_STAGE(PG8_SB(1, 1), b3 + hstep, voffB); PG8_STAGE(PG8_SA(1, 0), a3, voffA);
            PG8_WAIT_V(8); PG8_WAIT_L(0); PG8_BAR; PG8_MMA(1, 0, At, B0); PG8_MMA(1, 1, At, B1); PG8_BAR; PG8_SCHED;
            } else {
            PG8_LDB(B0, 0, 0); PG8_SCHED; PG8_LDA(At, 0, 0); PG8_STAGE(PG8_SA(1, 1), a1 + hstep, voffA);
            PG8_WAIT_L(8); PG8_BAR; PG8_WAIT_L(0); PG8_MMA(0, 0, At, B0); PG8_BAR; PG8_SCHED;
            PG8_LDB(B1, 0, 1); PG8_STAGE(PG8_SB(0, 0), b2, voffB);
            PG8_BAR; PG8_WAIT_L(0); PG8_MMA(0, 1, At, B1); PG8_BAR;
            PG8_LDA(At, 0, 1); PG8_STAGE(PG8_SA(0, 0), a2, voffA);
            PG8_BAR; PG8_WAIT_L(0); PG8_MMA(1, 0, At, B0); PG8_BAR; PG8_SCHED;
            PG8_STAGE(PG8_SB(0, 1), b2 + hstep, voffB);
            PG8_WAIT_V(6); PG8_BAR; PG8_MMA(1, 1, At, B1); PG8_BAR;
            PG8_LDB(B0, 1, 0); PG8_SCHED; PG8_LDA(At, 1, 0); PG8_STAGE(PG8_SA(0, 1), a2 + hstep, voffA);
            PG8_WAIT_L(8); PG8_BAR; PG8_WAIT_L(0); PG8_MMA(0, 0, At, B0); PG8_BAR; PG8_SCHED;
            PG8_LDB(B1, 1, 1); PG8_STAGE(PG8_SB(1, 0), b3, voffB);
            PG8_BAR; PG8_WAIT_L(0); PG8_MMA(0, 1, At, B1); PG8_BAR;
            PG8_LDA(At, 1, 1); PG8_STAGE(PG8_SA(1, 0), a3, voffA);
            PG8_BAR; PG8_WAIT_L(0); PG8_MMA(1, 0, At, B0); PG8_BAR; PG8_SCHED;
            PG8_STAGE(PG8_SB(1, 1), b3 + hstep, voffB);
            PG8_WAIT_V(6); PG8_BAR; PG8_MMA(1, 1, At, B1); PG8_BAR;
            }
        }
        if constexpr (ALIGN_EPI) { if (wr == 0) PG8_BAR; }
        bool keep_acc = false;
        if constexpr (!Epi::AFTER_DRAIN) { if constexpr (Sched::MULTI) keep_acc = E(acc, cur, wr, wc, fr, fq); else E(acc, cur, wr, wc, fr, fq); S.done(cur); }
        if (!has_next) break;
        if (!keep_acc) {
#pragma unroll
        for (int a = 0; a < 2; ++a)
#pragma unroll
            for (int b = 0; b < 2; ++b)
#pragma unroll
                for (int m = 0; m < 4; ++m)
#pragma unroll
                    for (int n = 0; n < 2; ++n) acc[a][b][m][n] = (f32x4){0.f, 0.f, 0.f, 0.f};
        }
        cur = nxt; cA = nA; cB = nB; ++ui;
        if constexpr (ALIGN_EPI) { if (wr == 1) PG8_BAR; }
    }
    PG8_WAIT_V(0);
    if constexpr (!ALIGN_EPI) { if (wr == 0) PG8_BAR; }
    PG8_BAR;
    if constexpr (Epi::AFTER_DRAIN) { E.fused(acc, cur, wr, wc, fr, fq, lds, wid, lane); S.done(cur); }
#undef PG8_AB
#undef PG8_BB
#undef PG8_SA
#undef PG8_SB
#undef PG8_STAGE
#undef PG8_LDA
#undef PG8_LDB
#undef PG8_MMA
#undef PG8_WAIT_V
#undef PG8_WAIT_L
#undef PG8_BAR
#undef PG8_SCHED
}
}


namespace tk {
typedef short bf16x8 __attribute__((ext_vector_type(8)));
constexpr int RSK = 272, TAB = 69632, TABW = 33 * 16 * 4, IJT = TAB + 8 * TABW;
__device__ __forceinline__ void ce(float& a, float& b) { const float hi = __builtin_fmaxf(a, b), lo = __builtin_fminf(a, b); a = hi; b = lo; }
__device__ __forceinline__ void sort16(float (&v)[16]) {
#pragma unroll
    for (int k = 2; k <= 16; k <<= 1)
#pragma unroll
        for (int j = k >> 1; j > 0; j >>= 1)
#pragma unroll
            for (int i = 0; i < 16; ++i) { const int l = i ^ j; if (l > i) { if ((i & k) == 0) ce(v[i], v[l]); else ce(v[l], v[i]); } }
}
__device__ __forceinline__ void merge16(float (&a)[16], const float (&b)[16]) {
#pragma unroll
    for (int i = 0; i < 16; ++i) a[i] = __builtin_fmaxf(a[i], b[15 - i]);
#pragma unroll
    for (int j = 8; j > 0; j >>= 1)
#pragma unroll
        for (int i = 0; i < 16; ++i) { const int l = i ^ j; if (l > i) ce(a[i], a[l]); }
}
__device__ __forceinline__ void xmerge(float (&a)[16], int mask) { float b[16];
#pragma unroll
    for (int i = 0; i < 16; ++i) b[i] = __shfl_xor(a[i], mask);
    merge16(a, b); }
}
template <bool OWN>
__device__ __forceinline__ void p_topk(const Ctx& C, const bf16_t* qp, const bf16_t* keys, unsigned short* pidx, float* pgate) {
    using namespace tk;
    LAS unsigned char* L = C.lds;
    const int tid = C.tid, lane = C.lane, w = C.wave, g = lane >> 4, i16 = lane & 15;
    __syncthreads();
    for (int i = tid; i < 4096; i += NTHR) { const int r = i >> 4, cc = i & 15; *(LAS u32x4*)(L + r * RSK + cc * 16) = *(const u32x4*)(keys + (size_t)r * 128 + cc * 8); }
    if (tid < 64) { int cnt = 0, fi = 0, fj = 0;
        for (int i = 0; i < 16; ++i) for (int j = 0; j < 16; ++j) if ((i + 1) * (j + 1) <= 16) { if (cnt == tid) { fi = i; fj = j; } ++cnt; }
        ((LAS unsigned*)(L + IJT))[tid] = (unsigned)(fi | (fj << 4)); }
    __syncthreads();
    LAS unsigned* tab = (LAS unsigned*)(L + TAB + w * TABW) + i16 * 33;
    const LAS unsigned* ijt = (const LAS unsigned*)(L + IJT);
    const float NEGV = -1.0e30f;
    const int gw = C.bid * NWAVES + w, NGW = C.G * NWAVES;
    pg8::StaticOrder SO; SO.init(T, 2048, C.G, C.bid);
    for (int unit = OWN ? w : gw; ; unit += OWN ? NWAVES : NGW) {
        int tg, hh;
        if constexpr (OWN) { pg8::Unit u; if (!SO.next(unit >> 4, u)) break; tg = 16 * u.pm + (unit & 15); hh = u.pn; }
        else { if (unit >= (T / 16) * 8) break; tg = unit >> 3; hh = unit & 7; }
        const size_t t0 = (size_t)tg * 16;
        float s1[16], s2[16];
#pragma unroll
        for (int z = 0; z < 2; ++z) {
            bf16x8 qf[4];
#pragma unroll
            for (int ks = 0; ks < 4; ++ks) qf[ks] = *(const bf16x8*)(qp + (t0 + i16) * 2048 + hh * 256 + z * 128 + ks * 32 + g * 8);
            float lo[16], hi[16];
#pragma unroll
            for (int nt = 0; nt < 8; ++nt) { f32x4 acc = (f32x4){0.f, 0.f, 0.f, 0.f};
#pragma unroll
                for (int ks = 0; ks < 4; ++ks) { const bf16x8 kf = *(const LAS bf16x8*)(L + (z * 128 + 16 * nt + i16) * RSK + ks * 64 + g * 16);
                    acc = __builtin_amdgcn_mfma_f32_16x16x32_bf16(kf, qf[ks], acc, 0, 0, 0); }
#pragma unroll
                for (int r = 0; r < 4; ++r) { const float pv = __uint_as_float((__float_as_uint(acc[r]) & 0xFFFFFF80u) | (unsigned)(16 * nt + 4 * g + r));
                    if (nt < 4) lo[nt * 4 + r] = pv; else hi[(nt - 4) * 4 + r] = pv; } }
            sort16(lo); sort16(hi); merge16(lo, hi);
            xmerge(lo, 16); xmerge(lo, 32);
#pragma unroll
            for (int i = 0; i < 16; ++i) { if (z == 0) s1[i] = lo[i]; else s2[i] = lo[i]; }
        }
#pragma unroll
        for (int i = 0; i < 16; ++i) { tab[i] = __float_as_uint(s1[i]); tab[16 + i] = __float_as_uint(s2[i]); }
        float cand[16];
            { const float a_ = (g == 0 ? s1[0] : g == 1 ? s1[1] : g == 2 ? s1[3] : s1[14]), b_ = (g == 0 ? s2[0] : g == 1 ? s2[0] : g == 2 ? s2[3] : s2[0]); cand[0] = __uint_as_float((__float_as_uint(a_ + b_) & 0xFFFFFFC0u) | (unsigned)(16 * g + 0)); }
            { const float a_ = (g == 0 ? s1[0] : g == 1 ? s1[1] : g == 2 ? s1[4] : s1[15]), b_ = (g == 0 ? s2[1] : g == 1 ? s2[1] : g == 2 ? s2[0] : s2[0]); cand[1] = __uint_as_float((__float_as_uint(a_ + b_) & 0xFFFFFFC0u) | (unsigned)(16 * g + 1)); }
            { const float a_ = (g == 0 ? s1[0] : g == 1 ? s1[1] : g == 2 ? s1[4] : NEGV), b_ = (g == 0 ? s2[2] : g == 1 ? s2[2] : g == 2 ? s2[1] : NEGV); cand[2] = __uint_as_float((__float_as_uint(a_ + b_) & 0xFFFFFFC0u) | (unsigned)(16 * g + 2)); }
            { const float a_ = (g == 0 ? s1[0] : g == 1 ? s1[1] : g == 2 ? s1[4] : NEGV), b_ = (g == 0 ? s2[3] : g == 1 ? s2[3] : g == 2 ? s2[2] : NEGV); cand[3] = __uint_as_float((__float_as_uint(a_ + b_) & 0xFFFFFFC0u) | (unsigned)(16 * g + 3)); }
            { const float a_ = (g == 0 ? s1[0] : g == 1 ? s1[1] : g == 2 ? s1[5] : NEGV), b_ = (g == 0 ? s2[4] : g == 1 ? s2[4] : g == 2 ? s2[0] : NEGV); cand[4] = __uint_as_float((__float_as_uint(a_ + b_) & 0xFFFFFFC0u) | (unsigned)(16 * g + 4)); }
            { const float a_ = (g == 0 ? s1[0] : g == 1 ? s1[1] : g == 2 ? s1[5] : NEGV), b_ = (g == 0 ? s2[5] : g == 1 ? s2[5] : g == 2 ? s2[1] : NEGV); cand[5] = __uint_as_float((__float_as_uint(a_ + b_) & 0xFFFFFFC0u) | (unsigned)(16 * g + 5)); }
            { const float a_ = (g == 0 ? s1[0] : g == 1 ? s1[1] : g == 2 ? s1[6] : NEGV), b_ = (g == 0 ? s2[6] : g == 1 ? s2[6] : g == 2 ? s2[0] : NEGV); cand[6] = __uint_as_float((__float_as_uint(a_ + b_) & 0xFFFFFFC0u) | (unsigned)(16 * g + 6)); }
            { const float a_ = (g == 0 ? s1[0] : g == 1 ? s1[1] : g == 2 ? s1[6] : NEGV), b_ = (g == 0 ? s2[7] : g == 1 ? s2[7] : g == 2 ? s2[1] : NEGV); cand[7] = __uint_as_float((__float_as_uint(a_ + b_) & 0xFFFFFFC0u) | (unsigned)(16 * g + 7)); }
            { const float a_ = (g == 0 ? s1[0] : g == 1 ? s1[2] : g == 2 ? s1[7] : NEGV), b_ = (g == 0 ? s2[8] : g == 1 ? s2[0] : g == 2 ? s2[0] : NEGV); cand[8] = __uint_as_float((__float_as_uint(a_ + b_) & 0xFFFFFFC0u) | (unsigned)(16 * g + 8)); }
            { const float a_ = (g == 0 ? s1[0] : g == 1 ? s1[2] : g == 2 ? s1[7] : NEGV), b_ = (g == 0 ? s2[9] : g == 1 ? s2[1] : g == 2 ? s2[1] : NEGV); cand[9] = __uint_as_float((__float_as_uint(a_ + b_) & 0xFFFFFFC0u) | (unsigned)(16 * g + 9)); }
            { const float a_ = (g == 0 ? s1[0] : g == 1 ? s1[2] : g == 2 ? s1[8] : NEGV), b_ = (g == 0 ? s2[10] : g == 1 ? s2[2] : g == 2 ? s2[0] : NEGV); cand[10] = __uint_as_float((__float_as_uint(a_ + b_) & 0xFFFFFFC0u) | (unsigned)(16 * g + 10)); }
            { const float a_ = (g == 0 ? s1[0] : g == 1 ? s1[2] : g == 2 ? s1[9] : NEGV), b_ = (g == 0 ? s2[11] : g == 1 ? s2[3] : g == 2 ? s2[0] : NEGV); cand[11] = __uint_as_float((__float_as_uint(a_ + b_) & 0xFFFFFFC0u) | (unsigned)(16 * g + 11)); }
            { const float a_ = (g == 0 ? s1[0] : g == 1 ? s1[2] : g == 2 ? s1[10] : NEGV), b_ = (g == 0 ? s2[12] : g == 1 ? s2[4] : g == 2 ? s2[0] : NEGV); cand[12] = __uint_as_float((__float_as_uint(a_ + b_) & 0xFFFFFFC0u) | (unsigned)(16 * g + 12)); }
            { const float a_ = (g == 0 ? s1[0] : g == 1 ? s1[3] : g == 2 ? s1[11] : NEGV), b_ = (g == 0 ? s2[13] : g == 1 ? s2[0] : g == 2 ? s2[0] : NEGV); cand[13] = __uint_as_float((__float_as_uint(a_ + b_) & 0xFFFFFFC0u) | (unsigned)(16 * g + 13)); }
            { const float a_ = (g == 0 ? s1[0] : g == 1 ? s1[3] : g == 2 ? s1[12] : NEGV), b_ = (g == 0 ? s2[14] : g == 1 ? s2[1] : g == 2 ? s2[0] : NEGV); cand[14] = __uint_as_float((__float_as_uint(a_ + b_) & 0xFFFFFFC0u) | (unsigned)(16 * g + 14)); }
            { const float a_ = (g == 0 ? s1[0] : g == 1 ? s1[3] : g == 2 ? s1[13] : NEGV), b_ = (g == 0 ? s2[15] : g == 1 ? s2[2] : g == 2 ? s2[0] : NEGV); cand[15] = __uint_as_float((__float_as_uint(a_ + b_) & 0xFFFFFFC0u) | (unsigned)(16 * g + 15)); }
        sort16(cand);
        xmerge(cand, 16); xmerge(cand, 32);
        float den = 0.f, ex[16];
#pragma unroll
        for (int i = 0; i < 16; ++i) { ex[i] = __expf(cand[i] - cand[0]); den += ex[i]; }
        const float inv = 1.f / den;
        unsigned short eo[4]; float go[4];
#pragma unroll
        for (int e = 0; e < 4; ++e) {
            const float cv = (g == 0 ? cand[e] : g == 1 ? cand[4 + e] : g == 2 ? cand[8 + e] : cand[12 + e]);
            const float gv = (g == 0 ? ex[e] : g == 1 ? ex[4 + e] : g == 2 ? ex[8 + e] : ex[12 + e]);
            const unsigned code = __float_as_uint(cv) & 63u; const unsigned ij = ijt[code];
            const unsigned p1 = tab[ij & 15u], p2 = tab[16 + (ij >> 4)];
            eo[e] = (unsigned short)((p1 & 127u) * 128u + (p2 & 127u)); go[e] = gv * inv; }
        u32x2 ov; ov.x = (unsigned)eo[0] | ((unsigned)eo[1] << 16); ov.y = (unsigned)eo[2] | ((unsigned)eo[3] << 16);
        *(u32x2*)(pidx + (t0 + i16) * 128 + hh * 16 + 4 * g) = ov;
        *(f32x4*)(pgate + (t0 + i16) * 128 + hh * 16 + 4 * g) = (f32x4){go[0], go[1], go[2], go[3]};
    }
    __syncthreads();
}

#define GAS __attribute__((address_space(1)))
typedef GAS unsigned gu32;
#define RLX_AGENT __ATOMIC_RELAXED, __HIP_MEMORY_SCOPE_AGENT
#define XB_TMO      128
#define XB_XCNT(j)  (256  + 64 * (j))
#define XB_XSUB(j)  (1280 + 64 * (j))
#define XB_XGEN(j)  (2304 + 64 * (j))
#define XB_TOP      3328
#define XB_TOPGEN   3392
#define XCD_BAR_WORDS 3456
#define XB_SPIN_CAP (1u << 18)

__device__ __forceinline__ unsigned xb_ld(unsigned* p)              { return __hip_atomic_load(p, __ATOMIC_RELAXED, __HIP_MEMORY_SCOPE_AGENT); }
__device__ __forceinline__ unsigned xb_add(unsigned* p, unsigned v) { return __hip_atomic_fetch_add(p, v, __ATOMIC_RELAXED, __HIP_MEMORY_SCOPE_AGENT); }
__device__ __forceinline__ unsigned xb_xcc_id() { return (unsigned)__builtin_amdgcn_s_getreg((3 << 11) | 20) & 0xFu; }
#define XB_SPIN(cond, bar) do { unsigned _sp = 0; while (cond) { __builtin_amdgcn_s_sleep(1); \
    if ((++_sp & 255u) == 0u) { if (xb_ld(&(bar)[XB_TMO])) break; if (_sp > XB_SPIN_CAP) { atomicAdd(&(bar)[XB_TMO], 1u); break; } } } } while (0)

struct XcdBarrier {
    unsigned* bar; unsigned x;
    volatile LAS unsigned* st;
};

__device__ __forceinline__ XcdBarrier xcd_barrier_post(unsigned* bar, volatile LAS unsigned* st) {
    XcdBarrier b; b.bar = bar; b.x = xb_xcc_id(); b.st = st;
    if (threadIdx.x == 0) (void)xb_add(&bar[XB_XCNT(b.x)], 1u);
    return b;
}
__device__ __forceinline__ void xcd_barrier_complete(unsigned* bar, unsigned x, unsigned& nloc, unsigned& nx) {
    const unsigned G = gridDim.x * gridDim.y * gridDim.z;
    unsigned sum, cnt, mine, sp = 0u;
    for (;;) {
        sum = 0u; cnt = 0u; mine = 0u;
#pragma unroll
        for (unsigned j = 0; j < 16; ++j) { const unsigned c = xb_ld(&bar[XB_XCNT(j)]); sum += c; cnt += (c > 0u) ? 1u : 0u; mine = (j == x) ? c : mine; }
        if (sum == G) break;
        __builtin_amdgcn_s_sleep(1);
        if ((++sp & 255u) == 0u) { if (xb_ld(&bar[XB_TMO])) break; if (sp > XB_SPIN_CAP) { atomicAdd(&bar[XB_TMO], 1u); break; } }
    }
    nloc = mine > 0u ? mine : 1u; nx = cnt > 0u ? cnt : 1u;
}

__device__ __forceinline__ void xcd_barrier(const XcdBarrier& b) {
    asm volatile("s_waitcnt vmcnt(0)" ::: "memory");
    __syncthreads();
    if (threadIdx.x == 0) {
        unsigned* bar = b.bar;
        __builtin_amdgcn_s_waitcnt(0);
        unsigned nloc = b.st[0], nx = b.st[1];
        if (nloc == 0u) { xcd_barrier_complete(bar, b.x, nloc, nx); b.st[0] = nloc; b.st[1] = nx; }
        const unsigned old = xb_add(&bar[XB_XSUB(b.x)], 1u);
        const unsigned gen = old / nloc;
        if (old + 1u == (gen + 1u) * nloc) {
            __builtin_amdgcn_fence(__ATOMIC_RELEASE, "agent");
            asm volatile("s_waitcnt vmcnt(0)" ::: "memory");
            const unsigned og = xb_add(&bar[XB_TOP], 1u);
            const unsigned tg = og / nx;
            if (og + 1u == (tg + 1u) * nx) xb_add(&bar[XB_TOPGEN], 1u);
            else XB_SPIN(xb_ld(&bar[XB_TOPGEN]) == tg, bar);
            __builtin_amdgcn_fence(__ATOMIC_ACQUIRE, "agent");
            xb_add(&bar[XB_XGEN(b.x)], 1u);
            asm volatile("s_waitcnt vmcnt(0)" ::: "memory");
        } else {
            XB_SPIN(xb_ld(&bar[XB_XGEN(b.x)]) == gen, bar);
            __builtin_amdgcn_fence(__ATOMIC_ACQUIRE, "agent");
            asm volatile("s_waitcnt vmcnt(0)" ::: "memory");
        }
    }
    __syncthreads();
}


constexpr int N_PHASES = 14;
constexpr int CW_BAR = 4096;
constexpr size_t CTL_ZERO_BYTES = 64 * 1024;
constexpr int MISC_OFF = LDS_BYTES - 256;

template <int PH>
__device__ __forceinline__ void run_phase(const Ctx& C, const Args& a) {
    bf16_t* R0 = C.bfp(WS_R0); bf16_t* R1 = C.bfp(WS_R1); bf16_t* R2 = C.bfp(WS_R2); bf16_t* R3 = C.bfp(WS_R3);
    bf16_t* OB = (bf16_t*)a.out;
    const size_t TD = (size_t)T * 1024;
    if constexpr (PH == 0) p_prep(C);
    if constexpr (PH == 1) p_rownorm(C, C.in[0], C.in[4], 0, 1024, R0);
    if constexpr (PH == 2) {
        { pg8::Gemm g{R0, C.bfp(WS_WIN_T), T, 6144, 1024}; pg8::StaticOrder S; S.init(T, 6144, C.G, C.bid);
          pg8::EpiInProj e{R1, R2, R3, R3 + TD, R3 + 2 * TD};
          pg8::gemm_phase<pg8::EpiInProj, pg8::StaticOrder, true, true>(C.lds, g, S, e); }
        p_dt(C, R0, C.bfp(WS_WDT_T), C.f32p(WS_DT));
    }
    if constexpr (PH == 3) { p_conv(C, R2, OB); p_na(C, R3, R3 + TD, R3 + 2 * TD); }
    if constexpr (PH == 4) p_ssd(C, OB, C.f32p(WS_DT), R2, R2 + TD);
    if constexpr (PH == 5) p_combine(C, R2, R2 + TD, R1, C.f32p(WS_RSTD));
    if constexpr (PH == 6) {
        pg8::MultiOrder S; S.b.init(T, 1024, C.G, C.bid); S.nk = 4;
        pg8::Gemm g{R0, C.bfp(WS_WG_T), T, 1024, 1024, R0, C.bfp(WS_WG_T) + (size_t)1024 * 1024, R1, C.bfp(WS_WSSD_T), R3, C.bfp(WS_WNA_T)};
        pg8::EpiMix e{OB, OB + TD, R2 + TD, C.f32p(WS_RSTD)};
        pg8::gemm_phase<pg8::EpiMix, pg8::MultiOrder, true, true>(C.lds, g, S, e);
    }
    if constexpr (PH == 7) { pg8::Gemm g{R2 + TD, C.bfp(WS_WOUT_T), T, 1024, 1024}; pg8::StaticOrder S; S.init(T, 1024, C.G, C.bid);
        pg8::EpiD3 e{R3 + TD, C.in[0], C.f32p(WS_MOD)}; pg8::gemm_phase<pg8::EpiD3, pg8::StaticOrder, true, true>(C.lds, g, S, e); }
    if constexpr (PH == 8) { p_rownorm_b(C, R3 + TD, C.in[18], 3072, 4096, R0); p_cvt_tables8(C, (unsigned char*)R2, (unsigned char*)R2 + (size_t)16384 * 1024); }
    if constexpr (PH == 9) { pg8::Gemm g{R0, C.bfp(WS_WPQ_T), T, 2048, 1024}; pg8::StaticOrder S; S.init(T, 2048, C.G, C.bid);
        pg8::EpiQp e{OB}; pg8::gemm_phase<pg8::EpiQp, pg8::StaticOrder, true, true>(C.lds, g, S, e);
        asm volatile("s_waitcnt vmcnt(0)" ::: "memory"); __syncthreads();
        if (C.tid == 0) __builtin_amdgcn_fence(__ATOMIC_ACQUIRE, "agent");
        asm volatile("s_waitcnt vmcnt(0)" ::: "memory"); __syncthreads();
        p_topk<true>(C, OB, C.bfp(WS_KEYS), (unsigned short*)R1, (float*)(R1 + 4 * MiB)); }
    if constexpr (PH == 10) p_gu(C, R0, (const unsigned short*)R1, (const unsigned char*)R2, a.out);
    if constexpr (PH == 11) p_gc(C, a.out, (const float*)(R1 + 4 * MiB), (float*)((unsigned char*)R2 + 32 * MiB));
    if constexpr (PH == 12) p_gv(C, (const float*)((unsigned char*)R2 + 32 * MiB), (const unsigned short*)R1, (const unsigned char*)R2 + (size_t)16384 * 1024, R3);
    if constexpr (PH == 13) p_gf(C, R3 + TD, R3, a.out);
}

template <int PH> struct PhaseLoop {
    static __device__ __forceinline__ void run(const Ctx& C, const Args& a, const XcdBarrier& bar) {
        if (PH >= a.ph_lo && PH < a.ph_hi) { run_phase<PH>(C, a); if (PH + 1 < a.ph_hi) xcd_barrier(bar); }
        PhaseLoop<PH + 1>::run(C, a, bar);
    }
};
template <> struct PhaseLoop<N_PHASES> { static __device__ __forceinline__ void run(const Ctx&, const Args&, const XcdBarrier&) {} };

__global__ void __launch_bounds__(NTHR, 2) mega(Args a) {
    extern __shared__ __attribute__((aligned(16))) unsigned char lds_raw[];
    Ctx C; C.in = a.in; C.out = a.out; C.ws = a.ws; C.tid = threadIdx.x; C.lane = C.tid & 63; C.wave = __builtin_amdgcn_readfirstlane(C.tid >> 6);
    C.G = gridDim.x; C.bid = blockIdx.x; C.lds = (LAS unsigned char*)lds_raw;
    volatile LAS unsigned* MISC = (volatile LAS unsigned*)(C.lds + MISC_OFF);
    if (C.tid < 64) MISC[C.tid] = 0u;
    __syncthreads();
    XcdBarrier bar; bar.bar = (unsigned*)(a.ws + WS_CTL) + CW_BAR; bar.x = 0; bar.st = nullptr;
    if (a.ph_hi - a.ph_lo > 1) bar = xcd_barrier_post((unsigned*)(a.ws + WS_CTL) + CW_BAR, MISC + 8);
    PhaseLoop<0>::run(C, a, bar);
}

extern "C" void kernel_launch(void* const* d_in, const int* in_sizes, int n_in, void* d_out, int out_size, void* d_ws, size_t ws_size, hipStream_t stream) {
    static int grid = 0;
    if (grid == 0) {
        if (n_in != 24 || out_size != T * D || ws_size < WS_END) { fprintf(stderr, "kernel_launch: unexpected shapes n_in %d out %d ws %zu\n", n_in, out_size, ws_size); grid = -1; return; }
        int dev = 0, cus = 0;
        if (hipGetDevice(&dev) != hipSuccess || hipDeviceGetAttribute(&cus, hipDeviceAttributeMultiprocessorCount, dev) != hipSuccess) { grid = -1; return; }
        if (hipFuncSetAttribute((const void*)mega, hipFuncAttributeMaxDynamicSharedMemorySize, LDS_BYTES) != hipSuccess) { grid = -1; return; }
        grid = cus;
    }
    if (grid < 0) return;
    (void)hipMemsetAsync((char*)d_ws + WS_CTL, 0, CTL_ZERO_BYTES, stream);
    Args a{};
    for (int i = 0; i < 24; ++i) a.in[i] = (const float*)d_in[i];
    a.out = (float*)d_out; a.ws = (unsigned char*)d_ws;
    a.ph_lo = 0; a.ph_hi = N_PHASES;
    hipLaunchKernelGGL(mega, dim3(grid), dim3(NTHR), LDS_BYTES, stream, a);
}
```

```cpp
#include <hip/hip_runtime.h>
#include <cstdio>
#include <cstdint>

#define LAS __attribute__((address_space(3)))
typedef unsigned short bf16_t;
typedef float f32x4 __attribute__((ext_vector_type(4)));
typedef unsigned u32x4 __attribute__((ext_vector_type(4)));
typedef unsigned u32x2 __attribute__((ext_vector_type(2)));
typedef __bf16 bf16x2_t __attribute__((ext_vector_type(2)));

constexpr int T = 32768, D = 1024, NB = 8, SEQ = 4096;
constexpr int NWAVES = 8, NTHR = 512;
constexpr float EPS = 1e-6f;
constexpr int OFF_Z = 0, OFF_XBC = 1024, OFF_DTF = 3072, OFF_DTB = 3088, OFF_QKV = 3104, OFF_GS = 6176, OFF_GN = 7200, D_IN = 8224;

constexpr size_t MiB = 1u << 20;
constexpr size_t WS_CTL = 0;
constexpr size_t WS_MOD = 1 * MiB;
constexpr size_t WS_RSTD = 1 * MiB + 512 * 1024;
constexpr size_t WS_DT = 2 * MiB;
constexpr size_t WS_WIN_T = 6 * MiB;
constexpr size_t WS_WG_T = 18 * MiB;
constexpr size_t WS_WDT_T = 22 * MiB;
constexpr size_t WS_KEYS = 22 * MiB + 512 * 1024;
constexpr size_t WS_WSSD_T = 23 * MiB, WS_WNA_T = 25 * MiB, WS_WOUT_T = 27 * MiB, WS_WPQ_T = 29 * MiB;
constexpr size_t WS_R0 = 40 * MiB, WS_R1 = 104 * MiB, WS_R2 = 168 * MiB, WS_R3 = 296 * MiB, WS_END = 488 * MiB;

constexpr int LDS_BYTES = 163840;

struct Args { const float* in[24]; float* out; unsigned char* ws; int ph_lo, ph_hi; };

__device__ __forceinline__ float bf2f(unsigned v) { return __uint_as_float(v << 16); }
__device__ __forceinline__ float bflo(unsigned v) { return __uint_as_float(v << 16); }
__device__ __forceinline__ float bfhi(unsigned v) { return __uint_as_float(v & 0xffff0000u); }
__device__ __forceinline__ unsigned f2bf(float f) { unsigned u = __float_as_uint(f); return (u + 0x7fffu + ((u >> 16) & 1u)) >> 16; }
typedef float f32x2_t __attribute__((ext_vector_type(2)));
__device__ __forceinline__ unsigned pk2(float lo, float hi) { f32x2_t v = {lo, hi}; bf16x2_t b = __builtin_convertvector(v, bf16x2_t); return __builtin_bit_cast(unsigned, b); }
__device__ __forceinline__ float wave_sum(float v) {
#pragma unroll
    for (int o = 1; o < 64; o <<= 1) v += __shfl_xor(v, o);
    return v;
}
__device__ __forceinline__ float silu_f(float x) { return x / (1.f + __expf(-x)); }
__device__ __forceinline__ float sigmoid_f(float x) { return 1.f / (1.f + __expf(-x)); }
__device__ __forceinline__ float softplus_f(float x) { return x > 20.f ? x : log1pf(__expf(x)); }
__device__ __forceinline__ float gelu_f(float x) { return 0.5f * x * (1.f + erff(x * 0.70710678118654752f)); }

struct Ctx {
    const float* const* in; float* out; unsigned char* ws;
    int tid, lane, wave, G, bid;
    LAS unsigned char* lds;
    __device__ __forceinline__ float* f32p(size_t off) const { return (float*)(ws + off); }
    __device__ __forceinline__ bf16_t* bfp(size_t off) const { return (bf16_t*)(ws + off); }
};

__device__ __forceinline__ void tr_item(const float* W, int ldw, int col0, int K, bf16_t* WT, int row_off, LAS float* scr, int item, int nblk, int lane, const float* kscale) {
    const int kb = item / nblk, nb = item % nblk, k0 = 64 * kb, n0 = 32 * nb;
#pragma unroll 8
    for (int i = 0; i < 32; ++i) { const int kk = 2 * i + (lane >> 5); float x = W[(size_t)(k0 + kk) * ldw + col0 + n0 + (lane & 31)]; if (kscale) x *= kscale[k0 + kk]; scr[kk * 33 + (lane & 31)] = x; }
    asm volatile("s_waitcnt lgkmcnt(0)" ::: "memory");
    const int c = lane & 7;
#pragma unroll
    for (int j = 0; j < 4; ++j) { const int n = (lane >> 3) + 8 * j; const LAS float* sp = scr + (8 * c) * 33 + n;
        u32x4 o; o.x = pk2(sp[0 * 33], sp[1 * 33]); o.y = pk2(sp[2 * 33], sp[3 * 33]); o.z = pk2(sp[4 * 33], sp[5 * 33]); o.w = pk2(sp[6 * 33], sp[7 * 33]);
        *(u32x4*)(WT + (size_t)(row_off + n0 + n) * K + k0 + 8 * c) = o; }
    asm volatile("s_waitcnt lgkmcnt(0)" ::: "memory");
}
__device__ __forceinline__ void p_prep(const Ctx& C) {
    const float* c = C.in[1]; const float* w_ada = C.in[2]; const float* b_ada = C.in[3];
    float* mod = C.f32p(WS_MOD);
    LAS float* sc = (LAS float*)C.lds;
    LAS float* red = sc + 8192;
    for (int i = C.tid; i < 8192; i += NTHR) sc[i] = silu_f(c[i]);
    __syncthreads();
    for (int jb = C.bid; jb < 256; jb += C.G) {
        const int j0 = jb * 24, jl = C.tid % 24, kq = C.tid / 24;
        if (C.tid < 504) { float acc[8];
#pragma unroll
            for (int b = 0; b < 8; ++b) acc[b] = 0.f;
            for (int k = kq; k < 1024; k += 21) { const float w = w_ada[(size_t)k * 6144 + j0 + jl];
#pragma unroll
                for (int b = 0; b < 8; ++b) acc[b] += sc[b * 1024 + k] * w; }
#pragma unroll
            for (int b = 0; b < 8; ++b) red[(kq * 24 + jl) * 8 + b] = acc[b]; }
        __syncthreads();
        if (C.tid < 192) { const int jl2 = C.tid % 24, b2 = C.tid / 24; float sacc = b_ada[j0 + jl2];
            for (int kq2 = 0; kq2 < 21; ++kq2) sacc += red[(kq2 * 24 + jl2) * 8 + b2];
            mod[b2 * 6144 + j0 + jl2] = sacc; }
        __syncthreads();
    }
    LAS float* scr = (LAS float*)(C.lds + 65536 + C.wave * 8448);
    const int gw = C.bid * NWAVES + C.wave, NGW = C.G * NWAVES;
    const float* w_in = C.in[5];
    constexpr int I_A = 16 * 96, I_B = 16 * 96, I_G = 16 * 64, I_DT = 16, I_S = 16 * 32, I_PQ = 16 * 64;
    constexpr int NIT = I_A + I_B + I_G + I_DT + 3 * I_S + I_PQ;
    for (int it = gw; it < NIT; it += NGW) {
        int r = it;
        if (r < I_A) { tr_item(w_in, D_IN, 0, D, C.bfp(WS_WIN_T), 0, scr, r, 96, C.lane, nullptr); continue; } r -= I_A;
        if (r < I_B) { tr_item(w_in, D_IN, OFF_QKV, D, C.bfp(WS_WIN_T), 3072, scr, r, 96, C.lane, nullptr); continue; } r -= I_B;
        if (r < I_G) { tr_item(w_in, D_IN, OFF_GS, D, C.bfp(WS_WG_T), 0, scr, r, 64, C.lane, nullptr); continue; } r -= I_G;
        if (r < I_DT) { tr_item(w_in, D_IN, OFF_DTF, D, C.bfp(WS_WDT_T), 0, scr, r, 1, C.lane, nullptr); continue; } r -= I_DT;
        if (r < I_S) { tr_item(C.in[14], D, 0, D, C.bfp(WS_WSSD_T), 0, scr, r, 32, C.lane, C.in[13]); continue; } r -= I_S;
        if (r < I_S) { tr_item(C.in[16], D, 0, D, C.bfp(WS_WNA_T), 0, scr, r, 32, C.lane, nullptr); continue; } r -= I_S;
        if (r < I_S) { tr_item(C.in[17], D, 0, D, C.bfp(WS_WOUT_T), 0, scr, r, 32, C.lane, nullptr); continue; } r -= I_S;
        tr_item(C.in[19], 2048, 0, D, C.bfp(WS_WPQ_T), 0, scr, r, 64, C.lane, nullptr);
    }
    { const int gt = C.bid * NTHR + C.tid, NT = C.G * NTHR; const float* kf = C.in[20]; bf16_t* kb = C.bfp(WS_KEYS);
      for (int i = gt; i < 2 * 128 * 128; i += NT) kb[i] = (bf16_t)f2bf(kf[i]); }
    __syncthreads();
}

__device__ __forceinline__ void p_rownorm(const Ctx& C, const float* X, const float* gamma, int sh_off, int sc_off, bf16_t* dst) {
    const float* mod = C.f32p(WS_MOD);
    const int gw = C.bid * NWAVES + C.wave, NGW = C.G * NWAVES;
    for (int row0 = gw * 4; row0 < T; row0 += NGW * 4) {
        const int b = row0 / SEQ;
        f32x4 v[4][4]; float s[4];
#pragma unroll
        for (int r = 0; r < 4; ++r) { const f32x4* xr = (const f32x4*)(X + (size_t)(row0 + r) * D) + C.lane;
#pragma unroll
            for (int j = 0; j < 4; ++j) v[r][j] = xr[64 * j]; }
#pragma unroll
        for (int r = 0; r < 4; ++r) { float a = 0.f;
#pragma unroll
            for (int j = 0; j < 4; ++j) a += (v[r][j].x * v[r][j].x + v[r][j].y * v[r][j].y) + (v[r][j].z * v[r][j].z + v[r][j].w * v[r][j].w);
            s[r] = rsqrtf(wave_sum(a) * (1.f / D) + EPS); }
#pragma unroll
        for (int j = 0; j < 4; ++j) {
            const int col = 4 * C.lane + 256 * j;
            const f32x4 g = *(const f32x4*)(gamma + col), sh = *(const f32x4*)(mod + b * 6144 + sh_off + col), sc = *(const f32x4*)(mod + b * 6144 + sc_off + col);
            const f32x4 gs = g * (sc + 1.f);
#pragma unroll
            for (int r = 0; r < 4; ++r) { const f32x4 y = v[r][j] * s[r] * gs + sh; u32x2 w; w.x = pk2(y.x, y.y); w.y = pk2(y.z, y.w);
                *((u32x2*)(dst + (size_t)(row0 + r) * D) + C.lane + 64 * j) = w; }
        }
    }
}

__device__ __forceinline__ void p_rownorm_b(const Ctx& C, const bf16_t* X, const float* gamma, int sh_off, int sc_off, bf16_t* dst) {
    const float* mod = C.f32p(WS_MOD);
    const int gw = C.bid * NWAVES + C.wave, NGW = C.G * NWAVES;
    for (int row0 = gw * 4; row0 < T; row0 += NGW * 4) {
        const int b = row0 / SEQ;
        u32x2 w[4][4]; float s[4];
#pragma unroll
        for (int r = 0; r < 4; ++r)
#pragma unroll
            for (int j = 0; j < 4; ++j) w[r][j] = *((const u32x2*)(X + (size_t)(row0 + r) * D) + C.lane + 64 * j);
        f32x4 v[4][4];
#pragma unroll
        for (int r = 0; r < 4; ++r) { float a = 0.f;
#pragma unroll
            for (int j = 0; j < 4; ++j) { v[r][j].x = bflo(w[r][j].x); v[r][j].y = bfhi(w[r][j].x); v[r][j].z = bflo(w[r][j].y); v[r][j].w = bfhi(w[r][j].y);
                a += (v[r][j].x * v[r][j].x + v[r][j].y * v[r][j].y) + (v[r][j].z * v[r][j].z + v[r][j].w * v[r][j].w); }
            s[r] = rsqrtf(wave_sum(a) * (1.f / D) + EPS); }
#pragma unroll
        for (int j = 0; j < 4; ++j) {
            const int col = 4 * C.lane + 256 * j;
            const f32x4 g = *(const f32x4*)(gamma + col), sh = *(const f32x4*)(mod + b * 6144 + sh_off + col), sc = *(const f32x4*)(mod + b * 6144 + sc_off + col);
            const f32x4 gs = g * (sc + 1.f);
#pragma unroll
            for (int r = 0; r < 4; ++r) { const f32x4 y = v[r][j] * s[r] * gs + sh; u32x2 o; o.x = pk2(y.x, y.y); o.y = pk2(y.z, y.w);
                *((u32x2*)(dst + (size_t)(row0 + r) * D) + C.lane + 64 * j) = o; }
        }
    }
}

__device__ __forceinline__ void p_dt(const Ctx& C, const bf16_t* n1, const bf16_t* wdt, float* dt) {
    typedef short bf16x8 __attribute__((ext_vector_type(8)));
    const float* bf = C.in[8]; const float* bb = C.in[9];
    const int gw = C.bid * NWAVES + C.wave, NGW = C.G * NWAVES, lane = C.lane, g = lane >> 4, i16 = lane & 15;
    for (int tile = gw; tile < T / 16; tile += NGW) {
        const size_t t0 = (size_t)tile * 16;
        f32x4 a0 = (f32x4){0.f, 0.f, 0.f, 0.f}, a1 = a0;
#pragma unroll 8
        for (int ks = 0; ks < 32; ++ks) {
            const bf16x8 av = *(const bf16x8*)(n1 + (t0 + i16) * 1024 + ks * 32 + g * 8);
            const bf16x8 b0 = *(const bf16x8*)(wdt + (size_t)i16 * 1024 + ks * 32 + g * 8), b1 = *(const bf16x8*)(wdt + (size_t)(16 + i16) * 1024 + ks * 32 + g * 8);
            a0 = __builtin_amdgcn_mfma_f32_16x16x32_bf16(av, b0, a0, 0, 0, 0); a1 = __builtin_amdgcn_mfma_f32_16x16x32_bf16(av, b1, a1, 0, 0, 0); }
        const float bias0 = bf[i16], bias1 = bb[i16];
#pragma unroll
        for (int r = 0; r < 4; ++r) { dt[(t0 + 4 * g + r) * 32 + i16] = softplus_f(a0[r] + bias0); dt[(t0 + 4 * g + r) * 32 + 16 + i16] = softplus_f(a1[r] + bias1); }
    }
}

__device__ __forceinline__ void p_conv(const Ctx& C, const bf16_t* xbc, bf16_t* xc) {
    const float* cw = C.in[6]; const float* cb = C.in[7];
    const int gt = C.bid * NTHR + C.tid, NT = C.G * NTHR;
    for (int i = gt; i < (T / 8) * 256; i += NT) {
        const int cg = i & 255, run = i >> 8, t0 = run * 8, l0 = t0 & (SEQ - 1), ch = cg * 8;
        float w[5][8], acc[8][8];
#pragma unroll
        for (int j = 0; j < 5; ++j) { const f32x4 w0 = *(const f32x4*)(cw + j * 2048 + ch), w1 = *(const f32x4*)(cw + j * 2048 + ch + 4);
            w[j][0] = w0.x; w[j][1] = w0.y; w[j][2] = w0.z; w[j][3] = w0.w; w[j][4] = w1.x; w[j][5] = w1.y; w[j][6] = w1.z; w[j][7] = w1.w; }
        { const f32x4 b0 = *(const f32x4*)(cb + ch), b1 = *(const f32x4*)(cb + ch + 4);
#pragma unroll
          for (int o = 0; o < 8; ++o) { acc[o][0] = b0.x; acc[o][1] = b0.y; acc[o][2] = b0.z; acc[o][3] = b0.w; acc[o][4] = b1.x; acc[o][5] = b1.y; acc[o][6] = b1.z; acc[o][7] = b1.w; } }
        u32x4 rw[12];
#pragma unroll
        for (int rr = 0; rr < 12; ++rr) { const int ll = l0 + rr - 2; rw[rr] = (u32x4){0u, 0u, 0u, 0u};
            if (ll >= 0 && ll < SEQ) rw[rr] = *(const u32x4*)(xbc + (size_t)(t0 + rr - 2) * 2048 + ch); }
#pragma unroll
        for (int rr = 0; rr < 12; ++rr) {
            const float x[8] = {bflo(rw[rr].x), bfhi(rw[rr].x), bflo(rw[rr].y), bfhi(rw[rr].y), bflo(rw[rr].z), bfhi(rw[rr].z), bflo(rw[rr].w), bfhi(rw[rr].w)};
#pragma unroll
            for (int j = 0; j < 5; ++j) { const int o = rr - j; if (o >= 0 && o < 8) {
#pragma unroll
                for (int q = 0; q < 8; ++q) acc[o][q] += w[j][q] * x[q]; } }
        }
#pragma unroll
        for (int o = 0; o < 8; ++o) { u32x4 ov; ov.x = pk2(silu_f(acc[o][0]), silu_f(acc[o][1])); ov.y = pk2(silu_f(acc[o][2]), silu_f(acc[o][3])); ov.z = pk2(silu_f(acc[o][4]), silu_f(acc[o][5])); ov.w = pk2(silu_f(acc[o][6]), silu_f(acc[o][7]));
            *(u32x4*)(xc + (size_t)(t0 + o) * 2048 + ch) = ov; }
    }
}

namespace ssd {
typedef short bf16x8 __attribute__((ext_vector_type(8)));
typedef short s16x4 __attribute__((ext_vector_type(4)));
constexpr int RS = 272, RSX = 144;
constexpr int CN = 0, BN = 34816, BS = 69632, SL = 104448, SLB = 17408, XN = 139264, CSB = 157696;
__device__ __forceinline__ unsigned pkbf(float lo, float hi) { return pk2(lo, hi); }
__device__ __forceinline__ bf16x8 trfrag_p(LAS unsigned char* base, int stride, int ks, int c, int g, int q, int pp) {
    LAS unsigned char* a0 = base + (32 * ks + 4 * g + q) * stride + 32 * c + 8 * pp;
    const s16x4 v0 = __builtin_amdgcn_ds_read_tr16_b64_v4i16((LAS s16x4*)a0);
    const s16x4 v1 = __builtin_amdgcn_ds_read_tr16_b64_v4i16((LAS s16x4*)(a0 + 16 * stride));
    bf16x8 r; r[0] = v0[0]; r[1] = v0[1]; r[2] = v0[2]; r[3] = v0[3]; r[4] = v1[0]; r[5] = v1[1]; r[6] = v1[2]; r[7] = v1[3]; return r;
}
}
__device__ __forceinline__ void p_ssd(const Ctx& C, const bf16_t* xc, const float* dtb, bf16_t* yf, bf16_t* yb) {
    using namespace ssd;
    LAS unsigned char* L = C.lds;
    const int tid = C.tid, lane = C.lane, w = C.wave, g = lane >> 4, i16 = lane & 15, q = (lane >> 2) & 3, pp = lane & 3;
    for (int unit = C.bid; unit < 256; unit += C.G) {
        const int dir = unit & 1, hd = (unit >> 1) & 15, b = unit >> 5, grp = hd >> 2;
        const float a = -__expf((dir ? C.in[11] : C.in[10])[hd]);
        const float dsk = dir ? 0.f : C.in[12][hd];
        bf16_t* yout = dir ? yb : yf;
        f32x4 sacc[4];
#pragma unroll
        for (int pt = 0; pt < 4; ++pt) sacc[pt] = (f32x4){0.f, 0.f, 0.f, 0.f};
        __syncthreads();
        for (int i = tid; i < 2 * SLB / 4; i += NTHR) ((LAS unsigned*)(L + SL))[i] = 0u;
        u32x4 pfC[4], pfB[4], pfX[2]; float pfd0 = 0.f, pfd1 = 0.f;
#define SSD_ISSUE(ci_) do { const int c_ = dir ? (31 - (ci_)) : (ci_); const size_t t0_ = (size_t)b * SEQ + (size_t)c_ * 128; \
            _Pragma("unroll") for (int i_ = 0; i_ < 4; ++i_) { const int idx_ = tid + NTHR * i_, l_ = idx_ >> 4, cc_ = idx_ & 15; const bf16_t* rp_ = xc + (t0_ + l_) * 2048 + grp * 128 + cc_ * 8; \
                pfB[i_] = *(const u32x4*)(rp_ + 1024); pfC[i_] = *(const u32x4*)(rp_ + 1536); } \
            _Pragma("unroll") for (int i_ = 0; i_ < 2; ++i_) { const int idx_ = tid + NTHR * i_, l_ = idx_ >> 3, cc_ = idx_ & 7; pfX[i_] = *(const u32x4*)(xc + (t0_ + l_) * 2048 + hd * 64 + cc_ * 8); } \
            if (w == 0) { const int l0_ = dir ? (127 - 2 * lane) : (2 * lane), l1_ = dir ? (126 - 2 * lane) : (2 * lane + 1); \
                pfd0 = dtb[(t0_ + l0_) * 32 + dir * 16 + hd]; pfd1 = dtb[(t0_ + l1_) * 32 + dir * 16 + hd]; } } while (0)
#define SSD_SCAN(buf_) do { if (w == 0) { const float da0_ = pfd0 * a, da1_ = pfd1 * a; const float p1_ = da0_ + da1_; float s_ = p1_; \
            _Pragma("unroll") for (int o_ = 1; o_ < 64; o_ <<= 1) { const float t_ = __shfl_up(s_, o_); if (lane >= o_) s_ += t_; } \
            const float ex_ = s_ - p1_, cs0_ = ex_ + da0_, cs1_ = ex_ + p1_, tot_ = __shfl(s_, 63); \
            const int l0_ = dir ? (127 - 2 * lane) : (2 * lane), l1_ = dir ? (126 - 2 * lane) : (2 * lane + 1); \
            LAS float* cb_ = (LAS float*)(L + CSB + (buf_) * 1536); \
            cb_[l0_] = cs0_; cb_[l1_] = cs1_; cb_[128 + l0_] = pfd0; cb_[128 + l1_] = pfd1; cb_[256 + l0_] = pfd0 * __expf(tot_ - cs0_); cb_[256 + l1_] = pfd1 * __expf(tot_ - cs1_); \
            if (lane == 0) *(LAS float*)(L + CSB + 3072 + 8 * (buf_)) = tot_; } } while (0)
#define SSD_WRITE(buf_) do { const LAS float* dw_ = (const LAS float*)(L + CSB + (buf_) * 1536 + 1024); \
            _Pragma("unroll") for (int i_ = 0; i_ < 4; ++i_) { const int idx_ = tid + NTHR * i_, l_ = idx_ >> 4, cc_ = idx_ & 15; \
                *(LAS u32x4*)(L + CN + l_ * RS + cc_ * 16) = pfC[i_]; *(LAS u32x4*)(L + BN + l_ * RS + cc_ * 16) = pfB[i_]; \
                const float sc_ = dw_[l_]; const u32x4 v_ = pfB[i_]; u32x4 o_; \
                o_.x = pkbf(bflo(v_.x) * sc_, bfhi(v_.x) * sc_); o_.y = pkbf(bflo(v_.y) * sc_, bfhi(v_.y) * sc_); o_.z = pkbf(bflo(v_.z) * sc_, bfhi(v_.z) * sc_); o_.w = pkbf(bflo(v_.w) * sc_, bfhi(v_.w) * sc_); \
                *(LAS u32x4*)(L + BS + l_ * RS + cc_ * 16) = o_; } \
            _Pragma("unroll") for (int i_ = 0; i_ < 2; ++i_) { const int idx_ = tid + NTHR * i_, l_ = idx_ >> 3, cc_ = idx_ & 7; *(LAS u32x4*)(L + XN + l_ * RSX + cc_ * 16) = pfX[i_]; } } while (0)
        SSD_ISSUE(0);
        SSD_SCAN(0);
        __syncthreads();
        SSD_WRITE(0);
        __syncthreads();
        for (int ci = 0; ci < 32; ++ci) {
            const int buf = ci & 1;
            const int c = dir ? (31 - ci) : ci; const size_t t0 = (size_t)b * SEQ + (size_t)c * 128;
            if (ci + 1 < 32) SSD_ISSUE(ci + 1);
            const LAS float* csb = (const LAS float*)(L + CSB + buf * 1536);
            const float cs_l = csb[16 * w + i16];
            const float cs_end = *(const LAS float*)(L + CSB + 3072 + 8 * buf);
            bf16x8 cfrag[4];
#pragma unroll
            for (int ks = 0; ks < 4; ++ks) cfrag[ks] = *(const LAS bf16x8*)(L + CN + (16 * w + i16) * RS + ks * 64 + g * 16);
            u32x2 mreg[8];
            const int lrow = 16 * w + i16;
#pragma unroll
            for (int st = 0; st < 8; ++st) {
                f32x4 acc = (f32x4){0.f, 0.f, 0.f, 0.f};
#pragma unroll
                for (int ks = 0; ks < 4; ++ks) { const bf16x8 af = *(const LAS bf16x8*)(L + BN + (16 * st + i16) * RS + ks * 64 + g * 16);
                    acc = __builtin_amdgcn_mfma_f32_16x16x32_bf16(af, cfrag[ks], acc, 0, 0, 0); }
                const f32x4 cs_s = *(const LAS f32x4*)(csb + 16 * st + 4 * g), dt_s = *(const LAS f32x4*)(csb + 128 + 16 * st + 4 * g);
                float mv[4];
#pragma unroll
                for (int r = 0; r < 4; ++r) { const int srow = 16 * st + 4 * g + r; const bool valid = dir ? (srow >= lrow) : (srow <= lrow);
                    const float e = valid ? __expf(cs_l - cs_s[r]) : 0.f; mv[r] = acc[r] * dt_s[r] * e; }
                mreg[st].x = pkbf(mv[0], mv[1]); mreg[st].y = pkbf(mv[2], mv[3]);
            }
            f32x4 yacc[4];
            const float el = __expf(cs_l);
#pragma unroll
            for (int pt = 0; pt < 4; ++pt) { f32x4 acc = (f32x4){0.f, 0.f, 0.f, 0.f};
#pragma unroll
                for (int ks = 0; ks < 4; ++ks) { const bf16x8 af = *(const LAS bf16x8*)(L + SL + buf * SLB + (16 * pt + i16) * RS + ks * 64 + g * 16);
                    acc = __builtin_amdgcn_mfma_f32_16x16x32_bf16(af, cfrag[ks], acc, 0, 0, 0); }
                yacc[pt] = acc * el; }
#pragma unroll
            for (int ks = 0; ks < 4; ++ks) { u32x4 mw; mw.x = mreg[2 * ks].x; mw.y = mreg[2 * ks].y; mw.z = mreg[2 * ks + 1].x; mw.w = mreg[2 * ks + 1].y;
                const bf16x8 mf = __builtin_bit_cast(bf16x8, mw);
#pragma unroll
                for (int pt = 0; pt < 4; ++pt) { const bf16x8 xf = trfrag_p(L + XN, RSX, ks, pt, g, q, pp); yacc[pt] = __builtin_amdgcn_mfma_f32_16x16x32_bf16(xf, mf, yacc[pt], 0, 0, 0); } }
#pragma unroll
            for (int pt = 0; pt < 4; ++pt) { const u32x2 xv = *(const LAS u32x2*)(L + XN + lrow * RSX + (16 * pt + 4 * g) * 2);
                u32x2 o; o.x = pkbf(yacc[pt][0] + dsk * bflo(xv.x), yacc[pt][1] + dsk * bfhi(xv.x)); o.y = pkbf(yacc[pt][2] + dsk * bflo(xv.y), yacc[pt][3] + dsk * bfhi(xv.y));
                *(u32x2*)(yout + (t0 + lrow) * 1024 + hd * 64 + 16 * pt + 4 * g) = o; }
            { const float dec = __expf(cs_end);
#pragma unroll
              for (int pt = 0; pt < 4; ++pt) sacc[pt] = sacc[pt] * dec; }
#pragma unroll
            for (int ks = 0; ks < 4; ++ks) { const bf16x8 bf = trfrag_p(L + BS, RS, ks, w, g, q, pp);
#pragma unroll
                for (int pt = 0; pt < 4; ++pt) { const bf16x8 xf = trfrag_p(L + XN, RSX, ks, pt, g, q, pp); sacc[pt] = __builtin_amdgcn_mfma_f32_16x16x32_bf16(bf, xf, sacc[pt], 0, 0, 0); } }
#pragma unroll
            for (int pt = 0; pt < 4; ++pt) { u32x2 o; o.x = pkbf(sacc[pt][0], sacc[pt][1]); o.y = pkbf(sacc[pt][2], sacc[pt][3]);
                *(LAS u32x2*)(L + SL + (buf ^ 1) * SLB + (16 * pt + i16) * RS + (16 * w + 4 * g) * 2) = o; }
            if (ci + 1 < 32) SSD_SCAN(buf ^ 1);
            __syncthreads();
            if (ci + 1 < 32) SSD_WRITE(buf ^ 1);
            __syncthreads();
        }
#undef SSD_ISSUE
#undef SSD_SCAN
#undef SSD_WRITE
    }
}

namespace nat {
typedef short bf16x8 __attribute__((ext_vector_type(8)));
typedef short s16x4 __attribute__((ext_vector_type(4)));
constexpr int VH = 65536, RPB = 131072;
__device__ __forceinline__ int voff(int ks, int d) { return ks * 128 + ((((d >> 3) ^ (ks & 7))) << 4) + (d & 7) * 2; }
__device__ __forceinline__ int clampi(int x, int lo, int hi) { return x < lo ? lo : (x > hi ? hi : x); }
}
__device__ __forceinline__ void p_na(const Ctx& C, bf16_t* q, const bf16_t* k, const bf16_t* v) {
    using namespace nat;
    LAS unsigned char* L = C.lds;
    const float* rpb = C.in[15];
    const int tid = C.tid, lane = C.lane, w = C.wave, g = lane >> 4, i16 = lane & 15, qq = (lane >> 2) & 3, pp = lane & 3;
    const int hl = w >> 2, m = w & 3;
    const int bs = (m == 0) ? 0 : (m == 1) ? 8 : (m == 2) ? 24 : 32;
    const int qc = 16 * m + i16, wsx = clampi(qc - 8, 0, 48);
    unsigned vmask = 0u; int dcol[8];
#pragma unroll
    for (int c = 0; c < 8; ++c) { const int kc = bs + (c >> 2) * 16 + 4 * g + (c & 3); if (kc >= wsx && kc < wsx + 16) vmask |= (1u << c); dcol[c] = clampi(kc - qc + 15, 0, 30); }
    for (int unit = C.bid; unit < 256; unit += C.G) {
        const int rseg = unit & 3, hp = (unit >> 2) & 7, b = unit >> 5, h = 2 * hp + hl;
        __syncthreads();
        for (int i = tid; i < 930; i += NTHR) ((LAS float*)(L + RPB))[i] = rpb[(2 * hp) * 465 + i];
#define NA_LOAD_ROW(row_) do { _Pragma("unroll") for (int i_ = 0; i_ < 2; ++i_) { const int idx_ = tid + NTHR * i_, hl_ = idx_ >> 9, col_ = (idx_ >> 3) & 63, dch_ = idx_ & 7; \
            const u32x4 val_ = *(const u32x4*)(v + ((size_t)b * SEQ + (size_t)(row_) * 64 + col_) * 1024 + (2 * hp + hl_) * 64 + dch_ * 8); \
            *(LAS u32x4*)(L + hl_ * VH + voff(((row_) & 7) * 64 + col_, dch_ * 8)) = val_; } } while (0)
        const int r0 = 16 * rseg; int rs_prev = clampi(r0 - 4, 0, 56);
        for (int rr = 0; rr < 8; ++rr) NA_LOAD_ROW(rs_prev + rr);
        __syncthreads();
        const LAS float* rpbl = (const LAS float*)(L + RPB) + hl * 465;
        for (int s = 0; s < 16; ++s) {
            const int r = r0 + s, rs = clampi(r - 4, 0, 56);
            if (rs != rs_prev) { __syncthreads(); NA_LOAD_ROW(rs + 7); __syncthreads(); rs_prev = rs; }
            const size_t tokq = (size_t)b * SEQ + (size_t)r * 64 + qc;
            bf16x8 qf[2];
#pragma unroll
            for (int ks = 0; ks < 2; ++ks) qf[ks] = *(const bf16x8*)(q + tokq * 1024 + h * 64 + ks * 32 + g * 8);
            f32x4 sc[16];
#pragma unroll
            for (int kt = 0; kt < 16; ++kt) { const size_t tokk = (size_t)b * SEQ + (size_t)(rs + (kt >> 1)) * 64 + bs + (kt & 1) * 16 + i16;
                f32x4 acc = (f32x4){0.f, 0.f, 0.f, 0.f};
#pragma unroll
                for (int ks = 0; ks < 2; ++ks) { const bf16x8 kf = *(const bf16x8*)(k + tokk * 1024 + h * 64 + ks * 32 + g * 8); acc = __builtin_amdgcn_mfma_f32_16x16x32_bf16(kf, qf[ks], acc, 0, 0, 0); }
                sc[kt] = acc; }
            float mx = -1.0e30f;
#pragma unroll
            for (int kt = 0; kt < 16; ++kt) { const int drow = rs + (kt >> 1) - r + 7;
#pragma unroll
                for (int e = 0; e < 4; ++e) { const int c = (kt & 1) * 4 + e; const float bias = rpbl[drow * 31 + dcol[c]];
                    const float val = ((vmask >> c) & 1u) ? sc[kt][e] + bias : -1.0e30f; sc[kt][e] = val; mx = fmaxf(mx, val); } }
            mx = fmaxf(mx, __shfl_xor(mx, 16)); mx = fmaxf(mx, __shfl_xor(mx, 32));
            float sum = 0.f;
#pragma unroll
            for (int kt = 0; kt < 16; ++kt)
#pragma unroll
                for (int e = 0; e < 4; ++e) { const float p = __expf(sc[kt][e] - mx); sc[kt][e] = p; sum += p; }
            sum += __shfl_xor(sum, 16); sum += __shfl_xor(sum, 32);
            f32x4 o[4];
#pragma unroll
            for (int dt = 0; dt < 4; ++dt) o[dt] = (f32x4){0.f, 0.f, 0.f, 0.f};
#pragma unroll
            for (int kk = 0; kk < 8; ++kk) {
                u32x4 pw; pw.x = pk2(sc[2 * kk][0], sc[2 * kk][1]); pw.y = pk2(sc[2 * kk][2], sc[2 * kk][3]); pw.z = pk2(sc[2 * kk + 1][0], sc[2 * kk + 1][1]); pw.w = pk2(sc[2 * kk + 1][2], sc[2 * kk + 1][3]);
                const bf16x8 pf = __builtin_bit_cast(bf16x8, pw);
                const int ks0 = ((rs + kk) & 7) * 64 + bs + 4 * g + qq, ks1 = ks0 + 16;
#pragma unroll
                for (int dt = 0; dt < 4; ++dt) {
                    const s16x4 v0 = __builtin_amdgcn_ds_read_tr16_b64_v4i16((LAS s16x4*)(L + hl * VH + voff(ks0, 16 * dt + 4 * pp)));
                    const s16x4 v1 = __builtin_amdgcn_ds_read_tr16_b64_v4i16((LAS s16x4*)(L + hl * VH + voff(ks1, 16 * dt + 4 * pp)));
                    bf16x8 vf; vf[0] = v0[0]; vf[1] = v0[1]; vf[2] = v0[2]; vf[3] = v0[3]; vf[4] = v1[0]; vf[5] = v1[1]; vf[6] = v1[2]; vf[7] = v1[3];
                    o[dt] = __builtin_amdgcn_mfma_f32_16x16x32_bf16(vf, pf, o[dt], 0, 0, 0); }
            }
            const float inv = 1.f / sum;
#pragma unroll
            for (int dt = 0; dt < 4; ++dt) { u32x2 ov; ov.x = pk2(o[dt][0] * inv, o[dt][1] * inv); ov.y = pk2(o[dt][2] * inv, o[dt][3] * inv);
                *(u32x2*)(q + tokq * 1024 + h * 64 + 16 * dt + 4 * g) = ov; }
        }
#undef NA_LOAD_ROW
    }
    __syncthreads();
}

__device__ __forceinline__ void p_combine(const Ctx& C, const bf16_t* yf, const bf16_t* yb, bf16_t* szu, float* rstd) {
    const int gw = C.bid * NWAVES + C.wave, NGW = C.G * NWAVES;
    for (int row0 = gw * 2; row0 < T; row0 += NGW * 2) {
        u32x4 a[2][2], b[2][2], z[2][2];
#pragma unroll
        for (int r = 0; r < 2; ++r)
#pragma unroll
            for (int j = 0; j < 2; ++j) { const size_t off = (size_t)(row0 + r) * 1024 + j * 512 + C.lane * 8;
                a[r][j] = *(const u32x4*)(yf + off); b[r][j] = *(const u32x4*)(yb + off); z[r][j] = *(const u32x4*)(szu + off); }
#pragma unroll
        for (int r = 0; r < 2; ++r) { float s = 0.f; u32x4 outv[2];
#pragma unroll
            for (int j = 0; j < 2; ++j) { const u32x4 av = a[r][j], bv = b[r][j], zv = z[r][j]; float u[8];
                u[0] = (bflo(av.x) + bflo(bv.x)) * bflo(zv.x); u[1] = (bfhi(av.x) + bfhi(bv.x)) * bfhi(zv.x);
                u[2] = (bflo(av.y) + bflo(bv.y)) * bflo(zv.y); u[3] = (bfhi(av.y) + bfhi(bv.y)) * bfhi(zv.y);
                u[4] = (bflo(av.z) + bflo(bv.z)) * bflo(zv.z); u[5] = (bfhi(av.z) + bfhi(bv.z)) * bfhi(zv.z);
                u[6] = (bflo(av.w) + bflo(bv.w)) * bflo(zv.w); u[7] = (bfhi(av.w) + bfhi(bv.w)) * bfhi(zv.w);
#pragma unroll
                for (int q = 0; q < 8; ++q) s += u[q] * u[q];
                outv[j].x = pk2(u[0], u[1]); outv[j].y = pk2(u[2], u[3]); outv[j].z = pk2(u[4], u[5]); outv[j].w = pk2(u[6], u[7]); }
            s = wave_sum(s);
#pragma unroll
            for (int j = 0; j < 2; ++j) *(u32x4*)(szu + (size_t)(row0 + r) * 1024 + j * 512 + C.lane * 8) = outv[j];
            if (C.lane == 0) rstd[row0 + r] = rsqrtf(s * (1.f / 1024.f) + EPS); }
    }
}

__device__ __forceinline__ void p_cvt_tables8(const Ctx& C, unsigned char* u8, unsigned char* v8) {
    const int gt = C.bid * NTHR + C.tid, NT = C.G * NTHR;
    const float* u = C.in[21]; const float* v = C.in[22];
    constexpr int N4 = 16384 * 1024 / 4;
    for (int i0 = gt; i0 < N4; i0 += 4 * NT) {
        f32x4 a[4], b[4];
#pragma unroll
        for (int r = 0; r < 4; ++r) { const int i = i0 + r * NT; if (i < N4) { a[r] = *(const f32x4*)(u + (size_t)i * 4); b[r] = *(const f32x4*)(v + (size_t)i * 4); } }
#pragma unroll
        for (int r = 0; r < 4; ++r) { const int i = i0 + r * NT; if (i < N4) {
            const f32x4 av = a[r] * 256.f, bv = b[r] * 64.f; unsigned x = 0u, y = 0u;
            x = __builtin_amdgcn_cvt_pk_fp8_f32(av.x, av.y, x, false); x = __builtin_amdgcn_cvt_pk_fp8_f32(av.z, av.w, x, true);
            y = __builtin_amdgcn_cvt_pk_fp8_f32(bv.x, bv.y, y, false); y = __builtin_amdgcn_cvt_pk_fp8_f32(bv.z, bv.w, y, true);
            *(unsigned*)(u8 + (size_t)i * 4) = x; *(unsigned*)(v8 + (size_t)i * 4) = y; } }
    }
}

template <int CTRL> __device__ __forceinline__ float dppf(float x) { return __int_as_float(__builtin_amdgcn_update_dpp(0, __float_as_int(x), CTRL, 0xF, 0xF, false)); }
constexpr int DPP_HMIRROR = 0x141, DPP_XOR2 = 0x4E, DPP_XOR1 = 0xB1, DPP_ROR8 = 0x128;
__device__ __forceinline__ int idx16(const u32x4& a, const u32x4& b, int i) { const unsigned w = (i < 8 ? a : b)[(i & 7) >> 1]; return (int)((i & 1) ? (w >> 16) : (w & 0xffffu)); }
__device__ __forceinline__ int gslot(int R) { return 16 * (R & 7) + (R >> 3); }
#define GQ_DMA(tab_, qi_, mi_) do { const u32x2 iw_ = *(const LAS u32x2*)(meta + (mi_) * MSTRIDE + 32 * (lane >> 3) + 8 * (qi_)); \
        _Pragma("unroll") for (int k_ = 0; k_ < 4; ++k_) { const int kk_ = 4 * (qi_) + k_, R_ = 8 * kk_ + (lane >> 3); \
            const unsigned e_ = (k_ & 1) ? ((k_ < 2 ? iw_.x : iw_.y) >> 16) : ((k_ < 2 ? iw_.x : iw_.y) & 0xffffu); \
            const unsigned char* src_ = (tab_) + (size_t)e_ * 1024 + 128 * j + 16 * ((lane & 7) ^ ((R_ >> 1) & 7)); \
            __builtin_amdgcn_global_load_lds((const unsigned*)src_, (LAS unsigned*)(img + kk_ * 1024), 16, 0, 0); } } while (0)
#define GQ_WAIT(n_) asm volatile("s_waitcnt vmcnt(" #n_ ")" ::: "memory")
#define GQ_LWAIT() asm volatile("s_waitcnt lgkmcnt(0)" ::: "memory")
__device__ __forceinline__ void p_gu(const Ctx& C, const bf16_t* n2, const unsigned short* pidx, const unsigned char* u8, float* pd) {
    const int j = C.bid & 7, nsl = C.G >> 3, NW = nsl * NWAVES, wsl = (C.bid >> 3) * NWAVES + C.wave, lane = C.lane, i16 = lane & 15, g = lane >> 4;
    if ((C.bid >> 3) >= nsl) return;
    constexpr int MSTRIDE = 512;
    LAS unsigned char* img = C.lds + 16384 + C.wave * 16384;
    LAS unsigned char* meta = C.lds + 4096 + C.wave * (3 * MSTRIDE);
    LAS unsigned char* xq = C.lds + C.wave * 256;
#define GU_META(t_, mi_) do { const int tt_ = (t_) < T ? (t_) : wsl; \
        __builtin_amdgcn_global_load_lds((const unsigned*)((const unsigned char*)(pidx + (size_t)tt_ * 128) + 4 * lane), (LAS unsigned*)(meta + (mi_) * MSTRIDE), 4, 0, 0); \
        __builtin_amdgcn_global_load_lds((const unsigned*)((const unsigned char*)(n2 + (size_t)tt_ * 1024 + 128 * j) + 4 * lane), (LAS unsigned*)(meta + (mi_) * MSTRIDE + 256), 4, 0, 0); } while (0)
    GU_META(wsl, 0); GU_META(wsl + NW, 1);
    GQ_WAIT(0);
    GQ_DMA(u8, 0, 0); GQ_DMA(u8, 1, 0); GQ_DMA(u8, 2, 0); GQ_DMA(u8, 3, 0);
    GQ_WAIT(0);
    int mi = 0;
    for (int t = wsl; t < T; t += NW) {
        const int mi1 = mi == 2 ? 0 : mi + 1, mi2 = mi1 == 2 ? 0 : mi1 + 1;
        GU_META(t + 2 * NW, mi2);
        { const unsigned xcur = *(const LAS unsigned*)(meta + mi * MSTRIDE + 256 + 4 * lane);
          const float x0 = bflo(xcur) * 16.f, x1 = bfhi(xcur) * 16.f;
          const unsigned hw = __builtin_amdgcn_cvt_pk_fp8_f32(x0, x1, 0u, false);
          const f32x2_t h01 = __builtin_amdgcn_cvt_pk_f32_fp8(hw, false);
          const unsigned lw = __builtin_amdgcn_cvt_pk_fp8_f32((x0 - h01.x) * 16.f, (x1 - h01.y) * 16.f, 0u, false);
          *(LAS unsigned short*)(xq + 2 * lane) = (unsigned short)(hw & 0xffffu); *(LAS unsigned short*)(xq + 128 + 2 * lane) = (unsigned short)(lw & 0xffffu); }
        GQ_LWAIT();
        long bq[4];
#pragma unroll
        for (int ks = 0; ks < 4; ++ks) bq[ks] = *(const LAS long*)(xq + (i16 & 1) * 128 + 32 * ks + 8 * g);
        f32x4 o[8];
#pragma unroll
        for (int qi = 0; qi < 4; ++qi) {
            GQ_WAIT(22);
#pragma unroll
            for (int tl = 2 * qi; tl < 2 * qi + 2; ++tl) { const int R = 16 * tl + i16; f32x4 acc = (f32x4){0.f, 0.f, 0.f, 0.f};
#pragma unroll
                for (int ks = 0; ks < 4; ++ks) { const int sc = 2 * ks + (g >> 1);
                    const long av = *(const LAS long*)(img + R * 128 + ((sc ^ ((R >> 1) & 7)) << 4) + 8 * (g & 1));
                    acc = __builtin_amdgcn_mfma_f32_16x16x32_fp8_fp8(av, bq[ks], acc, 0, 0, 0); }
#pragma unroll
                for (int r = 0; r < 4; ++r) o[tl][r] = (acc[r] + dppf<DPP_XOR1>(acc[r]) * 0.0625f) * (1.f / 4096.f); }
            GQ_LWAIT();
            GQ_DMA(u8, qi, mi1);
        }
#pragma unroll
        for (int tl = 0; tl < 8; ++tl) { if (i16 == 0) *(f32x4*)(pd + ((size_t)j * T + t) * 128 + 16 * tl + 4 * g) = o[tl]; }
        mi = mi1;
    }
    GQ_WAIT(0);
#undef GU_META
}
__device__ __forceinline__ void p_gc(const Ctx& C, const float* pd, const float* pgate, float* cc) {
    const int gt = C.bid * NTHR + C.tid, NT = C.G * NTHR;
    for (int i = gt; i < T * 32; i += NT) {
        f32x4 sdot = *(const f32x4*)(pd + (size_t)i * 4);
#pragma unroll
        for (int j = 1; j < 8; ++j) sdot += *(const f32x4*)(pd + (size_t)j * T * 128 + (size_t)i * 4);
        const int t_ = i >> 5, R0 = (i & 31) * 4; const float* gp = pgate + (size_t)t_ * 128;
        f32x4 gv; gv.x = gp[gslot(R0)]; gv.y = gp[gslot(R0 + 1)]; gv.z = gp[gslot(R0 + 2)]; gv.w = gp[gslot(R0 + 3)];
        f32x4 o; o.x = gelu_f(sdot.x) * gv.x; o.y = gelu_f(sdot.y) * gv.y; o.z = gelu_f(sdot.z) * gv.z; o.w = gelu_f(sdot.w) * gv.w;
        *(f32x4*)(cc + (size_t)i * 4) = o; }
}
__device__ __forceinline__ void p_gv(const Ctx& C, const float* cc, const unsigned short* pidx, const unsigned char* v8, bf16_t* op) {
    typedef int i32x2 __attribute__((ext_vector_type(2)));
    const int j = C.bid & 7, nsl = C.G >> 3, NW = nsl * NWAVES, wsl = (C.bid >> 3) * NWAVES + C.wave, lane = C.lane, i16 = lane & 15, g = lane >> 4;
    if ((C.bid >> 3) >= nsl) return;
    constexpr int MSTRIDE = 768;
    LAS unsigned char* img = C.lds + 24576 + C.wave * 16384;
    LAS unsigned char* meta = C.lds + 4096 + C.wave * (3 * MSTRIDE);
    LAS unsigned char* cq = C.lds + C.wave * 256;
    const int tr_r = i16 >> 1, tr_c = i16 & 1;
    unsigned toff[8];
#pragma unroll
    for (int ct = 0; ct < 8; ++ct) toff[ct] = (unsigned)((ct ^ ((4 * g + (tr_r >> 1)) & 7)) << 4);
#define GV_META(t_, mi_) do { const int tt_ = (t_) < T ? (t_) : wsl; \
        __builtin_amdgcn_global_load_lds((const unsigned*)((const unsigned char*)(pidx + (size_t)tt_ * 128) + 4 * lane), (LAS unsigned*)(meta + (mi_) * MSTRIDE), 4, 0, 0); \
        __builtin_amdgcn_global_load_lds((const unsigned*)(cc + (size_t)tt_ * 128 + lane), (LAS unsigned*)(meta + (mi_) * MSTRIDE + 256), 4, 0, 0); \
        __builtin_amdgcn_global_load_lds((const unsigned*)(cc + (size_t)tt_ * 128 + 64 + lane), (LAS unsigned*)(meta + (mi_) * MSTRIDE + 512), 4, 0, 0); } while (0)
    GV_META(wsl, 0); GV_META(wsl + NW, 1);
    GQ_WAIT(0);
    GQ_DMA(v8, 0, 0); GQ_DMA(v8, 1, 0); GQ_DMA(v8, 2, 0); GQ_DMA(v8, 3, 0);
    GQ_WAIT(0);
    int mi = 0;
    for (int t = wsl; t < T; t += NW) {
        const int mi1 = mi == 2 ? 0 : mi + 1, mi2 = mi1 == 2 ? 0 : mi1 + 1;
        GV_META(t + 2 * NW, mi2);
        { const f32x2_t ccur = *(const LAS f32x2_t*)(meta + mi * MSTRIDE + 256 + 8 * lane);
          const float c0 = ccur.x * 64.f, c1 = ccur.y * 64.f;
          const unsigned hw = __builtin_amdgcn_cvt_pk_fp8_f32(c0, c1, 0u, false);
          const f32x2_t h01 = __builtin_amdgcn_cvt_pk_f32_fp8(hw, false);
          const unsigned lw = __builtin_amdgcn_cvt_pk_fp8_f32((c0 - h01.x) * 16.f, (c1 - h01.y) * 16.f, 0u, false);
          *(LAS unsigned short*)(cq + 2 * lane) = (unsigned short)(hw & 0xffffu); *(LAS unsigned short*)(cq + 128 + 2 * lane) = (unsigned short)(lw & 0xffffu); }
        GQ_LWAIT();
        long aq[4];
#pragma unroll
        for (int ks = 0; ks < 4; ++ks) aq[ks] = *(const LAS long*)(cq + (i16 & 1) * 128 + 32 * ks + 8 * g);
        f32x4 acc[8];
#pragma unroll
        for (int ct = 0; ct < 8; ++ct) acc[ct] = (f32x4){0.f, 0.f, 0.f, 0.f};
#pragma unroll
        for (int ks = 0; ks < 4; ++ks) {
            GQ_WAIT(23);
            const unsigned rb = (unsigned)(size_t)(img + (32 * ks + 8 * g + tr_r) * 128 + 8 * tr_c);
            long b0, b1, b2, b3, b4, b5, b6, b7;
            asm volatile("ds_read_b64_tr_b8 %0, %8\n\tds_read_b64_tr_b8 %1, %9\n\tds_read_b64_tr_b8 %2, %10\n\tds_read_b64_tr_b8 %3, %11\n\t"
                         "ds_read_b64_tr_b8 %4, %12\n\tds_read_b64_tr_b8 %5, %13\n\tds_read_b64_tr_b8 %6, %14\n\tds_read_b64_tr_b8 %7, %15\n\ts_waitcnt lgkmcnt(0)"
                         : "=&v"(b0), "=&v"(b1), "=&v"(b2), "=&v"(b3), "=&v"(b4), "=&v"(b5), "=&v"(b6), "=&v"(b7)
                         : "v"(rb + toff[0]), "v"(rb + toff[1]), "v"(rb + toff[2]), "v"(rb + toff[3]), "v"(rb + toff[4]), "v"(rb + toff[5]), "v"(rb + toff[6]), "v"(rb + toff[7]) : "memory");
            acc[0] = __builtin_amdgcn_mfma_f32_16x16x32_fp8_fp8(aq[ks], b0, acc[0], 0, 0, 0); acc[1] = __builtin_amdgcn_mfma_f32_16x16x32_fp8_fp8(aq[ks], b1, acc[1], 0, 0, 0);
            acc[2] = __builtin_amdgcn_mfma_f32_16x16x32_fp8_fp8(aq[ks], b2, acc[2], 0, 0, 0); acc[3] = __builtin_amdgcn_mfma_f32_16x16x32_fp8_fp8(aq[ks], b3, acc[3], 0, 0, 0);
            acc[4] = __builtin_amdgcn_mfma_f32_16x16x32_fp8_fp8(aq[ks], b4, acc[4], 0, 0, 0); acc[5] = __builtin_amdgcn_mfma_f32_16x16x32_fp8_fp8(aq[ks], b5, acc[5], 0, 0, 0);
            acc[6] = __builtin_amdgcn_mfma_f32_16x16x32_fp8_fp8(aq[ks], b6, acc[6], 0, 0, 0); acc[7] = __builtin_amdgcn_mfma_f32_16x16x32_fp8_fp8(aq[ks], b7, acc[7], 0, 0, 0);
            GQ_DMA(v8, ks, mi1);
        }
#pragma unroll
        for (int ct = 0; ct < 8; ++ct) { if (g == 0) op[(size_t)t * 1024 + 128 * j + 16 * ct + i16] = (bf16_t)f2bf((acc[ct][0] + acc[ct][1] * 0.0625f) * (1.f / 4096.f)); }
        mi = mi1;
    }
    GQ_WAIT(0);
#undef GV_META
}
__device__ __forceinline__ void p_gf(const Ctx& C, const bf16_t* h, const bf16_t* op, float* out) {
    const float* mod = C.f32p(WS_MOD); const float* fg = C.in[23];
    const int gw = C.bid * NWAVES + C.wave, NGW = C.G * NWAVES, lane = C.lane;
    for (int t0 = gw * 2; t0 < T; t0 += NGW * 2) {
        const int b = t0 / SEQ;
        u32x2 ov[2][4], hw[2][4];
#pragma unroll
        for (int r = 0; r < 2; ++r)
#pragma unroll
            for (int d = 0; d < 4; ++d) { const size_t off = (size_t)(t0 + r) * 1024 + 256 * d + 4 * lane; ov[r][d] = *(const u32x2*)(op + off); hw[r][d] = *(const u32x2*)(h + off); }
        f32x4 mv[4], fv[4];
#pragma unroll
        for (int d = 0; d < 4; ++d) { mv[d] = *(const f32x4*)(mod + b * 6144 + 5120 + 256 * d + 4 * lane); fv[d] = *(const f32x4*)(fg + 256 * d + 4 * lane); }
#pragma unroll
        for (int r = 0; r < 2; ++r) { f32x4 hf[4]; float ss = 0.f;
#pragma unroll
            for (int d = 0; d < 4; ++d) { f32x4 hv, o4; hv.x = bflo(hw[r][d].x); hv.y = bfhi(hw[r][d].x); hv.z = bflo(hw[r][d].y); hv.w = bfhi(hw[r][d].y);
                o4.x = bflo(ov[r][d].x); o4.y = bfhi(ov[r][d].x); o4.z = bflo(ov[r][d].y); o4.w = bfhi(ov[r][d].y);
                hf[d] = hv + mv[d] * o4; ss += (hf[d].x * hf[d].x + hf[d].y * hf[d].y) + (hf[d].z * hf[d].z + hf[d].w * hf[d].w); }
            const float rstd = rsqrtf(wave_sum(ss) * (1.f / 1024.f) + EPS);
#pragma unroll
            for (int d = 0; d < 4; ++d) *(f32x4*)(out + (size_t)(t0 + r) * 1024 + 256 * d + 4 * lane) = hf[d] * rstd * fv[d]; }
    }
}

namespace pg8 {
#define PG8_LAS __attribute__((address_space(3)))
typedef unsigned short bf16_t;
typedef short bf16x8 __attribute__((ext_vector_type(8)));
typedef float f32x4 __attribute__((ext_vector_type(4)));
typedef unsigned u32x4 __attribute__((ext_vector_type(4)));
constexpr int BM = 256, BK = 64, HALF = 128, HTB = HALF * BK * 2  , STAGE_BYTES = 8 * HTB, NXCD = 8, WGM = 8;

__host__ __device__ __forceinline__ int lds_byte(int r, int c) { const int st = (r >> 4) * 2 + (c >> 5), rr = r & 15, cc = c & 31, ob = rr * 64 + cc * 2; return st * 1024 + (ob ^ (((ob >> 9) & 1) << 5)); }
__host__ __device__ __forceinline__ void stage_rc(int b, int& R, int& C) { const int st = b / 1024, sb = b % 1024, swz = sb ^ (((sb >> 9) & 1) << 5); R = (st >> 1) * 16 + swz / 64; C = (st & 1) * 32 + (swz % 64) / 2; }
__host__ __device__ __forceinline__ int perm32(int rho) { const int n = rho >> 4, i = rho & 15; return 8 * (i >> 2) + 4 * n + (i & 3); }

struct Unit { int pm, pn, kind; };
struct Gemm { const bf16_t* A; const bf16_t* Bt; int M, N, K; const bf16_t *A1, *B1, *A2, *B2, *A3, *B3; };

struct StaticOrder {
    static constexpr bool MULTI = false;
    int nM, nN, nwg, G, c;
    __host__ __device__ void init(int M, int N, int G_, int c_) { nM = M / BM; nN = N / BM; nwg = nM * nN; G = G_; c = c_; }
    __host__ __device__ bool next(int i, Unit& u) const {
        const long L = (long)i * G + c; if (L >= nwg) return false;
        int wgid = (int)L; { const int q = nwg / NXCD, r = nwg % NXCD, xcd = wgid % NXCD, off = wgid / NXCD; wgid = (xcd < r ? xcd * (q + 1) : r * (q + 1) + (xcd - r) * q) + off; }
        const int nig = WGM * nN, gid = wgid / nig, fm = gid * WGM, gsz = (nM - fm) < WGM ? (nM - fm) : WGM;
        u.pm = fm + ((wgid % nig) % gsz); u.pn = (wgid % nig) / gsz; u.kind = 0; return true;
    }
    __device__ __forceinline__ void a_ready(const Unit&) const {}
    __device__ __forceinline__ void done(const Unit&) const {}
};

struct MultiOrder {
    static constexpr bool MULTI = true;
    StaticOrder b; int nk;
    __host__ __device__ bool next(int i, Unit& u) const { if (!b.next(i / nk, u)) return false; u.kind = i % nk; return true; }
    __device__ __forceinline__ void a_ready(const Unit&) const {}
    __device__ __forceinline__ void done(const Unit&) const {}
};

__device__ __forceinline__ unsigned cvt_pk_bf16(float lo, float hi) { return ::pk2(lo, hi); }
__device__ __forceinline__ float e_silu(float x) { return x / (1.f + __expf(-x)); }
__device__ __forceinline__ float e_sigm(float x) { return 1.f / (1.f + __expf(-x)); }
__device__ __forceinline__ float e_lo(unsigned v) { return __uint_as_float(v << 16); }
__device__ __forceinline__ float e_hi(unsigned v) { return __uint_as_float(v & 0xffff0000u); }
__device__ __forceinline__ u32x4 pack8(const f32x4 v0, const f32x4 v1) { u32x4 w; w.x = cvt_pk_bf16(v0[0], v0[1]); w.y = cvt_pk_bf16(v0[2], v0[3]); w.z = cvt_pk_bf16(v1[0], v1[1]); w.w = cvt_pk_bf16(v1[2], v1[3]); return w; }

struct EpiInProj {
    static constexpr bool PERM = true, AFTER_DRAIN = false;
    bf16_t *sz, *xbc, *q, *k, *v;
    __device__ __forceinline__ void operator()(const f32x4 (&acc)[2][2][4][2], const Unit& u, int wr, int wc, int fr, int fq) const {
        const int pn = u.pn; bf16_t* base; int ldc = 1024, colt, mode = 0;
        if (pn < 4) { base = sz; colt = pn * 256; mode = 1; }
        else if (pn < 12) { base = xbc; ldc = 2048; colt = (pn - 4) * 256; }
        else if (pn < 16) { base = q; colt = (pn - 12) * 256; mode = 2; }
        else if (pn < 20) { base = k; colt = (pn - 16) * 256; }
        else { base = v; colt = (pn - 20) * 256; }
        const int row0 = u.pm * BM + wr * 64 + fr, col0 = colt + wc * 32 + 8 * fq;
#pragma unroll
        for (int ai = 0; ai < 2; ++ai)
#pragma unroll
            for (int m = 0; m < 4; ++m) { bf16_t* rowp = base + (size_t)(row0 + ai * HALF + m * 16) * ldc + col0;
#pragma unroll
                for (int bj = 0; bj < 2; ++bj) { f32x4 v0 = acc[ai][bj][m][0], v1 = acc[ai][bj][m][1];
                    if (mode == 1) {
#pragma unroll
                        for (int i = 0; i < 4; ++i) { v0[i] = e_silu(v0[i]); v1[i] = e_silu(v1[i]); } }
                    else if (mode == 2) { v0 = v0 * 0.125f; v1 = v1 * 0.125f; }
                    *(u32x4*)(rowp + bj * HALF) = pack8(v0, v1); } }
    }
};
struct EpiMix {
    static constexpr bool PERM = true, AFTER_DRAIN = false;
    bf16_t *sg1, *sg2, *mixed; const float* rstd;
    __device__ __forceinline__ bool operator()(f32x4 (&acc)[2][2][4][2], const Unit& u, int wr, int wc, int fr, int fq) const {
        const int row0 = u.pm * BM + wr * 64 + fr, col0 = u.pn * BM + wc * 32 + 8 * fq; const int kind = u.kind;
#pragma unroll
        for (int ai = 0; ai < 2; ++ai)
#pragma unroll
            for (int m = 0; m < 4; ++m) { const int row = row0 + ai * HALF + m * 16; const size_t off = (size_t)row * 1024 + col0;
                const float rs = (kind == 2) ? rstd[row] : 1.f;
#pragma unroll
                for (int bj = 0; bj < 2; ++bj) { f32x4 v0 = acc[ai][bj][m][0], v1 = acc[ai][bj][m][1];
                    if (kind < 2) {
#pragma unroll
                        for (int i = 0; i < 4; ++i) { v0[i] = e_sigm(v0[i]); v1[i] = e_sigm(v1[i]); }
                        *(u32x4*)((kind == 0 ? sg1 : sg2) + off + bj * HALF) = pack8(v0, v1);
                    } else if (kind == 2) {
                        const u32x4 a = *(const u32x4*)(sg1 + off + bj * HALF), b = *(const u32x4*)(sg2 + off + bj * HALF);
                        v0[0] *= rs * e_lo(a.x) / fmaxf(e_lo(b.x), 1e-30f); v0[1] *= rs * e_hi(a.x) / fmaxf(e_hi(b.x), 1e-30f); v0[2] *= rs * e_lo(a.y) / fmaxf(e_lo(b.y), 1e-30f); v0[3] *= rs * e_hi(a.y) / fmaxf(e_hi(b.y), 1e-30f);
                        v1[0] *= rs * e_lo(a.z) / fmaxf(e_lo(b.z), 1e-30f); v1[1] *= rs * e_hi(a.z) / fmaxf(e_hi(b.z), 1e-30f); v1[2] *= rs * e_lo(a.w) / fmaxf(e_lo(b.w), 1e-30f); v1[3] *= rs * e_hi(a.w) / fmaxf(e_hi(b.w), 1e-30f);
                        acc[ai][bj][m][0] = v0; acc[ai][bj][m][1] = v1;
                    } else {
                        const u32x4 b = *(const u32x4*)(sg2 + off + bj * HALF);
                        v0[0] *= e_lo(b.x); v0[1] *= e_hi(b.x); v0[2] *= e_lo(b.y); v0[3] *= e_hi(b.y); v1[0] *= e_lo(b.z); v1[1] *= e_hi(b.z); v1[2] *= e_lo(b.w); v1[3] *= e_hi(b.w);
                        *(u32x4*)(mixed + off + bj * HALF) = pack8(v0, v1);
                    } } }
        return kind == 2;
    }
};
struct EpiD3 {
    static constexpr bool PERM = true, AFTER_DRAIN = false;
    bf16_t* h; const float* x; const float* mod;
    __device__ __forceinline__ void operator()(const f32x4 (&acc)[2][2][4][2], const Unit& u, int wr, int wc, int fr, int fq) const {
        const int row0 = u.pm * BM + wr * 64 + fr, col0 = u.pn * BM + wc * 32 + 8 * fq;
        const float* g1 = mod + (size_t)((u.pm * BM) >> 12) * 6144 + 2048;
#pragma unroll
        for (int ai = 0; ai < 2; ++ai)
#pragma unroll
            for (int m = 0; m < 4; ++m) { const size_t off = (size_t)(row0 + ai * HALF + m * 16) * 1024 + col0;
#pragma unroll
                for (int bj = 0; bj < 2; ++bj) { const int c = bj * HALF;
                    const f32x4 x0 = *(const f32x4*)(x + off + c), x1 = *(const f32x4*)(x + off + c + 4), g0 = *(const f32x4*)(g1 + col0 + c), g4 = *(const f32x4*)(g1 + col0 + c + 4);
                    *(u32x4*)(h + off + c) = pack8(x0 + g0 * acc[ai][bj][m][0], x1 + g4 * acc[ai][bj][m][1]); } }
    }
};
struct EpiQp {
    static constexpr bool PERM = true, AFTER_DRAIN = false;
    bf16_t* qp;
    __device__ __forceinline__ void operator()(const f32x4 (&acc)[2][2][4][2], const Unit& u, int wr, int wc, int fr, int fq) const {
        const int row0 = u.pm * BM + wr * 64 + fr, col0 = u.pn * BM + wc * 32 + 8 * fq;
#pragma unroll
        for (int ai = 0; ai < 2; ++ai)
#pragma unroll
            for (int m = 0; m < 4; ++m) { bf16_t* rowp = qp + (size_t)(row0 + ai * HALF + m * 16) * 2048 + col0;
#pragma unroll
                for (int bj = 0; bj < 2; ++bj) *(u32x4*)(rowp + bj * HALF) = pack8(acc[ai][bj][m][0], acc[ai][bj][m][1]); }
    }
};

template <class Epi, class Sched, bool ALIGN_EPI = false, bool SP2 = false>
__device__ __forceinline__ void gemm_phase(PG8_LAS unsigned char* lds, const Gemm g, const Sched& S, const Epi& E) {
    const int tid = threadIdx.x, wid = __builtin_amdgcn_readfirstlane(tid >> 6), lane = tid & 63, wr = wid >> 2, wc = wid & 3, fr = lane & 15, fq = lane >> 4;
    const int K = g.K, nt = K / BK;
    unsigned voffA[2], voffB[2];
#pragma unroll
    for (int i = 0; i < 2; ++i) { int R, C; stage_rc(tid * 16 + i * 8192, R, C); const int Rb = Epi::PERM ? ((R & ~31) + perm32(R & 31)) : R;
        voffA[i] = (unsigned)(R * K + C) * 2u; voffB[i] = (unsigned)(Rb * K + C) * 2u; }
    const size_t kstep = (size_t)(BK * 2);
    const size_t hstep = (size_t)HALF * K * 2;
    const size_t tstep = 2 * hstep;
    const unsigned ldsw = (unsigned)wid * 1024u;
    const int aoff = lds_byte(wr * 64 + fr, fq * 8), boff = lds_byte(wc * 32 + fr, fq * 8);
#define PG8_SA(b, h) (((b) * 2 + (h)) * HTB)
#define PG8_SB(b, h) ((4 + (b) * 2 + (h)) * HTB)
#define PG8_STAGE(bufoff, gbase, voff) do { _Pragma("unroll") for (int _i = 0; _i < 2; ++_i) \
        __builtin_amdgcn_global_load_lds((const unsigned*)((const char*)(gbase) + (voff)[_i]), (PG8_LAS unsigned*)(lds + (bufoff) + ldsw + _i * 8192), 16, 0, 0); } while (0)
#define PG8_LDA(dst, b, h) do { _Pragma("unroll") for (int m = 0; m < 4; ++m) _Pragma("unroll") for (int k = 0; k < 2; ++k) dst[m][k] = *(const PG8_LAS bf16x8*)(lds + PG8_SA(b, h) + aoff + m * 2048 + k * 1024); } while (0)
#define PG8_LDB(dst, b, h) do { _Pragma("unroll") for (int n = 0; n < 2; ++n) _Pragma("unroll") for (int k = 0; k < 2; ++k) dst[n][k] = *(const PG8_LAS bf16x8*)(lds + PG8_SB(b, h) + boff + n * 2048 + k * 1024); } while (0)
#define PG8_MMA(ai, bj, At, Bt) do { __builtin_amdgcn_s_setprio(1); _Pragma("unroll") for (int m = 0; m < 4; ++m) _Pragma("unroll") for (int n = 0; n < 2; ++n) _Pragma("unroll") for (int k = 0; k < 2; ++k) \
        acc[ai][bj][m][n] = __builtin_amdgcn_mfma_f32_16x16x32_bf16(Bt[n][k], At[m][k], acc[ai][bj][m][n], 0, 0, 0); __builtin_amdgcn_s_setprio(0); } while (0)
#define PG8_WAIT_V(n) asm volatile("s_waitcnt vmcnt(" #n ")" ::: "memory")
#define PG8_WAIT_L(n) asm volatile("s_waitcnt lgkmcnt(" #n ")" ::: "memory")
#define PG8_BAR __builtin_amdgcn_s_barrier()
#define PG8_SCHED __builtin_amdgcn_sched_barrier(0)
    Unit cur, nxt; int ui = 0;
    if (!S.next(0, cur)) return;
    f32x4 acc[2][2][4][2];
#pragma unroll
    for (int a = 0; a < 2; ++a)
#pragma unroll
        for (int b = 0; b < 2; ++b)
#pragma unroll
            for (int m = 0; m < 4; ++m)
#pragma unroll
                for (int n = 0; n < 2; ++n) acc[a][b][m][n] = (f32x4){0.f, 0.f, 0.f, 0.f};
    bf16x8 At[4][2], B0[2][2], B1[2][2];
#define PG8_AB(u_) (Sched::MULTI ? (const char*)((u_).kind == 0 ? g.A : (u_).kind == 1 ? g.A1 : (u_).kind == 2 ? g.A2 : g.A3) : (const char*)g.A)
#define PG8_BB(u_) (Sched::MULTI ? (const char*)((u_).kind == 0 ? g.Bt : (u_).kind == 1 ? g.B1 : (u_).kind == 2 ? g.B2 : g.B3) : (const char*)g.Bt)
    const char* cA = PG8_AB(cur) + (size_t)cur.pm * tstep; const char* cB = PG8_BB(cur) + (size_t)cur.pn * tstep;
    S.a_ready(cur);
    if constexpr (SP2) {
        PG8_STAGE(PG8_SB(0, 0), cB, voffB); PG8_STAGE(PG8_SB(0, 1), cB + hstep, voffB); PG8_STAGE(PG8_SA(0, 0), cA, voffA); PG8_STAGE(PG8_SA(0, 1), cA + hstep, voffA);
        if (wr == 1) PG8_BAR;
        PG8_WAIT_V(2); PG8_BAR;
        PG8_STAGE(PG8_SB(1, 0), cB + kstep, voffB); PG8_STAGE(PG8_SA(1, 0), cA + kstep, voffA); PG8_STAGE(PG8_SB(1, 1), cB + hstep + kstep, voffB);
        PG8_WAIT_V(6); PG8_BAR;
    } else {
        PG8_STAGE(PG8_SB(0, 0), cB, voffB); PG8_STAGE(PG8_SA(0, 0), cA, voffA); PG8_STAGE(PG8_SB(0, 1), cB + hstep, voffB); PG8_STAGE(PG8_SA(0, 1), cA + hstep, voffA);
        if (wr == 1) PG8_BAR;
        PG8_WAIT_V(4); PG8_BAR;
        PG8_STAGE(PG8_SB(1, 0), cB + kstep, voffB); PG8_STAGE(PG8_SA(1, 0), cA + kstep, voffA); PG8_STAGE(PG8_SB(1, 1), cB + hstep + kstep, voffB);
        PG8_WAIT_V(6); PG8_BAR;
    }
    for (;;) {
        const bool has_next = S.next(ui + 1, nxt);
        const char* nA = has_next ? PG8_AB(nxt) + (size_t)nxt.pm * tstep : cA; const char* nB = has_next ? PG8_BB(nxt) + (size_t)nxt.pn * tstep : cB;
        for (int t = 0; t < nt; t += 2) {
            const bool last = (t == nt - 2);
            const char* a1 = cA + (size_t)(t + 1) * kstep;
            const char* a2 = last ? nA : cA + (size_t)(t + 2) * kstep; const char* b2 = last ? nB : cB + (size_t)(t + 2) * kstep;
            const char* a3 = a2 + kstep; const char* b3 = b2 + kstep;
            if (last && has_next) S.a_ready(nxt);
            if constexpr (SP2) {
            PG8_LDB(B0, 0, 0); PG8_LDB(B1, 0, 1); PG8_SCHED; PG8_LDA(At, 0, 0); PG8_STAGE(PG8_SA(1, 1), a1 + hstep, voffA);
            PG8_WAIT_V(8); PG8_WAIT_L(0); PG8_BAR; PG8_MMA(0, 0, At, B0); PG8_MMA(0, 1, At, B1); PG8_BAR; PG8_SCHED;
            PG8_LDA(At, 0, 1); PG8_STAGE(PG8_SB(0, 0), b2, voffB); PG8_STAGE(PG8_SB(0, 1), b2 + hstep, voffB); PG8_STAGE(PG8_SA(0, 0), a2, voffA);
            PG8_WAIT_V(8); PG8_WAIT_L(0); PG8_BAR; PG8_MMA(1, 0, At, B0); PG8_MMA(1, 1, At, B1); PG8_BAR; PG8_SCHED;
            PG8_LDB(B0, 1, 0); PG8_LDB(B1, 1, 1); PG8_SCHED; PG8_LDA(At, 1, 0); PG8_STAGE(PG8_SA(0, 1), a2 + hstep, voffA);
            PG8_WAIT_V(8); PG8_WAIT_L(0); PG8_BAR; PG8_MMA(0, 0, At, B0); PG8_MMA(0, 1, At, B1); PG8_BAR; PG8_SCHED;
            PG8_LDA(At, 1, 1); PG8_STAGE(PG8_SB(1, 0), b3, voffB); PG8_STAGE(PG8_SB(1, 1), b3 + hstep, voffB); PG8_STAGE(PG8_SA(1, 0), a3, voffA);
            PG8_WAIT_V(8); PG8_WAIT_L(0); PG8_BAR; PG8_MMA(1, 0, At, B0); PG8_MMA(1, 1, At, B1); PG8_BAR; PG8_SCHED;
            } else {
            PG8_LDB(B0, 0, 0); PG8_SCHED; PG8_LDA(At, 0, 0); PG8_STAGE(PG8_SA(1, 1), a1 + hstep, voffA);
            PG8_WAIT_L(8); PG8_BAR; PG8_WAIT_L(0); PG8_MMA(0, 0, At, B0); PG8_BAR; PG8_SCHED;
            PG8_LDB(B1, 0, 1); PG8_STAGE(PG8_SB(0, 0), b2, voffB);
            PG8_BAR; PG8_WAIT_L(0); PG8_MMA(0, 1, At, B1); PG8_BAR;
            PG8_LDA(At, 0, 1); PG8_STAGE(PG8_SA(0, 0), a2, voffA);
            PG8_BAR; PG8_WAIT_L(0); PG8_MMA(1, 0, At, B0); PG8_BAR; PG8_SCHED;
            PG8_STAGE(PG8_SB(0, 1), b2 + hstep, voffB);
            PG8_WAIT_V(6); PG8_BAR; PG8_MMA(1, 1, At, B1); PG8_BAR;
            PG8_LDB(B0, 1, 0); PG8_SCHED; PG8_LDA(At, 1, 0); PG8_STAGE(PG8_SA(0, 1), a2 + hstep, voffA);
            PG8_WAIT_L(8); PG8_BAR; PG8_WAIT_L(0); PG8_MMA(0, 0, At, B0); PG8_BAR; PG8_SCHED;
            PG8_LDB(B1, 1, 1); PG8_STAGE(PG8_SB(1, 0), b3, voffB);
            PG8_BAR; PG8_WAIT_L(0); PG8_MMA(0, 1, At, B1); PG8_BAR;
            PG8_LDA(At, 1, 1); PG8_STAGE(PG8_SA(1, 0), a3, voffA);
            PG8_BAR; PG8_WAIT_L(0); PG8_MMA(1, 0, At, B0); PG8_BAR; PG8_SCHED;
            PG8_STAGE(PG8_SB(1, 1), b3 + hstep, voffB);
            PG8_WAIT_V(6); PG8_BAR; PG8_MMA(1, 1, At, B1); PG8_BAR;
            }
        }
        if constexpr (ALIGN_EPI) { if (wr == 0) PG8_BAR; }
        bool keep_acc = false;
        if constexpr (!Epi::AFTER_DRAIN) { if constexpr (Sched::MULTI) keep_acc = E(acc, cur, wr, wc, fr, fq); else E(acc, cur, wr, wc, fr, fq); S.done(cur); }
        if (!has_next) break;
        if (!keep_acc) {
#pragma unroll
        for (int a = 0; a < 2; ++a)
#pragma unroll
            for (int b = 0; b < 2; ++b)
#pragma unroll
                for (int m = 0; m < 4; ++m)
#pragma unroll
                    for (int n = 0; n < 2; ++n) acc[a][b][m][n] = (f32x4){0.f, 0.f, 0.f, 0.f};
        }
        cur = nxt; cA = nA; cB = nB; ++ui;
        if constexpr (ALIGN_EPI) { if (wr == 1) PG8_BAR; }
    }
    PG8_WAIT_V(0);
    if constexpr (!ALIGN_EPI) { if (wr == 0) PG8_BAR; }
    PG8_BAR;
    if constexpr (Epi::AFTER_DRAIN) { E.fused(acc, cur, wr, wc, fr, fq, lds, wid, lane); S.done(cur); }
#undef PG8_AB
#undef PG8_BB
#undef PG8_SA
#undef PG8_SB
#undef PG8_STAGE
#undef PG8_LDA
#undef PG8_LDB
#undef PG8_MMA
#undef PG8_WAIT_V
#undef PG8_WAIT_L
#undef PG8_BAR
#undef PG8_SCHED
}
}


namespace tk {
typedef short bf16x8 __attribute__((ext_vector_type(8)));
constexpr int RSK = 272, TAB = 69632, TABW = 33 * 16 * 4, IJT = TAB + 8 * TABW;
__device__ __forceinline__ void ce(float& a, float& b) { const float hi = __builtin_fmaxf(a, b), lo = __builtin_fminf(a, b); a = hi; b = lo; }
__device__ __forceinline__ void sort16(float (&v)[16]) {
#pragma unroll
    for (int k = 2; k <= 16; k <<= 1)
#pragma unroll
        for (int j = k >> 1; j > 0; j >>= 1)
#pragma unroll
            for (int i = 0; i < 16; ++i) { const int l = i ^ j; if (l > i) { if ((i & k) == 0) ce(v[i], v[l]); else ce(v[l], v[i]); } }
}
__device__ __forceinline__ void merge16(float (&a)[16], const float (&b)[16]) {
#pragma unroll
    for (int i = 0; i < 16; ++i) a[i] = __builtin_fmaxf(a[i], b[15 - i]);
#pragma unroll
    for (int j = 8; j > 0; j >>= 1)
#pragma unroll
        for (int i = 0; i < 16; ++i) { const int l = i ^ j; if (l > i) ce(a[i], a[l]); }
}
__device__ __forceinline__ void xmerge(float (&a)[16], int mask) { float b[16];
#pragma unroll
    for (int i = 0; i < 16; ++i) b[i] = __shfl_xor(a[i], mask);
    merge16(a, b); }
}
template <bool OWN>
__device__ __forceinline__ void p_topk(const Ctx& C, const bf16_t* qp, const bf16_t* keys, unsigned short* pidx, float* pgate) {
    using namespace tk;
    LAS unsigned char* L = C.lds;
    const int tid = C.tid, lane = C.lane, w = C.wave, g = lane >> 4, i16 = lane & 15;
    __syncthreads();
    for (int i = tid; i < 4096; i += NTHR) { const int r = i >> 4, cc = i & 15; *(LAS u32x4*)(L + r * RSK + cc * 16) = *(const u32x4*)(keys + (size_t)r * 128 + cc * 8); }
    if (tid < 64) { int cnt = 0, fi = 0, fj = 0;
        for (int i = 0; i < 16; ++i) for (int j = 0; j < 16; ++j) if ((i + 1) * (j + 1) <= 16) { if (cnt == tid) { fi = i; fj = j; } ++cnt; }
        ((LAS unsigned*)(L + IJT))[tid] = (unsigned)(fi | (fj << 4)); }
    __syncthreads();
    LAS unsigned* tab = (LAS unsigned*)(L + TAB + w * TABW) + i16 * 33;
    const LAS unsigned* ijt = (const LAS unsigned*)(L + IJT);
    const float NEGV = -1.0e30f;
    const int gw = C.bid * NWAVES + w, NGW = C.G * NWAVES;
    pg8::StaticOrder SO; SO.init(T, 2048, C.G, C.bid);
    for (int unit = OWN ? w : gw; ; unit += OWN ? NWAVES : NGW) {
        int tg, hh;
        if constexpr (OWN) { pg8::Unit u; if (!SO.next(unit >> 4, u)) break; tg = 16 * u.pm + (unit & 15); hh = u.pn; }
        else { if (unit >= (T / 16) * 8) break; tg = unit >> 3; hh = unit & 7; }
        const size_t t0 = (size_t)tg * 16;
        float s1[16], s2[16];
#pragma unroll
        for (int z = 0; z < 2; ++z) {
            bf16x8 qf[4];
#pragma unroll
            for (int ks = 0; ks < 4; ++ks) qf[ks] = *(const bf16x8*)(qp + (t0 + i16) * 2048 + hh * 256 + z * 128 + ks * 32 + g * 8);
            float lo[16], hi[16];
#pragma unroll
            for (int nt = 0; nt < 8; ++nt) { f32x4 acc = (f32x4){0.f, 0.f, 0.f, 0.f};
#pragma unroll
                for (int ks = 0; ks < 4; ++ks) { const bf16x8 kf = *(const LAS bf16x8*)(L + (z * 128 + 16 * nt + i16) * RSK + ks * 64 + g * 16);
                    acc = __builtin_amdgcn_mfma_f32_16x16x32_bf16(kf, qf[ks], acc, 0, 0, 0); }
#pragma unroll
                for (int r = 0; r < 4; ++r) { const float pv = __uint_as_float((__float_as_uint(acc[r]) & 0xFFFFFF80u) | (unsigned)(16 * nt + 4 * g + r));
                    if (nt < 4) lo[nt * 4 + r] = pv; else hi[(nt - 4) * 4 + r] = pv; } }
            sort16(lo); sort16(hi); merge16(lo, hi);
            xmerge(lo, 16); xmerge(lo, 32);
#pragma unroll
            for (int i = 0; i < 16; ++i) { if (z == 0) s1[i] = lo[i]; else s2[i] = lo[i]; }
        }
#pragma unroll
        for (int i = 0; i < 16; ++i) { tab[i] = __float_as_uint(s1[i]); tab[16 + i] = __float_as_uint(s2[i]); }
        float cand[16];
            { const float a_ = (g == 0 ? s1[0] : g == 1 ? s1[1] : g == 2 ? s1[3] : s1[14]), b_ = (g == 0 ? s2[0] : g == 1 ? s2[0] : g == 2 ? s2[3] : s2[0]); cand[0] = __uint_as_float((__float_as_uint(a_ + b_) & 0xFFFFFFC0u) | (unsigned)(16 * g + 0)); }
            { const float a_ = (g == 0 ? s1[0] : g == 1 ? s1[1] : g == 2 ? s1[4] : s1[15]), b_ = (g == 0 ? s2[1] : g == 1 ? s2[1] : g == 2 ? s2[0] : s2[0]); cand[1] = __uint_as_float((__float_as_uint(a_ + b_) & 0xFFFFFFC0u) | (unsigned)(16 * g + 1)); }
            { const float a_ = (g == 0 ? s1[0] : g == 1 ? s1[1] : g == 2 ? s1[4] : NEGV), b_ = (g == 0 ? s2[2] : g == 1 ? s2[2] : g == 2 ? s2[1] : NEGV); cand[2] = __uint_as_float((__float_as_uint(a_ + b_) & 0xFFFFFFC0u) | (unsigned)(16 * g + 2)); }
            { const float a_ = (g == 0 ? s1[0] : g == 1 ? s1[1] : g == 2 ? s1[4] : NEGV), b_ = (g == 0 ? s2[3] : g == 1 ? s2[3] : g == 2 ? s2[2] : NEGV); cand[3] = __uint_as_float((__float_as_uint(a_ + b_) & 0xFFFFFFC0u) | (unsigned)(16 * g + 3)); }
            { const float a_ = (g == 0 ? s1[0] : g == 1 ? s1[1] : g == 2 ? s1[5] : NEGV), b_ = (g == 0 ? s2[4] : g == 1 ? s2[4] : g == 2 ? s2[0] : NEGV); cand[4] = __uint_as_float((__float_as_uint(a_ + b_) & 0xFFFFFFC0u) | (unsigned)(16 * g + 4)); }
            { const float a_ = (g == 0 ? s1[0] : g == 1 ? s1[1] : g == 2 ? s1[5] : NEGV), b_ = (g == 0 ? s2[5] : g == 1 ? s2[5] : g == 2 ? s2[1] : NEGV); cand[5] = __uint_as_float((__float_as_uint(a_ + b_) & 0xFFFFFFC0u) | (unsigned)(16 * g + 5)); }
            { const float a_ = (g == 0 ? s1[0] : g == 1 ? s1[1] : g == 2 ? s1[6] : NEGV), b_ = (g == 0 ? s2[6] : g == 1 ? s2[6] : g == 2 ? s2[0] : NEGV); cand[6] = __uint_as_float((__float_as_uint(a_ + b_) & 0xFFFFFFC0u) | (unsigned)(16 * g + 6)); }
            { const float a_ = (g == 0 ? s1[0] : g == 1 ? s1[1] : g == 2 ? s1[6] : NEGV), b_ = (g == 0 ? s2[7] : g == 1 ? s2[7] : g == 2 ? s2[1] : NEGV); cand[7] = __uint_as_float((__float_as_uint(a_ + b_) & 0xFFFFFFC0u) | (unsigned)(16 * g + 7)); }
            { const float a_ = (g == 0 ? s1[0] : g == 1 ? s1[2] : g == 2 ? s1[7] : NEGV), b_ = (g == 0 ? s2[8] : g == 1 ? s2[0] : g == 2 ? s2[0] : NEGV); cand[8] = __uint_as_float((__float_as_uint(a_ + b_) & 0xFFFFFFC0u) | (unsigned)(16 * g + 8)); }
            { const float a_ = (g == 0 ? s1[0] : g == 1 ? s1[2] : g == 2 ? s1[7] : NEGV), b_ = (g == 0 ? s2[9] : g == 1 ? s2[1] : g == 2 ? s2[1] : NEGV); cand[9] = __uint_as_float((__float_as_uint(a_ + b_) & 0xFFFFFFC0u) | (unsigned)(16 * g + 9)); }
            { const float a_ = (g == 0 ? s1[0] : g == 1 ? s1[2] : g == 2 ? s1[8] : NEGV), b_ = (g == 0 ? s2[10] : g == 1 ? s2[2] : g == 2 ? s2[0] : NEGV); cand[10] = __uint_as_float((__float_as_uint(a_ + b_) & 0xFFFFFFC0u) | (unsigned)(16 * g + 10)); }
            { const float a_ = (g == 0 ? s1[0] : g == 1 ? s1[2] : g == 2 ? s1[9] : NEGV), b_ = (g == 0 ? s2[11] : g == 1 ? s2[3] : g == 2 ? s2[0] : NEGV); cand[11] = __uint_as_float((__float_as_uint(a_ + b_) & 0xFFFFFFC0u) | (unsigned)(16 * g + 11)); }
            { const float a_ = (g == 0 ? s1[0] : g == 1 ? s1[2] : g == 2 ? s1[10] : NEGV), b_ = (g == 0 ? s2[12] : g == 1 ? s2[4] : g == 2 ? s2[0] : NEGV); cand[12] = __uint_as_float((__float_as_uint(a_ + b_) & 0xFFFFFFC0u) | (unsigned)(16 * g + 12)); }
            { const float a_ = (g == 0 ? s1[0] : g == 1 ? s1[3] : g == 2 ? s1[11] : NEGV), b_ = (g == 0 ? s2[13] : g == 1 ? s2[0] : g == 2 ? s2[0] : NEGV); cand[13] = __uint_as_float((__float_as_uint(a_ + b_) & 0xFFFFFFC0u) | (unsigned)(16 * g + 13)); }
            { const float a_ = (g == 0 ? s1[0] : g == 1 ? s1[3] : g == 2 ? s1[12] : NEGV), b_ = (g == 0 ? s2[14] : g == 1 ? s2[1] : g == 2 ? s2[0] : NEGV); cand[14] = __uint_as_float((__float_as_uint(a_ + b_) & 0xFFFFFFC0u) | (unsigned)(16 * g + 14)); }
            { const float a_ = (g == 0 ? s1[0] : g == 1 ? s1[3] : g == 2 ? s1[13] : NEGV), b_ = (g == 0 ? s2[15] : g == 1 ? s2[2] : g == 2 ? s2[0] : NEGV); cand[15] = __uint_as_float((__float_as_uint(a_ + b_) & 0xFFFFFFC0u) | (unsigned)(16 * g + 15)); }
        sort16(cand);
        xmerge(cand, 16); xmerge(cand, 32);
        float den = 0.f, ex[16];
#pragma unroll
        for (int i = 0; i < 16; ++i) { ex[i] = __expf(cand[i] - cand[0]); den += ex[i]; }
        const float inv = 1.f / den;
        unsigned short eo[4]; float go[4];
#pragma unroll
        for (int e = 0; e < 4; ++e) {
            const float cv = (g == 0 ? cand[e] : g == 1 ? cand[4 + e] : g == 2 ? cand[8 + e] : cand[12 + e]);
            const float gv = (g == 0 ? ex[e] : g == 1 ? ex[4 + e] : g == 2 ? ex[8 + e] : ex[12 + e]);
            const unsigned code = __float_as_uint(cv) & 63u; const unsigned ij = ijt[code];
            const unsigned p1 = tab[ij & 15u], p2 = tab[16 + (ij >> 4)];
            eo[e] = (unsigned short)((p1 & 127u) * 128u + (p2 & 127u)); go[e] = gv * inv; }
        u32x2 ov; ov.x = (unsigned)eo[0] | ((unsigned)eo[1] << 16); ov.y = (unsigned)eo[2] | ((unsigned)eo[3] << 16);
        *(u32x2*)(pidx + (t0 + i16) * 128 + hh * 16 + 4 * g) = ov;
        *(f32x4*)(pgate + (t0 + i16) * 128 + hh * 16 + 4 * g) = (f32x4){go[0], go[1], go[2], go[3]};
    }
    __syncthreads();
}

#define GAS __attribute__((address_space(1)))
typedef GAS unsigned gu32;
#define RLX_AGENT __ATOMIC_RELAXED, __HIP_MEMORY_SCOPE_AGENT
#define XB_TMO      128
#define XB_XCNT(j)  (256  + 64 * (j))
#define XB_XSUB(j)  (1280 + 64 * (j))
#define XB_XGEN(j)  (2304 + 64 * (j))
#define XB_TOP      3328
#define XB_TOPGEN   3392
#define XCD_BAR_WORDS 3456
#define XB_SPIN_CAP (1u << 18)

__device__ __forceinline__ unsigned xb_ld(unsigned* p)              { return __hip_atomic_load(p, __ATOMIC_RELAXED, __HIP_MEMORY_SCOPE_AGENT); }
__device__ __forceinline__ unsigned xb_add(unsigned* p, unsigned v) { return __hip_atomic_fetch_add(p, v, __ATOMIC_RELAXED, __HIP_MEMORY_SCOPE_AGENT); }
__device__ __forceinline__ unsigned xb_xcc_id() { return (unsigned)__builtin_amdgcn_s_getreg((3 << 11) | 20) & 0xFu; }
#define XB_SPIN(cond, bar) do { unsigned _sp = 0; while (cond) { __builtin_amdgcn_s_sleep(1); \
    if ((++_sp & 255u) == 0u) { if (xb_ld(&(bar)[XB_TMO])) break; if (_sp > XB_SPIN_CAP) { atomicAdd(&(bar)[XB_TMO], 1u); break; } } } } while (0)

struct XcdBarrier {
    unsigned* bar; unsigned x;
    volatile LAS unsigned* st;
};

__device__ __forceinline__ XcdBarrier xcd_barrier_post(unsigned* bar, volatile LAS unsigned* st) {
    XcdBarrier b; b.bar = bar; b.x = xb_xcc_id(); b.st = st;
    if (threadIdx.x == 0) (void)xb_add(&bar[XB_XCNT(b.x)], 1u);
    return b;
}
__device__ __forceinline__ void xcd_barrier_complete(unsigned* bar, unsigned x, unsigned& nloc, unsigned& nx) {
    const unsigned G = gridDim.x * gridDim.y * gridDim.z;
    unsigned sum, cnt, mine, sp = 0u;
    for (;;) {
        sum = 0u; cnt = 0u; mine = 0u;
#pragma unroll
        for (unsigned j = 0; j < 16; ++j) { const unsigned c = xb_ld(&bar[XB_XCNT(j)]); sum += c; cnt += (c > 0u) ? 1u : 0u; mine = (j == x) ? c : mine; }
        if (sum == G) break;
        __builtin_amdgcn_s_sleep(1);
        if ((++sp & 255u) == 0u) { if (xb_ld(&bar[XB_TMO])) break; if (sp > XB_SPIN_CAP) { atomicAdd(&bar[XB_TMO], 1u); break; } }
    }
    nloc = mine > 0u ? mine : 1u; nx = cnt > 0u ? cnt : 1u;
}

__device__ __forceinline__ void xcd_barrier(const XcdBarrier& b) {
    asm volatile("s_waitcnt vmcnt(0)" ::: "memory");
    __syncthreads();
    if (threadIdx.x == 0) {
        unsigned* bar = b.bar;
        __builtin_amdgcn_s_waitcnt(0);
        unsigned nloc = b.st[0], nx = b.st[1];
        if (nloc == 0u) { xcd_barrier_complete(bar, b.x, nloc, nx); b.st[0] = nloc; b.st[1] = nx; }
        const unsigned old = xb_add(&bar[XB_XSUB(b.x)], 1u);
        const unsigned gen = old / nloc;
        if (old + 1u == (gen + 1u) * nloc) {
            __builtin_amdgcn_fence(__ATOMIC_RELEASE, "agent");
            asm volatile("s_waitcnt vmcnt(0)" ::: "memory");
            const unsigned og = xb_add(&bar[XB_TOP], 1u);
            const unsigned tg = og / nx;
            if (og + 1u == (tg + 1u) * nx) xb_add(&bar[XB_TOPGEN], 1u);
            else XB_SPIN(xb_ld(&bar[XB_TOPGEN]) == tg, bar);
            __builtin_amdgcn_fence(__ATOMIC_ACQUIRE, "agent");
            xb_add(&bar[XB_XGEN(b.x)], 1u);
            asm volatile("s_waitcnt vmcnt(0)" ::: "memory");
        } else {
            XB_SPIN(xb_ld(&bar[XB_XGEN(b.x)]) == gen, bar);
            __builtin_amdgcn_fence(__ATOMIC_ACQUIRE, "agent");
            asm volatile("s_waitcnt vmcnt(0)" ::: "memory");
        }
    }
    __syncthreads();
}


constexpr int N_PHASES = 14;
constexpr int CW_BAR = 4096;
constexpr size_t CTL_ZERO_BYTES = 64 * 1024;
constexpr int MISC_OFF = LDS_BYTES - 256;

template <int PH>
__device__ __forceinline__ void run_phase(const Ctx& C, const Args& a) {
    bf16_t* R0 = C.bfp(WS_R0); bf16_t* R1 = C.bfp(WS_R1); bf16_t* R2 = C.bfp(WS_R2); bf16_t* R3 = C.bfp(WS_R3);
    bf16_t* OB = (bf16_t*)a.out;
    const size_t TD = (size_t)T * 1024;
    if constexpr (PH == 0) p_prep(C);
    if constexpr (PH == 1) p_rownorm(C, C.in[0], C.in[4], 0, 1024, R0);
    if constexpr (PH == 2) {
        { pg8::Gemm g{R0, C.bfp(WS_WIN_T), T, 6144, 1024}; pg8::StaticOrder S; S.init(T, 6144, C.G, C.bid);
          pg8::EpiInProj e{R1, R2, R3, R3 + TD, R3 + 2 * TD};
          pg8::gemm_phase<pg8::EpiInProj, pg8::StaticOrder, true, true>(C.lds, g, S, e); }
        p_dt(C, R0, C.bfp(WS_WDT_T), C.f32p(WS_DT));
    }
    if constexpr (PH == 3) { p_conv(C, R2, OB); p_na(C, R3, R3 + TD, R3 + 2 * TD); }
    if constexpr (PH == 4) p_ssd(C, OB, C.f32p(WS_DT), R2, R2 + TD);
    if constexpr (PH == 5) p_combine(C, R2, R2 + TD, R1, C.f32p(WS_RSTD));
    if constexpr (PH == 6) {
        pg8::MultiOrder S; S.b.init(T, 1024, C.G, C.bid); S.nk = 4;
        pg8::Gemm g{R0, C.bfp(WS_WG_T), T, 1024, 1024, R0, C.bfp(WS_WG_T) + (size_t)1024 * 1024, R1, C.bfp(WS_WSSD_T), R3, C.bfp(WS_WNA_T)};
        pg8::EpiMix e{OB, OB + TD, R2 + TD, C.f32p(WS_RSTD)};
        pg8::gemm_phase<pg8::EpiMix, pg8::MultiOrder, true, true>(C.lds, g, S, e);
    }
    if constexpr (PH == 7) { pg8::Gemm g{R2 + TD, C.bfp(WS_WOUT_T), T, 1024, 1024}; pg8::StaticOrder S; S.init(T, 1024, C.G, C.bid);
        pg8::EpiD3 e{R3 + TD, C.in[0], C.f32p(WS_MOD)}; pg8::gemm_phase<pg8::EpiD3, pg8::StaticOrder, true, true>(C.lds, g, S, e); }
    if constexpr (PH == 8) { p_rownorm_b(C, R3 + TD, C.in[18], 3072, 4096, R0); p_cvt_tables8(C, (unsigned char*)R2, (unsigned char*)R2 + (size_t)16384 * 1024); }
    if constexpr (PH == 9) { pg8::Gemm g{R0, C.bfp(WS_WPQ_T), T, 2048, 1024}; pg8::StaticOrder S; S.init(T, 2048, C.G, C.bid);
        pg8::EpiQp e{OB}; pg8::gemm_phase<pg8::EpiQp, pg8::StaticOrder, true, true>(C.lds, g, S, e);
        asm volatile("s_waitcnt vmcnt(0)" ::: "memory"); __syncthreads();
        if (C.tid == 0) __builtin_amdgcn_fence(__ATOMIC_ACQUIRE, "agent");
        asm volatile("s_waitcnt vmcnt(0)" ::: "memory"); __syncthreads();
        p_topk<true>(C, OB, C.bfp(WS_KEYS), (unsigned short*)R1, (float*)(R1 + 4 * MiB)); }
    if constexpr (PH == 10) p_gu(C, R0, (const unsigned short*)R1, (const unsigned char*)R2, a.out);
    if constexpr (PH == 11) p_gc(C, a.out, (const float*)(R1 + 4 * MiB), (float*)((unsigned char*)R2 + 32 * MiB));
    if constexpr (PH == 12) p_gv(C, (const float*)((unsigned char*)R2 + 32 * MiB), (const unsigned short*)R1, (const unsigned char*)R2 + (size_t)16384 * 1024, R3);
    if constexpr (PH == 13) p_gf(C, R3 + TD, R3, a.out);
}

template <int PH> struct PhaseLoop {
    static __device__ __forceinline__ void run(const Ctx& C, const Args& a, const XcdBarrier& bar) {
        if (PH >= a.ph_lo && PH < a.ph_hi) { run_phase<PH>(C, a); if (PH + 1 < a.ph_hi) xcd_barrier(bar); }
        PhaseLoop<PH + 1>::run(C, a, bar);
    }
};
template <> struct PhaseLoop<N_PHASES> { static __device__ __forceinline__ void run(const Ctx&, const Args&, const XcdBarrier&) {} };

__global__ void __launch_bounds__(NTHR, 2) mega(Args a) {
    extern __shared__ __attribute__((aligned(16))) unsigned char lds_raw[];
    Ctx C; C.in = a.in; C.out = a.out; C.ws = a.ws; C.tid = threadIdx.x; C.lane = C.tid & 63; C.wave = __builtin_amdgcn_readfirstlane(C.tid >> 6);
    C.G = gridDim.x; C.bid = blockIdx.x; C.lds = (LAS unsigned char*)lds_raw;
    volatile LAS unsigned* MISC = (volatile LAS unsigned*)(C.lds + MISC_OFF);
    if (C.tid < 64) MISC[C.tid] = 0u;
    __syncthreads();
    XcdBarrier bar; bar.bar = (unsigned*)(a.ws + WS_CTL) + CW_BAR; bar.x = 0; bar.st = nullptr;
    if (a.ph_hi - a.ph_lo > 1) bar = xcd_barrier_post((unsigned*)(a.ws + WS_CTL) + CW_BAR, MISC + 8);
    PhaseLoop<0>::run(C, a, bar);
}

extern "C" void kernel_launch(void* const* d_in, const int* in_sizes, int n_in, void* d_out, int out_size, void* d_ws, size_t ws_size, hipStream_t stream) {
    static int grid = 0;
    if (grid == 0) {
        if (n_in != 24 || out_size != T * D || ws_size < WS_END) { fprintf(stderr, "kernel_launch: unexpected shapes n_in %d out %d ws %zu\n", n_in, out_size, ws_size); grid = -1; return; }
        int dev = 0, cus = 0;
        if (hipGetDevice(&dev) != hipSuccess || hipDeviceGetAttribute(&cus, hipDeviceAttributeMultiprocessorCount, dev) != hipSuccess) { grid = -1; return; }
        if (hipFuncSetAttribute((const void*)mega, hipFuncAttributeMaxDynamicSharedMemorySize, LDS_BYTES) != hipSuccess) { grid = -1; return; }
        grid = cus;
    }
    if (grid < 0) return;
    (void)hipMemsetAsync((char*)d_ws + WS_CTL, 0, CTL_ZERO_BYTES, stream);
    Args a{};
    for (int i = 0; i < 24; ++i) a.in[i] = (const float*)d_in[i];
    a.out = (float*)d_out; a.ws = (unsigned char*)d_ws;
    a.ph_lo = 0; a.ph_hi = N_PHASES;
    hipLaunchKernelGGL(mega, dim3(grid), dim3(NTHR), LDS_BYTES, stream, a);
}
```

```cpp
#include <hip/hip_runtime.h>
#include <cstdio>
#include <cstdint>

#define LAS __attribute__((address_space(3)))
typedef unsigned short bf16_t;
typedef float f32x4 __attribute__((ext_vector_type(4)));
typedef unsigned u32x4 __attribute__((ext_vector_type(4)));
typedef unsigned u32x2 __attribute__((ext_vector_type(2)));
typedef __bf16 bf16x2_t __attribute__((ext_vector_type(2)));

constexpr int T = 32768, D = 1024, NB = 8, SEQ = 4096;
constexpr int NWAVES = 8, NTHR = 512;
constexpr float EPS = 1e-6f;
constexpr int OFF_Z = 0, OFF_XBC = 1024, OFF_DTF = 3072, OFF_DTB = 3088, OFF_QKV = 3104, OFF_GS = 6176, OFF_GN = 7200, D_IN = 8224;

constexpr size_t MiB = 1u << 20;
constexpr size_t WS_CTL = 0;
constexpr size_t WS_MOD = 1 * MiB;
constexpr size_t WS_RSTD = 1 * MiB + 512 * 1024;
constexpr size_t WS_DT = 2 * MiB;
constexpr size_t WS_WIN_T = 6 * MiB;
constexpr size_t WS_WG_T = 18 * MiB;
constexpr size_t WS_WDT_T = 22 * MiB;
constexpr size_t WS_KEYS = 22 * MiB + 512 * 1024;
constexpr size_t WS_WSSD_T = 23 * MiB, WS_WNA_T = 25 * MiB, WS_WOUT_T = 27 * MiB, WS_WPQ_T = 29 * MiB;
constexpr size_t WS_R0 = 40 * MiB, WS_R1 = 104 * MiB, WS_R2 = 168 * MiB, WS_R3 = 296 * MiB, WS_END = 488 * MiB;

constexpr int LDS_BYTES = 163840;

struct Args { const float* in[24]; float* out; unsigned char* ws; int ph_lo, ph_hi; };

__device__ __forceinline__ float bf2f(unsigned v) { return __uint_as_float(v << 16); }
__device__ __forceinline__ float bflo(unsigned v) { return __uint_as_float(v << 16); }
__device__ __forceinline__ float bfhi(unsigned v) { return __uint_as_float(v & 0xffff0000u); }
__device__ __forceinline__ unsigned f2bf(float f) { unsigned u = __float_as_uint(f); return (u + 0x7fffu + ((u >> 16) & 1u)) >> 16; }
typedef float f32x2_t __attribute__((ext_vector_type(2)));
__device__ __forceinline__ unsigned pk2(float lo, float hi) { f32x2_t v = {lo, hi}; bf16x2_t b = __builtin_convertvector(v, bf16x2_t); return __builtin_bit_cast(unsigned, b); }
__device__ __forceinline__ void st_wt16(void* p, const u32x4 v) { asm volatile("global_store_dwordx4 %0, %1, off sc0 sc1\n\ts_nop 1" :: "v"(p), "v"(v) : "memory"); }
__device__ __forceinline__ void st_wt8(void* p, const u32x2 v) { asm volatile("global_store_dwordx2 %0, %1, off sc0 sc1\n\ts_nop 1" :: "v"(p), "v"(v) : "memory"); }
__device__ __forceinline__ float wave_sum(float v) {
#pragma unroll
    for (int o = 1; o < 64; o <<= 1) v += __shfl_xor(v, o);
    return v;
}
__device__ __forceinline__ float silu_f(float x) { return x / (1.f + __expf(-x)); }
__device__ __forceinline__ float sigmoid_f(float x) { return 1.f / (1.f + __expf(-x)); }
__device__ __forceinline__ float softplus_f(float x) { return x > 20.f ? x : log1pf(__expf(x)); }
__device__ __forceinline__ float gelu_f(float x) { return 0.5f * x * (1.f + erff(x * 0.70710678118654752f)); }

struct Ctx {
    const float* const* in; float* out; unsigned char* ws;
    int tid, lane, wave, G, bid;
    LAS unsigned char* lds;
    __device__ __forceinline__ float* f32p(size_t off) const { return (float*)(ws + off); }
    __device__ __forceinline__ bf16_t* bfp(size_t off) const { return (bf16_t*)(ws + off); }
};

__device__ __forceinline__ void tr_item(const float* W, int ldw, int col0, int K, bf16_t* WT, int row_off, LAS float* scr, int item, int nblk, int lane, const float* kscale) {
    const int kb = item / nblk, nb = item % nblk, k0 = 64 * kb, n0 = 32 * nb;
#pragma unroll
    for (int h = 0; h < 2; ++h) {
        float xv[16];
#pragma unroll
        for (int i = 0; i < 16; ++i) { const int kk = 2 * (16 * h + i) + (lane >> 5); xv[i] = W[(size_t)(k0 + kk) * ldw + col0 + n0 + (lane & 31)]; }
        if (kscale) {
#pragma unroll
            for (int i = 0; i < 16; ++i) xv[i] *= kscale[k0 + 2 * (16 * h + i) + (lane >> 5)]; }
        asm volatile("" ::: "memory");
#pragma unroll
        for (int i = 0; i < 16; ++i) { const int kk = 2 * (16 * h + i) + (lane >> 5); scr[kk * 33 + (lane & 31)] = xv[i]; }
    }
    asm volatile("s_waitcnt lgkmcnt(0)" ::: "memory");
    const int c = lane & 7;
#pragma unroll
    for (int j = 0; j < 4; ++j) { const int n = (lane >> 3) + 8 * j; const LAS float* sp = scr + (8 * c) * 33 + n;
        u32x4 o; o.x = pk2(sp[0 * 33], sp[1 * 33]); o.y = pk2(sp[2 * 33], sp[3 * 33]); o.z = pk2(sp[4 * 33], sp[5 * 33]); o.w = pk2(sp[6 * 33], sp[7 * 33]);
        *(u32x4*)(WT + (size_t)(row_off + n0 + n) * K + k0 + 8 * c) = o; }
    asm volatile("s_waitcnt lgkmcnt(0)" ::: "memory");
}
__device__ __forceinline__ void p_prep(const Ctx& C) {
    const float* c = C.in[1]; const float* w_ada = C.in[2]; const float* b_ada = C.in[3];
    float* mod = C.f32p(WS_MOD);
    LAS float* sc = (LAS float*)C.lds;
    LAS float* red = sc + 8192;
    for (int i = C.tid; i < 8192; i += NTHR) sc[i] = silu_f(c[i]);
    __syncthreads();
    for (int jb = C.bid; jb < 256; jb += C.G) {
        const int j0 = jb * 24, jl = C.tid % 24, kq = C.tid / 24;
        if (C.tid < 504) { float acc[8];
#pragma unroll
            for (int b = 0; b < 8; ++b) acc[b] = 0.f;
            const float* wp = w_ada + (size_t)kq * 6144 + j0 + jl; const LAS float* sp = sc + kq;
            for (int i0 = 0; i0 < 48; i0 += 8) { float wv[8];
#pragma unroll
                for (int u = 0; u < 8; ++u) wv[u] = wp[(size_t)(i0 + u) * (21 * 6144)];
                asm volatile("" ::: "memory");
#pragma unroll
                for (int u = 0; u < 8; ++u)
#pragma unroll
                    for (int b = 0; b < 8; ++b) acc[b] += sp[b * 1024 + 21 * (i0 + u)] * wv[u]; }
            if (kq < 16) { const float w = wp[(size_t)48 * (21 * 6144)];
#pragma unroll
                for (int b = 0; b < 8; ++b) acc[b] += sp[b * 1024 + 21 * 48] * w; }
#pragma unroll
            for (int b = 0; b < 8; ++b) red[(kq * 24 + jl) * 8 + b] = acc[b]; }
        __syncthreads();
        if (C.tid < 192) { const int jl2 = C.tid % 24, b2 = C.tid / 24; float sacc = b_ada[j0 + jl2];
            for (int kq2 = 0; kq2 < 21; ++kq2) sacc += red[(kq2 * 24 + jl2) * 8 + b2];
            mod[b2 * 6144 + j0 + jl2] = sacc; }
        __syncthreads();
    }
    LAS float* scr = (LAS float*)(C.lds + 65536 + C.wave * 8448);
    const int gw = C.bid * NWAVES + C.wave, NGW = C.G * NWAVES;
    const float* w_in = C.in[5];
    constexpr int I_A = 16 * 96, I_B = 16 * 96, I_G = 16 * 64, I_DT = 16, I_S = 16 * 32, I_PQ = 16 * 64;
    constexpr int NIT = I_A + I_B + I_G + I_DT + 3 * I_S + I_PQ;
    for (int it = gw; it < NIT; it += NGW) {
        int r = it;
        if (r < I_A) { tr_item(w_in, D_IN, 0, D, C.bfp(WS_WIN_T), 0, scr, r, 96, C.lane, nullptr); continue; } r -= I_A;
        if (r < I_B) { tr_item(w_in, D_IN, OFF_QKV, D, C.bfp(WS_WIN_T), 3072, scr, r, 96, C.lane, nullptr); continue; } r -= I_B;
        if (r < I_G) { tr_item(w_in, D_IN, OFF_GS, D, C.bfp(WS_WG_T), 0, scr, r, 64, C.lane, nullptr); continue; } r -= I_G;
        if (r < I_DT) { tr_item(w_in, D_IN, OFF_DTF, D, C.bfp(WS_WDT_T), 0, scr, r, 1, C.lane, nullptr); continue; } r -= I_DT;
        if (r < I_S) { tr_item(C.in[14], D, 0, D, C.bfp(WS_WSSD_T), 0, scr, r, 32, C.lane, C.in[13]); continue; } r -= I_S;
        if (r < I_S) { tr_item(C.in[16], D, 0, D, C.bfp(WS_WNA_T), 0, scr, r, 32, C.lane, nullptr); continue; } r -= I_S;
        if (r < I_S) { tr_item(C.in[17], D, 0, D, C.bfp(WS_WOUT_T), 0, scr, r, 32, C.lane, nullptr); continue; } r -= I_S;
        tr_item(C.in[19], 2048, 0, D, C.bfp(WS_WPQ_T), 0, scr, r, 64, C.lane, nullptr);
    }
    { const int gt = C.bid * NTHR + C.tid, NT = C.G * NTHR; const float* kf = C.in[20]; bf16_t* kb = C.bfp(WS_KEYS);
      for (int i = gt; i < 2 * 128 * 128; i += NT) kb[i] = (bf16_t)f2bf(kf[i]); }
    __syncthreads();
}

__device__ __forceinline__ void p_rownorm(const Ctx& C, const float* X, const float* gamma, int sh_off, int sc_off, bf16_t* dst) {
    const float* mod = C.f32p(WS_MOD);
    const int gw = C.bid * NWAVES + C.wave, NGW = C.G * NWAVES;
    for (int row0 = gw * 4; row0 < T; row0 += NGW * 4) {
        const int b = row0 / SEQ;
        f32x4 v[4][4]; float s[4];
#pragma unroll
        for (int r = 0; r < 4; ++r) { const f32x4* xr = (const f32x4*)(X + (size_t)(row0 + r) * D) + C.lane;
#pragma unroll
            for (int j = 0; j < 4; ++j) v[r][j] = xr[64 * j]; }
#pragma unroll
        for (int r = 0; r < 4; ++r) { float a = 0.f;
#pragma unroll
            for (int j = 0; j < 4; ++j) a += (v[r][j].x * v[r][j].x + v[r][j].y * v[r][j].y) + (v[r][j].z * v[r][j].z + v[r][j].w * v[r][j].w);
            s[r] = rsqrtf(wave_sum(a) * (1.f / D) + EPS); }
#pragma unroll
        for (int j = 0; j < 4; ++j) {
            const int col = 4 * C.lane + 256 * j;
            const f32x4 g = *(const f32x4*)(gamma + col), sh = *(const f32x4*)(mod + b * 6144 + sh_off + col), sc = *(const f32x4*)(mod + b * 6144 + sc_off + col);
            const f32x4 gs = g * (sc + 1.f);
#pragma unroll
            for (int r = 0; r < 4; ++r) { const f32x4 y = v[r][j] * s[r] * gs + sh; u32x2 w; w.x = pk2(y.x, y.y); w.y = pk2(y.z, y.w);
                st_wt8((u32x2*)(dst + (size_t)(row0 + r) * D) + C.lane + 64 * j, w); }
        }
    }
}

__device__ __forceinline__ void p_rownorm_b(const Ctx& C, const bf16_t* X, const float* gamma, int sh_off, int sc_off, bf16_t* dst) {
    const float* mod = C.f32p(WS_MOD);
    const int gw = C.bid * NWAVES + C.wave, NGW = C.G * NWAVES;
    for (int row0 = gw * 4; row0 < T; row0 += NGW * 4) {
        const int b = row0 / SEQ;
        u32x2 w[4][4]; float s[4];
#pragma unroll
        for (int r = 0; r < 4; ++r)
#pragma unroll
            for (int j = 0; j < 4; ++j) w[r][j] = *((const u32x2*)(X + (size_t)(row0 + r) * D) + C.lane + 64 * j);
        f32x4 v[4][4];
#pragma unroll
        for (int r = 0; r < 4; ++r) { float a = 0.f;
#pragma unroll
            for (int j = 0; j < 4; ++j) { v[r][j].x = bflo(w[r][j].x); v[r][j].y = bfhi(w[r][j].x); v[r][j].z = bflo(w[r][j].y); v[r][j].w = bfhi(w[r][j].y);
                a += (v[r][j].x * v[r][j].x + v[r][j].y * v[r][j].y) + (v[r][j].z * v[r][j].z + v[r][j].w * v[r][j].w); }
            s[r] = rsqrtf(wave_sum(a) * (1.f / D) + EPS); }
#pragma unroll
        for (int j = 0; j < 4; ++j) {
            const int col = 4 * C.lane + 256 * j;
            const f32x4 g = *(const f32x4*)(gamma + col), sh = *(const f32x4*)(mod + b * 6144 + sh_off + col), sc = *(const f32x4*)(mod + b * 6144 + sc_off + col);
            const f32x4 gs = g * (sc + 1.f);
#pragma unroll
            for (int r = 0; r < 4; ++r) { const f32x4 y = v[r][j] * s[r] * gs + sh; u32x2 o; o.x = pk2(y.x, y.y); o.y = pk2(y.z, y.w);
                st_wt8((u32x2*)(dst + (size_t)(row0 + r) * D) + C.lane + 64 * j, o); }
        }
    }
}

__device__ __forceinline__ void p_dt(const Ctx& C, const bf16_t* n1, const bf16_t* wdt, float* dt) {
    typedef short bf16x8 __attribute__((ext_vector_type(8)));
    const float* bf = C.in[8]; const float* bb = C.in[9];
    const int gw = C.bid * NWAVES + C.wave, NGW = C.G * NWAVES, lane = C.lane, g = lane >> 4, i16 = lane & 15;
    for (int tile = gw; tile < T / 16; tile += NGW) {
        const size_t t0 = (size_t)tile * 16;
        f32x4 a0 = (f32x4){0.f, 0.f, 0.f, 0.f}, a1 = a0;
#pragma unroll 8
        for (int ks = 0; ks < 32; ++ks) {
            const bf16x8 av = *(const bf16x8*)(n1 + (t0 + i16) * 1024 + ks * 32 + g * 8);
            const bf16x8 b0 = *(const bf16x8*)(wdt + (size_t)i16 * 1024 + ks * 32 + g * 8), b1 = *(const bf16x8*)(wdt + (size_t)(16 + i16) * 1024 + ks * 32 + g * 8);
            a0 = __builtin_amdgcn_mfma_f32_16x16x32_bf16(av, b0, a0, 0, 0, 0); a1 = __builtin_amdgcn_mfma_f32_16x16x32_bf16(av, b1, a1, 0, 0, 0); }
        const float bias0 = bf[i16], bias1 = bb[i16];
#pragma unroll
        for (int r = 0; r < 4; ++r) { dt[(t0 + 4 * g + r) * 32 + i16] = softplus_f(a0[r] + bias0); dt[(t0 + 4 * g + r) * 32 + 16 + i16] = softplus_f(a1[r] + bias1); }
    }
}

__device__ __forceinline__ void p_conv(const Ctx& C, const bf16_t* xbc, bf16_t* xc) {
    const float* cw = C.in[6]; const float* cb = C.in[7];
    const int gt = C.bid * NTHR + C.tid, NT = C.G * NTHR;
    for (int i = gt; i < (T / 8) * 256; i += NT) {
        const int cg = i & 255, run = i >> 8, t0 = run * 8, l0 = t0 & (SEQ - 1), ch = cg * 8;
        float w[5][8], acc[8][8];
#pragma unroll
        for (int j = 0; j < 5; ++j) { const f32x4 w0 = *(const f32x4*)(cw + j * 2048 + ch), w1 = *(const f32x4*)(cw + j * 2048 + ch + 4);
            w[j][0] = w0.x; w[j][1] = w0.y; w[j][2] = w0.z; w[j][3] = w0.w; w[j][4] = w1.x; w[j][5] = w1.y; w[j][6] = w1.z; w[j][7] = w1.w; }
        { const f32x4 b0 = *(const f32x4*)(cb + ch), b1 = *(const f32x4*)(cb + ch + 4);
#pragma unroll
          for (int o = 0; o < 8; ++o) { acc[o][0] = b0.x; acc[o][1] = b0.y; acc[o][2] = b0.z; acc[o][3] = b0.w; acc[o][4] = b1.x; acc[o][5] = b1.y; acc[o][6] = b1.z; acc[o][7] = b1.w; } }
        u32x4 rw[12];
#pragma unroll
        for (int rr = 0; rr < 12; ++rr) { const int ll = l0 + rr - 2; rw[rr] = (u32x4){0u, 0u, 0u, 0u};
            if (ll >= 0 && ll < SEQ) rw[rr] = *(const u32x4*)(xbc + (size_t)(t0 + rr - 2) * 2048 + ch); }
#pragma unroll
        for (int rr = 0; rr < 12; ++rr) {
            const float x[8] = {bflo(rw[rr].x), bfhi(rw[rr].x), bflo(rw[rr].y), bfhi(rw[rr].y), bflo(rw[rr].z), bfhi(rw[rr].z), bflo(rw[rr].w), bfhi(rw[rr].w)};
#pragma unroll
            for (int j = 0; j < 5; ++j) { const int o = rr - j; if (o >= 0 && o < 8) {
#pragma unroll
                for (int q = 0; q < 8; ++q) acc[o][q] += w[j][q] * x[q]; } }
        }
#pragma unroll
        for (int o = 0; o < 8; ++o) { u32x4 ov; ov.x = pk2(silu_f(acc[o][0]), silu_f(acc[o][1])); ov.y = pk2(silu_f(acc[o][2]), silu_f(acc[o][3])); ov.z = pk2(silu_f(acc[o][4]), silu_f(acc[o][5])); ov.w = pk2(silu_f(acc[o][6]), silu_f(acc[o][7]));
            st_wt16(xc + (size_t)(t0 + o) * 2048 + ch, ov); }
    }
}

namespace ssd {
typedef short bf16x8 __attribute__((ext_vector_type(8)));
typedef short s16x4 __attribute__((ext_vector_type(4)));
constexpr int RS = 272, RSX = 144;
constexpr int CN = 0, BN = 34816, BS = 69632, SL = 104448, SLB = 17408, XN = 139264, CSB = 157696;
__device__ __forceinline__ unsigned pkbf(float lo, float hi) { return pk2(lo, hi); }
__device__ __forceinline__ bf16x8 trfrag_p(LAS unsigned char* base, int stride, int ks, int c, int g, int q, int pp) {
    LAS unsigned char* a0 = base + (32 * ks + 4 * g + q) * stride + 32 * c + 8 * pp;
    const s16x4 v0 = __builtin_amdgcn_ds_read_tr16_b64_v4i16((LAS s16x4*)a0);
    const s16x4 v1 = __builtin_amdgcn_ds_read_tr16_b64_v4i16((LAS s16x4*)(a0 + 16 * stride));
    bf16x8 r; r[0] = v0[0]; r[1] = v0[1]; r[2] = v0[2]; r[3] = v0[3]; r[4] = v1[0]; r[5] = v1[1]; r[6] = v1[2]; r[7] = v1[3]; return r;
}
}
__device__ __forceinline__ void p_ssd(const Ctx& C, const bf16_t* xc, const float* dtb, bf16_t* yf, bf16_t* yb) {
    using namespace ssd;
    LAS unsigned char* L = C.lds;
    const int tid = C.tid, lane = C.lane, w = C.wave, g = lane >> 4, i16 = lane & 15, q = (lane >> 2) & 3, pp = lane & 3;
    for (int unit = C.bid; unit < 256; unit += C.G) {
        const int dir = unit & 1, hd = (unit >> 1) & 15, b = unit >> 5, grp = hd >> 2;
        const float a = -__expf((dir ? C.in[11] : C.in[10])[hd]);
        const float dsk = dir ? 0.f : C.in[12][hd];
        bf16_t* yout = dir ? yb : yf;
        f32x4 sacc[4];
#pragma unroll
        for (int pt = 0; pt < 4; ++pt) sacc[pt] = (f32x4){0.f, 0.f, 0.f, 0.f};
        __syncthreads();
        for (int i = tid; i < 2 * SLB / 4; i += NTHR) ((LAS unsigned*)(L + SL))[i] = 0u;
        u32x4 pfC[4], pfB[4], pfX[2]; float pfd0 = 0.f, pfd1 = 0.f;
#define SSD_ISSUE(ci_) do { const int c_ = dir ? (31 - (ci_)) : (ci_); const size_t t0_ = (size_t)b * SEQ + (size_t)c_ * 128; \
            _Pragma("unroll") for (int i_ = 0; i_ < 4; ++i_) { const int idx_ = tid + NTHR * i_, l_ = idx_ >> 4, cc_ = idx_ & 15; const bf16_t* rp_ = xc + (t0_ + l_) * 2048 + grp * 128 + cc_ * 8; \
                pfB[i_] = *(const u32x4*)(rp_ + 1024); pfC[i_] = *(const u32x4*)(rp_ + 1536); } \
            _Pragma("unroll") for (int i_ = 0; i_ < 2; ++i_) { const int idx_ = tid + NTHR * i_, l_ = idx_ >> 3, cc_ = idx_ & 7; pfX[i_] = *(const u32x4*)(xc + (t0_ + l_) * 2048 + hd * 64 + cc_ * 8); } \
            if (w == 0) { const int l0_ = dir ? (127 - 2 * lane) : (2 * lane), l1_ = dir ? (126 - 2 * lane) : (2 * lane + 1); \
                pfd0 = dtb[(t0_ + l0_) * 32 + dir * 16 + hd]; pfd1 = dtb[(t0_ + l1_) * 32 + dir * 16 + hd]; } } while (0)
#define SSD_SCAN(buf_) do { if (w == 0) { const float da0_ = pfd0 * a, da1_ = pfd1 * a; const float p1_ = da0_ + da1_; float s_ = p1_; \
            s_ += __int_as_float(__builtin_amdgcn_update_dpp(0, __float_as_int(s_), 0x111, 0xF, 0xF, false)); s_ += __int_as_float(__builtin_amdgcn_update_dpp(0, __float_as_int(s_), 0x112, 0xF, 0xF, false)); \
            s_ += __int_as_float(__builtin_amdgcn_update_dpp(0, __float_as_int(s_), 0x114, 0xF, 0xF, false)); s_ += __int_as_float(__builtin_amdgcn_update_dpp(0, __float_as_int(s_), 0x118, 0xF, 0xF, false)); \
            s_ += __int_as_float(__builtin_amdgcn_update_dpp(0, __float_as_int(s_), 0x142, 0xA, 0xF, false)); s_ += __int_as_float(__builtin_amdgcn_update_dpp(0, __float_as_int(s_), 0x143, 0xC, 0xF, false)); \
            const float ex_ = s_ - p1_, cs0_ = ex_ + da0_, cs1_ = ex_ + p1_, tot_ = __int_as_float(__builtin_amdgcn_readlane(__float_as_int(s_), 63)); \
            const int l0_ = dir ? (127 - 2 * lane) : (2 * lane), l1_ = dir ? (126 - 2 * lane) : (2 * lane + 1); \
            LAS float* cb_ = (LAS float*)(L + CSB + (buf_) * 1536); \
            cb_[l0_] = cs0_; cb_[l1_] = cs1_; cb_[128 + l0_] = pfd0; cb_[128 + l1_] = pfd1; cb_[256 + l0_] = pfd0 * __expf(tot_ - cs0_); cb_[256 + l1_] = pfd1 * __expf(tot_ - cs1_); \
            if (lane == 0) *(LAS float*)(L + CSB + 3072 + 8 * (buf_)) = tot_; } } while (0)
#define SSD_WRITE(buf_) do { const LAS float* dw_ = (const LAS float*)(L + CSB + (buf_) * 1536 + 1024); float scv_[4]; \
            _Pragma("unroll") for (int i_ = 0; i_ < 4; ++i_) scv_[i_] = dw_[(tid + NTHR * i_) >> 4]; \
            _Pragma("unroll") for (int i_ = 0; i_ < 4; ++i_) { const int idx_ = tid + NTHR * i_, l_ = idx_ >> 4, cc_ = idx_ & 15; \
                *(LAS u32x4*)(L + CN + l_ * RS + cc_ * 16) = pfC[i_]; *(LAS u32x4*)(L + BN + l_ * RS + cc_ * 16) = pfB[i_]; \
                const float sc_ = scv_[i_]; const u32x4 v_ = pfB[i_]; u32x4 o_; \
                o_.x = pkbf(bflo(v_.x) * sc_, bfhi(v_.x) * sc_); o_.y = pkbf(bflo(v_.y) * sc_, bfhi(v_.y) * sc_); o_.z = pkbf(bflo(v_.z) * sc_, bfhi(v_.z) * sc_); o_.w = pkbf(bflo(v_.w) * sc_, bfhi(v_.w) * sc_); \
                *(LAS u32x4*)(L + BS + l_ * RS + cc_ * 16) = o_; } \
            _Pragma("unroll") for (int i_ = 0; i_ < 2; ++i_) { const int idx_ = tid + NTHR * i_, l_ = idx_ >> 3, cc_ = idx_ & 7; *(LAS u32x4*)(L + XN + l_ * RSX + cc_ * 16) = pfX[i_]; } } while (0)
        SSD_ISSUE(0);
        SSD_SCAN(0);
        __syncthreads();
        SSD_WRITE(0);
        __syncthreads();
        for (int ci = 0; ci < 32; ++ci) {
            const int buf = ci & 1;
            const int c = dir ? (31 - ci) : ci; const size_t t0 = (size_t)b * SEQ + (size_t)c * 128;
            if (ci + 1 < 32) SSD_ISSUE(ci + 1);
            const LAS float* csb = (const LAS float*)(L + CSB + buf * 1536);
            const float cs_l = csb[16 * w + i16];
            const float cs_end = *(const LAS float*)(L + CSB + 3072 + 8 * buf);
            bf16x8 cfrag[4];
#pragma unroll
            for (int ks = 0; ks < 4; ++ks) cfrag[ks] = *(const LAS bf16x8*)(L + CN + (16 * w + i16) * RS + ks * 64 + g * 16);
            u32x2 mreg[8];
            const int lrow = 16 * w + i16;
            bf16x8 afb[2][4]; f32x4 csv[2], dtv[2];
#define SSD_LD1(st_, bb_) do { _Pragma("unroll") for (int ks = 0; ks < 4; ++ks) afb[bb_][ks] = *(const LAS bf16x8*)(L + BN + (16 * (st_) + i16) * RS + ks * 64 + g * 16); \
                csv[bb_] = *(const LAS f32x4*)(csb + 16 * (st_) + 4 * g); dtv[bb_] = *(const LAS f32x4*)(csb + 128 + 16 * (st_) + 4 * g); } while (0)
            SSD_LD1(0, 0);
#pragma unroll
            for (int st = 0; st < 8; ++st) {
                if (st < 7) SSD_LD1(st + 1, (st + 1) & 1);
                asm volatile("" ::: "memory");
                f32x4 acc = (f32x4){0.f, 0.f, 0.f, 0.f};
#pragma unroll
                for (int ks = 0; ks < 4; ++ks) acc = __builtin_amdgcn_mfma_f32_16x16x32_bf16(afb[st & 1][ks], cfrag[ks], acc, 0, 0, 0);
                const f32x4 cs_s = csv[st & 1], dt_s = dtv[st & 1];
                float mv[4];
#pragma unroll
                for (int r = 0; r < 4; ++r) { const int srow = 16 * st + 4 * g + r; const bool valid = dir ? (srow >= lrow) : (srow <= lrow);
                    const float e = valid ? __expf(cs_l - cs_s[r]) : 0.f; mv[r] = acc[r] * dt_s[r] * e; }
                mreg[st].x = pkbf(mv[0], mv[1]); mreg[st].y = pkbf(mv[2], mv[3]);
            }
#undef SSD_LD1
            f32x4 yacc[4];
            const float el = __expf(cs_l);
#pragma unroll
            for (int ph = 0; ph < 2; ++ph) { bf16x8 sf[2][4];
#pragma unroll
                for (int pi = 0; pi < 2; ++pi)
#pragma unroll
                    for (int ks = 0; ks < 4; ++ks) sf[pi][ks] = *(const LAS bf16x8*)(L + SL + buf * SLB + (16 * (2 * ph + pi) + i16) * RS + ks * 64 + g * 16);
                asm volatile("" ::: "memory");
#pragma unroll
                for (int pi = 0; pi < 2; ++pi) { f32x4 acc = (f32x4){0.f, 0.f, 0.f, 0.f};
#pragma unroll
                    for (int ks = 0; ks < 4; ++ks) acc = __builtin_amdgcn_mfma_f32_16x16x32_bf16(sf[pi][ks], cfrag[ks], acc, 0, 0, 0);
                    yacc[2 * ph + pi] = acc * el; } }
            bf16x8 xfa[4][4], bfa[4];
#pragma unroll
            for (int ks = 0; ks < 4; ++ks)
#pragma unroll
                for (int pt = 0; pt < 4; ++pt) xfa[ks][pt] = trfrag_p(L + XN, RSX, ks, pt, g, q, pp);
#pragma unroll
            for (int ks = 0; ks < 4; ++ks) bfa[ks] = trfrag_p(L + BS, RS, ks, w, g, q, pp);
            asm volatile("" ::: "memory");
#pragma unroll
            for (int ks = 0; ks < 4; ++ks) { u32x4 mw; mw.x = mreg[2 * ks].x; mw.y = mreg[2 * ks].y; mw.z = mreg[2 * ks + 1].x; mw.w = mreg[2 * ks + 1].y;
                const bf16x8 mf = __builtin_bit_cast(bf16x8, mw);
#pragma unroll
                for (int pt = 0; pt < 4; ++pt) yacc[pt] = __builtin_amdgcn_mfma_f32_16x16x32_bf16(xfa[ks][pt], mf, yacc[pt], 0, 0, 0); }
            u32x2 xvv[4];
#pragma unroll
            for (int pt = 0; pt < 4; ++pt) xvv[pt] = *(const LAS u32x2*)(L + XN + lrow * RSX + (16 * pt + 4 * g) * 2);
            asm volatile("" ::: "memory");
#pragma unroll
            for (int pt = 0; pt < 4; ++pt) { const u32x2 xv = xvv[pt];
                u32x2 o; o.x = pkbf(yacc[pt][0] + dsk * bflo(xv.x), yacc[pt][1] + dsk * bfhi(xv.x)); o.y = pkbf(yacc[pt][2] + dsk * bflo(xv.y), yacc[pt][3] + dsk * bfhi(xv.y));
                *(u32x2*)(yout + (t0 + lrow) * 1024 + hd * 64 + 16 * pt + 4 * g) = o; }
            { const float dec = __expf(cs_end);
#pragma unroll
              for (int pt = 0; pt < 4; ++pt) sacc[pt] = sacc[pt] * dec; }
#pragma unroll
            for (int ks = 0; ks < 4; ++ks)
#pragma unroll
                for (int pt = 0; pt < 4; ++pt) sacc[pt] = __builtin_amdgcn_mfma_f32_16x16x32_bf16(bfa[ks], xfa[ks][pt], sacc[pt], 0, 0, 0);
#pragma unroll
            for (int pt = 0; pt < 4; ++pt) { u32x2 o; o.x = pkbf(sacc[pt][0], sacc[pt][1]); o.y = pkbf(sacc[pt][2], sacc[pt][3]);
                *(LAS u32x2*)(L + SL + (buf ^ 1) * SLB + (16 * pt + i16) * RS + (16 * w + 4 * g) * 2) = o; }
            if (ci + 1 < 32) SSD_SCAN(buf ^ 1);
            __syncthreads();
            if (ci + 1 < 32) SSD_WRITE(buf ^ 1);
            __syncthreads();
        }
#undef SSD_ISSUE
#undef SSD_SCAN
#undef SSD_WRITE
    }
}

namespace nat {
typedef short bf16x8 __attribute__((ext_vector_type(8)));
typedef short s16x4 __attribute__((ext_vector_type(4)));
constexpr int VH = 65536, RPB = 131072;
__device__ __forceinline__ int voff(int ks, int d) { return ks * 128 + ((((d >> 3) ^ (ks & 7))) << 4) + (d & 7) * 2; }
__device__ __forceinline__ int clampi(int x, int lo, int hi) { return x < lo ? lo : (x > hi ? hi : x); }
}
__device__ __forceinline__ void p_na(const Ctx& C, bf16_t* q, const bf16_t* k, const bf16_t* v) {
    using namespace nat;
    LAS unsigned char* L = C.lds;
    const float* rpb = C.in[15];
    const int tid = C.tid, lane = C.lane, w = C.wave, g = lane >> 4, i16 = lane & 15, qq = (lane >> 2) & 3, pp = lane & 3;
    const int hl = w >> 2, m = w & 3;
    const int bs = (m == 0) ? 0 : (m == 1) ? 8 : (m == 2) ? 24 : 32;
    const int qc = 16 * m + i16, wsx = clampi(qc - 8, 0, 48);
    float madd[8]; int dcol[8];
#pragma unroll
    for (int c = 0; c < 8; ++c) { const int kc = bs + (c >> 2) * 16 + 4 * g + (c & 3); madd[c] = (kc >= wsx && kc < wsx + 16) ? 0.f : -1.0e30f; dcol[c] = clampi(kc - qc + 15, 0, 30); }
    for (int unit = C.bid; unit < 256; unit += C.G) {
        const int rseg = unit & 3, hp = (unit >> 2) & 7, b = unit >> 5, h = 2 * hp + hl;
        __syncthreads();
        for (int i = tid; i < 930; i += NTHR) ((LAS float*)(L + RPB))[i] = rpb[(2 * hp) * 465 + i];
#define NA_LOAD_ROW(row_) do { _Pragma("unroll") for (int i_ = 0; i_ < 2; ++i_) { const int idx_ = tid + NTHR * i_, hl_ = idx_ >> 9, col_ = (idx_ >> 3) & 63, dch_ = idx_ & 7; \
            const u32x4 val_ = *(const u32x4*)(v + ((size_t)b * SEQ + (size_t)(row_) * 64 + col_) * 1024 + (2 * hp + hl_) * 64 + dch_ * 8); \
            *(LAS u32x4*)(L + hl_ * VH + voff(((row_) & 7) * 64 + col_, dch_ * 8)) = val_; } } while (0)
#define NA_FETCH_ROW(row_) do { _Pragma("unroll") for (int i_ = 0; i_ < 2; ++i_) { const int idx_ = tid + NTHR * i_, hl_ = idx_ >> 9, col_ = (idx_ >> 3) & 63, dch_ = idx_ & 7; \
            vpre[i_] = *(const u32x4*)(v + ((size_t)b * SEQ + (size_t)(row_) * 64 + col_) * 1024 + (2 * hp + hl_) * 64 + dch_ * 8); } } while (0)
#define NA_STORE_ROW(row_) do { _Pragma("unroll") for (int i_ = 0; i_ < 2; ++i_) { const int idx_ = tid + NTHR * i_, hl_ = idx_ >> 9, col_ = (idx_ >> 3) & 63, dch_ = idx_ & 7; \
            *(LAS u32x4*)(L + hl_ * VH + voff(((row_) & 7) * 64 + col_, dch_ * 8)) = vpre[i_]; } } while (0)
        u32x4 vpre[2] = {(u32x4){0u, 0u, 0u, 0u}, (u32x4){0u, 0u, 0u, 0u}};
        const int r0 = 16 * rseg; int rs_prev = clampi(r0 - 4, 0, 56);
        for (int rr = 0; rr < 8; ++rr) NA_LOAD_ROW(rs_prev + rr);
        __syncthreads();
        const LAS float* rpbl = (const LAS float*)(L + RPB) + hl * 465;
        f32x4 bm[16]; int boff = -100;
        for (int s = 0; s < 16; ++s) {
            const int r = r0 + s, rs = clampi(r - 4, 0, 56);
            if (rs != rs_prev) { __syncthreads(); NA_STORE_ROW(rs + 7); __syncthreads(); rs_prev = rs; }
            { const int rsn = clampi(r - 3, 0, 56); if (s + 1 < 16 && rsn != rs) NA_FETCH_ROW(rsn + 7); }
            const size_t tokq = (size_t)b * SEQ + (size_t)r * 64 + qc;
            bf16x8 qf[2];
#pragma unroll
            for (int ks = 0; ks < 2; ++ks) qf[ks] = *(const bf16x8*)(q + tokq * 1024 + h * 64 + ks * 32 + g * 8);
            f32x4 sc[16];
#pragma unroll
            for (int kt = 0; kt < 16; ++kt) { const size_t tokk = (size_t)b * SEQ + (size_t)(rs + (kt >> 1)) * 64 + bs + (kt & 1) * 16 + i16;
                f32x4 acc = (f32x4){0.f, 0.f, 0.f, 0.f};
#pragma unroll
                for (int ks = 0; ks < 2; ++ks) { const bf16x8 kf = *(const bf16x8*)(k + tokk * 1024 + h * 64 + ks * 32 + g * 8); acc = __builtin_amdgcn_mfma_f32_16x16x32_bf16(kf, qf[ks], acc, 0, 0, 0); }
                sc[kt] = acc; }
            if (rs - r != boff) {
                boff = rs - r;
#pragma unroll
                for (int kt = 0; kt < 16; ++kt) { const int drow = boff + (kt >> 1) + 7;
#pragma unroll
                    for (int e = 0; e < 4; ++e) { const int c = (kt & 1) * 4 + e; bm[kt][e] = rpbl[drow * 31 + dcol[c]] + madd[c]; } } }
            float mx = -1.0e30f;
#pragma unroll
            for (int kt = 0; kt < 16; ++kt)
#pragma unroll
                for (int e = 0; e < 4; ++e) { const float val = sc[kt][e] + bm[kt][e]; sc[kt][e] = val; mx = fmaxf(mx, val); }
            mx = fmaxf(mx, __shfl_xor(mx, 16)); mx = fmaxf(mx, __shfl_xor(mx, 32));
            float sum = 0.f;
#pragma unroll
            for (int kt = 0; kt < 16; ++kt)
#pragma unroll
                for (int e = 0; e < 4; ++e) { const float p = __expf(sc[kt][e] - mx); sc[kt][e] = p; sum += p; }
            sum += __shfl_xor(sum, 16); sum += __shfl_xor(sum, 32);
            f32x4 o[4];
#pragma unroll
            for (int dt = 0; dt < 4; ++dt) o[dt] = (f32x4){0.f, 0.f, 0.f, 0.f};
#pragma unroll
            for (int kk = 0; kk < 8; ++kk) {
                u32x4 pw; pw.x = pk2(sc[2 * kk][0], sc[2 * kk][1]); pw.y = pk2(sc[2 * kk][2], sc[2 * kk][3]); pw.z = pk2(sc[2 * kk + 1][0], sc[2 * kk + 1][1]); pw.w = pk2(sc[2 * kk + 1][2], sc[2 * kk + 1][3]);
                const bf16x8 pf = __builtin_bit_cast(bf16x8, pw);
                const int ks0 = ((rs + kk) & 7) * 64 + bs + 4 * g + qq, ks1 = ks0 + 16;
#pragma unroll
                for (int dt = 0; dt < 4; ++dt) {
                    const s16x4 v0 = __builtin_amdgcn_ds_read_tr16_b64_v4i16((LAS s16x4*)(L + hl * VH + voff(ks0, 16 * dt + 4 * pp)));
                    const s16x4 v1 = __builtin_amdgcn_ds_read_tr16_b64_v4i16((LAS s16x4*)(L + hl * VH + voff(ks1, 16 * dt + 4 * pp)));
                    bf16x8 vf; vf[0] = v0[0]; vf[1] = v0[1]; vf[2] = v0[2]; vf[3] = v0[3]; vf[4] = v1[0]; vf[5] = v1[1]; vf[6] = v1[2]; vf[7] = v1[3];
                    o[dt] = __builtin_amdgcn_mfma_f32_16x16x32_bf16(vf, pf, o[dt], 0, 0, 0); }
            }
            const float inv = 1.f / sum;
#pragma unroll
            for (int dt = 0; dt < 4; ++dt) { u32x2 ov; ov.x = pk2(o[dt][0] * inv, o[dt][1] * inv); ov.y = pk2(o[dt][2] * inv, o[dt][3] * inv);
                *(u32x2*)(q + tokq * 1024 + h * 64 + 16 * dt + 4 * g) = ov; }
        }
#undef NA_LOAD_ROW
#undef NA_FETCH_ROW
#undef NA_STORE_ROW
    }
    __syncthreads();
}

__device__ __forceinline__ void p_combine(const Ctx& C, const bf16_t* yf, const bf16_t* yb, bf16_t* szu, float* rstd) {
    const int gw = C.bid * NWAVES + C.wave, NGW = C.G * NWAVES;
    for (int row0 = gw * 2; row0 < T; row0 += NGW * 2) {
        u32x4 a[2][2], b[2][2], z[2][2];
#pragma unroll
        for (int r = 0; r < 2; ++r)
#pragma unroll
            for (int j = 0; j < 2; ++j) { const size_t off = (size_t)(row0 + r) * 1024 + j * 512 + C.lane * 8;
                a[r][j] = *(const u32x4*)(yf + off); b[r][j] = *(const u32x4*)(yb + off); z[r][j] = *(const u32x4*)(szu + off); }
#pragma unroll
        for (int r = 0; r < 2; ++r) { float s = 0.f; u32x4 outv[2];
#pragma unroll
            for (int j = 0; j < 2; ++j) { const u32x4 av = a[r][j], bv = b[r][j], zv = z[r][j]; float u[8];
                u[0] = (bflo(av.x) + bflo(bv.x)) * bflo(zv.x); u[1] = (bfhi(av.x) + bfhi(bv.x)) * bfhi(zv.x);
                u[2] = (bflo(av.y) + bflo(bv.y)) * bflo(zv.y); u[3] = (bfhi(av.y) + bfhi(bv.y)) * bfhi(zv.y);
                u[4] = (bflo(av.z) + bflo(bv.z)) * bflo(zv.z); u[5] = (bfhi(av.z) + bfhi(bv.z)) * bfhi(zv.z);
                u[6] = (bflo(av.w) + bflo(bv.w)) * bflo(zv.w); u[7] = (bfhi(av.w) + bfhi(bv.w)) * bfhi(zv.w);
#pragma unroll
                for (int q = 0; q < 8; ++q) s += u[q] * u[q];
                outv[j].x = pk2(u[0], u[1]); outv[j].y = pk2(u[2], u[3]); outv[j].z = pk2(u[4], u[5]); outv[j].w = pk2(u[6], u[7]); }
            s = wave_sum(s);
#pragma unroll
            for (int j = 0; j < 2; ++j) *(u32x4*)(szu + (size_t)(row0 + r) * 1024 + j * 512 + C.lane * 8) = outv[j];
            if (C.lane == 0) rstd[row0 + r] = rsqrtf(s * (1.f / 1024.f) + EPS); }
    }
}

__device__ __forceinline__ void p_cvt_tables8(const Ctx& C, unsigned char* u8, unsigned char* v8) {
    const int gt = C.bid * NTHR + C.tid, NT = C.G * NTHR;
    const float* u = C.in[21]; const float* v = C.in[22];
    constexpr int N4 = 16384 * 1024 / 4;
    for (int i0 = gt; i0 < N4; i0 += 4 * NT) {
        f32x4 a[4], b[4];
#pragma unroll
        for (int r = 0; r < 4; ++r) { const int i = i0 + r * NT; if (i < N4) { a[r] = *(const f32x4*)(u + (size_t)i * 4); b[r] = *(const f32x4*)(v + (size_t)i * 4); } }
#pragma unroll
        for (int r = 0; r < 4; ++r) { const int i = i0 + r * NT; if (i < N4) {
            const f32x4 av = a[r] * 256.f, bv = b[r] * 64.f; unsigned x = 0u, y = 0u;
            x = __builtin_amdgcn_cvt_pk_fp8_f32(av.x, av.y, x, false); x = __builtin_amdgcn_cvt_pk_fp8_f32(av.z, av.w, x, true);
            y = __builtin_amdgcn_cvt_pk_fp8_f32(bv.x, bv.y, y, false); y = __builtin_amdgcn_cvt_pk_fp8_f32(bv.z, bv.w, y, true);
            *(unsigned*)(u8 + (size_t)i * 4) = x; *(unsigned*)(v8 + (size_t)i * 4) = y; } }
    }
}

template <int CTRL> __device__ __forceinline__ float dppf(float x) { return __int_as_float(__builtin_amdgcn_update_dpp(0, __float_as_int(x), CTRL, 0xF, 0xF, false)); }
constexpr int DPP_HMIRROR = 0x141, DPP_XOR2 = 0x4E, DPP_XOR1 = 0xB1, DPP_ROR8 = 0x128;
__device__ __forceinline__ int idx16(const u32x4& a, const u32x4& b, int i) { const unsigned w = (i < 8 ? a : b)[(i & 7) >> 1]; return (int)((i & 1) ? (w >> 16) : (w & 0xffffu)); }
__device__ __forceinline__ int gslot(int R) { return 16 * (R & 7) + (R >> 3); }
#define GQ_DMA(tab_, qi_, mi_) do { const u32x2 iw_ = *(const LAS u32x2*)(meta + (mi_) * MSTRIDE + 32 * (lane >> 3) + 8 * (qi_)); \
        _Pragma("unroll") for (int k_ = 0; k_ < 4; ++k_) { const int kk_ = 4 * (qi_) + k_, R_ = 8 * kk_ + (lane >> 3); \
            const unsigned e_ = (k_ & 1) ? ((k_ < 2 ? iw_.x : iw_.y) >> 16) : ((k_ < 2 ? iw_.x : iw_.y) & 0xffffu); \
            const unsigned char* src_ = (tab_) + (size_t)e_ * 1024 + 128 * j + 16 * ((lane & 7) ^ ((R_ >> 1) & 7)); \
            __builtin_amdgcn_global_load_lds((const unsigned*)src_, (LAS unsigned*)(img + kk_ * 1024), 16, 0, 0); } } while (0)
#define GQ_WAIT(n_) asm volatile("s_waitcnt vmcnt(" #n_ ")" ::: "memory")
#define GQ_LWAIT() asm volatile("s_waitcnt lgkmcnt(0)" ::: "memory")
__device__ __forceinline__ void p_gu(const Ctx& C, const bf16_t* n2, const unsigned short* pidx, const unsigned char* u8, float* pd) {
    const int j = C.bid & 7, nsl = C.G >> 3, NW = nsl * NWAVES, wsl = (C.bid >> 3) * NWAVES + C.wave, lane = C.lane, i16 = lane & 15, g = lane >> 4;
    if ((C.bid >> 3) >= nsl) return;
    constexpr int MSTRIDE = 512;
    LAS unsigned char* img = C.lds + 16384 + C.wave * 16384;
    LAS unsigned char* meta = C.lds + 4096 + C.wave * (3 * MSTRIDE);
    LAS unsigned char* xq = C.lds + C.wave * 256;
#define GU_META(t_, mi_) do { const int tt_ = (t_) < T ? (t_) : wsl; \
        __builtin_amdgcn_global_load_lds((const unsigned*)((const unsigned char*)(pidx + (size_t)tt_ * 128) + 4 * lane), (LAS unsigned*)(meta + (mi_) * MSTRIDE), 4, 0, 0); \
        __builtin_amdgcn_global_load_lds((const unsigned*)((const unsigned char*)(n2 + (size_t)tt_ * 1024 + 128 * j) + 4 * lane), (LAS unsigned*)(meta + (mi_) * MSTRIDE + 256), 4, 0, 0); } while (0)
    GU_META(wsl, 0); GU_META(wsl + NW, 1);
    GQ_WAIT(0);
    GQ_DMA(u8, 0, 0); GQ_DMA(u8, 1, 0); GQ_DMA(u8, 2, 0); GQ_DMA(u8, 3, 0);
    GQ_WAIT(0);
    int mi = 0;
    for (int t = wsl; t < T; t += NW) {
        const int mi1 = mi == 2 ? 0 : mi + 1, mi2 = mi1 == 2 ? 0 : mi1 + 1;
        GU_META(t + 2 * NW, mi2);
        { const unsigned xcur = *(const LAS unsigned*)(meta + mi * MSTRIDE + 256 + 4 * lane);
          const float x0 = bflo(xcur) * 16.f, x1 = bfhi(xcur) * 16.f;
          const unsigned hw = __builtin_amdgcn_cvt_pk_fp8_f32(x0, x1, 0u, false);
          const f32x2_t h01 = __builtin_amdgcn_cvt_pk_f32_fp8(hw, false);
          const unsigned lw = __builtin_amdgcn_cvt_pk_fp8_f32((x0 - h01.x) * 16.f, (x1 - h01.y) * 16.f, 0u, false);
          *(LAS unsigned short*)(xq + 2 * lane) = (unsigned short)(hw & 0xffffu); *(LAS unsigned short*)(xq + 128 + 2 * lane) = (unsigned short)(lw & 0xffffu); }
        GQ_LWAIT();
        long bq[4];
#pragma unroll
        for (int ks = 0; ks < 4; ++ks) bq[ks] = *(const LAS long*)(xq + (i16 & 1) * 128 + 32 * ks + 8 * g);
        f32x4 o[8];
#pragma unroll
        for (int qi = 0; qi < 4; ++qi) {
            GQ_WAIT(18);
#pragma unroll
            for (int tl = 2 * qi; tl < 2 * qi + 2; ++tl) { const int R = 16 * tl + i16; f32x4 acc = (f32x4){0.f, 0.f, 0.f, 0.f};
#pragma unroll
                for (int ks = 0; ks < 4; ++ks) { const int sc = 2 * ks + (g >> 1);
                    const long av = *(const LAS long*)(img + R * 128 + ((sc ^ ((R >> 1) & 7)) << 4) + 8 * (g & 1));
                    acc = __builtin_amdgcn_mfma_f32_16x16x32_fp8_fp8(av, bq[ks], acc, 0, 0, 0); }
#pragma unroll
                for (int r = 0; r < 4; ++r) o[tl][r] = (acc[r] + dppf<DPP_XOR1>(acc[r]) * 0.0625f) * (1.f / 4096.f); }
            GQ_LWAIT();
            GQ_DMA(u8, qi, mi1);
        }
#pragma unroll
        for (int k4 = 0; k4 < 4; ++k4) { if (i16 == 0) { u32x4 w; w.x = pk2(o[2 * k4][0], o[2 * k4][1]); w.y = pk2(o[2 * k4][2], o[2 * k4][3]); w.z = pk2(o[2 * k4 + 1][0], o[2 * k4 + 1][1]); w.w = pk2(o[2 * k4 + 1][2], o[2 * k4 + 1][3]);
            *(u32x4*)((bf16_t*)pd + ((size_t)j * T + t) * 128 + 32 * g + 8 * k4) = w; } }
        mi = mi1;
    }
    GQ_WAIT(0);
#undef GU_META
}
__device__ __forceinline__ void p_gc(const Ctx& C, const float* pd, const float* pgate, float* cc) {
    const int gt = C.bid * NTHR + C.tid, NT = C.G * NTHR; const bf16_t* pb = (const bf16_t*)pd;
    for (int i = gt; i < T * 32; i += NT) {
        f32x4 sdot = (f32x4){0.f, 0.f, 0.f, 0.f};
#pragma unroll
        for (int j = 0; j < 8; ++j) { const u32x2 w = *(const u32x2*)(pb + (size_t)j * T * 128 + (size_t)i * 4); sdot.x += bflo(w.x); sdot.y += bfhi(w.x); sdot.z += bflo(w.y); sdot.w += bfhi(w.y); }
        const int t_ = i >> 5, q = i & 31, R0 = 16 * (q & 7) + 4 * (q >> 3); const float* gp = pgate + (size_t)t_ * 128;
        f32x4 gv; gv.x = gp[gslot(R0)]; gv.y = gp[gslot(R0 + 1)]; gv.z = gp[gslot(R0 + 2)]; gv.w = gp[gslot(R0 + 3)];
        f32x4 o; o.x = gelu_f(sdot.x) * gv.x; o.y = gelu_f(sdot.y) * gv.y; o.z = gelu_f(sdot.z) * gv.z; o.w = gelu_f(sdot.w) * gv.w;
        *(f32x4*)(cc + (size_t)t_ * 128 + R0) = o; }
}
__device__ __forceinline__ void p_gv(const Ctx& C, const float* cc, const unsigned short* pidx, const unsigned char* v8, bf16_t* op) {
    typedef int i32x2 __attribute__((ext_vector_type(2)));
    const int j = C.bid & 7, nsl = C.G >> 3, NW = nsl * NWAVES, wsl = (C.bid >> 3) * NWAVES + C.wave, lane = C.lane, i16 = lane & 15, g = lane >> 4;
    if ((C.bid >> 3) >= nsl) return;
    constexpr int MSTRIDE = 768;
    LAS unsigned char* img = C.lds + 24576 + C.wave * 16384;
    LAS unsigned char* meta = C.lds + 4096 + C.wave * (3 * MSTRIDE);
    LAS unsigned char* cq = C.lds + C.wave * 256;
    const int tr_r = i16 >> 1, tr_c = i16 & 1;
    unsigned toff[8];
#pragma unroll
    for (int ct = 0; ct < 8; ++ct) toff[ct] = (unsigned)((ct ^ ((4 * g + (tr_r >> 1)) & 7)) << 4);
#define GV_META(t_, mi_) do { const int tt_ = (t_) < T ? (t_) : wsl; \
        __builtin_amdgcn_global_load_lds((const unsigned*)((const unsigned char*)(pidx + (size_t)tt_ * 128) + 4 * lane), (LAS unsigned*)(meta + (mi_) * MSTRIDE), 4, 0, 0); \
        __builtin_amdgcn_global_load_lds((const unsigned*)(cc + (size_t)tt_ * 128 + lane), (LAS unsigned*)(meta + (mi_) * MSTRIDE + 256), 4, 0, 0); \
        __builtin_amdgcn_global_load_lds((const unsigned*)(cc + (size_t)tt_ * 128 + 64 + lane), (LAS unsigned*)(meta + (mi_) * MSTRIDE + 512), 4, 0, 0); } while (0)
    GV_META(wsl, 0); GV_META(wsl + NW, 1);
    GQ_WAIT(0);
    GQ_DMA(v8, 0, 0); GQ_DMA(v8, 1, 0); GQ_DMA(v8, 2, 0); GQ_DMA(v8, 3, 0);
    GQ_WAIT(0);
    int mi = 0;
    for (int t = wsl; t < T; t += NW) {
        const int mi1 = mi == 2 ? 0 : mi + 1, mi2 = mi1 == 2 ? 0 : mi1 + 1;
        GV_META(t + 2 * NW, mi2);
        { const f32x2_t ccur = *(const LAS f32x2_t*)(meta + mi * MSTRIDE + 256 + 8 * lane);
          const float c0 = __builtin_fminf(__builtin_fmaxf(ccur.x * 64.f, -440.f), 440.f), c1 = __builtin_fminf(__builtin_fmaxf(ccur.y * 64.f, -440.f), 440.f);
          const unsigned hw = __builtin_amdgcn_cvt_pk_fp8_f32(c0, c1, 0u, false);
          const f32x2_t h01 = __builtin_amdgcn_cvt_pk_f32_fp8(hw, false);
          const unsigned lw = __builtin_amdgcn_cvt_pk_fp8_f32((c0 - h01.x) * 16.f, (c1 - h01.y) * 16.f, 0u, false);
          *(LAS unsigned short*)(cq + 2 * lane) = (unsigned short)(hw & 0xffffu); *(LAS unsigned short*)(cq + 128 + 2 * lane) = (unsigned short)(lw & 0xffffu); }
        GQ_LWAIT();
        long aq[4];
#pragma unroll
        for (int ks = 0; ks < 4; ++ks) aq[ks] = *(const LAS long*)(cq + (i16 & 1) * 128 + 32 * ks + 8 * g);
        f32x4 acc[8];
#pragma unroll
        for (int ct = 0; ct < 8; ++ct) acc[ct] = (f32x4){0.f, 0.f, 0.f, 0.f};
#pragma unroll
        for (int ks = 0; ks < 4; ++ks) {
            GQ_WAIT(23);
            const unsigned rb = (unsigned)(size_t)(img + (32 * ks + 8 * g + tr_r) * 128 + 8 * tr_c);
            long b0, b1, b2, b3, b4, b5, b6, b7;
            asm volatile("ds_read_b64_tr_b8 %0, %8\n\tds_read_b64_tr_b8 %1, %9\n\tds_read_b64_tr_b8 %2, %10\n\tds_read_b64_tr_b8 %3, %11\n\t"
                         "ds_read_b64_tr_b8 %4, %12\n\tds_read_b64_tr_b8 %5, %13\n\tds_read_b64_tr_b8 %6, %14\n\tds_read_b64_tr_b8 %7, %15\n\ts_waitcnt lgkmcnt(0)"
                         : "=&v"(b0), "=&v"(b1), "=&v"(b2), "=&v"(b3), "=&v"(b4), "=&v"(b5), "=&v"(b6), "=&v"(b7)
                         : "v"(rb + toff[0]), "v"(rb + toff[1]), "v"(rb + toff[2]), "v"(rb + toff[3]), "v"(rb + toff[4]), "v"(rb + toff[5]), "v"(rb + toff[6]), "v"(rb + toff[7]) : "memory");
            acc[0] = __builtin_amdgcn_mfma_f32_16x16x32_fp8_fp8(aq[ks], b0, acc[0], 0, 0, 0); acc[1] = __builtin_amdgcn_mfma_f32_16x16x32_fp8_fp8(aq[ks], b1, acc[1], 0, 0, 0);
            acc[2] = __builtin_amdgcn_mfma_f32_16x16x32_fp8_fp8(aq[ks], b2, acc[2], 0, 0, 0); acc[3] = __builtin_amdgcn_mfma_f32_16x16x32_fp8_fp8(aq[ks], b3, acc[3], 0, 0, 0);
            acc[4] = __builtin_amdgcn_mfma_f32_16x16x32_fp8_fp8(aq[ks], b4, acc[4], 0, 0, 0); acc[5] = __builtin_amdgcn_mfma_f32_16x16x32_fp8_fp8(aq[ks], b5, acc[5], 0, 0, 0);
            acc[6] = __builtin_amdgcn_mfma_f32_16x16x32_fp8_fp8(aq[ks], b6, acc[6], 0, 0, 0); acc[7] = __builtin_amdgcn_mfma_f32_16x16x32_fp8_fp8(aq[ks], b7, acc[7], 0, 0, 0);
            GQ_DMA(v8, ks, mi1);
        }
#pragma unroll
        for (int ct = 0; ct < 8; ++ct) { if (g == 0) op[(size_t)t * 1024 + 128 * j + 16 * ct + i16] = (bf16_t)f2bf((acc[ct][0] + acc[ct][1] * 0.0625f) * (1.f / 4096.f)); }
        mi = mi1;
    }
    GQ_WAIT(0);
#undef GV_META
}
__device__ __forceinline__ void p_gf(const Ctx& C, const bf16_t* h, const bf16_t* op, float* out) {
    const float* mod = C.f32p(WS_MOD); const float* fg = C.in[23];
    const int gw = C.bid * NWAVES + C.wave, NGW = C.G * NWAVES, lane = C.lane;
    for (int t0 = gw * 2; t0 < T; t0 += NGW * 2) {
        const int b = t0 / SEQ;
        u32x2 ov[2][4], hw[2][4];
#pragma unroll
        for (int r = 0; r < 2; ++r)
#pragma unroll
            for (int d = 0; d < 4; ++d) { const size_t off = (size_t)(t0 + r) * 1024 + 256 * d + 4 * lane; ov[r][d] = *(const u32x2*)(op + off); hw[r][d] = *(const u32x2*)(h + off); }
        f32x4 mv[4], fv[4];
#pragma unroll
        for (int d = 0; d < 4; ++d) { mv[d] = *(const f32x4*)(mod + b * 6144 + 5120 + 256 * d + 4 * lane); fv[d] = *(const f32x4*)(fg + 256 * d + 4 * lane); }
#pragma unroll
        for (int r = 0; r < 2; ++r) { f32x4 hf[4]; float ss = 0.f;
#pragma unroll
            for (int d = 0; d < 4; ++d) { f32x4 hv, o4; hv.x = bflo(hw[r][d].x); hv.y = bfhi(hw[r][d].x); hv.z = bflo(hw[r][d].y); hv.w = bfhi(hw[r][d].y);
                o4.x = bflo(ov[r][d].x); o4.y = bfhi(ov[r][d].x); o4.z = bflo(ov[r][d].y); o4.w = bfhi(ov[r][d].y);
                hf[d] = hv + mv[d] * o4; ss += (hf[d].x * hf[d].x + hf[d].y * hf[d].y) + (hf[d].z * hf[d].z + hf[d].w * hf[d].w); }
            const float rstd = rsqrtf(wave_sum(ss) * (1.f / 1024.f) + EPS);
#pragma unroll
            for (int d = 0; d < 4; ++d) { const f32x4 ov_ = hf[d] * rstd * fv[d]; st_wt16(out + (size_t)(t0 + r) * 1024 + 256 * d + 4 * lane, __builtin_bit_cast(u32x4, ov_)); } }
    }
}

namespace pg8 {
#define PG8_LAS __attribute__((address_space(3)))
typedef unsigned short bf16_t;
typedef short bf16x8 __attribute__((ext_vector_type(8)));
typedef float f32x4 __attribute__((ext_vector_type(4)));
typedef unsigned u32x4 __attribute__((ext_vector_type(4)));
constexpr int BM = 256, BK = 64, HALF = 128, HTB = HALF * BK * 2  , STAGE_BYTES = 8 * HTB, NXCD = 8, WGM = 8;

__host__ __device__ __forceinline__ int lds_byte(int r, int c) { const int st = (r >> 4) * 2 + (c >> 5), rr = r & 15, cc = c & 31, ob = rr * 64 + cc * 2; return st * 1024 + (ob ^ (((ob >> 9) & 1) << 5)); }
__host__ __device__ __forceinline__ void stage_rc(int b, int& R, int& C) { const int st = b / 1024, sb = b % 1024, swz = sb ^ (((sb >> 9) & 1) << 5); R = (st >> 1) * 16 + swz / 64; C = (st & 1) * 32 + (swz % 64) / 2; }
__host__ __device__ __forceinline__ int perm32(int rho) { const int n = rho >> 4, i = rho & 15; return 8 * (i >> 2) + 4 * n + (i & 3); }

struct Unit { int pm, pn, kind; };
struct Gemm { const bf16_t* A; const bf16_t* Bt; int M, N, K; const bf16_t *A1, *B1, *A2, *B2, *A3, *B3; };

struct StaticOrder {
    static constexpr bool MULTI = false;
    int nM, nN, nwg, G, c;
    __host__ __device__ void init(int M, int N, int G_, int c_) { nM = M / BM; nN = N / BM; nwg = nM * nN; G = G_; c = c_; }
    __host__ __device__ bool next(int i, Unit& u) const {
        const long L = (long)i * G + c; if (L >= nwg) return false;
        int wgid = (int)L; { const int q = nwg / NXCD, r = nwg % NXCD, xcd = wgid % NXCD, off = wgid / NXCD; wgid = (xcd < r ? xcd * (q + 1) : r * (q + 1) + (xcd - r) * q) + off; }
        const int nig = WGM * nN, gid = wgid / nig, fm = gid * WGM, gsz = (nM - fm) < WGM ? (nM - fm) : WGM;
        u.pm = fm + ((wgid % nig) % gsz); u.pn = (wgid % nig) / gsz; u.kind = 0; return true;
    }
    __device__ __forceinline__ void a_ready(const Unit&) const {}
    __device__ __forceinline__ void done(const Unit&) const {}
};

struct MultiOrder {
    static constexpr bool MULTI = true;
    StaticOrder b; int nk;
    __host__ __device__ bool next(int i, Unit& u) const { if (!b.next(i / nk, u)) return false; u.kind = i % nk; return true; }
    __device__ __forceinline__ void a_ready(const Unit&) const {}
    __device__ __forceinline__ void done(const Unit&) const {}
};

__device__ __forceinline__ unsigned cvt_pk_bf16(float lo, float hi) { return ::pk2(lo, hi); }
__device__ __forceinline__ float e_silu(float x) { return x / (1.f + __expf(-x)); }
__device__ __forceinline__ float e_sigm(float x) { return 1.f / (1.f + __expf(-x)); }
__device__ __forceinline__ float e_lo(unsigned v) { return __uint_as_float(v << 16); }
__device__ __forceinline__ float e_hi(unsigned v) { return __uint_as_float(v & 0xffff0000u); }
__device__ __forceinline__ u32x4 pack8(const f32x4 v0, const f32x4 v1) { u32x4 w; w.x = cvt_pk_bf16(v0[0], v0[1]); w.y = cvt_pk_bf16(v0[2], v0[3]); w.z = cvt_pk_bf16(v1[0], v1[1]); w.w = cvt_pk_bf16(v1[2], v1[3]); return w; }

struct EpiInProj {
    static constexpr bool PERM = true, AFTER_DRAIN = false;
    bf16_t *sz, *xbc, *q, *k, *v;
    __device__ __forceinline__ void locate(const Unit& u, bf16_t*& base, int& ldc, int& colt) const {
        const int pn = u.pn; const long dx = xbc - sz, dq = q - sz, dk = k - q;
        const int g3 = pn >= 12 ? ((pn - 12) >> 2) : 0;
        const long eoff = pn < 4 ? 0l : (pn < 12 ? dx : dq + (long)g3 * dk);
        base = sz + eoff; ldc = (pn >= 4 && pn < 12) ? 2048 : 1024;
        colt = pn < 4 ? pn * 256 : (pn < 12 ? (pn - 4) * 256 : ((pn - 12) & 3) * 256);
    }
    __device__ __forceinline__ void operator()(const f32x4 (&acc)[2][2][4][2], const Unit& u, int wr, int wc, int fr, int fq) const {
        const int pn = u.pn; bf16_t* base; int ldc = 1024, colt, mode = 0;
        if (pn < 4) { base = sz; colt = pn * 256; mode = 1; }
        else if (pn < 12) { base = xbc; ldc = 2048; colt = (pn - 4) * 256; }
        else if (pn < 16) { base = q; colt = (pn - 12) * 256; mode = 2; }
        else if (pn < 20) { base = k; colt = (pn - 16) * 256; }
        else { base = v; colt = (pn - 20) * 256; }
        const int row0 = u.pm * BM + wr * 64 + fr, col0 = colt + wc * 32 + 8 * fq;
#pragma unroll
        for (int ai = 0; ai < 2; ++ai)
#pragma unroll
            for (int m = 0; m < 4; ++m) { bf16_t* rowp = base + (size_t)(row0 + ai * HALF + m * 16) * ldc + col0;
#pragma unroll
                for (int bj = 0; bj < 2; ++bj) { f32x4 v0 = acc[ai][bj][m][0], v1 = acc[ai][bj][m][1];
                    if (mode == 1) {
#pragma unroll
                        for (int i = 0; i < 4; ++i) { v0[i] = e_silu(v0[i]); v1[i] = e_silu(v1[i]); } }
                    else if (mode == 2) { v0 = v0 * 0.125f; v1 = v1 * 0.125f; }
                    *(u32x4*)(rowp + bj * HALF) = pack8(v0, v1); } }
    }
};
__device__ __forceinline__ void ld8(u32x4 (&d)[8], unsigned lo, const char* b0, const char* b1, const char* b2, const char* b3, const char* b4, const char* b5, const char* b6, const char* b7) {
    asm volatile("s_nop 4\n\tglobal_load_dwordx4 %0, %8, %9\n\tglobal_load_dwordx4 %1, %8, %10\n\tglobal_load_dwordx4 %2, %8, %11\n\tglobal_load_dwordx4 %3, %8, %12\n\t"
                 "global_load_dwordx4 %4, %8, %13\n\tglobal_load_dwordx4 %5, %8, %14\n\tglobal_load_dwordx4 %6, %8, %15\n\tglobal_load_dwordx4 %7, %8, %16\n\ts_waitcnt vmcnt(0)"
                 : "=&v"(d[0]), "=&v"(d[1]), "=&v"(d[2]), "=&v"(d[3]), "=&v"(d[4]), "=&v"(d[5]), "=&v"(d[6]), "=&v"(d[7])
                 : "v"(lo), "s"(b0), "s"(b1), "s"(b2), "s"(b3), "s"(b4), "s"(b5), "s"(b6), "s"(b7) : "memory");
}
__device__ __forceinline__ void st16(char* base, unsigned lo, const u32x4 v) { asm volatile("s_nop 4\n\tglobal_store_dwordx4 %0, %1, %2\n\ts_nop 1" :: "v"(lo), "v"(v), "s"(base) : "memory"); }
struct EpiMix {
    static constexpr bool PERM = true, AFTER_DRAIN = false;
    bf16_t *sg1, *sg2, *mixed; const float* rstd;
    __device__ __forceinline__ bool operator()(f32x4 (&acc)[2][2][4][2], const Unit& u, int wr, int wc, int fr, int fq) const {
        const int kind = u.kind;
        const size_t tile0 = ((size_t)u.pm * BM * 1024 + (size_t)u.pn * BM) * 2;
        const unsigned lo = (unsigned)(((wr * 64 + fr) * 1024 + wc * 32 + 8 * fq) * 2);
        const unsigned lg = (unsigned)(((wr * 64 + fr) * 256 + wc * 32 + 8 * fq) * 2);
#define PIECE(ai_, m_, bj_) ((size_t)((((ai_) * HALF + (m_) * 16) * 1024 + (bj_) * HALF) * 2))
#define PIECEG(ai_, m_, bj_) ((size_t)((((ai_) * HALF + (m_) * 16) * 256 + (bj_) * HALF) * 2))
#define LD8(dst_, base_, ai_) ld8(dst_, lg, (base_) + PIECEG(ai_, 0, 0), (base_) + PIECEG(ai_, 0, 1), (base_) + PIECEG(ai_, 1, 0), (base_) + PIECEG(ai_, 1, 1), \
                                  (base_) + PIECEG(ai_, 2, 0), (base_) + PIECEG(ai_, 2, 1), (base_) + PIECEG(ai_, 3, 0), (base_) + PIECEG(ai_, 3, 1))
        const char* p1 = (const char*)sg1; const char* p2 = (const char*)sg2;
        char* dg = (char*)(kind == 0 ? sg1 : sg2); char* dm = (char*)mixed + tile0;
        float rs[2][4];
#pragma unroll
        for (int ai = 0; ai < 2; ++ai)
#pragma unroll
            for (int m = 0; m < 4; ++m) rs[ai][m] = 1.f;
        if (kind == 2) { const char* rb = (const char*)(rstd + u.pm * BM); const unsigned rl = (unsigned)((wr * 64 + fr) * 4);
            asm volatile("s_nop 4\n\tglobal_load_dword %0, %8, %9\n\tglobal_load_dword %1, %8, %10\n\tglobal_load_dword %2, %8, %11\n\tglobal_load_dword %3, %8, %12\n\t"
                         "global_load_dword %4, %8, %13\n\tglobal_load_dword %5, %8, %14\n\tglobal_load_dword %6, %8, %15\n\tglobal_load_dword %7, %8, %16\n\ts_waitcnt vmcnt(0)"
                         : "=&v"(rs[0][0]), "=&v"(rs[0][1]), "=&v"(rs[0][2]), "=&v"(rs[0][3]), "=&v"(rs[1][0]), "=&v"(rs[1][1]), "=&v"(rs[1][2]), "=&v"(rs[1][3])
                         : "v"(rl), "s"(rb), "s"(rb + 64), "s"(rb + 128), "s"(rb + 192), "s"(rb + 512), "s"(rb + 576), "s"(rb + 640), "s"(rb + 704) : "memory"); }
#pragma unroll
        for (int ai = 0; ai < 2; ++ai) {
            u32x4 ga[8], gb[8];
            if (kind == 2) { LD8(ga, p1, ai); LD8(gb, p2, ai); } else if (kind == 3) { LD8(gb, p2, ai); }
#pragma unroll
            for (int m = 0; m < 4; ++m) {
#pragma unroll
                for (int bj = 0; bj < 2; ++bj) { f32x4 v0 = acc[ai][bj][m][0], v1 = acc[ai][bj][m][1];
                    if (kind < 2) {
#pragma unroll
                        for (int i = 0; i < 4; ++i) { v0[i] = e_sigm(v0[i]); v1[i] = e_sigm(v1[i]); }
                        st16(dg + PIECEG(ai, m, bj), lg, pack8(v0, v1));
                    } else if (kind == 2) {
                        const u32x4 a = ga[2 * m + bj], b = gb[2 * m + bj]; const float r_ = rs[ai][m];
                        v0[0] *= r_ * e_lo(a.x) / fmaxf(e_lo(b.x), 1e-30f); v0[1] *= r_ * e_hi(a.x) / fmaxf(e_hi(b.x), 1e-30f); v0[2] *= r_ * e_lo(a.y) / fmaxf(e_lo(b.y), 1e-30f); v0[3] *= r_ * e_hi(a.y) / fmaxf(e_hi(b.y), 1e-30f);
                        v1[0] *= r_ * e_lo(a.z) / fmaxf(e_lo(b.z), 1e-30f); v1[1] *= r_ * e_hi(a.z) / fmaxf(e_hi(b.z), 1e-30f); v1[2] *= r_ * e_lo(a.w) / fmaxf(e_lo(b.w), 1e-30f); v1[3] *= r_ * e_hi(a.w) / fmaxf(e_hi(b.w), 1e-30f);
                        acc[ai][bj][m][0] = v0; acc[ai][bj][m][1] = v1;
                    } else {
                        const u32x4 b = gb[2 * m + bj];
                        v0[0] *= e_lo(b.x); v0[1] *= e_hi(b.x); v0[2] *= e_lo(b.y); v0[3] *= e_hi(b.y); v1[0] *= e_lo(b.z); v1[1] *= e_hi(b.z); v1[2] *= e_lo(b.w); v1[3] *= e_hi(b.w);
                        st16(dm + PIECE(ai, m, bj), lo, pack8(v0, v1));
                    } } }
        }
#undef LD8
#undef PIECE
#undef PIECEG
        return kind == 2;
    }
};
struct EpiD3 {
    static constexpr bool PERM = true, AFTER_DRAIN = false;
    bf16_t* h; const float* x; const float* mod;
    __device__ __forceinline__ void operator()(const f32x4 (&acc)[2][2][4][2], const Unit& u, int wr, int wc, int fr, int fq) const {
        const int row0 = u.pm * BM + wr * 64 + fr, col0 = u.pn * BM + wc * 32 + 8 * fq;
        const float* g1 = mod + (size_t)((u.pm * BM) >> 12) * 6144 + 2048;
#pragma unroll
        for (int ai = 0; ai < 2; ++ai)
#pragma unroll
            for (int m = 0; m < 4; ++m) { const size_t off = (size_t)(row0 + ai * HALF + m * 16) * 1024 + col0;
#pragma unroll
                for (int bj = 0; bj < 2; ++bj) { const int c = bj * HALF;
                    const f32x4 x0 = *(const f32x4*)(x + off + c), x1 = *(const f32x4*)(x + off + c + 4), g0 = *(const f32x4*)(g1 + col0 + c), g4 = *(const f32x4*)(g1 + col0 + c + 4);
                    *(u32x4*)(h + off + c) = pack8(x0 + g0 * acc[ai][bj][m][0], x1 + g4 * acc[ai][bj][m][1]); } }
    }
};
struct EpiQp {
    static constexpr bool PERM = true, AFTER_DRAIN = false;
    bf16_t* qp;
    __device__ __forceinline__ void operator()(const f32x4 (&acc)[2][2][4][2], const Unit& u, int wr, int wc, int fr, int fq) const {
        const int row0 = u.pm * BM + wr * 64 + fr, col0 = u.pn * BM + wc * 32 + 8 * fq;
#pragma unroll
        for (int ai = 0; ai < 2; ++ai)
#pragma unroll
            for (int m = 0; m < 4; ++m) { bf16_t* rowp = qp + (size_t)(row0 + ai * HALF + m * 16) * 2048 + col0;
#pragma unroll
                for (int bj = 0; bj < 2; ++bj) *(u32x4*)(rowp + bj * HALF) = pack8(acc[ai][bj][m][0], acc[ai][bj][m][1]); }
    }
};

template <class Epi, class Sched, bool ALIGN_EPI = false, bool SP2 = false, bool PFOUT = false>
__device__ __forceinline__ void gemm_phase(PG8_LAS unsigned char* lds, const Gemm g, const Sched& S, const Epi& E) {
    const int tid = threadIdx.x, wid = __builtin_amdgcn_readfirstlane(tid >> 6), lane = tid & 63, wr = wid >> 2, wc = wid & 3, fr = lane & 15, fq = lane >> 4;
    const int K = g.K, nt = K / BK;
    unsigned voffA[2], voffB[2];
#pragma unroll
    for (int i = 0; i < 2; ++i) { int R, C; stage_rc(tid * 16 + i * 8192, R, C); const int Rb = Epi::PERM ? ((R & ~31) + perm32(R & 31)) : R;
        voffA[i] = (unsigned)(R * K + C) * 2u; voffB[i] = (unsigned)(Rb * K + C) * 2u; }
    const size_t kstep = (size_t)(BK * 2);
    const size_t hstep = (size_t)HALF * K * 2;
    const size_t tstep = 2 * hstep;
    const unsigned ldsw = (unsigned)wid * 1024u;
    const int aoff = lds_byte(wr * 64 + fr, fq * 8), boff = lds_byte(wc * 32 + fr, fq * 8);
#define PG8_SA(b, h) (((b) * 2 + (h)) * HTB)
#define PG8_SB(b, h) ((4 + (b) * 2 + (h)) * HTB)
#define PG8_STAGE(bufoff, gbase, voff) do { _Pragma("unroll") for (int _i = 0; _i < 2; ++_i) \
        __builtin_amdgcn_global_load_lds((const unsigned*)((const char*)(gbase) + (voff)[_i]), (PG8_LAS unsigned*)(lds + (bufoff) + ldsw + _i * 8192), 16, 0, 0); } while (0)
#define PG8_LDA(dst, b, h) do { _Pragma("unroll") for (int m = 0; m < 4; ++m) _Pragma("unroll") for (int k = 0; k < 2; ++k) dst[m][k] = *(const PG8_LAS bf16x8*)(lds + PG8_SA(b, h) + aoff + m * 2048 + k * 1024); } while (0)
#define PG8_LDB(dst, b, h) do { _Pragma("unroll") for (int n = 0; n < 2; ++n) _Pragma("unroll") for (int k = 0; k < 2; ++k) dst[n][k] = *(const PG8_LAS bf16x8*)(lds + PG8_SB(b, h) + boff + n * 2048 + k * 1024); } while (0)
#define PG8_MMA(ai, bj, At, Bt) do { __builtin_amdgcn_s_setprio(1); _Pragma("unroll") for (int m = 0; m < 4; ++m) _Pragma("unroll") for (int n = 0; n < 2; ++n) _Pragma("unroll") for (int k = 0; k < 2; ++k) \
        acc[ai][bj][m][n] = __builtin_amdgcn_mfma_f32_16x16x32_bf16(Bt[n][k], At[m][k], acc[ai][bj][m][n], 0, 0, 0); __builtin_amdgcn_s_setprio(0); } while (0)
#define PG8_WAIT_V(n) asm volatile("s_waitcnt vmcnt(" #n ")" ::: "memory")
#define PG8_WAIT_L(n) asm volatile("s_waitcnt lgkmcnt(" #n ")" ::: "memory")
#define PG8_BAR __builtin_amdgcn_s_barrier()
#define PG8_SCHED __builtin_amdgcn_sched_barrier(0)
    Unit cur, nxt; int ui = 0;
    if (!S.next(0, cur)) return;
    f32x4 acc[2][2][4][2];
#pragma unroll
    for (int a = 0; a < 2; ++a)
#pragma unroll
        for (int b = 0; b < 2; ++b)
#pragma unroll
            for (int m = 0; m < 4; ++m)
#pragma unroll
                for (int n = 0; n < 2; ++n) acc[a][b][m][n] = (f32x4){0.f, 0.f, 0.f, 0.f};
    bf16x8 At[4][2], B0[2][2], B1[2][2];
#define PG8_AB(u_) (Sched::MULTI ? (const char*)((u_).kind == 0 ? g.A : (u_).kind == 1 ? g.A1 : (u_).kind == 2 ? g.A2 : g.A3) : (const char*)g.A)
#define PG8_BB(u_) (Sched::MULTI ? (const char*)((u_).kind == 0 ? g.Bt : (u_).kind == 1 ? g.B1 : (u_).kind == 2 ? g.B2 : g.B3) : (const char*)g.Bt)
    const char* cA = PG8_AB(cur) + (size_t)cur.pm * tstep; const char* cB = PG8_BB(cur) + (size_t)cur.pn * tstep;
    S.a_ready(cur);
    if constexpr (SP2) {
        PG8_STAGE(PG8_SB(0, 0), cB, voffB); PG8_STAGE(PG8_SB(0, 1), cB + hstep, voffB); PG8_STAGE(PG8_SA(0, 0), cA, voffA); PG8_STAGE(PG8_SA(0, 1), cA + hstep, voffA);
        if (wr == 1) PG8_BAR;
        PG8_WAIT_V(2); PG8_BAR;
        PG8_STAGE(PG8_SB(1, 0), cB + kstep, voffB); PG8_STAGE(PG8_SA(1, 0), cA + kstep, voffA); PG8_STAGE(PG8_SB(1, 1), cB + hstep + kstep, voffB);
        PG8_WAIT_V(6); PG8_BAR;
    } else {
        PG8_STAGE(PG8_SB(0, 0), cB, voffB); PG8_STAGE(PG8_SA(0, 0), cA, voffA); PG8_STAGE(PG8_SB(0, 1), cB + hstep, voffB); PG8_STAGE(PG8_SA(0, 1), cA + hstep, voffA);
        if (wr == 1) PG8_BAR;
        PG8_WAIT_V(4); PG8_BAR;
        PG8_STAGE(PG8_SB(1, 0), cB + kstep, voffB); PG8_STAGE(PG8_SA(1, 0), cA + kstep, voffA); PG8_STAGE(PG8_SB(1, 1), cB + hstep + kstep, voffB);
        PG8_WAIT_V(6); PG8_BAR;
    }
    for (;;) {
        const bool has_next = S.next(ui + 1, nxt);
        const char* nA = has_next ? PG8_AB(nxt) + (size_t)nxt.pm * tstep : cA; const char* nB = has_next ? PG8_BB(nxt) + (size_t)nxt.pn * tstep : cB;
        for (int t = 0; t < nt; t += 2) {
            const bool last = (t == nt - 2);
            const char* a1 = cA + (size_t)(t + 1) * kstep;
            const char* a2 = last ? nA : cA + (size_t)(t + 2) * kstep; const char* b2 = last ? nB : cB + (size_t)(t + 2) * kstep;
            const char* a3 = a2 + kstep; const char* b3 = b2 + kstep;
            if (last && has_next) S.a_ready(nxt);
            if constexpr (PFOUT) { if (t == nt - 4) { bf16_t* pbase; int pldc, pcolt; E.locate(cur, pbase, pldc, pcolt);
#pragma unroll
                for (int i_ = 0; i_ < 2; ++i_) { const int L_ = (wid * 2 + i_) * 64 + lane;
                    const char* pp_ = (const char*)(pbase + (size_t)(cur.pm * BM + (L_ >> 2)) * pldc + pcolt) + (L_ & 3) * 128;
                    __builtin_amdgcn_global_load_lds((const unsigned*)pp_, (PG8_LAS unsigned*)(lds + 131072 + wid * 512 + i_ * 256), 4, 0, 0); } } }
            if constexpr (SP2) {
            PG8_LDB(B0, 0, 0); PG8_LDB(B1, 0, 1); PG8_SCHED; PG8_LDA(At, 0, 0); PG8_STAGE(PG8_SA(1, 1), a1 + hstep, voffA);
            PG8_WAIT_V(8); PG8_WAIT_L(0); PG8_BAR; PG8_MMA(0, 0, At, B0); PG8_MMA(0, 1, At, B1); PG8_BAR; PG8_SCHED;
            PG8_LDA(At, 0, 1); PG8_STAGE(PG8_SB(0, 0), b2, voffB); PG8_STAGE(PG8_SB(0, 1), b2 + hstep, voffB); PG8_STAGE(PG8_SA(0, 0), a2, voffA);
            PG8_WAIT_V(8); PG8_WAIT_L(0); PG8_BAR; PG8_MMA(1, 0, At, B0); PG8_MMA(1, 1, At, B1); PG8_BAR; PG8_SCHED;
            PG8_LDB(B0, 1, 0); PG8_LDB(B1, 1, 1); PG8_SCHED; PG8_LDA(At, 1, 0); PG8_STAGE(PG8_SA(0, 1), a2 + hstep, voffA);
            PG8_WAIT_V(8); PG8_WAIT_L(0); PG8_BAR; PG8_MMA(0, 0, At, B0); PG8_MMA(0, 1, At, B1); PG8_BAR; PG8_SCHED;
            PG8_LDA(At, 1, 1); PG8_STAGE(PG8_SB(1, 0), b3, voffB); PG8_STAGE(PG8_SB(1, 1), b3 + hstep, voffB); PG8_STAGE(PG8_SA(1, 0), a3, voffA);
            PG8_WAIT_V(8); PG8_WAIT_L(0); PG8_BAR; PG8_MMA(1, 0, At, B0); PG8_MMA(1, 1, At, B1); PG8_BAR; PG8_SCHED;
            } else {
            PG8_LDB(B0, 0, 0); PG8_SCHED; PG8_LDA(At, 0, 0); PG8_STAGE(PG8_SA(1, 1), a1 + hstep, voffA);
            PG8_WAIT_L(8); PG8_BAR; PG8_WAIT_L(0); PG8_MMA(0, 0, At, B0); PG8_BAR; PG8_SCHED;
            PG8_LDB(B1, 0, 1); PG8_STAGE(PG8_SB(0, 0), b2, voffB);
            PG8_BAR; PG8_WAIT_L(0); PG8_MMA(0, 1, At, B1); PG8_BAR;
            PG8_LDA(At, 0, 1); PG8_STAGE(PG8_SA(0, 0), a2, voffA);
            PG8_BAR; PG8_WAIT_L(0); PG8_MMA(1, 0, At, B0); PG8_BAR; PG8_SCHED;
            PG8_STAGE(PG8_SB(0, 1), b2 + hstep, voffB);
            PG8_WAIT_V(6); PG8_BAR; PG8_MMA(1, 1, At, B1); PG8_BAR;
            PG8_LDB(B0, 1, 0); PG8_SCHED; PG8_LDA(At, 1, 0); PG8_STAGE(PG8_SA(0, 1), a2 + hstep, voffA);
            PG8_WAIT_L(8); PG8_BAR; PG8_WAIT_L(0); PG8_MMA(0, 0, At, B0); PG8_BAR; PG8_SCHED;
            PG8_LDB(B1, 1, 1); PG8_STAGE(PG8_SB(1, 0), b3, voffB);
            PG8_BAR; PG8_WAIT_L(0); PG8_MMA(0, 1, At, B1); PG8_BAR;
            PG8_LDA(At, 1, 1); PG8_STAGE(PG8_SA(1, 0), a3, voffA);
            PG8_BAR; PG8_WAIT_L(0); PG8_MMA(1, 0, At, B0); PG8_BAR; PG8_SCHED;
            PG8_STAGE(PG8_SB(1, 1), b3 + hstep, voffB);
            PG8_WAIT_V(6); PG8_BAR; PG8_MMA(1, 1, At, B1); PG8_BAR;
            }
        }
        if constexpr (ALIGN_EPI) { if (wr == 0) PG8_BAR; }
        bool keep_acc = false;
        if constexpr (!Epi::AFTER_DRAIN) { if constexpr (Sched::MULTI) keep_acc = E(acc, cur, wr, wc, fr, fq); else E(acc, cur, wr, wc, fr, fq); S.done(cur); }
        if (!has_next) break;
        if (!keep_acc) {
#pragma unroll
        for (int a = 0; a < 2; ++a)
#pragma unroll
            for (int b = 0; b < 2; ++b)
#pragma unroll
                for (int m = 0; m < 4; ++m)
#pragma unroll
                    for (int n = 0; n < 2; ++n) acc[a][b][m][n] = (f32x4){0.f, 0.f, 0.f, 0.f};
        }
        cur = nxt; cA = nA; cB = nB; ++ui;
        if constexpr (ALIGN_EPI) { if (wr == 1) PG8_BAR; }
    }
    PG8_WAIT_V(0);
    if constexpr (!ALIGN_EPI) { if (wr == 0) PG8_BAR; }
    PG8_BAR;
    if constexpr (Epi::AFTER_DRAIN) { E.fused(acc, cur, wr, wc, fr, fq, lds, wid, lane); S.done(cur); }
#undef PG8_AB
#undef PG8_BB
#undef PG8_SA
#undef PG8_SB
#undef PG8_STAGE
#undef PG8_LDA
#undef PG8_LDB
#undef PG8_MMA
#undef PG8_WAIT_V
#undef PG8_WAIT_L
#undef PG8_BAR
#undef PG8_SCHED
}
}


namespace tk {
typedef short bf16x8 __attribute__((ext_vector_type(8)));
constexpr int RSK = 272, TAB = 69632, TABW = 33 * 16 * 4, IJT = TAB + 8 * TABW;
__device__ __forceinline__ void ce(float& a, float& b) { const float hi = __builtin_fmaxf(a, b), lo = __builtin_fminf(a, b); a = hi; b = lo; }
__device__ __forceinline__ void sort16(float (&v)[16]) {
#pragma unroll
    for (int k = 2; k <= 16; k <<= 1)
#pragma unroll
        for (int j = k >> 1; j > 0; j >>= 1)
#pragma unroll
            for (int i = 0; i < 16; ++i) { const int l = i ^ j; if (l > i) { if ((i & k) == 0) ce(v[i], v[l]); else ce(v[l], v[i]); } }
}
__device__ __forceinline__ void merge16(float (&a)[16], const float (&b)[16]) {
#pragma unroll
    for (int i = 0; i < 16; ++i) a[i] = __builtin_fmaxf(a[i], b[15 - i]);
#pragma unroll
    for (int j = 8; j > 0; j >>= 1)
#pragma unroll
        for (int i = 0; i < 16; ++i) { const int l = i ^ j; if (l > i) ce(a[i], a[l]); }
}
__device__ __forceinline__ void xmerge(float (&a)[16], int mask) { float b[16];
#pragma unroll
    for (int i = 0; i < 16; ++i) b[i] = __shfl_xor(a[i], mask);
    merge16(a, b); }
}
template <bool OWN>
__device__ __forceinline__ void p_topk(const Ctx& C, const bf16_t* qp, const bf16_t* keys, unsigned short* pidx, float* pgate) {
    using namespace tk;
    LAS unsigned char* L = C.lds;
    const int tid = C.tid, lane = C.lane, w = C.wave, g = lane >> 4, i16 = lane & 15;
    __syncthreads();
    for (int i = tid; i < 4096; i += NTHR) { const int r = i >> 4, cc = i & 15; *(LAS u32x4*)(L + r * RSK + cc * 16) = *(const u32x4*)(keys + (size_t)r * 128 + cc * 8); }
    if (tid < 64) { int cnt = 0, fi = 0, fj = 0;
        for (int i = 0; i < 16; ++i) for (int j = 0; j < 16; ++j) if ((i + 1) * (j + 1) <= 16) { if (cnt == tid) { fi = i; fj = j; } ++cnt; }
        ((LAS unsigned*)(L + IJT))[tid] = (unsigned)(fi | (fj << 4)); }
    __syncthreads();
    LAS unsigned* tab = (LAS unsigned*)(L + TAB + w * TABW) + i16 * 33;
    const LAS unsigned* ijt = (const LAS unsigned*)(L + IJT);
    const float NEGV = -1.0e30f;
    const int gw = C.bid * NWAVES + w, NGW = C.G * NWAVES;
    pg8::StaticOrder SO; SO.init(T, 2048, C.G, C.bid);
    for (int unit = OWN ? w : gw; ; unit += OWN ? NWAVES : NGW) {
        int tg, hh;
        if constexpr (OWN) { pg8::Unit u; if (!SO.next(unit >> 4, u)) break; tg = 16 * u.pm + (unit & 15); hh = u.pn; }
        else { if (unit >= (T / 16) * 8) break; tg = unit >> 3; hh = unit & 7; }
        const size_t t0 = (size_t)tg * 16;
        float s1[16], s2[16];
#pragma unroll
        for (int z = 0; z < 2; ++z) {
            bf16x8 qf[4];
#pragma unroll
            for (int ks = 0; ks < 4; ++ks) qf[ks] = *(const bf16x8*)(qp + (t0 + i16) * 2048 + hh * 256 + z * 128 + ks * 32 + g * 8);
            float lo[16], hi[16];
#pragma unroll
            for (int nt = 0; nt < 8; ++nt) { f32x4 acc = (f32x4){0.f, 0.f, 0.f, 0.f};
#pragma unroll
                for (int ks = 0; ks < 4; ++ks) { const bf16x8 kf = *(const LAS bf16x8*)(L + (z * 128 + 16 * nt + i16) * RSK + ks * 64 + g * 16);
                    acc = __builtin_amdgcn_mfma_f32_16x16x32_bf16(kf, qf[ks], acc, 0, 0, 0); }
#pragma unroll
                for (int r = 0; r < 4; ++r) { const float pv = __uint_as_float((__float_as_uint(acc[r]) & 0xFFFFFF80u) | (unsigned)(16 * nt + 4 * g + r));
                    if (nt < 4) lo[nt * 4 + r] = pv; else hi[(nt - 4) * 4 + r] = pv; } }
            sort16(lo); sort16(hi); merge16(lo, hi);
            xmerge(lo, 16); xmerge(lo, 32);
#pragma unroll
            for (int i = 0; i < 16; ++i) { if (z == 0) s1[i] = lo[i]; else s2[i] = lo[i]; }
        }
#pragma unroll
        for (int i = 0; i < 16; ++i) { tab[i] = __float_as_uint(s1[i]); tab[16 + i] = __float_as_uint(s2[i]); }
        float cand[16];
            { const float a_ = (g == 0 ? s1[0] : g == 1 ? s1[1] : g == 2 ? s1[3] : s1[14]), b_ = (g == 0 ? s2[0] : g == 1 ? s2[0] : g == 2 ? s2[3] : s2[0]); cand[0] = __uint_as_float((__float_as_uint(a_ + b_) & 0xFFFFFFC0u) | (unsigned)(16 * g + 0)); }
            { const float a_ = (g == 0 ? s1[0] : g == 1 ? s1[1] : g == 2 ? s1[4] : s1[15]), b_ = (g == 0 ? s2[1] : g == 1 ? s2[1] : g == 2 ? s2[0] : s2[0]); cand[1] = __uint_as_float((__float_as_uint(a_ + b_) & 0xFFFFFFC0u) | (unsigned)(16 * g + 1)); }
            { const float a_ = (g == 0 ? s1[0] : g == 1 ? s1[1] : g == 2 ? s1[4] : NEGV), b_ = (g == 0 ? s2[2] : g == 1 ? s2[2] : g == 2 ? s2[1] : NEGV); cand[2] = __uint_as_float((__float_as_uint(a_ + b_) & 0xFFFFFFC0u) | (unsigned)(16 * g + 2)); }
            { const float a_ = (g == 0 ? s1[0] : g == 1 ? s1[1] : g == 2 ? s1[4] : NEGV), b_ = (g == 0 ? s2[3] : g == 1 ? s2[3] : g == 2 ? s2[2] : NEGV); cand[3] = __uint_as_float((__float_as_uint(a_ + b_) & 0xFFFFFFC0u) | (unsigned)(16 * g + 3)); }
            { const float a_ = (g == 0 ? s1[0] : g == 1 ? s1[1] : g == 2 ? s1[5] : NEGV), b_ = (g == 0 ? s2[4] : g == 1 ? s2[4] : g == 2 ? s2[0] : NEGV); cand[4] = __uint_as_float((__float_as_uint(a_ + b_) & 0xFFFFFFC0u) | (unsigned)(16 * g + 4)); }
            { const float a_ = (g == 0 ? s1[0] : g == 1 ? s1[1] : g == 2 ? s1[5] : NEGV), b_ = (g == 0 ? s2[5] : g == 1 ? s2[5] : g == 2 ? s2[1] : NEGV); cand[5] = __uint_as_float((__float_as_uint(a_ + b_) & 0xFFFFFFC0u) | (unsigned)(16 * g + 5)); }
            { const float a_ = (g == 0 ? s1[0] : g == 1 ? s1[1] : g == 2 ? s1[6] : NEGV), b_ = (g == 0 ? s2[6] : g == 1 ? s2[6] : g == 2 ? s2[0] : NEGV); cand[6] = __uint_as_float((__float_as_uint(a_ + b_) & 0xFFFFFFC0u) | (unsigned)(16 * g + 6)); }
            { const float a_ = (g == 0 ? s1[0] : g == 1 ? s1[1] : g == 2 ? s1[6] : NEGV), b_ = (g == 0 ? s2[7] : g == 1 ? s2[7] : g == 2 ? s2[1] : NEGV); cand[7] = __uint_as_float((__float_as_uint(a_ + b_) & 0xFFFFFFC0u) | (unsigned)(16 * g + 7)); }
            { const float a_ = (g == 0 ? s1[0] : g == 1 ? s1[2] : g == 2 ? s1[7] : NEGV), b_ = (g == 0 ? s2[8] : g == 1 ? s2[0] : g == 2 ? s2[0] : NEGV); cand[8] = __uint_as_float((__float_as_uint(a_ + b_) & 0xFFFFFFC0u) | (unsigned)(16 * g + 8)); }
            { const float a_ = (g == 0 ? s1[0] : g == 1 ? s1[2] : g == 2 ? s1[7] : NEGV), b_ = (g == 0 ? s2[9] : g == 1 ? s2[1] : g == 2 ? s2[1] : NEGV); cand[9] = __uint_as_float((__float_as_uint(a_ + b_) & 0xFFFFFFC0u) | (unsigned)(16 * g + 9)); }
            { const float a_ = (g == 0 ? s1[0] : g == 1 ? s1[2] : g == 2 ? s1[8] : NEGV), b_ = (g == 0 ? s2[10] : g == 1 ? s2[2] : g == 2 ? s2[0] : NEGV); cand[10] = __uint_as_float((__float_as_uint(a_ + b_) & 0xFFFFFFC0u) | (unsigned)(16 * g + 10)); }
            { const float a_ = (g == 0 ? s1[0] : g == 1 ? s1[2] : g == 2 ? s1[9] : NEGV), b_ = (g == 0 ? s2[11] : g == 1 ? s2[3] : g == 2 ? s2[0] : NEGV); cand[11] = __uint_as_float((__float_as_uint(a_ + b_) & 0xFFFFFFC0u) | (unsigned)(16 * g + 11)); }
            { const float a_ = (g == 0 ? s1[0] : g == 1 ? s1[2] : g == 2 ? s1[10] : NEGV), b_ = (g == 0 ? s2[12] : g == 1 ? s2[4] : g == 2 ? s2[0] : NEGV); cand[12] = __uint_as_float((__float_as_uint(a_ + b_) & 0xFFFFFFC0u) | (unsigned)(16 * g + 12)); }
            { const float a_ = (g == 0 ? s1[0] : g == 1 ? s1[3] : g == 2 ? s1[11] : NEGV), b_ = (g == 0 ? s2[13] : g == 1 ? s2[0] : g == 2 ? s2[0] : NEGV); cand[13] = __uint_as_float((__float_as_uint(a_ + b_) & 0xFFFFFFC0u) | (unsigned)(16 * g + 13)); }
            { const float a_ = (g == 0 ? s1[0] : g == 1 ? s1[3] : g == 2 ? s1[12] : NEGV), b_ = (g == 0 ? s2[14] : g == 1 ? s2[1] : g == 2 ? s2[0] : NEGV); cand[14] = __uint_as_float((__float_as_uint(a_ + b_) & 0xFFFFFFC0u) | (unsigned)(16 * g + 14)); }
            { const float a_ = (g == 0 ? s1[0] : g == 1 ? s1[3] : g == 2 ? s1[13] : NEGV), b_ = (g == 0 ? s2[15] : g == 1 ? s2[2] : g == 2 ? s2[0] : NEGV); cand[15] = __uint_as_float((__float_as_uint(a_ + b_) & 0xFFFFFFC0u) | (unsigned)(16 * g + 15)); }
        sort16(cand);
        xmerge(cand, 16); xmerge(cand, 32);
        float den = 0.f, ex[16];
#pragma unroll
        for (int i = 0; i < 16; ++i) { ex[i] = __expf(cand[i] - cand[0]); den += ex[i]; }
        const float inv = 1.f / den;
        unsigned short eo[4]; float go[4];
#pragma unroll
        for (int e = 0; e < 4; ++e) {
            const float cv = (g == 0 ? cand[e] : g == 1 ? cand[4 + e] : g == 2 ? cand[8 + e] : cand[12 + e]);
            const float gv = (g == 0 ? ex[e] : g == 1 ? ex[4 + e] : g == 2 ? ex[8 + e] : ex[12 + e]);
            const unsigned code = __float_as_uint(cv) & 63u; const unsigned ij = ijt[code];
            const unsigned p1 = tab[ij & 15u], p2 = tab[16 + (ij >> 4)];
            eo[e] = (unsigned short)((p1 & 127u) * 128u + (p2 & 127u)); go[e] = gv * inv; }
        u32x2 ov; ov.x = (unsigned)eo[0] | ((unsigned)eo[1] << 16); ov.y = (unsigned)eo[2] | ((unsigned)eo[3] << 16);
        *(u32x2*)(pidx + (t0 + i16) * 128 + hh * 16 + 4 * g) = ov;
        *(f32x4*)(pgate + (t0 + i16) * 128 + hh * 16 + 4 * g) = (f32x4){go[0], go[1], go[2], go[3]};
    }
    __syncthreads();
}

#define GAS __attribute__((address_space(1)))
typedef GAS unsigned gu32;
#define RLX_AGENT __ATOMIC_RELAXED, __HIP_MEMORY_SCOPE_AGENT
#define XB_TMO      128
#define XB_XCNT(j)  (256  + 64 * (j))
#define XB_XSUB(j)  (1280 + 64 * (j))
#define XB_XGEN(j)  (2304 + 64 * (j))
#define XB_TOP      3328
#define XB_TOPGEN   3392
#define XCD_BAR_WORDS 3456
#define XB_SPIN_CAP (1u << 18)

__device__ __forceinline__ unsigned xb_ld(unsigned* p)              { return __hip_atomic_load(p, __ATOMIC_RELAXED, __HIP_MEMORY_SCOPE_AGENT); }
__device__ __forceinline__ unsigned xb_add(unsigned* p, unsigned v) { return __hip_atomic_fetch_add(p, v, __ATOMIC_RELAXED, __HIP_MEMORY_SCOPE_AGENT); }
__device__ __forceinline__ unsigned xb_xcc_id() { return (unsigned)__builtin_amdgcn_s_getreg((3 << 11) | 20) & 0xFu; }
#define XB_SPIN(cond, bar) do { unsigned _sp = 0; while (cond) { __builtin_amdgcn_s_sleep(1); \
    if ((++_sp & 255u) == 0u) { if (xb_ld(&(bar)[XB_TMO])) break; if (_sp > XB_SPIN_CAP) { atomicAdd(&(bar)[XB_TMO], 1u); break; } } } } while (0)

struct XcdBarrier {
    unsigned* bar; unsigned x;
    volatile LAS unsigned* st;
};

__device__ __forceinline__ XcdBarrier xcd_barrier_post(unsigned* bar, volatile LAS unsigned* st) {
    XcdBarrier b; b.bar = bar; b.x = xb_xcc_id(); b.st = st;
    if (threadIdx.x == 0) (void)xb_add(&bar[XB_XCNT(b.x)], 1u);
    return b;
}
__device__ __forceinline__ void xcd_barrier_complete(unsigned* bar, unsigned x, unsigned& nloc, unsigned& nx) {
    const unsigned G = gridDim.x * gridDim.y * gridDim.z;
    unsigned sum, cnt, mine, sp = 0u;
    for (;;) {
        sum = 0u; cnt = 0u; mine = 0u;
#pragma unroll
        for (unsigned j = 0; j < 16; ++j) { const unsigned c = xb_ld(&bar[XB_XCNT(j)]); sum += c; cnt += (c > 0u) ? 1u : 0u; mine = (j == x) ? c : mine; }
        if (sum == G) break;
        __builtin_amdgcn_s_sleep(1);
        if ((++sp & 255u) == 0u) { if (xb_ld(&bar[XB_TMO])) break; if (sp > XB_SPIN_CAP) { atomicAdd(&bar[XB_TMO], 1u); break; } }
    }
    nloc = mine > 0u ? mine : 1u; nx = cnt > 0u ? cnt : 1u;
}

__device__ __forceinline__ void xcd_barrier(const XcdBarrier& b) {
    asm volatile("s_waitcnt vmcnt(0)" ::: "memory");
    __syncthreads();
    if (threadIdx.x == 0) {
        unsigned* bar = b.bar;
        __builtin_amdgcn_s_waitcnt(0);
        unsigned nloc = b.st[0], nx = b.st[1];
        if (nloc == 0u) { xcd_barrier_complete(bar, b.x, nloc, nx); b.st[0] = nloc; b.st[1] = nx; }
        const unsigned old = xb_add(&bar[XB_XSUB(b.x)], 1u);
        const unsigned gen = old / nloc;
        if (old + 1u == (gen + 1u) * nloc) {
            __builtin_amdgcn_fence(__ATOMIC_RELEASE, "agent");
            asm volatile("s_waitcnt vmcnt(0)" ::: "memory");
            const unsigned og = xb_add(&bar[XB_TOP], 1u);
            const unsigned tg = og / nx;
            if (og + 1u == (tg + 1u) * nx) xb_add(&bar[XB_TOPGEN], 1u);
            else XB_SPIN(xb_ld(&bar[XB_TOPGEN]) == tg, bar);
            __builtin_amdgcn_fence(__ATOMIC_ACQUIRE, "agent");
            xb_add(&bar[XB_XGEN(b.x)], 1u);
            asm volatile("s_waitcnt vmcnt(0)" ::: "memory");
        } else {
            XB_SPIN(xb_ld(&bar[XB_XGEN(b.x)]) == gen, bar);
            __builtin_amdgcn_fence(__ATOMIC_ACQUIRE, "agent");
            asm volatile("s_waitcnt vmcnt(0)" ::: "memory");
        }
    }
    __syncthreads();
}


constexpr int N_PHASES = 14;
constexpr int CW_BAR = 4096;
constexpr size_t CTL_ZERO_BYTES = 64 * 1024;
constexpr int MISC_OFF = LDS_BYTES - 256;

template <int PH>
__device__ __forceinline__ void run_phase(const Ctx& C, const Args& a) {
    bf16_t* R0 = C.bfp(WS_R0); bf16_t* R1 = C.bfp(WS_R1); bf16_t* R2 = C.bfp(WS_R2); bf16_t* R3 = C.bfp(WS_R3);
    bf16_t* OB = (bf16_t*)a.out;
    const size_t TD = (size_t)T * 1024;
    if constexpr (PH == 0) p_prep(C);
    if constexpr (PH == 1) p_rownorm(C, C.in[0], C.in[4], 0, 1024, R0);
    if constexpr (PH == 2) {
        { pg8::Gemm g{R0, C.bfp(WS_WIN_T), T, 6144, 1024}; pg8::StaticOrder S; S.init(T, 6144, C.G, C.bid);
          pg8::EpiInProj e{R1, R2, R3, R3 + TD, R3 + 2 * TD};
          pg8::gemm_phase<pg8::EpiInProj, pg8::StaticOrder, true, true, true>(C.lds, g, S, e); }
        p_dt(C, R0, C.bfp(WS_WDT_T), C.f32p(WS_DT));
    }
    if constexpr (PH == 3) {
        if ((C.bid >> 3) & 1) { p_na(C, R3, R3 + TD, R3 + 2 * TD); p_conv(C, R2, OB); } else { p_conv(C, R2, OB); p_na(C, R3, R3 + TD, R3 + 2 * TD); } }
    if constexpr (PH == 4) p_ssd(C, OB, C.f32p(WS_DT), R2, R2 + TD);
    if constexpr (PH == 5) p_combine(C, R2, R2 + TD, R1, C.f32p(WS_RSTD));
    if constexpr (PH == 6) {
        pg8::MultiOrder S; S.b.init(T, 1024, C.G, C.bid); S.nk = 4;
        pg8::Gemm g{R0, C.bfp(WS_WG_T), T, 1024, 1024, R0, C.bfp(WS_WG_T) + (size_t)1024 * 1024, R1, C.bfp(WS_WSSD_T), R3, C.bfp(WS_WNA_T)};
        pg8::EpiMix e{OB + (size_t)C.bid * 131072, OB + (size_t)C.bid * 131072 + 65536, R2 + TD, C.f32p(WS_RSTD)};
        pg8::gemm_phase<pg8::EpiMix, pg8::MultiOrder, true, true>(C.lds, g, S, e);
    }
    if constexpr (PH == 7) { pg8::Gemm g{R2 + TD, C.bfp(WS_WOUT_T), T, 1024, 1024}; pg8::StaticOrder S; S.init(T, 1024, C.G, C.bid);
        pg8::EpiD3 e{R3 + TD, C.in[0], C.f32p(WS_MOD)}; pg8::gemm_phase<pg8::EpiD3, pg8::StaticOrder, true, true>(C.lds, g, S, e); }
    if constexpr (PH == 8) { p_rownorm_b(C, R3 + TD, C.in[18], 3072, 4096, R0); p_cvt_tables8(C, (unsigned char*)R2, (unsigned char*)R2 + (size_t)16384 * 1024); }
    if constexpr (PH == 9) { pg8::Gemm g{R0, C.bfp(WS_WPQ_T), T, 2048, 1024}; pg8::StaticOrder S; S.init(T, 2048, C.G, C.bid);
        pg8::EpiQp e{OB}; pg8::gemm_phase<pg8::EpiQp, pg8::StaticOrder, true, true>(C.lds, g, S, e);
        asm volatile("s_waitcnt vmcnt(0)" ::: "memory"); __syncthreads();
        if (C.tid == 0) __builtin_amdgcn_fence(__ATOMIC_ACQUIRE, "agent");
        asm volatile("s_waitcnt vmcnt(0)" ::: "memory"); __syncthreads();
        p_topk<true>(C, OB, C.bfp(WS_KEYS), (unsigned short*)R1, (float*)(R1 + 4 * MiB)); }
    if constexpr (PH == 10) p_gu(C, R0, (const unsigned short*)R1, (const unsigned char*)R2, a.out);
    if constexpr (PH == 11) p_gc(C, a.out, (const float*)(R1 + 4 * MiB), (float*)((unsigned char*)R2 + 32 * MiB));
    if constexpr (PH == 12) p_gv(C, (const float*)((unsigned char*)R2 + 32 * MiB), (const unsigned short*)R1, (const unsigned char*)R2 + (size_t)16384 * 1024, R3);
    if constexpr (PH == 13) p_gf(C, R3 + TD, R3, a.out);
}

template <int PH> struct PhaseLoop {
    static __device__ __forceinline__ void run(const Ctx& C, const Args& a, const XcdBarrier& bar) {
        if (PH >= a.ph_lo && PH < a.ph_hi) { run_phase<PH>(C, a); if (PH + 1 < a.ph_hi) xcd_barrier(bar); }
        PhaseLoop<PH + 1>::run(C, a, bar);
    }
};
template <> struct PhaseLoop<N_PHASES> { static __device__ __forceinline__ void run(const Ctx&, const Args&, const XcdBarrier&) {} };

__global__ void __launch_bounds__(NTHR, 2) mega(Args a) {
    extern __shared__ __attribute__((aligned(16))) unsigned char lds_raw[];
    Ctx C; C.in = a.in; C.out = a.out; C.ws = a.ws; C.tid = threadIdx.x; C.lane = C.tid & 63; C.wave = __builtin_amdgcn_readfirstlane(C.tid >> 6);
    C.G = gridDim.x; C.bid = blockIdx.x; C.lds = (LAS unsigned char*)lds_raw;
    volatile LAS unsigned* MISC = (volatile LAS unsigned*)(C.lds + MISC_OFF);
    if (C.tid < 64) MISC[C.tid] = 0u;
    __syncthreads();
    XcdBarrier bar; bar.bar = (unsigned*)(a.ws + WS_CTL) + CW_BAR; bar.x = 0; bar.st = nullptr;
    if (a.ph_hi - a.ph_lo > 1) bar = xcd_barrier_post((unsigned*)(a.ws + WS_CTL) + CW_BAR, MISC + 8);
    PhaseLoop<0>::run(C, a, bar);
}

extern "C" void kernel_launch(void* const* d_in, const int* in_sizes, int n_in, void* d_out, int out_size, void* d_ws, size_t ws_size, hipStream_t stream) {
    static int grid = 0;
    if (grid == 0) {
        if (n_in != 24 || out_size != T * D || ws_size < WS_END) { fprintf(stderr, "kernel_launch: unexpected shapes n_in %d out %d ws %zu\n", n_in, out_size, ws_size); grid = -1; return; }
        int dev = 0, cus = 0;
        if (hipGetDevice(&dev) != hipSuccess || hipDeviceGetAttribute(&cus, hipDeviceAttributeMultiprocessorCount, dev) != hipSuccess) { grid = -1; return; }
        if (hipFuncSetAttribute((const void*)mega, hipFuncAttributeMaxDynamicSharedMemorySize, LDS_BYTES) != hipSuccess) { grid = -1; return; }
        grid = cus;
    }
    if (grid < 0) return;
    (void)hipMemsetAsync((char*)d_ws + WS_CTL, 0, CTL_ZERO_BYTES, stream);
    Args a{};
    for (int i = 0; i < 24; ++i) a.in[i] = (const float*)d_in[i];
    a.out = (float*)d_out; a.ws = (unsigned char*)d_ws;
    a.ph_lo = 0; a.ph_hi = N_PHASES;
    hipLaunchKernelGGL(mega, dim3(grid), dim3(NTHR), LDS_BYTES, stream, a);
}
```

```cpp
#include <hip/hip_runtime.h>
#include <cstdio>
#include <cstdint>

#define LAS __attribute__((address_space(3)))
typedef unsigned short bf16_t;
typedef float f32x4 __attribute__((ext_vector_type(4)));
typedef unsigned u32x4 __attribute__((ext_vector_type(4)));
typedef unsigned u32x2 __attribute__((ext_vector_type(2)));
typedef __bf16 bf16x2_t __attribute__((ext_vector_type(2)));

constexpr int T = 32768, D = 1024, NB = 8, SEQ = 4096;
constexpr int NWAVES = 8, NTHR = 512;
constexpr float EPS = 1e-6f;
constexpr int OFF_Z = 0, OFF_XBC = 1024, OFF_DTF = 3072, OFF_DTB = 3088, OFF_QKV = 3104, OFF_GS = 6176, OFF_GN = 7200, D_IN = 8224;

constexpr size_t MiB = 1u << 20;
constexpr size_t WS_CTL = 0;
constexpr size_t WS_MOD = 1 * MiB;
constexpr size_t WS_RSTD = 1 * MiB + 512 * 1024;
constexpr size_t WS_DT = 2 * MiB;
constexpr size_t WS_WIN_T = 6 * MiB;
constexpr size_t WS_WG_T = 18 * MiB;
constexpr size_t WS_WDT_T = 22 * MiB;
constexpr size_t WS_KEYS = 22 * MiB + 512 * 1024;
constexpr size_t WS_WSSD_T = 23 * MiB, WS_WNA_T = 25 * MiB, WS_WOUT_T = 27 * MiB, WS_WPQ_T = 29 * MiB;
constexpr size_t WS_R0 = 40 * MiB, WS_R1 = 104 * MiB, WS_R2 = 168 * MiB, WS_R3 = 296 * MiB, WS_END = 488 * MiB;

constexpr int LDS_BYTES = 163840;

struct Args { const float* in[24]; float* out; unsigned char* ws; int ph_lo, ph_hi; };

__device__ __forceinline__ float bf2f(unsigned v) { return __uint_as_float(v << 16); }
__device__ __forceinline__ float bflo(unsigned v) { return __uint_as_float(v << 16); }
__device__ __forceinline__ float bfhi(unsigned v) { return __uint_as_float(v & 0xffff0000u); }
__device__ __forceinline__ unsigned f2bf(float f) { unsigned u = __float_as_uint(f); return (u + 0x7fffu + ((u >> 16) & 1u)) >> 16; }
typedef float f32x2_t __attribute__((ext_vector_type(2)));
__device__ __forceinline__ unsigned pk2(float lo, float hi) { f32x2_t v = {lo, hi}; bf16x2_t b = __builtin_convertvector(v, bf16x2_t); return __builtin_bit_cast(unsigned, b); }
__device__ __forceinline__ void st_wt16(void* p, const u32x4 v) { asm volatile("global_store_dwordx4 %0, %1, off sc0 sc1\n\ts_nop 1" :: "v"(p), "v"(v) : "memory"); }
__device__ __forceinline__ void st_wt8(void* p, const u32x2 v) { asm volatile("global_store_dwordx2 %0, %1, off sc0 sc1\n\ts_nop 1" :: "v"(p), "v"(v) : "memory"); }
__device__ __forceinline__ float wave_sum(float v) {
#pragma unroll
    for (int o = 1; o < 64; o <<= 1) v += __shfl_xor(v, o);
    return v;
}
__device__ __forceinline__ float silu_f(float x) { return x / (1.f + __expf(-x)); }
__device__ __forceinline__ float sigmoid_f(float x) { return 1.f / (1.f + __expf(-x)); }
__device__ __forceinline__ float softplus_f(float x) { return x > 20.f ? x : log1pf(__expf(x)); }
__device__ __forceinline__ float gelu_f(float x) { return 0.5f * x * (1.f + erff(x * 0.70710678118654752f)); }

struct Ctx {
    const float* const* in; float* out; unsigned char* ws;
    int tid, lane, wave, G, bid;
    LAS unsigned char* lds;
    __device__ __forceinline__ float* f32p(size_t off) const { return (float*)(ws + off); }
    __device__ __forceinline__ bf16_t* bfp(size_t off) const { return (bf16_t*)(ws + off); }
};

__device__ __forceinline__ void tr_item(const float* W, int ldw, int col0, int K, bf16_t* WT, int row_off, LAS float* scr, int item, int nblk, int lane, const float* kscale) {
    const int kb = item / nblk, nb = item % nblk, k0 = 64 * kb, n0 = 32 * nb;
#pragma unroll
    for (int h = 0; h < 2; ++h) {
        float xv[16];
#pragma unroll
        for (int i = 0; i < 16; ++i) { const int kk = 2 * (16 * h + i) + (lane >> 5); xv[i] = W[(size_t)(k0 + kk) * ldw + col0 + n0 + (lane & 31)]; }
        if (kscale) {
#pragma unroll
            for (int i = 0; i < 16; ++i) xv[i] *= kscale[k0 + 2 * (16 * h + i) + (lane >> 5)]; }
        asm volatile("" ::: "memory");
#pragma unroll
        for (int i = 0; i < 16; ++i) { const int kk = 2 * (16 * h + i) + (lane >> 5); scr[kk * 33 + (lane & 31)] = xv[i]; }
    }
    asm volatile("s_waitcnt lgkmcnt(0)" ::: "memory");
    const int c = lane & 7;
#pragma unroll
    for (int j = 0; j < 4; ++j) { const int n = (lane >> 3) + 8 * j; const LAS float* sp = scr + (8 * c) * 33 + n;
        u32x4 o; o.x = pk2(sp[0 * 33], sp[1 * 33]); o.y = pk2(sp[2 * 33], sp[3 * 33]); o.z = pk2(sp[4 * 33], sp[5 * 33]); o.w = pk2(sp[6 * 33], sp[7 * 33]);
        *(u32x4*)(WT + (size_t)(row_off + n0 + n) * K + k0 + 8 * c) = o; }
    asm volatile("s_waitcnt lgkmcnt(0)" ::: "memory");
}
__device__ __forceinline__ void p_prep(const Ctx& C) {
    const float* c = C.in[1]; const float* w_ada = C.in[2]; const float* b_ada = C.in[3];
    float* mod = C.f32p(WS_MOD);
    LAS float* sc = (LAS float*)C.lds;
    LAS float* red = sc + 8192;
    for (int i = C.tid; i < 8192; i += NTHR) sc[i] = silu_f(c[i]);
    __syncthreads();
    for (int jb = C.bid; jb < 256; jb += C.G) {
        const int j0 = jb * 24, jl = C.tid % 24, kq = C.tid / 24;
        if (C.tid < 504) { float acc[8];
#pragma unroll
            for (int b = 0; b < 8; ++b) acc[b] = 0.f;
            const float* wp = w_ada + (size_t)kq * 6144 + j0 + jl; const LAS float* sp = sc + kq;
            for (int i0 = 0; i0 < 48; i0 += 8) { float wv[8];
#pragma unroll
                for (int u = 0; u < 8; ++u) wv[u] = wp[(size_t)(i0 + u) * (21 * 6144)];
                asm volatile("" ::: "memory");
#pragma unroll
                for (int u = 0; u < 8; ++u)
#pragma unroll
                    for (int b = 0; b < 8; ++b) acc[b] += sp[b * 1024 + 21 * (i0 + u)] * wv[u]; }
            if (kq < 16) { const float w = wp[(size_t)48 * (21 * 6144)];
#pragma unroll
                for (int b = 0; b < 8; ++b) acc[b] += sp[b * 1024 + 21 * 48] * w; }
#pragma unroll
            for (int b = 0; b < 8; ++b) red[(kq * 24 + jl) * 8 + b] = acc[b]; }
        __syncthreads();
        if (C.tid < 192) { const int jl2 = C.tid % 24, b2 = C.tid / 24; float sacc = b_ada[j0 + jl2];
            for (int kq2 = 0; kq2 < 21; ++kq2) sacc += red[(kq2 * 24 + jl2) * 8 + b2];
            mod[b2 * 6144 + j0 + jl2] = sacc; }
        __syncthreads();
    }
    LAS float* scr = (LAS float*)(C.lds + 65536 + C.wave * 8448);
    const int gw = C.bid * NWAVES + C.wave, NGW = C.G * NWAVES;
    const float* w_in = C.in[5];
    constexpr int I_A = 16 * 96, I_B = 16 * 96, I_G = 16 * 64, I_DT = 16, I_S = 16 * 32, I_PQ = 16 * 64;
    constexpr int NIT = I_A + I_B + I_G + I_DT + 3 * I_S + I_PQ;
    for (int it = gw; it < NIT; it += NGW) {
        int r = it;
        if (r < I_A) { tr_item(w_in, D_IN, 0, D, C.bfp(WS_WIN_T), 0, scr, r, 96, C.lane, nullptr); continue; } r -= I_A;
        if (r < I_B) { tr_item(w_in, D_IN, OFF_QKV, D, C.bfp(WS_WIN_T), 3072, scr, r, 96, C.lane, nullptr); continue; } r -= I_B;
        if (r < I_G) { tr_item(w_in, D_IN, OFF_GS, D, C.bfp(WS_WG_T), 0, scr, r, 64, C.lane, nullptr); continue; } r -= I_G;
        if (r < I_DT) { tr_item(w_in, D_IN, OFF_DTF, D, C.bfp(WS_WDT_T), 0, scr, r, 1, C.lane, nullptr); continue; } r -= I_DT;
        if (r < I_S) { tr_item(C.in[14], D, 0, D, C.bfp(WS_WSSD_T), 0, scr, r, 32, C.lane, C.in[13]); continue; } r -= I_S;
        if (r < I_S) { tr_item(C.in[16], D, 0, D, C.bfp(WS_WNA_T), 0, scr, r, 32, C.lane, nullptr); continue; } r -= I_S;
        if (r < I_S) { tr_item(C.in[17], D, 0, D, C.bfp(WS_WOUT_T), 0, scr, r, 32, C.lane, nullptr); continue; } r -= I_S;
        tr_item(C.in[19], 2048, 0, D, C.bfp(WS_WPQ_T), 0, scr, r, 64, C.lane, nullptr);
    }
    { const int gt = C.bid * NTHR + C.tid, NT = C.G * NTHR; const float* kf = C.in[20]; bf16_t* kb = C.bfp(WS_KEYS);
      for (int i = gt; i < 2 * 128 * 128; i += NT) kb[i] = (bf16_t)f2bf(kf[i]); }
    __syncthreads();
}

__device__ __forceinline__ void p_rownorm(const Ctx& C, const float* X, const float* gamma, int sh_off, int sc_off, bf16_t* dst) {
    const float* mod = C.f32p(WS_MOD);
    const int gw = C.bid * NWAVES + C.wave, NGW = C.G * NWAVES;
    for (int row0 = gw * 4; row0 < T; row0 += NGW * 4) {
        const int b = row0 / SEQ;
        f32x4 v[4][4]; float s[4];
#pragma unroll
        for (int r = 0; r < 4; ++r) { const f32x4* xr = (const f32x4*)(X + (size_t)(row0 + r) * D) + C.lane;
#pragma unroll
            for (int j = 0; j < 4; ++j) v[r][j] = xr[64 * j]; }
#pragma unroll
        for (int r = 0; r < 4; ++r) { float a = 0.f;
#pragma unroll
            for (int j = 0; j < 4; ++j) a += (v[r][j].x * v[r][j].x + v[r][j].y * v[r][j].y) + (v[r][j].z * v[r][j].z + v[r][j].w * v[r][j].w);
            s[r] = rsqrtf(wave_sum(a) * (1.f / D) + EPS); }
#pragma unroll
        for (int j = 0; j < 4; ++j) {
            const int col = 4 * C.lane + 256 * j;
            const f32x4 g = *(const f32x4*)(gamma + col), sh = *(const f32x4*)(mod + b * 6144 + sh_off + col), sc = *(const f32x4*)(mod + b * 6144 + sc_off + col);
            const f32x4 gs = g * (sc + 1.f);
#pragma unroll
            for (int r = 0; r < 4; ++r) { const f32x4 y = v[r][j] * s[r] * gs + sh; u32x2 w; w.x = pk2(y.x, y.y); w.y = pk2(y.z, y.w);
                st_wt8((u32x2*)(dst + (size_t)(row0 + r) * D) + C.lane + 64 * j, w); }
        }
    }
}

__device__ __forceinline__ void p_rownorm_b(const Ctx& C, const bf16_t* X, const float* gamma, int sh_off, int sc_off, bf16_t* dst) {
    const float* mod = C.f32p(WS_MOD);
    const int gw = C.bid * NWAVES + C.wave, NGW = C.G * NWAVES;
    for (int row0 = gw * 4; row0 < T; row0 += NGW * 4) {
        const int b = row0 / SEQ;
        u32x2 w[4][4]; float s[4];
#pragma unroll
        for (int r = 0; r < 4; ++r)
#pragma unroll
            for (int j = 0; j < 4; ++j) w[r][j] = *((const u32x2*)(X + (size_t)(row0 + r) * D) + C.lane + 64 * j);
        f32x4 v[4][4];
#pragma unroll
        for (int r = 0; r < 4; ++r) { float a = 0.f;
#pragma unroll
            for (int j = 0; j < 4; ++j) { v[r][j].x = bflo(w[r][j].x); v[r][j].y = bfhi(w[r][j].x); v[r][j].z = bflo(w[r][j].y); v[r][j].w = bfhi(w[r][j].y);
                a += (v[r][j].x * v[r][j].x + v[r][j].y * v[r][j].y) + (v[r][j].z * v[r][j].z + v[r][j].w * v[r][j].w); }
            s[r] = rsqrtf(wave_sum(a) * (1.f / D) + EPS); }
#pragma unroll
        for (int j = 0; j < 4; ++j) {
            const int col = 4 * C.lane + 256 * j;
            const f32x4 g = *(const f32x4*)(gamma + col), sh = *(const f32x4*)(mod + b * 6144 + sh_off + col), sc = *(const f32x4*)(mod + b * 6144 + sc_off + col);
            const f32x4 gs = g * (sc + 1.f);
#pragma unroll
            for (int r = 0; r < 4; ++r) { const f32x4 y = v[r][j] * s[r] * gs + sh; u32x2 o; o.x = pk2(y.x, y.y); o.y = pk2(y.z, y.w);
                st_wt8((u32x2*)(dst + (size_t)(row0 + r) * D) + C.lane + 64 * j, o); }
        }
    }
}

__device__ __forceinline__ void p_dt(const Ctx& C, const bf16_t* n1, const bf16_t* wdt, float* dt) {
    typedef short bf16x8 __attribute__((ext_vector_type(8)));
    const float* bf = C.in[8]; const float* bb = C.in[9];
    const int gw = C.bid * NWAVES + C.wave, NGW = C.G * NWAVES, lane = C.lane, g = lane >> 4, i16 = lane & 15;
    for (int tile = gw; tile < T / 16; tile += NGW) {
        const size_t t0 = (size_t)tile * 16;
        f32x4 a0 = (f32x4){0.f, 0.f, 0.f, 0.f}, a1 = a0;
#pragma unroll 8
        for (int ks = 0; ks < 32; ++ks) {
            const bf16x8 av = *(const bf16x8*)(n1 + (t0 + i16) * 1024 + ks * 32 + g * 8);
            const bf16x8 b0 = *(const bf16x8*)(wdt + (size_t)i16 * 1024 + ks * 32 + g * 8), b1 = *(const bf16x8*)(wdt + (size_t)(16 + i16) * 1024 + ks * 32 + g * 8);
            a0 = __builtin_amdgcn_mfma_f32_16x16x32_bf16(av, b0, a0, 0, 0, 0); a1 = __builtin_amdgcn_mfma_f32_16x16x32_bf16(av, b1, a1, 0, 0, 0); }
        const float bias0 = bf[i16], bias1 = bb[i16];
#pragma unroll
        for (int r = 0; r < 4; ++r) { dt[(t0 + 4 * g + r) * 32 + i16] = softplus_f(a0[r] + bias0); dt[(t0 + 4 * g + r) * 32 + 16 + i16] = softplus_f(a1[r] + bias1); }
    }
}

__device__ __forceinline__ void p_conv(const Ctx& C, const bf16_t* xbc, bf16_t* xc) {
    const float* cw = C.in[6]; const float* cb = C.in[7];
    const int gt = C.bid * NTHR + C.tid, NT = C.G * NTHR;
    for (int i = gt; i < (T / 8) * 256; i += NT) {
        const int cg = i & 255, run = i >> 8, t0 = run * 8, l0 = t0 & (SEQ - 1), ch = cg * 8;
        float w[5][8], acc[8][8];
#pragma unroll
        for (int j = 0; j < 5; ++j) { const f32x4 w0 = *(const f32x4*)(cw + j * 2048 + ch), w1 = *(const f32x4*)(cw + j * 2048 + ch + 4);
            w[j][0] = w0.x; w[j][1] = w0.y; w[j][2] = w0.z; w[j][3] = w0.w; w[j][4] = w1.x; w[j][5] = w1.y; w[j][6] = w1.z; w[j][7] = w1.w; }
        { const f32x4 b0 = *(const f32x4*)(cb + ch), b1 = *(const f32x4*)(cb + ch + 4);
#pragma unroll
          for (int o = 0; o < 8; ++o) { acc[o][0] = b0.x; acc[o][1] = b0.y; acc[o][2] = b0.z; acc[o][3] = b0.w; acc[o][4] = b1.x; acc[o][5] = b1.y; acc[o][6] = b1.z; acc[o][7] = b1.w; } }
        u32x4 rw[12];
#pragma unroll
        for (int rr = 0; rr < 12; ++rr) { const int ll = l0 + rr - 2; rw[rr] = (u32x4){0u, 0u, 0u, 0u};
            if (ll >= 0 && ll < SEQ) rw[rr] = *(const u32x4*)(xbc + (size_t)(t0 + rr - 2) * 2048 + ch); }
#pragma unroll
        for (int rr = 0; rr < 12; ++rr) {
            const float x[8] = {bflo(rw[rr].x), bfhi(rw[rr].x), bflo(rw[rr].y), bfhi(rw[rr].y), bflo(rw[rr].z), bfhi(rw[rr].z), bflo(rw[rr].w), bfhi(rw[rr].w)};
#pragma unroll
            for (int j = 0; j < 5; ++j) { const int o = rr - j; if (o >= 0 && o < 8) {
#pragma unroll
                for (int q = 0; q < 8; ++q) acc[o][q] += w[j][q] * x[q]; } }
        }
#pragma unroll
        for (int o = 0; o < 8; ++o) { u32x4 ov; ov.x = pk2(silu_f(acc[o][0]), silu_f(acc[o][1])); ov.y = pk2(silu_f(acc[o][2]), silu_f(acc[o][3])); ov.z = pk2(silu_f(acc[o][4]), silu_f(acc[o][5])); ov.w = pk2(silu_f(acc[o][6]), silu_f(acc[o][7]));
            st_wt16(xc + (size_t)(t0 + o) * 2048 + ch, ov); }
    }
}

namespace ssd {
typedef short bf16x8 __attribute__((ext_vector_type(8)));
typedef short s16x4 __attribute__((ext_vector_type(4)));
constexpr int RS = 272, RSX = 144;
constexpr int CN = 0, BN = 34816, BS = 69632, SL = 104448, SLB = 17408, XN = 139264, CSB = 157696;
__device__ __forceinline__ unsigned pkbf(float lo, float hi) { return pk2(lo, hi); }
__device__ __forceinline__ bf16x8 trfrag_p(LAS unsigned char* base, int stride, int ks, int c, int g, int q, int pp) {
    LAS unsigned char* a0 = base + (32 * ks + 4 * g + q) * stride + 32 * c + 8 * pp;
    const s16x4 v0 = __builtin_amdgcn_ds_read_tr16_b64_v4i16((LAS s16x4*)a0);
    const s16x4 v1 = __builtin_amdgcn_ds_read_tr16_b64_v4i16((LAS s16x4*)(a0 + 16 * stride));
    bf16x8 r; r[0] = v0[0]; r[1] = v0[1]; r[2] = v0[2]; r[3] = v0[3]; r[4] = v1[0]; r[5] = v1[1]; r[6] = v1[2]; r[7] = v1[3]; return r;
}
}
__device__ __forceinline__ void p_ssd(const Ctx& C, const bf16_t* xc, const float* dtb, bf16_t* yf, bf16_t* yb) {
    using namespace ssd;
    LAS unsigned char* L = C.lds;
    const int tid = C.tid, lane = C.lane, w = C.wave, g = lane >> 4, i16 = lane & 15, q = (lane >> 2) & 3, pp = lane & 3;
    for (int unit = C.bid; unit < 256; unit += C.G) {
        const int dir = unit & 1, hd = (unit >> 1) & 15, b = unit >> 5, grp = hd >> 2;
        const float a = -__expf((dir ? C.in[11] : C.in[10])[hd]);
        const float dsk = dir ? 0.f : C.in[12][hd];
        bf16_t* yout = dir ? yb : yf;
        f32x4 sacc[4];
#pragma unroll
        for (int pt = 0; pt < 4; ++pt) sacc[pt] = (f32x4){0.f, 0.f, 0.f, 0.f};
        __syncthreads();
        for (int i = tid; i < 2 * SLB / 4; i += NTHR) ((LAS unsigned*)(L + SL))[i] = 0u;
        u32x4 pfC[4], pfB[4], pfX[2]; float pfd0 = 0.f, pfd1 = 0.f;
#define SSD_ISSUE(ci_) do { const int c_ = dir ? (31 - (ci_)) : (ci_); const size_t t0_ = (size_t)b * SEQ + (size_t)c_ * 128; \
            _Pragma("unroll") for (int i_ = 0; i_ < 4; ++i_) { const int idx_ = tid + NTHR * i_, l_ = idx_ >> 4, cc_ = idx_ & 15; const bf16_t* rp_ = xc + (t0_ + l_) * 2048 + grp * 128 + cc_ * 8; \
                pfB[i_] = *(const u32x4*)(rp_ + 1024); pfC[i_] = *(const u32x4*)(rp_ + 1536); } \
            _Pragma("unroll") for (int i_ = 0; i_ < 2; ++i_) { const int idx_ = tid + NTHR * i_, l_ = idx_ >> 3, cc_ = idx_ & 7; pfX[i_] = *(const u32x4*)(xc + (t0_ + l_) * 2048 + hd * 64 + cc_ * 8); } \
            if (w == 0) { const int l0_ = dir ? (127 - 2 * lane) : (2 * lane), l1_ = dir ? (126 - 2 * lane) : (2 * lane + 1); \
                pfd0 = dtb[(t0_ + l0_) * 32 + dir * 16 + hd]; pfd1 = dtb[(t0_ + l1_) * 32 + dir * 16 + hd]; } } while (0)
#define SSD_SCAN(buf_) do { if (w == 0) { const float da0_ = pfd0 * a, da1_ = pfd1 * a; const float p1_ = da0_ + da1_; float s_ = p1_; \
            s_ += __int_as_float(__builtin_amdgcn_update_dpp(0, __float_as_int(s_), 0x111, 0xF, 0xF, false)); s_ += __int_as_float(__builtin_amdgcn_update_dpp(0, __float_as_int(s_), 0x112, 0xF, 0xF, false)); \
            s_ += __int_as_float(__builtin_amdgcn_update_dpp(0, __float_as_int(s_), 0x114, 0xF, 0xF, false)); s_ += __int_as_float(__builtin_amdgcn_update_dpp(0, __float_as_int(s_), 0x118, 0xF, 0xF, false)); \
            s_ += __int_as_float(__builtin_amdgcn_update_dpp(0, __float_as_int(s_), 0x142, 0xA, 0xF, false)); s_ += __int_as_float(__builtin_amdgcn_update_dpp(0, __float_as_int(s_), 0x143, 0xC, 0xF, false)); \
            const float ex_ = s_ - p1_, cs0_ = ex_ + da0_, cs1_ = ex_ + p1_, tot_ = __int_as_float(__builtin_amdgcn_readlane(__float_as_int(s_), 63)); \
            const int l0_ = dir ? (127 - 2 * lane) : (2 * lane), l1_ = dir ? (126 - 2 * lane) : (2 * lane + 1); \
            LAS float* cb_ = (LAS float*)(L + CSB + (buf_) * 1536); \
            cb_[l0_] = cs0_; cb_[l1_] = cs1_; cb_[128 + l0_] = pfd0; cb_[128 + l1_] = pfd1; cb_[256 + l0_] = pfd0 * __expf(tot_ - cs0_); cb_[256 + l1_] = pfd1 * __expf(tot_ - cs1_); \
            if (lane == 0) *(LAS float*)(L + CSB + 3072 + 8 * (buf_)) = tot_; } } while (0)
#define SSD_WRITE(buf_) do { const LAS float* dw_ = (const LAS float*)(L + CSB + (buf_) * 1536 + 1024); float scv_[4]; \
            _Pragma("unroll") for (int i_ = 0; i_ < 4; ++i_) scv_[i_] = dw_[(tid + NTHR * i_) >> 4]; \
            _Pragma("unroll") for (int i_ = 0; i_ < 4; ++i_) { const int idx_ = tid + NTHR * i_, l_ = idx_ >> 4, cc_ = idx_ & 15; \
                *(LAS u32x4*)(L + CN + l_ * RS + cc_ * 16) = pfC[i_]; *(LAS u32x4*)(L + BN + l_ * RS + cc_ * 16) = pfB[i_]; \
                const float sc_ = scv_[i_]; const u32x4 v_ = pfB[i_]; u32x4 o_; \
                o_.x = pkbf(bflo(v_.x) * sc_, bfhi(v_.x) * sc_); o_.y = pkbf(bflo(v_.y) * sc_, bfhi(v_.y) * sc_); o_.z = pkbf(bflo(v_.z) * sc_, bfhi(v_.z) * sc_); o_.w = pkbf(bflo(v_.w) * sc_, bfhi(v_.w) * sc_); \
                *(LAS u32x4*)(L + BS + l_ * RS + cc_ * 16) = o_; } \
            _Pragma("unroll") for (int i_ = 0; i_ < 2; ++i_) { const int idx_ = tid + NTHR * i_, l_ = idx_ >> 3, cc_ = idx_ & 7; *(LAS u32x4*)(L + XN + l_ * RSX + cc_ * 16) = pfX[i_]; } } while (0)
        SSD_ISSUE(0);
        SSD_SCAN(0);
        __syncthreads();
        SSD_WRITE(0);
        __syncthreads();
        for (int ci = 0; ci < 32; ++ci) {
            const int buf = ci & 1;
            const int c = dir ? (31 - ci) : ci; const size_t t0 = (size_t)b * SEQ + (size_t)c * 128;
            if (ci + 1 < 32) SSD_ISSUE(ci + 1);
            const LAS float* csb = (const LAS float*)(L + CSB + buf * 1536);
            const float cs_l = csb[16 * w + i16];
            const float cs_end = *(const LAS float*)(L + CSB + 3072 + 8 * buf);
            bf16x8 cfrag[4];
#pragma unroll
            for (int ks = 0; ks < 4; ++ks) cfrag[ks] = *(const LAS bf16x8*)(L + CN + (16 * w + i16) * RS + ks * 64 + g * 16);
            u32x2 mreg[8];
            const int lrow = 16 * w + i16;
            bf16x8 afb[2][4]; f32x4 csv[2], dtv[2];
#define SSD_LD1(st_, bb_) do { _Pragma("unroll") for (int ks = 0; ks < 4; ++ks) afb[bb_][ks] = *(const LAS bf16x8*)(L + BN + (16 * (st_) + i16) * RS + ks * 64 + g * 16); \
                csv[bb_] = *(const LAS f32x4*)(csb + 16 * (st_) + 4 * g); dtv[bb_] = *(const LAS f32x4*)(csb + 128 + 16 * (st_) + 4 * g); } while (0)
            SSD_LD1(0, 0);
#pragma unroll
            for (int st = 0; st < 8; ++st) {
                if (st < 7) SSD_LD1(st + 1, (st + 1) & 1);
                asm volatile("" ::: "memory");
                f32x4 acc = (f32x4){0.f, 0.f, 0.f, 0.f};
#pragma unroll
                for (int ks = 0; ks < 4; ++ks) acc = __builtin_amdgcn_mfma_f32_16x16x32_bf16(afb[st & 1][ks], cfrag[ks], acc, 0, 0, 0);
                const f32x4 cs_s = csv[st & 1], dt_s = dtv[st & 1];
                float mv[4];
#pragma unroll
                for (int r = 0; r < 4; ++r) { const int srow = 16 * st + 4 * g + r; const bool valid = dir ? (srow >= lrow) : (srow <= lrow);
                    const float e = valid ? __expf(cs_l - cs_s[r]) : 0.f; mv[r] = acc[r] * dt_s[r] * e; }
                mreg[st].x = pkbf(mv[0], mv[1]); mreg[st].y = pkbf(mv[2], mv[3]);
            }
#undef SSD_LD1
            f32x4 yacc[4];
            const float el = __expf(cs_l);
#pragma unroll
            for (int ph = 0; ph < 2; ++ph) { bf16x8 sf[2][4];
#pragma unroll
                for (int pi = 0; pi < 2; ++pi)
#pragma unroll
                    for (int ks = 0; ks < 4; ++ks) sf[pi][ks] = *(const LAS bf16x8*)(L + SL + buf * SLB + (16 * (2 * ph + pi) + i16) * RS + ks * 64 + g * 16);
                asm volatile("" ::: "memory");
#pragma unroll
                for (int pi = 0; pi < 2; ++pi) { f32x4 acc = (f32x4){0.f, 0.f, 0.f, 0.f};
#pragma unroll
                    for (int ks = 0; ks < 4; ++ks) acc = __builtin_amdgcn_mfma_f32_16x16x32_bf16(sf[pi][ks], cfrag[ks], acc, 0, 0, 0);
                    yacc[2 * ph + pi] = acc * el; } }
            bf16x8 xfa[4][4], bfa[4];
#pragma unroll
            for (int ks = 0; ks < 4; ++ks)
#pragma unroll
                for (int pt = 0; pt < 4; ++pt) xfa[ks][pt] = trfrag_p(L + XN, RSX, ks, pt, g, q, pp);
#pragma unroll
            for (int ks = 0; ks < 4; ++ks) bfa[ks] = trfrag_p(L + BS, RS, ks, w, g, q, pp);
            asm volatile("" ::: "memory");
#pragma unroll
            for (int ks = 0; ks < 4; ++ks) { u32x4 mw; mw.x = mreg[2 * ks].x; mw.y = mreg[2 * ks].y; mw.z = mreg[2 * ks + 1].x; mw.w = mreg[2 * ks + 1].y;
                const bf16x8 mf = __builtin_bit_cast(bf16x8, mw);
#pragma unroll
                for (int pt = 0; pt < 4; ++pt) yacc[pt] = __builtin_amdgcn_mfma_f32_16x16x32_bf16(xfa[ks][pt], mf, yacc[pt], 0, 0, 0); }
            u32x2 xvv[4];
#pragma unroll
            for (int pt = 0; pt < 4; ++pt) xvv[pt] = *(const LAS u32x2*)(L + XN + lrow * RSX + (16 * pt + 4 * g) * 2);
            asm volatile("" ::: "memory");
#pragma unroll
            for (int pt = 0; pt < 4; ++pt) { const u32x2 xv = xvv[pt];
                u32x2 o; o.x = pkbf(yacc[pt][0] + dsk * bflo(xv.x), yacc[pt][1] + dsk * bfhi(xv.x)); o.y = pkbf(yacc[pt][2] + dsk * bflo(xv.y), yacc[pt][3] + dsk * bfhi(xv.y));
                *(u32x2*)(yout + (t0 + lrow) * 1024 + hd * 64 + 16 * pt + 4 * g) = o; }
            { const float dec = __expf(cs_end);
#pragma unroll
              for (int pt = 0; pt < 4; ++pt) sacc[pt] = sacc[pt] * dec; }
#pragma unroll
            for (int ks = 0; ks < 4; ++ks)
#pragma unroll
                for (int pt = 0; pt < 4; ++pt) sacc[pt] = __builtin_amdgcn_mfma_f32_16x16x32_bf16(bfa[ks], xfa[ks][pt], sacc[pt], 0, 0, 0);
#pragma unroll
            for (int pt = 0; pt < 4; ++pt) { u32x2 o; o.x = pkbf(sacc[pt][0], sacc[pt][1]); o.y = pkbf(sacc[pt][2], sacc[pt][3]);
                *(LAS u32x2*)(L + SL + (buf ^ 1) * SLB + (16 * pt + i16) * RS + (16 * w + 4 * g) * 2) = o; }
            if (ci + 1 < 32) SSD_SCAN(buf ^ 1);
            __syncthreads();
            if (ci + 1 < 32) SSD_WRITE(buf ^ 1);
            __syncthreads();
        }
#undef SSD_ISSUE
#undef SSD_SCAN
#undef SSD_WRITE
    }
}

namespace nat {
typedef short bf16x8 __attribute__((ext_vector_type(8)));
typedef short s16x4 __attribute__((ext_vector_type(4)));
constexpr int VH = 73728, RPB = 147456;
__device__ __forceinline__ int voff(int ks, int d) { return ks * 128 + ((((d >> 3) ^ (ks & 7))) << 4) + (d & 7) * 2; }
__device__ __forceinline__ int clampi(int x, int lo, int hi) { return x < lo ? lo : (x > hi ? hi : x); }
}
__device__ __forceinline__ void p_na(const Ctx& C, bf16_t* q, const bf16_t* k, const bf16_t* v) {
    using namespace nat;
    LAS unsigned char* L = C.lds;
    const float* rpb = C.in[15];
    const int tid = C.tid, lane = C.lane, w = C.wave, g = lane >> 4, i16 = lane & 15, qq = (lane >> 2) & 3, pp = lane & 3;
    const int hl = w >> 2, m = w & 3;
    const int bs = (m == 0) ? 0 : (m == 1) ? 8 : (m == 2) ? 24 : 32;
    const int qc = 16 * m + i16, wsx = clampi(qc - 8, 0, 48);
    float madd[8]; int dcol[8];
#pragma unroll
    for (int c = 0; c < 8; ++c) { const int kc = bs + (c >> 2) * 16 + 4 * g + (c & 3); madd[c] = (kc >= wsx && kc < wsx + 16) ? 0.f : -1.0e30f; dcol[c] = clampi(kc - qc + 15, 0, 30); }
    for (int unit = C.bid; unit < 256; unit += C.G) {
        const int rseg = unit & 3, hp = (unit >> 2) & 7, b = unit >> 5, h = 2 * hp + hl;
        __syncthreads();
        for (int i = tid; i < 930; i += NTHR) ((LAS float*)(L + RPB))[i] = rpb[(2 * hp) * 465 + i];
#define NA_LOAD_ROW(row_) do { _Pragma("unroll") for (int i_ = 0; i_ < 2; ++i_) { const int idx_ = tid + NTHR * i_, hl_ = idx_ >> 9, col_ = (idx_ >> 3) & 63, dch_ = idx_ & 7; \
            const u32x4 val_ = *(const u32x4*)(v + ((size_t)b * SEQ + (size_t)(row_) * 64 + col_) * 1024 + (2 * hp + hl_) * 64 + dch_ * 8); \
            *(LAS u32x4*)(L + hl_ * VH + voff(((row_) % 9) * 64 + col_, dch_ * 8)) = val_; } } while (0)
#define NA_FETCH_ROW(row_) do { _Pragma("unroll") for (int i_ = 0; i_ < 2; ++i_) { const int idx_ = tid + NTHR * i_, hl_ = idx_ >> 9, col_ = (idx_ >> 3) & 63, dch_ = idx_ & 7; \
            vpre[i_] = *(const u32x4*)(v + ((size_t)b * SEQ + (size_t)(row_) * 64 + col_) * 1024 + (2 * hp + hl_) * 64 + dch_ * 8); } } while (0)
#define NA_STORE_ROW(row_) do { _Pragma("unroll") for (int i_ = 0; i_ < 2; ++i_) { const int idx_ = tid + NTHR * i_, hl_ = idx_ >> 9, col_ = (idx_ >> 3) & 63, dch_ = idx_ & 7; \
            *(LAS u32x4*)(L + hl_ * VH + voff(((row_) % 9) * 64 + col_, dch_ * 8)) = vpre[i_]; } } while (0)
        u32x4 vpre[2] = {(u32x4){0u, 0u, 0u, 0u}, (u32x4){0u, 0u, 0u, 0u}};
        const int r0 = 16 * rseg; const int rs0 = clampi(r0 - 4, 0, 56);
        for (int rr = 0; rr < 8; ++rr) NA_LOAD_ROW(rs0 + rr);
        int pending = -1;
        { const int rs1 = clampi(r0 - 3, 0, 56); if (rs1 != rs0) { NA_FETCH_ROW(rs1 + 7); pending = rs1 + 7; } }
        __syncthreads();
        const LAS float* rpbl = (const LAS float*)(L + RPB) + hl * 465;
        f32x4 bm[16]; int boff = -100;
        for (int s = 0; s < 16; ++s) {
            const int r = r0 + s, rs = clampi(r - 4, 0, 56);
            if (s > 0) __syncthreads();
            if (pending >= 0) { NA_STORE_ROW(pending); pending = -1; }
            if (s + 2 < 16) { const int rs1 = clampi(r - 3, 0, 56), rs2 = clampi(r - 2, 0, 56); if (rs2 != rs1) { NA_FETCH_ROW(rs2 + 7); pending = rs2 + 7; } }
            const size_t tokq = (size_t)b * SEQ + (size_t)r * 64 + qc;
            bf16x8 qf[2];
#pragma unroll
            for (int ks = 0; ks < 2; ++ks) qf[ks] = *(const bf16x8*)(q + tokq * 1024 + h * 64 + ks * 32 + g * 8);
            f32x4 sc[16];
#pragma unroll
            for (int kt = 0; kt < 16; ++kt) { const size_t tokk = (size_t)b * SEQ + (size_t)(rs + (kt >> 1)) * 64 + bs + (kt & 1) * 16 + i16;
                f32x4 acc = (f32x4){0.f, 0.f, 0.f, 0.f};
#pragma unroll
                for (int ks = 0; ks < 2; ++ks) { const bf16x8 kf = *(const bf16x8*)(k + tokk * 1024 + h * 64 + ks * 32 + g * 8); acc = __builtin_amdgcn_mfma_f32_16x16x32_bf16(kf, qf[ks], acc, 0, 0, 0); }
                sc[kt] = acc; }
            if (rs - r != boff) {
                boff = rs - r;
#pragma unroll
                for (int kt = 0; kt < 16; ++kt) { const int drow = boff + (kt >> 1) + 7;
#pragma unroll
                    for (int e = 0; e < 4; ++e) { const int c = (kt & 1) * 4 + e; bm[kt][e] = rpbl[drow * 31 + dcol[c]] * 1.44269504f + madd[c]; } } }
            float mx = -1.0e30f;
#pragma unroll
            for (int kt = 0; kt < 16; ++kt)
#pragma unroll
                for (int e = 0; e < 4; ++e) { const float val = sc[kt][e] + bm[kt][e]; sc[kt][e] = val; mx = fmaxf(mx, val); }
            mx = fmaxf(mx, __shfl_xor(mx, 16)); mx = fmaxf(mx, __shfl_xor(mx, 32));
            float sum = 0.f;
#pragma unroll
            for (int kt = 0; kt < 16; ++kt)
#pragma unroll
                for (int e = 0; e < 4; ++e) { const float p = __builtin_amdgcn_exp2f(sc[kt][e] - mx); sc[kt][e] = p; sum += p; }
            sum += __shfl_xor(sum, 16); sum += __shfl_xor(sum, 32);
            f32x4 o[4];
#pragma unroll
            for (int dt = 0; dt < 4; ++dt) o[dt] = (f32x4){0.f, 0.f, 0.f, 0.f};
#pragma unroll
            for (int kk = 0; kk < 8; ++kk) {
                u32x4 pw; pw.x = pk2(sc[2 * kk][0], sc[2 * kk][1]); pw.y = pk2(sc[2 * kk][2], sc[2 * kk][3]); pw.z = pk2(sc[2 * kk + 1][0], sc[2 * kk + 1][1]); pw.w = pk2(sc[2 * kk + 1][2], sc[2 * kk + 1][3]);
                const bf16x8 pf = __builtin_bit_cast(bf16x8, pw);
                const int ks0 = ((rs + kk) % 9) * 64 + bs + 4 * g + qq, ks1 = ks0 + 16;
#pragma unroll
                for (int dt = 0; dt < 4; ++dt) {
                    const s16x4 v0 = __builtin_amdgcn_ds_read_tr16_b64_v4i16((LAS s16x4*)(L + hl * VH + voff(ks0, 16 * dt + 4 * pp)));
                    const s16x4 v1 = __builtin_amdgcn_ds_read_tr16_b64_v4i16((LAS s16x4*)(L + hl * VH + voff(ks1, 16 * dt + 4 * pp)));
                    bf16x8 vf; vf[0] = v0[0]; vf[1] = v0[1]; vf[2] = v0[2]; vf[3] = v0[3]; vf[4] = v1[0]; vf[5] = v1[1]; vf[6] = v1[2]; vf[7] = v1[3];
                    o[dt] = __builtin_amdgcn_mfma_f32_16x16x32_bf16(vf, pf, o[dt], 0, 0, 0); }
            }
            const float inv = 1.f / sum;
#pragma unroll
            for (int dt = 0; dt < 4; ++dt) { u32x2 ov; ov.x = pk2(o[dt][0] * inv, o[dt][1] * inv); ov.y = pk2(o[dt][2] * inv, o[dt][3] * inv);
                *(u32x2*)(q + tokq * 1024 + h * 64 + 16 * dt + 4 * g) = ov; }
        }
#undef NA_LOAD_ROW
#undef NA_FETCH_ROW
#undef NA_STORE_ROW
    }
    __syncthreads();
}

__device__ __forceinline__ void p_combine(const Ctx& C, const bf16_t* yf, const bf16_t* yb, bf16_t* szu, float* rstd) {
    const int gw = C.bid * NWAVES + C.wave, NGW = C.G * NWAVES;
    for (int row0 = gw * 2; row0 < T; row0 += NGW * 2) {
        u32x4 a[2][2], b[2][2], z[2][2];
#pragma unroll
        for (int r = 0; r < 2; ++r)
#pragma unroll
            for (int j = 0; j < 2; ++j) { const size_t off = (size_t)(row0 + r) * 1024 + j * 512 + C.lane * 8;
                a[r][j] = __builtin_nontemporal_load((const u32x4*)(yf + off)); b[r][j] = __builtin_nontemporal_load((const u32x4*)(yb + off)); z[r][j] = __builtin_nontemporal_load((const u32x4*)(szu + off)); }
#pragma unroll
        for (int r = 0; r < 2; ++r) { float s = 0.f; u32x4 outv[2];
#pragma unroll
            for (int j = 0; j < 2; ++j) { const u32x4 av = a[r][j], bv = b[r][j], zv = z[r][j]; float u[8];
                u[0] = (bflo(av.x) + bflo(bv.x)) * bflo(zv.x); u[1] = (bfhi(av.x) + bfhi(bv.x)) * bfhi(zv.x);
                u[2] = (bflo(av.y) + bflo(bv.y)) * bflo(zv.y); u[3] = (bfhi(av.y) + bfhi(bv.y)) * bfhi(zv.y);
                u[4] = (bflo(av.z) + bflo(bv.z)) * bflo(zv.z); u[5] = (bfhi(av.z) + bfhi(bv.z)) * bfhi(zv.z);
                u[6] = (bflo(av.w) + bflo(bv.w)) * bflo(zv.w); u[7] = (bfhi(av.w) + bfhi(bv.w)) * bfhi(zv.w);
#pragma unroll
                for (int q = 0; q < 8; ++q) s += u[q] * u[q];
                outv[j].x = pk2(u[0], u[1]); outv[j].y = pk2(u[2], u[3]); outv[j].z = pk2(u[4], u[5]); outv[j].w = pk2(u[6], u[7]); }
            s = wave_sum(s);
#pragma unroll
            for (int j = 0; j < 2; ++j) *(u32x4*)(szu + (size_t)(row0 + r) * 1024 + j * 512 + C.lane * 8) = outv[j];
            if (C.lane == 0) rstd[row0 + r] = rsqrtf(s * (1.f / 1024.f) + EPS); }
    }
}

__device__ __forceinline__ void p_cvt_tables8(const Ctx& C, unsigned char* u8, unsigned char* v8) {
    const int gt = C.bid * NTHR + C.tid, NT = C.G * NTHR;
    const float* u = C.in[21]; const float* v = C.in[22];
    constexpr int N4 = 16384 * 1024 / 4;
    for (int i0 = gt; i0 < N4; i0 += 4 * NT) {
        f32x4 a[4], b[4];
#pragma unroll
        for (int r = 0; r < 4; ++r) { const int i = i0 + r * NT; if (i < N4) { a[r] = __builtin_nontemporal_load((const f32x4*)(u + (size_t)i * 4)); b[r] = __builtin_nontemporal_load((const f32x4*)(v + (size_t)i * 4)); } }
#pragma unroll
        for (int r = 0; r < 4; ++r) { const int i = i0 + r * NT; if (i < N4) {
            const f32x4 av = a[r] * 256.f, bv = b[r] * 64.f; unsigned x = 0u, y = 0u;
            x = __builtin_amdgcn_cvt_pk_fp8_f32(av.x, av.y, x, false); x = __builtin_amdgcn_cvt_pk_fp8_f32(av.z, av.w, x, true);
            y = __builtin_amdgcn_cvt_pk_fp8_f32(bv.x, bv.y, y, false); y = __builtin_amdgcn_cvt_pk_fp8_f32(bv.z, bv.w, y, true);
            *(unsigned*)(u8 + (size_t)i * 4) = x; *(unsigned*)(v8 + (size_t)i * 4) = y; } }
    }
}

template <int CTRL> __device__ __forceinline__ float dppf(float x) { return __int_as_float(__builtin_amdgcn_update_dpp(0, __float_as_int(x), CTRL, 0xF, 0xF, false)); }
constexpr int DPP_HMIRROR = 0x141, DPP_XOR2 = 0x4E, DPP_XOR1 = 0xB1, DPP_ROR8 = 0x128;
__device__ __forceinline__ int idx16(const u32x4& a, const u32x4& b, int i) { const unsigned w = (i < 8 ? a : b)[(i & 7) >> 1]; return (int)((i & 1) ? (w >> 16) : (w & 0xffffu)); }
__device__ __forceinline__ int gslot(int R) { return 16 * (R & 7) + (R >> 3); }
#define GQ_DMA(tab_, qi_, mi_) do { const u32x2 iw_ = *(const LAS u32x2*)(meta + (mi_) * MSTRIDE + 32 * (lane >> 3) + 8 * (qi_)); \
        _Pragma("unroll") for (int k_ = 0; k_ < 4; ++k_) { const int kk_ = 4 * (qi_) + k_, R_ = 8 * kk_ + (lane >> 3); \
            const unsigned e_ = (k_ & 1) ? ((k_ < 2 ? iw_.x : iw_.y) >> 16) : ((k_ < 2 ? iw_.x : iw_.y) & 0xffffu); \
            const unsigned char* src_ = (tab_) + (size_t)e_ * 1024 + 128 * j + 16 * ((lane & 7) ^ ((R_ >> 1) & 7)); \
            __builtin_amdgcn_global_load_lds((const unsigned*)src_, (LAS unsigned*)(img + kk_ * 1024), 16, 0, 0); } } while (0)
#define GQ_IW(qi_, mi_) (*(const LAS u32x2*)(meta + (mi_) * MSTRIDE + 32 * (lane >> 3) + 8 * (qi_)))
#define GQ_DMAW(tab_, qi_, iw_) do { _Pragma("unroll") for (int k_ = 0; k_ < 4; ++k_) { const int kk_ = 4 * (qi_) + k_, R_ = 8 * kk_ + (lane >> 3); \
            const unsigned e_ = (k_ & 1) ? ((k_ < 2 ? (iw_).x : (iw_).y) >> 16) : ((k_ < 2 ? (iw_).x : (iw_).y) & 0xffffu); \
            const unsigned char* src_ = (tab_) + (size_t)e_ * 1024 + 128 * j + 16 * ((lane & 7) ^ ((R_ >> 1) & 7)); \
            __builtin_amdgcn_global_load_lds((const unsigned*)src_, (LAS unsigned*)(img + kk_ * 1024), 16, 0, 0); } } while (0)
#define GQ_WAIT(n_) asm volatile("s_waitcnt vmcnt(" #n_ ")" ::: "memory")
#define GQ_LWAIT() asm volatile("s_waitcnt lgkmcnt(0)" ::: "memory")
__device__ __forceinline__ void p_gu(const Ctx& C, const bf16_t* n2, const unsigned short* pidx, const unsigned char* u8, float* pd) {
    const int j = C.bid & 7, nsl = C.G >> 3, NW = nsl * NWAVES, wsl = (C.bid >> 3) * NWAVES + C.wave, lane = C.lane, i16 = lane & 15, g = lane >> 4;
    if ((C.bid >> 3) >= nsl) return;
    constexpr int MSTRIDE = 512;
    LAS unsigned char* img = C.lds + 16384 + C.wave * 16384;
    LAS unsigned char* meta = C.lds + 4096 + C.wave * (3 * MSTRIDE);
    LAS unsigned char* xq = C.lds + C.wave * 256;
#define GU_META(t_, mi_) do { const int tt_ = (t_) < T ? (t_) : wsl; \
        __builtin_amdgcn_global_load_lds((const unsigned*)((const unsigned char*)(pidx + (size_t)tt_ * 128) + 4 * lane), (LAS unsigned*)(meta + (mi_) * MSTRIDE), 4, 0, 0); \
        __builtin_amdgcn_global_load_lds((const unsigned*)((const unsigned char*)(n2 + (size_t)tt_ * 1024 + 128 * j) + 4 * lane), (LAS unsigned*)(meta + (mi_) * MSTRIDE + 256), 4, 0, 0); } while (0)
    GU_META(wsl, 0); GU_META(wsl + NW, 1);
    GQ_WAIT(0);
    GQ_DMA(u8, 0, 0); GQ_DMA(u8, 1, 0); GQ_DMA(u8, 2, 0); GQ_DMA(u8, 3, 0);
    GQ_WAIT(0);
    int mi = 0;
    for (int t = wsl; t < T; t += NW) {
        const int mi1 = mi == 2 ? 0 : mi + 1, mi2 = mi1 == 2 ? 0 : mi1 + 1;
        GU_META(t + 2 * NW, mi2);
        { const unsigned xcur = *(const LAS unsigned*)(meta + mi * MSTRIDE + 256 + 4 * lane);
          const float x0 = bflo(xcur) * 16.f, x1 = bfhi(xcur) * 16.f;
          const unsigned hw = __builtin_amdgcn_cvt_pk_fp8_f32(x0, x1, 0u, false);
          const f32x2_t h01 = __builtin_amdgcn_cvt_pk_f32_fp8(hw, false);
          const unsigned lw = __builtin_amdgcn_cvt_pk_fp8_f32((x0 - h01.x) * 16.f, (x1 - h01.y) * 16.f, 0u, false);
          *(LAS unsigned short*)(xq + 2 * lane) = (unsigned short)(hw & 0xffffu); *(LAS unsigned short*)(xq + 128 + 2 * lane) = (unsigned short)(lw & 0xffffu); }
        GQ_LWAIT();
        long bq[4];
#pragma unroll
        for (int ks = 0; ks < 4; ++ks) bq[ks] = *(const LAS long*)(xq + (i16 & 1) * 128 + 32 * ks + 8 * g);
        f32x4 o[8]; u32x2 iw[4];
#pragma unroll
        for (int qi = 0; qi < 4; ++qi) {
            GQ_WAIT(18);
            if (qi == 0) {
#pragma unroll
                for (int q2 = 0; q2 < 4; ++q2) iw[q2] = GQ_IW(q2, mi1); }
#pragma unroll
            for (int tl = 2 * qi; tl < 2 * qi + 2; ++tl) { const int R = 16 * tl + i16; f32x4 acc = (f32x4){0.f, 0.f, 0.f, 0.f};
#pragma unroll
                for (int ks = 0; ks < 4; ++ks) { const int sc = 2 * ks + (g >> 1);
                    const long av = *(const LAS long*)(img + R * 128 + ((sc ^ ((R >> 1) & 7)) << 4) + 8 * (g & 1));
                    acc = __builtin_amdgcn_mfma_f32_16x16x32_fp8_fp8(av, bq[ks], acc, 0, 0, 0); }
#pragma unroll
                for (int r = 0; r < 4; ++r) o[tl][r] = (acc[r] + dppf<DPP_XOR1>(acc[r]) * 0.0625f) * (1.f / 4096.f); }
            GQ_LWAIT();
            GQ_DMAW(u8, qi, iw[qi]);
        }
#pragma unroll
        for (int k4 = 0; k4 < 4; ++k4) { if (i16 == 0) { u32x4 w; w.x = pk2(o[2 * k4][0], o[2 * k4][1]); w.y = pk2(o[2 * k4][2], o[2 * k4][3]); w.z = pk2(o[2 * k4 + 1][0], o[2 * k4 + 1][1]); w.w = pk2(o[2 * k4 + 1][2], o[2 * k4 + 1][3]);
            *(u32x4*)((bf16_t*)pd + ((size_t)j * T + t) * 128 + 32 * g + 8 * k4) = w; } }
        mi = mi1;
    }
    GQ_WAIT(0);
#undef GU_META
}
__device__ __forceinline__ void p_gc(const Ctx& C, const float* pd, const float* pgate, float* cc) {
    const int gt = C.bid * NTHR + C.tid, NT = C.G * NTHR; const bf16_t* pb = (const bf16_t*)pd;
    for (int i = gt; i < T * 32; i += NT) {
        f32x4 sdot = (f32x4){0.f, 0.f, 0.f, 0.f};
#pragma unroll
        for (int j = 0; j < 8; ++j) { const u32x2 w = *(const u32x2*)(pb + (size_t)j * T * 128 + (size_t)i * 4); sdot.x += bflo(w.x); sdot.y += bfhi(w.x); sdot.z += bflo(w.y); sdot.w += bfhi(w.y); }
        const int t_ = i >> 5, q = i & 31, R0 = 16 * (q & 7) + 4 * (q >> 3); const float* gp = pgate + (size_t)t_ * 128;
        f32x4 gv; gv.x = gp[gslot(R0)]; gv.y = gp[gslot(R0 + 1)]; gv.z = gp[gslot(R0 + 2)]; gv.w = gp[gslot(R0 + 3)];
        f32x4 o; o.x = gelu_f(sdot.x) * gv.x; o.y = gelu_f(sdot.y) * gv.y; o.z = gelu_f(sdot.z) * gv.z; o.w = gelu_f(sdot.w) * gv.w;
        *(f32x4*)(cc + (size_t)t_ * 128 + R0) = o; }
}
__device__ __forceinline__ void p_gv(const Ctx& C, const float* cc, const unsigned short* pidx, const unsigned char* v8, bf16_t* op) {
    typedef int i32x2 __attribute__((ext_vector_type(2)));
    const int j = C.bid & 7, nsl = C.G >> 3, NW = nsl * NWAVES, wsl = (C.bid >> 3) * NWAVES + C.wave, lane = C.lane, i16 = lane & 15, g = lane >> 4;
    if ((C.bid >> 3) >= nsl) return;
    constexpr int MSTRIDE = 768;
    LAS unsigned char* img = C.lds + 24576 + C.wave * 16384;
    LAS unsigned char* meta = C.lds + 4096 + C.wave * (3 * MSTRIDE);
    LAS unsigned char* cq = C.lds + C.wave * 256;
    const int tr_r = i16 >> 1, tr_c = i16 & 1;
    unsigned toff[8];
#pragma unroll
    for (int ct = 0; ct < 8; ++ct) toff[ct] = (unsigned)((ct ^ ((4 * g + (tr_r >> 1)) & 7)) << 4);
#define GV_META(t_, mi_) do { const int tt_ = (t_) < T ? (t_) : wsl; \
        __builtin_amdgcn_global_load_lds((const unsigned*)((const unsigned char*)(pidx + (size_t)tt_ * 128) + 4 * lane), (LAS unsigned*)(meta + (mi_) * MSTRIDE), 4, 0, 0); \
        __builtin_amdgcn_global_load_lds((const unsigned*)(cc + (size_t)tt_ * 128 + lane), (LAS unsigned*)(meta + (mi_) * MSTRIDE + 256), 4, 0, 0); \
        __builtin_amdgcn_global_load_lds((const unsigned*)(cc + (size_t)tt_ * 128 + 64 + lane), (LAS unsigned*)(meta + (mi_) * MSTRIDE + 512), 4, 0, 0); } while (0)
    GV_META(wsl, 0); GV_META(wsl + NW, 1);
    GQ_WAIT(0);
    GQ_DMA(v8, 0, 0); GQ_DMA(v8, 1, 0); GQ_DMA(v8, 2, 0); GQ_DMA(v8, 3, 0);
    GQ_WAIT(0);
    int mi = 0;
    for (int t = wsl; t < T; t += NW) {
        const int mi1 = mi == 2 ? 0 : mi + 1, mi2 = mi1 == 2 ? 0 : mi1 + 1;
        GV_META(t + 2 * NW, mi2);
        { const f32x2_t ccur = *(const LAS f32x2_t*)(meta + mi * MSTRIDE + 256 + 8 * lane);
          const float c0 = __builtin_fminf(__builtin_fmaxf(ccur.x * 64.f, -440.f), 440.f), c1 = __builtin_fminf(__builtin_fmaxf(ccur.y * 64.f, -440.f), 440.f);
          const unsigned hw = __builtin_amdgcn_cvt_pk_fp8_f32(c0, c1, 0u, false);
          const f32x2_t h01 = __builtin_amdgcn_cvt_pk_f32_fp8(hw, false);
          const unsigned lw = __builtin_amdgcn_cvt_pk_fp8_f32((c0 - h01.x) * 16.f, (c1 - h01.y) * 16.f, 0u, false);
          *(LAS unsigned short*)(cq + 2 * lane) = (unsigned short)(hw & 0xffffu); *(LAS unsigned short*)(cq + 128 + 2 * lane) = (unsigned short)(lw & 0xffffu); }
        GQ_LWAIT();
        long aq[4];
#pragma unroll
        for (int ks = 0; ks < 4; ++ks) aq[ks] = *(const LAS long*)(cq + (i16 & 1) * 128 + 32 * ks + 8 * g);
        f32x4 acc[8]; u32x2 iw[4];
#pragma unroll
        for (int ct = 0; ct < 8; ++ct) acc[ct] = (f32x4){0.f, 0.f, 0.f, 0.f};
#pragma unroll
        for (int ks = 0; ks < 4; ++ks) {
            GQ_WAIT(23);
            if (ks == 0) {
#pragma unroll
                for (int q2 = 0; q2 < 4; ++q2) iw[q2] = GQ_IW(q2, mi1); }
            const unsigned rb = (unsigned)(size_t)(img + (32 * ks + 8 * g + tr_r) * 128 + 8 * tr_c);
            long b0, b1, b2, b3, b4, b5, b6, b7;
            asm volatile("ds_read_b64_tr_b8 %0, %8\n\tds_read_b64_tr_b8 %1, %9\n\tds_read_b64_tr_b8 %2, %10\n\tds_read_b64_tr_b8 %3, %11\n\t"
                         "ds_read_b64_tr_b8 %4, %12\n\tds_read_b64_tr_b8 %5, %13\n\tds_read_b64_tr_b8 %6, %14\n\tds_read_b64_tr_b8 %7, %15\n\ts_waitcnt lgkmcnt(0)"
                         : "=&v"(b0), "=&v"(b1), "=&v"(b2), "=&v"(b3), "=&v"(b4), "=&v"(b5), "=&v"(b6), "=&v"(b7)
                         : "v"(rb + toff[0]), "v"(rb + toff[1]), "v"(rb + toff[2]), "v"(rb + toff[3]), "v"(rb + toff[4]), "v"(rb + toff[5]), "v"(rb + toff[6]), "v"(rb + toff[7]) : "memory");
            acc[0] = __builtin_amdgcn_mfma_f32_16x16x32_fp8_fp8(aq[ks], b0, acc[0], 0, 0, 0); acc[1] = __builtin_amdgcn_mfma_f32_16x16x32_fp8_fp8(aq[ks], b1, acc[1], 0, 0, 0);
            acc[2] = __builtin_amdgcn_mfma_f32_16x16x32_fp8_fp8(aq[ks], b2, acc[2], 0, 0, 0); acc[3] = __builtin_amdgcn_mfma_f32_16x16x32_fp8_fp8(aq[ks], b3, acc[3], 0, 0, 0);
            acc[4] = __builtin_amdgcn_mfma_f32_16x16x32_fp8_fp8(aq[ks], b4, acc[4], 0, 0, 0); acc[5] = __builtin_amdgcn_mfma_f32_16x16x32_fp8_fp8(aq[ks], b5, acc[5], 0, 0, 0);
            acc[6] = __builtin_amdgcn_mfma_f32_16x16x32_fp8_fp8(aq[ks], b6, acc[6], 0, 0, 0); acc[7] = __builtin_amdgcn_mfma_f32_16x16x32_fp8_fp8(aq[ks], b7, acc[7], 0, 0, 0);
            GQ_DMAW(v8, ks, iw[ks]);
        }
#pragma unroll
        for (int ct = 0; ct < 8; ++ct) { if (g == 0) op[(size_t)t * 1024 + 128 * j + 16 * ct + i16] = (bf16_t)f2bf((acc[ct][0] + acc[ct][1] * 0.0625f) * (1.f / 4096.f)); }
        mi = mi1;
    }
    GQ_WAIT(0);
#undef GV_META
}
__device__ __forceinline__ void p_gf(const Ctx& C, const bf16_t* h, const bf16_t* op, float* out) {
    const float* mod = C.f32p(WS_MOD); const float* fg = C.in[23];
    const int gw = C.bid * NWAVES + C.wave, NGW = C.G * NWAVES, lane = C.lane;
    for (int t0 = gw * 2; t0 < T; t0 += NGW * 2) {
        const int b = t0 / SEQ;
        u32x2 ov[2][4], hw[2][4];
#pragma unroll
        for (int r = 0; r < 2; ++r)
#pragma unroll
            for (int d = 0; d < 4; ++d) { const size_t off = (size_t)(t0 + r) * 1024 + 256 * d + 4 * lane; ov[r][d] = __builtin_nontemporal_load((const u32x2*)(op + off)); hw[r][d] = __builtin_nontemporal_load((const u32x2*)(h + off)); }
        f32x4 mv[4], fv[4];
#pragma unroll
        for (int d = 0; d < 4; ++d) { mv[d] = *(const f32x4*)(mod + b * 6144 + 5120 + 256 * d + 4 * lane); fv[d] = *(const f32x4*)(fg + 256 * d + 4 * lane); }
#pragma unroll
        for (int r = 0; r < 2; ++r) { f32x4 hf[4]; float ss = 0.f;
#pragma unroll
            for (int d = 0; d < 4; ++d) { f32x4 hv, o4; hv.x = bflo(hw[r][d].x); hv.y = bfhi(hw[r][d].x); hv.z = bflo(hw[r][d].y); hv.w = bfhi(hw[r][d].y);
                o4.x = bflo(ov[r][d].x); o4.y = bfhi(ov[r][d].x); o4.z = bflo(ov[r][d].y); o4.w = bfhi(ov[r][d].y);
                hf[d] = hv + mv[d] * o4; ss += (hf[d].x * hf[d].x + hf[d].y * hf[d].y) + (hf[d].z * hf[d].z + hf[d].w * hf[d].w); }
            const float rstd = rsqrtf(wave_sum(ss) * (1.f / 1024.f) + EPS);
#pragma unroll
            for (int d = 0; d < 4; ++d) { const f32x4 ov_ = hf[d] * rstd * fv[d]; st_wt16(out + (size_t)(t0 + r) * 1024 + 256 * d + 4 * lane, __builtin_bit_cast(u32x4, ov_)); } }
    }
}

namespace pg8 {
#define PG8_LAS __attribute__((address_space(3)))
typedef unsigned short bf16_t;
typedef short bf16x8 __attribute__((ext_vector_type(8)));
typedef float f32x4 __attribute__((ext_vector_type(4)));
typedef unsigned u32x4 __attribute__((ext_vector_type(4)));
constexpr int BM = 256, BK = 64, HALF = 128, HTB = HALF * BK * 2  , STAGE_BYTES = 8 * HTB, NXCD = 8, WGM = 8;

__host__ __device__ __forceinline__ int lds_byte(int r, int c) { const int st = (r >> 4) * 2 + (c >> 5), rr = r & 15, cc = c & 31, ob = rr * 64 + cc * 2; return st * 1024 + (ob ^ (((ob >> 9) & 1) << 5)); }
__host__ __device__ __forceinline__ void stage_rc(int b, int& R, int& C) { const int st = b / 1024, sb = b % 1024, swz = sb ^ (((sb >> 9) & 1) << 5); R = (st >> 1) * 16 + swz / 64; C = (st & 1) * 32 + (swz % 64) / 2; }
__host__ __device__ __forceinline__ int perm32(int rho) { const int n = rho >> 4, i = rho & 15; return 8 * (i >> 2) + 4 * n + (i & 3); }

struct Unit { int pm, pn, kind; };
struct Gemm { const bf16_t* A; const bf16_t* Bt; int M, N, K; const bf16_t *A1, *B1, *A2, *B2, *A3, *B3; };

struct StaticOrder {
    static constexpr bool MULTI = false;
    int nM, nN, nwg, G, c;
    __host__ __device__ void init(int M, int N, int G_, int c_) { nM = M / BM; nN = N / BM; nwg = nM * nN; G = G_; c = c_; }
    __host__ __device__ bool next(int i, Unit& u) const {
        const long L = (long)i * G + c; if (L >= nwg) return false;
        int wgid = (int)L; { const int q = nwg / NXCD, r = nwg % NXCD, xcd = wgid % NXCD, off = wgid / NXCD; wgid = (xcd < r ? xcd * (q + 1) : r * (q + 1) + (xcd - r) * q) + off; }
        const int nig = WGM * nN, gid = wgid / nig, fm = gid * WGM, gsz = (nM - fm) < WGM ? (nM - fm) : WGM;
        u.pm = fm + ((wgid % nig) % gsz); u.pn = (wgid % nig) / gsz; u.kind = 0; return true;
    }
    __device__ __forceinline__ void a_ready(const Unit&) const {}
    __device__ __forceinline__ void done(const Unit&) const {}
};

struct MultiOrder {
    static constexpr bool MULTI = true;
    StaticOrder b; int nk;
    __host__ __device__ bool next(int i, Unit& u) const { if (!b.next(i / nk, u)) return false; u.kind = i % nk; return true; }
    __device__ __forceinline__ void a_ready(const Unit&) const {}
    __device__ __forceinline__ void done(const Unit&) const {}
};

__device__ __forceinline__ unsigned cvt_pk_bf16(float lo, float hi) { return ::pk2(lo, hi); }
__device__ __forceinline__ float e_silu(float x) { return x / (1.f + __expf(-x)); }
__device__ __forceinline__ float e_sigm(float x) { return 1.f / (1.f + __expf(-x)); }
__device__ __forceinline__ float e_lo(unsigned v) { return __uint_as_float(v << 16); }
__device__ __forceinline__ float e_hi(unsigned v) { return __uint_as_float(v & 0xffff0000u); }
__device__ __forceinline__ u32x4 pack8(const f32x4 v0, const f32x4 v1) { u32x4 w; w.x = cvt_pk_bf16(v0[0], v0[1]); w.y = cvt_pk_bf16(v0[2], v0[3]); w.z = cvt_pk_bf16(v1[0], v1[1]); w.w = cvt_pk_bf16(v1[2], v1[3]); return w; }

struct EpiInProj {
    static constexpr bool PERM = true, AFTER_DRAIN = false;
    bf16_t *sz, *xbc, *q, *k, *v;
    __device__ __forceinline__ void operator()(const f32x4 (&acc)[2][2][4][2], const Unit& u, int wr, int wc, int fr, int fq) const {
        const int pn = u.pn; bf16_t* base; int ldc = 1024, colt, mode = 0;
        if (pn < 4) { base = sz; colt = pn * 256; mode = 1; }
        else if (pn < 12) { base = xbc; ldc = 2048; colt = (pn - 4) * 256; }
        else if (pn < 16) { base = q; colt = (pn - 12) * 256; mode = 2; }
        else if (pn < 20) { base = k; colt = (pn - 16) * 256; }
        else { base = v; colt = (pn - 20) * 256; }
        const int row0 = u.pm * BM + wr * 64 + fr, col0 = colt + wc * 32 + 8 * fq;
#pragma unroll
        for (int ai = 0; ai < 2; ++ai)
#pragma unroll
            for (int m = 0; m < 4; ++m) { bf16_t* rowp = base + (size_t)(row0 + ai * HALF + m * 16) * ldc + col0;
#pragma unroll
                for (int bj = 0; bj < 2; ++bj) { f32x4 v0 = acc[ai][bj][m][0], v1 = acc[ai][bj][m][1];
                    if (mode == 1) {
#pragma unroll
                        for (int i = 0; i < 4; ++i) { v0[i] = e_silu(v0[i]); v1[i] = e_silu(v1[i]); } }
                    else if (mode == 2) { v0 = v0 * (0.125f * 1.44269504f); v1 = v1 * (0.125f * 1.44269504f); }
                    *(u32x4*)(rowp + bj * HALF) = pack8(v0, v1); } }
    }
};
__device__ __forceinline__ void ld8(u32x4 (&d)[8], unsigned lo, const char* b0, const char* b1, const char* b2, const char* b3, const char* b4, const char* b5, const char* b6, const char* b7) {
    asm volatile("s_nop 4\n\tglobal_load_dwordx4 %0, %8, %9\n\tglobal_load_dwordx4 %1, %8, %10\n\tglobal_load_dwordx4 %2, %8, %11\n\tglobal_load_dwordx4 %3, %8, %12\n\t"
                 "global_load_dwordx4 %4, %8, %13\n\tglobal_load_dwordx4 %5, %8, %14\n\tglobal_load_dwordx4 %6, %8, %15\n\tglobal_load_dwordx4 %7, %8, %16\n\ts_waitcnt vmcnt(0)"
                 : "=&v"(d[0]), "=&v"(d[1]), "=&v"(d[2]), "=&v"(d[3]), "=&v"(d[4]), "=&v"(d[5]), "=&v"(d[6]), "=&v"(d[7])
                 : "v"(lo), "s"(b0), "s"(b1), "s"(b2), "s"(b3), "s"(b4), "s"(b5), "s"(b6), "s"(b7) : "memory");
}
__device__ __forceinline__ void st16(char* base, unsigned lo, const u32x4 v) { asm volatile("s_nop 4\n\tglobal_store_dwordx4 %0, %1, %2\n\ts_nop 1" :: "v"(lo), "v"(v), "s"(base) : "memory"); }
struct EpiMix {
    static constexpr bool PERM = true, AFTER_DRAIN = false;
    bf16_t *sg1, *sg2, *mixed; const float* rstd;
    __device__ __forceinline__ bool operator()(f32x4 (&acc)[2][2][4][2], const Unit& u, int wr, int wc, int fr, int fq) const {
        const int kind = u.kind;
        const size_t tile0 = ((size_t)u.pm * BM * 1024 + (size_t)u.pn * BM) * 2;
        const unsigned lo = (unsigned)(((wr * 64 + fr) * 1024 + wc * 32 + 8 * fq) * 2);
        const unsigned lg = (unsigned)(((wr * 64 + fr) * 256 + wc * 32 + 8 * fq) * 2);
#define PIECE(ai_, m_, bj_) ((size_t)((((ai_) * HALF + (m_) * 16) * 1024 + (bj_) * HALF) * 2))
#define PIECEG(ai_, m_, bj_) ((size_t)((((ai_) * HALF + (m_) * 16) * 256 + (bj_) * HALF) * 2))
#define LD8(dst_, base_, ai_) ld8(dst_, lg, (base_) + PIECEG(ai_, 0, 0), (base_) + PIECEG(ai_, 0, 1), (base_) + PIECEG(ai_, 1, 0), (base_) + PIECEG(ai_, 1, 1), \
                                  (base_) + PIECEG(ai_, 2, 0), (base_) + PIECEG(ai_, 2, 1), (base_) + PIECEG(ai_, 3, 0), (base_) + PIECEG(ai_, 3, 1))
        const char* p1 = (const char*)sg1; const char* p2 = (const char*)sg2;
        char* dg = (char*)(kind == 0 ? sg1 : sg2); char* dm = (char*)mixed + tile0;
        float rs[2][4];
#pragma unroll
        for (int ai = 0; ai < 2; ++ai)
#pragma unroll
            for (int m = 0; m < 4; ++m) rs[ai][m] = 1.f;
        if (kind == 2) { const char* rb = (const char*)(rstd + u.pm * BM); const unsigned rl = (unsigned)((wr * 64 + fr) * 4);
            asm volatile("s_nop 4\n\tglobal_load_dword %0, %8, %9\n\tglobal_load_dword %1, %8, %10\n\tglobal_load_dword %2, %8, %11\n\tglobal_load_dword %3, %8, %12\n\t"
                         "global_load_dword %4, %8, %13\n\tglobal_load_dword %5, %8, %14\n\tglobal_load_dword %6, %8, %15\n\tglobal_load_dword %7, %8, %16\n\ts_waitcnt vmcnt(0)"
                         : "=&v"(rs[0][0]), "=&v"(rs[0][1]), "=&v"(rs[0][2]), "=&v"(rs[0][3]), "=&v"(rs[1][0]), "=&v"(rs[1][1]), "=&v"(rs[1][2]), "=&v"(rs[1][3])
                         : "v"(rl), "s"(rb), "s"(rb + 64), "s"(rb + 128), "s"(rb + 192), "s"(rb + 512), "s"(rb + 576), "s"(rb + 640), "s"(rb + 704) : "memory"); }
#pragma unroll
        for (int ai = 0; ai < 2; ++ai) {
            u32x4 ga[8], gb[8];
            if (kind == 2) { LD8(ga, p1, ai); LD8(gb, p2, ai); } else if (kind == 3) { LD8(gb, p2, ai); }
#pragma unroll
            for (int m = 0; m < 4; ++m) {
#pragma unroll
                for (int bj = 0; bj < 2; ++bj) { f32x4 v0 = acc[ai][bj][m][0], v1 = acc[ai][bj][m][1];
                    if (kind < 2) {
#pragma unroll
                        for (int i = 0; i < 4; ++i) { v0[i] = e_sigm(v0[i]); v1[i] = e_sigm(v1[i]); }
                        st16(dg + PIECEG(ai, m, bj), lg, pack8(v0, v1));
                    } else if (kind == 2) {
                        const u32x4 a = ga[2 * m + bj], b = gb[2 * m + bj]; const float r_ = rs[ai][m];
                        v0[0] *= r_ * e_lo(a.x) / fmaxf(e_lo(b.x), 1e-30f); v0[1] *= r_ * e_hi(a.x) / fmaxf(e_hi(b.x), 1e-30f); v0[2] *= r_ * e_lo(a.y) / fmaxf(e_lo(b.y), 1e-30f); v0[3] *= r_ * e_hi(a.y) / fmaxf(e_hi(b.y), 1e-30f);
                        v1[0] *= r_ * e_lo(a.z) / fmaxf(e_lo(b.z), 1e-30f); v1[1] *= r_ * e_hi(a.z) / fmaxf(e_hi(b.z), 1e-30f); v1[2] *= r_ * e_lo(a.w) / fmaxf(e_lo(b.w), 1e-30f); v1[3] *= r_ * e_hi(a.w) / fmaxf(e_hi(b.w), 1e-30f);
                        acc[ai][bj][m][0] = v0; acc[ai][bj][m][1] = v1;
                    } else {
                        const u32x4 b = gb[2 * m + bj];
                        v0[0] *= e_lo(b.x); v0[1] *= e_hi(b.x); v0[2] *= e_lo(b.y); v0[3] *= e_hi(b.y); v1[0] *= e_lo(b.z); v1[1] *= e_hi(b.z); v1[2] *= e_lo(b.w); v1[3] *= e_hi(b.w);
                        st16(dm + PIECE(ai, m, bj), lo, pack8(v0, v1));
                    } } }
        }
#undef LD8
#undef PIECE
#undef PIECEG
        return kind == 2;
    }
};
struct EpiD3 {
    static constexpr bool PERM = true, AFTER_DRAIN = false;
    bf16_t* h; const float* x; const float* mod;
    __device__ __forceinline__ void operator()(const f32x4 (&acc)[2][2][4][2], const Unit& u, int wr, int wc, int fr, int fq) const {
        const int row0 = u.pm * BM + wr * 64 + fr, col0 = u.pn * BM + wc * 32 + 8 * fq;
        const float* g1 = mod + (size_t)((u.pm * BM) >> 12) * 6144 + 2048;
#pragma unroll
        for (int ai = 0; ai < 2; ++ai)
#pragma unroll
            for (int m = 0; m < 4; ++m) { const size_t off = (size_t)(row0 + ai * HALF + m * 16) * 1024 + col0;
#pragma unroll
                for (int bj = 0; bj < 2; ++bj) { const int c = bj * HALF;
                    const f32x4 x0 = *(const f32x4*)(x + off + c), x1 = *(const f32x4*)(x + off + c + 4), g0 = *(const f32x4*)(g1 + col0 + c), g4 = *(const f32x4*)(g1 + col0 + c + 4);
                    *(u32x4*)(h + off + c) = pack8(x0 + g0 * acc[ai][bj][m][0], x1 + g4 * acc[ai][bj][m][1]); } }
    }
};
struct EpiQp {
    static constexpr bool PERM = true, AFTER_DRAIN = false;
    bf16_t* qp;
    __device__ __forceinline__ void operator()(const f32x4 (&acc)[2][2][4][2], const Unit& u, int wr, int wc, int fr, int fq) const {
        const int row0 = u.pm * BM + wr * 64 + fr, col0 = u.pn * BM + wc * 32 + 8 * fq;
#pragma unroll
        for (int ai = 0; ai < 2; ++ai)
#pragma unroll
            for (int m = 0; m < 4; ++m) { bf16_t* rowp = qp + (size_t)(row0 + ai * HALF + m * 16) * 2048 + col0;
#pragma unroll
                for (int bj = 0; bj < 2; ++bj) *(u32x4*)(rowp + bj * HALF) = pack8(acc[ai][bj][m][0], acc[ai][bj][m][1]); }
    }
};

template <class Epi, class Sched, bool ALIGN_EPI = false, bool SP2 = false>
__device__ __forceinline__ void gemm_phase(PG8_LAS unsigned char* lds, const Gemm g, const Sched& S, const Epi& E) {
    const int tid = threadIdx.x, wid = __builtin_amdgcn_readfirstlane(tid >> 6), lane = tid & 63, wr = wid >> 2, wc = wid & 3, fr = lane & 15, fq = lane >> 4;
    const int K = g.K, nt = K / BK;
    unsigned voffA[2], voffB[2];
#pragma unroll
    for (int i = 0; i < 2; ++i) { int R, C; stage_rc(tid * 16 + i * 8192, R, C); const int Rb = Epi::PERM ? ((R & ~31) + perm32(R & 31)) : R;
        voffA[i] = (unsigned)(R * K + C) * 2u; voffB[i] = (unsigned)(Rb * K + C) * 2u; }
    const size_t kstep = (size_t)(BK * 2);
    const size_t hstep = (size_t)HALF * K * 2;
    const size_t tstep = 2 * hstep;
    const unsigned ldsw = (unsigned)wid * 1024u;
    const int aoff = lds_byte(wr * 64 + fr, fq * 8), boff = lds_byte(wc * 32 + fr, fq * 8);
#define PG8_SA(b, h) (((b) * 2 + (h)) * HTB)
#define PG8_SB(b, h) ((4 + (b) * 2 + (h)) * HTB)
#define PG8_STAGE(bufoff, gbase, voff) do { _Pragma("unroll") for (int _i = 0; _i < 2; ++_i) \
        __builtin_amdgcn_global_load_lds((const unsigned*)((const char*)(gbase) + (voff)[_i]), (PG8_LAS unsigned*)(lds + (bufoff) + ldsw + _i * 8192), 16, 0, 0); } while (0)
#define PG8_LDA(dst, b, h) do { _Pragma("unroll") for (int m = 0; m < 4; ++m) _Pragma("unroll") for (int k = 0; k < 2; ++k) dst[m][k] = *(const PG8_LAS bf16x8*)(lds + PG8_SA(b, h) + aoff + m * 2048 + k * 1024); } while (0)
#define PG8_LDB(dst, b, h) do { _Pragma("unroll") for (int n = 0; n < 2; ++n) _Pragma("unroll") for (int k = 0; k < 2; ++k) dst[n][k] = *(const PG8_LAS bf16x8*)(lds + PG8_SB(b, h) + boff + n * 2048 + k * 1024); } while (0)
#define PG8_MMA(ai, bj, At, Bt) do { __builtin_amdgcn_s_setprio(1); _Pragma("unroll") for (int m = 0; m < 4; ++m) _Pragma("unroll") for (int n = 0; n < 2; ++n) _Pragma("unroll") for (int k = 0; k < 2; ++k) \
        acc[ai][bj][m][n] = __builtin_amdgcn_mfma_f32_16x16x32_bf16(Bt[n][k], At[m][k], acc[ai][bj][m][n], 0, 0, 0); __builtin_amdgcn_s_setprio(0); } while (0)
#define PG8_WAIT_V(n) asm volatile("s_waitcnt vmcnt(" #n ")" ::: "memory")
#define PG8_WAIT_L(n) asm volatile("s_waitcnt lgkmcnt(" #n ")" ::: "memory")
#define PG8_BAR __builtin_amdgcn_s_barrier()
#define PG8_SCHED __builtin_amdgcn_sched_barrier(0)
    Unit cur, nxt; int ui = 0;
    if (!S.next(0, cur)) return;
    f32x4 acc[2][2][4][2];
#pragma unroll
    for (int a = 0; a < 2; ++a)
#pragma unroll
        for (int b = 0; b < 2; ++b)
#pragma unroll
            for (int m = 0; m < 4; ++m)
#pragma unroll
                for (int n = 0; n < 2; ++n) acc[a][b][m][n] = (f32x4){0.f, 0.f, 0.f, 0.f};
    bf16x8 At[4][2], B0[2][2], B1[2][2];
#define PG8_AB(u_) (Sched::MULTI ? (const char*)((u_).kind == 0 ? g.A : (u_).kind == 1 ? g.A1 : (u_).kind == 2 ? g.A2 : g.A3) : (const char*)g.A)
#define PG8_BB(u_) (Sched::MULTI ? (const char*)((u_).kind == 0 ? g.Bt : (u_).kind == 1 ? g.B1 : (u_).kind == 2 ? g.B2 : g.B3) : (const char*)g.Bt)
    const char* cA = PG8_AB(cur) + (size_t)cur.pm * tstep; const char* cB = PG8_BB(cur) + (size_t)cur.pn * tstep;
    S.a_ready(cur);
    if constexpr (SP2) {
        PG8_STAGE(PG8_SB(0, 0), cB, voffB); PG8_STAGE(PG8_SB(0, 1), cB + hstep, voffB); PG8_STAGE(PG8_SA(0, 0), cA, voffA); PG8_STAGE(PG8_SA(0, 1), cA + hstep, voffA);
        if (wr == 1) PG8_BAR;
        PG8_WAIT_V(2); PG8_BAR;
        PG8_STAGE(PG8_SB(1, 0), cB + kstep, voffB); PG8_STAGE(PG8_SA(1, 0), cA + kstep, voffA); PG8_STAGE(PG8_SB(1, 1), cB + hstep + kstep, voffB);
        PG8_WAIT_V(6); PG8_BAR;
    } else {
        PG8_STAGE(PG8_SB(0, 0), cB, voffB); PG8_STAGE(PG8_SA(0, 0), cA, voffA); PG8_STAGE(PG8_SB(0, 1), cB + hstep, voffB); PG8_STAGE(PG8_SA(0, 1), cA + hstep, voffA);
        if (wr == 1) PG8_BAR;
        PG8_WAIT_V(4); PG8_BAR;
        PG8_STAGE(PG8_SB(1, 0), cB + kstep, voffB); PG8_STAGE(PG8_SA(1, 0), cA + kstep, voffA); PG8_STAGE(PG8_SB(1, 1), cB + hstep + kstep, voffB);
        PG8_WAIT_V(6); PG8_BAR;
    }
    for (;;) {
        const bool has_next = S.next(ui + 1, nxt);
        const char* nA = has_next ? PG8_AB(nxt) + (size_t)nxt.pm * tstep : cA; const char* nB = has_next ? PG8_BB(nxt) + (size_t)nxt.pn * tstep : cB;
        for (int t = 0; t < nt; t += 2) {
            const bool last = (t == nt - 2);
            const char* a1 = cA + (size_t)(t + 1) * kstep;
            const char* a2 = last ? nA : cA + (size_t)(t + 2) * kstep; const char* b2 = last ? nB : cB + (size_t)(t + 2) * kstep;
            const char* a3 = a2 + kstep; const char* b3 = b2 + kstep;
            if (last && has_next) S.a_ready(nxt);
            if constexpr (SP2) {
            PG8_LDB(B0, 0, 0); PG8_LDB(B1, 0, 1); PG8_SCHED; PG8_LDA(At, 0, 0); PG8_STAGE(PG8_SA(1, 1), a1 + hstep, voffA);
            PG8_WAIT_V(8); PG8_WAIT_L(0); PG8_BAR; PG8_MMA(0, 0, At, B0); PG8_MMA(0, 1, At, B1); PG8_BAR; PG8_SCHED;
            PG8_LDA(At, 0, 1); PG8_STAGE(PG8_SB(0, 0), b2, voffB); PG8_STAGE(PG8_SB(0, 1), b2 + hstep, voffB); PG8_STAGE(PG8_SA(0, 0), a2, voffA);
            PG8_WAIT_V(8); PG8_WAIT_L(0); PG8_BAR; PG8_MMA(1, 0, At, B0); PG8_MMA(1, 1, At, B1); PG8_BAR; PG8_SCHED;
            PG8_LDB(B0, 1, 0); PG8_LDB(B1, 1, 1); PG8_SCHED; PG8_LDA(At, 1, 0); PG8_STAGE(PG8_SA(0, 1), a2 + hstep, voffA);
            PG8_WAIT_V(8); PG8_WAIT_L(0); PG8_BAR; PG8_MMA(0, 0, At, B0); PG8_MMA(0, 1, At, B1); PG8_BAR; PG8_SCHED;
            PG8_LDA(At, 1, 1); PG8_STAGE(PG8_SB(1, 0), b3, voffB); PG8_STAGE(PG8_SB(1, 1), b3 + hstep, voffB); PG8_STAGE(PG8_SA(1, 0), a3, voffA);
            PG8_WAIT_V(8); PG8_WAIT_L(0); PG8_BAR; PG8_MMA(1, 0, At, B0); PG8_MMA(1, 1, At, B1); PG8_BAR; PG8_SCHED;
            } else {
            PG8_LDB(B0, 0, 0); PG8_SCHED; PG8_LDA(At, 0, 0); PG8_STAGE(PG8_SA(1, 1), a1 + hstep, voffA);
            PG8_WAIT_L(8); PG8_BAR; PG8_WAIT_L(0); PG8_MMA(0, 0, At, B0); PG8_BAR; PG8_SCHED;
            PG8_LDB(B1, 0, 1); PG8_STAGE(PG8_SB(0, 0), b2, voffB);
            PG8_BAR; PG8_WAIT_L(0); PG8_MMA(0, 1, At, B1); PG8_BAR;
            PG8_LDA(At, 0, 1); PG8_STAGE(PG8_SA(0, 0), a2, voffA);
            PG8_BAR; PG8_WAIT_L(0); PG8_MMA(1, 0, At, B0); PG8_BAR; PG8_SCHED;
            PG8_STAGE(PG8_SB(0, 1), b2 + hstep, voffB);
            PG8_WAIT_V(6); PG8_BAR; PG8_MMA(1, 1, At, B1); PG8_BAR;
            PG8_LDB(B0, 1, 0); PG8_SCHED; PG8_LDA(At, 1, 0); PG8_STAGE(PG8_SA(0, 1), a2 + hstep, voffA);
            PG8_WAIT_L(8); PG8_BAR; PG8_WAIT_L(0); PG8_MMA(0, 0, At, B0); PG8_BAR; PG8_SCHED;
            PG8_LDB(B1, 1, 1); PG8_STAGE(PG8_SB(1, 0), b3, voffB);
            PG8_BAR; PG8_WAIT_L(0); PG8_MMA(0, 1, At, B1); PG8_BAR;
            PG8_LDA(At, 1, 1); PG8_STAGE(PG8_SA(1, 0), a3, voffA);
            PG8_BAR; PG8_WAIT_L(0); PG8_MMA(1, 0, At, B0); PG8_BAR; PG8_SCHED;
            PG8_STAGE(PG8_SB(1, 1), b3 + hstep, voffB);
            PG8_WAIT_V(6); PG8_BAR; PG8_MMA(1, 1, At, B1); PG8_BAR;
            }
        }
        if constexpr (ALIGN_EPI) { if (wr == 0) PG8_BAR; }
        bool keep_acc = false;
        if constexpr (!Epi::AFTER_DRAIN) { if constexpr (Sched::MULTI) keep_acc = E(acc, cur, wr, wc, fr, fq); else E(acc, cur, wr, wc, fr, fq); S.done(cur); }
        if (!has_next) break;
        if (!keep_acc) {
#pragma unroll
        for (int a = 0; a < 2; ++a)
#pragma unroll
            for (int b = 0; b < 2; ++b)
#pragma unroll
                for (int m = 0; m < 4; ++m)
#pragma unroll
                    for (int n = 0; n < 2; ++n) acc[a][b][m][n] = (f32x4){0.f, 0.f, 0.f, 0.f};
        }
        cur = nxt; cA = nA; cB = nB; ++ui;
        if constexpr (ALIGN_EPI) { if (wr == 1) PG8_BAR; }
    }
    PG8_WAIT_V(0);
    if constexpr (!ALIGN_EPI) { if (wr == 0) PG8_BAR; }
    PG8_BAR;
    if constexpr (Epi::AFTER_DRAIN) { E.fused(acc, cur, wr, wc, fr, fq, lds, wid, lane); S.done(cur); }
#undef PG8_AB
#undef PG8_BB
#undef PG8_SA
#undef PG8_SB
#undef PG8_STAGE
#undef PG8_LDA
#undef PG8_LDB
#undef PG8_MMA
#undef PG8_WAIT_V
#undef PG8_WAIT_L
#undef PG8_BAR
#undef PG8_SCHED
}
}


namespace tk {
typedef short bf16x8 __attribute__((ext_vector_type(8)));
constexpr int RSK = 272, TAB = 69632, TABW = 33 * 16 * 4, IJT = TAB + 8 * TABW;
__device__ __forceinline__ void ce(float& a, float& b) { const float hi = __builtin_fmaxf(a, b), lo = __builtin_fminf(a, b); a = hi; b = lo; }
__device__ __forceinline__ void sort16(float (&v)[16]) {
#pragma unroll
    for (int k = 2; k <= 16; k <<= 1)
#pragma unroll
        for (int j = k >> 1; j > 0; j >>= 1)
#pragma unroll
            for (int i = 0; i < 16; ++i) { const int l = i ^ j; if (l > i) { if ((i & k) == 0) ce(v[i], v[l]); else ce(v[l], v[i]); } }
}
__device__ __forceinline__ void merge16(float (&a)[16], const float (&b)[16]) {
#pragma unroll
    for (int i = 0; i < 16; ++i) a[i] = __builtin_fmaxf(a[i], b[15 - i]);
#pragma unroll
    for (int j = 8; j > 0; j >>= 1)
#pragma unroll
        for (int i = 0; i < 16; ++i) { const int l = i ^ j; if (l > i) ce(a[i], a[l]); }
}
__device__ __forceinline__ void xmerge(float (&a)[16], int mask) { float b[16];
#pragma unroll
    for (int i = 0; i < 16; ++i) b[i] = __shfl_xor(a[i], mask);
    merge16(a, b); }
}
template <bool OWN>
__device__ __forceinline__ void p_topk(const Ctx& C, const bf16_t* qp, const bf16_t* keys, unsigned short* pidx, float* pgate) {
    using namespace tk;
    LAS unsigned char* L = C.lds;
    const int tid = C.tid, lane = C.lane, w = C.wave, g = lane >> 4, i16 = lane & 15;
    __syncthreads();
    for (int i = tid; i < 4096; i += NTHR) { const int r = i >> 4, cc = i & 15; *(LAS u32x4*)(L + r * RSK + cc * 16) = *(const u32x4*)(keys + (size_t)r * 128 + cc * 8); }
    if (tid < 64) { int cnt = 0, fi = 0, fj = 0;
        for (int i = 0; i < 16; ++i) for (int j = 0; j < 16; ++j) if ((i + 1) * (j + 1) <= 16) { if (cnt == tid) { fi = i; fj = j; } ++cnt; }
        ((LAS unsigned*)(L + IJT))[tid] = (unsigned)(fi | (fj << 4)); }
    __syncthreads();
    LAS unsigned* tab = (LAS unsigned*)(L + TAB + w * TABW) + i16 * 33;
    const LAS unsigned* ijt = (const LAS unsigned*)(L + IJT);
    const float NEGV = -1.0e30f;
    const int gw = C.bid * NWAVES + w, NGW = C.G * NWAVES;
    pg8::StaticOrder SO; SO.init(T, 2048, C.G, C.bid);
    for (int unit = OWN ? w : gw; ; unit += OWN ? NWAVES : NGW) {
        int tg, hh;
        if constexpr (OWN) { pg8::Unit u; if (!SO.next(unit >> 4, u)) break; tg = 16 * u.pm + (unit & 15); hh = u.pn; }
        else { if (unit >= (T / 16) * 8) break; tg = unit >> 3; hh = unit & 7; }
        const size_t t0 = (size_t)tg * 16;
        float s1[16], s2[16];
#pragma unroll
        for (int z = 0; z < 2; ++z) {
            bf16x8 qf[4];
#pragma unroll
            for (int ks = 0; ks < 4; ++ks) qf[ks] = *(const bf16x8*)(qp + (t0 + i16) * 2048 + hh * 256 + z * 128 + ks * 32 + g * 8);
            float lo[16], hi[16];
#pragma unroll
            for (int nt = 0; nt < 8; ++nt) { f32x4 acc = (f32x4){0.f, 0.f, 0.f, 0.f};
#pragma unroll
                for (int ks = 0; ks < 4; ++ks) { const bf16x8 kf = *(const LAS bf16x8*)(L + (z * 128 + 16 * nt + i16) * RSK + ks * 64 + g * 16);
                    acc = __builtin_amdgcn_mfma_f32_16x16x32_bf16(kf, qf[ks], acc, 0, 0, 0); }
#pragma unroll
                for (int r = 0; r < 4; ++r) { const float pv = __uint_as_float((__float_as_uint(acc[r]) & 0xFFFFFF80u) | (unsigned)(16 * nt + 4 * g + r));
                    if (nt < 4) lo[nt * 4 + r] = pv; else hi[(nt - 4) * 4 + r] = pv; } }
            sort16(lo); sort16(hi); merge16(lo, hi);
            xmerge(lo, 16); xmerge(lo, 32);
#pragma unroll
            for (int i = 0; i < 16; ++i) { if (z == 0) s1[i] = lo[i]; else s2[i] = lo[i]; }
        }
#pragma unroll
        for (int i = 0; i < 16; ++i) { tab[i] = __float_as_uint(s1[i]); tab[16 + i] = __float_as_uint(s2[i]); }
        float cand[16];
            { const float a_ = (g == 0 ? s1[0] : g == 1 ? s1[1] : g == 2 ? s1[3] : s1[14]), b_ = (g == 0 ? s2[0] : g == 1 ? s2[0] : g == 2 ? s2[3] : s2[0]); cand[0] = __uint_as_float((__float_as_uint(a_ + b_) & 0xFFFFFFC0u) | (unsigned)(16 * g + 0)); }
            { const float a_ = (g == 0 ? s1[0] : g == 1 ? s1[1] : g == 2 ? s1[4] : s1[15]), b_ = (g == 0 ? s2[1] : g == 1 ? s2[1] : g == 2 ? s2[0] : s2[0]); cand[1] = __uint_as_float((__float_as_uint(a_ + b_) & 0xFFFFFFC0u) | (unsigned)(16 * g + 1)); }
            { const float a_ = (g == 0 ? s1[0] : g == 1 ? s1[1] : g == 2 ? s1[4] : NEGV), b_ = (g == 0 ? s2[2] : g == 1 ? s2[2] : g == 2 ? s2[1] : NEGV); cand[2] = __uint_as_float((__float_as_uint(a_ + b_) & 0xFFFFFFC0u) | (unsigned)(16 * g + 2)); }
            { const float a_ = (g == 0 ? s1[0] : g == 1 ? s1[1] : g == 2 ? s1[4] : NEGV), b_ = (g == 0 ? s2[3] : g == 1 ? s2[3] : g == 2 ? s2[2] : NEGV); cand[3] = __uint_as_float((__float_as_uint(a_ + b_) & 0xFFFFFFC0u) | (unsigned)(16 * g + 3)); }
            { const float a_ = (g == 0 ? s1[0] : g == 1 ? s1[1] : g == 2 ? s1[5] : NEGV), b_ = (g == 0 ? s2[4] : g == 1 ? s2[4] : g == 2 ? s2[0] : NEGV); cand[4] = __uint_as_float((__float_as_uint(a_ + b_) & 0xFFFFFFC0u) | (unsigned)(16 * g + 4)); }
            { const float a_ = (g == 0 ? s1[0] : g == 1 ? s1[1] : g == 2 ? s1[5] : NEGV), b_ = (g == 0 ? s2[5] : g == 1 ? s2[5] : g == 2 ? s2[1] : NEGV); cand[5] = __uint_as_float((__float_as_uint(a_ + b_) & 0xFFFFFFC0u) | (unsigned)(16 * g + 5)); }
            { const float a_ = (g == 0 ? s1[0] : g == 1 ? s1[1] : g == 2 ? s1[6] : NEGV), b_ = (g == 0 ? s2[6] : g == 1 ? s2[6] : g == 2 ? s2[0] : NEGV); cand[6] = __uint_as_float((__float_as_uint(a_ + b_) & 0xFFFFFFC0u) | (unsigned)(16 * g + 6)); }
            { const float a_ = (g == 0 ? s1[0] : g == 1 ? s1[1] : g == 2 ? s1[6] : NEGV), b_ = (g == 0 ? s2[7] : g == 1 ? s2[7] : g == 2 ? s2[1] : NEGV); cand[7] = __uint_as_float((__float_as_uint(a_ + b_) & 0xFFFFFFC0u) | (unsigned)(16 * g + 7)); }
            { const float a_ = (g == 0 ? s1[0] : g == 1 ? s1[2] : g == 2 ? s1[7] : NEGV), b_ = (g == 0 ? s2[8] : g == 1 ? s2[0] : g == 2 ? s2[0] : NEGV); cand[8] = __uint_as_float((__float_as_uint(a_ + b_) & 0xFFFFFFC0u) | (unsigned)(16 * g + 8)); }
            { const float a_ = (g == 0 ? s1[0] : g == 1 ? s1[2] : g == 2 ? s1[7] : NEGV), b_ = (g == 0 ? s2[9] : g == 1 ? s2[1] : g == 2 ? s2[1] : NEGV); cand[9] = __uint_as_float((__float_as_uint(a_ + b_) & 0xFFFFFFC0u) | (unsigned)(16 * g + 9)); }
            { const float a_ = (g == 0 ? s1[0] : g == 1 ? s1[2] : g == 2 ? s1[8] : NEGV), b_ = (g == 0 ? s2[10] : g == 1 ? s2[2] : g == 2 ? s2[0] : NEGV); cand[10] = __uint_as_float((__float_as_uint(a_ + b_) & 0xFFFFFFC0u) | (unsigned)(16 * g + 10)); }
            { const float a_ = (g == 0 ? s1[0] : g == 1 ? s1[2] : g == 2 ? s1[9] : NEGV), b_ = (g == 0 ? s2[11] : g == 1 ? s2[3] : g == 2 ? s2[0] : NEGV); cand[11] = __uint_as_float((__float_as_uint(a_ + b_) & 0xFFFFFFC0u) | (unsigned)(16 * g + 11)); }
            { const float a_ = (g == 0 ? s1[0] : g == 1 ? s1[2] : g == 2 ? s1[10] : NEGV), b_ = (g == 0 ? s2[12] : g == 1 ? s2[4] : g == 2 ? s2[0] : NEGV); cand[12] = __uint_as_float((__float_as_uint(a_ + b_) & 0xFFFFFFC0u) | (unsigned)(16 * g + 12)); }
            { const float a_ = (g == 0 ? s1[0] : g == 1 ? s1[3] : g == 2 ? s1[11] : NEGV), b_ = (g == 0 ? s2[13] : g == 1 ? s2[0] : g == 2 ? s2[0] : NEGV); cand[13] = __uint_as_float((__float_as_uint(a_ + b_) & 0xFFFFFFC0u) | (unsigned)(16 * g + 13)); }
            { const float a_ = (g == 0 ? s1[0] : g == 1 ? s1[3] : g == 2 ? s1[12] : NEGV), b_ = (g == 0 ? s2[14] : g == 1 ? s2[1] : g == 2 ? s2[0] : NEGV); cand[14] = __uint_as_float((__float_as_uint(a_ + b_) & 0xFFFFFFC0u) | (unsigned)(16 * g + 14)); }
            { const float a_ = (g == 0 ? s1[0] : g == 1 ? s1[3] : g == 2 ? s1[13] : NEGV), b_ = (g == 0 ? s2[15] : g == 1 ? s2[2] : g == 2 ? s2[0] : NEGV); cand[15] = __uint_as_float((__float_as_uint(a_ + b_) & 0xFFFFFFC0u) | (unsigned)(16 * g + 15)); }
        sort16(cand);
        xmerge(cand, 16); xmerge(cand, 32);
        float den = 0.f, ex[16];
#pragma unroll
        for (int i = 0; i < 16; ++i) { ex[i] = __expf(cand[i] - cand[0]); den += ex[i]; }
        const float inv = 1.f / den;
        unsigned short eo[4]; float go[4];
#pragma unroll
        for (int e = 0; e < 4; ++e) {
            const float cv = (g == 0 ? cand[e] : g == 1 ? cand[4 + e] : g == 2 ? cand[8 + e] : cand[12 + e]);
            const float gv = (g == 0 ? ex[e] : g == 1 ? ex[4 + e] : g == 2 ? ex[8 + e] : ex[12 + e]);
            const unsigned code = __float_as_uint(cv) & 63u; const unsigned ij = ijt[code];
            const unsigned p1 = tab[ij & 15u], p2 = tab[16 + (ij >> 4)];
            eo[e] = (unsigned short)((p1 & 127u) * 128u + (p2 & 127u)); go[e] = gv * inv; }
        u32x2 ov; ov.x = (unsigned)eo[0] | ((unsigned)eo[1] << 16); ov.y = (unsigned)eo[2] | ((unsigned)eo[3] << 16);
        *(u32x2*)(pidx + (t0 + i16) * 128 + hh * 16 + 4 * g) = ov;
        *(f32x4*)(pgate + (t0 + i16) * 128 + hh * 16 + 4 * g) = (f32x4){go[0], go[1], go[2], go[3]};
    }
    __syncthreads();
}

#define GAS __attribute__((address_space(1)))
typedef GAS unsigned gu32;
#define RLX_AGENT __ATOMIC_RELAXED, __HIP_MEMORY_SCOPE_AGENT
#define XB_TMO      128
#define XB_XCNT(j)  (256  + 64 * (j))
#define XB_XSUB(j)  (1280 + 64 * (j))
#define XB_XGEN(j)  (2304 + 64 * (j))
#define XB_TOP      3328
#define XB_TOPGEN   3392
#define XCD_BAR_WORDS 3456
#define XB_SPIN_CAP (1u << 18)

__device__ __forceinline__ unsigned xb_ld(unsigned* p)              { return __hip_atomic_load(p, __ATOMIC_RELAXED, __HIP_MEMORY_SCOPE_AGENT); }
__device__ __forceinline__ unsigned xb_add(unsigned* p, unsigned v) { return __hip_atomic_fetch_add(p, v, __ATOMIC_RELAXED, __HIP_MEMORY_SCOPE_AGENT); }
__device__ __forceinline__ unsigned xb_xcc_id() { return (unsigned)__builtin_amdgcn_s_getreg((3 << 11) | 20) & 0xFu; }
#define XB_SPIN(cond, bar) do { unsigned _sp = 0; while (cond) { __builtin_amdgcn_s_sleep(1); \
    if ((++_sp & 255u) == 0u) { if (xb_ld(&(bar)[XB_TMO])) break; if (_sp > XB_SPIN_CAP) { atomicAdd(&(bar)[XB_TMO], 1u); break; } } } } while (0)

struct XcdBarrier {
    unsigned* bar; unsigned x;
    volatile LAS unsigned* st;
};

__device__ __forceinline__ XcdBarrier xcd_barrier_post(unsigned* bar, volatile LAS unsigned* st) {
    XcdBarrier b; b.bar = bar; b.x = xb_xcc_id(); b.st = st;
    if (threadIdx.x == 0) (void)xb_add(&bar[XB_XCNT(b.x)], 1u);
    return b;
}
__device__ __forceinline__ void xcd_barrier_complete(unsigned* bar, unsigned x, unsigned& nloc, unsigned& nx) {
    const unsigned G = gridDim.x * gridDim.y * gridDim.z;
    unsigned sum, cnt, mine, sp = 0u;
    for (;;) {
        sum = 0u; cnt = 0u; mine = 0u;
#pragma unroll
        for (unsigned j = 0; j < 16; ++j) { const unsigned c = xb_ld(&bar[XB_XCNT(j)]); sum += c; cnt += (c > 0u) ? 1u : 0u; mine = (j == x) ? c : mine; }
        if (sum == G) break;
        __builtin_amdgcn_s_sleep(1);
        if ((++sp & 255u) == 0u) { if (xb_ld(&bar[XB_TMO])) break; if (sp > XB_SPIN_CAP) { atomicAdd(&bar[XB_TMO], 1u); break; } }
    }
    nloc = mine > 0u ? mine : 1u; nx = cnt > 0u ? cnt : 1u;
}

__device__ __forceinline__ void xcd_barrier(const XcdBarrier& b) {
    asm volatile("s_waitcnt vmcnt(0)" ::: "memory");
    __syncthreads();
    if (threadIdx.x == 0) {
        unsigned* bar = b.bar;
        __builtin_amdgcn_s_waitcnt(0);
        unsigned nloc = b.st[0], nx = b.st[1];
        if (nloc == 0u) { xcd_barrier_complete(bar, b.x, nloc, nx); b.st[0] = nloc; b.st[1] = nx; }
        const unsigned old = xb_add(&bar[XB_XSUB(b.x)], 1u);
        const unsigned gen = old / nloc;
        if (old + 1u == (gen + 1u) * nloc) {
            __builtin_amdgcn_fence(__ATOMIC_RELEASE, "agent");
            asm volatile("s_waitcnt vmcnt(0)" ::: "memory");
            const unsigned og = xb_add(&bar[XB_TOP], 1u);
            const unsigned tg = og / nx;
            if (og + 1u == (tg + 1u) * nx) xb_add(&bar[XB_TOPGEN], 1u);
            else XB_SPIN(xb_ld(&bar[XB_TOPGEN]) == tg, bar);
            __builtin_amdgcn_fence(__ATOMIC_ACQUIRE, "agent");
            xb_add(&bar[XB_XGEN(b.x)], 1u);
            asm volatile("s_waitcnt vmcnt(0)" ::: "memory");
        } else {
            XB_SPIN(xb_ld(&bar[XB_XGEN(b.x)]) == gen, bar);
            __builtin_amdgcn_fence(__ATOMIC_ACQUIRE, "agent");
            asm volatile("s_waitcnt vmcnt(0)" ::: "memory");
        }
    }
    __syncthreads();
}


constexpr int N_PHASES = 14;
constexpr int CW_BAR = 4096;
constexpr size_t CTL_ZERO_BYTES = 64 * 1024;
constexpr int MISC_OFF = LDS_BYTES - 256;

template <int PH>
__device__ __forceinline__ void run_phase(const Ctx& C, const Args& a) {
    bf16_t* R0 = C.bfp(WS_R0); bf16_t* R1 = C.bfp(WS_R1); bf16_t* R2 = C.bfp(WS_R2); bf16_t* R3 = C.bfp(WS_R3);
    bf16_t* OB = (bf16_t*)a.out;
    const size_t TD = (size_t)T * 1024;
    if constexpr (PH == 0) p_prep(C);
    if constexpr (PH == 1) p_rownorm(C, C.in[0], C.in[4], 0, 1024, R0);
    if constexpr (PH == 2) {
        { pg8::Gemm g{R0, C.bfp(WS_WIN_T), T, 6144, 1024}; pg8::StaticOrder S; S.init(T, 6144, C.G, C.bid);
          pg8::EpiInProj e{R1, R2, R3, R3 + TD, R3 + 2 * TD};
          pg8::gemm_phase<pg8::EpiInProj, pg8::StaticOrder, true, true>(C.lds, g, S, e); }
        p_dt(C, R0, C.bfp(WS_WDT_T), C.f32p(WS_DT));
    }
    if constexpr (PH == 3) {
        if ((C.bid >> 3) & 1) { p_na(C, R3, R3 + TD, R3 + 2 * TD); p_conv(C, R2, OB); } else { p_conv(C, R2, OB); p_na(C, R3, R3 + TD, R3 + 2 * TD); } }
    if constexpr (PH == 4) p_ssd(C, OB, C.f32p(WS_DT), R2, R2 + TD);
    if constexpr (PH == 5) p_combine(C, R2, R2 + TD, R1, C.f32p(WS_RSTD));
    if constexpr (PH == 6) {
        pg8::MultiOrder S; S.b.init(T, 1024, C.G, C.bid); S.nk = 4;
        pg8::Gemm g{R0, C.bfp(WS_WG_T), T, 1024, 1024, R0, C.bfp(WS_WG_T) + (size_t)1024 * 1024, R1, C.bfp(WS_WSSD_T), R3, C.bfp(WS_WNA_T)};
        pg8::EpiMix e{OB + (size_t)C.bid * 131072, OB + (size_t)C.bid * 131072 + 65536, R2 + TD, C.f32p(WS_RSTD)};
        pg8::gemm_phase<pg8::EpiMix, pg8::MultiOrder, true, true>(C.lds, g, S, e);
    }
    if constexpr (PH == 7) { pg8::Gemm g{R2 + TD, C.bfp(WS_WOUT_T), T, 1024, 1024}; pg8::StaticOrder S; S.init(T, 1024, C.G, C.bid);
        pg8::EpiD3 e{R3 + TD, C.in[0], C.f32p(WS_MOD)}; pg8::gemm_phase<pg8::EpiD3, pg8::StaticOrder, true, true>(C.lds, g, S, e); }
    if constexpr (PH == 8) { p_rownorm_b(C, R3 + TD, C.in[18], 3072, 4096, R0); p_cvt_tables8(C, (unsigned char*)R2, (unsigned char*)R2 + (size_t)16384 * 1024); }
    if constexpr (PH == 9) { pg8::Gemm g{R0, C.bfp(WS_WPQ_T), T, 2048, 1024}; pg8::StaticOrder S; S.init(T, 2048, C.G, C.bid);
        pg8::EpiQp e{OB}; pg8::gemm_phase<pg8::EpiQp, pg8::StaticOrder, true, true>(C.lds, g, S, e);
        asm volatile("s_waitcnt vmcnt(0)" ::: "memory"); __syncthreads();
        if (C.tid == 0) __builtin_amdgcn_fence(__ATOMIC_ACQUIRE, "agent");
        asm volatile("s_waitcnt vmcnt(0)" ::: "memory"); __syncthreads();
        p_topk<true>(C, OB, C.bfp(WS_KEYS), (unsigned short*)R1, (float*)(R1 + 4 * MiB)); }
    if constexpr (PH == 10) p_gu(C, R0, (const unsigned short*)R1, (const unsigned char*)R2, a.out);
    if constexpr (PH == 11) p_gc(C, a.out, (const float*)(R1 + 4 * MiB), (float*)((unsigned char*)R2 + 32 * MiB));
    if constexpr (PH == 12) p_gv(C, (const float*)((unsigned char*)R2 + 32 * MiB), (const unsigned short*)R1, (const unsigned char*)R2 + (size_t)16384 * 1024, R3);
    if constexpr (PH == 13) p_gf(C, R3 + TD, R3, a.out);
}

template <int PH> struct PhaseLoop {
    static __device__ __forceinline__ void run(const Ctx& C, const Args& a, const XcdBarrier& bar) {
        if (PH >= a.ph_lo && PH < a.ph_hi) { run_phase<PH>(C, a); if (PH + 1 < a.ph_hi) xcd_barrier(bar); }
        PhaseLoop<PH + 1>::run(C, a, bar);
    }
};
template <> struct PhaseLoop<N_PHASES> { static __device__ __forceinline__ void run(const Ctx&, const Args&, const XcdBarrier&) {} };

__global__ void __launch_bounds__(NTHR, 2) mega(Args a) {
    extern __shared__ __attribute__((aligned(16))) unsigned char lds_raw[];
    Ctx C; C.in = a.in; C.out = a.out; C.ws = a.ws; C.tid = threadIdx.x; C.lane = C.tid & 63; C.wave = __builtin_amdgcn_readfirstlane(C.tid >> 6);
    C.G = gridDim.x; C.bid = blockIdx.x; C.lds = (LAS unsigned char*)lds_raw;
    volatile LAS unsigned* MISC = (volatile LAS unsigned*)(C.lds + MISC_OFF);
    if (C.tid < 64) MISC[C.tid] = 0u;
    __syncthreads();
    XcdBarrier bar; bar.bar = (unsigned*)(a.ws + WS_CTL) + CW_BAR; bar.x = 0; bar.st = nullptr;
    if (a.ph_hi - a.ph_lo > 1) bar = xcd_barrier_post((unsigned*)(a.ws + WS_CTL) + CW_BAR, MISC + 8);
    PhaseLoop<0>::run(C, a, bar);
}

extern "C" void kernel_launch(void* const* d_in, const int* in_sizes, int n_in, void* d_out, int out_size, void* d_ws, size_t ws_size, hipStream_t stream) {
    static int grid = 0;
    if (grid == 0) {
        if (n_in != 24 || out_size != T * D || ws_size < WS_END) { fprintf(stderr, "kernel_launch: unexpected shapes n_in %d out %d ws %zu\n", n_in, out_size, ws_size); grid = -1; return; }
        int dev = 0, cus = 0;
        if (hipGetDevice(&dev) != hipSuccess || hipDeviceGetAttribute(&cus, hipDeviceAttributeMultiprocessorCount, dev) != hipSuccess) { grid = -1; return; }
        if (hipFuncSetAttribute((const void*)mega, hipFuncAttributeMaxDynamicSharedMemorySize, LDS_BYTES) != hipSuccess) { grid = -1; return; }
        grid = cus;
    }
    if (grid < 0) return;
    (void)hipMemsetAsync((char*)d_ws + WS_CTL, 0, CTL_ZERO_BYTES, stream);
    Args a{};
    for (int i = 0; i < 24; ++i) a.in[i] = (const float*)d_in[i];
    a.out = (float*)d_out; a.ws = (unsigned char*)d_ws;
    a.ph_lo = 0; a.ph_hi = N_PHASES;
    hipLaunchKernelGGL(mega, dim3(grid), dim3(NTHR), LDS_BYTES, stream, a);
}
```

```cpp
#include <hip/hip_runtime.h>
#include <cstdio>
#include <cstdint>

#define LAS __attribute__((address_space(3)))
typedef unsigned short bf16_t;
typedef float f32x4 __attribute__((ext_vector_type(4)));
typedef unsigned u32x4 __attribute__((ext_vector_type(4)));
typedef unsigned u32x2 __attribute__((ext_vector_type(2)));
typedef __bf16 bf16x2_t __attribute__((ext_vector_type(2)));

constexpr int T = 32768, D = 1024, NB = 8, SEQ = 4096;
constexpr int NWAVES = 8, NTHR = 512;
constexpr float EPS = 1e-6f;
constexpr int OFF_Z = 0, OFF_XBC = 1024, OFF_DTF = 3072, OFF_DTB = 3088, OFF_QKV = 3104, OFF_GS = 6176, OFF_GN = 7200, D_IN = 8224;

constexpr size_t MiB = 1u << 20;
constexpr size_t WS_CTL = 0;
constexpr size_t WS_MOD = 1 * MiB;
constexpr size_t WS_RSTD = 1 * MiB + 512 * 1024;
constexpr size_t WS_DT = 2 * MiB;
constexpr size_t WS_WIN_T = 6 * MiB;
constexpr size_t WS_WG_T = 18 * MiB;
constexpr size_t WS_WDT_T = 22 * MiB;
constexpr size_t WS_KEYS = 22 * MiB + 512 * 1024;
constexpr size_t WS_WSSD_T = 23 * MiB, WS_WNA_T = 25 * MiB, WS_WOUT_T = 27 * MiB, WS_WPQ_T = 29 * MiB;
constexpr size_t WS_R0 = 40 * MiB, WS_R1 = 104 * MiB, WS_R2 = 168 * MiB, WS_R3 = 296 * MiB, WS_EDGE = 488 * MiB  , WS_END = 492 * MiB;

constexpr int LDS_BYTES = 163840;

struct Args { const float* in[24]; float* out; unsigned char* ws; int ph_lo, ph_hi; };

__device__ __forceinline__ float bf2f(unsigned v) { return __uint_as_float(v << 16); }
__device__ __forceinline__ float bflo(unsigned v) { return __uint_as_float(v << 16); }
__device__ __forceinline__ float bfhi(unsigned v) { return __uint_as_float(v & 0xffff0000u); }
__device__ __forceinline__ unsigned f2bf(float f) { unsigned u = __float_as_uint(f); return (u + 0x7fffu + ((u >> 16) & 1u)) >> 16; }
typedef float f32x2_t __attribute__((ext_vector_type(2)));
__device__ __forceinline__ unsigned pk2(float lo, float hi) { f32x2_t v = {lo, hi}; bf16x2_t b = __builtin_convertvector(v, bf16x2_t); return __builtin_bit_cast(unsigned, b); }
__device__ __forceinline__ void st_wt16(void* p, const u32x4 v) { asm volatile("global_store_dwordx4 %0, %1, off sc0 sc1\n\ts_nop 1" :: "v"(p), "v"(v) : "memory"); }
__device__ __forceinline__ void st_wt8(void* p, const u32x2 v) { asm volatile("global_store_dwordx2 %0, %1, off sc0 sc1\n\ts_nop 1" :: "v"(p), "v"(v) : "memory"); }
__device__ __forceinline__ float wave_sum(float v) {
#pragma unroll
    for (int o = 1; o < 64; o <<= 1) v += __shfl_xor(v, o);
    return v;
}
__device__ __forceinline__ float silu_f(float x) { return x * __builtin_amdgcn_rcpf(1.f + __expf(-x)); }
__device__ __forceinline__ float sigmoid_f(float x) { return __builtin_amdgcn_rcpf(1.f + __expf(-x)); }
__device__ __forceinline__ float softplus_f(float x) { return x > 20.f ? x : log1pf(__expf(x)); }
__device__ __forceinline__ float gelu_f(float x) { return 0.5f * x * (1.f + erff(x * 0.70710678118654752f)); }

struct Ctx {
    const float* const* in; float* out; unsigned char* ws;
    int tid, lane, wave, G, bid;
    LAS unsigned char* lds;
    __device__ __forceinline__ float* f32p(size_t off) const { return (float*)(ws + off); }
    __device__ __forceinline__ bf16_t* bfp(size_t off) const { return (bf16_t*)(ws + off); }
};

__device__ __forceinline__ void tr_item(const float* W, int ldw, int col0, int K, bf16_t* WT, int row_off, LAS float* scr, int item, int nblk, int lane, const float* kscale) {
    const int kb = item / nblk, nb = item % nblk, k0 = 64 * kb, n0 = 32 * nb;
#pragma unroll
    for (int h = 0; h < 2; ++h) {
        float xv[16];
#pragma unroll
        for (int i = 0; i < 16; ++i) { const int kk = 2 * (16 * h + i) + (lane >> 5); xv[i] = W[(size_t)(k0 + kk) * ldw + col0 + n0 + (lane & 31)]; }
        if (kscale) {
#pragma unroll
            for (int i = 0; i < 16; ++i) xv[i] *= kscale[k0 + 2 * (16 * h + i) + (lane >> 5)]; }
        asm volatile("" ::: "memory");
#pragma unroll
        for (int i = 0; i < 16; ++i) { const int kk = 2 * (16 * h + i) + (lane >> 5); scr[kk * 33 + (lane & 31)] = xv[i]; }
    }
    asm volatile("s_waitcnt lgkmcnt(0)" ::: "memory");
    const int c = lane & 7;
#pragma unroll
    for (int j = 0; j < 4; ++j) { const int n = (lane >> 3) + 8 * j; const LAS float* sp = scr + (8 * c) * 33 + n;
        u32x4 o; o.x = pk2(sp[0 * 33], sp[1 * 33]); o.y = pk2(sp[2 * 33], sp[3 * 33]); o.z = pk2(sp[4 * 33], sp[5 * 33]); o.w = pk2(sp[6 * 33], sp[7 * 33]);
        *(u32x4*)(WT + (size_t)(row_off + n0 + n) * K + k0 + 8 * c) = o; }
    asm volatile("s_waitcnt lgkmcnt(0)" ::: "memory");
}
__device__ __forceinline__ void p_prep(const Ctx& C) {
    const float* c = C.in[1]; const float* w_ada = C.in[2]; const float* b_ada = C.in[3];
    float* mod = C.f32p(WS_MOD);
    LAS float* sc = (LAS float*)C.lds;
    LAS float* red = sc + 8192;
    for (int i = C.tid; i < 8192; i += NTHR) sc[i] = silu_f(c[i]);
    __syncthreads();
    for (int jb = C.bid; jb < 256; jb += C.G) {
        const int j0 = jb * 24, jl = C.tid % 24, kq = C.tid / 24;
        if (C.tid < 504) { float acc[8];
#pragma unroll
            for (int b = 0; b < 8; ++b) acc[b] = 0.f;
            const float* wp = w_ada + (size_t)kq * 6144 + j0 + jl; const LAS float* sp = sc + kq;
            for (int i0 = 0; i0 < 48; i0 += 8) { float wv[8];
#pragma unroll
                for (int u = 0; u < 8; ++u) wv[u] = wp[(size_t)(i0 + u) * (21 * 6144)];
                asm volatile("" ::: "memory");
#pragma unroll
                for (int u = 0; u < 8; ++u)
#pragma unroll
                    for (int b = 0; b < 8; ++b) acc[b] += sp[b * 1024 + 21 * (i0 + u)] * wv[u]; }
            if (kq < 16) { const float w = wp[(size_t)48 * (21 * 6144)];
#pragma unroll
                for (int b = 0; b < 8; ++b) acc[b] += sp[b * 1024 + 21 * 48] * w; }
#pragma unroll
            for (int b = 0; b < 8; ++b) red[(kq * 24 + jl) * 8 + b] = acc[b]; }
        __syncthreads();
        if (C.tid < 192) { const int jl2 = C.tid % 24, b2 = C.tid / 24; float sacc = b_ada[j0 + jl2];
            for (int kq2 = 0; kq2 < 21; ++kq2) sacc += red[(kq2 * 24 + jl2) * 8 + b2];
            mod[b2 * 6144 + j0 + jl2] = sacc; }
        __syncthreads();
    }
    LAS float* scr = (LAS float*)(C.lds + 65536 + C.wave * 8448);
    const int gw = C.bid * NWAVES + C.wave, NGW = C.G * NWAVES;
    const float* w_in = C.in[5];
    constexpr int I_A = 16 * 96, I_B = 16 * 96, I_G = 16 * 64, I_DT = 16, I_S = 16 * 32, I_PQ = 16 * 64;
    constexpr int NIT = I_A + I_B + I_G + I_DT + 3 * I_S + I_PQ;
    for (int it = gw; it < NIT; it += NGW) {
        int r = it;
        if (r < I_A) { tr_item(w_in, D_IN, 0, D, C.bfp(WS_WIN_T), 0, scr, r, 96, C.lane, nullptr); continue; } r -= I_A;
        if (r < I_B) { tr_item(w_in, D_IN, OFF_QKV, D, C.bfp(WS_WIN_T), 3072, scr, r, 96, C.lane, nullptr); continue; } r -= I_B;
        if (r < I_G) { tr_item(w_in, D_IN, OFF_GS, D, C.bfp(WS_WG_T), 0, scr, r, 64, C.lane, nullptr); continue; } r -= I_G;
        if (r < I_DT) { tr_item(w_in, D_IN, OFF_DTF, D, C.bfp(WS_WDT_T), 0, scr, r, 1, C.lane, nullptr); continue; } r -= I_DT;
        if (r < I_S) { tr_item(C.in[14], D, 0, D, C.bfp(WS_WSSD_T), 0, scr, r, 32, C.lane, C.in[13]); continue; } r -= I_S;
        if (r < I_S) { tr_item(C.in[16], D, 0, D, C.bfp(WS_WNA_T), 0, scr, r, 32, C.lane, nullptr); continue; } r -= I_S;
        if (r < I_S) { tr_item(C.in[17], D, 0, D, C.bfp(WS_WOUT_T), 0, scr, r, 32, C.lane, nullptr); continue; } r -= I_S;
        tr_item(C.in[19], 2048, 0, D, C.bfp(WS_WPQ_T), 0, scr, r, 64, C.lane, nullptr);
    }
    { const int gt = C.bid * NTHR + C.tid, NT = C.G * NTHR; const float* kf = C.in[20]; bf16_t* kb = C.bfp(WS_KEYS);
      for (int i = gt; i < 2 * 128 * 128; i += NT) kb[i] = (bf16_t)f2bf(kf[i]); }
    __syncthreads();
}

__device__ __forceinline__ void p_rownorm(const Ctx& C, const float* X, const float* gamma, int sh_off, int sc_off, bf16_t* dst) {
    const float* mod = C.f32p(WS_MOD);
    const int gw = C.bid * NWAVES + C.wave, NGW = C.G * NWAVES;
    for (int row0 = gw * 4; row0 < T; row0 += NGW * 4) {
        const int b = row0 / SEQ;
        f32x4 v[4][4]; float s[4];
#pragma unroll
        for (int r = 0; r < 4; ++r) { const f32x4* xr = (const f32x4*)(X + (size_t)(row0 + r) * D) + C.lane;
#pragma unroll
            for (int j = 0; j < 4; ++j) v[r][j] = xr[64 * j]; }
#pragma unroll
        for (int r = 0; r < 4; ++r) { float a = 0.f;
#pragma unroll
            for (int j = 0; j < 4; ++j) a += (v[r][j].x * v[r][j].x + v[r][j].y * v[r][j].y) + (v[r][j].z * v[r][j].z + v[r][j].w * v[r][j].w);
            s[r] = rsqrtf(wave_sum(a) * (1.f / D) + EPS); }
#pragma unroll
        for (int j = 0; j < 4; ++j) {
            const int col = 4 * C.lane + 256 * j;
            const f32x4 g = *(const f32x4*)(gamma + col), sh = *(const f32x4*)(mod + b * 6144 + sh_off + col), sc = *(const f32x4*)(mod + b * 6144 + sc_off + col);
            const f32x4 gs = g * (sc + 1.f);
#pragma unroll
            for (int r = 0; r < 4; ++r) { const f32x4 y = v[r][j] * s[r] * gs + sh; u32x2 w; w.x = pk2(y.x, y.y); w.y = pk2(y.z, y.w);
                st_wt8((u32x2*)(dst + (size_t)(row0 + r) * D) + C.lane + 64 * j, w); }
        }
    }
}

__device__ __forceinline__ void p_rownorm_b(const Ctx& C, const bf16_t* X, const float* gamma, int sh_off, int sc_off, bf16_t* dst) {
    const float* mod = C.f32p(WS_MOD);
    const int gw = C.bid * NWAVES + C.wave, NGW = C.G * NWAVES;
    for (int row0 = gw * 4; row0 < T; row0 += NGW * 4) {
        const int b = row0 / SEQ;
        u32x2 w[4][4]; float s[4];
#pragma unroll
        for (int r = 0; r < 4; ++r)
#pragma unroll
            for (int j = 0; j < 4; ++j) w[r][j] = *((const u32x2*)(X + (size_t)(row0 + r) * D) + C.lane + 64 * j);
        f32x4 v[4][4];
#pragma unroll
        for (int r = 0; r < 4; ++r) { float a = 0.f;
#pragma unroll
            for (int j = 0; j < 4; ++j) { v[r][j].x = bflo(w[r][j].x); v[r][j].y = bfhi(w[r][j].x); v[r][j].z = bflo(w[r][j].y); v[r][j].w = bfhi(w[r][j].y);
                a += (v[r][j].x * v[r][j].x + v[r][j].y * v[r][j].y) + (v[r][j].z * v[r][j].z + v[r][j].w * v[r][j].w); }
            s[r] = rsqrtf(wave_sum(a) * (1.f / D) + EPS); }
#pragma unroll
        for (int j = 0; j < 4; ++j) {
            const int col = 4 * C.lane + 256 * j;
            const f32x4 g = *(const f32x4*)(gamma + col), sh = *(const f32x4*)(mod + b * 6144 + sh_off + col), sc = *(const f32x4*)(mod + b * 6144 + sc_off + col);
            const f32x4 gs = g * (sc + 1.f);
#pragma unroll
            for (int r = 0; r < 4; ++r) { const f32x4 y = v[r][j] * s[r] * gs + sh; u32x2 o; o.x = pk2(y.x, y.y); o.y = pk2(y.z, y.w);
                st_wt8((u32x2*)(dst + (size_t)(row0 + r) * D) + C.lane + 64 * j, o); }
        }
    }
}

__device__ __forceinline__ void p_dt(const Ctx& C, const bf16_t* n1, const bf16_t* wdt, float* dt) {
    typedef short bf16x8 __attribute__((ext_vector_type(8)));
    const float* bf = C.in[8]; const float* bb = C.in[9];
    const int gw = C.bid * NWAVES + C.wave, NGW = C.G * NWAVES, lane = C.lane, g = lane >> 4, i16 = lane & 15;
    for (int tile = gw; tile < T / 16; tile += NGW) {
        const size_t t0 = (size_t)tile * 16;
        f32x4 a0 = (f32x4){0.f, 0.f, 0.f, 0.f}, a1 = a0;
#pragma unroll 8
        for (int ks = 0; ks < 32; ++ks) {
            const bf16x8 av = *(const bf16x8*)(n1 + (t0 + i16) * 1024 + ks * 32 + g * 8);
            const bf16x8 b0 = *(const bf16x8*)(wdt + (size_t)i16 * 1024 + ks * 32 + g * 8), b1 = *(const bf16x8*)(wdt + (size_t)(16 + i16) * 1024 + ks * 32 + g * 8);
            a0 = __builtin_amdgcn_mfma_f32_16x16x32_bf16(av, b0, a0, 0, 0, 0); a1 = __builtin_amdgcn_mfma_f32_16x16x32_bf16(av, b1, a1, 0, 0, 0); }
        const float bias0 = bf[i16], bias1 = bb[i16];
#pragma unroll
        for (int r = 0; r < 4; ++r) { dt[(t0 + 4 * g + r) * 32 + i16] = softplus_f(a0[r] + bias0); dt[(t0 + 4 * g + r) * 32 + 16 + i16] = softplus_f(a1[r] + bias1); }
    }
}

__device__ __forceinline__ void p_conv(const Ctx& C, const bf16_t* xbc, bf16_t* xc) {
    const float* cw = C.in[6]; const float* cb = C.in[7];
    const int gt = C.bid * NTHR + C.tid, NT = C.G * NTHR;
    for (int i = gt; i < (T / 8) * 256; i += NT) {
        const int cg = i & 255, run = i >> 8, t0 = run * 8, l0 = t0 & (SEQ - 1), ch = cg * 8;
        float w[5][8], acc[8][8];
#pragma unroll
        for (int j = 0; j < 5; ++j) { const f32x4 w0 = *(const f32x4*)(cw + j * 2048 + ch), w1 = *(const f32x4*)(cw + j * 2048 + ch + 4);
            w[j][0] = w0.x; w[j][1] = w0.y; w[j][2] = w0.z; w[j][3] = w0.w; w[j][4] = w1.x; w[j][5] = w1.y; w[j][6] = w1.z; w[j][7] = w1.w; }
        { const f32x4 b0 = *(const f32x4*)(cb + ch), b1 = *(const f32x4*)(cb + ch + 4);
#pragma unroll
          for (int o = 0; o < 8; ++o) { acc[o][0] = b0.x; acc[o][1] = b0.y; acc[o][2] = b0.z; acc[o][3] = b0.w; acc[o][4] = b1.x; acc[o][5] = b1.y; acc[o][6] = b1.z; acc[o][7] = b1.w; } }
        u32x4 rw[12];
#pragma unroll
        for (int rr = 0; rr < 12; ++rr) { const int ll = l0 + rr - 2; rw[rr] = (u32x4){0u, 0u, 0u, 0u};
            if (ll >= 0 && ll < SEQ) rw[rr] = *(const u32x4*)(xbc + (size_t)(t0 + rr - 2) * 2048 + ch); }
#pragma unroll
        for (int rr = 0; rr < 12; ++rr) {
            const float x[8] = {bflo(rw[rr].x), bfhi(rw[rr].x), bflo(rw[rr].y), bfhi(rw[rr].y), bflo(rw[rr].z), bfhi(rw[rr].z), bflo(rw[rr].w), bfhi(rw[rr].w)};
#pragma unroll
            for (int j = 0; j < 5; ++j) { const int o = rr - j; if (o >= 0 && o < 8) {
#pragma unroll
                for (int q = 0; q < 8; ++q) acc[o][q] += w[j][q] * x[q]; } }
        }
#pragma unroll
        for (int o = 0; o < 8; ++o) { u32x4 ov; ov.x = pk2(silu_f(acc[o][0]), silu_f(acc[o][1])); ov.y = pk2(silu_f(acc[o][2]), silu_f(acc[o][3])); ov.z = pk2(silu_f(acc[o][4]), silu_f(acc[o][5])); ov.w = pk2(silu_f(acc[o][6]), silu_f(acc[o][7]));
            st_wt16(xc + (size_t)(t0 + o) * 2048 + ch, ov); }
    }
}

__device__ __forceinline__ void p_conv_fix(const Ctx& C, const bf16_t* edge, bf16_t* xc) {
    const float* cw = C.in[6]; const float* cb = C.in[7];
    const int gt = C.bid * NTHR + C.tid, NT = C.G * NTHR;
    for (int i = gt; i < 128 * 8 * 4 * 32; i += NT) {
        const int cg = i & 31, rsel = (i >> 5) & 3, pnl = (i >> 7) & 7, pm = i >> 10, ch = pnl * 256 + cg * 8;
        const int r = rsel == 0 ? 0 : rsel == 1 ? 1 : rsel == 2 ? 254 : 255;
        float acc[8];
        { const f32x4 b0 = *(const f32x4*)(cb + ch), b1 = *(const f32x4*)(cb + ch + 4); acc[0] = b0.x; acc[1] = b0.y; acc[2] = b0.z; acc[3] = b0.w; acc[4] = b1.x; acc[5] = b1.y; acc[6] = b1.z; acc[7] = b1.w; }
#pragma unroll
        for (int j = 0; j < 5; ++j) {
            const int src = r + j - 2; int tp = pm, e; bool ok = true;
            if (src < 0) { tp = pm - 1; e = src + 8; ok = (pm & 15) != 0; }
            else if (src < 4) e = src;
            else if (src < 256) e = src - 248;
            else { tp = pm + 1; e = src - 256; ok = (pm & 15) != 15; }
            u32x4 rw = (u32x4){0u, 0u, 0u, 0u};
            if (ok) rw = *(const u32x4*)(edge + ((size_t)((tp * 8 + pnl) * 8 + e)) * 256 + cg * 8);
            const f32x4 w0 = *(const f32x4*)(cw + j * 2048 + ch), w1 = *(const f32x4*)(cw + j * 2048 + ch + 4);
            acc[0] += w0.x * bflo(rw.x); acc[1] += w0.y * bfhi(rw.x); acc[2] += w0.z * bflo(rw.y); acc[3] += w0.w * bfhi(rw.y);
            acc[4] += w1.x * bflo(rw.z); acc[5] += w1.y * bfhi(rw.z); acc[6] += w1.z * bflo(rw.w); acc[7] += w1.w * bfhi(rw.w); }
        u32x4 ov; ov.x = pk2(silu_f(acc[0]), silu_f(acc[1])); ov.y = pk2(silu_f(acc[2]), silu_f(acc[3])); ov.z = pk2(silu_f(acc[4]), silu_f(acc[5])); ov.w = pk2(silu_f(acc[6]), silu_f(acc[7]));
        st_wt16(xc + (size_t)(pm * 256 + r) * 2048 + ch, ov);
    }
}

namespace ssd {
typedef short bf16x8 __attribute__((ext_vector_type(8)));
typedef short s16x4 __attribute__((ext_vector_type(4)));
constexpr int RS = 272, RSX = 144;
constexpr int CN = 0, BN = 34816, BS = 69632, SL = 104448, SLB = 17408, XN = 139264, CSB = 157696;
__device__ __forceinline__ unsigned pkbf(float lo, float hi) { return pk2(lo, hi); }
__device__ __forceinline__ bf16x8 trfrag_p(LAS unsigned char* base, int stride, int ks, int c, int g, int q, int pp) {
    LAS unsigned char* a0 = base + (32 * ks + 4 * g + q) * stride + 32 * c + 8 * pp;
    const s16x4 v0 = __builtin_amdgcn_ds_read_tr16_b64_v4i16((LAS s16x4*)a0);
    const s16x4 v1 = __builtin_amdgcn_ds_read_tr16_b64_v4i16((LAS s16x4*)(a0 + 16 * stride));
    bf16x8 r; r[0] = v0[0]; r[1] = v0[1]; r[2] = v0[2]; r[3] = v0[3]; r[4] = v1[0]; r[5] = v1[1]; r[6] = v1[2]; r[7] = v1[3]; return r;
}
}
__device__ __forceinline__ void p_ssd(const Ctx& C, const bf16_t* xc, const float* dtb, bf16_t* yf, bf16_t* yb) {
    using namespace ssd;
    LAS unsigned char* L = C.lds;
    const int tid = C.tid, lane = C.lane, w = C.wave, g = lane >> 4, i16 = lane & 15, q = (lane >> 2) & 3, pp = lane & 3;
    for (int unit = C.bid; unit < 256; unit += C.G) {
        const int dir = unit & 1, hd = (unit >> 1) & 15, b = unit >> 5, grp = hd >> 2;
        const float a = -__expf((dir ? C.in[11] : C.in[10])[hd]);
        const float dsk = dir ? 0.f : C.in[12][hd];
        bf16_t* yout = dir ? yb : yf;
        f32x4 sacc[4];
#pragma unroll
        for (int pt = 0; pt < 4; ++pt) sacc[pt] = (f32x4){0.f, 0.f, 0.f, 0.f};
        __syncthreads();
        for (int i = tid; i < 2 * SLB / 4; i += NTHR) ((LAS unsigned*)(L + SL))[i] = 0u;
        u32x4 pfC[4], pfB[4], pfX[2]; float pfd0 = 0.f, pfd1 = 0.f;
#define SSD_ISSUE(ci_) do { const int c_ = dir ? (31 - (ci_)) : (ci_); const size_t t0_ = (size_t)b * SEQ + (size_t)c_ * 128; \
            _Pragma("unroll") for (int i_ = 0; i_ < 4; ++i_) { const int idx_ = tid + NTHR * i_, l_ = idx_ >> 4, cc_ = idx_ & 15; const bf16_t* rp_ = xc + (t0_ + l_) * 2048 + grp * 128 + cc_ * 8; \
                pfB[i_] = *(const u32x4*)(rp_ + 1024); pfC[i_] = *(const u32x4*)(rp_ + 1536); } \
            _Pragma("unroll") for (int i_ = 0; i_ < 2; ++i_) { const int idx_ = tid + NTHR * i_, l_ = idx_ >> 3, cc_ = idx_ & 7; pfX[i_] = *(const u32x4*)(xc + (t0_ + l_) * 2048 + hd * 64 + cc_ * 8); } \
            if (w == 0) { const int l0_ = dir ? (127 - 2 * lane) : (2 * lane), l1_ = dir ? (126 - 2 * lane) : (2 * lane + 1); \
                pfd0 = dtb[(t0_ + l0_) * 32 + dir * 16 + hd]; pfd1 = dtb[(t0_ + l1_) * 32 + dir * 16 + hd]; } } while (0)
#define SSD_SCAN(buf_) do { if (w == 0) { const float da0_ = pfd0 * a, da1_ = pfd1 * a; const float p1_ = da0_ + da1_; float s_ = p1_; \
            s_ += __int_as_float(__builtin_amdgcn_update_dpp(0, __float_as_int(s_), 0x111, 0xF, 0xF, false)); s_ += __int_as_float(__builtin_amdgcn_update_dpp(0, __float_as_int(s_), 0x112, 0xF, 0xF, false)); \
            s_ += __int_as_float(__builtin_amdgcn_update_dpp(0, __float_as_int(s_), 0x114, 0xF, 0xF, false)); s_ += __int_as_float(__builtin_amdgcn_update_dpp(0, __float_as_int(s_), 0x118, 0xF, 0xF, false)); \
            s_ += __int_as_float(__builtin_amdgcn_update_dpp(0, __float_as_int(s_), 0x142, 0xA, 0xF, false)); s_ += __int_as_float(__builtin_amdgcn_update_dpp(0, __float_as_int(s_), 0x143, 0xC, 0xF, false)); \
            const float ex_ = s_ - p1_, cs0_ = ex_ + da0_, cs1_ = ex_ + p1_, tot_ = __int_as_float(__builtin_amdgcn_readlane(__float_as_int(s_), 63)); \
            const int l0_ = dir ? (127 - 2 * lane) : (2 * lane), l1_ = dir ? (126 - 2 * lane) : (2 * lane + 1); \
            LAS float* cb_ = (LAS float*)(L + CSB + (buf_) * 1536); \
            cb_[l0_] = cs0_; cb_[l1_] = cs1_; cb_[128 + l0_] = pfd0; cb_[128 + l1_] = pfd1; cb_[256 + l0_] = pfd0 * __expf(tot_ - cs0_); cb_[256 + l1_] = pfd1 * __expf(tot_ - cs1_); \
            if (lane == 0) *(LAS float*)(L + CSB + 3072 + 8 * (buf_)) = tot_; } } while (0)
#define SSD_WRITE(buf_) do { const LAS float* dw_ = (const LAS float*)(L + CSB + (buf_) * 1536 + 1024); float scv_[4]; \
            _Pragma("unroll") for (int i_ = 0; i_ < 4; ++i_) scv_[i_] = dw_[(tid + NTHR * i_) >> 4]; \
            _Pragma("unroll") for (int i_ = 0; i_ < 4; ++i_) { const int idx_ = tid + NTHR * i_, l_ = idx_ >> 4, cc_ = idx_ & 15; \
                *(LAS u32x4*)(L + CN + l_ * RS + cc_ * 16) = pfC[i_]; *(LAS u32x4*)(L + BN + l_ * RS + cc_ * 16) = pfB[i_]; \
                const float sc_ = scv_[i_]; const u32x4 v_ = pfB[i_]; u32x4 o_; \
                o_.x = pkbf(bflo(v_.x) * sc_, bfhi(v_.x) * sc_); o_.y = pkbf(bflo(v_.y) * sc_, bfhi(v_.y) * sc_); o_.z = pkbf(bflo(v_.z) * sc_, bfhi(v_.z) * sc_); o_.w = pkbf(bflo(v_.w) * sc_, bfhi(v_.w) * sc_); \
                *(LAS u32x4*)(L + BS + l_ * RS + cc_ * 16) = o_; } \
            _Pragma("unroll") for (int i_ = 0; i_ < 2; ++i_) { const int idx_ = tid + NTHR * i_, l_ = idx_ >> 3, cc_ = idx_ & 7; *(LAS u32x4*)(L + XN + l_ * RSX + cc_ * 16) = pfX[i_]; } } while (0)
        SSD_ISSUE(0);
        SSD_SCAN(0);
        __syncthreads();
        SSD_WRITE(0);
        __syncthreads();
        for (int ci = 0; ci < 32; ++ci) {
            const int buf = ci & 1;
            const int c = dir ? (31 - ci) : ci; const size_t t0 = (size_t)b * SEQ + (size_t)c * 128;
            if (ci + 1 < 32) SSD_ISSUE(ci + 1);
            const LAS float* csb = (const LAS float*)(L + CSB + buf * 1536);
            const float cs_l = csb[16 * w + i16];
            const float cs_end = *(const LAS float*)(L + CSB + 3072 + 8 * buf);
            bf16x8 cfrag[4];
#pragma unroll
            for (int ks = 0; ks < 4; ++ks) cfrag[ks] = *(const LAS bf16x8*)(L + CN + (16 * w + i16) * RS + ks * 64 + g * 16);
            u32x2 mreg[8];
            const int lrow = 16 * w + i16;
            bf16x8 afb[2][4]; f32x4 csv[2], dtv[2];
#define SSD_LD1(st_, bb_) do { _Pragma("unroll") for (int ks = 0; ks < 4; ++ks) afb[bb_][ks] = *(const LAS bf16x8*)(L + BN + (16 * (st_) + i16) * RS + ks * 64 + g * 16); \
                csv[bb_] = *(const LAS f32x4*)(csb + 16 * (st_) + 4 * g); dtv[bb_] = *(const LAS f32x4*)(csb + 128 + 16 * (st_) + 4 * g); } while (0)
            SSD_LD1(0, 0);
#pragma unroll
            for (int st = 0; st < 8; ++st) {
                if (st < 7) SSD_LD1(st + 1, (st + 1) & 1);
                asm volatile("" ::: "memory");
                f32x4 acc = (f32x4){0.f, 0.f, 0.f, 0.f};
#pragma unroll
                for (int ks = 0; ks < 4; ++ks) acc = __builtin_amdgcn_mfma_f32_16x16x32_bf16(afb[st & 1][ks], cfrag[ks], acc, 0, 0, 0);
                const f32x4 cs_s = csv[st & 1], dt_s = dtv[st & 1];
                float mv[4];
#pragma unroll
                for (int r = 0; r < 4; ++r) { const int srow = 16 * st + 4 * g + r; const bool valid = dir ? (srow >= lrow) : (srow <= lrow);
                    const float e = valid ? __expf(cs_l - cs_s[r]) : 0.f; mv[r] = acc[r] * dt_s[r] * e; }
                mreg[st].x = pkbf(mv[0], mv[1]); mreg[st].y = pkbf(mv[2], mv[3]);
            }
#undef SSD_LD1
            f32x4 yacc[4];
            const float el = __expf(cs_l);
#pragma unroll
            for (int ph = 0; ph < 2; ++ph) { bf16x8 sf[2][4];
#pragma unroll
                for (int pi = 0; pi < 2; ++pi)
#pragma unroll
                    for (int ks = 0; ks < 4; ++ks) sf[pi][ks] = *(const LAS bf16x8*)(L + SL + buf * SLB + (16 * (2 * ph + pi) + i16) * RS + ks * 64 + g * 16);
                asm volatile("" ::: "memory");
#pragma unroll
                for (int pi = 0; pi < 2; ++pi) { f32x4 acc = (f32x4){0.f, 0.f, 0.f, 0.f};
#pragma unroll
                    for (int ks = 0; ks < 4; ++ks) acc = __builtin_amdgcn_mfma_f32_16x16x32_bf16(sf[pi][ks], cfrag[ks], acc, 0, 0, 0);
                    yacc[2 * ph + pi] = acc * el; } }
            bf16x8 xfa[4][4], bfa[4];
#pragma unroll
            for (int ks = 0; ks < 4; ++ks)
#pragma unroll
                for (int pt = 0; pt < 4; ++pt) xfa[ks][pt] = trfrag_p(L + XN, RSX, ks, pt, g, q, pp);
#pragma unroll
            for (int ks = 0; ks < 4; ++ks) bfa[ks] = trfrag_p(L + BS, RS, ks, w, g, q, pp);
            asm volatile("" ::: "memory");
#pragma unroll
            for (int ks = 0; ks < 4; ++ks) { u32x4 mw; mw.x = mreg[2 * ks].x; mw.y = mreg[2 * ks].y; mw.z = mreg[2 * ks + 1].x; mw.w = mreg[2 * ks + 1].y;
                const bf16x8 mf = __builtin_bit_cast(bf16x8, mw);
#pragma unroll
                for (int pt = 0; pt < 4; ++pt) yacc[pt] = __builtin_amdgcn_mfma_f32_16x16x32_bf16(xfa[ks][pt], mf, yacc[pt], 0, 0, 0); }
            u32x2 xvv[4];
#pragma unroll
            for (int pt = 0; pt < 4; ++pt) xvv[pt] = *(const LAS u32x2*)(L + XN + lrow * RSX + (16 * pt + 4 * g) * 2);
            asm volatile("" ::: "memory");
#pragma unroll
            for (int pt = 0; pt < 4; ++pt) { const u32x2 xv = xvv[pt];
                u32x2 o; o.x = pkbf(yacc[pt][0] + dsk * bflo(xv.x), yacc[pt][1] + dsk * bfhi(xv.x)); o.y = pkbf(yacc[pt][2] + dsk * bflo(xv.y), yacc[pt][3] + dsk * bfhi(xv.y));
                *(u32x2*)(yout + (t0 + lrow) * 1024 + hd * 64 + 16 * pt + 4 * g) = o; }
            { const float dec = __expf(cs_end);
#pragma unroll
              for (int pt = 0; pt < 4; ++pt) sacc[pt] = sacc[pt] * dec; }
#pragma unroll
            for (int ks = 0; ks < 4; ++ks)
#pragma unroll
                for (int pt = 0; pt < 4; ++pt) sacc[pt] = __builtin_amdgcn_mfma_f32_16x16x32_bf16(bfa[ks], xfa[ks][pt], sacc[pt], 0, 0, 0);
#pragma unroll
            for (int pt = 0; pt < 4; ++pt) { u32x2 o; o.x = pkbf(sacc[pt][0], sacc[pt][1]); o.y = pkbf(sacc[pt][2], sacc[pt][3]);
                *(LAS u32x2*)(L + SL + (buf ^ 1) * SLB + (16 * pt + i16) * RS + (16 * w + 4 * g) * 2) = o; }
            if (ci + 1 < 32) SSD_SCAN(buf ^ 1);
            __syncthreads();
            if (ci + 1 < 32) SSD_WRITE(buf ^ 1);
            __syncthreads();
        }
#undef SSD_ISSUE
#undef SSD_SCAN
#undef SSD_WRITE
    }
}

namespace nat {
typedef short bf16x8 __attribute__((ext_vector_type(8)));
typedef short s16x4 __attribute__((ext_vector_type(4)));
constexpr int VH = 73728, RPB = 147456;
__device__ __forceinline__ int voff(int ks, int d) { return ks * 128 + ((((d >> 3) ^ (ks & 7))) << 4) + (d & 7) * 2; }
__device__ __forceinline__ int clampi(int x, int lo, int hi) { return x < lo ? lo : (x > hi ? hi : x); }
}
__device__ __forceinline__ void p_na(const Ctx& C, bf16_t* q, const bf16_t* k, const bf16_t* v) {
    using namespace nat;
    LAS unsigned char* L = C.lds;
    const float* rpb = C.in[15];
    const int tid = C.tid, lane = C.lane, w = C.wave, g = lane >> 4, i16 = lane & 15, qq = (lane >> 2) & 3, pp = lane & 3;
    const int hl = w >> 2, m = w & 3;
    const int bs = (m == 0) ? 0 : (m == 1) ? 8 : (m == 2) ? 24 : 32;
    const int qc = 16 * m + i16, wsx = clampi(qc - 8, 0, 48);
    float madd[8]; int dcol[8];
#pragma unroll
    for (int c = 0; c < 8; ++c) { const int kc = bs + (c >> 2) * 16 + 4 * g + (c & 3); madd[c] = (kc >= wsx && kc < wsx + 16) ? 0.f : -1.0e30f; dcol[c] = clampi(kc - qc + 15, 0, 30); }
    for (int unit = C.bid; unit < 256; unit += C.G) {
        const int rseg = unit & 3, hp = (unit >> 2) & 7, b = unit >> 5, h = 2 * hp + hl;
        __syncthreads();
        for (int i = tid; i < 930; i += NTHR) ((LAS float*)(L + RPB))[i] = rpb[(2 * hp) * 465 + i];
#define NA_LOAD_ROW(row_) do { _Pragma("unroll") for (int i_ = 0; i_ < 2; ++i_) { const int idx_ = tid + NTHR * i_, hl_ = idx_ >> 9, col_ = (idx_ >> 3) & 63, dch_ = idx_ & 7; \
            const u32x4 val_ = *(const u32x4*)(v + ((size_t)b * SEQ + (size_t)(row_) * 64 + col_) * 1024 + (2 * hp + hl_) * 64 + dch_ * 8); \
            *(LAS u32x4*)(L + hl_ * VH + voff(((row_) % 9) * 64 + col_, dch_ * 8)) = val_; } } while (0)
#define NA_FETCH_ROW(row_) do { _Pragma("unroll") for (int i_ = 0; i_ < 2; ++i_) { const int idx_ = tid + NTHR * i_, hl_ = idx_ >> 9, col_ = (idx_ >> 3) & 63, dch_ = idx_ & 7; \
            vpre[i_] = *(const u32x4*)(v + ((size_t)b * SEQ + (size_t)(row_) * 64 + col_) * 1024 + (2 * hp + hl_) * 64 + dch_ * 8); } } while (0)
#define NA_STORE_ROW(row_) do { _Pragma("unroll") for (int i_ = 0; i_ < 2; ++i_) { const int idx_ = tid + NTHR * i_, hl_ = idx_ >> 9, col_ = (idx_ >> 3) & 63, dch_ = idx_ & 7; \
            *(LAS u32x4*)(L + hl_ * VH + voff(((row_) % 9) * 64 + col_, dch_ * 8)) = vpre[i_]; } } while (0)
        u32x4 vpre[2] = {(u32x4){0u, 0u, 0u, 0u}, (u32x4){0u, 0u, 0u, 0u}};
        const int r0 = 16 * rseg; const int rs0 = clampi(r0 - 4, 0, 56);
        for (int rr = 0; rr < 8; ++rr) NA_LOAD_ROW(rs0 + rr);
        int pending = -1;
        { const int rs1 = clampi(r0 - 3, 0, 56); if (rs1 != rs0) { NA_FETCH_ROW(rs1 + 7); pending = rs1 + 7; } }
        __syncthreads();
        const LAS float* rpbl = (const LAS float*)(L + RPB) + hl * 465;
        const char* kbase = (const char*)(k + ((size_t)b * SEQ * 1024 + (size_t)h * 64));
        const unsigned koff = (unsigned)(((bs + i16) * 1024 + g * 8) * 2);
        unsigned lb[4];
#pragma unroll
        for (int dt = 0; dt < 4; ++dt) lb[dt] = (unsigned)(hl * VH + (bs + 4 * g + qq) * 128 + ((((2 * dt + (pp >> 1)) ^ ((4 * g + qq) & 7))) << 4) + 8 * (pp & 1));
        f32x4 bm[16]; int boff = -100;
        for (int s = 0; s < 16; ++s) {
            const int r = r0 + s, rs = clampi(r - 4, 0, 56);
            if (s > 0) __syncthreads();
            if (pending >= 0) { NA_STORE_ROW(pending); pending = -1; }
            if (s + 2 < 16) { const int rs1 = clampi(r - 3, 0, 56), rs2 = clampi(r - 2, 0, 56); if (rs2 != rs1) { NA_FETCH_ROW(rs2 + 7); pending = rs2 + 7; } }
            const size_t tokq = (size_t)b * SEQ + (size_t)r * 64 + qc;
            bf16x8 qf[2];
#pragma unroll
            for (int ks = 0; ks < 2; ++ks) qf[ks] = *(const bf16x8*)(q + tokq * 1024 + h * 64 + ks * 32 + g * 8);
            f32x4 sc[16];
#pragma unroll
            for (int kt = 0; kt < 16; ++kt) { const char* kbu = kbase + (size_t)((rs + (kt >> 1)) * 64 + (kt & 1) * 16) * 2048;
                f32x4 acc = (f32x4){0.f, 0.f, 0.f, 0.f};
#pragma unroll
                for (int ks = 0; ks < 2; ++ks) { const bf16x8 kf = *(const bf16x8*)(kbu + koff + ks * 64); acc = __builtin_amdgcn_mfma_f32_16x16x32_bf16(kf, qf[ks], acc, 0, 0, 0); }
                sc[kt] = acc; }
            if (rs - r != boff) {
                boff = rs - r;
#pragma unroll
                for (int kt = 0; kt < 16; ++kt) { const int drow = boff + (kt >> 1) + 7;
#pragma unroll
                    for (int e = 0; e < 4; ++e) { const int c = (kt & 1) * 4 + e; bm[kt][e] = rpbl[drow * 31 + dcol[c]] * 1.44269504f + madd[c]; } } }
            float mx = -1.0e30f;
#pragma unroll
            for (int kt = 0; kt < 16; ++kt)
#pragma unroll
                for (int e = 0; e < 4; ++e) { const float val = sc[kt][e] + bm[kt][e]; sc[kt][e] = val; mx = fmaxf(mx, val); }
            mx = fmaxf(mx, __shfl_xor(mx, 16)); mx = fmaxf(mx, __shfl_xor(mx, 32));
            float sum = 0.f;
#pragma unroll
            for (int kt = 0; kt < 16; ++kt)
#pragma unroll
                for (int e = 0; e < 4; ++e) { const float p = __builtin_amdgcn_exp2f(sc[kt][e] - mx); sc[kt][e] = p; sum += p; }
            sum += __shfl_xor(sum, 16); sum += __shfl_xor(sum, 32);
            f32x4 o[4];
#pragma unroll
            for (int dt = 0; dt < 4; ++dt) o[dt] = (f32x4){0.f, 0.f, 0.f, 0.f};
#pragma unroll
            for (int kk = 0; kk < 8; ++kk) {
                u32x4 pw; pw.x = pk2(sc[2 * kk][0], sc[2 * kk][1]); pw.y = pk2(sc[2 * kk][2], sc[2 * kk][3]); pw.z = pk2(sc[2 * kk + 1][0], sc[2 * kk + 1][1]); pw.w = pk2(sc[2 * kk + 1][2], sc[2 * kk + 1][3]);
                const bf16x8 pf = __builtin_bit_cast(bf16x8, pw);
                const unsigned sl = (unsigned)(((rs + kk) % 9) * 8192);
#pragma unroll
                for (int dt = 0; dt < 4; ++dt) {
                    LAS unsigned char* vp = L + (lb[dt] + sl);
                    const s16x4 v0 = __builtin_amdgcn_ds_read_tr16_b64_v4i16((LAS s16x4*)vp);
                    const s16x4 v1 = __builtin_amdgcn_ds_read_tr16_b64_v4i16((LAS s16x4*)(vp + 2048));
                    bf16x8 vf; vf[0] = v0[0]; vf[1] = v0[1]; vf[2] = v0[2]; vf[3] = v0[3]; vf[4] = v1[0]; vf[5] = v1[1]; vf[6] = v1[2]; vf[7] = v1[3];
                    o[dt] = __builtin_amdgcn_mfma_f32_16x16x32_bf16(vf, pf, o[dt], 0, 0, 0); }
            }
            const float inv = __builtin_amdgcn_rcpf(sum);
#pragma unroll
            for (int dt = 0; dt < 4; ++dt) { u32x2 ov; ov.x = pk2(o[dt][0] * inv, o[dt][1] * inv); ov.y = pk2(o[dt][2] * inv, o[dt][3] * inv);
                *(u32x2*)(q + tokq * 1024 + h * 64 + 16 * dt + 4 * g) = ov; }
        }
#undef NA_LOAD_ROW
#undef NA_FETCH_ROW
#undef NA_STORE_ROW
    }
    __syncthreads();
}

__device__ __forceinline__ void p_cvt_tables8(const Ctx& C, unsigned char* u8, unsigned char* v8) {
    const int gt = C.bid * NTHR + C.tid, NT = C.G * NTHR;
    const float* u = C.in[21]; const float* v = C.in[22];
    constexpr int N4 = 16384 * 1024 / 4;
    for (int i0 = gt; i0 < N4; i0 += 4 * NT) {
        f32x4 a[4], b[4];
#pragma unroll
        for (int r = 0; r < 4; ++r) { const int i = i0 + r * NT; if (i < N4) { a[r] = __builtin_nontemporal_load((const f32x4*)(u + (size_t)i * 4)); b[r] = __builtin_nontemporal_load((const f32x4*)(v + (size_t)i * 4)); } }
#pragma unroll
        for (int r = 0; r < 4; ++r) { const int i = i0 + r * NT; if (i < N4) {
            const f32x4 av = a[r] * 256.f, bv = b[r] * 64.f; unsigned x = 0u, y = 0u;
            x = __builtin_amdgcn_cvt_pk_fp8_f32(av.x, av.y, x, false); x = __builtin_amdgcn_cvt_pk_fp8_f32(av.z, av.w, x, true);
            y = __builtin_amdgcn_cvt_pk_fp8_f32(bv.x, bv.y, y, false); y = __builtin_amdgcn_cvt_pk_fp8_f32(bv.z, bv.w, y, true);
            __hip_atomic_store((unsigned*)(u8 + (size_t)i * 4), x, __ATOMIC_RELAXED, __HIP_MEMORY_SCOPE_SYSTEM); __hip_atomic_store((unsigned*)(v8 + (size_t)i * 4), y, __ATOMIC_RELAXED, __HIP_MEMORY_SCOPE_SYSTEM); } }
    }
}

template <int CTRL> __device__ __forceinline__ float dppf(float x) { return __int_as_float(__builtin_amdgcn_update_dpp(0, __float_as_int(x), CTRL, 0xF, 0xF, false)); }
constexpr int DPP_HMIRROR = 0x141, DPP_XOR2 = 0x4E, DPP_XOR1 = 0xB1, DPP_ROR8 = 0x128;
__device__ __forceinline__ int idx16(const u32x4& a, const u32x4& b, int i) { const unsigned w = (i < 8 ? a : b)[(i & 7) >> 1]; return (int)((i & 1) ? (w >> 16) : (w & 0xffffu)); }
__device__ __forceinline__ int gslot(int R) { return 16 * (R & 7) + (R >> 3); }
#define GQ_DMA(tab_, qi_, mi_) do { const u32x2 iw_ = *(const LAS u32x2*)(meta + (mi_) * MSTRIDE + 32 * (lane >> 3) + 8 * (qi_)); \
        _Pragma("unroll") for (int k_ = 0; k_ < 4; ++k_) { const int kk_ = 4 * (qi_) + k_, R_ = 8 * kk_ + (lane >> 3); \
            const unsigned e_ = (k_ & 1) ? ((k_ < 2 ? iw_.x : iw_.y) >> 16) : ((k_ < 2 ? iw_.x : iw_.y) & 0xffffu); \
            const unsigned char* src_ = (tab_) + (size_t)e_ * 1024 + 128 * j + 16 * ((lane & 7) ^ ((R_ >> 1) & 7)); \
            __builtin_amdgcn_global_load_lds((const unsigned*)src_, (LAS unsigned*)(img + kk_ * 1024), 16, 0, 0); } } while (0)
#define GQ_IW(qi_, mi_) (*(const LAS u32x2*)(meta + (mi_) * MSTRIDE + 32 * (lane >> 3) + 8 * (qi_)))
#define GQ_DMAW(tab_, qi_, iw_) do { _Pragma("unroll") for (int k_ = 0; k_ < 4; ++k_) { const int kk_ = 4 * (qi_) + k_, R_ = 8 * kk_ + (lane >> 3); \
            const unsigned e_ = (k_ & 1) ? ((k_ < 2 ? (iw_).x : (iw_).y) >> 16) : ((k_ < 2 ? (iw_).x : (iw_).y) & 0xffffu); \
            const unsigned char* src_ = (tab_) + (size_t)e_ * 1024 + 128 * j + 16 * ((lane & 7) ^ ((R_ >> 1) & 7)); \
            __builtin_amdgcn_global_load_lds((const unsigned*)src_, (LAS unsigned*)(img + kk_ * 1024), 16, 0, 0); } } while (0)
#define GQ_WAIT(n_) asm volatile("s_waitcnt vmcnt(" #n_ ")" ::: "memory")
#define GQ_LWAIT() asm volatile("s_waitcnt lgkmcnt(0)" ::: "memory")
__device__ __forceinline__ void p_gu(const Ctx& C, const bf16_t* n2, const unsigned short* pidx, const unsigned char* u8, float* pd) {
    const int j = C.bid & 7, nsl = C.G >> 3, NW = nsl * NWAVES, wsl = (C.bid >> 3) * NWAVES + C.wave, lane = C.lane, i16 = lane & 15, g = lane >> 4;
    if ((C.bid >> 3) >= nsl) return;
    constexpr int MSTRIDE = 512;
    LAS unsigned char* img = C.lds + 16384 + C.wave * 16384;
    LAS unsigned char* meta = C.lds + 4096 + C.wave * (3 * MSTRIDE);
    LAS unsigned char* xq = C.lds + C.wave * 256;
#define GU_META(t_, mi_) do { const int tt_ = (t_) < T ? (t_) : wsl; \
        __builtin_amdgcn_global_load_lds((const unsigned*)((const unsigned char*)(pidx + (size_t)tt_ * 128) + 4 * lane), (LAS unsigned*)(meta + (mi_) * MSTRIDE), 4, 0, 0); \
        __builtin_amdgcn_global_load_lds((const unsigned*)((const unsigned char*)(n2 + (size_t)tt_ * 1024 + 128 * j) + 4 * lane), (LAS unsigned*)(meta + (mi_) * MSTRIDE + 256), 4, 0, 0); } while (0)
    GU_META(wsl, 0); GU_META(wsl + NW, 1);
    GQ_WAIT(0);
    GQ_DMA(u8, 0, 0); GQ_DMA(u8, 1, 0); GQ_DMA(u8, 2, 0); GQ_DMA(u8, 3, 0);
    GQ_WAIT(0);
    int mi = 0;
    for (int t = wsl; t < T; t += NW) {
        const int mi1 = mi == 2 ? 0 : mi + 1, mi2 = mi1 == 2 ? 0 : mi1 + 1;
        GU_META(t + 2 * NW, mi2);
        { const unsigned xcur = *(const LAS unsigned*)(meta + mi * MSTRIDE + 256 + 4 * lane);
          const float x0 = bflo(xcur) * 16.f, x1 = bfhi(xcur) * 16.f;
          const unsigned hw = __builtin_amdgcn_cvt_pk_fp8_f32(x0, x1, 0u, false);
          const f32x2_t h01 = __builtin_amdgcn_cvt_pk_f32_fp8(hw, false);
          const unsigned lw = __builtin_amdgcn_cvt_pk_fp8_f32((x0 - h01.x) * 16.f, (x1 - h01.y) * 16.f, 0u, false);
          *(LAS unsigned short*)(xq + 2 * lane) = (unsigned short)(hw & 0xffffu); *(LAS unsigned short*)(xq + 128 + 2 * lane) = (unsigned short)(lw & 0xffffu); }
        GQ_LWAIT();
        long bq[4];
#pragma unroll
        for (int ks = 0; ks < 4; ++ks) bq[ks] = *(const LAS long*)(xq + (i16 & 1) * 128 + 32 * ks + 8 * g);
        f32x4 o[8]; u32x2 iw[4];
#pragma unroll
        for (int qi = 0; qi < 4; ++qi) {
            GQ_WAIT(18);
            if (qi == 0) {
#pragma unroll
                for (int q2 = 0; q2 < 4; ++q2) iw[q2] = GQ_IW(q2, mi1); }
            {
                long av[2][4];
#pragma unroll
                for (int t2 = 0; t2 < 2; ++t2) { const int R = 16 * (2 * qi + t2) + i16;
#pragma unroll
                    for (int ks = 0; ks < 4; ++ks) { const int sc = 2 * ks + (g >> 1); av[t2][ks] = *(const LAS long*)(img + R * 128 + ((sc ^ ((R >> 1) & 7)) << 4) + 8 * (g & 1)); } }
                GQ_LWAIT();
                GQ_DMAW(u8, qi, iw[qi]);
                f32x4 acc0 = (f32x4){0.f, 0.f, 0.f, 0.f}, acc1 = acc0;
#pragma unroll
                for (int ks = 0; ks < 4; ++ks) { acc0 = __builtin_amdgcn_mfma_f32_16x16x32_fp8_fp8(av[0][ks], bq[ks], acc0, 0, 0, 0); acc1 = __builtin_amdgcn_mfma_f32_16x16x32_fp8_fp8(av[1][ks], bq[ks], acc1, 0, 0, 0); }
#pragma unroll
                for (int r = 0; r < 4; ++r) { o[2 * qi][r] = (acc0[r] + dppf<DPP_XOR1>(acc0[r]) * 0.0625f) * (1.f / 4096.f); o[2 * qi + 1][r] = (acc1[r] + dppf<DPP_XOR1>(acc1[r]) * 0.0625f) * (1.f / 4096.f); }
            }
        }
#pragma unroll
        for (int k4 = 0; k4 < 4; ++k4) { if (i16 == 0) { u32x4 w; w.x = pk2(o[2 * k4][0], o[2 * k4][1]); w.y = pk2(o[2 * k4][2], o[2 * k4][3]); w.z = pk2(o[2 * k4 + 1][0], o[2 * k4 + 1][1]); w.w = pk2(o[2 * k4 + 1][2], o[2 * k4 + 1][3]);
            *(u32x4*)((bf16_t*)pd + ((size_t)j * T + t) * 128 + 32 * g + 8 * k4) = w; } }
        mi = mi1;
    }
    GQ_WAIT(0);
#undef GU_META
}
__device__ __forceinline__ void p_gc(const Ctx& C, const float* pd, const float* pgate, float* cc) {
    const int gt = C.bid * NTHR + C.tid, NT = C.G * NTHR; const bf16_t* pb = (const bf16_t*)pd;
    for (int i = gt; i < T * 32; i += NT) {
        f32x4 sdot = (f32x4){0.f, 0.f, 0.f, 0.f};
#pragma unroll
        for (int j = 0; j < 8; ++j) { const u32x2 w = *(const u32x2*)(pb + (size_t)j * T * 128 + (size_t)i * 4); sdot.x += bflo(w.x); sdot.y += bfhi(w.x); sdot.z += bflo(w.y); sdot.w += bfhi(w.y); }
        const int t_ = i >> 5, q = i & 31, R0 = 16 * (q & 7) + 4 * (q >> 3); const float* gp = pgate + (size_t)t_ * 128;
        f32x4 gv; gv.x = gp[gslot(R0)]; gv.y = gp[gslot(R0 + 1)]; gv.z = gp[gslot(R0 + 2)]; gv.w = gp[gslot(R0 + 3)];
        f32x4 o; o.x = gelu_f(sdot.x) * gv.x; o.y = gelu_f(sdot.y) * gv.y; o.z = gelu_f(sdot.z) * gv.z; o.w = gelu_f(sdot.w) * gv.w;
#pragma unroll
        for (int e = 0; e < 4; ++e) o[e] = __builtin_fminf(__builtin_fmaxf(o[e] * 64.f, -440.f), 440.f);
        unsigned hw = __builtin_amdgcn_cvt_pk_fp8_f32(o.x, o.y, 0u, false); hw = __builtin_amdgcn_cvt_pk_fp8_f32(o.z, o.w, hw, true);
        const f32x2_t h01 = __builtin_amdgcn_cvt_pk_f32_fp8(hw, false), h23 = __builtin_amdgcn_cvt_pk_f32_fp8(hw, true);
        unsigned lw = __builtin_amdgcn_cvt_pk_fp8_f32((o.x - h01.x) * 16.f, (o.y - h01.y) * 16.f, 0u, false); lw = __builtin_amdgcn_cvt_pk_fp8_f32((o.z - h23.x) * 16.f, (o.w - h23.y) * 16.f, lw, true);
        unsigned char* cb = (unsigned char*)cc + (size_t)t_ * 256 + R0;
        *(unsigned*)cb = hw; *(unsigned*)(cb + 128) = lw; }
}
__device__ __forceinline__ void p_gv(const Ctx& C, const float* cc, const unsigned short* pidx, const unsigned char* v8, bf16_t* op) {
    typedef int i32x2 __attribute__((ext_vector_type(2)));
    const int j = C.bid & 7, nsl = C.G >> 3, NW = nsl * NWAVES, wsl = (C.bid >> 3) * NWAVES + C.wave, lane = C.lane, i16 = lane & 15, g = lane >> 4;
    if ((C.bid >> 3) >= nsl) return;
    constexpr int MSTRIDE = 768;
    LAS unsigned char* img = C.lds + 24576 + C.wave * 16384;
    LAS unsigned char* meta = C.lds + 4096 + C.wave * (3 * MSTRIDE);
    const int tr_r = i16 >> 1, tr_c = i16 & 1;
    unsigned toff[8];
#pragma unroll
    for (int ct = 0; ct < 8; ++ct) toff[ct] = (unsigned)((ct ^ ((4 * g + (tr_r >> 1)) & 7)) << 4);
#define GV_META(t_, mi_) do { const int tt_ = (t_) < T ? (t_) : wsl; \
        __builtin_amdgcn_global_load_lds((const unsigned*)((const unsigned char*)(pidx + (size_t)tt_ * 128) + 4 * lane), (LAS unsigned*)(meta + (mi_) * MSTRIDE), 4, 0, 0); \
        __builtin_amdgcn_global_load_lds((const unsigned*)((const unsigned char*)cc + (size_t)tt_ * 256 + 4 * lane), (LAS unsigned*)(meta + (mi_) * MSTRIDE + 256), 4, 0, 0); } while (0)
    GV_META(wsl, 0); GV_META(wsl + NW, 1);
    GQ_WAIT(0);
    GQ_DMA(v8, 0, 0); GQ_DMA(v8, 1, 0); GQ_DMA(v8, 2, 0); GQ_DMA(v8, 3, 0);
    GQ_WAIT(0);
    int mi = 0;
    for (int t = wsl; t < T; t += NW) {
        const int mi1 = mi == 2 ? 0 : mi + 1, mi2 = mi1 == 2 ? 0 : mi1 + 1;
        GV_META(t + 2 * NW, mi2);
        const LAS unsigned char* cq = meta + mi * MSTRIDE + 256;
        long aq[4];
#pragma unroll
        for (int ks = 0; ks < 4; ++ks) aq[ks] = *(const LAS long*)(cq + (i16 & 1) * 128 + 32 * ks + 8 * g);
        f32x4 acc[8]; u32x2 iw[4];
#pragma unroll
        for (int ct = 0; ct < 8; ++ct) acc[ct] = (f32x4){0.f, 0.f, 0.f, 0.f};
#pragma unroll
        for (int ks = 0; ks < 4; ++ks) {
            GQ_WAIT(22);
            if (ks == 0) {
#pragma unroll
                for (int q2 = 0; q2 < 4; ++q2) iw[q2] = GQ_IW(q2, mi1); }
            const unsigned rb = (unsigned)(size_t)(img + (32 * ks + 8 * g + tr_r) * 128 + 8 * tr_c);
            long b0, b1, b2, b3, b4, b5, b6, b7;
            asm volatile("ds_read_b64_tr_b8 %0, %8\n\tds_read_b64_tr_b8 %1, %9\n\tds_read_b64_tr_b8 %2, %10\n\tds_read_b64_tr_b8 %3, %11\n\t"
                         "ds_read_b64_tr_b8 %4, %12\n\tds_read_b64_tr_b8 %5, %13\n\tds_read_b64_tr_b8 %6, %14\n\tds_read_b64_tr_b8 %7, %15\n\ts_waitcnt lgkmcnt(0)"
                         : "=&v"(b0), "=&v"(b1), "=&v"(b2), "=&v"(b3), "=&v"(b4), "=&v"(b5), "=&v"(b6), "=&v"(b7)
                         : "v"(rb + toff[0]), "v"(rb + toff[1]), "v"(rb + toff[2]), "v"(rb + toff[3]), "v"(rb + toff[4]), "v"(rb + toff[5]), "v"(rb + toff[6]), "v"(rb + toff[7]) : "memory");
            acc[0] = __builtin_amdgcn_mfma_f32_16x16x32_fp8_fp8(aq[ks], b0, acc[0], 0, 0, 0); acc[1] = __builtin_amdgcn_mfma_f32_16x16x32_fp8_fp8(aq[ks], b1, acc[1], 0, 0, 0);
            acc[2] = __builtin_amdgcn_mfma_f32_16x16x32_fp8_fp8(aq[ks], b2, acc[2], 0, 0, 0); acc[3] = __builtin_amdgcn_mfma_f32_16x16x32_fp8_fp8(aq[ks], b3, acc[3], 0, 0, 0);
            acc[4] = __builtin_amdgcn_mfma_f32_16x16x32_fp8_fp8(aq[ks], b4, acc[4], 0, 0, 0); acc[5] = __builtin_amdgcn_mfma_f32_16x16x32_fp8_fp8(aq[ks], b5, acc[5], 0, 0, 0);
            acc[6] = __builtin_amdgcn_mfma_f32_16x16x32_fp8_fp8(aq[ks], b6, acc[6], 0, 0, 0); acc[7] = __builtin_amdgcn_mfma_f32_16x16x32_fp8_fp8(aq[ks], b7, acc[7], 0, 0, 0);
            GQ_DMAW(v8, ks, iw[ks]);
        }
#pragma unroll
        for (int ct = 0; ct < 8; ++ct) { if (g == 0) op[(size_t)t * 1024 + 128 * j + 16 * ct + i16] = (bf16_t)f2bf((acc[ct][0] + acc[ct][1] * 0.0625f) * (1.f / 4096.f)); }
        mi = mi1;
    }
    GQ_WAIT(0);
#undef GV_META
}
__device__ __forceinline__ void p_gf(const Ctx& C, const bf16_t* h, const bf16_t* op, float* out) {
    const float* mod = C.f32p(WS_MOD); const float* fg = C.in[23];
    const int gw = C.bid * NWAVES + C.wave, NGW = C.G * NWAVES, lane = C.lane;
    for (int t0 = gw * 2; t0 < T; t0 += NGW * 2) {
        const int b = t0 / SEQ;
        u32x2 ov[2][4], hw[2][4];
#pragma unroll
        for (int r = 0; r < 2; ++r)
#pragma unroll
            for (int d = 0; d < 4; ++d) { const size_t off = (size_t)(t0 + r) * 1024 + 256 * d + 4 * lane; ov[r][d] = __builtin_nontemporal_load((const u32x2*)(op + off)); hw[r][d] = __builtin_nontemporal_load((const u32x2*)(h + off)); }
        f32x4 mv[4], fv[4];
#pragma unroll
        for (int d = 0; d < 4; ++d) { mv[d] = *(const f32x4*)(mod + b * 6144 + 5120 + 256 * d + 4 * lane); fv[d] = *(const f32x4*)(fg + 256 * d + 4 * lane); }
#pragma unroll
        for (int r = 0; r < 2; ++r) { f32x4 hf[4]; float ss = 0.f;
#pragma unroll
            for (int d = 0; d < 4; ++d) { f32x4 hv, o4; hv.x = bflo(hw[r][d].x); hv.y = bfhi(hw[r][d].x); hv.z = bflo(hw[r][d].y); hv.w = bfhi(hw[r][d].y);
                o4.x = bflo(ov[r][d].x); o4.y = bfhi(ov[r][d].x); o4.z = bflo(ov[r][d].y); o4.w = bfhi(ov[r][d].y);
                hf[d] = hv + mv[d] * o4; ss += (hf[d].x * hf[d].x + hf[d].y * hf[d].y) + (hf[d].z * hf[d].z + hf[d].w * hf[d].w); }
            const float rstd = rsqrtf(wave_sum(ss) * (1.f / 1024.f) + EPS);
#pragma unroll
            for (int d = 0; d < 4; ++d) { const f32x4 ov_ = hf[d] * rstd * fv[d]; st_wt16(out + (size_t)(t0 + r) * 1024 + 256 * d + 4 * lane, __builtin_bit_cast(u32x4, ov_)); } }
    }
}

namespace pg8 {
#define PG8_LAS __attribute__((address_space(3)))
typedef unsigned short bf16_t;
typedef short bf16x8 __attribute__((ext_vector_type(8)));
typedef float f32x4 __attribute__((ext_vector_type(4)));
typedef unsigned u32x4 __attribute__((ext_vector_type(4)));
constexpr int BM = 256, BK = 64, HALF = 128, HTB = HALF * BK * 2  , STAGE_BYTES = 8 * HTB, NXCD = 8, WGM = 8;

__host__ __device__ __forceinline__ int lds_byte(int r, int c) { const int st = (r >> 4) * 2 + (c >> 5), rr = r & 15, cc = c & 31, ob = rr * 64 + cc * 2; return st * 1024 + (ob ^ (((ob >> 9) & 1) << 5)); }
__host__ __device__ __forceinline__ void stage_rc(int b, int& R, int& C) { const int st = b / 1024, sb = b % 1024, swz = sb ^ (((sb >> 9) & 1) << 5); R = (st >> 1) * 16 + swz / 64; C = (st & 1) * 32 + (swz % 64) / 2; }
__host__ __device__ __forceinline__ int perm32(int rho) { const int n = rho >> 4, i = rho & 15; return 8 * (i >> 2) + 4 * n + (i & 3); }

struct Unit { int pm, pn, kind; };
struct Gemm { const bf16_t* A; const bf16_t* Bt; int M, N, K; const bf16_t *A1, *B1, *A2, *B2, *A3, *B3; };

struct StaticOrder {
    static constexpr bool MULTI = false;
    int nM, nN, nwg, G, c;
    __host__ __device__ void init(int M, int N, int G_, int c_) { nM = M / BM; nN = N / BM; nwg = nM * nN; G = G_; c = c_; }
    __host__ __device__ bool next(int i, Unit& u) const {
        const long L = (long)i * G + c; if (L >= nwg) return false;
        int wgid = (int)L; { const int q = nwg / NXCD, r = nwg % NXCD, xcd = wgid % NXCD, off = wgid / NXCD; wgid = (xcd < r ? xcd * (q + 1) : r * (q + 1) + (xcd - r) * q) + off; }
        const int nig = WGM * nN, gid = wgid / nig, fm = gid * WGM, gsz = (nM - fm) < WGM ? (nM - fm) : WGM;
        u.pm = fm + ((wgid % nig) % gsz); u.pn = (wgid % nig) / gsz; u.kind = 0; return true;
    }
    __device__ __forceinline__ void a_ready(const Unit&) const {}
    __device__ __forceinline__ void done(const Unit&) const {}
};

struct MultiOrder {
    static constexpr bool MULTI = true;
    StaticOrder b; int nk;
    __host__ __device__ bool next(int i, Unit& u) const { if (!b.next(i / nk, u)) return false; u.kind = i % nk; return true; }
    __device__ __forceinline__ void a_ready(const Unit&) const {}
    __device__ __forceinline__ void done(const Unit&) const {}
};

__device__ __forceinline__ unsigned cvt_pk_bf16(float lo, float hi) { return ::pk2(lo, hi); }
__device__ __forceinline__ float e_silu(float x) { return x * __builtin_amdgcn_rcpf(1.f + __expf(-x)); }
__device__ __forceinline__ float e_sigm(float x) { return __builtin_amdgcn_rcpf(1.f + __expf(-x)); }
__device__ __forceinline__ float e_lo(unsigned v) { return __uint_as_float(v << 16); }
__device__ __forceinline__ float e_hi(unsigned v) { return __uint_as_float(v & 0xffff0000u); }
__device__ __forceinline__ u32x4 pack8(const f32x4 v0, const f32x4 v1) { u32x4 w; w.x = cvt_pk_bf16(v0[0], v0[1]); w.y = cvt_pk_bf16(v0[2], v0[3]); w.z = cvt_pk_bf16(v1[0], v1[1]); w.w = cvt_pk_bf16(v1[2], v1[3]); return w; }

struct EpiInProj {
    static constexpr bool PERM = true, AFTER_DRAIN = false;
    bf16_t *sz, *xbc, *q, *k, *v;
    __device__ __forceinline__ void operator()(const f32x4 (&acc)[2][2][4][2], const Unit& u, int wr, int wc, int fr, int fq) const {
        const int pn = u.pn; bf16_t* base; int ldc = 1024, colt, mode = 0;
        if (pn < 4) { base = sz; colt = pn * 256; mode = 1; }
        else if (pn < 12) { base = xbc; ldc = 2048; colt = (pn - 4) * 256; }
        else if (pn < 16) { base = q; colt = (pn - 12) * 256; mode = 2; }
        else if (pn < 20) { base = k; colt = (pn - 16) * 256; }
        else { base = v; colt = (pn - 20) * 256; }
        const int row0 = u.pm * BM + wr * 64 + fr, col0 = colt + wc * 32 + 8 * fq;
#pragma unroll
        for (int ai = 0; ai < 2; ++ai)
#pragma unroll
            for (int m = 0; m < 4; ++m) { bf16_t* rowp = base + (size_t)(row0 + ai * HALF + m * 16) * ldc + col0;
#pragma unroll
                for (int bj = 0; bj < 2; ++bj) { f32x4 v0 = acc[ai][bj][m][0], v1 = acc[ai][bj][m][1];
                    if (mode == 1) {
#pragma unroll
                        for (int i = 0; i < 4; ++i) { v0[i] = e_silu(v0[i]); v1[i] = e_silu(v1[i]); } }
                    else if (mode == 2) { v0 = v0 * (0.125f * 1.44269504f); v1 = v1 * (0.125f * 1.44269504f); }
                    *(u32x4*)(rowp + bj * HALF) = pack8(v0, v1); } }
    }
};
__device__ __forceinline__ void ld8(u32x4 (&d)[8], unsigned lo, const char* b0, const char* b1, const char* b2, const char* b3, const char* b4, const char* b5, const char* b6, const char* b7) {
    asm volatile("s_nop 4\n\tglobal_load_dwordx4 %0, %8, %9\n\tglobal_load_dwordx4 %1, %8, %10\n\tglobal_load_dwordx4 %2, %8, %11\n\tglobal_load_dwordx4 %3, %8, %12\n\t"
                 "global_load_dwordx4 %4, %8, %13\n\tglobal_load_dwordx4 %5, %8, %14\n\tglobal_load_dwordx4 %6, %8, %15\n\tglobal_load_dwordx4 %7, %8, %16\n\ts_waitcnt vmcnt(0)"
                 : "=&v"(d[0]), "=&v"(d[1]), "=&v"(d[2]), "=&v"(d[3]), "=&v"(d[4]), "=&v"(d[5]), "=&v"(d[6]), "=&v"(d[7])
                 : "v"(lo), "s"(b0), "s"(b1), "s"(b2), "s"(b3), "s"(b4), "s"(b5), "s"(b6), "s"(b7) : "memory");
}
__device__ __forceinline__ void st16(char* base, unsigned lo, const u32x4 v) { asm volatile("s_nop 4\n\tglobal_store_dwordx4 %0, %1, %2\n\ts_nop 1" :: "v"(lo), "v"(v), "s"(base) : "memory"); }
__device__ __forceinline__ float ub0(unsigned w) { return (float)(w & 0xffu); }
__device__ __forceinline__ float ub1(unsigned w) { return (float)((w >> 8) & 0xffu); }
__device__ __forceinline__ float ub2(unsigned w) { return (float)((w >> 16) & 0xffu); }
__device__ __forceinline__ float ub3(unsigned w) { return (float)(w >> 24); }
__device__ __forceinline__ unsigned gate_q4(const f32x4 v) {
    const unsigned q0 = (unsigned)(e_sigm(v[0]) * 255.f + 0.5f), q1 = (unsigned)(e_sigm(v[1]) * 255.f + 0.5f), q2 = (unsigned)(e_sigm(v[2]) * 255.f + 0.5f), q3 = (unsigned)(e_sigm(v[3]) * 255.f + 0.5f);
    return max(q0, 1u) | (max(q1, 1u) << 8) | (max(q2, 1u) << 16) | (max(q3, 1u) << 24);
}
__device__ __forceinline__ void ld8nt(u32x4 (&d)[8], unsigned lo, const char* b0, const char* b1, const char* b2, const char* b3, const char* b4, const char* b5, const char* b6, const char* b7) {
    asm volatile("s_nop 4\n\tglobal_load_dwordx4 %0, %8, %9 nt\n\tglobal_load_dwordx4 %1, %8, %10 nt\n\tglobal_load_dwordx4 %2, %8, %11 nt\n\tglobal_load_dwordx4 %3, %8, %12 nt\n\t"
                 "global_load_dwordx4 %4, %8, %13 nt\n\tglobal_load_dwordx4 %5, %8, %14 nt\n\tglobal_load_dwordx4 %6, %8, %15 nt\n\tglobal_load_dwordx4 %7, %8, %16 nt\n\ts_waitcnt vmcnt(0)"
                 : "=&v"(d[0]), "=&v"(d[1]), "=&v"(d[2]), "=&v"(d[3]), "=&v"(d[4]), "=&v"(d[5]), "=&v"(d[6]), "=&v"(d[7])
                 : "v"(lo), "s"(b0), "s"(b1), "s"(b2), "s"(b3), "s"(b4), "s"(b5), "s"(b6), "s"(b7) : "memory");
}
__device__ __forceinline__ void st16nt(char* base, unsigned lo, const u32x4 v) { asm volatile("s_nop 4\n\tglobal_store_dwordx4 %0, %1, %2 nt\n\ts_nop 1" :: "v"(lo), "v"(v), "s"(base) : "memory"); }
__device__ __forceinline__ void st16wt(char* base, unsigned lo, const u32x4 v) { asm volatile("s_nop 4\n\tglobal_store_dwordx4 %0, %1, %2 sc0 sc1\n\ts_nop 1" :: "v"(lo), "v"(v), "s"(base) : "memory"); }
struct EpiMix {
    static constexpr bool PERM = true, AFTER_DRAIN = false;
    bf16_t *sg1, *sg2, *mixed; const float* rstd;
    __device__ __forceinline__ bool operator()(f32x4 (&acc)[2][2][4][2], const Unit& u, int wr, int wc, int fr, int fq) const {
        const int kind = u.kind;
        const size_t tile0 = ((size_t)u.pm * BM * 1024 + (size_t)u.pn * BM) * 2;
        const unsigned lo = (unsigned)(((wr * 64 + fr) * 1024 + wc * 32 + 8 * fq) * 2);
        const unsigned lg = (unsigned)(((wr * 4 + wc) * 64 + fq * 16 + fr) * 16);
#define PIECE(ai_, m_, bj_) ((size_t)((((ai_) * HALF + (m_) * 16) * 1024 + (bj_) * HALF) * 2))
        const char* p1 = (const char*)sg1; const char* p2 = (const char*)sg2;
        char* dg = (char*)(kind == 0 ? sg1 : sg2); char* dm = (char*)mixed + tile0;
        float rs[2][4];
#pragma unroll
        for (int ai = 0; ai < 2; ++ai)
#pragma unroll
            for (int m = 0; m < 4; ++m) rs[ai][m] = 1.f;
        if (kind == 2) { const char* rb = (const char*)(rstd + u.pm * BM); const unsigned rl = (unsigned)((wr * 64 + fr) * 4);
            asm volatile("s_nop 4\n\tglobal_load_dword %0, %8, %9\n\tglobal_load_dword %1, %8, %10\n\tglobal_load_dword %2, %8, %11\n\tglobal_load_dword %3, %8, %12\n\t"
                         "global_load_dword %4, %8, %13\n\tglobal_load_dword %5, %8, %14\n\tglobal_load_dword %6, %8, %15\n\tglobal_load_dword %7, %8, %16\n\ts_waitcnt vmcnt(0)"
                         : "=&v"(rs[0][0]), "=&v"(rs[0][1]), "=&v"(rs[0][2]), "=&v"(rs[0][3]), "=&v"(rs[1][0]), "=&v"(rs[1][1]), "=&v"(rs[1][2]), "=&v"(rs[1][3])
                         : "v"(rl), "s"(rb), "s"(rb + 64), "s"(rb + 128), "s"(rb + 192), "s"(rb + 512), "s"(rb + 576), "s"(rb + 640), "s"(rb + 704) : "memory"); }
        u32x4 g[8];
        if (kind == 3) ld8nt(g, lg, p2, p2 + 8192, p2 + 2 * 8192, p2 + 3 * 8192, p2 + 4 * 8192, p2 + 5 * 8192, p2 + 6 * 8192, p2 + 7 * 8192);
        const float k255 = 1.f / 255.f;
#pragma unroll
        for (int ai = 0; ai < 2; ++ai) {
            if (kind == 2) ld8nt(g, lg, p1 + (size_t)((ai * 4 + 0) * 8192), p1 + (size_t)((ai * 4 + 1) * 8192), p1 + (size_t)((ai * 4 + 2) * 8192), p1 + (size_t)((ai * 4 + 3) * 8192),
                                      p2 + (size_t)((ai * 4 + 0) * 8192), p2 + (size_t)((ai * 4 + 1) * 8192), p2 + (size_t)((ai * 4 + 2) * 8192), p2 + (size_t)((ai * 4 + 3) * 8192));
#pragma unroll
            for (int m = 0; m < 4; ++m) {
                f32x4 v00 = acc[ai][0][m][0], v01 = acc[ai][0][m][1], v10 = acc[ai][1][m][0], v11 = acc[ai][1][m][1];
                if (kind < 2) {
                    u32x4 w; w.x = gate_q4(v00); w.y = gate_q4(v01); w.z = gate_q4(v10); w.w = gate_q4(v11);
                    st16nt(dg + (size_t)((ai * 4 + m) * 8192), lg, w);
                } else if (kind == 2) {
                    const u32x4 a = g[m], b = g[4 + m]; const float r_ = rs[ai][m];
#define MXQ(v_, wa_, wb_) do { v_[0] *= r_ * ub0(wa_) * __builtin_amdgcn_rcpf(ub0(wb_)); v_[1] *= r_ * ub1(wa_) * __builtin_amdgcn_rcpf(ub1(wb_)); v_[2] *= r_ * ub2(wa_) * __builtin_amdgcn_rcpf(ub2(wb_)); v_[3] *= r_ * ub3(wa_) * __builtin_amdgcn_rcpf(ub3(wb_)); } while (0)
                    MXQ(v00, a.x, b.x); MXQ(v01, a.y, b.y); MXQ(v10, a.z, b.z); MXQ(v11, a.w, b.w);
#undef MXQ
                    acc[ai][0][m][0] = v00; acc[ai][0][m][1] = v01; acc[ai][1][m][0] = v10; acc[ai][1][m][1] = v11;
                } else {
                    const u32x4 b = g[ai * 4 + m];
#define MXS(v_, wb_) do { v_[0] *= k255 * ub0(wb_); v_[1] *= k255 * ub1(wb_); v_[2] *= k255 * ub2(wb_); v_[3] *= k255 * ub3(wb_); } while (0)
                    MXS(v00, b.x); MXS(v01, b.y); MXS(v10, b.z); MXS(v11, b.w);
#undef MXS
                    st16wt(dm + PIECE(ai, m, 0), lo, pack8(v00, v01)); st16wt(dm + PIECE(ai, m, 1), lo, pack8(v10, v11));
                } }
        }
#undef PIECE
        return kind == 2;
    }
};
struct EpiD3 {
    static constexpr bool PERM = true, AFTER_DRAIN = false;
    bf16_t* h; const float* x; const float* mod;
    __device__ __forceinline__ void operator()(const f32x4 (&acc)[2][2][4][2], const Unit& u, int wr, int wc, int fr, int fq) const {
        const int row0 = u.pm * BM + wr * 64 + fr, col0 = u.pn * BM + wc * 32 + 8 * fq;
        const float* g1 = mod + (size_t)((u.pm * BM) >> 12) * 6144 + 2048;
#pragma unroll
        for (int ai = 0; ai < 2; ++ai)
#pragma unroll
            for (int m = 0; m < 4; ++m) { const size_t off = (size_t)(row0 + ai * HALF + m * 16) * 1024 + col0;
#pragma unroll
                for (int bj = 0; bj < 2; ++bj) { const int c = bj * HALF;
                    const f32x4 x0 = *(const f32x4*)(x + off + c), x1 = *(const f32x4*)(x + off + c + 4), g0 = *(const f32x4*)(g1 + col0 + c), g4 = *(const f32x4*)(g1 + col0 + c + 4);
                    ::st_wt16(h + off + c, pack8(x0 + g0 * acc[ai][bj][m][0], x1 + g4 * acc[ai][bj][m][1])); } }
    }
};
struct EpiZComb {
    static constexpr bool PERM = true, AFTER_DRAIN = false;
    const bf16_t *yf, *yb; bf16_t* uo; float* ss;
    __device__ __forceinline__ void operator()(const f32x4 (&acc)[2][2][4][2], const Unit& u, int wr, int wc, int fr, int fq) const {
        const int row0 = u.pm * BM + wr * 64 + fr, col0 = u.pn * BM + wc * 32 + 8 * fq;
        u32x4 ya[2][4], yb4[2][4];
#define ZC_ISSUE(g_, buf_) do { _Pragma("unroll") for (int mm = 0; mm < 2; ++mm) _Pragma("unroll") for (int bj = 0; bj < 2; ++bj) { \
            const size_t off = (size_t)(row0 + ((g_) >> 1) * HALF + (((g_) & 1) * 2 + mm) * 16) * 1024 + col0 + bj * HALF; \
            ya[buf_][mm * 2 + bj] = __builtin_nontemporal_load((const u32x4*)(yf + off)); yb4[buf_][mm * 2 + bj] = __builtin_nontemporal_load((const u32x4*)(yb + off)); } } while (0)
#define ZC_COMPUTE(g_, buf_) do { _Pragma("unroll") for (int mm = 0; mm < 2; ++mm) { const int ai = (g_) >> 1, m = ((g_) & 1) * 2 + mm, row = row0 + ai * HALF + m * 16; float s = 0.f; \
            _Pragma("unroll") for (int bj = 0; bj < 2; ++bj) { const u32x4 a = ya[buf_][mm * 2 + bj], b = yb4[buf_][mm * 2 + bj]; f32x4 v0 = acc[ai][bj][m][0], v1 = acc[ai][bj][m][1]; \
                _Pragma("unroll") for (int i = 0; i < 4; ++i) { v0[i] = e_silu(v0[i]); v1[i] = e_silu(v1[i]); } \
                v0[0] *= e_lo(a.x) + e_lo(b.x); v0[1] *= e_hi(a.x) + e_hi(b.x); v0[2] *= e_lo(a.y) + e_lo(b.y); v0[3] *= e_hi(a.y) + e_hi(b.y); \
                v1[0] *= e_lo(a.z) + e_lo(b.z); v1[1] *= e_hi(a.z) + e_hi(b.z); v1[2] *= e_lo(a.w) + e_lo(b.w); v1[3] *= e_hi(a.w) + e_hi(b.w); \
                _Pragma("unroll") for (int i = 0; i < 4; ++i) s += v0[i] * v0[i] + v1[i] * v1[i]; \
                ::st_wt16(uo + (size_t)row * 1024 + col0 + bj * HALF, pack8(v0, v1)); } \
            s += __shfl_xor(s, 16); s += __shfl_xor(s, 32); \
            if (fq == 0) ss[(size_t)row * 16 + u.pn * 4 + wc] = s; } } while (0)
        ZC_ISSUE(0, 0); ZC_ISSUE(1, 1); __builtin_amdgcn_sched_barrier(0);
        ZC_COMPUTE(0, 0); __builtin_amdgcn_sched_barrier(0); ZC_ISSUE(2, 0); __builtin_amdgcn_sched_barrier(0);
        ZC_COMPUTE(1, 1); __builtin_amdgcn_sched_barrier(0); ZC_ISSUE(3, 1); __builtin_amdgcn_sched_barrier(0);
        ZC_COMPUTE(2, 0); __builtin_amdgcn_sched_barrier(0);
        ZC_COMPUTE(3, 1);
#undef ZC_ISSUE
#undef ZC_COMPUTE
    }
};
struct EpiQp {
    static constexpr bool PERM = true, AFTER_DRAIN = false;
    bf16_t* qp;
    __device__ __forceinline__ void operator()(const f32x4 (&acc)[2][2][4][2], const Unit& u, int wr, int wc, int fr, int fq) const {
        const int row0 = u.pm * BM + wr * 64 + fr, col0 = u.pn * BM + wc * 32 + 8 * fq;
#pragma unroll
        for (int ai = 0; ai < 2; ++ai)
#pragma unroll
            for (int m = 0; m < 4; ++m) { bf16_t* rowp = qp + (size_t)(row0 + ai * HALF + m * 16) * 2048 + col0;
#pragma unroll
                for (int bj = 0; bj < 2; ++bj) *(u32x4*)(rowp + bj * HALF) = pack8(acc[ai][bj][m][0], acc[ai][bj][m][1]); }
    }
};

template <class Epi, class Sched, bool ALIGN_EPI = false, bool SP2 = false>
__device__ __forceinline__ void gemm_phase(PG8_LAS unsigned char* lds, const Gemm g, const Sched& S, const Epi& E) {
    const int tid = threadIdx.x, wid = __builtin_amdgcn_readfirstlane(tid >> 6), lane = tid & 63, wr = wid >> 2, wc = wid & 3, fr = lane & 15, fq = lane >> 4;
    const int K = g.K, nt = K / BK;
    unsigned voffA[2], voffB[2];
#pragma unroll
    for (int i = 0; i < 2; ++i) { int R, C; stage_rc(tid * 16 + i * 8192, R, C); const int Rb = Epi::PERM ? ((R & ~31) + perm32(R & 31)) : R;
        voffA[i] = (unsigned)(R * K + C) * 2u; voffB[i] = (unsigned)(Rb * K + C) * 2u; }
    const size_t kstep = (size_t)(BK * 2);
    const size_t hstep = (size_t)HALF * K * 2;
    const size_t tstep = 2 * hstep;
    const unsigned ldsw = (unsigned)wid * 1024u;
    const int aoff = lds_byte(wr * 64 + fr, fq * 8), boff = lds_byte(wc * 32 + fr, fq * 8);
#define PG8_SA(b, h) (((b) * 2 + (h)) * HTB)
#define PG8_SB(b, h) ((4 + (b) * 2 + (h)) * HTB)
#define PG8_STAGE(bufoff, gbase, voff) do { _Pragma("unroll") for (int _i = 0; _i < 2; ++_i) \
        __builtin_amdgcn_global_load_lds((const unsigned*)((const char*)(gbase) + (voff)[_i]), (PG8_LAS unsigned*)(lds + (bufoff) + ldsw + _i * 8192), 16, 0, 0); } while (0)
#define PG8_LDA(dst, b, h) do { _Pragma("unroll") for (int m = 0; m < 4; ++m) _Pragma("unroll") for (int k = 0; k < 2; ++k) dst[m][k] = *(const PG8_LAS bf16x8*)(lds + PG8_SA(b, h) + aoff + m * 2048 + k * 1024); } while (0)
#define PG8_LDB(dst, b, h) do { _Pragma("unroll") for (int n = 0; n < 2; ++n) _Pragma("unroll") for (int k = 0; k < 2; ++k) dst[n][k] = *(const PG8_LAS bf16x8*)(lds + PG8_SB(b, h) + boff + n * 2048 + k * 1024); } while (0)
#define PG8_MMA(ai, bj, At, Bt) do { __builtin_amdgcn_s_setprio(1); _Pragma("unroll") for (int m = 0; m < 4; ++m) _Pragma("unroll") for (int n = 0; n < 2; ++n) _Pragma("unroll") for (int k = 0; k < 2; ++k) \
        acc[ai][bj][m][n] = __builtin_amdgcn_mfma_f32_16x16x32_bf16(Bt[n][k], At[m][k], acc[ai][bj][m][n], 0, 0, 0); __builtin_amdgcn_s_setprio(0); } while (0)
#define PG8_WAIT_V(n) asm volatile("s_waitcnt vmcnt(" #n ")" ::: "memory")
#define PG8_WAIT_L(n) asm volatile("s_waitcnt lgkmcnt(" #n ")" ::: "memory")
#define PG8_BAR __builtin_amdgcn_s_barrier()
#define PG8_SCHED __builtin_amdgcn_sched_barrier(0)
    Unit cur, nxt; int ui = 0;
    if (!S.next(0, cur)) return;
    f32x4 acc[2][2][4][2];
#pragma unroll
    for (int a = 0; a < 2; ++a)
#pragma unroll
        for (int b = 0; b < 2; ++b)
#pragma unroll
            for (int m = 0; m < 4; ++m)
#pragma unroll
                for (int n = 0; n < 2; ++n) acc[a][b][m][n] = (f32x4){0.f, 0.f, 0.f, 0.f};
    bf16x8 At[4][2], B0[2][2], B1[2][2];
#define PG8_AB(u_) (Sched::MULTI ? (const char*)((u_).kind == 0 ? g.A : (u_).kind == 1 ? g.A1 : (u_).kind == 2 ? g.A2 : g.A3) : (const char*)g.A)
#define PG8_BB(u_) (Sched::MULTI ? (const char*)((u_).kind == 0 ? g.Bt : (u_).kind == 1 ? g.B1 : (u_).kind == 2 ? g.B2 : g.B3) : (const char*)g.Bt)
    const char* cA = PG8_AB(cur) + (size_t)cur.pm * tstep; const char* cB = PG8_BB(cur) + (size_t)cur.pn * tstep;
    S.a_ready(cur);
    if constexpr (SP2) {
        PG8_STAGE(PG8_SB(0, 0), cB, voffB); PG8_STAGE(PG8_SB(0, 1), cB + hstep, voffB); PG8_STAGE(PG8_SA(0, 0), cA, voffA); PG8_STAGE(PG8_SA(0, 1), cA + hstep, voffA);
        if (wr == 1) PG8_BAR;
        PG8_WAIT_V(2); PG8_BAR;
        PG8_STAGE(PG8_SB(1, 0), cB + kstep, voffB); PG8_STAGE(PG8_SA(1, 0), cA + kstep, voffA); PG8_STAGE(PG8_SB(1, 1), cB + hstep + kstep, voffB);
        PG8_WAIT_V(6); PG8_BAR;
    } else {
        PG8_STAGE(PG8_SB(0, 0), cB, voffB); PG8_STAGE(PG8_SA(0, 0), cA, voffA); PG8_STAGE(PG8_SB(0, 1), cB + hstep, voffB); PG8_STAGE(PG8_SA(0, 1), cA + hstep, voffA);
        if (wr == 1) PG8_BAR;
        PG8_WAIT_V(4); PG8_BAR;
        PG8_STAGE(PG8_SB(1, 0), cB + kstep, voffB); PG8_STAGE(PG8_SA(1, 0), cA + kstep, voffA); PG8_STAGE(PG8_SB(1, 1), cB + hstep + kstep, voffB);
        PG8_WAIT_V(6); PG8_BAR;
    }
    for (;;) {
        const bool has_next = S.next(ui + 1, nxt);
        const char* nA = has_next ? PG8_AB(nxt) + (size_t)nxt.pm * tstep : cA; const char* nB = has_next ? PG8_BB(nxt) + (size_t)nxt.pn * tstep : cB;
        for (int t = 0; t < nt; t += 2) {
            const bool last = (t == nt - 2);
            const char* a1 = cA + (size_t)(t + 1) * kstep;
            const char* a2 = last ? nA : cA + (size_t)(t + 2) * kstep; const char* b2 = last ? nB : cB + (size_t)(t + 2) * kstep;
            const char* a3 = a2 + kstep; const char* b3 = b2 + kstep;
            if (last && has_next) S.a_ready(nxt);
            if constexpr (SP2) {
            PG8_LDB(B0, 0, 0); PG8_LDB(B1, 0, 1); PG8_SCHED; PG8_LDA(At, 0, 0); PG8_STAGE(PG8_SA(1, 1), a1 + hstep, voffA);
            PG8_WAIT_V(8); PG8_WAIT_L(0); PG8_BAR; PG8_MMA(0, 0, At, B0); PG8_MMA(0, 1, At, B1); PG8_BAR; PG8_SCHED;
            PG8_LDA(At, 0, 1); PG8_STAGE(PG8_SB(0, 0), b2, voffB); PG8_STAGE(PG8_SB(0, 1), b2 + hstep, voffB); PG8_STAGE(PG8_SA(0, 0), a2, voffA);
            PG8_WAIT_V(8); PG8_WAIT_L(0); PG8_BAR; PG8_MMA(1, 0, At, B0); PG8_MMA(1, 1, At, B1); PG8_BAR; PG8_SCHED;
            PG8_LDB(B0, 1, 0); PG8_LDB(B1, 1, 1); PG8_SCHED; PG8_LDA(At, 1, 0); PG8_STAGE(PG8_SA(0, 1), a2 + hstep, voffA);
            PG8_WAIT_V(8); PG8_WAIT_L(0); PG8_BAR; PG8_MMA(0, 0, At, B0); PG8_MMA(0, 1, At, B1); PG8_BAR; PG8_SCHED;
            PG8_LDA(At, 1, 1); PG8_STAGE(PG8_SB(1, 0), b3, voffB); PG8_STAGE(PG8_SB(1, 1), b3 + hstep, voffB); PG8_STAGE(PG8_SA(1, 0), a3, voffA);
            PG8_WAIT_V(8); PG8_WAIT_L(0); PG8_BAR; PG8_MMA(1, 0, At, B0); PG8_MMA(1, 1, At, B1); PG8_BAR; PG8_SCHED;
            } else {
            PG8_LDB(B0, 0, 0); PG8_SCHED; PG8_LDA(At, 0, 0); PG8_STAGE(PG8_SA(1, 1), a1 + hstep, voffA);
            PG8_WAIT_L(8); PG8_BAR; PG8_WAIT_L(0); PG8_MMA(0, 0, At, B0); PG8_BAR; PG8_SCHED;
            PG8_LDB(B1, 0, 1); PG8_STAGE(PG8_SB(0, 0), b2, voffB);
            PG8_BAR; PG8_WAIT_L(0); PG8_MMA(0, 1, At, B1); PG8_BAR;
            PG8_LDA(At, 0, 1); PG8_STAGE(PG8_SA(0, 0), a2, voffA);
            PG8_BAR; PG8_WAIT_L(0); PG8_MMA(1, 0, At, B0); PG8_BAR; PG8_SCHED;
            PG8_STAGE(PG8_SB(0, 1), b2 + hstep, voffB);
            PG8_WAIT_V(6); PG8_BAR; PG8_MMA(1, 1, At, B1); PG8_BAR;
            PG8_LDB(B0, 1, 0); PG8_SCHED; PG8_LDA(At, 1, 0); PG8_STAGE(PG8_SA(0, 1), a2 + hstep, voffA);
            PG8_WAIT_L(8); PG8_BAR; PG8_WAIT_L(0); PG8_MMA(0, 0, At, B0); PG8_BAR; PG8_SCHED;
            PG8_LDB(B1, 1, 1); PG8_STAGE(PG8_SB(1, 0), b3, voffB);
            PG8_BAR; PG8_WAIT_L(0); PG8_MMA(0, 1, At, B1); PG8_BAR;
            PG8_LDA(At, 1, 1); PG8_STAGE(PG8_SA(1, 0), a3, voffA);
            PG8_BAR; PG8_WAIT_L(0); PG8_MMA(1, 0, At, B0); PG8_BAR; PG8_SCHED;
            PG8_STAGE(PG8_SB(1, 1), b3 + hstep, voffB);
            PG8_WAIT_V(6); PG8_BAR; PG8_MMA(1, 1, At, B1); PG8_BAR;
            }
        }
        if constexpr (ALIGN_EPI) { if (wr == 0) PG8_BAR; }
        bool keep_acc = false;
        if constexpr (!Epi::AFTER_DRAIN) { if constexpr (Sched::MULTI) keep_acc = E(acc, cur, wr, wc, fr, fq); else E(acc, cur, wr, wc, fr, fq); S.done(cur); }
        if (!has_next) break;
        if (!keep_acc) {
#pragma unroll
        for (int a = 0; a < 2; ++a)
#pragma unroll
            for (int b = 0; b < 2; ++b)
#pragma unroll
                for (int m = 0; m < 4; ++m)
#pragma unroll
                    for (int n = 0; n < 2; ++n) acc[a][b][m][n] = (f32x4){0.f, 0.f, 0.f, 0.f};
        }
        cur = nxt; cA = nA; cB = nB; ++ui;
        if constexpr (ALIGN_EPI) { if (wr == 1) PG8_BAR; }
    }
    PG8_WAIT_V(0);
    if constexpr (!ALIGN_EPI) { if (wr == 0) PG8_BAR; }
    PG8_BAR;
    if constexpr (Epi::AFTER_DRAIN) { E.fused(acc, cur, wr, wc, fr, fq, lds, wid, lane); S.done(cur); }
#undef PG8_AB
#undef PG8_BB
#undef PG8_SA
#undef PG8_SB
#undef PG8_STAGE
#undef PG8_LDA
#undef PG8_LDB
#undef PG8_MMA
#undef PG8_WAIT_V
#undef PG8_WAIT_L
#undef PG8_BAR
#undef PG8_SCHED
}
}


namespace tk {
typedef short bf16x8 __attribute__((ext_vector_type(8)));
constexpr int RSK = 272, TAB = 69632, TABW = 33 * 16 * 4, IJT = TAB + 8 * TABW;
__device__ __forceinline__ float vmaxf(float a, float b) { float r; asm("v_max_f32 %0, %1, %2" : "=v"(r) : "v"(a), "v"(b)); return r; }
__device__ __forceinline__ float vminf(float a, float b) { float r; asm("v_min_f32 %0, %1, %2" : "=v"(r) : "v"(a), "v"(b)); return r; }
__device__ __forceinline__ void ce(float& a, float& b) { const float hi = vmaxf(a, b), lo = vminf(a, b); a = hi; b = lo; }
__device__ __forceinline__ void sort16(float (&v)[16]) {
    ce(v[0], v[13]); ce(v[1], v[12]); ce(v[2], v[15]); ce(v[3], v[14]); ce(v[4], v[8]); ce(v[5], v[6]); ce(v[7], v[11]); ce(v[9], v[10]);
    ce(v[0], v[5]); ce(v[1], v[7]); ce(v[2], v[9]); ce(v[3], v[4]); ce(v[6], v[13]); ce(v[8], v[14]); ce(v[10], v[15]); ce(v[11], v[12]);
    ce(v[0], v[1]); ce(v[2], v[3]); ce(v[4], v[5]); ce(v[6], v[8]); ce(v[7], v[9]); ce(v[10], v[11]); ce(v[12], v[13]); ce(v[14], v[15]);
    ce(v[0], v[2]); ce(v[1], v[3]); ce(v[4], v[10]); ce(v[5], v[11]); ce(v[6], v[7]); ce(v[8], v[9]); ce(v[12], v[14]); ce(v[13], v[15]);
    ce(v[1], v[2]); ce(v[3], v[12]); ce(v[4], v[6]); ce(v[5], v[7]); ce(v[8], v[10]); ce(v[9], v[11]); ce(v[13], v[14]); ce(v[1], v[4]);
    ce(v[2], v[6]); ce(v[5], v[8]); ce(v[7], v[10]); ce(v[9], v[13]); ce(v[11], v[14]); ce(v[2], v[4]); ce(v[3], v[6]); ce(v[9], v[12]);
    ce(v[11], v[13]); ce(v[3], v[5]); ce(v[6], v[8]); ce(v[7], v[9]); ce(v[10], v[12]); ce(v[3], v[4]); ce(v[5], v[6]); ce(v[7], v[8]);
    ce(v[9], v[10]); ce(v[11], v[12]); ce(v[6], v[7]); ce(v[8], v[9]);
}
__device__ __forceinline__ void merge16(float (&a)[16], const float (&b)[16]) {
#pragma unroll
    for (int i = 0; i < 16; ++i) a[i] = vmaxf(a[i], b[15 - i]);
#pragma unroll
    for (int j = 8; j > 0; j >>= 1)
#pragma unroll
        for (int i = 0; i < 16; ++i) { const int l = i ^ j; if (l > i) ce(a[i], a[l]); }
}
__device__ __forceinline__ void xmerge(float (&a)[16], int mask) { float b[16];
#pragma unroll
    for (int i = 0; i < 16; ++i) b[i] = __shfl_xor(a[i], mask);
    merge16(a, b); }
}
constexpr int TK_QOFF = 90112, TK_QSTR = 528;
template <bool OWN, bool LDSQ = false>
__device__ __forceinline__ void p_topk(const Ctx& C, const bf16_t* qp, const bf16_t* keys, unsigned short* pidx, float* pgate, LAS unsigned char* Q = nullptr, int tgbase = 0, int hhf = 0, bool setup = true) {
    using namespace tk;
    LAS unsigned char* L = C.lds;
    const int tid = C.tid, lane = C.lane, w = C.wave, g = lane >> 4, i16 = lane & 15;
    __syncthreads();
    if (setup) {
    for (int i = tid; i < 4096; i += NTHR) { const int r = i >> 4, cc = i & 15; *(LAS u32x4*)(L + r * RSK + cc * 16) = *(const u32x4*)(keys + (size_t)r * 128 + cc * 8); }
    if (tid < 64) { int cnt = 0, fi = 0, fj = 0;
        for (int i = 0; i < 16; ++i) for (int j = 0; j < 16; ++j) if ((i + 1) * (j + 1) <= 16) { if (cnt == tid) { fi = i; fj = j; } ++cnt; }
        ((LAS unsigned*)(L + IJT))[tid] = (unsigned)(fi | (fj << 4)); }
    __syncthreads(); }
    LAS unsigned* tab = (LAS unsigned*)(L + TAB + w * TABW) + i16 * 33;
    const LAS unsigned* ijt = (const LAS unsigned*)(L + IJT);
    const float NEGV = -1.0e30f;
    const int gw = C.bid * NWAVES + w, NGW = C.G * NWAVES;
    pg8::StaticOrder SO; SO.init(T, 2048, C.G, C.bid);
    for (int unit = OWN ? w : gw; ; unit += OWN ? NWAVES : NGW) {
        int tg, hh;
        if constexpr (LDSQ) { if (unit >= 8) break; tg = tgbase + unit; hh = hhf; }
        else if constexpr (OWN) { pg8::Unit u; if (!SO.next(unit >> 4, u)) break; tg = 16 * u.pm + (unit & 15); hh = u.pn; }
        else { if (unit >= (T / 16) * 8) break; tg = unit >> 3; hh = unit & 7; }
        const size_t t0 = (size_t)tg * 16;
        float s1[16], s2[16];
#pragma unroll
        for (int z = 0; z < 2; ++z) {
            bf16x8 qf[4];
#pragma unroll
            for (int ks = 0; ks < 4; ++ks) { if constexpr (LDSQ) qf[ks] = *(const LAS bf16x8*)(Q + (16 * unit + i16) * TK_QSTR + z * 256 + ks * 64 + g * 16);
                else qf[ks] = *(const bf16x8*)(qp + (t0 + i16) * 2048 + hh * 256 + z * 128 + ks * 32 + g * 8); }
            float lo[16], hi[16];
#pragma unroll
            for (int nt = 0; nt < 8; ++nt) { f32x4 acc = (f32x4){0.f, 0.f, 0.f, 0.f};
#pragma unroll
                for (int ks = 0; ks < 4; ++ks) { const bf16x8 kf = *(const LAS bf16x8*)(L + (z * 128 + 16 * nt + i16) * RSK + ks * 64 + g * 16);
                    acc = __builtin_amdgcn_mfma_f32_16x16x32_bf16(kf, qf[ks], acc, 0, 0, 0); }
#pragma unroll
                for (int r = 0; r < 4; ++r) { const float pv = __uint_as_float((__float_as_uint(acc[r]) & 0xFFFFFF80u) | (unsigned)(16 * nt + 4 * g + r));
                    if (nt < 4) lo[nt * 4 + r] = pv; else hi[(nt - 4) * 4 + r] = pv; } }
            sort16(lo); sort16(hi); merge16(lo, hi);
            xmerge(lo, 16); xmerge(lo, 32);
#pragma unroll
            for (int i = 0; i < 16; ++i) { if (z == 0) s1[i] = lo[i]; else s2[i] = lo[i]; }
        }
#pragma unroll
        for (int i = 0; i < 16; ++i) { tab[i] = __float_as_uint(s1[i]); tab[16 + i] = __float_as_uint(s2[i]); }
        float cand[16];
            { const float a_ = (g == 0 ? s1[0] : g == 1 ? s1[1] : g == 2 ? s1[3] : s1[14]), b_ = (g == 0 ? s2[0] : g == 1 ? s2[0] : g == 2 ? s2[3] : s2[0]); cand[0] = __uint_as_float((__float_as_uint(a_ + b_) & 0xFFFFFFC0u) | (unsigned)(16 * g + 0)); }
            { const float a_ = (g == 0 ? s1[0] : g == 1 ? s1[1] : g == 2 ? s1[4] : s1[15]), b_ = (g == 0 ? s2[1] : g == 1 ? s2[1] : g == 2 ? s2[0] : s2[0]); cand[1] = __uint_as_float((__float_as_uint(a_ + b_) & 0xFFFFFFC0u) | (unsigned)(16 * g + 1)); }
            { const float a_ = (g == 0 ? s1[0] : g == 1 ? s1[1] : g == 2 ? s1[4] : NEGV), b_ = (g == 0 ? s2[2] : g == 1 ? s2[2] : g == 2 ? s2[1] : NEGV); cand[2] = __uint_as_float((__float_as_uint(a_ + b_) & 0xFFFFFFC0u) | (unsigned)(16 * g + 2)); }
            { const float a_ = (g == 0 ? s1[0] : g == 1 ? s1[1] : g == 2 ? s1[4] : NEGV), b_ = (g == 0 ? s2[3] : g == 1 ? s2[3] : g == 2 ? s2[2] : NEGV); cand[3] = __uint_as_float((__float_as_uint(a_ + b_) & 0xFFFFFFC0u) | (unsigned)(16 * g + 3)); }
            { const float a_ = (g == 0 ? s1[0] : g == 1 ? s1[1] : g == 2 ? s1[5] : NEGV), b_ = (g == 0 ? s2[4] : g == 1 ? s2[4] : g == 2 ? s2[0] : NEGV); cand[4] = __uint_as_float((__float_as_uint(a_ + b_) & 0xFFFFFFC0u) | (unsigned)(16 * g + 4)); }
            { const float a_ = (g == 0 ? s1[0] : g == 1 ? s1[1] : g == 2 ? s1[5] : NEGV), b_ = (g == 0 ? s2[5] : g == 1 ? s2[5] : g == 2 ? s2[1] : NEGV); cand[5] = __uint_as_float((__float_as_uint(a_ + b_) & 0xFFFFFFC0u) | (unsigned)(16 * g + 5)); }
            { const float a_ = (g == 0 ? s1[0] : g == 1 ? s1[1] : g == 2 ? s1[6] : NEGV), b_ = (g == 0 ? s2[6] : g == 1 ? s2[6] : g == 2 ? s2[0] : NEGV); cand[6] = __uint_as_float((__float_as_uint(a_ + b_) & 0xFFFFFFC0u) | (unsigned)(16 * g + 6)); }
            { const float a_ = (g == 0 ? s1[0] : g == 1 ? s1[1] : g == 2 ? s1[6] : NEGV), b_ = (g == 0 ? s2[7] : g == 1 ? s2[7] : g == 2 ? s2[1] : NEGV); cand[7] = __uint_as_float((__float_as_uint(a_ + b_) & 0xFFFFFFC0u) | (unsigned)(16 * g + 7)); }
            { const float a_ = (g == 0 ? s1[0] : g == 1 ? s1[2] : g == 2 ? s1[7] : NEGV), b_ = (g == 0 ? s2[8] : g == 1 ? s2[0] : g == 2 ? s2[0] : NEGV); cand[8] = __uint_as_float((__float_as_uint(a_ + b_) & 0xFFFFFFC0u) | (unsigned)(16 * g + 8)); }
            { const float a_ = (g == 0 ? s1[0] : g == 1 ? s1[2] : g == 2 ? s1[7] : NEGV), b_ = (g == 0 ? s2[9] : g == 1 ? s2[1] : g == 2 ? s2[1] : NEGV); cand[9] = __uint_as_float((__float_as_uint(a_ + b_) & 0xFFFFFFC0u) | (unsigned)(16 * g + 9)); }
            { const float a_ = (g == 0 ? s1[0] : g == 1 ? s1[2] : g == 2 ? s1[8] : NEGV), b_ = (g == 0 ? s2[10] : g == 1 ? s2[2] : g == 2 ? s2[0] : NEGV); cand[10] = __uint_as_float((__float_as_uint(a_ + b_) & 0xFFFFFFC0u) | (unsigned)(16 * g + 10)); }
            { const float a_ = (g == 0 ? s1[0] : g == 1 ? s1[2] : g == 2 ? s1[9] : NEGV), b_ = (g == 0 ? s2[11] : g == 1 ? s2[3] : g == 2 ? s2[0] : NEGV); cand[11] = __uint_as_float((__float_as_uint(a_ + b_) & 0xFFFFFFC0u) | (unsigned)(16 * g + 11)); }
            { const float a_ = (g == 0 ? s1[0] : g == 1 ? s1[2] : g == 2 ? s1[10] : NEGV), b_ = (g == 0 ? s2[12] : g == 1 ? s2[4] : g == 2 ? s2[0] : NEGV); cand[12] = __uint_as_float((__float_as_uint(a_ + b_) & 0xFFFFFFC0u) | (unsigned)(16 * g + 12)); }
            { const float a_ = (g == 0 ? s1[0] : g == 1 ? s1[3] : g == 2 ? s1[11] : NEGV), b_ = (g == 0 ? s2[13] : g == 1 ? s2[0] : g == 2 ? s2[0] : NEGV); cand[13] = __uint_as_float((__float_as_uint(a_ + b_) & 0xFFFFFFC0u) | (unsigned)(16 * g + 13)); }
            { const float a_ = (g == 0 ? s1[0] : g == 1 ? s1[3] : g == 2 ? s1[12] : NEGV), b_ = (g == 0 ? s2[14] : g == 1 ? s2[1] : g == 2 ? s2[0] : NEGV); cand[14] = __uint_as_float((__float_as_uint(a_ + b_) & 0xFFFFFFC0u) | (unsigned)(16 * g + 14)); }
            { const float a_ = (g == 0 ? s1[0] : g == 1 ? s1[3] : g == 2 ? s1[13] : NEGV), b_ = (g == 0 ? s2[15] : g == 1 ? s2[2] : g == 2 ? s2[0] : NEGV); cand[15] = __uint_as_float((__float_as_uint(a_ + b_) & 0xFFFFFFC0u) | (unsigned)(16 * g + 15)); }
        sort16(cand);
        xmerge(cand, 16); xmerge(cand, 32);
        float den = 0.f, ex[16];
#pragma unroll
        for (int i = 0; i < 16; ++i) { ex[i] = __expf(cand[i] - cand[0]); den += ex[i]; }
        const float inv = __builtin_amdgcn_rcpf(den);
        unsigned short eo[4]; float go[4];
#pragma unroll
        for (int e = 0; e < 4; ++e) {
            const float cv = (g == 0 ? cand[e] : g == 1 ? cand[4 + e] : g == 2 ? cand[8 + e] : cand[12 + e]);
            const float gv = (g == 0 ? ex[e] : g == 1 ? ex[4 + e] : g == 2 ? ex[8 + e] : ex[12 + e]);
            const unsigned code = __float_as_uint(cv) & 63u; const unsigned ij = ijt[code];
            const unsigned p1 = tab[ij & 15u], p2 = tab[16 + (ij >> 4)];
            eo[e] = (unsigned short)((p1 & 127u) * 128u + (p2 & 127u)); go[e] = gv * inv; }
        u32x2 ov; ov.x = (unsigned)eo[0] | ((unsigned)eo[1] << 16); ov.y = (unsigned)eo[2] | ((unsigned)eo[3] << 16);
        *(u32x2*)(pidx + (t0 + i16) * 128 + hh * 16 + 4 * g) = ov;
        *(f32x4*)(pgate + (t0 + i16) * 128 + hh * 16 + 4 * g) = (f32x4){go[0], go[1], go[2], go[3]};
    }
    __syncthreads();
}

#define GAS __attribute__((address_space(1)))
typedef GAS unsigned gu32;
#define RLX_AGENT __ATOMIC_RELAXED, __HIP_MEMORY_SCOPE_AGENT
namespace pg8 {
struct SkipOrder {
    static constexpr bool MULTI = false;
    StaticOrder b;
    __device__ __forceinline__ bool next(int i, Unit& u) const { if (!b.next(i, u)) return false; u.pn += 12; return true; }
    __device__ __forceinline__ void a_ready(const Unit&) const {}
    __device__ __forceinline__ void done(const Unit&) const {}
};
struct EpiConvFused {
    static constexpr bool PERM = true, AFTER_DRAIN = true;
    const float* cw; const float* cb; bf16_t* xc; bf16_t* edge;
    __device__ __forceinline__ void operator()(const f32x4 (&)[2][2][4][2], const Unit&, int, int, int, int) const {}
    __device__ __forceinline__ void fused(const f32x4 (&acc)[2][2][4][2], const Unit& u, int wr, int wc, int fr, int fq, PG8_LAS unsigned char* lds, int wid, int lane) const {
        asm volatile("" : "+v"(lane), "+v"(fr), "+v"(fq));
        constexpr int LS = 528;
        PG8_LAS unsigned char* wb = lds + (64 * wr + fr) * LS + (32 * wc + 8 * fq) * 2;
#pragma unroll
        for (int ai = 0; ai < 2; ++ai)
#pragma unroll
            for (int m = 0; m < 4; ++m)
#pragma unroll
                for (int bj = 0; bj < 2; ++bj) *(PG8_LAS u32x4*)(wb + (128 * ai + 16 * m) * LS + bj * 256) = pack8(acc[ai][bj][m][0], acc[ai][bj][m][1]);
        __syncthreads();
        const int tid = wid * 64 + lane, cg = tid & 31, rc = tid >> 5, pnl = u.pn - 4, ch = pnl * 256 + cg * 8;
        float w[5][8], bias[8];
#pragma unroll
        for (int j = 0; j < 5; ++j) { const f32x4 w0 = *(const f32x4*)(cw + j * 2048 + ch), w1 = *(const f32x4*)(cw + j * 2048 + ch + 4);
            w[j][0] = w0.x; w[j][1] = w0.y; w[j][2] = w0.z; w[j][3] = w0.w; w[j][4] = w1.x; w[j][5] = w1.y; w[j][6] = w1.z; w[j][7] = w1.w; }
        { const f32x4 b0 = *(const f32x4*)(cb + ch), b1 = *(const f32x4*)(cb + ch + 4); bias[0] = b0.x; bias[1] = b0.y; bias[2] = b0.z; bias[3] = b0.w; bias[4] = b1.x; bias[5] = b1.y; bias[6] = b1.z; bias[7] = b1.w; }
#pragma unroll
        for (int hb = 0; hb < 2; ++hb) {
            const int r0 = 16 * rc + 8 * hb;
            u32x4 rw[12];
#pragma unroll
            for (int rr = 0; rr < 12; ++rr) { const int ri = r0 + rr - 2; rw[rr] = (u32x4){0u, 0u, 0u, 0u};
                if (ri >= 0 && ri < 256) rw[rr] = *(const PG8_LAS u32x4*)(lds + ri * LS + cg * 16); }
            float a8[8][8];
#pragma unroll
            for (int o = 0; o < 8; ++o)
#pragma unroll
                for (int q = 0; q < 8; ++q) a8[o][q] = bias[q];
#pragma unroll
            for (int rr = 0; rr < 12; ++rr) {
                const float x[8] = {e_lo(rw[rr].x), e_hi(rw[rr].x), e_lo(rw[rr].y), e_hi(rw[rr].y), e_lo(rw[rr].z), e_hi(rw[rr].z), e_lo(rw[rr].w), e_hi(rw[rr].w)};
#pragma unroll
                for (int j = 0; j < 5; ++j) { const int o = rr - j; if (o >= 0 && o < 8) {
#pragma unroll
                    for (int q = 0; q < 8; ++q) a8[o][q] += w[j][q] * x[q]; } }
            }
#pragma unroll
            for (int o = 0; o < 8; ++o) { const int ro = r0 + o;
                if (ro >= 2 && ro <= 253) { u32x4 ov; ov.x = cvt_pk_bf16(e_silu(a8[o][0]), e_silu(a8[o][1])); ov.y = cvt_pk_bf16(e_silu(a8[o][2]), e_silu(a8[o][3])); ov.z = cvt_pk_bf16(e_silu(a8[o][4]), e_silu(a8[o][5])); ov.w = cvt_pk_bf16(e_silu(a8[o][6]), e_silu(a8[o][7]));
                    ::st_wt16(xc + (size_t)(u.pm * BM + ro) * 2048 + ch, ov); } }
        }
        if (tid < 256) { const int e = tid >> 5, c2 = tid & 31, row = e < 4 ? e : 248 + e;
            *(u32x4*)(edge + ((size_t)((u.pm * 8 + pnl) * 8 + e)) * 256 + c2 * 8) = *(const PG8_LAS u32x4*)(lds + row * LS + c2 * 16); }
        __syncthreads();
    }
};
struct OneUnit {
    static constexpr bool MULTI = false;
    Unit u;
    __device__ __forceinline__ bool next(int i, Unit& o) const { if (i != 0) return false; o = u; return true; }
    __device__ __forceinline__ void a_ready(const Unit&) const {}
    __device__ __forceinline__ void done(const Unit&) const {}
};
struct EpiQpFused {
    static constexpr bool PERM = true, AFTER_DRAIN = true;
    const Ctx* C; const bf16_t* keys; unsigned short* pidx; float* pgate;
    __device__ __forceinline__ void operator()(const f32x4 (&)[2][2][4][2], const Unit&, int, int, int, int) const {}
    __device__ __forceinline__ void fused(const f32x4 (&acc)[2][2][4][2], const Unit& u, int wr, int wc, int fr, int fq, PG8_LAS unsigned char* lds, int wid, int lane) const {
        Ctx C2 = *C; asm volatile("" : "+v"(C2.lane), "+v"(C2.tid), "+v"(fr), "+v"(fq));
        u32x4 q1[8];
#pragma unroll
        for (int m = 0; m < 4; ++m)
#pragma unroll
            for (int bj = 0; bj < 2; ++bj) q1[2 * m + bj] = pack8(acc[1][bj][m][0], acc[1][bj][m][1]);
        PG8_LAS unsigned char* qb = lds + TK_QOFF + (64 * wr + fr) * TK_QSTR + (32 * wc + 8 * fq) * 2;
#pragma unroll
        for (int m = 0; m < 4; ++m)
#pragma unroll
            for (int bj = 0; bj < 2; ++bj) *(PG8_LAS u32x4*)(qb + 16 * m * TK_QSTR + bj * 256) = pack8(acc[0][bj][m][0], acc[0][bj][m][1]);
        ::p_topk<true, true>(C2, nullptr, keys, pidx, pgate, lds + TK_QOFF, (u.pm * 256) >> 4, u.pn, true);
#pragma unroll
        for (int m = 0; m < 4; ++m)
#pragma unroll
            for (int bj = 0; bj < 2; ++bj) *(PG8_LAS u32x4*)(qb + 16 * m * TK_QSTR + bj * 256) = q1[2 * m + bj];
        ::p_topk<true, true>(C2, nullptr, keys, pidx, pgate, lds + TK_QOFF, (u.pm * 256 + 128) >> 4, u.pn, false);
    }
};
}

#define XB_TMO      128
#define XB_XCNT(j)  (256  + 64 * (j))
#define XB_XSUB(j)  (1280 + 64 * (j))
#define XB_XGEN(j)  (2304 + 64 * (j))
#define XB_TOP      3328
#define XB_TOPGEN   3392
#define XCD_BAR_WORDS 3456
#define XB_SPIN_CAP (1u << 18)

__device__ __forceinline__ unsigned xb_ld(unsigned* p)              { return __hip_atomic_load(p, __ATOMIC_RELAXED, __HIP_MEMORY_SCOPE_AGENT); }
__device__ __forceinline__ unsigned xb_add(unsigned* p, unsigned v) { return __hip_atomic_fetch_add(p, v, __ATOMIC_RELAXED, __HIP_MEMORY_SCOPE_AGENT); }
__device__ __forceinline__ unsigned xb_xcc_id() { return (unsigned)__builtin_amdgcn_s_getreg((3 << 11) | 20) & 0xFu; }
#define XB_SPIN(cond, bar) do { unsigned _sp = 0; while (cond) { __builtin_amdgcn_s_sleep(1); \
    if ((++_sp & 255u) == 0u) { if (xb_ld(&(bar)[XB_TMO])) break; if (_sp > XB_SPIN_CAP) { atomicAdd(&(bar)[XB_TMO], 1u); break; } } } } while (0)

struct XcdBarrier {
    unsigned* bar; unsigned x;
    volatile LAS unsigned* st;
};

__device__ __forceinline__ XcdBarrier xcd_barrier_post(unsigned* bar, volatile LAS unsigned* st) {
    XcdBarrier b; b.bar = bar; b.x = xb_xcc_id(); b.st = st;
    if (threadIdx.x == 0) (void)xb_add(&bar[XB_XCNT(b.x)], 1u);
    return b;
}
__device__ __forceinline__ void xcd_barrier_complete(unsigned* bar, unsigned x, unsigned& nloc, unsigned& nx) {
    const unsigned G = gridDim.x * gridDim.y * gridDim.z;
    unsigned sum, cnt, mine, sp = 0u;
    for (;;) {
        sum = 0u; cnt = 0u; mine = 0u;
#pragma unroll
        for (unsigned j = 0; j < 16; ++j) { const unsigned c = xb_ld(&bar[XB_XCNT(j)]); sum += c; cnt += (c > 0u) ? 1u : 0u; mine = (j == x) ? c : mine; }
        if (sum == G) break;
        __builtin_amdgcn_s_sleep(1);
        if ((++sp & 255u) == 0u) { if (xb_ld(&bar[XB_TMO])) break; if (sp > XB_SPIN_CAP) { atomicAdd(&bar[XB_TMO], 1u); break; } }
    }
    nloc = mine > 0u ? mine : 1u; nx = cnt > 0u ? cnt : 1u;
}

__device__ __forceinline__ void xcd_barrier(const XcdBarrier& b) {
    asm volatile("s_waitcnt vmcnt(0)" ::: "memory");
    __syncthreads();
    if (threadIdx.x == 0) {
        unsigned* bar = b.bar;
        __builtin_amdgcn_s_waitcnt(0);
        unsigned nloc = b.st[0], nx = b.st[1];
        if (nloc == 0u) { xcd_barrier_complete(bar, b.x, nloc, nx); b.st[0] = nloc; b.st[1] = nx; }
        const unsigned old = xb_add(&bar[XB_XSUB(b.x)], 1u);
        const unsigned gen = old / nloc;
        if (old + 1u == (gen + 1u) * nloc) {
            __builtin_amdgcn_fence(__ATOMIC_RELEASE, "agent");
            asm volatile("s_waitcnt vmcnt(0)" ::: "memory");
            const unsigned og = xb_add(&bar[XB_TOP], 1u);
            const unsigned tg = og / nx;
            if (og + 1u == (tg + 1u) * nx) xb_add(&bar[XB_TOPGEN], 1u);
            else XB_SPIN(xb_ld(&bar[XB_TOPGEN]) == tg, bar);
            __builtin_amdgcn_fence(__ATOMIC_ACQUIRE, "agent");
            xb_add(&bar[XB_XGEN(b.x)], 1u);
            asm volatile("s_waitcnt vmcnt(0)" ::: "memory");
        } else {
            XB_SPIN(xb_ld(&bar[XB_XGEN(b.x)]) == gen, bar);
            __builtin_amdgcn_fence(__ATOMIC_ACQUIRE, "agent");
            asm volatile("s_waitcnt vmcnt(0)" ::: "memory");
        }
    }
    __syncthreads();
}


constexpr int N_PHASES = 14;
constexpr int CW_BAR = 4096;
constexpr size_t CTL_ZERO_BYTES = 64 * 1024;
constexpr int MISC_OFF = LDS_BYTES - 256;

template <int PH>
__device__ __forceinline__ void run_phase(const Ctx& C, const Args& a) {
    bf16_t* R0 = C.bfp(WS_R0); bf16_t* R1 = C.bfp(WS_R1); bf16_t* R2 = C.bfp(WS_R2); bf16_t* R3 = C.bfp(WS_R3);
    bf16_t* OB = (bf16_t*)a.out;
    const size_t TD = (size_t)T * 1024;
    if constexpr (PH == 0) p_prep(C);
    if constexpr (PH == 1) p_rownorm(C, C.in[0], C.in[4], 0, 1024, R0);
    if constexpr (PH == 2) {
        pg8::Gemm g{R0, C.bfp(WS_WIN_T), T, 6144, 1024};
        { pg8::SkipOrder S; S.b.init(T, 3072, C.G, C.bid);
          pg8::EpiInProj e{R1, R2, R3, R3 + TD, R3 + 2 * TD};
          pg8::gemm_phase<pg8::EpiInProj, pg8::SkipOrder, true, true>(C.lds, g, S, e); }
        { pg8::StaticOrder S2; S2.init(T, 2048, C.G, C.bid);
          pg8::EpiConvFused ec{C.in[6], C.in[7], OB, C.bfp(WS_EDGE)};
          pg8::Unit u;
          for (int i = 0; S2.next(i, u); ++i) { u.pn += 4; pg8::OneUnit S1{u}; pg8::gemm_phase<pg8::EpiConvFused, pg8::OneUnit, true, true>(C.lds, g, S1, ec); } }
        p_dt(C, R0, C.bfp(WS_WDT_T), C.f32p(WS_DT));
    }
    if constexpr (PH == 3) { p_conv_fix(C, C.bfp(WS_EDGE), OB); p_na(C, R3, R3 + TD, R3 + 2 * TD); }
    if constexpr (PH == 4) p_ssd(C, OB, C.f32p(WS_DT), R2, R2 + TD);
    if constexpr (PH == 5) {
        pg8::Gemm g{R0, C.bfp(WS_WIN_T), T, 1024, 1024}; pg8::StaticOrder S; S.init(T, 1024, C.G, C.bid);
        pg8::EpiZComb e{R2, R2 + TD, R1, C.f32p(WS_EDGE)}; pg8::gemm_phase<pg8::EpiZComb, pg8::StaticOrder, true, true>(C.lds, g, S, e); }
    if constexpr (PH == 6) {
        pg8::MultiOrder S; S.b.init(T, 1024, C.G, C.bid); S.nk = 4;
        { pg8::Unit u; const float* ss = C.f32p(WS_EDGE); float* rstd = C.f32p(WS_RSTD);
          for (int i = 0; S.b.next(i, u); ++i) { const int row = u.pm * 256 + (C.tid >> 1); const f32x4* sp = (const f32x4*)(ss + (size_t)row * 16 + (C.tid & 1) * 8);
              const f32x4 s0 = sp[0], s1 = sp[1]; float sum = ((s0[0] + s0[1]) + (s0[2] + s0[3])) + ((s1[0] + s1[1]) + (s1[2] + s1[3])); sum += __shfl_xor(sum, 1);
              if ((C.tid & 1) == 0) rstd[row] = rsqrtf(sum * (1.f / 1024.f) + EPS); }
          asm volatile("s_waitcnt vmcnt(0)" ::: "memory"); __syncthreads(); }
        pg8::Gemm g{R0, C.bfp(WS_WG_T), T, 1024, 1024, R0, C.bfp(WS_WG_T) + (size_t)1024 * 1024, R1, C.bfp(WS_WSSD_T), R3, C.bfp(WS_WNA_T)};
        pg8::EpiMix e{OB + (size_t)C.bid * 131072, OB + (size_t)C.bid * 131072 + 65536, R2 + TD, C.f32p(WS_RSTD)};
        pg8::gemm_phase<pg8::EpiMix, pg8::MultiOrder, true, true>(C.lds, g, S, e);
    }
    if constexpr (PH == 7) { pg8::Gemm g{R2 + TD, C.bfp(WS_WOUT_T), T, 1024, 1024}; pg8::StaticOrder S; S.init(T, 1024, C.G, C.bid);
        pg8::EpiD3 e{R3 + TD, C.in[0], C.f32p(WS_MOD)}; pg8::gemm_phase<pg8::EpiD3, pg8::StaticOrder, true, true>(C.lds, g, S, e); }
    if constexpr (PH == 8) { p_rownorm_b(C, R3 + TD, C.in[18], 3072, 4096, R0); p_cvt_tables8(C, (unsigned char*)R2, (unsigned char*)R2 + (size_t)16384 * 1024); }
    if constexpr (PH == 9) {
        pg8::Gemm g{R0, C.bfp(WS_WPQ_T), T, 2048, 1024}; pg8::StaticOrder S; S.init(T, 2048, C.G, C.bid);
        pg8::EpiQpFused e{&C, C.bfp(WS_KEYS), (unsigned short*)R1, (float*)(R1 + 4 * MiB)};
        pg8::Unit u;
        for (int i = 0; S.next(i, u); ++i) { pg8::OneUnit S1{u}; pg8::gemm_phase<pg8::EpiQpFused, pg8::OneUnit, true, true>(C.lds, g, S1, e); __syncthreads(); }
    }
    if constexpr (PH == 10) p_gu(C, R0, (const unsigned short*)R1, (const unsigned char*)R2, a.out);
    if constexpr (PH == 11) p_gc(C, a.out, (const float*)(R1 + 4 * MiB), (float*)((unsigned char*)R2 + 32 * MiB));
    if constexpr (PH == 12) p_gv(C, (const float*)((unsigned char*)R2 + 32 * MiB), (const unsigned short*)R1, (const unsigned char*)R2 + (size_t)16384 * 1024, R3);
    if constexpr (PH == 13) p_gf(C, R3 + TD, R3, a.out);
}

template <int PH> struct PhaseLoop {
    static __device__ __forceinline__ void run(const Ctx& C, const Args& a, const XcdBarrier& bar) {
        if (PH >= a.ph_lo && PH < a.ph_hi) { run_phase<PH>(C, a); if (PH + 1 < a.ph_hi) xcd_barrier(bar); }
        PhaseLoop<PH + 1>::run(C, a, bar);
    }
};
template <> struct PhaseLoop<N_PHASES> { static __device__ __forceinline__ void run(const Ctx&, const Args&, const XcdBarrier&) {} };

__global__ void __launch_bounds__(NTHR, 2) mega(Args a) {
    extern __shared__ __attribute__((aligned(16))) unsigned char lds_raw[];
    Ctx C; C.in = a.in; C.out = a.out; C.ws = a.ws; C.tid = threadIdx.x; C.lane = C.tid & 63; C.wave = __builtin_amdgcn_readfirstlane(C.tid >> 6);
    C.G = gridDim.x; C.bid = blockIdx.x; C.lds = (LAS unsigned char*)lds_raw;
    volatile LAS unsigned* MISC = (volatile LAS unsigned*)(C.lds + MISC_OFF);
    if (C.tid < 64) MISC[C.tid] = 0u;
    __syncthreads();
    XcdBarrier bar; bar.bar = (unsigned*)(a.ws + WS_CTL) + CW_BAR; bar.x = 0; bar.st = nullptr;
    if (a.ph_hi - a.ph_lo > 1) bar = xcd_barrier_post((unsigned*)(a.ws + WS_CTL) + CW_BAR, MISC + 8);
    PhaseLoop<0>::run(C, a, bar);
}

extern "C" void kernel_launch(void* const* d_in, const int* in_sizes, int n_in, void* d_out, int out_size, void* d_ws, size_t ws_size, hipStream_t stream) {
    static int grid = 0;
    if (grid == 0) {
        if (n_in != 24 || out_size != T * D || ws_size < WS_END) { fprintf(stderr, "kernel_launch: unexpected shapes n_in %d out %d ws %zu\n", n_in, out_size, ws_size); grid = -1; return; }
        int dev = 0, cus = 0;
        if (hipGetDevice(&dev) != hipSuccess || hipDeviceGetAttribute(&cus, hipDeviceAttributeMultiprocessorCount, dev) != hipSuccess) { grid = -1; return; }
        if (hipFuncSetAttribute((const void*)mega, hipFuncAttributeMaxDynamicSharedMemorySize, LDS_BYTES) != hipSuccess) { grid = -1; return; }
        grid = cus;
    }
    if (grid < 0) return;
    (void)hipMemsetAsync((char*)d_ws + WS_CTL, 0, CTL_ZERO_BYTES, stream);
    Args a{};
    for (int i = 0; i < 24; ++i) a.in[i] = (const float*)d_in[i];
    a.out = (float*)d_out; a.ws = (unsigned char*)d_ws;
    a.ph_lo = 0; a.ph_hi = N_PHASES;
    hipLaunchKernelGGL(mega, dim3(grid), dim3(NTHR), LDS_BYTES, stream, a);
}
```
